# Optimizing an MI355X kernel written in HIP

```python
import math
import jax
import jax.numpy as jnp
from jax import lax
import numpy as np

D_MODEL = 1024
BATCH = 8
SEQ = 2048
DEPTH = 2

GRID_W = 64
CTX_LEN = 256
HEAD_DIM = 64

HY_CH = 256
HY_SHORT = 3
HY_BANDS = 16
HY_EMB = 1 + 2 * HY_BANDS
HY_FFN = 64
HY_DECAY_MIN = -math.log(1e-2) / 1.5
HY_DECAY_MAX = -math.log(1e-2) / 0.3
HY_FILTER_SCALE = 0.05

WA_HEADS = 4
WA_KV_HEADS = 2
WINDOW = 128
WA_BLOCK = 128

NA_HEADS = 4
NA_KR = 8
NA_KC = 16

GDN_HEADS = 4
GDN_CONV = 4
GDN_CHUNK = 64

HY_IN = 3 * HY_CH
WA_IN = (WA_HEADS + 2 * WA_KV_HEADS) * HEAD_DIM
NA_IN = 3 * NA_HEADS * HEAD_DIM
GDN_W = GDN_HEADS * HEAD_DIM
GDN_IN = 4 * GDN_W + 4 * GDN_HEADS
D_IN = HY_IN + WA_IN + NA_IN + GDN_IN
D_MIX = HY_CH + (WA_HEADS + NA_HEADS) * HEAD_DIM + GDN_W

N_EXPERTS = 32
TOP_K = 4
D_EXPERT = 256
D_SHARED = 256
ROUTED_SCALE = 2.5
MOE_BLOCK = 128

ROPE_BASE = 10000.0
EPS = 1e-6
NEG = -1e30

kernel_name = 'hymba_hybrid_dit_moe_block'


def rmsnorm(x, g):
    xf = x.astype(jnp.float32)
    y = xf * lax.rsqrt(jnp.mean(xf * xf, axis=-1, keepdims=True) + EPS)
    return (y * g.astype(jnp.float32)).astype(x.dtype)


def depthwise_conv(x, w, left):
    k = w.shape[0]
    length = x.shape[1]
    xp = jnp.pad(x, ((0, 0), (left, k - 1 - left), (0, 0)))
    out = xp[:, 0:length] * w[0]
    for i in range(1, k):
        out = out + xp[:, i:i + length] * w[i]
    return out


def axial_rope(x, row, col):
    quarter = HEAD_DIM // 4
    half = HEAD_DIM // 2
    inv_freq = ROPE_BASE ** (-jnp.arange(quarter, dtype=jnp.float32) / quarter)

    def rotate(xa, pos):
        ang = pos.astype(jnp.float32)[:, None] * inv_freq[None, :]
        cos = jnp.cos(ang)[None, :, None, :]
        sin = jnp.sin(ang)[None, :, None, :]
        x1, x2 = xa[..., :quarter], xa[..., quarter:]
        return jnp.concatenate([x1 * cos - x2 * sin, x1 * sin + x2 * cos], axis=-1)

    xf = x.astype(jnp.float32)
    return jnp.concatenate([rotate(xf[..., :half], row), rotate(xf[..., half:], col)], axis=-1).astype(x.dtype)


def hyena_filters(length, w1, b1, w2, b2, w3, freq):
    t = jnp.arange(length, dtype=jnp.float32)
    t_norm = t / max(length - 1, 1)
    bands = jnp.linspace(1e-4, HY_BANDS - 1, HY_BANDS, dtype=jnp.float32)
    ang = (2.0 * math.pi / length) * t[:, None] * bands[None, :]
    z = jnp.concatenate([t_norm[:, None], jnp.cos(ang), -jnp.sin(ang)], axis=-1)
    fr = freq.astype(jnp.float32)
    h = jnp.sin(fr * (z @ w1.astype(jnp.float32) + b1.astype(jnp.float32)))
    h = jnp.sin(fr * (h @ w2.astype(jnp.float32) + b2.astype(jnp.float32)))
    h = h @ w3.astype(jnp.float32)
    decay = jnp.tile(jnp.linspace(HY_DECAY_MIN, HY_DECAY_MAX, HY_CH, dtype=jnp.float32), 2)
    h = h * jnp.exp(-t_norm[:, None] * decay[None, :])
    return h[:, :HY_CH], h[:, HY_CH:]


def bidirectional_long_conv(u, h_fwd, h_bwd, bias):
    length = u.shape[1]
    n = 2 * length
    kbuf = jnp.concatenate([h_fwd, jnp.zeros((1, HY_CH), jnp.float32), h_bwd[1:][::-1]], axis=0)
    uf = jnp.fft.rfft(u, n=n, axis=1)
    kf = jnp.fft.rfft(kbuf, n=n, axis=0)
    y = jnp.fft.irfft(uf * kf[None], n=n, axis=1)[:, :length]
    return y + u * bias


def hyena_mixer(p, conv_w, w1, b1, w2, b2, w3, freq, bias):
    length = p.shape[1]
    u = depthwise_conv(p, conv_w, (HY_SHORT - 1) // 2).astype(jnp.float32)
    x0, x1, v = u[..., :HY_CH], u[..., HY_CH:2 * HY_CH], u[..., 2 * HY_CH:]
    h_fwd, h_bwd = hyena_filters(length, w1, b1, w2, b2, w3, freq)
    z = bidirectional_long_conv(x1 * v, h_fwd, h_bwd, bias.astype(jnp.float32))
    return (x0 * z).astype(p.dtype)


def window_attention(p, pc, sink, row, col, need_ctx):
    b, s, _ = p.shape
    lc = pc.shape[1]
    grp = WA_HEADS // WA_KV_HEADS
    qd, kvd = WA_HEADS * HEAD_DIM, WA_KV_HEADS * HEAD_DIM
    scale = HEAD_DIM ** -0.5

    def split(t):
        n = t.shape[1]
        return (t[..., :qd].reshape(b, n, WA_KV_HEADS, grp, HEAD_DIM),
                t[..., qd:qd + kvd].reshape(b, n, WA_KV_HEADS, HEAD_DIM),
                t[..., qd + kvd:].reshape(b, n, WA_KV_HEADS, HEAD_DIM))

    q, k, v = split(p)
    qc, kc, vc = split(pc)
    q = axial_rope(q.reshape(b, s, WA_HEADS, HEAD_DIM), row, col).reshape(b, s, WA_KV_HEADS, grp, HEAD_DIM)
    k = axial_rope(k, row, col)
    sink_hg = sink.astype(jnp.float32).reshape(WA_KV_HEADS, grp)

    nb = s // WA_BLOCK
    span = WA_BLOCK + 2 * WINDOW
    pad = ((0, 0), (WINDOW, WINDOW), (0, 0), (0, 0))
    idx = jnp.arange(nb)[:, None] * WA_BLOCK + jnp.arange(span)[None, :]
    kb = jnp.pad(k, pad)[:, idx]
    vb = jnp.pad(v, pad)[:, idx]
    qb = q.reshape(b, nb, WA_BLOCK, WA_KV_HEADS, grp, HEAD_DIM)
    qpos = jnp.arange(nb)[:, None] * WA_BLOCK + jnp.arange(WA_BLOCK)[None, :]
    kpos = idx - WINDOW
    valid = ((jnp.abs(qpos[:, :, None] - kpos[:, None, :]) <= WINDOW)
             & (kpos[:, None, :] >= 0) & (kpos[:, None, :] < s))
    s_loc = jnp.einsum('bnqhgd,bnkhd->bnhgqk', qb, kb, preferred_element_type=jnp.float32) * scale
    s_loc = jnp.where(valid[None, :, None, None], s_loc, NEG)
    s_ctx = jnp.einsum('bnqhgd,bkhd->bnhgqk', qb, kc, preferred_element_type=jnp.float32) * scale
    sink_col = jnp.broadcast_to(sink_hg[None, None, :, :, None, None], s_ctx.shape[:-1] + (1,))
    prob = jax.nn.softmax(jnp.concatenate([sink_col, s_ctx, s_loc], axis=-1), axis=-1)
    o = (jnp.einsum('bnhgqk,bkhd->bnqhgd', prob[..., 1:1 + lc], vc.astype(jnp.float32))
         + jnp.einsum('bnhgqk,bnkhd->bnqhgd', prob[..., 1 + lc:], vb.astype(jnp.float32)))
    y = o.reshape(b, s, qd).astype(p.dtype)

    yc = None
    if need_ctx:
        sc = jnp.einsum('bqhgd,bkhd->bhgqk', qc, kc, preferred_element_type=jnp.float32) * scale
        sink_c = jnp.broadcast_to(sink_hg[None, :, :, None, None], sc.shape[:-1] + (1,))
        pcx = jax.nn.softmax(jnp.concatenate([sink_c, sc], axis=-1), axis=-1)
        yc = jnp.einsum('bhgqk,bkhd->bqhgd', pcx[..., 1:], vc.astype(jnp.float32)).reshape(b, lc, qd).astype(p.dtype)
    return y, yc


def neighborhood_attention(p, pc, rpb, need_ctx):
    b, s, _ = p.shape
    lc = pc.shape[1]
    hd = NA_HEADS * HEAD_DIM
    scale = HEAD_DIM ** -0.5
    rows = s // GRID_W
    kr = min(NA_KR, rows)
    q = p[..., :hd].reshape(b, rows, GRID_W, NA_HEADS, HEAD_DIM)
    k = p[..., hd:2 * hd].reshape(b, rows, GRID_W, NA_HEADS, HEAD_DIM)
    v = p[..., 2 * hd:].reshape(b, rows, GRID_W, NA_HEADS, HEAD_DIM)
    qc = pc[..., :hd].reshape(b, lc, NA_HEADS, HEAD_DIM)
    kc = pc[..., hd:2 * hd].reshape(b, lc, NA_HEADS, HEAD_DIM)
    vc = pc[..., 2 * hd:].reshape(b, lc, NA_HEADS, HEAD_DIM)

    r = jnp.arange(rows)
    key_rows = jnp.clip(r - kr // 2, 0, rows - kr)[:, None] + jnp.arange(kr)[None, :]
    kg = k[:, key_rows].reshape(b, rows, kr * GRID_W, NA_HEADS, HEAD_DIM)
    vg = v[:, key_rows].reshape(b, rows, kr * GRID_W, NA_HEADS, HEAD_DIM)
    cq = jnp.arange(GRID_W)
    c_start = jnp.clip(cq - NA_KC // 2, 0, GRID_W - NA_KC)
    col_ok = (cq[None, :] >= c_start[:, None]) & (cq[None, :] < c_start[:, None] + NA_KC)
    mask = jnp.broadcast_to(col_ok[:, None, :], (GRID_W, kr, GRID_W)).reshape(GRID_W, kr * GRID_W)
    dr = key_rows - r[:, None]
    dc = cq[None, :] - cq[:, None]
    ri = jnp.clip(dr + NA_KR - 1, 0, 2 * NA_KR - 2)[:, None, :, None]
    ci = jnp.clip(dc + NA_KC - 1, 0, 2 * NA_KC - 2)[None, :, None, :]
    bias = rpb.astype(jnp.float32)[:, ri, ci]
    bias = bias.reshape(NA_HEADS, rows, GRID_W, kr * GRID_W).transpose(1, 0, 2, 3)

    s_loc = jnp.einsum('brqhd,brkhd->brhqk', q, kg, preferred_element_type=jnp.float32) * scale + bias[None]
    s_loc = jnp.where(mask[None, None, None], s_loc, NEG)
    s_ctx = jnp.einsum('brqhd,bkhd->brhqk', q, kc, preferred_element_type=jnp.float32) * scale
    prob = jax.nn.softmax(jnp.concatenate([s_ctx, s_loc], axis=-1), axis=-1)
    o = (jnp.einsum('brhqk,bkhd->brqhd', prob[..., :lc], vc.astype(jnp.float32))
         + jnp.einsum('brhqk,brkhd->brqhd', prob[..., lc:], vg.astype(jnp.float32)))
    y = o.reshape(b, s, hd).astype(p.dtype)

    yc = None
    if need_ctx:
        sc = jnp.einsum('bqhd,bkhd->bhqk', qc, kc, preferred_element_type=jnp.float32) * scale
        pcx = jax.nn.softmax(sc, axis=-1)
        yc = jnp.einsum('bhqk,bkhd->bqhd', pcx, vc.astype(jnp.float32)).reshape(b, lc, hd).astype(p.dtype)
    return y, yc


def l2norm(x):
    return x * lax.rsqrt(jnp.sum(x * x, axis=-1, keepdims=True) + EPS)


def gdn_inputs(p, conv_w, a_log, dt_bias):
    b, n, _ = p.shape
    qkv = jax.nn.silu(depthwise_conv(p[..., :3 * GDN_W], conv_w, GDN_CONV // 2).astype(jnp.float32))
    q = l2norm(qkv[..., :GDN_W].reshape(b, n, GDN_HEADS, HEAD_DIM)) * HEAD_DIM ** -0.5
    k = l2norm(qkv[..., GDN_W:2 * GDN_W].reshape(b, n, GDN_HEADS, HEAD_DIM))
    v = qkv[..., 2 * GDN_W:].reshape(b, n, GDN_HEADS, HEAD_DIM)
    gate = p[..., 3 * GDN_W:4 * GDN_W].astype(jnp.float32)
    a = p[..., 4 * GDN_W:4 * GDN_W + 2 * GDN_HEADS].astype(jnp.float32).reshape(b, n, 2, GDN_HEADS)
    bb = p[..., 4 * GDN_W + 2 * GDN_HEADS:].astype(jnp.float32).reshape(b, n, 2, GDN_HEADS)
    g = -jnp.exp(a_log.astype(jnp.float32)) * jax.nn.softplus(a + dt_bias.astype(jnp.float32))
    beta = jax.nn.sigmoid(bb)
    return q, k, v, gate, g, beta


def gdn_chunked(q, k, v, g, beta, s0, emit):
    b, n, h, d = q.shape
    nc = n // GDN_CHUNK

    def to_chunks(x):
        x = x.reshape((b, nc, GDN_CHUNK, h) + x.shape[3:])
        return jnp.moveaxis(x, (1, 3), (0, 2))

    qc, kc, vc = to_chunks(q), to_chunks(k), to_chunks(v)
    gc, bc = to_chunks(g), to_chunks(beta)
    gcum = jnp.cumsum(gc, axis=-1)
    tri = jnp.tril(jnp.ones((GDN_CHUNK, GDN_CHUNK), bool))
    strict = jnp.tril(jnp.ones((GDN_CHUNK, GDN_CHUNK), bool), -1)
    decay = jnp.exp(jnp.where(tri, gcum[..., :, None] - gcum[..., None, :], NEG))
    kb = kc * bc[..., None]
    lmat = jnp.where(strict, jnp.einsum('nbhid,nbhjd->nbhij', kb, kc) * decay, 0.0)
    eye = jnp.eye(GDN_CHUNK, dtype=jnp.float32)
    tmat = lax.linalg.triangular_solve(eye + lmat, jnp.broadcast_to(eye, lmat.shape), left_side=True, lower=True)
    u = tmat @ (vc * bc[..., None])
    w = tmat @ (kb * jnp.exp(gcum)[..., None])
    k_dec = kc * jnp.exp(gcum[..., -1:] - gcum)[..., None]
    g_last = jnp.exp(gcum[..., -1])
    xs = (u, w, k_dec, g_last)
    if emit:
        attn = jnp.einsum('nbhid,nbhjd->nbhij', qc, kc) * decay
        q_dec = qc * jnp.exp(gcum)[..., None]
        xs = xs + (attn, q_dec)

    def step(state, xs_c):
        u_c, w_c, kd_c, gl = xs_c[:4]
        u_new = u_c - jnp.einsum('bhcd,bhde->bhce', w_c, state)
        s_new = state * gl[..., None, None] + jnp.einsum('bhcd,bhce->bhde', kd_c, u_new)
        if emit:
            a_c, qd_c = xs_c[4:]
            o = jnp.einsum('bhcd,bhde->bhce', qd_c, state) + jnp.einsum('bhij,bhje->bhie', a_c, u_new)
            return s_new, o
        return s_new, None

    s_final, o = lax.scan(step, s0, xs)
    if emit:
        o = jnp.moveaxis(o, (0, 2), (1, 3)).reshape(b, n, h, d)
    return o, s_final


def gdn_mixer(p, pc, conv_w, a_log, dt_bias, norm_g, need_ctx):
    q, k, v, gate, g, beta = gdn_inputs(p, conv_w, a_log, dt_bias)
    qc, kc, vc, gatec, gc, betac = gdn_inputs(pc, conv_w, a_log, dt_bias)
    b = p.shape[0]
    outs, outs_c = [], []
    for direction in range(2):
        flip = (lambda t: t[:, ::-1]) if direction == 1 else (lambda t: t)
        s0 = jnp.zeros((b, GDN_HEADS, HEAD_DIM, HEAD_DIM), jnp.float32)
        oc, s_ctx = gdn_chunked(flip(qc), flip(kc), flip(vc), flip(gc[:, :, direction]),
                                flip(betac[:, :, direction]), s0, need_ctx)
        o, _ = gdn_chunked(flip(q), flip(k), flip(v), flip(g[:, :, direction]),
                           flip(beta[:, :, direction]), s_ctx, True)
        outs.append(flip(o))
        if need_ctx:
            outs_c.append(flip(oc))

    def finish(o, gt):
        bb, n = o.shape[:2]
        return (rmsnorm(o, norm_g).reshape(bb, n, GDN_W) * jax.nn.silu(gt)).astype(p.dtype)

    y = finish(outs[0] + outs[1], gate)
    yc = finish(outs_c[0] + outs_c[1], gatec) if need_ctx else None
    return y, yc


def moe_ffn(t, w_router, e_bias, w_gate, w_up, w_down, ws_gate, ws_up, ws_down):
    n_tok, d = t.shape
    scores = jax.nn.sigmoid(jnp.dot(t, w_router, preferred_element_type=jnp.float32))
    _, top_idx = lax.top_k(scores + e_bias.astype(jnp.float32), TOP_K)
    top_s = jnp.take_along_axis(scores, top_idx, axis=-1)
    top_w = top_s / jnp.sum(top_s, axis=-1, keepdims=True) * ROUTED_SCALE
    n_asg = n_tok * TOP_K
    flat_e = top_idx.reshape(n_asg)
    flat_w = top_w.reshape(n_asg)
    counts = jnp.bincount(flat_e, length=N_EXPERTS)
    padded = (counts + MOE_BLOCK - 1) // MOE_BLOCK * MOE_BLOCK
    pad_end = jnp.cumsum(padded)
    pad_start = pad_end - padded
    raw_start = jnp.cumsum(counts) - counts
    order = jnp.argsort(flat_e)
    sorted_e = flat_e[order]
    dest = pad_start[sorted_e] + jnp.arange(n_asg) - raw_start[sorted_e]
    n_blocks = -(-n_asg // MOE_BLOCK) + N_EXPERTS
    n_rows = n_blocks * MOE_BLOCK
    row_tok = jnp.full((n_rows,), n_tok, jnp.int32).at[dest].set((order // TOP_K).astype(jnp.int32))
    row_w = jnp.zeros((n_rows,), jnp.float32).at[dest].set(flat_w[order])
    blk_e = jnp.minimum(jnp.searchsorted(pad_end, jnp.arange(n_blocks) * MOE_BLOCK, side='right'), N_EXPERTS - 1)
    t_pad = jnp.concatenate([t, jnp.zeros((1, d), t.dtype)], axis=0)
    xb = t_pad[row_tok].reshape(n_blocks, MOE_BLOCK, d)

    def expert_block(args):
        xblk, e = args
        hid = jax.nn.silu(xblk @ w_gate[e]) * (xblk @ w_up[e])
        return hid @ w_down[e]

    yb = lax.map(expert_block, (xb, blk_e)).reshape(n_rows, d)
    routed = jax.ops.segment_sum(yb * row_w[:, None].astype(yb.dtype), row_tok, num_segments=n_tok + 1)[:n_tok]
    shared = (jax.nn.silu(t @ ws_gate) * (t @ ws_up)) @ ws_down
    return routed + shared


def setup_inputs(seed: int = 0) -> dict:
    key = jax.random.key(seed)
    ks = iter(jax.random.split(key, 40))
    f32 = jnp.float32

    def nrm(shape, scale):
        return scale * jax.random.normal(next(ks), shape, f32)

    nl, d = DEPTH, D_MODEL
    a_init = jax.random.uniform(next(ks), (nl, 2, GDN_HEADS), f32, 1.0, 16.0)
    dt = jnp.exp(jax.random.uniform(next(ks), (nl, 2, GDN_HEADS), f32, math.log(1e-3), math.log(1e-1)))
    return {
        'x': nrm((BATCH, SEQ, d), 1.0),
        'c': nrm((BATCH, d), 1.0),
        'ctx': nrm((BATCH, CTX_LEN, d), 1.0),
        'c_ctx': nrm((d,), 1.0),
        'w_ada': nrm((nl, d, 6 * d), 0.5 * d ** -0.5),
        'b_ada': nrm((nl, 6 * d), 0.02),
        'norm1': 1.0 + nrm((nl, d), 0.02),
        'norm2': 1.0 + nrm((nl, d), 0.02),
        'norm_f': 1.0 + nrm((d,), 0.02),
        'w_in': nrm((nl, d, D_IN), d ** -0.5),
        'w_out': nrm((nl, D_MIX, d), D_MIX ** -0.5),
        'hy_conv': nrm((nl, HY_SHORT, HY_IN), HY_SHORT ** -0.5),
        'hy_w1': nrm((nl, HY_EMB, HY_FFN), HY_EMB ** -0.5),
        'hy_b1': nrm((nl, HY_FFN), 0.1),
        'hy_w2': nrm((nl, HY_FFN, HY_FFN), HY_FFN ** -0.5),
        'hy_b2': nrm((nl, HY_FFN), 0.1),
        'hy_w3': nrm((nl, HY_FFN, 2 * HY_CH), HY_FILTER_SCALE * HY_FFN ** -0.5),
        'hy_freq': 1.0 + nrm((nl, HY_FFN), 0.1),
        'hy_bias': nrm((nl, HY_CH), 0.5),
        'wa_sink': nrm((nl, WA_HEADS), 0.5),
        'na_rpb': nrm((nl, NA_HEADS, 2 * NA_KR - 1, 2 * NA_KC - 1), 0.02),
        'gdn_conv': nrm((nl, GDN_CONV, 3 * GDN_W), GDN_CONV ** -0.5),
        'gdn_a_log': jnp.log(a_init),
        'gdn_dt_bias': dt + jnp.log(-jnp.expm1(-dt)),
        'gdn_norm': 1.0 + nrm((nl, HEAD_DIM), 0.02),
        'moe_router': nrm((nl, d, N_EXPERTS), d ** -0.5),
        'moe_bias': nrm((nl, N_EXPERTS), 0.01),
        'moe_gate': nrm((nl, N_EXPERTS, d, D_EXPERT), d ** -0.5),
        'moe_up': nrm((nl, N_EXPERTS, d, D_EXPERT), d ** -0.5),
        'moe_down': nrm((nl, N_EXPERTS, D_EXPERT, d), D_EXPERT ** -0.5),
        'sh_gate': nrm((nl, d, D_SHARED), d ** -0.5),
        'sh_up': nrm((nl, d, D_SHARED), d ** -0.5),
        'sh_down': nrm((nl, D_SHARED, d), D_SHARED ** -0.5),
    }


def reference(x, c, ctx, c_ctx, w_ada, b_ada, norm1, norm2, norm_f, w_in, w_out,
              hy_conv, hy_w1, hy_b1, hy_w2, hy_b2, hy_w3, hy_freq, hy_bias,
              wa_sink, na_rpb, gdn_conv, gdn_a_log, gdn_dt_bias, gdn_norm,
              moe_router, moe_bias, moe_gate, moe_up, moe_down, sh_gate, sh_up, sh_down):
    b, s, d = x.shape
    lc = ctx.shape[1]
    pos = jnp.arange(s)
    row, col = pos // GRID_W, pos % GRID_W
    xc = ctx
    silu_c = jax.nn.silu(c)
    silu_cc = jax.nn.silu(c_ctx)
    o1, o2, o3 = HY_IN, HY_IN + WA_IN, HY_IN + WA_IN + NA_IN
    for l in range(DEPTH):
        need_ctx = l < DEPTH - 1
        sh1, sc1, g1, sh2, sc2, g2 = [m[:, None, :] for m in jnp.split(silu_c @ w_ada[l] + b_ada[l], 6, axis=-1)]
        sh1c, sc1c, g1c, sh2c, sc2c, g2c = jnp.split(silu_cc @ w_ada[l] + b_ada[l], 6, axis=-1)
        h = rmsnorm(x, norm1[l]) * (1.0 + sc1) + sh1
        hc = rmsnorm(xc, norm1[l]) * (1.0 + sc1c) + sh1c
        p = h @ w_in[l]
        pc = hc @ w_in[l]
        hy_args = (hy_conv[l], hy_w1[l], hy_b1[l], hy_w2[l], hy_b2[l], hy_w3[l], hy_freq[l], hy_bias[l])
        y_hy = hyena_mixer(p[..., :o1], *hy_args)
        y_wa, yc_wa = window_attention(p[..., o1:o2], pc[..., o1:o2], wa_sink[l], row, col, need_ctx)
        y_na, yc_na = neighborhood_attention(p[..., o2:o3], pc[..., o2:o3], na_rpb[l], need_ctx)
        y_gd, yc_gd = gdn_mixer(p[..., o3:], pc[..., o3:], gdn_conv[l], gdn_a_log[l], gdn_dt_bias[l], gdn_norm[l], need_ctx)
        x = x + g1 * (jnp.concatenate([y_hy, y_wa, y_na, y_gd], axis=-1) @ w_out[l])
        moe_args = (moe_router[l], moe_bias[l], moe_gate[l], moe_up[l], moe_down[l], sh_gate[l], sh_up[l], sh_down[l])
        h2 = rmsnorm(x, norm2[l]) * (1.0 + sc2) + sh2
        if need_ctx:
            yc_hy = hyena_mixer(pc[..., :o1], *hy_args)
            xc = xc + g1c * (jnp.concatenate([yc_hy, yc_wa, yc_na, yc_gd], axis=-1) @ w_out[l])
            h2c = rmsnorm(xc, norm2[l]) * (1.0 + sc2c) + sh2c
            f = moe_ffn(jnp.concatenate([h2.reshape(b * s, d), h2c.reshape(b * lc, d)], axis=0), *moe_args)
            x = x + g2 * f[:b * s].reshape(b, s, d)
            xc = xc + g2c * f[b * s:].reshape(b, lc, d)
        else:
            x = x + g2 * moe_ffn(h2.reshape(b * s, d), *moe_args).reshape(b, s, d)
    return rmsnorm(x, norm_f)
```

```cpp
#ifndef HOST_SIM
#include <hip/hip_runtime.h>
#include <hip/hip_cooperative_groups.h>
#define HD __host__ __device__ __forceinline__
#else
#include <cmath>
#include <cstdio>
#include <cstdlib>
#include <cstring>
#define HD inline
typedef void* hipStream_t;
#endif
#include <cstdint>
#include <cstddef>

#ifndef BATCH
#define BATCH 8
#endif
constexpr int B = BATCH, S = 2048, D = 1024, LC = 256, GRID_W = 64;
constexpr int TL = B * S, TC = B * LC, T = TL + TC;
constexpr int DIN = 3088, O1 = 768, O2 = 1280, O3 = 2048;
constexpr int WINDOW = 128, NA_KR = 8, NA_KC = 16;
constexpr float EPS = 1e-6f, ROPE_BASE = 10000.0f, ROUTED_SCALE = 2.5f;
constexpr float HY_DECAY_MIN = 3.0701134573253946f;
constexpr float HY_DECAY_MAX = 15.350567286626973f;
typedef unsigned short bf16;

HD float bf2f(bf16 h) { union { unsigned u; float f; } v; v.u = (unsigned)h << 16; return v.f; }
HD bf16 f2bf(float f) { union { float f; unsigned u; } v; v.f = f; unsigned u = v.u; u += 0x7fffu + ((u >> 16) & 1u); return (bf16)(u >> 16); }
HD float siluf(float x) { return x / (1.0f + expf(-x)); }

struct NkCopyX {
    const float* x; const float* ctx; float* xr;
    HD void operator()(long i) const { xr[i] = i < (long)TL * D ? x[i] : ctx[i - (long)TL * D]; }
    static HD long count() { return (long)T * D; }
};

struct NkAda {
    const float* c; const float* cctx; const float* w_ada; const float* b_ada; float* mod;
    HD void operator()(long i) const {
        int n = (int)(i % 6144); int r = (int)((i / 6144) % 9); int l = (int)(i / (6144 * 9));
        const float* cv = r < 8 ? c + (long)(r % B) * D : cctx;
        const float* w = w_ada + (long)l * D * 6144 + n;
        float acc = 0.f;
        for (int k = 0; k < D; ++k) { float v = cv[k]; acc += siluf(v) * w[(long)k * 6144]; }
        mod[i] = acc + b_ada[l * 6144 + n];
    }
    static HD long count() { return 2L * 9 * 6144; }
};

struct NkRstd {
    const float* xr; float* rstd; int nrows;
    HD void operator()(long t) const {
        const float* r = xr + t * D; float s = 0.f;
        for (int k = 0; k < D; ++k) s += r[k] * r[k];
        rstd[t] = 1.0f / sqrtf(s * (1.0f / D) + EPS);
    }
};

struct NkModNorm {
    const float* xr; const float* rstd; const float* g; const float* mod;   int sh_chunk, sc_chunk; bf16* h;
    HD void operator()(long i) const {
        long t = i / D; int k = (int)(i % D); int r = t < TL ? (int)(t / S) : 8;
        const float* m = mod + (long)r * 6144;
        float v = xr[i] * rstd[t] * g[k];
        h[i] = f2bf(v * (1.0f + m[sc_chunk * D + k]) + m[sh_chunk * D + k]);
    }
};

struct NkInProj {
    const bf16* h; const float* w; bf16* p;
    HD void operator()(long i) const {
        long t = i / DIN; int n = (int)(i % DIN);
        const bf16* hr = h + t * D; float acc = 0.f;
        for (int k = 0; k < D; ++k) acc += bf2f(hr[k]) * w[(long)k * DIN + n];
        p[i] = f2bf(acc);
    }
    static HD long count() { return (long)T * DIN; }
};

struct NkRope {
    bf16* p;
    HD void operator()(long i) const {
        int pr = (int)(i % 32); int hd = (int)((i / 32) % 6); long t = i / (32 * 6);
        int s = (int)(t % S); int row = s / GRID_W, col = s % GRID_W;
        int axis = pr >> 4, j = pr & 15;
        float pos = axis == 0 ? (float)row : (float)col;
        float inv = powf(ROPE_BASE, -(float)j / 16.0f);
        float ang = pos * inv; float cs = cosf(ang), sn = sinf(ang);
        bf16* q = p + t * DIN + O1 + hd * 64 + axis * 32;
        float x1 = bf2f(q[j]), x2 = bf2f(q[j + 16]);
        q[j] = f2bf(x1 * cs - x2 * sn); q[j + 16] = f2bf(x1 * sn + x2 * cs);
    }
    static HD long count() { return (long)TL * 6 * 32; }
};

struct NkHyF1 {
    const float* w1; const float* b1; const float* freq; float* f1;
    HD void operator()(long i) const {
        int j = (int)(i % 64); int tt = (int)(i / 64); int L = tt < S ? S : LC; int t = tt < S ? tt : tt - S;
        float tn = (float)t / (float)(L - 1);
        float acc = tn * w1[j];
        for (int bnd = 0; bnd < 16; ++bnd) {
            float band = 1e-4f + (float)bnd * ((15.0f - 1e-4f) / 15.0f);
            float ang = (6.283185307179586f / (float)L) * (float)t * band;
            acc += cosf(ang) * w1[(1 + bnd) * 64 + j] - sinf(ang) * w1[(17 + bnd) * 64 + j];
        }
        f1[i] = sinf(freq[j] * (acc + b1[j]));
    }
    static HD long count() { return (long)(S + LC) * 64; }
};
struct NkHyF2 {
    const float* w2; const float* b2; const float* freq; const float* f1; float* f2;
    HD void operator()(long i) const {
        int j = (int)(i % 64); long tt = i / 64; float acc = 0.f;
        for (int k = 0; k < 64; ++k) acc += f1[tt * 64 + k] * w2[k * 64 + j];
        f2[i] = sinf(freq[j] * (acc + b2[j]));
    }
    static HD long count() { return (long)(S + LC) * 64; }
};
struct NkHyF3 {
    const float* w3; const float* f2; float* filt;
    HD void operator()(long i) const {
        int c = (int)(i % 512); int tt = (int)(i / 512); int L = tt < S ? S : LC; int t = tt < S ? tt : tt - S;
        float tn = (float)t / (float)(L - 1);
        float acc = 0.f;
        for (int k = 0; k < 64; ++k) acc += f2[(long)tt * 64 + k] * w3[k * 512 + c];
        int cc = c & 255;
        float decay = HY_DECAY_MIN + (float)cc * ((HY_DECAY_MAX - HY_DECAY_MIN) / 255.0f);
        filt[i] = acc * expf(-tn * decay);
    }
    static HD long count() { return (long)(S + LC) * 512; }
};
HD float hy_conv3(const bf16* p, long t, int tin, int L, int col, const float* cw) {
    float acc = cw[768 + col] * bf2f(p[t * DIN + col]);
    if (tin > 0) acc += cw[col] * bf2f(p[(t - 1) * DIN + col]);
    if (tin < L - 1) acc += cw[2 * 768 + col] * bf2f(p[(t + 1) * DIN + col]);
    return acc;
}
struct NkHyUV {
    const bf16* p; const float* cw; bf16* uv; long tbase; long ntok; int L;
    HD void operator()(long i) const {
        int c = (int)(i % 256); long t = tbase + i / 256; int tin = (int)((t - tbase) % L);
        float x1 = hy_conv3(p, t, tin, L, 256 + c, cw), v = hy_conv3(p, t, tin, L, 512 + c, cw);
        uv[t * 256 + c] = f2bf(x1 * v);
    }
};
struct NkHyConv {
    const bf16* p; const float* cw; const bf16* uv; const float* filt; const float* hbias; bf16* ycat; long tbase; int L; int foff;
    HD void operator()(long i) const {
        int c = (int)(i % 256); long t = tbase + i / 256; int tin = (int)((t - tbase) % L); long t0 = t - tin;
        const float* f = filt + (long)foff * 512;
        float acc = 0.f;
        for (int s = 0; s < L; ++s) {
            int d = tin - s; float k = d >= 0 ? f[(long)d * 512 + c] : f[(long)(-d) * 512 + 256 + c];
            acc += k * bf2f(uv[(t0 + s) * 256 + c]);
        }
        acc += hbias[c] * bf2f(uv[t * 256 + c]);
        float x0 = hy_conv3(p, t, tin, L, c, cw);
        ycat[t * 1024 + c] = f2bf(x0 * acc);
    }
};

HD void attn_key(const float (&q)[64], const bf16* kr, const bf16* vr, float bias, float& m, float& l, float (&acc)[64]) {
    float sc = 0.f;
#pragma unroll
    for (int d = 0; d < 64; ++d) sc += q[d] * bf2f(kr[d]);
    sc = sc * 0.125f + bias;
    float mn = fmaxf(m, sc); float ca = expf(m - mn), cb = expf(sc - mn);
    l = l * ca + cb; m = mn;
#pragma unroll
    for (int d = 0; d < 64; ++d) acc[d] = acc[d] * ca + cb * bf2f(vr[d]);
}
struct NkWA {
    const bf16* p; const float* sink; bf16* ycat;
    HD void operator()(long i) const {
        int hq = (int)(i % 4); long t = i / 4; int b = (int)(t / S), s = (int)(t % S); int hk = hq >> 1;
        const bf16* qp = p + t * DIN + O1 + hq * 64;
        float q[64], acc[64];
#pragma unroll
        for (int d = 0; d < 64; ++d) { q[d] = bf2f(qp[d]); acc[d] = 0.f; }
        float m = sink[hq], l = 1.0f;
        for (int j = 0; j < LC; ++j) {
            const bf16* kr = p + ((long)TL + (long)b * LC + j) * DIN + O1 + 256 + hk * 64;
            attn_key(q, kr, kr + 128, 0.f, m, l, acc);
        }
        int j0 = s - WINDOW < 0 ? 0 : s - WINDOW, j1 = s + WINDOW > S - 1 ? S - 1 : s + WINDOW;
        for (int j = j0; j <= j1; ++j) {
            const bf16* kr = p + ((long)b * S + j) * DIN + O1 + 256 + hk * 64;
            attn_key(q, kr, kr + 128, 0.f, m, l, acc);
        }
        float il = 1.0f / l;
#pragma unroll
        for (int d = 0; d < 64; ++d) ycat[t * 1024 + 256 + hq * 64 + d] = f2bf(acc[d] * il);
    }
    static HD long count() { return (long)TL * 4; }
};
struct NkWACtx {
    const bf16* p; const float* sink; bf16* ycat;
    HD void operator()(long i) const {
        int hq = (int)(i % 4); long tc = i / 4; int b = (int)(tc / LC); int hk = hq >> 1; long t = TL + tc;
        const bf16* qp = p + t * DIN + O1 + hq * 64;
        float q[64], acc[64];
#pragma unroll
        for (int d = 0; d < 64; ++d) { q[d] = bf2f(qp[d]); acc[d] = 0.f; }
        float m = sink[hq], l = 1.0f;
        for (int j = 0; j < LC; ++j) {
            const bf16* kr = p + ((long)TL + (long)b * LC + j) * DIN + O1 + 256 + hk * 64;
            attn_key(q, kr, kr + 128, 0.f, m, l, acc);
        }
        float il = 1.0f / l;
#pragma unroll
        for (int d = 0; d < 64; ++d) ycat[t * 1024 + 256 + hq * 64 + d] = f2bf(acc[d] * il);
    }
    static HD long count() { return (long)TC * 4; }
};
struct NkNA {
    const bf16* p; const float* rpb; bf16* ycat;
    HD void operator()(long i) const {
        int h = (int)(i % 4); long t = i / 4; int b = (int)(t / S), s = (int)(t % S);
        int r = s / GRID_W, cq = s % GRID_W;
        const bf16* qp = p + t * DIN + O2 + h * 64;
        float q[64], acc[64];
#pragma unroll
        for (int d = 0; d < 64; ++d) { q[d] = bf2f(qp[d]); acc[d] = 0.f; }
        float m = -1e30f, l = 0.f;
        for (int j = 0; j < LC; ++j) {
            const bf16* kr = p + ((long)TL + (long)b * LC + j) * DIN + O2 + 256 + h * 64;
            attn_key(q, kr, kr + 256, 0.f, m, l, acc);
        }
        int r0 = r - NA_KR / 2; r0 = r0 < 0 ? 0 : (r0 > S / GRID_W - NA_KR ? S / GRID_W - NA_KR : r0);
        int c0 = cq - NA_KC / 2; c0 = c0 < 0 ? 0 : (c0 > GRID_W - NA_KC ? GRID_W - NA_KC : c0);
        for (int kk = 0; kk < NA_KR * NA_KC; ++kk) {
            int kr_ = r0 + kk / NA_KC, kc_ = c0 + kk % NA_KC;
            const bf16* kr = p + ((long)b * S + kr_ * GRID_W + kc_) * DIN + O2 + 256 + h * 64;
            attn_key(q, kr, kr + 256, rpb[(h * 15 + (kr_ - r + 7)) * 31 + (kc_ - cq + 15)], m, l, acc);
        }
        float il = 1.0f / l;
#pragma unroll
        for (int d = 0; d < 64; ++d) ycat[t * 1024 + 512 + h * 64 + d] = f2bf(acc[d] * il);
    }
    static HD long count() { return (long)TL * 4; }
};
struct NkNACtx {
    const bf16* p; bf16* ycat;
    HD void operator()(long i) const {
        int h = (int)(i % 4); long tc = i / 4; int b = (int)(tc / LC); long t = TL + tc;
        const bf16* qp = p + t * DIN + O2 + h * 64;
        float q[64], acc[64];
#pragma unroll
        for (int d = 0; d < 64; ++d) { q[d] = bf2f(qp[d]); acc[d] = 0.f; }
        float m = -1e30f, l = 0.f;
        for (int j = 0; j < LC; ++j) {
            const bf16* kr = p + ((long)TL + (long)b * LC + j) * DIN + O2 + 256 + h * 64;
            attn_key(q, kr, kr + 256, 0.f, m, l, acc);
        }
        float il = 1.0f / l;
#pragma unroll
        for (int d = 0; d < 64; ++d) ycat[t * 1024 + 512 + h * 64 + d] = f2bf(acc[d] * il);
    }
    static HD long count() { return (long)TC * 4; }
};

HD float gdn_conv4(const bf16* p, long t, int tin, int L, int col, const float* cw) {
    float acc = 0.f;
    for (int i = 0; i < 4; ++i) { int o = i - 2; if (tin + o >= 0 && tin + o < L) acc += cw[i * 768 + col] * bf2f(p[(t + o) * DIN + O3 + col]); }
    return siluf(acc);
}
struct NkGdnPrep {
    const bf16* p; const float* cw; bf16* qkv;
    HD void operator()(long i) const {
        int e = (int)(i % 64); int wh = (int)((i / 64) % 12); long t = i / 768; int which = wh / 4;
        int L = t < TL ? S : LC; int tin = t < TL ? (int)(t % S) : (int)((t - TL) % LC);
        int col0 = wh * 64;
        float v = gdn_conv4(p, t, tin, L, col0 + e, cw);
        if (which < 2) {
            float ss = 0.f; for (int d = 0; d < 64; ++d) { float u = gdn_conv4(p, t, tin, L, col0 + d, cw); ss += u * u; }
            v *= 1.0f / sqrtf(ss + EPS); if (which == 0) v *= 0.125f;
        }
        qkv[t * 768 + col0 + e] = f2bf(v);
    }
    static HD long count() { return (long)T * 768; }
};
struct NkGdnGate {
    const bf16* p; const float* a_log; const float* dt_bias; float* gb;
    HD void operator()(long i) const {
        int dh = (int)(i % 8); long t = i / 8;
        float a = bf2f(p[t * DIN + O3 + 1024 + dh]), bb = bf2f(p[t * DIN + O3 + 1032 + dh]);
        float x = a + dt_bias[dh]; float sp = x > 20.f ? x : log1pf(expf(x));
        gb[t * 16 + dh] = -expf(a_log[dh]) * sp; gb[t * 16 + 8 + dh] = 1.0f / (1.0f + expf(-bb));
    }
    static HD long count() { return (long)T * 8; }
};
struct NkGdnRec {
    const bf16* qkv; const float* gb; float* o;
    HD void operator()(long i) const {
        int e = (int)(i % 64); int dir = (int)((i / 64) % 2); int h = (int)((i / 128) % 4); int b = (int)(i / 512);
        float Sc[64];
#pragma unroll
        for (int d = 0; d < 64; ++d) Sc[d] = 0.f;
        for (int step = 0; step < LC + S; ++step) {
            long t;
            if (step < LC) { int j = dir ? LC - 1 - step : step; t = (long)TL + (long)b * LC + j; }
            else { int s = step - LC; s = dir ? S - 1 - s : s; t = (long)b * S + s; }
            const bf16* qr = qkv + t * 768 + h * 64; const bf16* kr = qr + 256; float v = bf2f(qr[512 + e]);
            float a = expf(gb[t * 16 + dir * 4 + h]), beta = gb[t * 16 + 8 + dir * 4 + h];
            float kS = 0.f;
#pragma unroll
            for (int d = 0; d < 64; ++d) kS += bf2f(kr[d]) * Sc[d];
            float w = beta * (v - a * kS); float oo = 0.f;
#pragma unroll
            for (int d = 0; d < 64; ++d) { Sc[d] = a * Sc[d] + bf2f(kr[d]) * w; oo += bf2f(qr[d]) * Sc[d]; }
            o[((long)dir * T + t) * 256 + h * 64 + e] = oo;
        }
    }
    static HD long count() { return (long)B * 4 * 2 * 64; }
};
struct NkGdnFin {
    const bf16* p; const float* o; const float* ng; bf16* ycat;
    HD void operator()(long i) const {
        int e = (int)(i % 64); int h = (int)((i / 64) % 4); long t = i / 256;
        const float* o0 = o + t * 256 + h * 64; const float* o1 = o + ((long)T + t) * 256 + h * 64;
        float ss = 0.f; for (int d = 0; d < 64; ++d) { float u = o0[d] + o1[d]; ss += u * u; }
        float v = (o0[e] + o1[e]) * (1.0f / sqrtf(ss * (1.0f / 64.0f) + EPS)) * ng[e];
        float gt = bf2f(p[t * DIN + O3 + 768 + h * 64 + e]);
        ycat[t * 1024 + 768 + h * 64 + e] = f2bf(v * siluf(gt));
    }
    static HD long count() { return (long)T * 256; }
};

struct NkOutProj {
    const bf16* ycat; const float* w; const float* mod; float* xr; long ntok;
    HD void operator()(long i) const {
        long t = i / D; int n = (int)(i % D); int r = t < TL ? (int)(t / S) : 8;
        const bf16* yr = ycat + t * 1024; float acc = 0.f;
        for (int k = 0; k < 1024; ++k) acc += bf2f(yr[k]) * w[(long)k * D + n];
        xr[i] += mod[(long)r * 6144 + 2 * D + n] * acc;
    }
};

struct NkRouter {
    const bf16* h; const float* wr; float* scores;
    HD void operator()(long i) const {
        int e = (int)(i % 32); long t = i / 32; float acc = 0.f;
        for (int k = 0; k < D; ++k) acc += bf2f(h[t * D + k]) * wr[k * 32 + e];
        scores[i] = 1.0f / (1.0f + expf(-acc));
    }
};
struct NkTopK {
    const float* scores; const float* ebias; int* topi; float* topw;
    HD void operator()(long t) const {
        int sel[4]; float ss[4]; float sum = 0.f;
#pragma unroll
        for (int k = 0; k < 4; ++k) {
            int best = -1; float bv = -1e30f;
            for (int e = 0; e < 32; ++e) {
                bool used = false;
#pragma unroll
                for (int q = 0; q < 4; ++q) if (q < k && sel[q] == e) used = true;
                float v = scores[t * 32 + e] + ebias[e];
                if (!used && v > bv) { bv = v; best = e; }
            }
            sel[k] = best; ss[k] = scores[t * 32 + best]; sum += ss[k];
        }
#pragma unroll
        for (int k = 0; k < 4; ++k) { topi[t * 4 + k] = sel[k]; topw[t * 4 + k] = ss[k] / sum * ROUTED_SCALE; }
    }
};
struct NkMoeHid {
    const bf16* h; const int* topi; const float* wg; const float* wu; const float* sg; const float* su; bf16* hid;
    HD void operator()(long i) const {
        int j = (int)(i % 256); int slot = (int)((i / 256) % 5); long t = i / 1280;
        const float* g; const float* u;
        if (slot < 4) { int e = topi[t * 4 + slot]; g = wg + (long)e * D * 256; u = wu + (long)e * D * 256; } else { g = sg; u = su; }
        float ag = 0.f, au = 0.f;
        for (int k = 0; k < D; ++k) { float x = bf2f(h[t * D + k]); ag += x * g[(long)k * 256 + j]; au += x * u[(long)k * 256 + j]; }
        hid[i] = f2bf(siluf(ag) * au);
    }
};
struct NkMoeOut {
    const bf16* hid; const int* topi; const float* topw; const float* wd; const float* sd; const float* mod; float* xr;
    HD void operator()(long i) const {
        long t = i / D; int n = (int)(i % D); int r = t < TL ? (int)(t / S) : 8;
        float f = 0.f;
        for (int slot = 0; slot < 5; ++slot) {
            const float* w; float wt;
            if (slot < 4) { w = wd + (long)topi[t * 4 + slot] * 256 * D; wt = topw[t * 4 + slot]; } else { w = sd; wt = 1.0f; }
            float acc = 0.f;
            for (int j = 0; j < 256; ++j) acc += bf2f(hid[(t * 5 + slot) * 256 + j]) * w[(long)j * D + n];
            f += wt * acc;
        }
        xr[i] += mod[(long)r * 6144 + 5 * D + n] * f;
    }
};
struct NkFinal {
    const float* xr; const float* rstd; const float* g; float* out;
    HD void operator()(long i) const { long t = i / D; int k = (int)(i % D); out[i] = xr[i] * rstd[t] * g[k]; }
    static HD long count() { return (long)TL * D; }
};
struct WS {
    float* mod; float* rstd; float* xr; bf16* h; bf16* p; bf16* ycat; float* hyf1; float* hyf2; float* filt; bf16* uv;
    bf16* qkv; float* gb; float* o; float* scores; int* topi; float* topw; bf16* hid;
};
static inline WS make_ws(void* d_ws) {
    char* base = (char*)d_ws; size_t off = 0;
    auto take = [&](size_t bytes) { char* r = base + off; off += (bytes + 255) & ~(size_t)255; return r; };
    WS w;
    w.mod = (float*)take(2ul * 9 * 6144 * 4);
    w.rstd = (float*)take((size_t)T * 4);
    w.xr = (float*)take((size_t)T * D * 4);
    w.h = (bf16*)take((size_t)T * D * 2);
    w.p = (bf16*)take((size_t)T * DIN * 2);
    w.ycat = (bf16*)take((size_t)T * 1024 * 2);
    w.hyf1 = (float*)take((size_t)(S + LC) * 64 * 4);
    w.hyf2 = (float*)take((size_t)(S + LC) * 64 * 4);
    w.filt = (float*)take((size_t)(S + LC) * 512 * 4);
    w.uv = (bf16*)take((size_t)T * 256 * 2);
    w.qkv = (bf16*)take((size_t)T * 768 * 2);
    w.gb = (float*)take((size_t)T * 16 * 4);
    w.o = (float*)take((size_t)2 * T * 256 * 4);
    w.scores = (float*)take((size_t)T * 32 * 4);
    w.topi = (int*)take((size_t)T * 4 * 4);
    w.topw = (float*)take((size_t)T * 4 * 4);
    w.hid = (bf16*)w.p;
    return w;
}

#ifndef HOST_SIM
template <class F> __global__ void __launch_bounds__(256) nk_kernel(F f, long n) { long i = blockIdx.x * 256L + threadIdx.x; if (i < n) f(i); }
template <class F> static inline void run(F f, long n, hipStream_t st) { nk_kernel<F><<<dim3((unsigned)((n + 255) / 256)), dim3(256), 0, st>>>(f, n); }
#else
template <class F> static inline void run(F f, long n, hipStream_t) {
#pragma omp parallel for schedule(dynamic, 256)
    for (long i = 0; i < n; ++i) f(i);
}
#endif

struct Inputs {
    const float *x, *c, *ctx, *c_ctx, *w_ada, *b_ada, *norm1, *norm2, *norm_f, *w_in, *w_out, *hy_conv, *hy_w1, *hy_b1, *hy_w2, *hy_b2, *hy_w3, *hy_freq, *hy_bias,
        *wa_sink, *na_rpb, *gdn_conv, *gdn_a_log, *gdn_dt_bias, *gdn_norm, *moe_router, *moe_bias, *moe_gate, *moe_up, *moe_down, *sh_gate, *sh_up, *sh_down;
};

static void forward_naive(const Inputs& in, float* out, const WS& w, hipStream_t st) {
    run(NkCopyX{in.x, in.ctx, w.xr}, NkCopyX::count(), st);
    run(NkAda{in.c, in.c_ctx, in.w_ada, in.b_ada, w.mod}, NkAda::count(), st);
    for (int l = 0; l < 2; ++l) {
        const bool need_ctx = l == 0;
        const float* mod = w.mod + (size_t)l * 9 * 6144;
        run(NkRstd{w.xr, w.rstd, T}, T, st);
        run(NkModNorm{w.xr, w.rstd, in.norm1 + l * D, mod, 0, 1, w.h}, (long)T * D, st);
        run(NkInProj{w.h, in.w_in + (size_t)l * D * DIN, w.p}, NkInProj::count(), st);
        run(NkRope{w.p}, NkRope::count(), st);
        run(NkHyF1{in.hy_w1 + l * 33 * 64, in.hy_b1 + l * 64, in.hy_freq + l * 64, w.hyf1}, NkHyF1::count(), st);
        run(NkHyF2{in.hy_w2 + l * 64 * 64, in.hy_b2 + l * 64, in.hy_freq + l * 64, w.hyf1, w.hyf2}, NkHyF2::count(), st);
        run(NkHyF3{in.hy_w3 + l * 64 * 512, w.hyf2, w.filt}, NkHyF3::count(), st);
        const float* hcw = in.hy_conv + l * 3 * 768;
        run(NkHyUV{w.p, hcw, w.uv, 0, TL, S}, (long)TL * 256, st);
        run(NkHyConv{w.p, hcw, w.uv, w.filt, in.hy_bias + l * 256, w.ycat, 0, S, 0}, (long)TL * 256, st);
        if (need_ctx) {
            run(NkHyUV{w.p, hcw, w.uv, TL, TC, LC}, (long)TC * 256, st);
            run(NkHyConv{w.p, hcw, w.uv, w.filt, in.hy_bias + l * 256, w.ycat, TL, LC, S}, (long)TC * 256, st);
        }
        run(NkWA{w.p, in.wa_sink + l * 4, w.ycat}, NkWA::count(), st);
        if (need_ctx) run(NkWACtx{w.p, in.wa_sink + l * 4, w.ycat}, NkWACtx::count(), st);
        run(NkNA{w.p, in.na_rpb + l * 4 * 15 * 31, w.ycat}, NkNA::count(), st);
        if (need_ctx) run(NkNACtx{w.p, w.ycat}, NkNACtx::count(), st);
        run(NkGdnPrep{w.p, in.gdn_conv + l * 4 * 768, w.qkv}, NkGdnPrep::count(), st);
        run(NkGdnGate{w.p, in.gdn_a_log + l * 8, in.gdn_dt_bias + l * 8, w.gb}, NkGdnGate::count(), st);
        run(NkGdnRec{w.qkv, w.gb, w.o}, NkGdnRec::count(), st);
        run(NkGdnFin{w.p, w.o, in.gdn_norm + l * 64, w.ycat}, need_ctx ? (long)T * 256 : (long)TL * 256, st);
        const long ntok = need_ctx ? T : TL;
        run(NkOutProj{w.ycat, in.w_out + (size_t)l * 1024 * D, mod, w.xr, ntok}, ntok * D, st);
        run(NkRstd{w.xr, w.rstd, (int)ntok}, ntok, st);
        run(NkModNorm{w.xr, w.rstd, in.norm2 + l * D, mod, 3, 4, w.h}, ntok * D, st);
        run(NkRouter{w.h, in.moe_router + l * D * 32, w.scores}, ntok * 32, st);
        run(NkTopK{w.scores, in.moe_bias + l * 32, w.topi, w.topw}, ntok, st);
        run(NkMoeHid{w.h, w.topi, in.moe_gate + (size_t)l * 32 * D * 256, in.moe_up + (size_t)l * 32 * D * 256, in.sh_gate + (size_t)l * D * 256, in.sh_up + (size_t)l * D * 256, w.hid}, ntok * 1280, st);
        run(NkMoeOut{w.hid, w.topi, w.topw, in.moe_down + (size_t)l * 32 * 256 * D, in.sh_down + (size_t)l * 256 * D, mod, w.xr}, ntok * D, st);
    }
    run(NkRstd{w.xr, w.rstd, TL}, TL, st);
    run(NkFinal{w.xr, w.rstd, in.norm_f, out}, NkFinal::count(), st);
}

extern "C" void kernel_launch(void* const* d_in, const int* in_sizes, int n_in, void* d_out, int out_size, void* d_ws, size_t ws_size, hipStream_t stream) {
    Inputs in;
    const float** ip = (const float**)&in;
    for (int i = 0; i < 33; ++i) ip[i] = (const float*)d_in[i];
    WS w = make_ws(d_ws);
    forward_naive(in, (float*)d_out, w, stream);
}
```

```cpp
#ifndef HOST_SIM
#include <hip/hip_runtime.h>
#include <hip/hip_cooperative_groups.h>
#include <cstdio>
#include <cstring>
#define HD __host__ __device__ __forceinline__
#else
#include <cmath>
#include <cstdio>
#include <cstdlib>
#include <cstring>
#define HD inline
typedef void* hipStream_t;
#endif
#include <cstdint>
#include <cstddef>

#ifndef BATCH
#define BATCH 8
#endif
constexpr int B = BATCH, S = 2048, D = 1024, LC = 256, GRID_W = 64;
constexpr int TL = B * S, TC = B * LC, T = TL + TC;
constexpr int DIN = 3088, O1 = 768, O2 = 1280, O3 = 2048;
constexpr int WINDOW = 128, NA_KR = 8, NA_KC = 16;
constexpr float EPS = 1e-6f, ROPE_BASE = 10000.0f, ROUTED_SCALE = 2.5f;
constexpr float HY_DECAY_MIN = 3.0701134573253946f;
constexpr float HY_DECAY_MAX = 15.350567286626973f;
typedef unsigned short bf16;

HD float bf2f(bf16 h) { union { unsigned u; float f; } v; v.u = (unsigned)h << 16; return v.f; }
HD bf16 f2bf(float f) { union { float f; unsigned u; } v; v.f = f; unsigned u = v.u; u += 0x7fffu + ((u >> 16) & 1u); return (bf16)(u >> 16); }
HD float siluf(float x) { return x / (1.0f + expf(-x)); }

struct NkCopyX {
    const float* x; const float* ctx; float* xr;
    HD void operator()(long i) const { xr[i] = i < (long)TL * D ? x[i] : ctx[i - (long)TL * D]; }
    static HD long count() { return (long)T * D; }
};

struct NkAda {
    const float* c; const float* cctx; const float* w_ada; const float* b_ada; float* mod;
    HD void operator()(long i) const {
        int n = (int)(i % 6144); int r = (int)((i / 6144) % 9); int l = (int)(i / (6144 * 9));
        const float* cv = r < 8 ? c + (long)(r % B) * D : cctx;
        const float* w = w_ada + (long)l * D * 6144 + n;
        float acc = 0.f;
        for (int k = 0; k < D; ++k) { float v = cv[k]; acc += siluf(v) * w[(long)k * 6144]; }
        mod[i] = acc + b_ada[l * 6144 + n];
    }
    static HD long count() { return 2L * 9 * 6144; }
};

struct NkRstd {
    const float* xr; float* rstd; int nrows;
    HD void operator()(long t) const {
        const float* r = xr + t * D; float s = 0.f;
        for (int k = 0; k < D; ++k) s += r[k] * r[k];
        rstd[t] = 1.0f / sqrtf(s * (1.0f / D) + EPS);
    }
};

struct NkModNorm {
    const float* xr; const float* rstd; const float* g; const float* mod;   int sh_chunk, sc_chunk; bf16* h;
    HD void operator()(long i) const {
        long t = i / D; int k = (int)(i % D); int r = t < TL ? (int)(t / S) : 8;
        const float* m = mod + (long)r * 6144;
        float v = xr[i] * rstd[t] * g[k];
        h[i] = f2bf(v * (1.0f + m[sc_chunk * D + k]) + m[sh_chunk * D + k]);
    }
};

struct NkInProj {
    const bf16* h; const float* w; bf16* p;
    HD void operator()(long i) const {
        long t = i / DIN; int n = (int)(i % DIN);
        const bf16* hr = h + t * D; float acc = 0.f;
        for (int k = 0; k < D; ++k) acc += bf2f(hr[k]) * w[(long)k * DIN + n];
        p[i] = f2bf(acc);
    }
    static HD long count() { return (long)T * DIN; }
};

struct NkRope {
    bf16* p;
    HD void operator()(long i) const {
        int pr = (int)(i % 32); int hd = (int)((i / 32) % 6); long t = i / (32 * 6);
        int s = (int)(t % S); int row = s / GRID_W, col = s % GRID_W;
        int axis = pr >> 4, j = pr & 15;
        float pos = axis == 0 ? (float)row : (float)col;
        float inv = powf(ROPE_BASE, -(float)j / 16.0f);
        float ang = pos * inv; float cs = cosf(ang), sn = sinf(ang);
        bf16* q = p + t * DIN + O1 + hd * 64 + axis * 32;
        float x1 = bf2f(q[j]), x2 = bf2f(q[j + 16]);
        q[j] = f2bf(x1 * cs - x2 * sn); q[j + 16] = f2bf(x1 * sn + x2 * cs);
    }
    static HD long count() { return (long)TL * 6 * 32; }
};

struct NkHyF1 {
    const float* w1; const float* b1; const float* freq; float* f1;
    HD void operator()(long i) const {
        int j = (int)(i % 64); int tt = (int)(i / 64); int L = tt < S ? S : LC; int t = tt < S ? tt : tt - S;
        float tn = (float)t / (float)(L - 1);
        float acc = tn * w1[j];
        for (int bnd = 0; bnd < 16; ++bnd) {
            float band = 1e-4f + (float)bnd * ((15.0f - 1e-4f) / 15.0f);
            float ang = (6.283185307179586f / (float)L) * (float)t * band;
            acc += cosf(ang) * w1[(1 + bnd) * 64 + j] - sinf(ang) * w1[(17 + bnd) * 64 + j];
        }
        f1[i] = sinf(freq[j] * (acc + b1[j]));
    }
    static HD long count() { return (long)(S + LC) * 64; }
};
struct NkHyF2 {
    const float* w2; const float* b2; const float* freq; const float* f1; float* f2;
    HD void operator()(long i) const {
        int j = (int)(i % 64); long tt = i / 64; float acc = 0.f;
        for (int k = 0; k < 64; ++k) acc += f1[tt * 64 + k] * w2[k * 64 + j];
        f2[i] = sinf(freq[j] * (acc + b2[j]));
    }
    static HD long count() { return (long)(S + LC) * 64; }
};
struct NkHyF3 {
    const float* w3; const float* f2; float* filt;
    HD void operator()(long i) const {
        int c = (int)(i % 512); int tt = (int)(i / 512); int L = tt < S ? S : LC; int t = tt < S ? tt : tt - S;
        float tn = (float)t / (float)(L - 1);
        float acc = 0.f;
        for (int k = 0; k < 64; ++k) acc += f2[(long)tt * 64 + k] * w3[k * 512 + c];
        int cc = c & 255;
        float decay = HY_DECAY_MIN + (float)cc * ((HY_DECAY_MAX - HY_DECAY_MIN) / 255.0f);
        filt[i] = acc * expf(-tn * decay);
    }
    static HD long count() { return (long)(S + LC) * 512; }
};
HD float hy_conv3(const bf16* p, long t, int tin, int L, int col, const float* cw) {
    float acc = cw[768 + col] * bf2f(p[t * DIN + col]);
    if (tin > 0) acc += cw[col] * bf2f(p[(t - 1) * DIN + col]);
    if (tin < L - 1) acc += cw[2 * 768 + col] * bf2f(p[(t + 1) * DIN + col]);
    return acc;
}
struct NkHyUV {
    const bf16* p; const float* cw; bf16* uv; long tbase; long ntok; int L;
    HD void operator()(long i) const {
        int c = (int)(i % 256); long t = tbase + i / 256; int tin = (int)((t - tbase) % L);
        float x1 = hy_conv3(p, t, tin, L, 256 + c, cw), v = hy_conv3(p, t, tin, L, 512 + c, cw);
        uv[t * 256 + c] = f2bf(x1 * v);
    }
};
struct NkHyConv {
    const bf16* p; const float* cw; const bf16* uv; const float* filt; const float* hbias; bf16* ycat; long tbase; int L; int foff;
    HD void operator()(long i) const {
        int c = (int)(i % 256); long t = tbase + i / 256; int tin = (int)((t - tbase) % L); long t0 = t - tin;
        const float* f = filt + (long)foff * 512;
        float acc = 0.f;
        for (int s = 0; s < L; ++s) {
            int d = tin - s; float k = d >= 0 ? f[(long)d * 512 + c] : f[(long)(-d) * 512 + 256 + c];
            acc += k * bf2f(uv[(t0 + s) * 256 + c]);
        }
        acc += hbias[c] * bf2f(uv[t * 256 + c]);
        float x0 = hy_conv3(p, t, tin, L, c, cw);
        ycat[t * 1024 + c] = f2bf(x0 * acc);
    }
};

HD void attn_key(const float (&q)[64], const bf16* kr, const bf16* vr, float bias, float& m, float& l, float (&acc)[64]) {
    float sc = 0.f;
#pragma unroll
    for (int d = 0; d < 64; ++d) sc += q[d] * bf2f(kr[d]);
    sc = sc * 0.125f + bias;
    float mn = fmaxf(m, sc); float ca = expf(m - mn), cb = expf(sc - mn);
    l = l * ca + cb; m = mn;
#pragma unroll
    for (int d = 0; d < 64; ++d) acc[d] = acc[d] * ca + cb * bf2f(vr[d]);
}
struct NkWA {
    const bf16* p; const float* sink; bf16* ycat;
    HD void operator()(long i) const {
        int hq = (int)(i % 4); long t = i / 4; int b = (int)(t / S), s = (int)(t % S); int hk = hq >> 1;
        const bf16* qp = p + t * DIN + O1 + hq * 64;
        float q[64], acc[64];
#pragma unroll
        for (int d = 0; d < 64; ++d) { q[d] = bf2f(qp[d]); acc[d] = 0.f; }
        float m = sink[hq], l = 1.0f;
        for (int j = 0; j < LC; ++j) {
            const bf16* kr = p + ((long)TL + (long)b * LC + j) * DIN + O1 + 256 + hk * 64;
            attn_key(q, kr, kr + 128, 0.f, m, l, acc);
        }
        int j0 = s - WINDOW < 0 ? 0 : s - WINDOW, j1 = s + WINDOW > S - 1 ? S - 1 : s + WINDOW;
        for (int j = j0; j <= j1; ++j) {
            const bf16* kr = p + ((long)b * S + j) * DIN + O1 + 256 + hk * 64;
            attn_key(q, kr, kr + 128, 0.f, m, l, acc);
        }
        float il = 1.0f / l;
#pragma unroll
        for (int d = 0; d < 64; ++d) ycat[t * 1024 + 256 + hq * 64 + d] = f2bf(acc[d] * il);
    }
    static HD long count() { return (long)TL * 4; }
};
struct NkWACtx {
    const bf16* p; const float* sink; bf16* ycat;
    HD void operator()(long i) const {
        int hq = (int)(i % 4); long tc = i / 4; int b = (int)(tc / LC); int hk = hq >> 1; long t = TL + tc;
        const bf16* qp = p + t * DIN + O1 + hq * 64;
        float q[64], acc[64];
#pragma unroll
        for (int d = 0; d < 64; ++d) { q[d] = bf2f(qp[d]); acc[d] = 0.f; }
        float m = sink[hq], l = 1.0f;
        for (int j = 0; j < LC; ++j) {
            const bf16* kr = p + ((long)TL + (long)b * LC + j) * DIN + O1 + 256 + hk * 64;
            attn_key(q, kr, kr + 128, 0.f, m, l, acc);
        }
        float il = 1.0f / l;
#pragma unroll
        for (int d = 0; d < 64; ++d) ycat[t * 1024 + 256 + hq * 64 + d] = f2bf(acc[d] * il);
    }
    static HD long count() { return (long)TC * 4; }
};
struct NkNA {
    const bf16* p; const float* rpb; bf16* ycat;
    HD void operator()(long i) const {
        int h = (int)(i % 4); long t = i / 4; int b = (int)(t / S), s = (int)(t % S);
        int r = s / GRID_W, cq = s % GRID_W;
        const bf16* qp = p + t * DIN + O2 + h * 64;
        float q[64], acc[64];
#pragma unroll
        for (int d = 0; d < 64; ++d) { q[d] = bf2f(qp[d]); acc[d] = 0.f; }
        float m = -1e30f, l = 0.f;
        for (int j = 0; j < LC; ++j) {
            const bf16* kr = p + ((long)TL + (long)b * LC + j) * DIN + O2 + 256 + h * 64;
            attn_key(q, kr, kr + 256, 0.f, m, l, acc);
        }
        int r0 = r - NA_KR / 2; r0 = r0 < 0 ? 0 : (r0 > S / GRID_W - NA_KR ? S / GRID_W - NA_KR : r0);
        int c0 = cq - NA_KC / 2; c0 = c0 < 0 ? 0 : (c0 > GRID_W - NA_KC ? GRID_W - NA_KC : c0);
        for (int kk = 0; kk < NA_KR * NA_KC; ++kk) {
            int kr_ = r0 + kk / NA_KC, kc_ = c0 + kk % NA_KC;
            const bf16* kr = p + ((long)b * S + kr_ * GRID_W + kc_) * DIN + O2 + 256 + h * 64;
            attn_key(q, kr, kr + 256, rpb[(h * 15 + (kr_ - r + 7)) * 31 + (kc_ - cq + 15)], m, l, acc);
        }
        float il = 1.0f / l;
#pragma unroll
        for (int d = 0; d < 64; ++d) ycat[t * 1024 + 512 + h * 64 + d] = f2bf(acc[d] * il);
    }
    static HD long count() { return (long)TL * 4; }
};
struct NkNACtx {
    const bf16* p; bf16* ycat;
    HD void operator()(long i) const {
        int h = (int)(i % 4); long tc = i / 4; int b = (int)(tc / LC); long t = TL + tc;
        const bf16* qp = p + t * DIN + O2 + h * 64;
        float q[64], acc[64];
#pragma unroll
        for (int d = 0; d < 64; ++d) { q[d] = bf2f(qp[d]); acc[d] = 0.f; }
        float m = -1e30f, l = 0.f;
        for (int j = 0; j < LC; ++j) {
            const bf16* kr = p + ((long)TL + (long)b * LC + j) * DIN + O2 + 256 + h * 64;
            attn_key(q, kr, kr + 256, 0.f, m, l, acc);
        }
        float il = 1.0f / l;
#pragma unroll
        for (int d = 0; d < 64; ++d) ycat[t * 1024 + 512 + h * 64 + d] = f2bf(acc[d] * il);
    }
    static HD long count() { return (long)TC * 4; }
};

HD float gdn_conv4(const bf16* p, long t, int tin, int L, int col, const float* cw) {
    float acc = 0.f;
    for (int i = 0; i < 4; ++i) { int o = i - 2; if (tin + o >= 0 && tin + o < L) acc += cw[i * 768 + col] * bf2f(p[(t + o) * DIN + O3 + col]); }
    return siluf(acc);
}
struct NkGdnPrep {
    const bf16* p; const float* cw; bf16* qkv;
    HD void operator()(long i) const {
        int e = (int)(i % 64); int wh = (int)((i / 64) % 12); long t = i / 768; int which = wh / 4;
        int L = t < TL ? S : LC; int tin = t < TL ? (int)(t % S) : (int)((t - TL) % LC);
        int col0 = wh * 64;
        float v = gdn_conv4(p, t, tin, L, col0 + e, cw);
        if (which < 2) {
            float ss = 0.f; for (int d = 0; d < 64; ++d) { float u = gdn_conv4(p, t, tin, L, col0 + d, cw); ss += u * u; }
            v *= 1.0f / sqrtf(ss + EPS); if (which == 0) v *= 0.125f;
        }
        qkv[t * 768 + col0 + e] = f2bf(v);
    }
    static HD long count() { return (long)T * 768; }
};
struct NkGdnGate {
    const bf16* p; const float* a_log; const float* dt_bias; float* gb;
    HD void operator()(long i) const {
        int dh = (int)(i % 8); long t = i / 8;
        float a = bf2f(p[t * DIN + O3 + 1024 + dh]), bb = bf2f(p[t * DIN + O3 + 1032 + dh]);
        float x = a + dt_bias[dh]; float sp = x > 20.f ? x : log1pf(expf(x));
        gb[t * 16 + dh] = -expf(a_log[dh]) * sp; gb[t * 16 + 8 + dh] = 1.0f / (1.0f + expf(-bb));
    }
    static HD long count() { return (long)T * 8; }
};
struct NkGdnRec {
    const bf16* qkv; const float* gb; float* o;
    HD void operator()(long i) const {
        int e = (int)(i % 64); int dir = (int)((i / 64) % 2); int h = (int)((i / 128) % 4); int b = (int)(i / 512);
        float Sc[64];
#pragma unroll
        for (int d = 0; d < 64; ++d) Sc[d] = 0.f;
        for (int step = 0; step < LC + S; ++step) {
            long t;
            if (step < LC) { int j = dir ? LC - 1 - step : step; t = (long)TL + (long)b * LC + j; }
            else { int s = step - LC; s = dir ? S - 1 - s : s; t = (long)b * S + s; }
            const bf16* qr = qkv + t * 768 + h * 64; const bf16* kr = qr + 256; float v = bf2f(qr[512 + e]);
            float a = expf(gb[t * 16 + dir * 4 + h]), beta = gb[t * 16 + 8 + dir * 4 + h];
            float kS = 0.f;
#pragma unroll
            for (int d = 0; d < 64; ++d) kS += bf2f(kr[d]) * Sc[d];
            float w = beta * (v - a * kS); float oo = 0.f;
#pragma unroll
            for (int d = 0; d < 64; ++d) { Sc[d] = a * Sc[d] + bf2f(kr[d]) * w; oo += bf2f(qr[d]) * Sc[d]; }
            o[((long)dir * T + t) * 256 + h * 64 + e] = oo;
        }
    }
    static HD long count() { return (long)B * 4 * 2 * 64; }
};
struct NkGdnFin {
    const bf16* p; const float* o; const float* ng; bf16* ycat;
    HD void operator()(long i) const {
        int e = (int)(i % 64); int h = (int)((i / 64) % 4); long t = i / 256;
        const float* o0 = o + t * 256 + h * 64; const float* o1 = o + ((long)T + t) * 256 + h * 64;
        float ss = 0.f; for (int d = 0; d < 64; ++d) { float u = o0[d] + o1[d]; ss += u * u; }
        float v = (o0[e] + o1[e]) * (1.0f / sqrtf(ss * (1.0f / 64.0f) + EPS)) * ng[e];
        float gt = bf2f(p[t * DIN + O3 + 768 + h * 64 + e]);
        ycat[t * 1024 + 768 + h * 64 + e] = f2bf(v * siluf(gt));
    }
    static HD long count() { return (long)T * 256; }
};

struct NkOutProj {
    const bf16* ycat; const float* w; const float* mod; float* xr; long ntok;
    HD void operator()(long i) const {
        long t = i / D; int n = (int)(i % D); int r = t < TL ? (int)(t / S) : 8;
        const bf16* yr = ycat + t * 1024; float acc = 0.f;
        for (int k = 0; k < 1024; ++k) acc += bf2f(yr[k]) * w[(long)k * D + n];
        xr[i] += mod[(long)r * 6144 + 2 * D + n] * acc;
    }
};

struct NkRouter {
    const bf16* h; const float* wr; float* scores;
    HD void operator()(long i) const {
        int e = (int)(i % 32); long t = i / 32; float acc = 0.f;
        for (int k = 0; k < D; ++k) acc += bf2f(h[t * D + k]) * wr[k * 32 + e];
        scores[i] = 1.0f / (1.0f + expf(-acc));
    }
};
struct NkTopK {
    const float* scores; const float* ebias; int* topi; float* topw;
    HD void operator()(long t) const {
        int sel[4]; float ss[4]; float sum = 0.f;
#pragma unroll
        for (int k = 0; k < 4; ++k) {
            int best = -1; float bv = -1e30f;
            for (int e = 0; e < 32; ++e) {
                bool used = false;
#pragma unroll
                for (int q = 0; q < 4; ++q) if (q < k && sel[q] == e) used = true;
                float v = scores[t * 32 + e] + ebias[e];
                if (!used && v > bv) { bv = v; best = e; }
            }
            sel[k] = best; ss[k] = scores[t * 32 + best]; sum += ss[k];
        }
#pragma unroll
        for (int k = 0; k < 4; ++k) { topi[t * 4 + k] = sel[k]; topw[t * 4 + k] = ss[k] / sum * ROUTED_SCALE; }
    }
};
struct NkMoeHid {
    const bf16* h; const int* topi; const float* wg; const float* wu; const float* sg; const float* su; bf16* hid;
    HD void operator()(long i) const {
        int j = (int)(i % 256); int slot = (int)((i / 256) % 5); long t = i / 1280;
        const float* g; const float* u;
        if (slot < 4) { int e = topi[t * 4 + slot]; g = wg + (long)e * D * 256; u = wu + (long)e * D * 256; } else { g = sg; u = su; }
        float ag = 0.f, au = 0.f;
        for (int k = 0; k < D; ++k) { float x = bf2f(h[t * D + k]); ag += x * g[(long)k * 256 + j]; au += x * u[(long)k * 256 + j]; }
        hid[i] = f2bf(siluf(ag) * au);
    }
};
struct NkMoeOut {
    const bf16* hid; const int* topi; const float* topw; const float* wd; const float* sd; const float* mod; float* xr;
    HD void operator()(long i) const {
        long t = i / D; int n = (int)(i % D); int r = t < TL ? (int)(t / S) : 8;
        float f = 0.f;
        for (int slot = 0; slot < 5; ++slot) {
            const float* w; float wt;
            if (slot < 4) { w = wd + (long)topi[t * 4 + slot] * 256 * D; wt = topw[t * 4 + slot]; } else { w = sd; wt = 1.0f; }
            float acc = 0.f;
            for (int j = 0; j < 256; ++j) acc += bf2f(hid[(t * 5 + slot) * 256 + j]) * w[(long)j * D + n];
            f += wt * acc;
        }
        xr[i] += mod[(long)r * 6144 + 5 * D + n] * f;
    }
};
struct NkFinal {
    const float* xr; const float* rstd; const float* g; float* out;
    HD void operator()(long i) const { long t = i / D; int k = (int)(i % D); out[i] = xr[i] * rstd[t] * g[k]; }
    static HD long count() { return (long)TL * D; }
};
struct WS {
    float* mod; float* rstd; float* xr; bf16* h; bf16* p; bf16* ycat; float* hyf1; float* hyf2; float* filt; bf16* uv;
    bf16* qkv; float* gb; float* o; float* scores; int* topi; float* topw; bf16* hid;
};
static inline WS make_ws(void* d_ws) {
    char* base = (char*)d_ws; size_t off = 0;
    auto take = [&](size_t bytes) { char* r = base + off; off += (bytes + 255) & ~(size_t)255; return r; };
    WS w;
    w.mod = (float*)take(2ul * 9 * 6144 * 4);
    w.rstd = (float*)take((size_t)T * 4);
    w.xr = (float*)take((size_t)T * D * 4);
    w.h = (bf16*)take((size_t)T * D * 2);
    w.p = (bf16*)take((size_t)T * DIN * 2);
    w.ycat = (bf16*)take((size_t)T * 1024 * 2);
    w.hyf1 = (float*)take((size_t)(S + LC) * 64 * 4);
    w.hyf2 = (float*)take((size_t)(S + LC) * 64 * 4);
    w.filt = (float*)take((size_t)(S + LC) * 512 * 4);
    w.uv = (bf16*)take((size_t)T * 256 * 2);
    w.qkv = (bf16*)take((size_t)T * 768 * 2);
    w.gb = (float*)take((size_t)T * 16 * 4);
    w.o = (float*)take((size_t)2 * T * 256 * 4);
    w.scores = (float*)take((size_t)T * 32 * 4);
    w.topi = (int*)take((size_t)T * 4 * 4);
    w.topw = (float*)take((size_t)T * 4 * 4);
    w.hid = (bf16*)w.p;
    return w;
}

#ifdef HOST_SIM
template <class F> static inline void run(F f, long n, hipStream_t) {
#pragma omp parallel for schedule(dynamic, 256)
    for (long i = 0; i < n; ++i) f(i);
}
#endif

struct Inputs {
    const float *x, *c, *ctx, *c_ctx, *w_ada, *b_ada, *norm1, *norm2, *norm_f, *w_in, *w_out, *hy_conv, *hy_w1, *hy_b1, *hy_w2, *hy_b2, *hy_w3, *hy_freq, *hy_bias,
        *wa_sink, *na_rpb, *gdn_conv, *gdn_a_log, *gdn_dt_bias, *gdn_norm, *moe_router, *moe_bias, *moe_gate, *moe_up, *moe_down, *sh_gate, *sh_up, *sh_down;
};

#ifdef HOST_SIM
static void forward_naive(const Inputs& in, float* out, const WS& w, hipStream_t st) {
    run(NkCopyX{in.x, in.ctx, w.xr}, NkCopyX::count(), st);
    run(NkAda{in.c, in.c_ctx, in.w_ada, in.b_ada, w.mod}, NkAda::count(), st);
    for (int l = 0; l < 2; ++l) {
        const bool need_ctx = l == 0;
        const float* mod = w.mod + (size_t)l * 9 * 6144;
        run(NkRstd{w.xr, w.rstd, T}, T, st);
        run(NkModNorm{w.xr, w.rstd, in.norm1 + l * D, mod, 0, 1, w.h}, (long)T * D, st);
        run(NkInProj{w.h, in.w_in + (size_t)l * D * DIN, w.p}, NkInProj::count(), st);
        run(NkRope{w.p}, NkRope::count(), st);
        run(NkHyF1{in.hy_w1 + l * 33 * 64, in.hy_b1 + l * 64, in.hy_freq + l * 64, w.hyf1}, NkHyF1::count(), st);
        run(NkHyF2{in.hy_w2 + l * 64 * 64, in.hy_b2 + l * 64, in.hy_freq + l * 64, w.hyf1, w.hyf2}, NkHyF2::count(), st);
        run(NkHyF3{in.hy_w3 + l * 64 * 512, w.hyf2, w.filt}, NkHyF3::count(), st);
        const float* hcw = in.hy_conv + l * 3 * 768;
        run(NkHyUV{w.p, hcw, w.uv, 0, TL, S}, (long)TL * 256, st);
        run(NkHyConv{w.p, hcw, w.uv, w.filt, in.hy_bias + l * 256, w.ycat, 0, S, 0}, (long)TL * 256, st);
        if (need_ctx) {
            run(NkHyUV{w.p, hcw, w.uv, TL, TC, LC}, (long)TC * 256, st);
            run(NkHyConv{w.p, hcw, w.uv, w.filt, in.hy_bias + l * 256, w.ycat, TL, LC, S}, (long)TC * 256, st);
        }
        run(NkWA{w.p, in.wa_sink + l * 4, w.ycat}, NkWA::count(), st);
        if (need_ctx) run(NkWACtx{w.p, in.wa_sink + l * 4, w.ycat}, NkWACtx::count(), st);
        run(NkNA{w.p, in.na_rpb + l * 4 * 15 * 31, w.ycat}, NkNA::count(), st);
        if (need_ctx) run(NkNACtx{w.p, w.ycat}, NkNACtx::count(), st);
        run(NkGdnPrep{w.p, in.gdn_conv + l * 4 * 768, w.qkv}, NkGdnPrep::count(), st);
        run(NkGdnGate{w.p, in.gdn_a_log + l * 8, in.gdn_dt_bias + l * 8, w.gb}, NkGdnGate::count(), st);
        run(NkGdnRec{w.qkv, w.gb, w.o}, NkGdnRec::count(), st);
        run(NkGdnFin{w.p, w.o, in.gdn_norm + l * 64, w.ycat}, need_ctx ? (long)T * 256 : (long)TL * 256, st);
        const long ntok = need_ctx ? T : TL;
        run(NkOutProj{w.ycat, in.w_out + (size_t)l * 1024 * D, mod, w.xr, ntok}, ntok * D, st);
        run(NkRstd{w.xr, w.rstd, (int)ntok}, ntok, st);
        run(NkModNorm{w.xr, w.rstd, in.norm2 + l * D, mod, 3, 4, w.h}, ntok * D, st);
        run(NkRouter{w.h, in.moe_router + l * D * 32, w.scores}, ntok * 32, st);
        run(NkTopK{w.scores, in.moe_bias + l * 32, w.topi, w.topw}, ntok, st);
        run(NkMoeHid{w.h, w.topi, in.moe_gate + (size_t)l * 32 * D * 256, in.moe_up + (size_t)l * 32 * D * 256, in.sh_gate + (size_t)l * D * 256, in.sh_up + (size_t)l * D * 256, w.hid}, ntok * 1280, st);
        run(NkMoeOut{w.hid, w.topi, w.topw, in.moe_down + (size_t)l * 32 * 256 * D, in.sh_down + (size_t)l * 256 * D, mod, w.xr}, ntok * D, st);
    }
    run(NkRstd{w.xr, w.rstd, TL}, TL, st);
    run(NkFinal{w.xr, w.rstd, in.norm_f, out}, NkFinal::count(), st);
}


#endif
#ifdef HOST_SIM
extern "C" void kernel_launch(void* const* d_in, const int* in_sizes, int n_in, void* d_out, int out_size, void* d_ws, size_t ws_size, hipStream_t stream) {
    Inputs in;
    const float** ip = (const float**)&in;
    for (int i = 0; i < 33; ++i) ip[i] = (const float*)d_in[i];
    WS w = make_ws(d_ws);
    forward_naive(in, (float*)d_out, w, stream);
}

#else
namespace cg = cooperative_groups;
struct MP { Inputs in; float* out; WS w; };

template <class F> __device__ __forceinline__ void dev_run(const F& f, long n) {
    for (long i = blockIdx.x * 256L + threadIdx.x; i < n; i += (long)gridDim.x * 256L) f(i);
}

__global__ void __launch_bounds__(256) mega_kernel(MP mp) {
    cg::grid_group grid = cg::this_grid();
    const Inputs& in = mp.in; const WS& w = mp.w;
    dev_run(NkCopyX{in.x, in.ctx, w.xr}, NkCopyX::count());
    dev_run(NkAda{in.c, in.c_ctx, in.w_ada, in.b_ada, w.mod}, NkAda::count());
    grid.sync();
    for (int l = 0; l < 2; ++l) {
        const bool need_ctx = l == 0;
        const float* mod = w.mod + (size_t)l * 9 * 6144;
        const long ntok = need_ctx ? T : TL;
        dev_run(NkRstd{w.xr, w.rstd, T}, T);
        grid.sync();
        dev_run(NkModNorm{w.xr, w.rstd, in.norm1 + l * D, mod, 0, 1, w.h}, (long)T * D);
        grid.sync();
        dev_run(NkInProj{w.h, in.w_in + (size_t)l * D * DIN, w.p}, NkInProj::count());
        grid.sync();
        dev_run(NkRope{w.p}, NkRope::count());
        dev_run(NkHyF1{in.hy_w1 + l * 33 * 64, in.hy_b1 + l * 64, in.hy_freq + l * 64, w.hyf1}, NkHyF1::count());
        grid.sync();
        const float* hcw = in.hy_conv + l * 3 * 768;
        dev_run(NkHyF2{in.hy_w2 + l * 64 * 64, in.hy_b2 + l * 64, in.hy_freq + l * 64, w.hyf1, w.hyf2}, NkHyF2::count());
        dev_run(NkHyUV{w.p, hcw, w.uv, 0, TL, S}, (long)TL * 256);
        if (need_ctx) dev_run(NkHyUV{w.p, hcw, w.uv, TL, TC, LC}, (long)TC * 256);
        dev_run(NkGdnPrep{w.p, in.gdn_conv + l * 4 * 768, w.qkv}, NkGdnPrep::count());
        dev_run(NkGdnGate{w.p, in.gdn_a_log + l * 8, in.gdn_dt_bias + l * 8, w.gb}, NkGdnGate::count());
        dev_run(NkWA{w.p, in.wa_sink + l * 4, w.ycat}, NkWA::count());
        if (need_ctx) dev_run(NkWACtx{w.p, in.wa_sink + l * 4, w.ycat}, NkWACtx::count());
        dev_run(NkNA{w.p, in.na_rpb + l * 4 * 15 * 31, w.ycat}, NkNA::count());
        if (need_ctx) dev_run(NkNACtx{w.p, w.ycat}, NkNACtx::count());
        grid.sync();
        dev_run(NkHyF3{in.hy_w3 + l * 64 * 512, w.hyf2, w.filt}, NkHyF3::count());
        dev_run(NkGdnRec{w.qkv, w.gb, w.o}, NkGdnRec::count());
        grid.sync();
        dev_run(NkHyConv{w.p, hcw, w.uv, w.filt, in.hy_bias + l * 256, w.ycat, 0, S, 0}, (long)TL * 256);
        if (need_ctx) dev_run(NkHyConv{w.p, hcw, w.uv, w.filt, in.hy_bias + l * 256, w.ycat, TL, LC, S}, (long)TC * 256);
        dev_run(NkGdnFin{w.p, w.o, in.gdn_norm + l * 64, w.ycat}, ntok * 256);
        grid.sync();
        dev_run(NkOutProj{w.ycat, in.w_out + (size_t)l * 1024 * D, mod, w.xr, ntok}, ntok * D);
        grid.sync();
        dev_run(NkRstd{w.xr, w.rstd, (int)ntok}, ntok);
        grid.sync();
        dev_run(NkModNorm{w.xr, w.rstd, in.norm2 + l * D, mod, 3, 4, w.h}, ntok * D);
        grid.sync();
        dev_run(NkRouter{w.h, in.moe_router + l * D * 32, w.scores}, ntok * 32);
        grid.sync();
        dev_run(NkTopK{w.scores, in.moe_bias + l * 32, w.topi, w.topw}, ntok);
        grid.sync();
        dev_run(NkMoeHid{w.h, w.topi, in.moe_gate + (size_t)l * 32 * D * 256, in.moe_up + (size_t)l * 32 * D * 256, in.sh_gate + (size_t)l * D * 256, in.sh_up + (size_t)l * D * 256, w.hid}, ntok * 1280);
        grid.sync();
        dev_run(NkMoeOut{w.hid, w.topi, w.topw, in.moe_down + (size_t)l * 32 * 256 * D, in.sh_down + (size_t)l * 256 * D, mod, w.xr}, ntok * D);
        grid.sync();
    }
    dev_run(NkRstd{w.xr, w.rstd, TL}, TL);
    grid.sync();
    dev_run(NkFinal{w.xr, w.rstd, in.norm_f, mp.out}, NkFinal::count());
}

extern "C" void kernel_launch(void* const* d_in, const int* in_sizes, int n_in, void* d_out, int out_size, void* d_ws, size_t ws_size, hipStream_t stream) {
    static int grid_blocks = 0;
    if (!grid_blocks) {
        int dev = 0, cus = 0, per_cu = 0;
        hipGetDevice(&dev);
        hipDeviceGetAttribute(&cus, hipDeviceAttributeMultiprocessorCount, dev);
        hipOccupancyMaxActiveBlocksPerMultiprocessor(&per_cu, mega_kernel, 256, 0);
        if (per_cu > 2) per_cu = 2;
        if (per_cu < 1) per_cu = 1;
        grid_blocks = cus * per_cu;
    }
    MP mp; memset(&mp, 0, sizeof(mp));
    const float** ip = (const float**)&mp.in;
    for (int i = 0; i < 33; ++i) ip[i] = (const float*)d_in[i];
    mp.out = (float*)d_out; mp.w = make_ws(d_ws);
    void* args[] = {&mp};
    hipError_t e = hipLaunchCooperativeKernel((void*)mega_kernel, dim3(grid_blocks), dim3(256), args, 0, stream);
    if (e != hipSuccess) fprintf(stderr, "cooperative launch failed: %s (grid %d)\n", hipGetErrorString(e), grid_blocks);
}
#endif
```

```cpp
#ifndef HOST_SIM
#include <hip/hip_runtime.h>
#include <hip/hip_cooperative_groups.h>
#include <cstdio>
#include <cstring>
#define HD __host__ __device__ __forceinline__
#else
#include <cmath>
#include <cstdio>
#include <cstdlib>
#include <cstring>
#define HD inline
typedef void* hipStream_t;
#endif
#include <cstdint>
#include <cstddef>

#ifndef BATCH
#define BATCH 8
#endif
constexpr int B = BATCH, S = 2048, D = 1024, LC = 256, GRID_W = 64;
constexpr int TL = B * S, TC = B * LC, T = TL + TC;
constexpr int DIN = 3088, O1 = 768, O2 = 1280, O3 = 2048;
constexpr int WINDOW = 128, NA_KR = 8, NA_KC = 16;
constexpr float EPS = 1e-6f, ROPE_BASE = 10000.0f, ROUTED_SCALE = 2.5f;
constexpr float HY_DECAY_MIN = 3.0701134573253946f;
constexpr float HY_DECAY_MAX = 15.350567286626973f;
typedef unsigned short bf16;

HD float bf2f(bf16 h) { union { unsigned u; float f; } v; v.u = (unsigned)h << 16; return v.f; }
HD bf16 f2bf(float f) { union { float f; unsigned u; } v; v.f = f; unsigned u = v.u; u += 0x7fffu + ((u >> 16) & 1u); return (bf16)(u >> 16); }
HD float siluf(float x) { return x / (1.0f + expf(-x)); }

struct NkCopyX {
    const float* x; const float* ctx; float* xr;
    HD void operator()(long i) const { xr[i] = i < (long)TL * D ? x[i] : ctx[i - (long)TL * D]; }
    static HD long count() { return (long)T * D; }
};

struct NkAda {
    const float* c; const float* cctx; const float* w_ada; const float* b_ada; float* mod;
    HD void operator()(long i) const {
        int n = (int)(i % 6144); int r = (int)((i / 6144) % 9); int l = (int)(i / (6144 * 9));
        const float* cv = r < 8 ? c + (long)(r % B) * D : cctx;
        const float* w = w_ada + (long)l * D * 6144 + n;
        float acc = 0.f;
        for (int k = 0; k < D; ++k) { float v = cv[k]; acc += siluf(v) * w[(long)k * 6144]; }
        mod[i] = acc + b_ada[l * 6144 + n];
    }
    static HD long count() { return 2L * 9 * 6144; }
};

struct NkRstd {
    const float* xr; float* rstd; int nrows;
    HD void operator()(long t) const {
        const float* r = xr + t * D; float s = 0.f;
        for (int k = 0; k < D; ++k) s += r[k] * r[k];
        rstd[t] = 1.0f / sqrtf(s * (1.0f / D) + EPS);
    }
};

struct NkModNorm {
    const float* xr; const float* rstd; const float* g; const float* mod;   int sh_chunk, sc_chunk; bf16* h;
    HD void operator()(long i) const {
        long t = i / D; int k = (int)(i % D); int r = t < TL ? (int)(t / S) : 8;
        const float* m = mod + (long)r * 6144;
        float v = xr[i] * rstd[t] * g[k];
        h[i] = f2bf(v * (1.0f + m[sc_chunk * D + k]) + m[sh_chunk * D + k]);
    }
};

struct NkInProj {
    const bf16* h; const float* w; bf16* p;
    HD void operator()(long i) const {
        long t = i / DIN; int n = (int)(i % DIN);
        const bf16* hr = h + t * D; float acc = 0.f;
        for (int k = 0; k < D; ++k) acc += bf2f(hr[k]) * w[(long)k * DIN + n];
        p[i] = f2bf(acc);
    }
    static HD long count() { return (long)T * DIN; }
};

struct NkRope {
    bf16* p;
    HD void operator()(long i) const {
        int pr = (int)(i % 32); int hd = (int)((i / 32) % 6); long t = i / (32 * 6);
        int s = (int)(t % S); int row = s / GRID_W, col = s % GRID_W;
        int axis = pr >> 4, j = pr & 15;
        float pos = axis == 0 ? (float)row : (float)col;
        float inv = powf(ROPE_BASE, -(float)j / 16.0f);
        float ang = pos * inv; float cs = cosf(ang), sn = sinf(ang);
        bf16* q = p + t * DIN + O1 + hd * 64 + axis * 32;
        float x1 = bf2f(q[j]), x2 = bf2f(q[j + 16]);
        q[j] = f2bf(x1 * cs - x2 * sn); q[j + 16] = f2bf(x1 * sn + x2 * cs);
    }
    static HD long count() { return (long)TL * 6 * 32; }
};

struct NkHyF1 {
    const float* w1; const float* b1; const float* freq; float* f1;
    HD void operator()(long i) const {
        int j = (int)(i % 64); int tt = (int)(i / 64); int L = tt < S ? S : LC; int t = tt < S ? tt : tt - S;
        float tn = (float)t / (float)(L - 1);
        float acc = tn * w1[j];
        for (int bnd = 0; bnd < 16; ++bnd) {
            float band = 1e-4f + (float)bnd * ((15.0f - 1e-4f) / 15.0f);
            float ang = (6.283185307179586f / (float)L) * (float)t * band;
            acc += cosf(ang) * w1[(1 + bnd) * 64 + j] - sinf(ang) * w1[(17 + bnd) * 64 + j];
        }
        f1[i] = sinf(freq[j] * (acc + b1[j]));
    }
    static HD long count() { return (long)(S + LC) * 64; }
};
struct NkHyF2 {
    const float* w2; const float* b2; const float* freq; const float* f1; float* f2;
    HD void operator()(long i) const {
        int j = (int)(i % 64); long tt = i / 64; float acc = 0.f;
        for (int k = 0; k < 64; ++k) acc += f1[tt * 64 + k] * w2[k * 64 + j];
        f2[i] = sinf(freq[j] * (acc + b2[j]));
    }
    static HD long count() { return (long)(S + LC) * 64; }
};
struct NkHyF3 {
    const float* w3; const float* f2; float* filt;
    HD void operator()(long i) const {
        int c = (int)(i % 512); int tt = (int)(i / 512); int L = tt < S ? S : LC; int t = tt < S ? tt : tt - S;
        float tn = (float)t / (float)(L - 1);
        float acc = 0.f;
        for (int k = 0; k < 64; ++k) acc += f2[(long)tt * 64 + k] * w3[k * 512 + c];
        int cc = c & 255;
        float decay = HY_DECAY_MIN + (float)cc * ((HY_DECAY_MAX - HY_DECAY_MIN) / 255.0f);
        filt[(long)c * (S + LC) + tt] = acc * expf(-tn * decay);
    }
    static HD long count() { return (long)(S + LC) * 512; }
};
HD float hy_conv3(const bf16* p, long t, int tin, int L, int col, const float* cw) {
    float acc = cw[768 + col] * bf2f(p[t * DIN + col]);
    if (tin > 0) acc += cw[col] * bf2f(p[(t - 1) * DIN + col]);
    if (tin < L - 1) acc += cw[2 * 768 + col] * bf2f(p[(t + 1) * DIN + col]);
    return acc;
}
struct NkHyUV {
    const bf16* p; const float* cw; bf16* uv; long tbase; long ntok; int L;
    HD void operator()(long i) const {
        int c = (int)(i % 256); long t = tbase + i / 256; int tin = (int)((t - tbase) % L);
        float x1 = hy_conv3(p, t, tin, L, 256 + c, cw), v = hy_conv3(p, t, tin, L, 512 + c, cw);
        uv[t * 256 + c] = f2bf(x1 * v);
    }
};
struct NkHyConv {
    const bf16* p; const float* cw; const bf16* uv; const float* filt; const float* hbias; bf16* ycat; long tbase; int L; int foff;
    HD void operator()(long i) const {
        int c = (int)(i % 256); long t = tbase + i / 256; int tin = (int)((t - tbase) % L); long t0 = t - tin;
        const float* f = filt + foff;
        float acc = 0.f;
        for (int s = 0; s < L; ++s) {
            int d = tin - s; float k = d >= 0 ? f[(long)c * (S + LC) + d] : f[(long)(256 + c) * (S + LC) - d];
            acc += k * bf2f(uv[(t0 + s) * 256 + c]);
        }
        acc += hbias[c] * bf2f(uv[t * 256 + c]);
        float x0 = hy_conv3(p, t, tin, L, c, cw);
        ycat[t * 1024 + c] = f2bf(x0 * acc);
    }
};

HD void attn_key(const float (&q)[64], const bf16* kr, const bf16* vr, float bias, float& m, float& l, float (&acc)[64]) {
    float sc = 0.f;
#pragma unroll
    for (int d = 0; d < 64; ++d) sc += q[d] * bf2f(kr[d]);
    sc = sc * 0.125f + bias;
    float mn = fmaxf(m, sc); float ca = expf(m - mn), cb = expf(sc - mn);
    l = l * ca + cb; m = mn;
#pragma unroll
    for (int d = 0; d < 64; ++d) acc[d] = acc[d] * ca + cb * bf2f(vr[d]);
}
struct NkWA {
    const bf16* p; const float* sink; bf16* ycat;
    HD void operator()(long i) const {
        int hq = (int)(i % 4); long t = i / 4; int b = (int)(t / S), s = (int)(t % S); int hk = hq >> 1;
        const bf16* qp = p + t * DIN + O1 + hq * 64;
        float q[64], acc[64];
#pragma unroll
        for (int d = 0; d < 64; ++d) { q[d] = bf2f(qp[d]); acc[d] = 0.f; }
        float m = sink[hq], l = 1.0f;
        for (int j = 0; j < LC; ++j) {
            const bf16* kr = p + ((long)TL + (long)b * LC + j) * DIN + O1 + 256 + hk * 64;
            attn_key(q, kr, kr + 128, 0.f, m, l, acc);
        }
        int j0 = s - WINDOW < 0 ? 0 : s - WINDOW, j1 = s + WINDOW > S - 1 ? S - 1 : s + WINDOW;
        for (int j = j0; j <= j1; ++j) {
            const bf16* kr = p + ((long)b * S + j) * DIN + O1 + 256 + hk * 64;
            attn_key(q, kr, kr + 128, 0.f, m, l, acc);
        }
        float il = 1.0f / l;
#pragma unroll
        for (int d = 0; d < 64; ++d) ycat[t * 1024 + 256 + hq * 64 + d] = f2bf(acc[d] * il);
    }
    static HD long count() { return (long)TL * 4; }
};
struct NkWACtx {
    const bf16* p; const float* sink; bf16* ycat;
    HD void operator()(long i) const {
        int hq = (int)(i % 4); long tc = i / 4; int b = (int)(tc / LC); int hk = hq >> 1; long t = TL + tc;
        const bf16* qp = p + t * DIN + O1 + hq * 64;
        float q[64], acc[64];
#pragma unroll
        for (int d = 0; d < 64; ++d) { q[d] = bf2f(qp[d]); acc[d] = 0.f; }
        float m = sink[hq], l = 1.0f;
        for (int j = 0; j < LC; ++j) {
            const bf16* kr = p + ((long)TL + (long)b * LC + j) * DIN + O1 + 256 + hk * 64;
            attn_key(q, kr, kr + 128, 0.f, m, l, acc);
        }
        float il = 1.0f / l;
#pragma unroll
        for (int d = 0; d < 64; ++d) ycat[t * 1024 + 256 + hq * 64 + d] = f2bf(acc[d] * il);
    }
    static HD long count() { return (long)TC * 4; }
};
struct NkNA {
    const bf16* p; const float* rpb; bf16* ycat;
    HD void operator()(long i) const {
        int h = (int)(i % 4); long t = i / 4; int b = (int)(t / S), s = (int)(t % S);
        int r = s / GRID_W, cq = s % GRID_W;
        const bf16* qp = p + t * DIN + O2 + h * 64;
        float q[64], acc[64];
#pragma unroll
        for (int d = 0; d < 64; ++d) { q[d] = bf2f(qp[d]); acc[d] = 0.f; }
        float m = -1e30f, l = 0.f;
        for (int j = 0; j < LC; ++j) {
            const bf16* kr = p + ((long)TL + (long)b * LC + j) * DIN + O2 + 256 + h * 64;
            attn_key(q, kr, kr + 256, 0.f, m, l, acc);
        }
        int r0 = r - NA_KR / 2; r0 = r0 < 0 ? 0 : (r0 > S / GRID_W - NA_KR ? S / GRID_W - NA_KR : r0);
        int c0 = cq - NA_KC / 2; c0 = c0 < 0 ? 0 : (c0 > GRID_W - NA_KC ? GRID_W - NA_KC : c0);
        for (int kk = 0; kk < NA_KR * NA_KC; ++kk) {
            int kr_ = r0 + kk / NA_KC, kc_ = c0 + kk % NA_KC;
            const bf16* kr = p + ((long)b * S + kr_ * GRID_W + kc_) * DIN + O2 + 256 + h * 64;
            attn_key(q, kr, kr + 256, rpb[(h * 15 + (kr_ - r + 7)) * 31 + (kc_ - cq + 15)], m, l, acc);
        }
        float il = 1.0f / l;
#pragma unroll
        for (int d = 0; d < 64; ++d) ycat[t * 1024 + 512 + h * 64 + d] = f2bf(acc[d] * il);
    }
    static HD long count() { return (long)TL * 4; }
};
struct NkNACtx {
    const bf16* p; bf16* ycat;
    HD void operator()(long i) const {
        int h = (int)(i % 4); long tc = i / 4; int b = (int)(tc / LC); long t = TL + tc;
        const bf16* qp = p + t * DIN + O2 + h * 64;
        float q[64], acc[64];
#pragma unroll
        for (int d = 0; d < 64; ++d) { q[d] = bf2f(qp[d]); acc[d] = 0.f; }
        float m = -1e30f, l = 0.f;
        for (int j = 0; j < LC; ++j) {
            const bf16* kr = p + ((long)TL + (long)b * LC + j) * DIN + O2 + 256 + h * 64;
            attn_key(q, kr, kr + 256, 0.f, m, l, acc);
        }
        float il = 1.0f / l;
#pragma unroll
        for (int d = 0; d < 64; ++d) ycat[t * 1024 + 512 + h * 64 + d] = f2bf(acc[d] * il);
    }
    static HD long count() { return (long)TC * 4; }
};

HD float gdn_conv4(const bf16* p, long t, int tin, int L, int col, const float* cw) {
    float acc = 0.f;
    for (int i = 0; i < 4; ++i) { int o = i - 2; if (tin + o >= 0 && tin + o < L) acc += cw[i * 768 + col] * bf2f(p[(t + o) * DIN + O3 + col]); }
    return siluf(acc);
}
struct NkGdnPrep {
    const bf16* p; const float* cw; bf16* qkv;
    HD void operator()(long i) const {
        int e = (int)(i % 64); int wh = (int)((i / 64) % 12); long t = i / 768; int which = wh / 4;
        int L = t < TL ? S : LC; int tin = t < TL ? (int)(t % S) : (int)((t - TL) % LC);
        int col0 = wh * 64;
        float v = gdn_conv4(p, t, tin, L, col0 + e, cw);
        if (which < 2) {
            float ss = 0.f; for (int d = 0; d < 64; ++d) { float u = gdn_conv4(p, t, tin, L, col0 + d, cw); ss += u * u; }
            v *= 1.0f / sqrtf(ss + EPS); if (which == 0) v *= 0.125f;
        }
        qkv[t * 768 + col0 + e] = f2bf(v);
    }
    static HD long count() { return (long)T * 768; }
};
struct NkGdnGate {
    const bf16* p; const float* a_log; const float* dt_bias; float* gb;
    HD void operator()(long i) const {
        int dh = (int)(i % 8); long t = i / 8;
        float a = bf2f(p[t * DIN + O3 + 1024 + dh]), bb = bf2f(p[t * DIN + O3 + 1032 + dh]);
        float x = a + dt_bias[dh]; float sp = x > 20.f ? x : log1pf(expf(x));
        gb[t * 16 + dh] = -expf(a_log[dh]) * sp; gb[t * 16 + 8 + dh] = 1.0f / (1.0f + expf(-bb));
    }
    static HD long count() { return (long)T * 8; }
};
struct NkGdnRec {
    const bf16* qkv; const float* gb; bf16* o;
    HD void operator()(long i) const {
        int e = (int)(i % 64); int dir = (int)((i / 64) % 2); int h = (int)((i / 128) % 4); int b = (int)(i / 512);
        float Sc[64];
#pragma unroll
        for (int d = 0; d < 64; ++d) Sc[d] = 0.f;
        for (int step = 0; step < LC + S; ++step) {
            long t;
            if (step < LC) { int j = dir ? LC - 1 - step : step; t = (long)TL + (long)b * LC + j; }
            else { int s = step - LC; s = dir ? S - 1 - s : s; t = (long)b * S + s; }
            const bf16* qr = qkv + t * 768 + h * 64; const bf16* kr = qr + 256; float v = bf2f(qr[512 + e]);
            float a = expf(gb[t * 16 + dir * 4 + h]), beta = gb[t * 16 + 8 + dir * 4 + h];
            float kS = 0.f;
#pragma unroll
            for (int c = 0; c < 4; ++c) {
#pragma unroll
                for (int d = c * 16; d < c * 16 + 16; ++d) kS += bf2f(kr[d]) * Sc[d];
                asm volatile("" ::: "memory");
            }
            float w = beta * (v - a * kS); float oo = 0.f;
#pragma unroll
            for (int c = 0; c < 4; ++c) {
#pragma unroll
                for (int d = c * 16; d < c * 16 + 16; ++d) { Sc[d] = a * Sc[d] + bf2f(kr[d]) * w; oo += bf2f(qr[d]) * Sc[d]; }
                asm volatile("" ::: "memory");
            }
            o[((long)dir * T + t) * 256 + h * 64 + e] = f2bf(oo);
        }
    }
    static HD long count() { return (long)B * 4 * 2 * 64; }
};
struct NkGdnFin {
    const bf16* p; const bf16* o; const float* ng; bf16* ycat;
    HD void operator()(long i) const {
        int e = (int)(i % 64); int h = (int)((i / 64) % 4); long t = i / 256;
        const bf16* o0 = o + t * 256 + h * 64; const bf16* o1 = o + ((long)T + t) * 256 + h * 64;
        float ss = 0.f; for (int d = 0; d < 64; ++d) { float u = bf2f(o0[d]) + bf2f(o1[d]); ss += u * u; }
        float v = (bf2f(o0[e]) + bf2f(o1[e])) * (1.0f / sqrtf(ss * (1.0f / 64.0f) + EPS)) * ng[e];
        float gt = bf2f(p[t * DIN + O3 + 768 + h * 64 + e]);
        ycat[t * 1024 + 768 + h * 64 + e] = f2bf(v * siluf(gt));
    }
    static HD long count() { return (long)T * 256; }
};

struct NkOutProj {
    const bf16* ycat; const float* w; const float* mod; float* xr; long ntok;
    HD void operator()(long i) const {
        long t = i / D; int n = (int)(i % D); int r = t < TL ? (int)(t / S) : 8;
        const bf16* yr = ycat + t * 1024; float acc = 0.f;
        for (int k = 0; k < 1024; ++k) acc += bf2f(yr[k]) * w[(long)k * D + n];
        xr[i] += mod[(long)r * 6144 + 2 * D + n] * acc;
    }
};

struct NkRouter {
    const bf16* h; const float* wr; float* scores;
    HD void operator()(long i) const {
        int e = (int)(i % 32); long t = i / 32; float acc = 0.f;
        for (int k = 0; k < D; ++k) acc += bf2f(h[t * D + k]) * wr[k * 32 + e];
        scores[i] = 1.0f / (1.0f + expf(-acc));
    }
};
struct NkTopK {
    const float* scores; const float* ebias; int* topi; float* topw;
    HD void operator()(long t) const {
        int sel[4]; float ss[4]; float sum = 0.f;
#pragma unroll
        for (int k = 0; k < 4; ++k) {
            int best = -1; float bv = -1e30f;
            for (int e = 0; e < 32; ++e) {
                bool used = false;
#pragma unroll
                for (int q = 0; q < 4; ++q) if (q < k && sel[q] == e) used = true;
                float v = scores[t * 32 + e] + ebias[e];
                if (!used && v > bv) { bv = v; best = e; }
            }
            sel[k] = best; ss[k] = scores[t * 32 + best]; sum += ss[k];
        }
#pragma unroll
        for (int k = 0; k < 4; ++k) { topi[t * 4 + k] = sel[k]; topw[t * 4 + k] = ss[k] / sum * ROUTED_SCALE; }
    }
};
struct NkMoeHid {
    const bf16* h; const int* topi; const float* wg; const float* wu; const float* sg; const float* su; bf16* hid;
    HD void operator()(long i) const {
        int j = (int)(i % 256); int slot = (int)((i / 256) % 5); long t = i / 1280;
        const float* g; const float* u;
        if (slot < 4) { int e = topi[t * 4 + slot]; g = wg + (long)e * D * 256; u = wu + (long)e * D * 256; } else { g = sg; u = su; }
        float ag = 0.f, au = 0.f;
        for (int k = 0; k < D; ++k) { float x = bf2f(h[t * D + k]); ag += x * g[(long)k * 256 + j]; au += x * u[(long)k * 256 + j]; }
        hid[i] = f2bf(siluf(ag) * au);
    }
};
struct NkMoeOut {
    const bf16* hid; const int* topi; const float* topw; const float* wd; const float* sd; const float* mod; float* xr;
    HD void operator()(long i) const {
        long t = i / D; int n = (int)(i % D); int r = t < TL ? (int)(t / S) : 8;
        float f = 0.f;
        for (int slot = 0; slot < 5; ++slot) {
            const float* w; float wt;
            if (slot < 4) { w = wd + (long)topi[t * 4 + slot] * 256 * D; wt = topw[t * 4 + slot]; } else { w = sd; wt = 1.0f; }
            float acc = 0.f;
            for (int j = 0; j < 256; ++j) acc += bf2f(hid[(t * 5 + slot) * 256 + j]) * w[(long)j * D + n];
            f += wt * acc;
        }
        xr[i] += mod[(long)r * 6144 + 5 * D + n] * f;
    }
};
struct NkFinal {
    const float* xr; const float* rstd; const float* g; float* out;
    HD void operator()(long i) const { long t = i / D; int k = (int)(i % D); out[i] = xr[i] * rstd[t] * g[k]; }
    static HD long count() { return (long)TL * D; }
};

struct NkCvtT {
    const float* src; bf16* dst; int K, N, Npad;
    HD void operator()(long i) const {
        int n = (int)(i % Npad); int k0 = (int)(i / Npad) * 8;
        bf16 v[8];
#pragma unroll
        for (int j = 0; j < 8; ++j) v[j] = n < N ? f2bf(src[(long)(k0 + j) * N + n]) : (bf16)0;
        bf16* d = dst + (long)n * K + k0;
#pragma unroll
        for (int j = 0; j < 8; ++j) d[j] = v[j];
    }
    HD long count() const { return (long)Npad * (K / 8); }
};
struct NkRopeTab {
    float* rope;
    HD void operator()(long i) const {
        int j = (int)(i % 16); int pos = (int)(i / 16);
        float ang = (float)pos * powf(ROPE_BASE, -(float)j / 16.0f);
        rope[i * 2] = cosf(ang); rope[i * 2 + 1] = sinf(ang);
    }
    static HD long count() { return 64 * 16; }
};

struct NkCvtUp {
    const float* wg; const float* wu; const float* sg; const float* su; bf16* dst;
    HD void operator()(long i) const {
        int j = (int)(i % 256); int k0 = (int)((i / 256) % 128) * 8; int which = (int)((i / (256 * 128)) % 2); int e = (int)(i / (256 * 128 * 2));
        const float* src = e < 32 ? (which ? wu : wg) + (long)e * D * 256 : (which ? su : sg);
        int np = (j >> 6) * 128 + ((j >> 5) & 1) * 64 + which * 32 + (j & 31);
        bf16* d = dst + ((long)e * 512 + np) * 1024 + k0;
#pragma unroll
        for (int q = 0; q < 8; ++q) d[q] = f2bf(src[(long)(k0 + q) * 256 + j]);
    }
    static HD long count() { return 33L * 2 * 128 * 256; }
};
struct NkCvtDown {
    const float* wd; const float* sd; bf16* dst;
    HD void operator()(long i) const {
        int n = (int)(i % 1024); int j0 = (int)((i / 1024) % 32) * 8; int e = (int)(i / (1024 * 32));
        const float* src = e < 32 ? wd + (long)e * 256 * D : sd;
        bf16* d = dst + ((long)e * 1024 + n) * 256 + j0;
#pragma unroll
        for (int q = 0; q < 8; ++q) d[q] = f2bf(src[(long)(j0 + q) * D + n]);
    }
    static HD long count() { return 33L * 32 * 1024; }
};
struct NkZeroI { int* p; HD void operator()(long i) const { p[i] = 0; } };
struct WS {
    float* mod; float* rstd; float* xr; bf16* h; bf16* p; bf16* ycat; float* hyf1; float* hyf2; float* filt; bf16* uv;
    bf16* qkv; float* gb; bf16* o; float* scores; int* topi; float* topw; bf16* hid;
    bf16* winT; bf16* woutT; bf16* wrT; float* rope; unsigned* bar; int* cnt; int* list;
    bf16* moeUpT; bf16* hid2; bf16* moeDownT;
    bf16* qk; bf16* uw; float* gc; bf16* x0T; bf16* uvT;
};
static inline WS make_ws(void* d_ws) {
    char* base = (char*)d_ws; size_t off = 0;
    auto take = [&](size_t bytes) { char* r = base + off; off += (bytes + 255) & ~(size_t)255; return r; };
    WS w;
    w.mod = (float*)take(2ul * 9 * 6144 * 4);
    w.rstd = (float*)take((size_t)T * 4);
    w.hyf1 = (float*)take(2 * (size_t)(S + LC) * 64 * 4);
    w.hyf2 = (float*)take(2 * (size_t)(S + LC) * 64 * 4);
    w.filt = (float*)take(2 * (size_t)(S + LC) * 512 * 4);
    w.gb = (float*)take((size_t)T * 16 * 4);
    w.scores = nullptr; w.topi = nullptr;
    w.topw = (float*)take((size_t)T * 4 * 4);
    w.winT = (bf16*)take(2ul * 3200 * 1024 * 2);
    w.woutT = (bf16*)take(2ul * 1024 * 1024 * 2);
    w.wrT = (bf16*)take(2ul * 32 * 1024 * 2);
    w.rope = (float*)take(64 * 16 * 2 * 4);
    w.bar = (unsigned*)take(4096 * 4);
    w.cnt = (int*)take(2 * 32 * 4);
    w.list = (int*)take((size_t)32 * T * 4);
    w.xr = (float*)take((size_t)T * D * 4);
    w.h = (bf16*)take((size_t)T * D * 2);
    w.p = (bf16*)take((size_t)T * DIN * 2);
    w.hid = (bf16*)w.p;
    char* R = take(0);
    const size_t szUp = 33ul * 512 * 1024 * 2, szHid = ((size_t)5 * T + 256) * 256 * 2, szDown = 33ul * 1024 * 256 * 2;
    w.moeUpT = (bf16*)R; w.hid2 = (bf16*)(R + szUp); w.moeDownT = (bf16*)(R + szUp + szHid);
    w.qkv = (bf16*)R;
    w.qk = (bf16*)R;
    w.ycat = w.hid2;
    w.o = (bf16*)((char*)w.ycat + (size_t)T * 1024 * 2);
    w.x0T = (bf16*)((char*)w.ycat + (size_t)T * 1024 * 2);
    w.uvT = w.x0T + (size_t)256 * B * S;
    w.uv = w.uvT + (size_t)256 * B * S;
    w.uw = w.h; w.gc = w.gb;
    size_t rsz = szUp + szHid + szDown; const size_t rsz2 = szUp + (size_t)T * 1024 * 2 + (size_t)2 * 256 * B * S * 2 + (size_t)T * 256 * 2;
    if (rsz2 > rsz) rsz = rsz2;
    (void)take(rsz);
    return w;
}
#ifdef HOST_SIM
template <class F> static inline void run(F f, long n, hipStream_t) {
#pragma omp parallel for schedule(dynamic, 256)
    for (long i = 0; i < n; ++i) f(i);
}
#endif

struct Inputs {
    const float *x, *c, *ctx, *c_ctx, *w_ada, *b_ada, *norm1, *norm2, *norm_f, *w_in, *w_out, *hy_conv, *hy_w1, *hy_b1, *hy_w2, *hy_b2, *hy_w3, *hy_freq, *hy_bias,
        *wa_sink, *na_rpb, *gdn_conv, *gdn_a_log, *gdn_dt_bias, *gdn_norm, *moe_router, *moe_bias, *moe_gate, *moe_up, *moe_down, *sh_gate, *sh_up, *sh_down;
};

#ifdef HOST_SIM
static void forward_naive(const Inputs& in, float* out, const WS& w, hipStream_t st) {
    run(NkCopyX{in.x, in.ctx, w.xr}, NkCopyX::count(), st);
    run(NkAda{in.c, in.c_ctx, in.w_ada, in.b_ada, w.mod}, NkAda::count(), st);
    for (int l = 0; l < 2; ++l) {
        const bool need_ctx = l == 0;
        const float* mod = w.mod + (size_t)l * 9 * 6144;
        run(NkRstd{w.xr, w.rstd, T}, T, st);
        run(NkModNorm{w.xr, w.rstd, in.norm1 + l * D, mod, 0, 1, w.h}, (long)T * D, st);
        run(NkInProj{w.h, in.w_in + (size_t)l * D * DIN, w.p}, NkInProj::count(), st);
        run(NkRope{w.p}, NkRope::count(), st);
        run(NkHyF1{in.hy_w1 + l * 33 * 64, in.hy_b1 + l * 64, in.hy_freq + l * 64, w.hyf1}, NkHyF1::count(), st);
        run(NkHyF2{in.hy_w2 + l * 64 * 64, in.hy_b2 + l * 64, in.hy_freq + l * 64, w.hyf1, w.hyf2}, NkHyF2::count(), st);
        run(NkHyF3{in.hy_w3 + l * 64 * 512, w.hyf2, w.filt}, NkHyF3::count(), st);
        const float* hcw = in.hy_conv + l * 3 * 768;
        run(NkHyUV{w.p, hcw, w.uv, 0, TL, S}, (long)TL * 256, st);
        run(NkHyConv{w.p, hcw, w.uv, w.filt, in.hy_bias + l * 256, w.ycat, 0, S, 0}, (long)TL * 256, st);
        if (need_ctx) {
            run(NkHyUV{w.p, hcw, w.uv, TL, TC, LC}, (long)TC * 256, st);
            run(NkHyConv{w.p, hcw, w.uv, w.filt, in.hy_bias + l * 256, w.ycat, TL, LC, S}, (long)TC * 256, st);
        }
        run(NkWA{w.p, in.wa_sink + l * 4, w.ycat}, NkWA::count(), st);
        if (need_ctx) run(NkWACtx{w.p, in.wa_sink + l * 4, w.ycat}, NkWACtx::count(), st);
        run(NkNA{w.p, in.na_rpb + l * 4 * 15 * 31, w.ycat}, NkNA::count(), st);
        if (need_ctx) run(NkNACtx{w.p, w.ycat}, NkNACtx::count(), st);
        run(NkGdnPrep{w.p, in.gdn_conv + l * 4 * 768, w.qkv}, NkGdnPrep::count(), st);
        run(NkGdnGate{w.p, in.gdn_a_log + l * 8, in.gdn_dt_bias + l * 8, w.gb}, NkGdnGate::count(), st);
        run(NkGdnRec{w.qkv, w.gb, w.o}, NkGdnRec::count(), st);
        run(NkGdnFin{w.p, w.o, in.gdn_norm + l * 64, w.ycat}, need_ctx ? (long)T * 256 : (long)TL * 256, st);
        const long ntok = need_ctx ? T : TL;
        run(NkOutProj{w.ycat, in.w_out + (size_t)l * 1024 * D, mod, w.xr, ntok}, ntok * D, st);
        run(NkRstd{w.xr, w.rstd, (int)ntok}, ntok, st);
        run(NkModNorm{w.xr, w.rstd, in.norm2 + l * D, mod, 3, 4, w.h}, ntok * D, st);
        run(NkRouter{w.h, in.moe_router + l * D * 32, w.scores}, ntok * 32, st);
        run(NkTopK{w.scores, in.moe_bias + l * 32, w.topi, w.topw}, ntok, st);
        run(NkMoeHid{w.h, w.topi, in.moe_gate + (size_t)l * 32 * D * 256, in.moe_up + (size_t)l * 32 * D * 256, in.sh_gate + (size_t)l * D * 256, in.sh_up + (size_t)l * D * 256, w.hid}, ntok * 1280, st);
        run(NkMoeOut{w.hid, w.topi, w.topw, in.moe_down + (size_t)l * 32 * 256 * D, in.sh_down + (size_t)l * 256 * D, mod, w.xr}, ntok * D, st);
    }
    run(NkRstd{w.xr, w.rstd, TL}, TL, st);
    run(NkFinal{w.xr, w.rstd, in.norm_f, out}, NkFinal::count(), st);
}


#endif
#ifdef HOST_SIM
extern "C" void kernel_launch(void* const* d_in, const int* in_sizes, int n_in, void* d_out, int out_size, void* d_ws, size_t ws_size, hipStream_t stream) {
    Inputs in;
    const float** ip = (const float**)&in;
    for (int i = 0; i < 33; ++i) ip[i] = (const float*)d_in[i];
    WS w = make_ws(d_ws);
    forward_naive(in, (float*)d_out, w, stream);
}

#endif
#ifndef HOST_SIM
#define XB_TMO      128
#define XB_XCNT(j)  (256  + 64 * (j))
#define XB_XSUB(j)  (1280 + 64 * (j))
#define XB_XGEN(j)  (2304 + 64 * (j))
#define XB_TOP      3328
#define XB_TOPGEN   3392
#define XCD_BAR_WORDS 3456
#define XB_SPIN_CAP (1u << 26)
#define LAS __attribute__((address_space(3)))
__device__ __forceinline__ unsigned xb_ld(unsigned* p)              { return __hip_atomic_load(p, __ATOMIC_RELAXED, __HIP_MEMORY_SCOPE_AGENT); }
__device__ __forceinline__ unsigned xb_add(unsigned* p, unsigned v) { return __hip_atomic_fetch_add(p, v, __ATOMIC_RELAXED, __HIP_MEMORY_SCOPE_AGENT); }
__device__ __forceinline__ unsigned xb_xcc_id() { return (unsigned)__builtin_amdgcn_s_getreg((3 << 11) | 20) & 0xFu; }
#define XB_SPIN(cond, bar) do { unsigned _sp = 0; while (cond) { __builtin_amdgcn_s_sleep(1); \
    if ((++_sp & 255u) == 0u) { if (xb_ld(&(bar)[XB_TMO])) break; if (_sp > XB_SPIN_CAP) { atomicAdd(&(bar)[XB_TMO], 1u); break; } } } } while (0)
struct XcdBarrier { unsigned* bar; unsigned x; volatile LAS unsigned* st; };
__device__ __forceinline__ XcdBarrier xcd_barrier_post(unsigned* bar, volatile LAS unsigned* st) {
    XcdBarrier b; b.bar = bar; b.x = xb_xcc_id(); b.st = st;
    if (threadIdx.x == 0) (void)xb_add(&bar[XB_XCNT(b.x)], 1u);
    return b;
}
__device__ __forceinline__ void xcd_barrier_complete(unsigned* bar, unsigned x, unsigned& nloc, unsigned& nx) {
    const unsigned G = gridDim.x * gridDim.y * gridDim.z;
    unsigned sum, cnt, mine, sp = 0u;
    for (;;) {
        sum = 0u; cnt = 0u; mine = 0u;
#pragma unroll
        for (unsigned j = 0; j < 16; ++j) { const unsigned c = xb_ld(&bar[XB_XCNT(j)]); sum += c; cnt += (c > 0u) ? 1u : 0u; mine = (j == x) ? c : mine; }
        if (sum == G) break;
        __builtin_amdgcn_s_sleep(1);
        if ((++sp & 255u) == 0u) { if (xb_ld(&bar[XB_TMO])) break; if (sp > XB_SPIN_CAP) { atomicAdd(&bar[XB_TMO], 1u); break; } }
    }
    nloc = mine > 0u ? mine : 1u; nx = cnt > 0u ? cnt : 1u;
}
__device__ __forceinline__ void xcd_barrier(const XcdBarrier& b) {
    asm volatile("s_waitcnt vmcnt(0)" ::: "memory");
    __syncthreads();
    if (threadIdx.x == 0) {
        unsigned* bar = b.bar;
        __builtin_amdgcn_s_waitcnt(0);
        unsigned nloc = b.st[0], nx = b.st[1];
        if (nloc == 0u) { xcd_barrier_complete(bar, b.x, nloc, nx); b.st[0] = nloc; b.st[1] = nx; }
        const unsigned old = xb_add(&bar[XB_XSUB(b.x)], 1u);
        const unsigned gen = old / nloc;
        if (old + 1u == (gen + 1u) * nloc) {
            __builtin_amdgcn_fence(__ATOMIC_RELEASE, "agent");
            asm volatile("s_waitcnt vmcnt(0)" ::: "memory");
            const unsigned og = xb_add(&bar[XB_TOP], 1u);
            const unsigned tg = og / nx;
            if (og + 1u == (tg + 1u) * nx) xb_add(&bar[XB_TOPGEN], 1u);
            else XB_SPIN(xb_ld(&bar[XB_TOPGEN]) == tg, bar);
            __builtin_amdgcn_fence(__ATOMIC_ACQUIRE, "agent");
            xb_add(&bar[XB_XGEN(b.x)], 1u);
            asm volatile("s_waitcnt vmcnt(0)" ::: "memory");
        } else {
            XB_SPIN(xb_ld(&bar[XB_XGEN(b.x)]) == gen, bar);
            __builtin_amdgcn_fence(__ATOMIC_ACQUIRE, "agent");
            asm volatile("s_waitcnt vmcnt(0)" ::: "memory");
        }
    }
    __syncthreads();
}
#endif
#ifndef HOST_SIM
typedef short bf16x8 __attribute__((ext_vector_type(8)));
typedef float f32x16 __attribute__((ext_vector_type(16)));
typedef float f32x4 __attribute__((ext_vector_type(4)));
typedef unsigned u32x4 __attribute__((ext_vector_type(4)));
typedef unsigned u32x2 __attribute__((ext_vector_type(2)));
#define NTHREADS 512

__device__ __forceinline__ unsigned pack_bf16(float lo, float hi) { return (unsigned)f2bf(lo) | ((unsigned)f2bf(hi) << 16); }

constexpr int GBM = 256, GBN = 128, GBK = 64;
constexpr int G_ASTAGE = GBM * GBK * 2, G_BSTAGE = GBN * GBK * 2, G_STAGE = G_ASTAGE + G_BSTAGE;
constexpr int G_LDS = 2 * G_STAGE;
__device__ __forceinline__ int g_lds_off(int r, int c) { return r * 128 + ((c ^ ((r >> 1) & 7)) << 4); }

template <class ARow, class Epi>
__device__ __forceinline__ void gemm_tile(char* lds, const ARow& arow, const bf16* __restrict__ Bt, int ldb, int K, int m0, int n0, const Epi& epi) {
    int tid = threadIdx.x; asm volatile("" : "+v"(tid));
    const int lane = tid & 63, wid = tid >> 6, wm = wid >> 1, wn = wid & 1;
    const int lr = tid >> 3, lc = tid & 7;
    const bf16* ap[4]; const bf16* bp[2];
#pragma unroll
    for (int i = 0; i < 4; ++i) ap[i] = arow(lr + 64 * i) + lc * 8;
#pragma unroll
    for (int i = 0; i < 2; ++i) bp[i] = Bt + (size_t)(n0 + lr + 64 * i) * ldb + lc * 8;
    u32x4 ra[4], rb[2];
    f32x16 acc[2][2];
#pragma unroll
    for (int a = 0; a < 2; ++a)
#pragma unroll
        for (int b = 0; b < 2; ++b)
#pragma unroll
            for (int r = 0; r < 16; ++r) acc[a][b][r] = 0.f;
    const int nk = K / GBK;
#pragma unroll
    for (int i = 0; i < 4; ++i) ra[i] = *(const u32x4*)(ap[i]);
#pragma unroll
    for (int i = 0; i < 2; ++i) rb[i] = *(const u32x4*)(bp[i]);
    __syncthreads();
#pragma unroll
    for (int i = 0; i < 4; ++i) *(u32x4*)(lds + g_lds_off(lr + 64 * i, lc)) = ra[i];
#pragma unroll
    for (int i = 0; i < 2; ++i) *(u32x4*)(lds + G_ASTAGE + g_lds_off(lr + 64 * i, lc)) = rb[i];
    __syncthreads();
    const int fr = lane & 31, fh = lane >> 5;
    for (int kt = 0; kt < nk; ++kt) {
        char* cur = lds + (kt & 1) * G_STAGE;
        if (kt + 1 < nk) {
#pragma unroll
            for (int i = 0; i < 4; ++i) ra[i] = *(const u32x4*)(ap[i] + (kt + 1) * GBK);
#pragma unroll
            for (int i = 0; i < 2; ++i) rb[i] = *(const u32x4*)(bp[i] + (kt + 1) * GBK);
        }
#pragma unroll
        for (int kk = 0; kk < 4; ++kk) {
            bf16x8 fa[2], fb[2];
#pragma unroll
            for (int mi = 0; mi < 2; ++mi) fa[mi] = *(const bf16x8*)(cur + g_lds_off(wm * 64 + mi * 32 + fr, kk * 2 + fh));
#pragma unroll
            for (int ni = 0; ni < 2; ++ni) fb[ni] = *(const bf16x8*)(cur + G_ASTAGE + g_lds_off(wn * 64 + ni * 32 + fr, kk * 2 + fh));
#pragma unroll
            for (int mi = 0; mi < 2; ++mi)
#pragma unroll
                for (int ni = 0; ni < 2; ++ni) acc[mi][ni] = __builtin_amdgcn_mfma_f32_32x32x16_bf16(fb[ni], fa[mi], acc[mi][ni], 0, 0, 0);
        }
        if (kt + 1 < nk) {
            char* nxt = lds + ((kt + 1) & 1) * G_STAGE;
#pragma unroll
            for (int i = 0; i < 4; ++i) *(u32x4*)(nxt + g_lds_off(lr + 64 * i, lc)) = ra[i];
#pragma unroll
            for (int i = 0; i < 2; ++i) *(u32x4*)(nxt + G_ASTAGE + g_lds_off(lr + 64 * i, lc)) = rb[i];
        }
        __syncthreads();
    }
    epi(acc, m0 + wm * 64 + fr, n0 + wn * 64 + 4 * fh);
}

struct ARowDense { const bf16* A; int lda; int m0; __device__ __forceinline__ const bf16* operator()(int i) const { return A + (size_t)(m0 + i) * lda; } };

struct EpiInProj {
    bf16* p; const float* rope;
    __device__ __forceinline__ void operator()(f32x16 (&acc)[2][2], int mrow, int ncol) const {
#pragma unroll
        for (int mi = 0; mi < 2; ++mi) {
            const int m = mrow + mi * 32;
#pragma unroll
            for (int ni = 0; ni < 2; ++ni) {
                const int nb = ncol + ni * 32;
                if (nb >= O1 && nb < O1 + 384 && m < TL) {
                    const int s = m & (S - 1); const int pos = ni == 0 ? (s >> 6) : (s & 63);
                    const int jb = (nb & 31);
#pragma unroll
                    for (int r = 0; r < 8; ++r) {
                        const int j = jb + (r & 3) + 8 * (r >> 2);
                        const float cs = rope[(pos * 16 + j) * 2], sn = rope[(pos * 16 + j) * 2 + 1];
                        const float x1 = acc[mi][ni][r], x2 = acc[mi][ni][r + 8];
                        acc[mi][ni][r] = x1 * cs - x2 * sn; acc[mi][ni][r + 8] = x1 * sn + x2 * cs;
                    }
                }
#pragma unroll
                for (int g = 0; g < 4; ++g) {
                    const int n = nb + 8 * g;
                    if (n < DIN) {
                        u32x2 v; v.x = pack_bf16(acc[mi][ni][4 * g], acc[mi][ni][4 * g + 1]); v.y = pack_bf16(acc[mi][ni][4 * g + 2], acc[mi][ni][4 * g + 3]);
                        *(u32x2*)(p + (size_t)m * DIN + n) = v;
                    }
                }
            }
        }
    }
};
struct EpiOutProj {
    float* xr; const float* mod;
    __device__ __forceinline__ void operator()(f32x16 (&acc)[2][2], int mrow, int ncol) const {
#pragma unroll
        for (int mi = 0; mi < 2; ++mi) {
            const int m = mrow + mi * 32; const int rb = m < TL ? m / S : 8;
            const float* g1 = mod + (size_t)rb * 6144 + 2 * D;
#pragma unroll
            for (int ni = 0; ni < 2; ++ni)
#pragma unroll
                for (int g = 0; g < 4; ++g) {
                    const int n = ncol + ni * 32 + 8 * g;
                    f32x4 gv = *(const f32x4*)(g1 + n); float* xp = xr + (size_t)m * D + n; f32x4 xv = *(const f32x4*)xp;
                    xv[0] += gv[0] * acc[mi][ni][4 * g]; xv[1] += gv[1] * acc[mi][ni][4 * g + 1]; xv[2] += gv[2] * acc[mi][ni][4 * g + 2]; xv[3] += gv[3] * acc[mi][ni][4 * g + 3];
                    *(f32x4*)xp = xv;
                }
        }
    }
};
#endif
#ifndef HOST_SIM
__device__ __forceinline__ float wave_sum(float v) {
#pragma unroll
    for (int o = 32; o > 0; o >>= 1) v += __shfl_xor(v, o);
    return v;
}
template <int MODE, int NORM>
__device__ __forceinline__ void row_pass(const WS& w, const Inputs& in, int ntok, const float* mod_cur  , const float* mod_nrm  ,
                                         const float* gnorm, int shc, int scc, const bf16* y, const float* topw, float* out) {
    int tid = threadIdx.x; asm volatile("" : "+v"(tid));
    const int lane = tid & 63, wv = tid >> 6;
    for (int t = blockIdx.x * 8 + wv; t < ntok; t += gridDim.x * 8) {
        const int rb = t < TL ? t / S : 8;
        f32x4 v[4];
        float* xrow = w.xr + (size_t)t * D;
        if (MODE == 0) {
            const float* src = t < TL ? in.x + (size_t)t * D : in.ctx + (size_t)(t - TL) * D;
#pragma unroll
            for (int j = 0; j < 4; ++j) { v[j] = *(const f32x4*)(src + j * 256 + lane * 4); *(f32x4*)(xrow + j * 256 + lane * 4) = v[j]; }
        } else {
#pragma unroll
            for (int j = 0; j < 4; ++j) v[j] = *(const f32x4*)(xrow + j * 256 + lane * 4);
        }
        if (MODE == 2) {
            const float* g2 = mod_cur + (size_t)rb * 6144 + 5 * D;
            f32x4 f[4];
#pragma unroll
            for (int j = 0; j < 4; ++j) f[j] = (f32x4){0.f, 0.f, 0.f, 0.f};
#pragma unroll
            for (int k = 0; k < 4; ++k) {
                const float wk = topw[(size_t)t * 4 + k]; const bf16* yr = y + ((size_t)t * 4 + k) * D;
#pragma unroll
                for (int j = 0; j < 4; ++j) { u32x2 u = *(const u32x2*)(yr + j * 256 + lane * 4);
                    f[j][0] += wk * __uint_as_float(u.x << 16); f[j][1] += wk * __uint_as_float(u.x & 0xffff0000u); f[j][2] += wk * __uint_as_float(u.y << 16); f[j][3] += wk * __uint_as_float(u.y & 0xffff0000u); }
            }
#pragma unroll
            for (int j = 0; j < 4; ++j) { f32x4 g = *(const f32x4*)(g2 + j * 256 + lane * 4); v[j] += g * f[j]; *(f32x4*)(xrow + j * 256 + lane * 4) = v[j]; }
        }
        if (NORM == 0) continue;
        if (NORM == 2 && t >= TL) continue;
        float ss = 0.f;
#pragma unroll
        for (int j = 0; j < 4; ++j) ss += v[j][0] * v[j][0] + v[j][1] * v[j][1] + v[j][2] * v[j][2] + v[j][3] * v[j][3];
        ss = wave_sum(ss);
        const float rstd = 1.0f / sqrtf(ss * (1.0f / D) + EPS);
        if (NORM == 1) {
            const float* m = mod_nrm + (size_t)rb * 6144;
#pragma unroll
            for (int j = 0; j < 4; ++j) {
                const int c = j * 256 + lane * 4;
                f32x4 g = *(const f32x4*)(gnorm + c), sc = *(const f32x4*)(m + scc * D + c), sh = *(const f32x4*)(m + shc * D + c);
                f32x4 hv = v[j] * rstd * g * (sc + 1.0f) + sh;
                u32x2 u; u.x = pack_bf16(hv[0], hv[1]); u.y = pack_bf16(hv[2], hv[3]);
                *(u32x2*)(w.h + (size_t)t * D + c) = u;
            }
        } else {
#pragma unroll
            for (int j = 0; j < 4; ++j) { const int c = j * 256 + lane * 4; f32x4 g = *(const f32x4*)(gnorm + c); *(f32x4*)(out + (size_t)t * D + c) = v[j] * rstd * g; }
        }
    }
}

__device__ __forceinline__ void phase_router(char* lds, const WS& w, const float* ebias, int ntok, int l) {
    int tid = threadIdx.x; asm volatile("" : "+v"(tid));
    const int lane = tid & 63, wv = tid >> 6, fr = lane & 15, fq = lane >> 4;
    float* sl = (float*)lds + wv * (16 * 33);
    const bf16* Bt = w.wrT + (size_t)l * 32 * 1024;
    int* cnt = w.cnt + l * 32; int* list = w.list;
    for (int t0 = (blockIdx.x * 8 + wv) * 16; t0 < ntok; t0 += gridDim.x * 8 * 16) {
        f32x4 a0 = {0.f, 0.f, 0.f, 0.f}, a1 = {0.f, 0.f, 0.f, 0.f};
        const bf16* ar = w.h + (size_t)(t0 + fr) * D + fq * 8;
        const bf16* b0 = Bt + (size_t)fr * 1024 + fq * 8; const bf16* b1 = b0 + 16 * 1024;
#pragma unroll 4
        for (int ks = 0; ks < 32; ++ks) {
            bf16x8 fa = *(const bf16x8*)(ar + ks * 32), fb0 = *(const bf16x8*)(b0 + ks * 32), fb1 = *(const bf16x8*)(b1 + ks * 32);
            a0 = __builtin_amdgcn_mfma_f32_16x16x32_bf16(fa, fb0, a0, 0, 0, 0);
            a1 = __builtin_amdgcn_mfma_f32_16x16x32_bf16(fa, fb1, a1, 0, 0, 0);
        }
#pragma unroll
        for (int j = 0; j < 4; ++j) { sl[(4 * fq + j) * 33 + fr] = a0[j]; sl[(4 * fq + j) * 33 + 16 + fr] = a1[j]; }
        __builtin_amdgcn_wave_barrier(); asm volatile("s_waitcnt lgkmcnt(0)" ::: "memory");
        if (lane < 16) {
            const int t = t0 + lane; const float* sr = sl + lane * 33;
            int sel[4]; float ss[4]; float sum = 0.f;
#pragma unroll
            for (int k = 0; k < 4; ++k) {
                int best = 0; float bv = -1e30f, bs = 0.f;
                for (int e = 0; e < 32; ++e) {
                    bool used = false;
#pragma unroll
                    for (int q = 0; q < 4; ++q) if (q < k && sel[q] == e) used = true;
                    const float sg = 1.0f / (1.0f + expf(-sr[e])); const float vv = sg + ebias[e];
                    if (!used && vv > bv) { bv = vv; best = e; bs = sg; }
                }
                sel[k] = best; ss[k] = bs; sum += bs;
            }
            const float inv = ROUTED_SCALE / sum;
#pragma unroll
            for (int k = 0; k < 4; ++k) {
                w.topw[(size_t)t * 4 + k] = ss[k] * inv;
                const int pos = atomicAdd(&cnt[sel[k]], 1);
                list[(size_t)sel[k] * T + pos] = t * 4 + k;
            }
        }
        __builtin_amdgcn_wave_barrier(); asm volatile("s_waitcnt lgkmcnt(0)" ::: "memory");
    }
}

__device__ __forceinline__ bool moe_decode(int tile, int NT, const int* cnt, int ntok, int& e, int& mt, int& nt, int& base, int& rows) {
    int t = tile / NT; nt = tile % NT; int b = 0;
    for (int i = 0; i < 33; ++i) {
        const int c = i < 32 ? cnt[i] : ntok; const int m = (c + GBM - 1) / GBM;
        if (t < m) { e = i; mt = t; rows = c; base = b; return true; }
        t -= m; b += c;
    }
    return false;
}
struct ARowGather {
    const bf16* A; const int* list; int rows; int r0; bool ident;
    __device__ __forceinline__ const bf16* operator()(int i) const {
        const int idx = r0 + i; int tok = 0;
        if (idx < rows) tok = ident ? idx : (list[idx] >> 2);
        return A + (size_t)tok * D;
    }
};
struct EpiUp {
    bf16* hid; int base; int rows;
    __device__ __forceinline__ void operator()(f32x16 (&acc)[2][2], int mrow, int ncol) const {
        const int hc = (ncol >> 7) * 64 + ((ncol >> 6) & 1) * 32 + (ncol & 63);
#pragma unroll
        for (int mi = 0; mi < 2; ++mi) {
            const int idx = mrow + mi * 32;
            if (idx < rows) {
#pragma unroll
                for (int g = 0; g < 4; ++g) {
                    float o[4];
#pragma unroll
                    for (int q = 0; q < 4; ++q) { const float gt = acc[mi][0][4 * g + q], up = acc[mi][1][4 * g + q]; o[q] = gt / (1.0f + expf(-gt)) * up; }
                    u32x2 v; v.x = pack_bf16(o[0], o[1]); v.y = pack_bf16(o[2], o[3]);
                    *(u32x2*)(hid + (size_t)(base + idx) * 256 + hc + 8 * g) = v;
                }
            }
        }
    }
};
struct EpiDown {
    bf16* y; const int* list; int rows; bool shared; float* xr; const float* mod;
    __device__ __forceinline__ void operator()(f32x16 (&acc)[2][2], int mrow, int ncol) const {
#pragma unroll
        for (int mi = 0; mi < 2; ++mi) {
            const int idx = mrow + mi * 32;
            if (idx < rows) {
                if (!shared) {
                    const int asg = list[idx];
#pragma unroll
                    for (int ni = 0; ni < 2; ++ni)
#pragma unroll
                        for (int g = 0; g < 4; ++g) {
                            u32x2 v; v.x = pack_bf16(acc[mi][ni][4 * g], acc[mi][ni][4 * g + 1]); v.y = pack_bf16(acc[mi][ni][4 * g + 2], acc[mi][ni][4 * g + 3]);
                            *(u32x2*)(y + (size_t)asg * D + ncol + ni * 32 + 8 * g) = v;
                        }
                } else {
                    const int rb = idx < TL ? idx / S : 8; const float* g2 = mod + (size_t)rb * 6144 + 5 * D;
#pragma unroll
                    for (int ni = 0; ni < 2; ++ni)
#pragma unroll
                        for (int g = 0; g < 4; ++g) {
                            const int n = ncol + ni * 32 + 8 * g;
                            f32x4 gv = *(const f32x4*)(g2 + n); float* xp = xr + (size_t)idx * D + n; f32x4 xv = *(const f32x4*)xp;
                            xv[0] += gv[0] * acc[mi][ni][4 * g]; xv[1] += gv[1] * acc[mi][ni][4 * g + 1]; xv[2] += gv[2] * acc[mi][ni][4 * g + 2]; xv[3] += gv[3] * acc[mi][ni][4 * g + 3];
                            *(f32x4*)xp = xv;
                        }
                }
            }
        }
    }
};
__device__ __forceinline__ void phase_moe_up(char* lds, const WS& w, int l, int ntok) {
    const int* cnt = w.cnt + l * 32;
    for (int tile = blockIdx.x;; tile += gridDim.x) {
        int e, mt, nt, base, rows;
        if (!moe_decode(tile, 4, cnt, ntok, e, mt, nt, base, rows)) break;
        gemm_tile(lds, ARowGather{w.h, w.list + (size_t)e * T, rows, mt * GBM, e == 32}, w.moeUpT + (size_t)e * 512 * 1024, 1024, 1024, mt * GBM, nt * GBN, EpiUp{w.hid2, base, rows});
    }
}
__device__ __forceinline__ void phase_moe_down(char* lds, const WS& w, int l, int ntok, const float* mod) {
    const int* cnt = w.cnt + l * 32;
    for (int tile = blockIdx.x;; tile += gridDim.x) {
        int e, mt, nt, base, rows;
        if (!moe_decode(tile, 8, cnt, ntok, e, mt, nt, base, rows)) break;
        gemm_tile(lds, ARowDense{w.hid2, 256, base + mt * GBM}, w.moeDownT + (size_t)e * 1024 * 256, 256, 256, mt * GBM, nt * GBN,
                  EpiDown{(bf16*)w.h, w.list + (size_t)e * T, rows, e == 32, w.xr, mod});
    }
}
#endif
#ifndef HOST_SIM
typedef short s16x4 __attribute__((ext_vector_type(4)));
constexpr int AT_KV = 64 * 128;
constexpr int AT_STAGE = 2 * AT_KV;
__device__ __forceinline__ int at_voff(int key, int dcol) { return key * 128 + ((((dcol >> 5) ^ ((key >> 1) & 1))) << 6) + ((dcol & 31) << 1); }
__device__ __forceinline__ int at_kappa(int r) { return (r & ~12) | ((r & 4) << 1) | ((r & 8) >> 1); }

struct AttnState { f32x16 o[2]; float m, l; };

__device__ __forceinline__ void at_qk(const char* st, const bf16x8 (&qf)[4], f32x16 (&s)[2], int lane) {
    const int fr = lane & 31, fh = lane >> 5, kr = at_kappa(fr);
#pragma unroll
    for (int tt = 0; tt < 2; ++tt) {
#pragma unroll
        for (int r = 0; r < 16; ++r) s[tt][r] = 0.f;
#pragma unroll
        for (int ks = 0; ks < 4; ++ks) {
            const bf16x8 kf = *(const bf16x8*)(st + g_lds_off(32 * tt + kr, ks * 2 + fh));
            s[tt] = __builtin_amdgcn_mfma_f32_32x32x16_bf16(kf, qf[ks], s[tt], 0, 0, 0);
        }
    }
}
__device__ __forceinline__ void at_softmax_pv(const char* st, f32x16 (&s)[2], AttnState& a, int lane) {
    float mx = -1e30f;
#pragma unroll
    for (int tt = 0; tt < 2; ++tt)
#pragma unroll
        for (int r = 0; r < 16; ++r) mx = fmaxf(mx, s[tt][r]);
    mx = fmaxf(mx, __shfl_xor(mx, 32));
    const float mn = fmaxf(a.m, mx), alpha = __expf(a.m - mn);
    float rs = 0.f;
#pragma unroll
    for (int tt = 0; tt < 2; ++tt)
#pragma unroll
        for (int r = 0; r < 16; ++r) { const float p = __expf(s[tt][r] - mn); s[tt][r] = p; rs += p; }
    rs += __shfl_xor(rs, 32);
    a.l = a.l * alpha + rs; a.m = mn;
#pragma unroll
    for (int dt = 0; dt < 2; ++dt)
#pragma unroll
        for (int r = 0; r < 16; ++r) a.o[dt][r] *= alpha;
    const int fh = lane >> 5, i16 = lane & 15, g1 = (lane >> 4) & 1;
    const char* vb = st + AT_KV;
#pragma unroll
    for (int tt = 0; tt < 2; ++tt)
#pragma unroll
        for (int sp = 0; sp < 2; ++sp) {
            bf16x8 pf;
#pragma unroll
            for (int j = 0; j < 8; ++j) pf[j] = (short)f2bf(s[tt][8 * sp + j]);
#pragma unroll
            for (int dt = 0; dt < 2; ++dt) {
                const int kb = 32 * tt + 16 * sp + 8 * fh + (i16 >> 2), dc = 32 * dt + 16 * g1 + 4 * (i16 & 3);
                const s16x4 v0 = __builtin_amdgcn_ds_read_tr16_b64_v4i16((LAS s16x4*)(vb + at_voff(kb, dc)));
                const s16x4 v1 = __builtin_amdgcn_ds_read_tr16_b64_v4i16((LAS s16x4*)(vb + at_voff(kb + 4, dc)));
                bf16x8 vf; vf[0] = v0[0]; vf[1] = v0[1]; vf[2] = v0[2]; vf[3] = v0[3]; vf[4] = v1[0]; vf[5] = v1[1]; vf[6] = v1[2]; vf[7] = v1[3];
                a.o[dt] = __builtin_amdgcn_mfma_f32_32x32x16_bf16(vf, pf, a.o[dt], 0, 0, 0);
            }
        }
}
__device__ __forceinline__ void at_store(const AttnState& a, bf16* orow  , int lane) {
    const float il = 1.0f / a.l; const int fh = lane >> 5;
#pragma unroll
    for (int dt = 0; dt < 2; ++dt)
#pragma unroll
        for (int g = 0; g < 4; ++g) {
            u32x2 v; v.x = pack_bf16(a.o[dt][4 * g] * il, a.o[dt][4 * g + 1] * il); v.y = pack_bf16(a.o[dt][4 * g + 2] * il, a.o[dt][4 * g + 3] * il);
            *(u32x2*)(orow + 32 * dt + 8 * g + 4 * fh) = v;
        }
}
struct AtRegs { u32x4 k, v; };
__device__ __forceinline__ AtRegs at_load(const bf16* kbase, const bf16* vbase, int tid) {
    const int key = tid >> 3, c = tid & 7; AtRegs r;
    r.k = *(const u32x4*)(kbase + (size_t)key * DIN + c * 8); r.v = *(const u32x4*)(vbase + (size_t)key * DIN + c * 8); return r;
}
__device__ __forceinline__ void at_write(char* st, const AtRegs& r, int tid) {
    const int key = tid >> 3, c = tid & 7;
    *(u32x4*)(st + g_lds_off(key, c)) = r.k; *(u32x4*)(st + AT_KV + at_voff(key, c * 8)) = r.v;
}
__device__ __forceinline__ void at_loadq(bf16x8 (&qf)[4], const bf16* qrow, int lane) {
    const int fh = lane >> 5;
#pragma unroll
    for (int ks = 0; ks < 4; ++ks) qf[ks] = *(const bf16x8*)(qrow + ks * 16 + fh * 8);
}
__device__ __forceinline__ int at_key(int tt, int r, int fh) { return 32 * tt + (r & 3) + 8 * fh + 4 * ((r >> 2) & 1) + 16 * (r >> 3); }

__device__ __forceinline__ void attn_wa_item(char* lds, const bf16* p, bf16* ycat, const float* sink, int b, int hk, int qb, bool ctxq) {
    int tid = threadIdx.x; asm volatile("" : "+v"(tid));
    const int lane = tid & 63, wv = tid >> 6, fr = lane & 31, fh = lane >> 5;
    const int hq = 2 * hk + (wv >> 2);
    const int qpos = qb * 128 + (wv & 3) * 32 + fr;
    const size_t qtok = ctxq ? (size_t)TL + (size_t)b * LC + qpos : (size_t)b * S + qpos;
    bf16x8 qf[4]; at_loadq(qf, p + qtok * DIN + O1 + hq * 64, lane);
    AttnState a;
#pragma unroll
    for (int dt = 0; dt < 2; ++dt)
#pragma unroll
        for (int r = 0; r < 16; ++r) a.o[dt][r] = 0.f;
    a.m = sink[hq]; a.l = 1.0f;
    int lo = qb * 128 - 128, hi = qb * 128 + 256; if (lo < 0) lo = 0; if (hi > S) hi = S;
    const int nloc = ctxq ? 0 : (hi - lo) / 64, nt = 4 + nloc;
    const bf16* kc = p + ((size_t)TL + (size_t)b * LC) * DIN + O1 + 256 + hk * 64;
    const bf16* kl = p + ((size_t)b * S + lo) * DIN + O1 + 256 + hk * 64;
    __syncthreads();
    AtRegs rg = at_load(kc, kc + 128, tid);
    at_write(lds, rg, tid);
    __syncthreads();
    for (int i = 0; i < nt; ++i) {
        const char* st = lds + (i & 1) * AT_STAGE;
        if (i + 1 < nt) { const bf16* kb = (i + 1 < 4) ? kc + (size_t)(i + 1) * 64 * DIN : kl + (size_t)(i + 1 - 4) * 64 * DIN; rg = at_load(kb, kb + 128, tid); }
        f32x16 s[2]; at_qk(st, qf, s, lane);
        if (i < 4) {
#pragma unroll
            for (int tt = 0; tt < 2; ++tt)
#pragma unroll
                for (int r = 0; r < 16; ++r) s[tt][r] *= 0.125f;
        } else {
            const int kb0 = lo + (i - 4) * 64;
#pragma unroll
            for (int tt = 0; tt < 2; ++tt)
#pragma unroll
                for (int r = 0; r < 16; ++r) { const int d = kb0 + at_key(tt, r, fh) - qpos; s[tt][r] = (d >= -WINDOW && d <= WINDOW) ? s[tt][r] * 0.125f : -1e30f; }
        }
        at_softmax_pv(st, s, a, lane);
        if (i + 1 < nt) at_write(lds + ((i + 1) & 1) * AT_STAGE, rg, tid);
        __syncthreads();
    }
    at_store(a, ycat + qtok * 1024 + 256 + hq * 64, lane);
}
__device__ __forceinline__ void attn_na_item(char* lds, const bf16* p, bf16* ycat, const float* rpb  , int b, int h, int rg4, bool ctxq) {
    int tid = threadIdx.x; asm volatile("" : "+v"(tid));
    const int lane = tid & 63, wv = tid >> 6, fr = lane & 31, fh = lane >> 5;
    const int r = rg4 * 4 + (wv >> 1), cq = (wv & 1) * 32 + fr;
    const size_t qtok = ctxq ? (size_t)TL + (size_t)b * LC + wv * 32 + fr : (size_t)b * S + r * 64 + cq;
    bf16x8 qf[4]; at_loadq(qf, p + qtok * DIN + O2 + h * 64, lane);
    AttnState a;
#pragma unroll
    for (int dt = 0; dt < 2; ++dt)
#pragma unroll
        for (int rr = 0; rr < 16; ++rr) a.o[dt][rr] = 0.f;
    a.m = -1e30f; a.l = 0.f;
    constexpr int ROWS = S / GRID_W;
    int klo = rg4 * 4 - 4; if (klo < 0) klo = 0; int khi = rg4 * 4 + 3 - 4; if (khi < 0) khi = 0; if (khi > ROWS - NA_KR) khi = ROWS - NA_KR; khi += NA_KR;
    if (klo > ROWS - NA_KR) klo = ROWS - NA_KR;
    const int nloc = ctxq ? 0 : khi - klo, nt = 4 + nloc;
    int myr0 = r - 4; myr0 = myr0 < 0 ? 0 : (myr0 > ROWS - NA_KR ? ROWS - NA_KR : myr0);
    int c0 = cq - 8; c0 = c0 < 0 ? 0 : (c0 > GRID_W - NA_KC ? GRID_W - NA_KC : c0);
    const bf16* kc = p + ((size_t)TL + (size_t)b * LC) * DIN + O2 + 256 + h * 64;
    const bf16* kl = p + ((size_t)b * S + (size_t)klo * 64) * DIN + O2 + 256 + h * 64;
    float* bl = (float*)(lds + 2 * AT_STAGE);
    __syncthreads();
    if (tid < 15 * 31) bl[(tid / 31) * 32 + (tid % 31)] = rpb[h * 15 * 31 + tid];
    AtRegs rg = at_load(kc, kc + 256, tid);
    at_write(lds, rg, tid);
    __syncthreads();
    for (int i = 0; i < nt; ++i) {
        const char* st = lds + (i & 1) * AT_STAGE;
        if (i + 1 < nt) { const bf16* kb = (i + 1 < 4) ? kc + (size_t)(i + 1) * 64 * DIN : kl + (size_t)(i + 1 - 4) * 64 * DIN; rg = at_load(kb, kb + 256, tid); }
        const int krow = klo + (i - 4);
        const bool act = i < 4 || (krow >= myr0 && krow < myr0 + NA_KR);
        if (act) {
            f32x16 s[2]; at_qk(st, qf, s, lane);
            if (i < 4) {
#pragma unroll
                for (int tt = 0; tt < 2; ++tt)
#pragma unroll
                    for (int rr = 0; rr < 16; ++rr) s[tt][rr] *= 0.125f;
            } else {
                const float* brow = bl + (krow - r + 7) * 32 + 15 - cq;
#pragma unroll
                for (int tt = 0; tt < 2; ++tt)
#pragma unroll
                    for (int rr = 0; rr < 16; ++rr) { const int kcol = at_key(tt, rr, fh); const bool ok = kcol >= c0 && kcol < c0 + NA_KC;
                        const float bias = ok ? brow[kcol] : 0.f; s[tt][rr] = ok ? s[tt][rr] * 0.125f + bias : -1e30f; }
            }
            at_softmax_pv(st, s, a, lane);
        }
        if (i + 1 < nt) at_write(lds + ((i + 1) & 1) * AT_STAGE, rg, tid);
        __syncthreads();
    }
    at_store(a, ycat + qtok * 1024 + 512 + h * 64, lane);
}
__device__ __forceinline__ void phase_attn(char* lds, const WS& w, const Inputs& in, int l, bool need_ctx) {
    const int nitems = 512 + (need_ctx ? 64 : 0);
    for (int it = blockIdx.x; it < nitems; it += gridDim.x) {
        if (it < 256) attn_wa_item(lds, w.p, w.ycat, in.wa_sink + l * 4, it >> 5, (it >> 4) & 1, it & 15, false);
        else if (it < 512) { const int j = it - 256; attn_na_item(lds, w.p, w.ycat, in.na_rpb + l * 4 * 15 * 31, j >> 5, (j >> 3) & 3, j & 7, false); }
        else if (it < 544) { const int j = it - 512; attn_wa_item(lds, w.p, w.ycat, in.wa_sink + l * 4, j >> 2, (j >> 1) & 1, j & 1, true); }
        else { const int j = it - 544; attn_na_item(lds, w.p, w.ycat, in.na_rpb + l * 4 * 15 * 31, j >> 2, j & 3, 0, true); }
    }
}
#endif
#ifndef HOST_SIM
__device__ __forceinline__ float hy_c3(const bf16* pr, int tin, int col, const float* cw) {
    float acc = cw[768 + col] * bf2f(pr[col]);
    if (tin > 0) acc += cw[col] * bf2f(pr[col - DIN]);
    if (tin < S - 1) acc += cw[2 * 768 + col] * bf2f(pr[col + DIN]);
    return acc;
}
__device__ __forceinline__ void hy_prep_item(char* lds, const bf16* p, const float* cw, bf16* x0T, bf16* uvT, int b, int ch) {
    int tid = threadIdx.x; asm volatile("" : "+v"(tid));
    bf16* lx = (bf16*)lds;
    bf16* lu = lx + 256 * 72;
    __syncthreads();
    const int tl = tid & 63, cg = tid >> 6;
    const int tin = ch * 64 + tl; const bf16* pr = p + ((size_t)b * S + tin) * DIN;
    for (int it = 0; it < 4; ++it) {
        const int c0 = (it * 8 + cg) * 8;
        float x0[8], x1[8], vv[8];
#pragma unroll
        for (int q = 0; q < 8; ++q) { x0[q] = 0.f; x1[q] = 0.f; vv[q] = 0.f; }
#pragma unroll
        for (int dr = -1; dr <= 1; ++dr) {
            if (tin + dr < 0 || tin + dr >= S) continue;
            const bf16* r = pr + (ptrdiff_t)dr * DIN;
            const u32x4 a = *(const u32x4*)(r + c0), bq = *(const u32x4*)(r + 256 + c0), cq = *(const u32x4*)(r + 512 + c0);
            const float* w0 = cw + (dr + 1) * 768;
#pragma unroll
            for (int q = 0; q < 4; ++q) {
                x0[2 * q] += w0[c0 + 2 * q] * __uint_as_float(a[q] << 16); x0[2 * q + 1] += w0[c0 + 2 * q + 1] * __uint_as_float(a[q] & 0xffff0000u);
                x1[2 * q] += w0[256 + c0 + 2 * q] * __uint_as_float(bq[q] << 16); x1[2 * q + 1] += w0[256 + c0 + 2 * q + 1] * __uint_as_float(bq[q] & 0xffff0000u);
                vv[2 * q] += w0[512 + c0 + 2 * q] * __uint_as_float(cq[q] << 16); vv[2 * q + 1] += w0[512 + c0 + 2 * q + 1] * __uint_as_float(cq[q] & 0xffff0000u);
            }
        }
#pragma unroll
        for (int q = 0; q < 8; ++q) { lx[(c0 + q) * 72 + tl] = f2bf(x0[q]); lu[(c0 + q) * 72 + tl] = f2bf(x1[q] * vv[q]); }
    }
    __syncthreads();
    for (int i = tid; i < 2048; i += NTHREADS) {
        const int c = i >> 3, k = i & 7;
        const size_t g = ((size_t)c * B + b) * S + ch * 64 + k * 8;
        *(u32x4*)(x0T + g) = *(const u32x4*)(lx + c * 72 + k * 8);
        *(u32x4*)(uvT + g) = *(const u32x4*)(lu + c * 72 + k * 8);
    }
}
constexpr int HY_NOFF = 2072, HY_NE = 4128, HY_CS = HY_NE * 2 + 32;
constexpr int HY_URS = S * 2 + 16;
constexpr int HY_LDS_U = 8 * HY_CS, HY_LDS_Z = HY_LDS_U + 8 * HY_URS, HY_LDS_REV = HY_LDS_Z + 64, HY_LDS_END = HY_LDS_REV + (HY_NE + 8) * 2;
__device__ __forceinline__ void hy_conv_item(char* lds, const float* filtT, const float* hbias, const bf16* uvT, bf16* x0T  , int c) {
    static_assert(B == 8, "hyena conv assumes batch 8");
    int tid = threadIdx.x; asm volatile("" : "+v"(tid));
    const int lane = tid & 63, wv = tid >> 6, fr = lane & 31, fh = lane >> 5;
    bf16* rev = (bf16*)(lds + HY_LDS_REV);
    __syncthreads();
    const float* hf = filtT + (size_t)c * (S + LC); const float* hb = filtT + (size_t)(256 + c) * (S + LC);
    for (int e = tid; e < HY_NE + 8; e += NTHREADS) {
        const int n = e - HY_NOFF; float v = 0.f;
        if (n > 0 && n < S) v = hb[n]; else if (n <= 0 && n > -S) v = hf[-n];
        rev[e] = f2bf(v);
    }
    for (int i = tid; i < 8 * 256; i += NTHREADS) { const int bb = i >> 8, k = i & 255; *(u32x4*)(lds + HY_LDS_U + bb * HY_URS + k * 16) = *(const u32x4*)(uvT + ((size_t)c * B + bb) * S + k * 8); }
    if (tid < 4) ((unsigned*)(lds + HY_LDS_Z))[tid] = 0u;
    __syncthreads();
    for (int i = tid; i < 8 * (HY_NE / 2); i += NTHREADS) {
        const int m = i / (HY_NE / 2), d = i % (HY_NE / 2);
        const unsigned lo = rev[2 * d + m], hi = rev[2 * d + 1 + m];
        *(unsigned*)(lds + m * HY_CS + d * 4) = lo | (hi << 16);
    }
    __syncthreads();
    f32x16 acc[2];
#pragma unroll
    for (int q = 0; q < 2; ++q)
#pragma unroll
        for (int r = 0; r < 16; ++r) acc[q][r] = 0.f;
    const int bb = fr >> 2, pp = fr & 3;
    const int m = (-fr) & 7;
    const char* abase = lds + m * HY_CS;
    const char* ubase = lds + HY_LDS_U + bb * HY_URS + fh * 16;
    for (int dl = 16 * wv - 127; dl <= 16 * wv + 14; ++dl) {
        const int n0 = 8 * fh - fr - 16 * dl;
        const bf16x8 af = *(const bf16x8*)(abase + (n0 - m + HY_NOFF) * 2);
#pragma unroll
        for (int qq = 0; qq < 2; ++qq) {
            const int q = 2 * wv + qq;
            if (dl < 8 * q - 127 || dl > 8 * q + 6) continue;
            const int sj = 8 * q - dl + 2 * pp;
            const char* up = (sj >= 0 && sj < 128) ? ubase + sj * 32 : lds + HY_LDS_Z;
            const bf16x8 uf = *(const bf16x8*)up;
            acc[qq] = __builtin_amdgcn_mfma_f32_32x32x16_bf16(af, uf, acc[qq], 0, 0, 0);
        }
    }
    const float hbc = hbias[c];
#pragma unroll
    for (int qq = 0; qq < 2; ++qq) {
        const int tb = 32 * (4 * (2 * wv + qq) + pp) + 4 * fh;
#pragma unroll
        for (int g = 0; g < 4; ++g) {
            const int t = tb + 8 * g;
            const u32x2 uu = *(const u32x2*)(lds + HY_LDS_U + bb * HY_URS + t * 2);
            bf16* xp = x0T + ((size_t)c * B + bb) * S + t; const u32x2 xx = *(const u32x2*)xp;
            const float u0 = __uint_as_float(uu.x << 16), u1 = __uint_as_float(uu.x & 0xffff0000u), u2 = __uint_as_float(uu.y << 16), u3 = __uint_as_float(uu.y & 0xffff0000u);
            const float a0 = __uint_as_float(xx.x << 16), a1 = __uint_as_float(xx.x & 0xffff0000u), a2 = __uint_as_float(xx.y << 16), a3 = __uint_as_float(xx.y & 0xffff0000u);
            u32x2 o; o.x = pack_bf16(a0 * (acc[qq][4 * g] + hbc * u0), a1 * (acc[qq][4 * g + 1] + hbc * u1)); o.y = pack_bf16(a2 * (acc[qq][4 * g + 2] + hbc * u2), a3 * (acc[qq][4 * g + 3] + hbc * u3));
            *(u32x2*)xp = o;
        }
    }
}
__device__ __forceinline__ void hy_fin_item(char* lds, const bf16* yT, bf16* ycat, int b, int ch) {
    int tid = threadIdx.x; asm volatile("" : "+v"(tid));
    bf16* ly = (bf16*)lds;
    __syncthreads();
    for (int i = tid; i < 2048; i += NTHREADS) {
        const int c = i >> 3, k = i & 7;
        const u32x4 v = *(const u32x4*)(yT + ((size_t)c * B + b) * S + ch * 64 + k * 8);
#pragma unroll
        for (int q = 0; q < 4; ++q) { ly[(k * 8 + 2 * q) * 264 + c] = (bf16)(v[q] & 0xffffu); ly[(k * 8 + 2 * q + 1) * 264 + c] = (bf16)(v[q] >> 16); }
    }
    __syncthreads();
    for (int i = tid; i < 2048; i += NTHREADS) {
        const int t = i >> 5, k = i & 31;
        *(u32x4*)(ycat + ((size_t)b * S + ch * 64 + t) * 1024 + k * 8) = *(const u32x4*)(ly + t * 264 + k * 8);
    }
}
#endif
#ifndef HOST_SIM
constexpr int GD_NC = 36;
__device__ __forceinline__ size_t gd_tok0(int b, int cc) { return cc < 4 ? (size_t)TL + (size_t)b * LC + cc * 64 : (size_t)b * S + (size_t)(cc - 4) * 64; }

constexpr int GP_K = 0, GP_V = 8192, GP_L0 = 16384, GP_T0 = GP_L0 + 2 * 16384, GP_VB0 = GP_T0 + 2 * 8192  , GP_G = GP_VB0 + 2 * 8192  ,
              GP_SM = GP_VB0 + 4 * 8192  , GP_END = GP_SM + 6 * 256;

__device__ __forceinline__ void gdn_pre_item(char* lds, const WS& w, const float* cw  , const float* a_log, const float* dt_bias, int b, int cc, int h) {
    int tid = threadIdx.x; asm volatile("" : "+v"(tid));
    const int lane = tid & 63, wv = tid >> 6, fr = lane & 31, fh = lane >> 5;
    const bf16* p = w.p;
    const int L = cc < 4 ? LC : S; const int tin0 = cc < 4 ? cc * 64 : (cc - 4) * 64; const size_t tok0 = gd_tok0(b, cc);
    float* sm = (float*)(lds + GP_SM);
    __syncthreads();
    {
        const int tl = tid >> 3, dg = tid & 7;
        float q8[8], k8[8], v8[8];
#pragma unroll
        for (int x = 0; x < 8; ++x) { q8[x] = 0.f; k8[x] = 0.f; v8[x] = 0.f; }
#pragma unroll
        for (int i = 0; i < 4; ++i) {
            const int tt = tin0 + tl + i - 2;
            if (tt < 0 || tt >= L) continue;
            const bf16* r = p + (tok0 + tl + i - 2) * DIN + O3 + h * 64 + dg * 8;
            const u32x4 a = *(const u32x4*)r, bq = *(const u32x4*)(r + 256), cq = *(const u32x4*)(r + 512);
            const float* wq = cw + i * 768 + h * 64 + dg * 8;
#pragma unroll
            for (int x = 0; x < 4; ++x) {
                q8[2 * x] += wq[2 * x] * __uint_as_float(a[x] << 16); q8[2 * x + 1] += wq[2 * x + 1] * __uint_as_float(a[x] & 0xffff0000u);
                k8[2 * x] += wq[256 + 2 * x] * __uint_as_float(bq[x] << 16); k8[2 * x + 1] += wq[256 + 2 * x + 1] * __uint_as_float(bq[x] & 0xffff0000u);
                v8[2 * x] += wq[512 + 2 * x] * __uint_as_float(cq[x] << 16); v8[2 * x + 1] += wq[512 + 2 * x + 1] * __uint_as_float(cq[x] & 0xffff0000u);
            }
        }
        float sq = 0.f, sk = 0.f;
#pragma unroll
        for (int x = 0; x < 8; ++x) { q8[x] = q8[x] / (1.0f + __expf(-q8[x])); k8[x] = k8[x] / (1.0f + __expf(-k8[x])); v8[x] = v8[x] / (1.0f + __expf(-v8[x])); sq += q8[x] * q8[x]; sk += k8[x] * k8[x]; }
        sq += __shfl_xor(sq, 1); sq += __shfl_xor(sq, 2); sq += __shfl_xor(sq, 4);
        sk += __shfl_xor(sk, 1); sk += __shfl_xor(sk, 2); sk += __shfl_xor(sk, 4);
        const float rq = 0.125f / sqrtf(sq + EPS), rk = 1.0f / sqrtf(sk + EPS);
        u32x4 qo, ko, vo;
#pragma unroll
        for (int x = 0; x < 4; ++x) { qo[x] = pack_bf16(q8[2 * x] * rq, q8[2 * x + 1] * rq); ko[x] = pack_bf16(k8[2 * x] * rk, k8[2 * x + 1] * rk); vo[x] = pack_bf16(v8[2 * x], v8[2 * x + 1]); }
        bf16* qkg = w.qk + ((size_t)((b * 4 + h) * GD_NC + cc) * 2) * 4096;
        *(u32x4*)(qkg + tl * 64 + dg * 8) = qo; *(u32x4*)(qkg + 4096 + tl * 64 + dg * 8) = ko;
        *(u32x4*)(lds + GP_K + g_lds_off(tl, dg)) = ko;
        *(u32x4*)(lds + GP_V + at_voff(tl, dg * 8)) = vo;
        if (tid < 128) {
            const int dir = tid >> 6, t = tid & 63; const bf16* r = p + (tok0 + t) * DIN + O3 + 1024 + dir * 4 + h;
            const float a = bf2f(r[0]), bbv = bf2f(r[8]); const float x = a + dt_bias[dir * 4 + h]; const float sp = x > 20.f ? x : log1pf(expf(x));
            sm[dir * 64 + t] = -expf(a_log[dir * 4 + h]) * sp; sm[128 + dir * 64 + t] = 1.0f / (1.0f + expf(-bbv));
        }
    }
    __syncthreads();
    if (wv < 4) {
        const int ta = wv >> 1, tb = wv & 1; f32x16 g;
#pragma unroll
        for (int r = 0; r < 16; ++r) g[r] = 0.f;
#pragma unroll
        for (int ks = 0; ks < 4; ++ks) {
            const bf16x8 fa = *(const bf16x8*)(lds + GP_K + g_lds_off(32 * ta + fr, ks * 2 + fh)), fb = *(const bf16x8*)(lds + GP_K + g_lds_off(32 * tb + fr, ks * 2 + fh));
            g = __builtin_amdgcn_mfma_f32_32x32x16_bf16(fa, fb, g, 0, 0, 0);
        }
        float* G = (float*)(lds + GP_G);
#pragma unroll
        for (int r = 0; r < 16; ++r) G[(32 * ta + (r & 3) + 8 * (r >> 2) + 4 * fh) * 64 + 32 * tb + fr] = g[r];
    } else if (wv < 6) {
        const int dir = wv - 4; float v = sm[dir * 64 + (dir ? 63 - lane : lane)];
#pragma unroll
        for (int o = 1; o < 64; o <<= 1) { const float t = __shfl_up(v, o); if (lane >= o) v += t; }
        sm[256 + dir * 64 + lane] = v;
        float* gcg = w.gc + ((size_t)((b * 4 + h) * 2 + dir) * GD_NC + cc) * 64; gcg[lane] = v;
    }
    __syncthreads();
    const int dir = wv >> 2, t4 = tid & 255;
    {
        const float* G = (const float*)(lds + GP_G); float* Lm = (float*)(lds + GP_L0 + dir * 16384);
        for (int e = t4; e < 4096; e += 256) {
            const int i = e >> 6, j = e & 63; const int ti = dir ? 63 - i : i, tj = dir ? 63 - j : j;
            Lm[e] = j < i ? sm[128 + dir * 64 + ti] * G[ti * 64 + tj] * __expf(sm[256 + dir * 64 + i] - sm[256 + dir * 64 + j]) : 0.f;
        }
    }
    __syncthreads();
    if ((wv & 3) == 0) {
        const float* Lm = (const float*)(lds + GP_L0 + dir * 16384);
        float Tc[64];
#pragma unroll
        for (int i = 0; i < 64; ++i) {
            float a0 = (lane == i) ? 1.0f : 0.f, a1 = 0.f, a2 = 0.f, a3 = 0.f;
#pragma unroll
            for (int j4 = 0; j4 < (i & ~3); j4 += 4) {
                const f32x4 l4 = *(const f32x4*)(Lm + i * 64 + j4);
                a0 -= l4[0] * Tc[j4]; a1 -= l4[1] * Tc[j4 + 1]; a2 -= l4[2] * Tc[j4 + 2]; a3 -= l4[3] * Tc[j4 + 3];
            }
#pragma unroll
            for (int j = (i & ~3); j < i; ++j) a0 -= Lm[i * 64 + j] * Tc[j];
            Tc[i] = (a0 + a1) + (a2 + a3);
        }
        bf16* Tm = (bf16*)(lds + GP_T0 + dir * 8192);
#pragma unroll
        for (int i = 0; i < 64; ++i) Tm[(g_lds_off(i, lane >> 3) >> 1) + (lane & 7)] = f2bf(Tc[i]);
    } else {
        const int t3 = t4 - 64;
        for (int e = t3; e < 1024; e += 192) {
            const int mat = e >> 9, j = (e >> 3) & 63, c8 = e & 7; const int tj = dir ? 63 - j : j;
            const float sc = sm[128 + dir * 64 + tj] * (mat ? __expf(sm[256 + dir * 64 + j]) : 1.0f);
            const u32x4 src = mat ? *(const u32x4*)(lds + GP_K + g_lds_off(tj, c8)) : *(const u32x4*)(lds + GP_V + at_voff(tj, c8 * 8));
            u32x4 d;
#pragma unroll
            for (int x = 0; x < 4; ++x) d[x] = pack_bf16(sc * __uint_as_float(src[x] << 16), sc * __uint_as_float(src[x] & 0xffff0000u));
            *(u32x4*)(lds + GP_VB0 + (dir * 2 + mat) * 8192 + at_voff(j, c8 * 8)) = d;
        }
    }
    __syncthreads();
    {
        const int w4 = wv & 3, ta = w4 >> 1, tb = w4 & 1; const int i16 = lane & 15, g1 = (lane >> 4) & 1;
        const char* Tm = lds + GP_T0 + dir * 8192; const char* vb = lds + GP_VB0 + (dir * 2) * 8192; const char* kbe = vb + 8192;
        f32x16 aw, au;
#pragma unroll
        for (int r = 0; r < 16; ++r) { aw[r] = 0.f; au[r] = 0.f; }
#pragma unroll
        for (int ks = 0; ks < 4; ++ks) {
            const int jr = 16 * ks + 8 * fh + (i16 >> 2), dc = 32 * ta + 16 * g1 + 4 * (i16 & 3);
            const s16x4 k0 = __builtin_amdgcn_ds_read_tr16_b64_v4i16((LAS s16x4*)(kbe + at_voff(jr, dc))), k1 = __builtin_amdgcn_ds_read_tr16_b64_v4i16((LAS s16x4*)(kbe + at_voff(jr + 4, dc)));
            bf16x8 fa; fa[0] = k0[0]; fa[1] = k0[1]; fa[2] = k0[2]; fa[3] = k0[3]; fa[4] = k1[0]; fa[5] = k1[1]; fa[6] = k1[2]; fa[7] = k1[3];
            const bf16x8 fbT = *(const bf16x8*)(Tm + g_lds_off(32 * tb + fr, ks * 2 + fh));
            aw = __builtin_amdgcn_mfma_f32_32x32x16_bf16(fa, fbT, aw, 0, 0, 0);
            const bf16x8 faT = *(const bf16x8*)(Tm + g_lds_off(32 * ta + fr, ks * 2 + fh));
            const int dc2 = 32 * tb + 16 * g1 + 4 * (i16 & 3);
            const s16x4 v0 = __builtin_amdgcn_ds_read_tr16_b64_v4i16((LAS s16x4*)(vb + at_voff(jr, dc2))), v1 = __builtin_amdgcn_ds_read_tr16_b64_v4i16((LAS s16x4*)(vb + at_voff(jr + 4, dc2)));
            bf16x8 fv; fv[0] = v0[0]; fv[1] = v0[1]; fv[2] = v0[2]; fv[3] = v0[3]; fv[4] = v1[0]; fv[5] = v1[1]; fv[6] = v1[2]; fv[7] = v1[3];
            au = __builtin_amdgcn_mfma_f32_32x32x16_bf16(faT, fv, au, 0, 0, 0);
        }
        bf16* uwg = w.uw + ((size_t)(((b * 4 + h) * 2 + dir) * GD_NC + cc) * 2) * 4096;
#pragma unroll
        for (int g = 0; g < 4; ++g) {
            const int rr = 32 * ta + 8 * g + 4 * fh;
            u32x2 o1; o1.x = pack_bf16(-aw[4 * g], -aw[4 * g + 1]); o1.y = pack_bf16(-aw[4 * g + 2], -aw[4 * g + 3]);
            *(u32x2*)(uwg + (32 * tb + fr) * 64 + rr) = o1;
            u32x2 o2; o2.x = pack_bf16(au[4 * g], au[4 * g + 1]); o2.y = pack_bf16(au[4 * g + 2], au[4 * g + 3]);
            *(u32x2*)(uwg + 4096 + (32 * tb + fr) * 64 + rr) = o2;
        }
    }
}
#endif
#ifndef HOST_SIM
constexpr int GS_IN = 0  , GS_ST = 65536  , GS_U1 = GS_ST + 16384, GS_U2 = GS_U1 + 8192, GS_AT = GS_U2 + 8192,
              GS_TB = GS_AT + 8192  , GS_END = GS_TB + 2 * 1024;
__device__ __forceinline__ int gd_chunk_of_step(int dir, int n) { return dir ? (n < 4 ? 3 - n : 39 - n) : n; }

__device__ __forceinline__ void gdn_scan_chain(char* lds, const WS& w, int b, int h, int dir, bool emit_ctx) {
    int tid = threadIdx.x; asm volatile("" : "+v"(tid));
    const int lane = tid & 63, wv = tid >> 6, fr = lane & 31, fh = lane >> 5, w4 = wv & 3, ta = w4 >> 1, tb = w4 & 1;
    const int i16 = lane & 15, g1 = (lane >> 4) & 1;
    const bool lo = wv < 4;
    const size_t chain = (size_t)((b * 4 + h) * 2 + dir) * GD_NC;
    const bf16* qkb = w.qk + (size_t)(b * 4 + h) * GD_NC * 2 * 4096;
    bf16* uwb = w.uw + chain * 2 * 4096; const float* gcb = w.gc + chain * 64;
    const int lrow = tid >> 3, lch = tid & 7;
    const int qrow = dir ? 63 - lrow : lrow;
    __syncthreads();
    *(u32x4*)(lds + GS_ST + tid * 16) = (u32x4){0u, 0u, 0u, 0u};
    f32x16 Sacc;
#pragma unroll
    for (int r = 0; r < 16; ++r) Sacc[r] = 0.f;
    u32x4 rw, rq, rk; float rg = 0.f; u32x2 uc[4];
    auto prefetch = [&](int n) {
        const int cc = gd_chunk_of_step(dir, n);
        const bf16* uwp = uwb + (size_t)cc * 2 * 4096; const bf16* qkp = qkb + (size_t)cc * 2 * 4096;
        rw = *(const u32x4*)(uwp + lrow * 64 + lch * 8);
        rq = *(const u32x4*)(qkp + lrow * 64 + lch * 8); rk = *(const u32x4*)(qkp + 4096 + lrow * 64 + lch * 8);
        if (tid < 64) rg = gcb[(size_t)cc * 64 + tid];
    };
    auto prefetch_u = [&](int n) {
        const int cc = gd_chunk_of_step(dir, n); const bf16* up = uwb + (size_t)cc * 2 * 4096 + 4096 + (32 * tb + fr) * 64 + 32 * ta + 4 * fh;
#pragma unroll
        for (int g = 0; g < 4; ++g) uc[g] = *(const u32x2*)(up + 8 * g);
    };
    auto stage = [&](int buf) {
        char* ib = lds + GS_IN + buf * 32768;
        *(u32x4*)(ib + g_lds_off(lrow, lch)) = rw;
        *(u32x4*)(ib + 8192 + g_lds_off(qrow, lch)) = rq;
        *(u32x4*)(ib + 16384 + g_lds_off(qrow, lch)) = rk;
        *(u32x4*)(ib + 24576 + at_voff(qrow, lch * 8)) = rk;
        float* tbp = (float*)(lds + GS_TB + buf * 1024);
        if (tid < 64) { const float g63 = __shfl(rg, 63); tbp[tid] = rg; tbp[64 + tid] = __expf(rg); tbp[128 + tid] = __expf(g63 - rg); if (tid == 0) tbp[192] = __expf(g63); }
    };
    prefetch(0); if (lo) prefetch_u(0);
    stage(0);
    prefetch(1);
    __syncthreads();
    for (int n = 0; n < GD_NC; ++n) {
        const int buf = n & 1; const char* ib = lds + GS_IN + buf * 32768; const float* tbp = (const float*)(lds + GS_TB + buf * 1024);
        const char* St = lds + GS_ST + buf * 8192; char* Stn = lds + GS_ST + (buf ^ 1) * 8192;
        const int cc = gd_chunk_of_step(dir, n);
        if (lo) {
            f32x16 acc;
#pragma unroll
            for (int g = 0; g < 4; ++g) { acc[4 * g] = __uint_as_float(uc[g].x << 16); acc[4 * g + 1] = __uint_as_float(uc[g].x & 0xffff0000u); acc[4 * g + 2] = __uint_as_float(uc[g].y << 16); acc[4 * g + 3] = __uint_as_float(uc[g].y & 0xffff0000u); }
#pragma unroll
            for (int ks = 0; ks < 4; ++ks) {
                const bf16x8 fa = *(const bf16x8*)(ib + g_lds_off(32 * ta + fr, ks * 2 + fh)), fb = *(const bf16x8*)(St + g_lds_off(32 * tb + fr, ks * 2 + fh));
                acc = __builtin_amdgcn_mfma_f32_32x32x16_bf16(fa, fb, acc, 0, 0, 0);
            }
#pragma unroll
            for (int g = 0; g < 4; ++g) {
                const int i0 = 32 * ta + 8 * g + 4 * fh; const f32x4 fc = *(const f32x4*)(tbp + 128 + i0);
                u32x2 o1; o1.x = pack_bf16(acc[4 * g], acc[4 * g + 1]); o1.y = pack_bf16(acc[4 * g + 2], acc[4 * g + 3]);
                u32x2 o2; o2.x = pack_bf16(acc[4 * g] * fc[0], acc[4 * g + 1] * fc[1]); o2.y = pack_bf16(acc[4 * g + 2] * fc[2], acc[4 * g + 3] * fc[3]);
                const int off = g_lds_off(32 * tb + fr, i0 >> 3) + (i0 & 7) * 2;
                *(u32x2*)(lds + GS_U1 + off) = o1; *(u32x2*)(lds + GS_U2 + off) = o2;
            }
            if (n + 1 < GD_NC) prefetch_u(n + 1);
        } else {
            f32x16 acc;
#pragma unroll
            for (int r = 0; r < 16; ++r) acc[r] = 0.f;
#pragma unroll
            for (int ks = 0; ks < 4; ++ks) {
                const bf16x8 fa = *(const bf16x8*)(ib + 16384 + g_lds_off(32 * ta + fr, ks * 2 + fh)), fb = *(const bf16x8*)(ib + 8192 + g_lds_off(32 * tb + fr, ks * 2 + fh));
                acc = __builtin_amdgcn_mfma_f32_32x32x16_bf16(fa, fb, acc, 0, 0, 0);
            }
            const int i = 32 * tb + fr; const float gi = tbp[i];
#pragma unroll
            for (int g = 0; g < 4; ++g) {
                const int j0 = 32 * ta + 8 * g + 4 * fh; const f32x4 gj = *(const f32x4*)(tbp + j0);
                float v[4];
#pragma unroll
                for (int x = 0; x < 4; ++x) v[x] = (j0 + x <= i) ? acc[4 * g + x] * __expf(gi - gj[x]) : 0.f;
                u32x2 o; o.x = pack_bf16(v[0], v[1]); o.y = pack_bf16(v[2], v[3]);
                *(u32x2*)(lds + GS_AT + g_lds_off(i, j0 >> 3) + (j0 & 7) * 2) = o;
            }
        }
        __syncthreads();
        if (lo) {
            f32x16 acc;
#pragma unroll
            for (int r = 0; r < 16; ++r) acc[r] = 0.f;
#pragma unroll
            for (int ks = 0; ks < 4; ++ks) {
                const bf16x8 fa = *(const bf16x8*)(ib + 8192 + g_lds_off(32 * ta + fr, ks * 2 + fh)), fb = *(const bf16x8*)(St + g_lds_off(32 * tb + fr, ks * 2 + fh));
                acc = __builtin_amdgcn_mfma_f32_32x32x16_bf16(fa, fb, acc, 0, 0, 0);
            }
#pragma unroll
            for (int g = 0; g < 4; ++g) { const f32x4 eg = *(const f32x4*)(tbp + 64 + 32 * ta + 8 * g + 4 * fh); acc[4 * g] *= eg[0]; acc[4 * g + 1] *= eg[1]; acc[4 * g + 2] *= eg[2]; acc[4 * g + 3] *= eg[3]; }
#pragma unroll
            for (int ks = 0; ks < 4; ++ks) {
                const bf16x8 fa = *(const bf16x8*)(lds + GS_AT + g_lds_off(32 * ta + fr, ks * 2 + fh)), fb = *(const bf16x8*)(lds + GS_U1 + g_lds_off(32 * tb + fr, ks * 2 + fh));
                acc = __builtin_amdgcn_mfma_f32_32x32x16_bf16(fa, fb, acc, 0, 0, 0);
            }
            if (cc >= 4 || emit_ctx) {
                bf16* op = uwb + (size_t)cc * 2 * 4096 + 4096 + (32 * tb + fr) * 64 + 32 * ta + 4 * fh;
#pragma unroll
                for (int g = 0; g < 4; ++g) { u32x2 o; o.x = pack_bf16(acc[4 * g], acc[4 * g + 1]); o.y = pack_bf16(acc[4 * g + 2], acc[4 * g + 3]); *(u32x2*)(op + 8 * g) = o; }
            }
        } else {
            const float e63 = tbp[192];
#pragma unroll
            for (int r = 0; r < 16; ++r) Sacc[r] *= e63;
#pragma unroll
            for (int ks = 0; ks < 4; ++ks) {
                const int ir = 16 * ks + 8 * fh + (i16 >> 2), dc = 32 * ta + 16 * g1 + 4 * (i16 & 3);
                const s16x4 k0 = __builtin_amdgcn_ds_read_tr16_b64_v4i16((LAS s16x4*)(ib + 24576 + at_voff(ir, dc))), k1 = __builtin_amdgcn_ds_read_tr16_b64_v4i16((LAS s16x4*)(ib + 24576 + at_voff(ir + 4, dc)));
                bf16x8 fa; fa[0] = k0[0]; fa[1] = k0[1]; fa[2] = k0[2]; fa[3] = k0[3]; fa[4] = k1[0]; fa[5] = k1[1]; fa[6] = k1[2]; fa[7] = k1[3];
                const bf16x8 fb = *(const bf16x8*)(lds + GS_U2 + g_lds_off(32 * tb + fr, ks * 2 + fh));
                Sacc = __builtin_amdgcn_mfma_f32_32x32x16_bf16(fa, fb, Sacc, 0, 0, 0);
            }
#pragma unroll
            for (int g = 0; g < 4; ++g) {
                const int d0 = 32 * ta + 8 * g + 4 * fh; u32x2 o; o.x = pack_bf16(Sacc[4 * g], Sacc[4 * g + 1]); o.y = pack_bf16(Sacc[4 * g + 2], Sacc[4 * g + 3]);
                *(u32x2*)(Stn + g_lds_off(32 * tb + fr, d0 >> 3) + (d0 & 7) * 2) = o;
            }
        }
        if (n + 1 < GD_NC) { stage(buf ^ 1); if (n + 2 < GD_NC) prefetch(n + 2); }
        __syncthreads();
    }
}

__device__ __forceinline__ void gdn_fin_item(char* lds, const WS& w, const float* ng, int b, int cc, int h) {
    int tid = threadIdx.x; asm volatile("" : "+v"(tid));
    bf16* lo_ = (bf16*)lds;
    __syncthreads();
    for (int i = tid; i < 1024; i += NTHREADS) {
        const int dir = i >> 9, dv = (i >> 3) & 63, k = i & 7;
        const bf16* src = w.uw + ((size_t)(((b * 4 + h) * 2 + dir) * GD_NC + cc) * 2 + 1) * 4096 + dv * 64 + k * 8;
        *(u32x4*)(lo_ + (dir * 64 + dv) * 72 + k * 8) = *(const u32x4*)src;
    }
    __syncthreads();
    const int tl = tid >> 3, dg = tid & 7; const size_t tok = gd_tok0(b, cc) + tl;
    float o[8]; float ss = 0.f;
#pragma unroll
    for (int x = 0; x < 8; ++x) { const int dv = dg * 8 + x; o[x] = bf2f(lo_[dv * 72 + tl]) + bf2f(lo_[(64 + dv) * 72 + 63 - tl]); ss += o[x] * o[x]; }
    ss += __shfl_xor(ss, 1); ss += __shfl_xor(ss, 2); ss += __shfl_xor(ss, 4);
    const float rs = 1.0f / sqrtf(ss * (1.0f / 64.0f) + EPS);
    const u32x4 gt = *(const u32x4*)(w.p + tok * DIN + O3 + 768 + h * 64 + dg * 8);
    u32x4 out;
#pragma unroll
    for (int x = 0; x < 4; ++x) {
        const float g0 = __uint_as_float(gt[x] << 16), g1v = __uint_as_float(gt[x] & 0xffff0000u);
        const float y0 = o[2 * x] * rs * ng[dg * 8 + 2 * x] * (g0 / (1.0f + __expf(-g0))), y1 = o[2 * x + 1] * rs * ng[dg * 8 + 2 * x + 1] * (g1v / (1.0f + __expf(-g1v)));
        out[x] = pack_bf16(y0, y1);
    }
    *(u32x4*)(w.ycat + tok * 1024 + 768 + h * 64 + dg * 8) = out;
}
#endif
#ifndef HOST_SIM
namespace cg = cooperative_groups;
struct MP { Inputs in; float* out; WS w; };

template <class F> __device__ __forceinline__ void dev_run(const F& f, long n) {
    int t0 = threadIdx.x; asm volatile("" : "+v"(t0));
    for (long i = (long)blockIdx.x * NTHREADS + t0; i < n; i += (long)gridDim.x * NTHREADS) f(i);
}

__device__ __forceinline__ void phase_inproj(char* lds, const WS& w, int l) {
    constexpr int MT = T / GBM, NT = (DIN + GBN - 1) / GBN;
    const bf16* Bt = w.winT + (size_t)l * 3200 * 1024;
    for (int tile = blockIdx.x; tile < MT * NT; tile += gridDim.x) {
        const int mg = tile / (8 * NT), rem = tile % (8 * NT), nt = rem / 8, mt = mg * 8 + (rem & 7);
        gemm_tile(lds, ARowDense{w.h, D, mt * GBM}, Bt, 1024, 1024, mt * GBM, nt * GBN, EpiInProj{w.p, w.rope});
    }
}
__device__ __forceinline__ void phase_outproj(char* lds, const WS& w, int l, const float* mod, int ntok) {
    const int MT = ntok / GBM, NT = D / GBN;
    const bf16* Bt = w.woutT + (size_t)l * 1024 * 1024;
    for (int tile = blockIdx.x; tile < MT * NT; tile += gridDim.x) {
        const int mt = tile / NT, nt = tile % NT;
        gemm_tile(lds, ARowDense{w.ycat, 1024, mt * GBM}, Bt, 1024, 1024, mt * GBM, nt * GBN, EpiOutProj{w.xr, mod});
    }
}

__global__ void __launch_bounds__(NTHREADS) mega_kernel(MP mp) {
    extern __shared__ __attribute__((aligned(16))) char lds[];
    __shared__ uint4 xb_words;
    cg::grid_group grid = cg::this_grid();
    const Inputs& in = mp.in; const WS& w = mp.w;
    if (threadIdx.x == 0) xb_words = make_uint4(0u, 0u, 0u, 0u);
    __syncthreads();
    XcdBarrier xb = xcd_barrier_post(w.bar, (volatile LAS unsigned*)&xb_words);
#define GSYNC() xcd_barrier(xb)
    dev_run(NkAda{in.c, in.c_ctx, in.w_ada, in.b_ada, w.mod}, NkAda::count());
    dev_run(NkRopeTab{w.rope}, NkRopeTab::count());
    dev_run(NkZeroI{w.cnt}, 64);
    for (int l = 0; l < 2; ++l) {
        NkCvtT c1{in.w_in + (size_t)l * D * DIN, w.winT + (size_t)l * 3200 * 1024, 1024, DIN, 3200}; dev_run(c1, c1.count());
        NkCvtT c2{in.w_out + (size_t)l * 1024 * D, w.woutT + (size_t)l * 1024 * 1024, 1024, 1024, 1024}; dev_run(c2, c2.count());
        NkCvtT c3{in.moe_router + (size_t)l * D * 32, w.wrT + (size_t)l * 32 * 1024, 1024, 32, 32}; dev_run(c3, c3.count());
        dev_run(NkHyF1{in.hy_w1 + l * 33 * 64, in.hy_b1 + l * 64, in.hy_freq + l * 64, w.hyf1 + (size_t)l * (S + LC) * 64}, NkHyF1::count());
    }
    grid.sync();
    for (int l = 0; l < 2; ++l)
        dev_run(NkHyF2{in.hy_w2 + l * 64 * 64, in.hy_b2 + l * 64, in.hy_freq + l * 64, w.hyf1 + (size_t)l * (S + LC) * 64, w.hyf2 + (size_t)l * (S + LC) * 64}, NkHyF2::count());
    row_pass<0, 1>(w, in, T, w.mod, w.mod, in.norm1, 0, 1, nullptr, nullptr, nullptr);
    GSYNC();
    for (int l = 0; l < 2; ++l) {
        const bool need_ctx = l == 0;
        const float* mod = w.mod + (size_t)l * 9 * 6144;
        const long ntok = need_ctx ? T : TL;
        if (l == 1) { row_pass<1, 1>(w, in, T, mod, mod, in.norm1 + l * D, 0, 1, nullptr, nullptr, nullptr); GSYNC(); }
        const float* filt = w.filt + (size_t)l * (S + LC) * 512;
        phase_inproj(lds, w, l);
        dev_run(NkHyF3{in.hy_w3 + l * 64 * 512, w.hyf2 + (size_t)l * (S + LC) * 64, w.filt + (size_t)l * (S + LC) * 512}, NkHyF3::count());
        GSYNC();
        const float* hcw = in.hy_conv + l * 3 * 768;
        for (int it = blockIdx.x; it < B * GD_NC * 4; it += gridDim.x) gdn_pre_item(lds, w, in.gdn_conv + l * 4 * 768, in.gdn_a_log + l * 8, in.gdn_dt_bias + l * 8, it / (GD_NC * 4), (it >> 2) % GD_NC, it & 3);
        for (int it = blockIdx.x; it < B * 32; it += gridDim.x) hy_prep_item(lds, w.p, hcw, w.x0T, w.uvT, it >> 5, it & 31);
        if (need_ctx) dev_run(NkHyUV{w.p, hcw, w.uv, TL, TC, LC}, (long)TC * 256);
        phase_attn(lds, w, in, l, need_ctx);
        GSYNC();
        if (blockIdx.x < 64) gdn_scan_chain(lds, w, blockIdx.x >> 3, (blockIdx.x >> 1) & 3, blockIdx.x & 1, need_ctx);
        else for (int c = blockIdx.x - 64; c < 256; c += gridDim.x - 64) hy_conv_item(lds, filt, in.hy_bias + l * 256, w.uvT, w.x0T, c);
        GSYNC();
        for (int it = blockIdx.x; it < B * 32; it += gridDim.x) hy_fin_item(lds, w.x0T, w.ycat, it >> 5, it & 31);
        if (need_ctx) dev_run(NkHyConv{w.p, hcw, w.uv, filt, in.hy_bias + l * 256, w.ycat, TL, LC, S}, (long)TC * 256);
        for (int it = blockIdx.x; it < B * GD_NC * 4; it += gridDim.x) { const int cc = (it >> 2) % GD_NC; if (cc >= 4 || need_ctx) gdn_fin_item(lds, w, in.gdn_norm + l * 64, it / (GD_NC * 4), cc, it & 3); }
        GSYNC();
        phase_outproj(lds, w, l, mod, (int)ntok);
        dev_run(NkCvtUp{in.moe_gate + (size_t)l * 32 * D * 256, in.moe_up + (size_t)l * 32 * D * 256, in.sh_gate + (size_t)l * D * 256, in.sh_up + (size_t)l * D * 256, w.moeUpT}, NkCvtUp::count());
        dev_run(NkCvtDown{in.moe_down + (size_t)l * 32 * 256 * D, in.sh_down + (size_t)l * 256 * D, w.moeDownT}, NkCvtDown::count());
        GSYNC();
        row_pass<1, 1>(w, in, (int)ntok, mod, mod, in.norm2 + l * D, 3, 4, nullptr, nullptr, nullptr);
        GSYNC();
        phase_router(lds, w, in.moe_bias + l * 32, (int)ntok, l);
        GSYNC();
        phase_moe_up(lds, w, l, (int)ntok);
        GSYNC();
        phase_moe_down(lds, w, l, (int)ntok, mod);
        GSYNC();
        if (l == 0) row_pass<2, 0>(w, in, (int)ntok, mod, mod, nullptr, 0, 0, (const bf16*)w.h, w.topw, nullptr);
        else row_pass<2, 2>(w, in, (int)ntok, mod, mod, in.norm_f, 0, 0, (const bf16*)w.h, w.topw, mp.out);
        GSYNC();
    }
}

constexpr size_t kDynLds = 112 * 1024;
static_assert(G_LDS <= kDynLds && HY_LDS_END <= kDynLds && 2 * AT_STAGE + 2048 <= kDynLds && GP_END <= kDynLds && GS_END <= kDynLds, "LDS budget");
extern "C" void kernel_launch(void* const* d_in, const int* in_sizes, int n_in, void* d_out, int out_size, void* d_ws, size_t ws_size, hipStream_t stream) {
    static int grid_blocks = 0;
    if (!grid_blocks) {
        int dev = 0, cus = 0, per_cu = 0;
        hipGetDevice(&dev);
        hipDeviceGetAttribute(&cus, hipDeviceAttributeMultiprocessorCount, dev);
        hipFuncSetAttribute((const void*)mega_kernel, hipFuncAttributeMaxDynamicSharedMemorySize, (int)kDynLds);
        hipOccupancyMaxActiveBlocksPerMultiprocessor(&per_cu, mega_kernel, NTHREADS, kDynLds);
        if (per_cu < 1) per_cu = 1;
        grid_blocks = cus;
    }
    MP mp; memset(&mp, 0, sizeof(mp));
    const float** ip = (const float**)&mp.in;
    for (int i = 0; i < 33; ++i) ip[i] = (const float*)d_in[i];
    mp.out = (float*)d_out; mp.w = make_ws(d_ws);
    hipMemsetAsync(mp.w.bar, 0, 4096 * 4, stream);
    void* args[] = {&mp};
    hipError_t e = hipLaunchCooperativeKernel((void*)mega_kernel, dim3(grid_blocks), dim3(NTHREADS), args, kDynLds, stream);
    if (e != hipSuccess) fprintf(stderr, "cooperative launch failed: %s (grid %d)\n", hipGetErrorString(e), grid_blocks);
}
#endif
```

```cpp
#ifndef HOST_SIM
#include <hip/hip_runtime.h>
#include <hip/hip_cooperative_groups.h>
#include <cstdio>
#include <cstring>
#define HD __host__ __device__ __forceinline__
#else
#include <cmath>
#include <cstdio>
#include <cstdlib>
#include <cstring>
#define HD inline
typedef void* hipStream_t;
#endif
#include <cstdint>
#include <cstddef>

#ifndef BATCH
#define BATCH 8
#endif
constexpr int B = BATCH, S = 2048, D = 1024, LC = 256, GRID_W = 64;
constexpr int TL = B * S, TC = B * LC, T = TL + TC;
constexpr int DIN = 3088, O1 = 768, O2 = 1280, O3 = 2048;
constexpr int WINDOW = 128, NA_KR = 8, NA_KC = 16;
constexpr float EPS = 1e-6f, ROPE_BASE = 10000.0f, ROUTED_SCALE = 2.5f;
constexpr float HY_DECAY_MIN = 3.0701134573253946f;
constexpr float HY_DECAY_MAX = 15.350567286626973f;
typedef unsigned short bf16;

HD float bf2f(bf16 h) { union { unsigned u; float f; } v; v.u = (unsigned)h << 16; return v.f; }
HD bf16 f2bf(float f) { union { float f; unsigned u; } v; v.f = f; unsigned u = v.u; u += 0x7fffu + ((u >> 16) & 1u); return (bf16)(u >> 16); }
HD float siluf(float x) { return x / (1.0f + expf(-x)); }

struct NkCopyX {
    const float* x; const float* ctx; float* xr;
    HD void operator()(long i) const { xr[i] = i < (long)TL * D ? x[i] : ctx[i - (long)TL * D]; }
    static HD long count() { return (long)T * D; }
};

struct NkAda {
    const float* c; const float* cctx; const float* w_ada; const float* b_ada; float* mod;
    HD void operator()(long i) const {
        int n = (int)(i % 6144); int r = (int)((i / 6144) % 9); int l = (int)(i / (6144 * 9));
        const float* cv = r < 8 ? c + (long)(r % B) * D : cctx;
        const float* w = w_ada + (long)l * D * 6144 + n;
        float acc = 0.f;
        for (int k = 0; k < D; ++k) { float v = cv[k]; acc += siluf(v) * w[(long)k * 6144]; }
        mod[i] = acc + b_ada[l * 6144 + n];
    }
    static HD long count() { return 2L * 9 * 6144; }
};

struct NkRstd {
    const float* xr; float* rstd; int nrows;
    HD void operator()(long t) const {
        const float* r = xr + t * D; float s = 0.f;
        for (int k = 0; k < D; ++k) s += r[k] * r[k];
        rstd[t] = 1.0f / sqrtf(s * (1.0f / D) + EPS);
    }
};

struct NkModNorm {
    const float* xr; const float* rstd; const float* g; const float* mod;   int sh_chunk, sc_chunk; bf16* h;
    HD void operator()(long i) const {
        long t = i / D; int k = (int)(i % D); int r = t < TL ? (int)(t / S) : 8;
        const float* m = mod + (long)r * 6144;
        float v = xr[i] * rstd[t] * g[k];
        h[i] = f2bf(v * (1.0f + m[sc_chunk * D + k]) + m[sh_chunk * D + k]);
    }
};

struct NkInProj {
    const bf16* h; const float* w; bf16* p;
    HD void operator()(long i) const {
        long t = i / DIN; int n = (int)(i % DIN);
        const bf16* hr = h + t * D; float acc = 0.f;
        for (int k = 0; k < D; ++k) acc += bf2f(hr[k]) * w[(long)k * DIN + n];
        p[i] = f2bf(acc);
    }
    static HD long count() { return (long)T * DIN; }
};

struct NkRope {
    bf16* p;
    HD void operator()(long i) const {
        int pr = (int)(i % 32); int hd = (int)((i / 32) % 6); long t = i / (32 * 6);
        int s = (int)(t % S); int row = s / GRID_W, col = s % GRID_W;
        int axis = pr >> 4, j = pr & 15;
        float pos = axis == 0 ? (float)row : (float)col;
        float inv = powf(ROPE_BASE, -(float)j / 16.0f);
        float ang = pos * inv; float cs = cosf(ang), sn = sinf(ang);
        bf16* q = p + t * DIN + O1 + hd * 64 + axis * 32;
        float x1 = bf2f(q[j]), x2 = bf2f(q[j + 16]);
        q[j] = f2bf(x1 * cs - x2 * sn); q[j + 16] = f2bf(x1 * sn + x2 * cs);
    }
    static HD long count() { return (long)TL * 6 * 32; }
};

struct NkHyF1 {
    const float* w1; const float* b1; const float* freq; float* f1;
    HD void operator()(long i) const {
        int j = (int)(i % 64); int tt = (int)(i / 64); int L = tt < S ? S : LC; int t = tt < S ? tt : tt - S;
        float tn = (float)t / (float)(L - 1);
        float acc = tn * w1[j];
        for (int bnd = 0; bnd < 16; ++bnd) {
            float band = 1e-4f + (float)bnd * ((15.0f - 1e-4f) / 15.0f);
            float ang = (6.283185307179586f / (float)L) * (float)t * band;
            acc += cosf(ang) * w1[(1 + bnd) * 64 + j] - sinf(ang) * w1[(17 + bnd) * 64 + j];
        }
        f1[i] = sinf(freq[j] * (acc + b1[j]));
    }
    static HD long count() { return (long)(S + LC) * 64; }
};
struct NkHyF2 {
    const float* w2; const float* b2; const float* freq; const float* f1; float* f2;
    HD void operator()(long i) const {
        int j = (int)(i % 64); long tt = i / 64; float acc = 0.f;
        for (int k = 0; k < 64; ++k) acc += f1[tt * 64 + k] * w2[k * 64 + j];
        f2[i] = sinf(freq[j] * (acc + b2[j]));
    }
    static HD long count() { return (long)(S + LC) * 64; }
};
struct NkHyF3 {
    const float* w3; const float* f2; float* filt;
    HD void operator()(long i) const {
        int tt = (int)(i % (S + LC)); int c = (int)(i / (S + LC)); int L = tt < S ? S : LC; int t = tt < S ? tt : tt - S;
        float tn = (float)t / (float)(L - 1);
        float acc = 0.f;
        for (int k = 0; k < 64; ++k) acc += f2[(long)tt * 64 + k] * w3[k * 512 + c];
        int cc = c & 255;
        float decay = HY_DECAY_MIN + (float)cc * ((HY_DECAY_MAX - HY_DECAY_MIN) / 255.0f);
        filt[(long)c * (S + LC) + tt] = acc * expf(-tn * decay);
    }
    static HD long count() { return (long)(S + LC) * 512; }
};
HD float hy_conv3(const bf16* p, long t, int tin, int L, int col, const float* cw) {
    float acc = cw[768 + col] * bf2f(p[t * DIN + col]);
    if (tin > 0) acc += cw[col] * bf2f(p[(t - 1) * DIN + col]);
    if (tin < L - 1) acc += cw[2 * 768 + col] * bf2f(p[(t + 1) * DIN + col]);
    return acc;
}
struct NkHyUV {
    const bf16* p; const float* cw; bf16* uv; long tbase; long ntok; int L;
    HD void operator()(long i) const {
        int c = (int)(i % 256); long t = tbase + i / 256; int tin = (int)((t - tbase) % L);
        float x1 = hy_conv3(p, t, tin, L, 256 + c, cw), v = hy_conv3(p, t, tin, L, 512 + c, cw);
        uv[t * 256 + c] = f2bf(x1 * v);
    }
};
struct NkHyConv {
    const bf16* p; const float* cw; const bf16* uv; const float* filt; const float* hbias; bf16* ycat; long tbase; int L; int foff;
    HD void operator()(long i) const {
        int tin = (int)(i % L); int c = (int)((i / L) % 256); long seq = i / ((long)L * 256); long t0 = tbase + seq * L; long t = t0 + tin;
        const float* f = filt + foff;
        float acc = 0.f;
        for (int s = 0; s < L; ++s) {
            int d = tin - s; float k = d >= 0 ? f[(long)c * (S + LC) + d] : f[(long)(256 + c) * (S + LC) - d];
            acc += k * bf2f(uv[(t0 + s) * 256 + c]);
        }
        acc += hbias[c] * bf2f(uv[t * 256 + c]);
        float x0 = hy_conv3(p, t, tin, L, c, cw);
        ycat[t * 1024 + c] = f2bf(x0 * acc);
    }
};

HD void attn_key(const float (&q)[64], const bf16* kr, const bf16* vr, float bias, float& m, float& l, float (&acc)[64]) {
    float sc = 0.f;
#pragma unroll
    for (int d = 0; d < 64; ++d) sc += q[d] * bf2f(kr[d]);
    sc = sc * 0.125f + bias;
    float mn = fmaxf(m, sc); float ca = expf(m - mn), cb = expf(sc - mn);
    l = l * ca + cb; m = mn;
#pragma unroll
    for (int d = 0; d < 64; ++d) acc[d] = acc[d] * ca + cb * bf2f(vr[d]);
}
struct NkWA {
    const bf16* p; const float* sink; bf16* ycat;
    HD void operator()(long i) const {
        int hq = (int)(i % 4); long t = i / 4; int b = (int)(t / S), s = (int)(t % S); int hk = hq >> 1;
        const bf16* qp = p + t * DIN + O1 + hq * 64;
        float q[64], acc[64];
#pragma unroll
        for (int d = 0; d < 64; ++d) { q[d] = bf2f(qp[d]); acc[d] = 0.f; }
        float m = sink[hq], l = 1.0f;
        for (int j = 0; j < LC; ++j) {
            const bf16* kr = p + ((long)TL + (long)b * LC + j) * DIN + O1 + 256 + hk * 64;
            attn_key(q, kr, kr + 128, 0.f, m, l, acc);
        }
        int j0 = s - WINDOW < 0 ? 0 : s - WINDOW, j1 = s + WINDOW > S - 1 ? S - 1 : s + WINDOW;
        for (int j = j0; j <= j1; ++j) {
            const bf16* kr = p + ((long)b * S + j) * DIN + O1 + 256 + hk * 64;
            attn_key(q, kr, kr + 128, 0.f, m, l, acc);
        }
        float il = 1.0f / l;
#pragma unroll
        for (int d = 0; d < 64; ++d) ycat[t * 1024 + 256 + hq * 64 + d] = f2bf(acc[d] * il);
    }
    static HD long count() { return (long)TL * 4; }
};
struct NkWACtx {
    const bf16* p; const float* sink; bf16* ycat;
    HD void operator()(long i) const {
        int hq = (int)(i % 4); long tc = i / 4; int b = (int)(tc / LC); int hk = hq >> 1; long t = TL + tc;
        const bf16* qp = p + t * DIN + O1 + hq * 64;
        float q[64], acc[64];
#pragma unroll
        for (int d = 0; d < 64; ++d) { q[d] = bf2f(qp[d]); acc[d] = 0.f; }
        float m = sink[hq], l = 1.0f;
        for (int j = 0; j < LC; ++j) {
            const bf16* kr = p + ((long)TL + (long)b * LC + j) * DIN + O1 + 256 + hk * 64;
            attn_key(q, kr, kr + 128, 0.f, m, l, acc);
        }
        float il = 1.0f / l;
#pragma unroll
        for (int d = 0; d < 64; ++d) ycat[t * 1024 + 256 + hq * 64 + d] = f2bf(acc[d] * il);
    }
    static HD long count() { return (long)TC * 4; }
};
struct NkNA {
    const bf16* p; const float* rpb; bf16* ycat;
    HD void operator()(long i) const {
        int h = (int)(i % 4); long t = i / 4; int b = (int)(t / S), s = (int)(t % S);
        int r = s / GRID_W, cq = s % GRID_W;
        const bf16* qp = p + t * DIN + O2 + h * 64;
        float q[64], acc[64];
#pragma unroll
        for (int d = 0; d < 64; ++d) { q[d] = bf2f(qp[d]); acc[d] = 0.f; }
        float m = -1e30f, l = 0.f;
        for (int j = 0; j < LC; ++j) {
            const bf16* kr = p + ((long)TL + (long)b * LC + j) * DIN + O2 + 256 + h * 64;
            attn_key(q, kr, kr + 256, 0.f, m, l, acc);
        }
        int r0 = r - NA_KR / 2; r0 = r0 < 0 ? 0 : (r0 > S / GRID_W - NA_KR ? S / GRID_W - NA_KR : r0);
        int c0 = cq - NA_KC / 2; c0 = c0 < 0 ? 0 : (c0 > GRID_W - NA_KC ? GRID_W - NA_KC : c0);
        for (int kk = 0; kk < NA_KR * NA_KC; ++kk) {
            int kr_ = r0 + kk / NA_KC, kc_ = c0 + kk % NA_KC;
            const bf16* kr = p + ((long)b * S + kr_ * GRID_W + kc_) * DIN + O2 + 256 + h * 64;
            attn_key(q, kr, kr + 256, rpb[(h * 15 + (kr_ - r + 7)) * 31 + (kc_ - cq + 15)], m, l, acc);
        }
        float il = 1.0f / l;
#pragma unroll
        for (int d = 0; d < 64; ++d) ycat[t * 1024 + 512 + h * 64 + d] = f2bf(acc[d] * il);
    }
    static HD long count() { return (long)TL * 4; }
};
struct NkNACtx {
    const bf16* p; bf16* ycat;
    HD void operator()(long i) const {
        int h = (int)(i % 4); long tc = i / 4; int b = (int)(tc / LC); long t = TL + tc;
        const bf16* qp = p + t * DIN + O2 + h * 64;
        float q[64], acc[64];
#pragma unroll
        for (int d = 0; d < 64; ++d) { q[d] = bf2f(qp[d]); acc[d] = 0.f; }
        float m = -1e30f, l = 0.f;
        for (int j = 0; j < LC; ++j) {
            const bf16* kr = p + ((long)TL + (long)b * LC + j) * DIN + O2 + 256 + h * 64;
            attn_key(q, kr, kr + 256, 0.f, m, l, acc);
        }
        float il = 1.0f / l;
#pragma unroll
        for (int d = 0; d < 64; ++d) ycat[t * 1024 + 512 + h * 64 + d] = f2bf(acc[d] * il);
    }
    static HD long count() { return (long)TC * 4; }
};

HD float gdn_conv4(const bf16* p, long t, int tin, int L, int col, const float* cw) {
    float acc = 0.f;
    for (int i = 0; i < 4; ++i) { int o = i - 2; if (tin + o >= 0 && tin + o < L) acc += cw[i * 768 + col] * bf2f(p[(t + o) * DIN + O3 + col]); }
    return siluf(acc);
}
struct NkGdnPrep {
    const bf16* p; const float* cw; bf16* qkv;
    HD void operator()(long i) const {
        int e = (int)(i % 64); int wh = (int)((i / 64) % 12); long t = i / 768; int which = wh / 4;
        int L = t < TL ? S : LC; int tin = t < TL ? (int)(t % S) : (int)((t - TL) % LC);
        int col0 = wh * 64;
        float v = gdn_conv4(p, t, tin, L, col0 + e, cw);
        if (which < 2) {
            float ss = 0.f; for (int d = 0; d < 64; ++d) { float u = gdn_conv4(p, t, tin, L, col0 + d, cw); ss += u * u; }
            v *= 1.0f / sqrtf(ss + EPS); if (which == 0) v *= 0.125f;
        }
        qkv[t * 768 + col0 + e] = f2bf(v);
    }
    static HD long count() { return (long)T * 768; }
};
struct NkGdnGate {
    const bf16* p; const float* a_log; const float* dt_bias; float* gb;
    HD void operator()(long i) const {
        int dh = (int)(i % 8); long t = i / 8;
        float a = bf2f(p[t * DIN + O3 + 1024 + dh]), bb = bf2f(p[t * DIN + O3 + 1032 + dh]);
        float x = a + dt_bias[dh]; float sp = x > 20.f ? x : log1pf(expf(x));
        gb[t * 16 + dh] = -expf(a_log[dh]) * sp; gb[t * 16 + 8 + dh] = 1.0f / (1.0f + expf(-bb));
    }
    static HD long count() { return (long)T * 8; }
};
struct NkGdnRec {
    const bf16* qkv; const float* gb; bf16* o;
    HD void operator()(long i) const {
        int e = (int)(i % 64); int dir = (int)((i / 64) % 2); int h = (int)((i / 128) % 4); int b = (int)(i / 512);
        float Sc[64];
#pragma unroll
        for (int d = 0; d < 64; ++d) Sc[d] = 0.f;
        for (int step = 0; step < LC + S; ++step) {
            long t;
            if (step < LC) { int j = dir ? LC - 1 - step : step; t = (long)TL + (long)b * LC + j; }
            else { int s = step - LC; s = dir ? S - 1 - s : s; t = (long)b * S + s; }
            const bf16* qr = qkv + t * 768 + h * 64; const bf16* kr = qr + 256; float v = bf2f(qr[512 + e]);
            float a = expf(gb[t * 16 + dir * 4 + h]), beta = gb[t * 16 + 8 + dir * 4 + h];
            float kS = 0.f;
#pragma unroll
            for (int c = 0; c < 4; ++c) {
#pragma unroll
                for (int d = c * 16; d < c * 16 + 16; ++d) kS += bf2f(kr[d]) * Sc[d];
                asm volatile("" ::: "memory");
            }
            float w = beta * (v - a * kS); float oo = 0.f;
#pragma unroll
            for (int c = 0; c < 4; ++c) {
#pragma unroll
                for (int d = c * 16; d < c * 16 + 16; ++d) { Sc[d] = a * Sc[d] + bf2f(kr[d]) * w; oo += bf2f(qr[d]) * Sc[d]; }
                asm volatile("" ::: "memory");
            }
            o[((long)dir * T + t) * 256 + h * 64 + e] = f2bf(oo);
        }
    }
    static HD long count() { return (long)B * 4 * 2 * 64; }
};
struct NkGdnFin {
    const bf16* p; const bf16* o; const float* ng; bf16* ycat;
    HD void operator()(long i) const {
        int e = (int)(i % 64); int h = (int)((i / 64) % 4); long t = i / 256;
        const bf16* o0 = o + t * 256 + h * 64; const bf16* o1 = o + ((long)T + t) * 256 + h * 64;
        float ss = 0.f; for (int d = 0; d < 64; ++d) { float u = bf2f(o0[d]) + bf2f(o1[d]); ss += u * u; }
        float v = (bf2f(o0[e]) + bf2f(o1[e])) * (1.0f / sqrtf(ss * (1.0f / 64.0f) + EPS)) * ng[e];
        float gt = bf2f(p[t * DIN + O3 + 768 + h * 64 + e]);
        ycat[t * 1024 + 768 + h * 64 + e] = f2bf(v * siluf(gt));
    }
    static HD long count() { return (long)T * 256; }
};

struct NkOutProj {
    const bf16* ycat; const float* w; const float* mod; float* xr; long ntok;
    HD void operator()(long i) const {
        long t = i / D; int n = (int)(i % D); int r = t < TL ? (int)(t / S) : 8;
        const bf16* yr = ycat + t * 1024; float acc = 0.f;
        for (int k = 0; k < 1024; ++k) acc += bf2f(yr[k]) * w[(long)k * D + n];
        xr[i] += mod[(long)r * 6144 + 2 * D + n] * acc;
    }
};

struct NkRouter {
    const bf16* h; const float* wr; float* scores;
    HD void operator()(long i) const {
        int e = (int)(i % 32); long t = i / 32; float acc = 0.f;
        for (int k = 0; k < D; ++k) acc += bf2f(h[t * D + k]) * wr[k * 32 + e];
        scores[i] = 1.0f / (1.0f + expf(-acc));
    }
};
struct NkTopK {
    const float* scores; const float* ebias; int* topi; float* topw;
    HD void operator()(long t) const {
        int sel[4]; float ss[4]; float sum = 0.f;
#pragma unroll
        for (int k = 0; k < 4; ++k) {
            int best = -1; float bv = -1e30f;
            for (int e = 0; e < 32; ++e) {
                bool used = false;
#pragma unroll
                for (int q = 0; q < 4; ++q) if (q < k && sel[q] == e) used = true;
                float v = scores[t * 32 + e] + ebias[e];
                if (!used && v > bv) { bv = v; best = e; }
            }
            sel[k] = best; ss[k] = scores[t * 32 + best]; sum += ss[k];
        }
#pragma unroll
        for (int k = 0; k < 4; ++k) { topi[t * 4 + k] = sel[k]; topw[t * 4 + k] = ss[k] / sum * ROUTED_SCALE; }
    }
};
struct NkMoeHid {
    const bf16* h; const int* topi; const float* wg; const float* wu; const float* sg; const float* su; bf16* hid;
    HD void operator()(long i) const {
        int j = (int)(i % 256); int slot = (int)((i / 256) % 5); long t = i / 1280;
        const float* g; const float* u;
        if (slot < 4) { int e = topi[t * 4 + slot]; g = wg + (long)e * D * 256; u = wu + (long)e * D * 256; } else { g = sg; u = su; }
        float ag = 0.f, au = 0.f;
        for (int k = 0; k < D; ++k) { float x = bf2f(h[t * D + k]); ag += x * g[(long)k * 256 + j]; au += x * u[(long)k * 256 + j]; }
        hid[i] = f2bf(siluf(ag) * au);
    }
};
struct NkMoeOut {
    const bf16* hid; const int* topi; const float* topw; const float* wd; const float* sd; const float* mod; float* xr;
    HD void operator()(long i) const {
        long t = i / D; int n = (int)(i % D); int r = t < TL ? (int)(t / S) : 8;
        float f = 0.f;
        for (int slot = 0; slot < 5; ++slot) {
            const float* w; float wt;
            if (slot < 4) { w = wd + (long)topi[t * 4 + slot] * 256 * D; wt = topw[t * 4 + slot]; } else { w = sd; wt = 1.0f; }
            float acc = 0.f;
            for (int j = 0; j < 256; ++j) acc += bf2f(hid[(t * 5 + slot) * 256 + j]) * w[(long)j * D + n];
            f += wt * acc;
        }
        xr[i] += mod[(long)r * 6144 + 5 * D + n] * f;
    }
};
struct NkFinal {
    const float* xr; const float* rstd; const float* g; float* out;
    HD void operator()(long i) const { long t = i / D; int k = (int)(i % D); out[i] = xr[i] * rstd[t] * g[k]; }
    static HD long count() { return (long)TL * D; }
};

struct NkCvtT {
    const float* src; bf16* dst; int K, N, Npad;
    HD void operator()(long i) const {
        int n = (int)(i % Npad); int k0 = (int)(i / Npad) * 8;
        bf16 v[8];
#pragma unroll
        for (int j = 0; j < 8; ++j) v[j] = n < N ? f2bf(src[(long)(k0 + j) * N + n]) : (bf16)0;
        bf16* d = dst + (long)n * K + k0;
#pragma unroll
        for (int j = 0; j < 8; ++j) d[j] = v[j];
    }
    HD long count() const { return (long)Npad * (K / 8); }
};
struct NkRopeTab {
    float* rope;
    HD void operator()(long i) const {
        int j = (int)(i % 16); int pos = (int)(i / 16);
        float ang = (float)pos * powf(ROPE_BASE, -(float)j / 16.0f);
        rope[i * 2] = cosf(ang); rope[i * 2 + 1] = sinf(ang);
    }
    static HD long count() { return 64 * 16; }
};

struct NkCvtUp {
    const float* wg; const float* wu; const float* sg; const float* su; bf16* dst;
    HD void operator()(long i) const {
        int j = (int)(i % 256); int k0 = (int)((i / 256) % 128) * 8; int which = (int)((i / (256 * 128)) % 2); int e = (int)(i / (256 * 128 * 2));
        const float* src = e < 32 ? (which ? wu : wg) + (long)e * D * 256 : (which ? su : sg);
        int np = (j >> 6) * 128 + ((j >> 5) & 1) * 64 + which * 32 + (j & 31);
        bf16* d = dst + ((long)e * 512 + np) * 1024 + k0;
#pragma unroll
        for (int q = 0; q < 8; ++q) d[q] = f2bf(src[(long)(k0 + q) * 256 + j]);
    }
    static HD long count() { return 33L * 2 * 128 * 256; }
};
struct NkCvtDown {
    const float* wd; const float* sd; bf16* dst;
    HD void operator()(long i) const {
        int n = (int)(i % 1024); int j0 = (int)((i / 1024) % 32) * 8; int e = (int)(i / (1024 * 32));
        const float* src = e < 32 ? wd + (long)e * 256 * D : sd;
        bf16* d = dst + ((long)e * 1024 + n) * 256 + j0;
#pragma unroll
        for (int q = 0; q < 8; ++q) d[q] = f2bf(src[(long)(j0 + q) * D + n]);
    }
    static HD long count() { return 33L * 32 * 1024; }
};
struct NkZeroI { int* p; HD void operator()(long i) const { p[i] = 0; } };
struct WS {
    float* mod; float* rstd; float* xr; bf16* h; bf16* p; bf16* ycat; float* hyf1; float* hyf2; float* filt; bf16* uv;
    bf16* qkv; float* gb; bf16* o; float* scores; int* topi; float* topw; bf16* hid;
    bf16* winT; bf16* woutT; bf16* wrT; float* rope; unsigned* bar; int* cnt; int* list;
    bf16* moeUpT; bf16* hid2; bf16* moeDownT;
    bf16* qk; bf16* uw; float* gc; bf16* x0T; bf16* uvT; int* qctr;
};
static inline WS make_ws(void* d_ws) {
    char* base = (char*)d_ws; size_t off = 0;
    auto take = [&](size_t bytes) { char* r = base + off; off += (bytes + 255) & ~(size_t)255; return r; };
    WS w;
    w.mod = (float*)take(2ul * 9 * 6144 * 4);
    w.rstd = (float*)take((size_t)T * 4);
    w.hyf1 = (float*)take(2 * (size_t)(S + LC) * 64 * 4);
    w.hyf2 = (float*)take(2 * (size_t)(S + LC) * 64 * 4);
    w.filt = (float*)take(2 * (size_t)(S + LC) * 512 * 4);
    w.gb = (float*)take((size_t)T * 16 * 4);
#ifdef HOST_SIM
    w.scores = (float*)take((size_t)T * 32 * 4); w.topi = (int*)take((size_t)T * 4 * 4);
#else
    w.scores = nullptr; w.topi = nullptr;
#endif
    w.topw = (float*)take((size_t)T * 4 * 4);
    w.winT = (bf16*)take(2ul * 3200 * 1024 * 2);
    w.woutT = (bf16*)take(2ul * 1024 * 1024 * 2);
    w.wrT = (bf16*)take(2ul * 32 * 1024 * 2);
    w.rope = (float*)take(64 * 16 * 2 * 4);
    w.bar = (unsigned*)take(4096 * 4);
    w.cnt = (int*)take(4 * 32 * 32 * 4);
    w.list = (int*)take((size_t)32 * T * 4);
    w.qctr = (int*)take(64 * 64 * 4);
    w.xr = (float*)take((size_t)T * D * 4);
    w.h = (bf16*)take((size_t)T * D * 2);
    w.p = (bf16*)take((size_t)T * DIN * 2);
    w.hid = (bf16*)w.p;
    char* R = take(0);
    const size_t szUp = 33ul * 512 * 1024 * 2, szHid = ((size_t)5 * T + 256) * 256 * 2, szDown = 33ul * 1024 * 256 * 2;
    w.moeUpT = (bf16*)R; w.hid2 = (bf16*)(R + szUp); w.moeDownT = (bf16*)(R + szUp + szHid);
    w.qkv = (bf16*)R;
    w.qk = (bf16*)R;
    w.ycat = w.hid2;
    w.o = (bf16*)((char*)w.ycat + (size_t)T * 1024 * 2);
    w.x0T = (bf16*)((char*)w.ycat + (size_t)T * 1024 * 2);
    w.uvT = w.x0T + (size_t)256 * B * S;
    w.uv = w.uvT + (size_t)256 * B * S;
    w.uw = w.h; w.gc = w.gb;
    size_t rsz = szUp + szHid + szDown; const size_t rsz2 = szUp + (size_t)T * 1024 * 2 + (size_t)2 * 256 * B * S * 2 + (size_t)T * 256 * 2;
    if (rsz2 > rsz) rsz = rsz2;
    (void)take(rsz);
    return w;
}
#ifdef HOST_SIM
template <class F> static inline void run(F f, long n, hipStream_t) {
#pragma omp parallel for schedule(dynamic, 256)
    for (long i = 0; i < n; ++i) f(i);
}
#endif

struct Inputs {
    const float *x, *c, *ctx, *c_ctx, *w_ada, *b_ada, *norm1, *norm2, *norm_f, *w_in, *w_out, *hy_conv, *hy_w1, *hy_b1, *hy_w2, *hy_b2, *hy_w3, *hy_freq, *hy_bias,
        *wa_sink, *na_rpb, *gdn_conv, *gdn_a_log, *gdn_dt_bias, *gdn_norm, *moe_router, *moe_bias, *moe_gate, *moe_up, *moe_down, *sh_gate, *sh_up, *sh_down;
};

#ifdef HOST_SIM
static void forward_naive(const Inputs& in, float* out, const WS& w, hipStream_t st) {
    run(NkCopyX{in.x, in.ctx, w.xr}, NkCopyX::count(), st);
    run(NkAda{in.c, in.c_ctx, in.w_ada, in.b_ada, w.mod}, NkAda::count(), st);
    for (int l = 0; l < 2; ++l) {
        const bool need_ctx = l == 0;
        const float* mod = w.mod + (size_t)l * 9 * 6144;
        run(NkRstd{w.xr, w.rstd, T}, T, st);
        run(NkModNorm{w.xr, w.rstd, in.norm1 + l * D, mod, 0, 1, w.h}, (long)T * D, st);
        run(NkInProj{w.h, in.w_in + (size_t)l * D * DIN, w.p}, NkInProj::count(), st);
        run(NkRope{w.p}, NkRope::count(), st);
        run(NkHyF1{in.hy_w1 + l * 33 * 64, in.hy_b1 + l * 64, in.hy_freq + l * 64, w.hyf1}, NkHyF1::count(), st);
        run(NkHyF2{in.hy_w2 + l * 64 * 64, in.hy_b2 + l * 64, in.hy_freq + l * 64, w.hyf1, w.hyf2}, NkHyF2::count(), st);
        run(NkHyF3{in.hy_w3 + l * 64 * 512, w.hyf2, w.filt}, NkHyF3::count(), st);
        const float* hcw = in.hy_conv + l * 3 * 768;
        run(NkHyUV{w.p, hcw, w.uv, 0, TL, S}, (long)TL * 256, st);
        run(NkHyConv{w.p, hcw, w.uv, w.filt, in.hy_bias + l * 256, w.ycat, 0, S, 0}, (long)TL * 256, st);
        if (need_ctx) {
            run(NkHyUV{w.p, hcw, w.uv, TL, TC, LC}, (long)TC * 256, st);
            run(NkHyConv{w.p, hcw, w.uv, w.filt, in.hy_bias + l * 256, w.ycat, TL, LC, S}, (long)TC * 256, st);
        }
        run(NkWA{w.p, in.wa_sink + l * 4, w.ycat}, NkWA::count(), st);
        if (need_ctx) run(NkWACtx{w.p, in.wa_sink + l * 4, w.ycat}, NkWACtx::count(), st);
        run(NkNA{w.p, in.na_rpb + l * 4 * 15 * 31, w.ycat}, NkNA::count(), st);
        if (need_ctx) run(NkNACtx{w.p, w.ycat}, NkNACtx::count(), st);
        run(NkGdnPrep{w.p, in.gdn_conv + l * 4 * 768, w.qkv}, NkGdnPrep::count(), st);
        run(NkGdnGate{w.p, in.gdn_a_log + l * 8, in.gdn_dt_bias + l * 8, w.gb}, NkGdnGate::count(), st);
        run(NkGdnRec{w.qkv, w.gb, w.o}, NkGdnRec::count(), st);
        run(NkGdnFin{w.p, w.o, in.gdn_norm + l * 64, w.ycat}, need_ctx ? (long)T * 256 : (long)TL * 256, st);
        const long ntok = need_ctx ? T : TL;
        run(NkOutProj{w.ycat, in.w_out + (size_t)l * 1024 * D, mod, w.xr, ntok}, ntok * D, st);
        run(NkRstd{w.xr, w.rstd, (int)ntok}, ntok, st);
        run(NkModNorm{w.xr, w.rstd, in.norm2 + l * D, mod, 3, 4, w.h}, ntok * D, st);
        run(NkRouter{w.h, in.moe_router + l * D * 32, w.scores}, ntok * 32, st);
        run(NkTopK{w.scores, in.moe_bias + l * 32, w.topi, w.topw}, ntok, st);
        run(NkMoeHid{w.h, w.topi, in.moe_gate + (size_t)l * 32 * D * 256, in.moe_up + (size_t)l * 32 * D * 256, in.sh_gate + (size_t)l * D * 256, in.sh_up + (size_t)l * D * 256, w.hid}, ntok * 1280, st);
        run(NkMoeOut{w.hid, w.topi, w.topw, in.moe_down + (size_t)l * 32 * 256 * D, in.sh_down + (size_t)l * 256 * D, mod, w.xr}, ntok * D, st);
    }
    run(NkRstd{w.xr, w.rstd, TL}, TL, st);
    run(NkFinal{w.xr, w.rstd, in.norm_f, out}, NkFinal::count(), st);
}


#endif
#ifdef HOST_SIM
extern "C" void kernel_launch(void* const* d_in, const int* in_sizes, int n_in, void* d_out, int out_size, void* d_ws, size_t ws_size, hipStream_t stream) {
    Inputs in;
    const float** ip = (const float**)&in;
    for (int i = 0; i < 33; ++i) ip[i] = (const float*)d_in[i];
    WS w = make_ws(d_ws);
    forward_naive(in, (float*)d_out, w, stream);
}

#endif
#ifndef HOST_SIM
#define XB_TMO      128
#define XB_XCNT(j)  (256  + 64 * (j))
#define XB_XSUB(j)  (1280 + 64 * (j))
#define XB_XGEN(j)  (2304 + 64 * (j))
#define XB_TOP      3328
#define XB_TOPGEN   3392
#define XCD_BAR_WORDS 3456
#define XB_SPIN_CAP (1u << 26)
#define LAS __attribute__((address_space(3)))
__device__ __forceinline__ unsigned xb_ld(unsigned* p)              { return __hip_atomic_load(p, __ATOMIC_RELAXED, __HIP_MEMORY_SCOPE_AGENT); }
__device__ __forceinline__ unsigned xb_add(unsigned* p, unsigned v) { return __hip_atomic_fetch_add(p, v, __ATOMIC_RELAXED, __HIP_MEMORY_SCOPE_AGENT); }
__device__ __forceinline__ unsigned xb_xcc_id() { return (unsigned)__builtin_amdgcn_s_getreg((3 << 11) | 20) & 0xFu; }
#define XB_SPIN(cond, bar) do { unsigned _sp = 0; while (cond) { __builtin_amdgcn_s_sleep(1); \
    if ((++_sp & 255u) == 0u) { if (xb_ld(&(bar)[XB_TMO])) break; if (_sp > XB_SPIN_CAP) { atomicAdd(&(bar)[XB_TMO], 1u); break; } } } } while (0)
struct XcdBarrier { unsigned* bar; unsigned x; volatile LAS unsigned* st; };
__device__ __forceinline__ XcdBarrier xcd_barrier_post(unsigned* bar, volatile LAS unsigned* st) {
    XcdBarrier b; b.bar = bar; b.x = xb_xcc_id(); b.st = st;
    if (threadIdx.x == 0) (void)xb_add(&bar[XB_XCNT(b.x)], 1u);
    return b;
}
__device__ __forceinline__ void xcd_barrier_complete(unsigned* bar, unsigned x, unsigned& nloc, unsigned& nx) {
    const unsigned G = gridDim.x * gridDim.y * gridDim.z;
    unsigned sum, cnt, mine, sp = 0u;
    for (;;) {
        sum = 0u; cnt = 0u; mine = 0u;
#pragma unroll
        for (unsigned j = 0; j < 16; ++j) { const unsigned c = xb_ld(&bar[XB_XCNT(j)]); sum += c; cnt += (c > 0u) ? 1u : 0u; mine = (j == x) ? c : mine; }
        if (sum == G) break;
        __builtin_amdgcn_s_sleep(1);
        if ((++sp & 255u) == 0u) { if (xb_ld(&bar[XB_TMO])) break; if (sp > XB_SPIN_CAP) { atomicAdd(&bar[XB_TMO], 1u); break; } }
    }
    nloc = mine > 0u ? mine : 1u; nx = cnt > 0u ? cnt : 1u;
}
__device__ __forceinline__ void xcd_barrier(const XcdBarrier& b) {
    asm volatile("s_waitcnt vmcnt(0)" ::: "memory");
    __syncthreads();
    if (threadIdx.x == 0) {
        unsigned* bar = b.bar;
        __builtin_amdgcn_s_waitcnt(0);
        unsigned nloc = b.st[0], nx = b.st[1];
        if (nloc == 0u) { xcd_barrier_complete(bar, b.x, nloc, nx); b.st[0] = nloc; b.st[1] = nx; }
        const unsigned old = xb_add(&bar[XB_XSUB(b.x)], 1u);
        const unsigned gen = old / nloc;
        if (old + 1u == (gen + 1u) * nloc) {
            __builtin_amdgcn_fence(__ATOMIC_RELEASE, "agent");
            asm volatile("s_waitcnt vmcnt(0)" ::: "memory");
            const unsigned og = xb_add(&bar[XB_TOP], 1u);
            const unsigned tg = og / nx;
            if (og + 1u == (tg + 1u) * nx) xb_add(&bar[XB_TOPGEN], 1u);
            else XB_SPIN(xb_ld(&bar[XB_TOPGEN]) == tg, bar);
            __builtin_amdgcn_fence(__ATOMIC_ACQUIRE, "agent");
            xb_add(&bar[XB_XGEN(b.x)], 1u);
            asm volatile("s_waitcnt vmcnt(0)" ::: "memory");
        } else {
            XB_SPIN(xb_ld(&bar[XB_XGEN(b.x)]) == gen, bar);
            __builtin_amdgcn_fence(__ATOMIC_ACQUIRE, "agent");
            asm volatile("s_waitcnt vmcnt(0)" ::: "memory");
        }
    }
    __syncthreads();
}
#endif
#ifndef HOST_SIM
typedef short bf16x8 __attribute__((ext_vector_type(8)));
typedef float f32x16 __attribute__((ext_vector_type(16)));
typedef float f32x4 __attribute__((ext_vector_type(4)));
typedef unsigned u32x4 __attribute__((ext_vector_type(4)));
typedef unsigned u32x2 __attribute__((ext_vector_type(2)));
#define NTHREADS 512

__device__ __forceinline__ void st_wt8(void* p, u32x2 v) { __hip_atomic_store((unsigned long long*)p, ((unsigned long long)v.y << 32) | v.x, __ATOMIC_RELAXED, __HIP_MEMORY_SCOPE_AGENT); }
typedef __bf16 bf16x2n __attribute__((ext_vector_type(2)));
typedef float f32x2n __attribute__((ext_vector_type(2)));
__device__ __forceinline__ unsigned pack_bf16(float lo, float hi) { f32x2n f = {lo, hi}; bf16x2n r = __builtin_convertvector(f, bf16x2n); return __builtin_bit_cast(unsigned, r); }

constexpr int GBM = 256, GBN = 128, GBK = 64;
constexpr int G_ASTAGE = GBM * GBK * 2, G_BSTAGE = GBN * GBK * 2, G_STAGE = G_ASTAGE + G_BSTAGE;
constexpr int G_LDS = 2 * G_STAGE;
__device__ __forceinline__ int g_lds_off(int r, int c) { return r * 128 + ((c ^ ((r >> 1) & 7)) << 4); }

template <class ARow, class Epi>
__device__ __forceinline__ void gemm_tile(char* lds, const ARow& arow, const bf16* __restrict__ Bt, int ldb, int K, int m0, int n0, const Epi& epi) {
    int tid = threadIdx.x; asm volatile("" : "+v"(tid));
    const int lane = tid & 63, wid = __builtin_amdgcn_readfirstlane(tid >> 6), wm = wid >> 1, wn = wid & 1;
    const bf16* ap[4]; const bf16* bp[2];
#pragma unroll
    for (int j = 0; j < 4; ++j) { const int r = 8 * (wid * 4 + j) + (lane >> 3); ap[j] = arow(r) + 8 * ((lane & 7) ^ ((r >> 1) & 7)); }
#pragma unroll
    for (int j = 0; j < 2; ++j) { const int r = 8 * (wid * 2 + j) + (lane >> 3); bp[j] = Bt + (size_t)(n0 + r) * ldb + 8 * ((lane & 7) ^ ((r >> 1) & 7)); }
    f32x16 acc[2][2];
#pragma unroll
    for (int a = 0; a < 2; ++a)
#pragma unroll
        for (int b = 0; b < 2; ++b)
#pragma unroll
            for (int r = 0; r < 16; ++r) acc[a][b][r] = 0.f;
    const int nk = K / GBK;
    __syncthreads();
#define G_DMA(kt_, stage_) do { \
        _Pragma("unroll") for (int j = 0; j < 4; ++j) __builtin_amdgcn_global_load_lds((const unsigned*)(ap[j] + (kt_) * GBK), (LAS unsigned*)((stage_) + (wid * 4 + j) * 1024), 16, 0, 0); \
        _Pragma("unroll") for (int j = 0; j < 2; ++j) __builtin_amdgcn_global_load_lds((const unsigned*)(bp[j] + (kt_) * GBK), (LAS unsigned*)((stage_) + G_ASTAGE + (wid * 2 + j) * 1024), 16, 0, 0); } while (0)
    G_DMA(0, lds);
    __syncthreads();
    const int fr = lane & 31, fh = lane >> 5;
    for (int kt = 0; kt < nk; ++kt) {
        char* cur = lds + (kt & 1) * G_STAGE;
        if (kt + 1 < nk) { char* nxt = lds + ((kt + 1) & 1) * G_STAGE; G_DMA(kt + 1, nxt); }
#pragma unroll
        for (int kk = 0; kk < 4; ++kk) {
            bf16x8 fa[2], fb[2];
#pragma unroll
            for (int mi = 0; mi < 2; ++mi) fa[mi] = *(const bf16x8*)(cur + g_lds_off(wm * 64 + mi * 32 + fr, kk * 2 + fh));
#pragma unroll
            for (int ni = 0; ni < 2; ++ni) fb[ni] = *(const bf16x8*)(cur + G_ASTAGE + g_lds_off(wn * 64 + ni * 32 + fr, kk * 2 + fh));
#pragma unroll
            for (int mi = 0; mi < 2; ++mi)
#pragma unroll
                for (int ni = 0; ni < 2; ++ni) acc[mi][ni] = __builtin_amdgcn_mfma_f32_32x32x16_bf16(fb[ni], fa[mi], acc[mi][ni], 0, 0, 0);
        }
        __syncthreads();
    }
#undef G_DMA
    epi(acc, m0 + wm * 64 + fr, n0 + wn * 64 + 4 * fh);
}


constexpr int G_LDS3 = 3 * G_STAGE;
struct GPtrs { const bf16* a[4]; const bf16* b[2]; };
template <class TL> __device__ __forceinline__ void g_ptrs(const TL& tl, const typename TL::Tile& t, int wid, int lane, GPtrs& P) {
#pragma unroll
    for (int j = 0; j < 4; ++j) { const int r = 8 * (wid * 4 + j) + (lane >> 3); P.a[j] = tl.arow(t, r) + 8 * ((lane & 7) ^ ((r >> 1) & 7)); }
#pragma unroll
    for (int j = 0; j < 2; ++j) { const int r = 8 * (wid * 2 + j) + (lane >> 3); P.b[j] = tl.brow(t, r) + 8 * ((lane & 7) ^ ((r >> 1) & 7)); }
}
__device__ __forceinline__ void g_dma(char* lds, const GPtrs& P, int kt, int stage, int wid) {
    char* st = lds + stage * G_STAGE;
#pragma unroll
    for (int j = 0; j < 4; ++j) __builtin_amdgcn_global_load_lds((const unsigned*)(P.a[j] + kt * GBK), (LAS unsigned*)(st + (wid * 4 + j) * 1024), 16, 0, 0);
#pragma unroll
    for (int j = 0; j < 2; ++j) __builtin_amdgcn_global_load_lds((const unsigned*)(P.b[j] + kt * GBK), (LAS unsigned*)(st + G_ASTAGE + (wid * 2 + j) * 1024), 16, 0, 0);
}
template <class TL>
__device__ __forceinline__ void gemm_stream(char* lds, const TL& tl) {
    int tid = threadIdx.x; asm volatile("" : "+v"(tid));
    const int lane = tid & 63, wid = __builtin_amdgcn_readfirstlane(tid >> 6), wm = wid >> 1, wn = wid & 1, fr = lane & 31, fh = lane >> 5;
    constexpr int nk = TL::K / GBK;
    static_assert(nk >= 2, "K too small");
    int idx = blockIdx.x;
    typename TL::Tile cur, nxt;
    if (!tl.tile(idx, cur)) return;
    GPtrs P, Pn;
    g_ptrs(tl, cur, wid, lane, P);
    bool has_next = tl.tile(idx + (int)gridDim.x, nxt);
    if (has_next) g_ptrs(tl, nxt, wid, lane, Pn);
    __syncthreads();
    g_dma(lds, P, 0, 0, wid); g_dma(lds, P, 1, 1, wid);
    int sg = 0;
    for (;;) {
        f32x16 acc[2][2];
#pragma unroll
        for (int a = 0; a < 2; ++a)
#pragma unroll
            for (int b = 0; b < 2; ++b)
#pragma unroll
                for (int r = 0; r < 16; ++r) acc[a][b][r] = 0.f;
        for (int kt = 0; kt < nk; ++kt) {
            if (kt + 1 < nk || has_next) asm volatile("s_waitcnt vmcnt(6)" ::: "memory"); else asm volatile("s_waitcnt vmcnt(0)" ::: "memory");
            __builtin_amdgcn_s_barrier();
            asm volatile("" ::: "memory");
            const int s2 = sg >= 1 ? sg - 1 : 2;
            if (kt + 2 < nk) g_dma(lds, P, kt + 2, s2, wid);
            else if (has_next) g_dma(lds, Pn, kt + 2 - nk, s2, wid);
            const char* cs = lds + sg * G_STAGE;
#pragma unroll
            for (int kk = 0; kk < 4; ++kk) {
                bf16x8 fa[2], fb[2];
#pragma unroll
                for (int mi = 0; mi < 2; ++mi) fa[mi] = *(const bf16x8*)(cs + g_lds_off(wm * 64 + mi * 32 + fr, kk * 2 + fh));
#pragma unroll
                for (int ni = 0; ni < 2; ++ni) fb[ni] = *(const bf16x8*)(cs + G_ASTAGE + g_lds_off(wn * 64 + ni * 32 + fr, kk * 2 + fh));
#pragma unroll
                for (int mi = 0; mi < 2; ++mi)
#pragma unroll
                    for (int ni = 0; ni < 2; ++ni) acc[mi][ni] = __builtin_amdgcn_mfma_f32_32x32x16_bf16(fb[ni], fa[mi], acc[mi][ni], 0, 0, 0);
            }
            sg = sg == 2 ? 0 : sg + 1;
        }
        tl.epi(cur, acc, wm * 64 + fr, wn * 64 + 4 * fh);
        if (!has_next) break;
        asm volatile("s_waitcnt vmcnt(0)" ::: "memory");
        cur = nxt; P = Pn; idx += (int)gridDim.x;
        has_next = tl.tile(idx + (int)gridDim.x, nxt);
        if (has_next) g_ptrs(tl, nxt, wid, lane, Pn);
    }
    asm volatile("s_waitcnt vmcnt(0)" ::: "memory");
}

struct ARowDense { const bf16* A; int lda; int m0; __device__ __forceinline__ const bf16* operator()(int i) const { return A + (size_t)(m0 + i) * lda; } };

struct EpiInProj {
    bf16* p; const float* rope;
    __device__ __forceinline__ void operator()(f32x16 (&acc)[2][2], int mrow, int ncol) const {
#pragma unroll
        for (int mi = 0; mi < 2; ++mi) {
            const int m = mrow + mi * 32;
#pragma unroll
            for (int ni = 0; ni < 2; ++ni) {
                const int nb = ncol + ni * 32;
                if (nb >= O1 && nb < O1 + 384 && m < TL) {
                    const int s = m & (S - 1); const int pos = ni == 0 ? (s >> 6) : (s & 63);
                    const int jb = (nb & 31);
#pragma unroll
                    for (int r = 0; r < 8; ++r) {
                        const int j = jb + (r & 3) + 8 * (r >> 2);
                        const float cs = rope[(pos * 16 + j) * 2], sn = rope[(pos * 16 + j) * 2 + 1];
                        const float x1 = acc[mi][ni][r], x2 = acc[mi][ni][r + 8];
                        acc[mi][ni][r] = x1 * cs - x2 * sn; acc[mi][ni][r + 8] = x1 * sn + x2 * cs;
                    }
                }
#pragma unroll
                for (int g = 0; g < 4; ++g) {
                    const int n = nb + 8 * g;
                    if (n < DIN) {
                        u32x2 v; v.x = pack_bf16(acc[mi][ni][4 * g], acc[mi][ni][4 * g + 1]); v.y = pack_bf16(acc[mi][ni][4 * g + 2], acc[mi][ni][4 * g + 3]);
                        *(u32x2*)(p + (size_t)m * DIN + n) = v;
                    }
                }
            }
        }
    }
};
struct EpiOutProj {
    float* xr; const float* mod;
    __device__ __forceinline__ void operator()(f32x16 (&acc)[2][2], int mrow, int ncol) const {
#pragma unroll
        for (int mi = 0; mi < 2; ++mi) {
            const int m = mrow + mi * 32; const int rb = m < TL ? m / S : 8;
            const float* g1 = mod + (size_t)rb * 6144 + 2 * D;
#pragma unroll
            for (int ni = 0; ni < 2; ++ni)
#pragma unroll
                for (int g = 0; g < 4; ++g) {
                    const int n = ncol + ni * 32 + 8 * g;
                    f32x4 gv = *(const f32x4*)(g1 + n); float* xp = xr + (size_t)m * D + n; f32x4 xv = *(const f32x4*)xp;
                    xv[0] += gv[0] * acc[mi][ni][4 * g]; xv[1] += gv[1] * acc[mi][ni][4 * g + 1]; xv[2] += gv[2] * acc[mi][ni][4 * g + 2]; xv[3] += gv[3] * acc[mi][ni][4 * g + 3];
                    *(f32x4*)xp = xv;
                }
        }
    }
};
#endif
#ifndef HOST_SIM
template <class NMap>
__device__ __forceinline__ void cvt_tile(char* lds, const float* __restrict__ src, int srcN, bf16* __restrict__ dst, int dstK, int k0, int n0, int nvalid  , int nrows  , const NMap& nmap) {
    int tid = threadIdx.x; asm volatile("" : "+v"(tid));
    bf16* t = (bf16*)lds;
    __syncthreads();
#pragma unroll
    for (int i = 0; i < 2; ++i) {
        const int c = tid + i * NTHREADS, k = c >> 4, n4 = (c & 15) * 4;
        f32x4 v = {0.f, 0.f, 0.f, 0.f};
        if (n0 + n4 < nvalid) v = *(const f32x4*)(src + (size_t)(k0 + k) * srcN + n0 + n4);
#pragma unroll
        for (int q = 0; q < 4; ++q) t[(n4 + q) * 66 + k] = f2bf(v[q]);
    }
    __syncthreads();
    {
        const int n = tid >> 3, kc = tid & 7;
        if (n0 + n < nrows) {
            const unsigned* s = (const unsigned*)(t + n * 66 + kc * 8);
            u32x4 o; o.x = s[0]; o.y = s[1]; o.z = s[2]; o.w = s[3];
            *(u32x4*)(dst + (size_t)nmap(n0 + n) * dstK + k0 + kc * 8) = o;
        }
    }
}
struct NMapId { __device__ __forceinline__ int operator()(int n) const { return n; } };
struct NMapUp { int which; __device__ __forceinline__ int operator()(int j) const { return (j >> 6) * 128 + ((j >> 5) & 1) * 64 + which * 32 + (j & 31); } };
#endif
#ifndef HOST_SIM
__device__ __forceinline__ float wave_sum(float v) {
#pragma unroll
    for (int o = 32; o > 0; o >>= 1) v += __shfl_xor(v, o);
    return v;
}
template <int MODE, int NORM>
__device__ __forceinline__ void row_pass(const WS& w, const Inputs& in, int ntok, const float* mod_cur  , const float* mod_nrm  ,
                                         const float* gnorm, int shc, int scc, const bf16* y, const float* topw, float* out, bf16* hout) {
    int tid = threadIdx.x; asm volatile("" : "+v"(tid));
    const int lane = tid & 63, wv = tid >> 6;
    for (int t = blockIdx.x * 8 + wv; t < ntok; t += gridDim.x * 8) {
        const int rb = t < TL ? t / S : 8;
        f32x4 v[4];
        float* xrow = w.xr + (size_t)t * D;
        if (MODE == 0) {
            const float* src = t < TL ? in.x + (size_t)t * D : in.ctx + (size_t)(t - TL) * D;
#pragma unroll
            for (int j = 0; j < 4; ++j) { v[j] = *(const f32x4*)(src + j * 256 + lane * 4); *(f32x4*)(xrow + j * 256 + lane * 4) = v[j]; }
        } else {
#pragma unroll
            for (int j = 0; j < 4; ++j) v[j] = *(const f32x4*)(xrow + j * 256 + lane * 4);
        }
        if (MODE == 2) {
            const float* g2 = mod_cur + (size_t)rb * 6144 + 5 * D;
            f32x4 f[4];
#pragma unroll
            for (int j = 0; j < 4; ++j) f[j] = (f32x4){0.f, 0.f, 0.f, 0.f};
#pragma unroll
            for (int k = 0; k < 4; ++k) {
                const float wk = topw[(size_t)t * 4 + k]; const bf16* yr = y + ((size_t)t * 4 + k) * D;
#pragma unroll
                for (int j = 0; j < 4; ++j) { u32x2 u = *(const u32x2*)(yr + j * 256 + lane * 4);
                    f[j][0] += wk * __uint_as_float(u.x << 16); f[j][1] += wk * __uint_as_float(u.x & 0xffff0000u); f[j][2] += wk * __uint_as_float(u.y << 16); f[j][3] += wk * __uint_as_float(u.y & 0xffff0000u); }
            }
#pragma unroll
            for (int j = 0; j < 4; ++j) { f32x4 g = *(const f32x4*)(g2 + j * 256 + lane * 4); v[j] += g * f[j]; *(f32x4*)(xrow + j * 256 + lane * 4) = v[j]; }
        }
        if (NORM == 0) continue;
        if (NORM == 2 && t >= TL) continue;
        float ss = 0.f;
#pragma unroll
        for (int j = 0; j < 4; ++j) ss += v[j][0] * v[j][0] + v[j][1] * v[j][1] + v[j][2] * v[j][2] + v[j][3] * v[j][3];
        ss = wave_sum(ss);
        const float rstd = 1.0f / sqrtf(ss * (1.0f / D) + EPS);
        if (NORM == 1) {
            const float* m = mod_nrm + (size_t)rb * 6144;
#pragma unroll
            for (int j = 0; j < 4; ++j) {
                const int c = j * 256 + lane * 4;
                f32x4 g = *(const f32x4*)(gnorm + c), sc = *(const f32x4*)(m + scc * D + c), sh = *(const f32x4*)(m + shc * D + c);
                f32x4 hv = v[j] * rstd * g * (sc + 1.0f) + sh;
                u32x2 u; u.x = pack_bf16(hv[0], hv[1]); u.y = pack_bf16(hv[2], hv[3]);
                *(u32x2*)(hout + (size_t)t * D + c) = u;
            }
        } else {
#pragma unroll
            for (int j = 0; j < 4; ++j) { const int c = j * 256 + lane * 4; f32x4 g = *(const f32x4*)(gnorm + c); *(f32x4*)(out + (size_t)t * D + c) = v[j] * rstd * g; }
        }
    }
}

constexpr int CNT_PAD = 32;
__device__ __forceinline__ void phase_router(char* lds, const WS& w, const float* ebias, int ntok, int l) {
    int tid = threadIdx.x; asm volatile("" : "+v"(tid));
    const int lane = tid & 63, wv = tid >> 6, fr = lane & 15, fq = lane >> 4;
    float* sl = (float*)lds + wv * (16 * 33);
    int* lcnt = (int*)(lds + 8 * 16 * 33 * 4);
    const bf16* Bt = w.wrT + (size_t)l * 32 * 1024;
    int* cnt = w.cnt + l * 32 * CNT_PAD; int* list = w.list;
    for (int tb0 = blockIdx.x * 128; tb0 < ntok; tb0 += gridDim.x * 128) {
        const int t0 = tb0 + wv * 16;
        if (tid < 32) lcnt[tid] = 0;
        f32x4 a0 = {0.f, 0.f, 0.f, 0.f}, a1 = {0.f, 0.f, 0.f, 0.f};
        const bf16* ar = w.h + (size_t)(t0 + fr) * D + fq * 8;
        const bf16* b0 = Bt + (size_t)fr * 1024 + fq * 8; const bf16* b1 = b0 + 16 * 1024;
#pragma unroll 8
        for (int ks = 0; ks < 32; ++ks) {
            bf16x8 fa = *(const bf16x8*)(ar + ks * 32), fb0 = *(const bf16x8*)(b0 + ks * 32), fb1 = *(const bf16x8*)(b1 + ks * 32);
            a0 = __builtin_amdgcn_mfma_f32_16x16x32_bf16(fa, fb0, a0, 0, 0, 0);
            a1 = __builtin_amdgcn_mfma_f32_16x16x32_bf16(fa, fb1, a1, 0, 0, 0);
        }
#pragma unroll
        for (int j = 0; j < 4; ++j) { sl[(4 * fq + j) * 33 + fr] = a0[j]; sl[(4 * fq + j) * 33 + 16 + fr] = a1[j]; }
        __syncthreads();
        int sel[4]; int lpos[4];
        if (lane < 16) {
            const int t = t0 + lane; const float* sr = sl + lane * 33;
            float ss[4]; float sum = 0.f;
#pragma unroll
            for (int k = 0; k < 4; ++k) {
                int best = 0; float bv = -1e30f, bs = 0.f;
                for (int e = 0; e < 32; ++e) {
                    bool used = false;
#pragma unroll
                    for (int q = 0; q < 4; ++q) if (q < k && sel[q] == e) used = true;
                    const float sg = 1.0f / (1.0f + expf(-sr[e])); const float vv = sg + ebias[e];
                    if (!used && vv > bv) { bv = vv; best = e; bs = sg; }
                }
                sel[k] = best; ss[k] = bs; sum += bs;
            }
            const float inv = ROUTED_SCALE / sum;
#pragma unroll
            for (int k = 0; k < 4; ++k) { w.topw[(size_t)t * 4 + k] = ss[k] * inv; lpos[k] = atomicAdd(&lcnt[sel[k]], 1); }
        }
        __syncthreads();
        if (tid < 32) lcnt[32 + tid] = atomicAdd(&cnt[tid * CNT_PAD], lcnt[tid]);
        __syncthreads();
        if (lane < 16) {
            const int t = t0 + lane;
#pragma unroll
            for (int k = 0; k < 4; ++k) list[(size_t)sel[k] * T + lcnt[32 + sel[k]] + lpos[k]] = t * 4 + k;
        }
        __syncthreads();
    }
}

__device__ __forceinline__ bool moe_decode(int tile, int NT, const int* cnt, int ntok, int& e, int& mt, int& nt, int& base, int& rows) {
    int t = tile / NT; nt = tile % NT; int b = 0;
    for (int i = 0; i < 33; ++i) {
        const int c = i < 32 ? cnt[i * CNT_PAD] : ntok; const int m = (c + GBM - 1) / GBM;
        if (t < m) { e = i; mt = t; rows = c; base = b; return true; }
        t -= m; b += c;
    }
    return false;
}
struct ARowGather {
    const bf16* A; const int* list; int rows; int r0; bool ident;
    __device__ __forceinline__ const bf16* operator()(int i) const {
        const int idx = r0 + i; int tok = 0;
        if (idx < rows) tok = ident ? idx : (list[idx] >> 2);
        return A + (size_t)tok * D;
    }
};
struct EpiUp {
    bf16* hid; int base; int rows;
    __device__ __forceinline__ void operator()(f32x16 (&acc)[2][2], int mrow, int ncol) const {
        const int hc = (ncol >> 7) * 64 + ((ncol >> 6) & 1) * 32 + (ncol & 63);
#pragma unroll
        for (int mi = 0; mi < 2; ++mi) {
            const int idx = mrow + mi * 32;
            if (idx < rows) {
#pragma unroll
                for (int g = 0; g < 4; ++g) {
                    float o[4];
#pragma unroll
                    for (int q = 0; q < 4; ++q) { const float gt = acc[mi][0][4 * g + q], up = acc[mi][1][4 * g + q]; o[q] = gt / (1.0f + expf(-gt)) * up; }
                    u32x2 v; v.x = pack_bf16(o[0], o[1]); v.y = pack_bf16(o[2], o[3]);
                    *(u32x2*)(hid + (size_t)(base + idx) * 256 + hc + 8 * g) = v;
                }
            }
        }
    }
};
struct EpiDown {
    bf16* y; const int* list; int rows; bool shared; float* xr; const float* mod;
    __device__ __forceinline__ void operator()(f32x16 (&acc)[2][2], int mrow, int ncol) const {
#pragma unroll
        for (int mi = 0; mi < 2; ++mi) {
            const int idx = mrow + mi * 32;
            if (idx < rows) {
                if (!shared) {
                    const int asg = list[idx];
#pragma unroll
                    for (int ni = 0; ni < 2; ++ni)
#pragma unroll
                        for (int g = 0; g < 4; ++g) {
                            u32x2 v; v.x = pack_bf16(acc[mi][ni][4 * g], acc[mi][ni][4 * g + 1]); v.y = pack_bf16(acc[mi][ni][4 * g + 2], acc[mi][ni][4 * g + 3]);
                            *(u32x2*)(y + (size_t)asg * D + ncol + ni * 32 + 8 * g) = v;
                        }
                } else {
                    const int rb = idx < TL ? idx / S : 8; const float* g2 = mod + (size_t)rb * 6144 + 5 * D;
#pragma unroll
                    for (int ni = 0; ni < 2; ++ni)
#pragma unroll
                        for (int g = 0; g < 4; ++g) {
                            const int n = ncol + ni * 32 + 8 * g;
                            f32x4 gv = *(const f32x4*)(g2 + n); float* xp = xr + (size_t)idx * D + n; f32x4 xv = *(const f32x4*)xp;
                            xv[0] += gv[0] * acc[mi][ni][4 * g]; xv[1] += gv[1] * acc[mi][ni][4 * g + 1]; xv[2] += gv[2] * acc[mi][ni][4 * g + 2]; xv[3] += gv[3] * acc[mi][ni][4 * g + 3];
                            *(f32x4*)xp = xv;
                        }
                }
            }
        }
    }
};
struct TLMoeUp {
    const WS* w; const int* cnt; int ntok; static constexpr int K = 1024;
    struct Tile { int e, mt, nt, base, rows; };
    __device__ __forceinline__ bool tile(int idx, Tile& t) const { return moe_decode(idx, 4, cnt, ntok, t.e, t.mt, t.nt, t.base, t.rows); }
    __device__ __forceinline__ const bf16* arow(const Tile& t, int r) const {
        const int i = t.mt * GBM + r; int tok = 0;
        if (i < t.rows) tok = t.e == 32 ? i : (w->list[(size_t)t.e * T + i] >> 2);
        return w->h + (size_t)tok * D;
    }
    __device__ __forceinline__ const bf16* brow(const Tile& t, int r) const { return w->moeUpT + ((size_t)t.e * 512 + t.nt * GBN + r) * 1024; }
    __device__ __forceinline__ void epi(const Tile& t, f32x16 (&acc)[2][2], int mr, int nc) const { EpiUp{w->hid2, t.base, t.rows}(acc, t.mt * GBM + mr, t.nt * GBN + nc); }
};
struct TLMoeDown {
    const WS* w; const int* cnt; int ntok; const float* mod; static constexpr int K = 256;
    struct Tile { int e, mt, nt, base, rows; };
    __device__ __forceinline__ bool tile(int idx, Tile& t) const { return moe_decode(idx, 8, cnt, ntok, t.e, t.mt, t.nt, t.base, t.rows); }
    __device__ __forceinline__ const bf16* arow(const Tile& t, int r) const { return w->hid2 + (size_t)(t.base + t.mt * GBM + r) * 256; }
    __device__ __forceinline__ const bf16* brow(const Tile& t, int r) const { return w->moeDownT + ((size_t)t.e * 1024 + t.nt * GBN + r) * 256; }
    __device__ __forceinline__ void epi(const Tile& t, f32x16 (&acc)[2][2], int mr, int nc) const {
        EpiDown{(bf16*)w->h, w->list + (size_t)t.e * T, t.rows, t.e == 32, w->xr, mod}(acc, t.mt * GBM + mr, t.nt * GBN + nc);
    }
};
struct TLMoeDownR : TLMoeDown {
    __device__ __forceinline__ bool tile(int idx, Tile& t) const { return moe_decode(idx, 8, cnt, ntok, t.e, t.mt, t.nt, t.base, t.rows) && t.e < 32; }
};
__device__ __forceinline__ void phase_moe_down_routed(char* lds, const WS& w, int l, int ntok, const float* mod) { TLMoeDownR tl; tl.w = &w; tl.cnt = w.cnt + l * 32 * CNT_PAD; tl.ntok = ntok; tl.mod = mod; gemm_stream(lds, tl); }
__device__ __forceinline__ void phase_moe_up(char* lds, const WS& w, int l, int ntok) { gemm_stream(lds, TLMoeUp{&w, w.cnt + l * 32 * CNT_PAD, ntok}); }
__device__ __forceinline__ void phase_moe_down(char* lds, const WS& w, int l, int ntok, const float* mod) { gemm_stream(lds, TLMoeDown{&w, w.cnt + l * 32 * CNT_PAD, ntok, mod}); }
#endif
#ifndef HOST_SIM
__device__ __forceinline__ void phase_ada(char* lds, const WS& w, const Inputs& in) {
    int tid = threadIdx.x; asm volatile("" : "+v"(tid));
    const int lane = tid & 63, wv = tid >> 6;
    float* sc = (float*)lds;
    float* red = sc + 9 * 1024;
    if ((int)blockIdx.x >= 192) return;
    __syncthreads();
    for (int i = tid; i < 9 * 1024; i += NTHREADS) { const int r = i >> 10, k = i & 1023; const float v = r < 8 ? in.c[(size_t)(r % B) * D + k] : in.c_ctx[k]; sc[i] = v / (1.0f + __expf(-v)); }
    __syncthreads();
    for (int it = blockIdx.x; it < 192; it += gridDim.x) {
        const int l = it / 96, n = (it % 96) * 64 + lane;
        const float* wp = in.w_ada + (size_t)l * D * 6144 + (size_t)(wv * 128) * 6144 + n;
        float acc[9];
#pragma unroll
        for (int r = 0; r < 9; ++r) acc[r] = 0.f;
#pragma unroll 8
        for (int k = 0; k < 128; ++k) {
            const float wvv = wp[(size_t)k * 6144];
#pragma unroll
            for (int r = 0; r < 9; ++r) acc[r] += sc[r * 1024 + wv * 128 + k] * wvv;
        }
#pragma unroll
        for (int r = 0; r < 9; ++r) red[(wv * 9 + r) * 64 + lane] = acc[r];
        __syncthreads();
        for (int i = tid; i < 9 * 64; i += NTHREADS) {
            const int r = i >> 6, c = i & 63; float s = 0.f;
#pragma unroll
            for (int q = 0; q < 8; ++q) s += red[(q * 9 + r) * 64 + c];
            const int nn = (it % 96) * 64 + c;
            w.mod[((size_t)l * 9 + r) * 6144 + nn] = s + in.b_ada[l * 6144 + nn];
        }
        __syncthreads();
    }
}
#endif
#ifndef HOST_SIM
typedef short s16x4 __attribute__((ext_vector_type(4)));
constexpr int AT_KV = 64 * 128;
constexpr int AT_STAGE = 2 * AT_KV;
__device__ __forceinline__ int at_voff(int key, int dcol) { return key * 128 + ((((dcol >> 5) ^ ((key >> 1) & 1))) << 6) + ((dcol & 31) << 1); }
__device__ __forceinline__ int at_kappa(int r) { return (r & ~12) | ((r & 4) << 1) | ((r & 8) >> 1); }

struct AttnState { f32x16 o[2]; float m, l; };

__device__ __forceinline__ void at_qk(const char* st, const bf16x8 (&qf)[4], f32x16 (&s)[2], int lane) {
    const int fr = lane & 31, fh = lane >> 5, kr = at_kappa(fr);
#pragma unroll
    for (int tt = 0; tt < 2; ++tt) {
#pragma unroll
        for (int r = 0; r < 16; ++r) s[tt][r] = 0.f;
#pragma unroll
        for (int ks = 0; ks < 4; ++ks) {
            const bf16x8 kf = *(const bf16x8*)(st + g_lds_off(32 * tt + kr, ks * 2 + fh));
            s[tt] = __builtin_amdgcn_mfma_f32_32x32x16_bf16(kf, qf[ks], s[tt], 0, 0, 0);
        }
    }
}
__device__ __forceinline__ void at_softmax_pv(const char* st, f32x16 (&s)[2], AttnState& a, int lane) {
    float mx = -1e30f;
#pragma unroll
    for (int tt = 0; tt < 2; ++tt)
#pragma unroll
        for (int r = 0; r < 16; ++r) mx = fmaxf(mx, s[tt][r]);
    mx = fmaxf(mx, __shfl_xor(mx, 32));
    const float mn = fmaxf(a.m, mx), alpha = __builtin_amdgcn_exp2f(a.m - mn);
    float rs = 0.f;
#pragma unroll
    for (int tt = 0; tt < 2; ++tt)
#pragma unroll
        for (int r = 0; r < 16; ++r) { const float p = __builtin_amdgcn_exp2f(s[tt][r] - mn); s[tt][r] = p; rs += p; }
    rs += __shfl_xor(rs, 32);
    a.l = a.l * alpha + rs; a.m = mn;
#pragma unroll
    for (int dt = 0; dt < 2; ++dt)
#pragma unroll
        for (int r = 0; r < 16; ++r) a.o[dt][r] *= alpha;
    const int fh = lane >> 5, i16 = lane & 15, g1 = (lane >> 4) & 1;
    const char* vb = st + AT_KV;
#pragma unroll
    for (int tt = 0; tt < 2; ++tt)
#pragma unroll
        for (int sp = 0; sp < 2; ++sp) {
            union { bf16x8 v; unsigned u[4]; } pu;
#pragma unroll
            for (int j = 0; j < 4; ++j) pu.u[j] = pack_bf16(s[tt][8 * sp + 2 * j], s[tt][8 * sp + 2 * j + 1]);
            const bf16x8 pf = pu.v;
#pragma unroll
            for (int dt = 0; dt < 2; ++dt) {
                const int kb = 32 * tt + 16 * sp + 8 * fh + (i16 >> 2), dc = 32 * dt + 16 * g1 + 4 * (i16 & 3);
                const s16x4 v0 = __builtin_amdgcn_ds_read_tr16_b64_v4i16((LAS s16x4*)(vb + at_voff(kb, dc)));
                const s16x4 v1 = __builtin_amdgcn_ds_read_tr16_b64_v4i16((LAS s16x4*)(vb + at_voff(kb + 4, dc)));
                bf16x8 vf; vf[0] = v0[0]; vf[1] = v0[1]; vf[2] = v0[2]; vf[3] = v0[3]; vf[4] = v1[0]; vf[5] = v1[1]; vf[6] = v1[2]; vf[7] = v1[3];
                a.o[dt] = __builtin_amdgcn_mfma_f32_32x32x16_bf16(vf, pf, a.o[dt], 0, 0, 0);
            }
        }
}
__device__ __forceinline__ void at_store(const AttnState& a, bf16* orow  , int lane) {
    const float il = 1.0f / a.l; const int fh = lane >> 5;
#pragma unroll
    for (int dt = 0; dt < 2; ++dt)
#pragma unroll
        for (int g = 0; g < 4; ++g) {
            u32x2 v; v.x = pack_bf16(a.o[dt][4 * g] * il, a.o[dt][4 * g + 1] * il); v.y = pack_bf16(a.o[dt][4 * g + 2] * il, a.o[dt][4 * g + 3] * il);
            *(u32x2*)(orow + 32 * dt + 8 * g + 4 * fh) = v;
        }
}
struct AtRegs { u32x4 k, v; };
__device__ __forceinline__ AtRegs at_load(const bf16* kbase, const bf16* vbase, int tid) {
    const int key = tid >> 3, c = tid & 7; AtRegs r;
    r.k = *(const u32x4*)(kbase + (size_t)key * DIN + c * 8); r.v = *(const u32x4*)(vbase + (size_t)key * DIN + c * 8); return r;
}
__device__ __forceinline__ void at_write(char* st, const AtRegs& r, int tid) {
    const int key = tid >> 3, c = tid & 7;
    *(u32x4*)(st + g_lds_off(key, c)) = r.k; *(u32x4*)(st + AT_KV + at_voff(key, c * 8)) = r.v;
}
__device__ __forceinline__ void at_dma(char* st, const bf16* kbase, int voff, int wid, int lane) {
    const int r = 8 * wid + (lane >> 3), pos = lane & 7;
    const bf16* kr = kbase + (size_t)r * DIN;
    const int ck = pos ^ ((r >> 1) & 7), cv = 4 * ((pos >> 2) ^ ((r >> 1) & 1)) + (pos & 3);
    __builtin_amdgcn_global_load_lds((const unsigned*)(kr + 8 * ck), (LAS unsigned*)(st + wid * 1024), 16, 0, 0);
    __builtin_amdgcn_global_load_lds((const unsigned*)(kr + voff + 8 * cv), (LAS unsigned*)(st + AT_KV + wid * 1024), 16, 0, 0);
}
#define AT_WAIT(n) asm volatile("s_waitcnt vmcnt(" #n ")" ::: "memory")
__device__ __forceinline__ void at_wait_tile(int remaining_after  ) {
    if (remaining_after >= 2) AT_WAIT(4); else if (remaining_after == 1) AT_WAIT(2); else AT_WAIT(0);
    __builtin_amdgcn_s_barrier();
    asm volatile("" ::: "memory");
}
constexpr int AT_RING = 4;
__device__ __forceinline__ void at_loadq(bf16x8 (&qf)[4], const bf16* qrow, int lane) {
    const int fh = lane >> 5;
#pragma unroll
    for (int ks = 0; ks < 4; ++ks) qf[ks] = *(const bf16x8*)(qrow + ks * 16 + fh * 8);
}
__device__ __forceinline__ int at_key(int tt, int r, int fh) { return 32 * tt + (r & 3) + 8 * fh + 4 * ((r >> 2) & 1) + 16 * (r >> 3); }

__device__ __forceinline__ void attn_wa_item(char* lds, const bf16* p, bf16* ycat, const float* sink, int b, int hk, int qb, bool ctxq) {
    int tid = threadIdx.x; asm volatile("" : "+v"(tid));
    const int lane = tid & 63, wv = tid >> 6, fr = lane & 31, fh = lane >> 5;
    const int hq = 2 * hk + (wv >> 2);
    const int qpos = qb * 128 + (wv & 3) * 32 + fr;
    const size_t qtok = ctxq ? (size_t)TL + (size_t)b * LC + qpos : (size_t)b * S + qpos;
    bf16x8 qf[4]; at_loadq(qf, p + qtok * DIN + O1 + hq * 64, lane);
    AttnState a;
#pragma unroll
    for (int dt = 0; dt < 2; ++dt)
#pragma unroll
        for (int r = 0; r < 16; ++r) a.o[dt][r] = 0.f;
    a.m = sink[hq] * 1.4426950408889634f; a.l = 1.0f;
    int lo = qb * 128 - 128, hi = qb * 128 + 256; if (lo < 0) lo = 0; if (hi > S) hi = S;
    const int nloc = ctxq ? 0 : (hi - lo) / 64, nt = 4 + nloc;
    const bf16* kc = p + ((size_t)TL + (size_t)b * LC) * DIN + O1 + 256 + hk * 64;
    const bf16* kl = p + ((size_t)b * S + lo) * DIN + O1 + 256 + hk * 64;
    const int wid = __builtin_amdgcn_readfirstlane(wv);
    asm volatile("s_waitcnt vmcnt(0)" ::: "memory");
    __syncthreads();
#define AT_TILE_K(i_) ((i_) < 4 ? kc + (size_t)(i_) * 64 * DIN : kl + (size_t)((i_) - 4) * 64 * DIN)
    for (int i = 0; i < 3 && i < nt; ++i) at_dma(lds + i * AT_STAGE, AT_TILE_K(i), 128, wid, lane);
    for (int i = 0; i < nt; ++i) {
        const char* st = lds + (i & 3) * AT_STAGE;
        at_wait_tile(nt - 1 - i);
        if (i + 3 < nt) at_dma(lds + ((i + 3) & 3) * AT_STAGE, AT_TILE_K(i + 3), 128, wid, lane);
        f32x16 s[2]; at_qk(st, qf, s, lane);
        if (i < 4) {
#pragma unroll
            for (int tt = 0; tt < 2; ++tt)
#pragma unroll
                for (int r = 0; r < 16; ++r) s[tt][r] *= 0.125f * 1.4426950408889634f;
        } else {
            const int kb0 = lo + (i - 4) * 64;
#pragma unroll
            for (int tt = 0; tt < 2; ++tt)
#pragma unroll
                for (int r = 0; r < 16; ++r) { const int d = kb0 + at_key(tt, r, fh) - qpos; s[tt][r] = (d >= -WINDOW && d <= WINDOW) ? s[tt][r] * (0.125f * 1.4426950408889634f) : -1e30f; }
        }
        at_softmax_pv(st, s, a, lane);
    }
    at_store(a, ycat + qtok * 1024 + 256 + hq * 64, lane);
}
__device__ __forceinline__ void attn_na_item(char* lds, const bf16* p, bf16* ycat, const float* rpb  , int b, int h, int rg4, bool ctxq) {
    int tid = threadIdx.x; asm volatile("" : "+v"(tid));
    const int lane = tid & 63, wv = tid >> 6, fr = lane & 31, fh = lane >> 5;
    const int r = rg4 * 4 + (wv >> 1), cq = (wv & 1) * 32 + fr;
    const size_t qtok = ctxq ? (size_t)TL + (size_t)b * LC + wv * 32 + fr : (size_t)b * S + r * 64 + cq;
    bf16x8 qf[4]; at_loadq(qf, p + qtok * DIN + O2 + h * 64, lane);
    AttnState a;
#pragma unroll
    for (int dt = 0; dt < 2; ++dt)
#pragma unroll
        for (int rr = 0; rr < 16; ++rr) a.o[dt][rr] = 0.f;
    a.m = -1e30f; a.l = 0.f;
    constexpr int ROWS = S / GRID_W;
    int klo = rg4 * 4 - 4; if (klo < 0) klo = 0; int khi = rg4 * 4 + 3 - 4; if (khi < 0) khi = 0; if (khi > ROWS - NA_KR) khi = ROWS - NA_KR; khi += NA_KR;
    if (klo > ROWS - NA_KR) klo = ROWS - NA_KR;
    const int nloc = ctxq ? 0 : khi - klo, nt = 4 + nloc;
    int myr0 = r - 4; myr0 = myr0 < 0 ? 0 : (myr0 > ROWS - NA_KR ? ROWS - NA_KR : myr0);
    int c0 = cq - 8; c0 = c0 < 0 ? 0 : (c0 > GRID_W - NA_KC ? GRID_W - NA_KC : c0);
    const bf16* kc = p + ((size_t)TL + (size_t)b * LC) * DIN + O2 + 256 + h * 64;
    const bf16* kl = p + ((size_t)b * S + (size_t)klo * 64) * DIN + O2 + 256 + h * 64;
    float* bl = (float*)(lds + AT_RING * AT_STAGE);
    __syncthreads();
    const int wid = __builtin_amdgcn_readfirstlane(wv);
    if (tid < 15 * 31) bl[(tid / 31) * 32 + (tid % 31)] = rpb[h * 15 * 31 + tid];
    asm volatile("s_waitcnt vmcnt(0) lgkmcnt(0)" ::: "memory");
    for (int i = 0; i < 3 && i < nt; ++i) at_dma(lds + i * AT_STAGE, AT_TILE_K(i), 256, wid, lane);
    for (int i = 0; i < nt; ++i) {
        const char* st = lds + (i & 3) * AT_STAGE;
        at_wait_tile(nt - 1 - i);
        if (i + 3 < nt) at_dma(lds + ((i + 3) & 3) * AT_STAGE, AT_TILE_K(i + 3), 256, wid, lane);
        const int krow = klo + (i - 4);
        const bool act = i < 4 || (krow >= myr0 && krow < myr0 + NA_KR);
        if (act) {
            f32x16 s[2]; at_qk(st, qf, s, lane);
            if (i < 4) {
#pragma unroll
                for (int tt = 0; tt < 2; ++tt)
#pragma unroll
                    for (int rr = 0; rr < 16; ++rr) s[tt][rr] *= 0.125f * 1.4426950408889634f;
            } else {
                const float* brow = bl + (krow - r + 7) * 32 + 15 - cq;
#pragma unroll
                for (int tt = 0; tt < 2; ++tt)
#pragma unroll
                    for (int rr = 0; rr < 16; ++rr) { const int kcol = at_key(tt, rr, fh); const bool ok = kcol >= c0 && kcol < c0 + NA_KC;
                        const float bias = ok ? brow[kcol] : 0.f; s[tt][rr] = ok ? (s[tt][rr] * 0.125f + bias) * 1.4426950408889634f : -1e30f; }
            }
            at_softmax_pv(st, s, a, lane);
        }
    }
    at_store(a, ycat + qtok * 1024 + 512 + h * 64, lane);
}
__device__ __forceinline__ void attn_item(char* lds, const WS& w, const Inputs& in, int l, int it) {
    if (it < 256) attn_wa_item(lds, w.p, w.ycat, in.wa_sink + l * 4, it >> 5, (it >> 4) & 1, it & 15, false);
    else if (it < 512) { const int j = it - 256; attn_na_item(lds, w.p, w.ycat, in.na_rpb + l * 4 * 15 * 31, j >> 5, (j >> 3) & 3, j & 7, false); }
    else if (it < 544) { const int j = it - 512; attn_wa_item(lds, w.p, w.ycat, in.wa_sink + l * 4, j >> 2, (j >> 1) & 1, j & 1, true); }
    else { const int j = it - 544; attn_na_item(lds, w.p, w.ycat, in.na_rpb + l * 4 * 15 * 31, j >> 2, j & 3, 0, true); }
}
#endif
#ifndef HOST_SIM
__device__ __forceinline__ float hy_c3(const bf16* pr, int tin, int col, const float* cw) {
    float acc = cw[768 + col] * bf2f(pr[col]);
    if (tin > 0) acc += cw[col] * bf2f(pr[col - DIN]);
    if (tin < S - 1) acc += cw[2 * 768 + col] * bf2f(pr[col + DIN]);
    return acc;
}
__device__ __forceinline__ void hy_prep_item(char* lds, const bf16* p, const float* cw, bf16* x0T, bf16* uvT, int b, int ch) {
    int tid = threadIdx.x; asm volatile("" : "+v"(tid));
    bf16* lx = (bf16*)lds;
    bf16* lu = lx + 256 * 72;
    __syncthreads();
    const int tl = tid & 63, cg = tid >> 6;
    const int tin = ch * 64 + tl; const bf16* pr = p + ((size_t)b * S + tin) * DIN;
    for (int it = 0; it < 4; ++it) {
        const int c0 = (it * 8 + cg) * 8;
        float x0[8], x1[8], vv[8];
#pragma unroll
        for (int q = 0; q < 8; ++q) { x0[q] = 0.f; x1[q] = 0.f; vv[q] = 0.f; }
#pragma unroll
        for (int dr = -1; dr <= 1; ++dr) {
            if (tin + dr < 0 || tin + dr >= S) continue;
            const bf16* r = pr + (ptrdiff_t)dr * DIN;
            const u32x4 a = *(const u32x4*)(r + c0), bq = *(const u32x4*)(r + 256 + c0), cq = *(const u32x4*)(r + 512 + c0);
            const float* w0 = cw + (dr + 1) * 768;
#pragma unroll
            for (int q = 0; q < 4; ++q) {
                x0[2 * q] += w0[c0 + 2 * q] * __uint_as_float(a[q] << 16); x0[2 * q + 1] += w0[c0 + 2 * q + 1] * __uint_as_float(a[q] & 0xffff0000u);
                x1[2 * q] += w0[256 + c0 + 2 * q] * __uint_as_float(bq[q] << 16); x1[2 * q + 1] += w0[256 + c0 + 2 * q + 1] * __uint_as_float(bq[q] & 0xffff0000u);
                vv[2 * q] += w0[512 + c0 + 2 * q] * __uint_as_float(cq[q] << 16); vv[2 * q + 1] += w0[512 + c0 + 2 * q + 1] * __uint_as_float(cq[q] & 0xffff0000u);
            }
        }
#pragma unroll
        for (int q = 0; q < 8; ++q) { lx[(c0 + q) * 72 + tl] = f2bf(x0[q]); lu[(c0 + q) * 72 + tl] = f2bf(x1[q] * vv[q]); }
    }
    __syncthreads();
    for (int i = tid; i < 2048; i += NTHREADS) {
        const int c = i >> 3, k = i & 7;
        const size_t g = ((size_t)c * B + b) * S + ch * 64 + k * 8;
        *(u32x4*)(x0T + g) = *(const u32x4*)(lx + c * 72 + k * 8);
        *(u32x4*)(uvT + g) = *(const u32x4*)(lu + c * 72 + k * 8);
    }
}
constexpr int HY_NOFF = 2072, HY_NE = 4128, HY_CS = HY_NE * 2 + 32;
constexpr int HY_URS = S * 2 + 16;
constexpr int HY_LDS_U = 8 * HY_CS, HY_LDS_Z = HY_LDS_U + 8 * HY_URS, HY_LDS_REV = HY_LDS_Z + 64, HY_LDS_END = HY_LDS_REV + (HY_NE + 8) * 2;
__device__ __forceinline__ void hy_conv_item(char* lds, const float* filtT, const float* hbias, const bf16* uvT, bf16* x0T  , int c) {
    static_assert(B == 8, "hyena conv assumes batch 8");
    int tid = threadIdx.x; asm volatile("" : "+v"(tid));
    const int lane = tid & 63, wv = tid >> 6, fr = lane & 31, fh = lane >> 5;
    bf16* rev = (bf16*)(lds + HY_LDS_REV);
    __syncthreads();
    const float* hf = filtT + (size_t)c * (S + LC); const float* hb = filtT + (size_t)(256 + c) * (S + LC);
    for (int e = tid; e < HY_NE + 8; e += NTHREADS) {
        const int n = e - HY_NOFF; float v = 0.f;
        if (n > 0 && n < S) v = hb[n]; else if (n <= 0 && n > -S) v = hf[-n];
        rev[e] = f2bf(v);
    }
    for (int i = tid; i < 8 * 256; i += NTHREADS) { const int bb = i >> 8, k = i & 255; *(u32x4*)(lds + HY_LDS_U + bb * HY_URS + k * 16) = *(const u32x4*)(uvT + ((size_t)c * B + bb) * S + k * 8); }
    if (tid < 4) ((unsigned*)(lds + HY_LDS_Z))[tid] = 0u;
    __syncthreads();
    for (int i = tid; i < 8 * (HY_NE / 2); i += NTHREADS) {
        const int m = i / (HY_NE / 2), d = i % (HY_NE / 2);
        const unsigned lo = rev[2 * d + m], hi = rev[2 * d + 1 + m];
        *(unsigned*)(lds + m * HY_CS + d * 4) = lo | (hi << 16);
    }
    __syncthreads();
    f32x16 acc[2];
#pragma unroll
    for (int q = 0; q < 2; ++q)
#pragma unroll
        for (int r = 0; r < 16; ++r) acc[q][r] = 0.f;
    const int bb = fr >> 2, pp = fr & 3;
    const int m = (-fr) & 7;
    const char* abase = lds + m * HY_CS;
    const char* ubase = lds + HY_LDS_U + bb * HY_URS + fh * 16;
    auto hstep = [&](int dl, bool a0, bool a1) {
        const int n0 = 8 * fh - fr - 16 * dl;
        const bf16x8 af = *(const bf16x8*)(abase + (n0 - m + HY_NOFF) * 2);
        if (a0) { const int sj = 16 * wv - dl + 2 * pp; const char* up = (sj >= 0 && sj < 128) ? ubase + sj * 32 : lds + HY_LDS_Z;
            acc[0] = __builtin_amdgcn_mfma_f32_32x32x16_bf16(af, *(const bf16x8*)up, acc[0], 0, 0, 0); }
        if (a1) { const int sj = 16 * wv + 8 - dl + 2 * pp; const char* up = (sj >= 0 && sj < 128) ? ubase + sj * 32 : lds + HY_LDS_Z;
            acc[1] = __builtin_amdgcn_mfma_f32_32x32x16_bf16(af, *(const bf16x8*)up, acc[1], 0, 0, 0); }
    };
#pragma unroll
    for (int dl = 16 * wv - 127; dl < 16 * wv - 119; ++dl) hstep(dl, true, false);
#pragma unroll 6
    for (int dl = 16 * wv - 119; dl <= 16 * wv + 6; ++dl) hstep(dl, true, true);
#pragma unroll
    for (int dl = 16 * wv + 7; dl <= 16 * wv + 14; ++dl) hstep(dl, false, true);
    const float hbc = hbias[c];
#pragma unroll
    for (int qq = 0; qq < 2; ++qq) {
        const int tb = 32 * (4 * (2 * wv + qq) + pp) + 4 * fh;
#pragma unroll
        for (int g = 0; g < 4; ++g) {
            const int t = tb + 8 * g;
            const u32x2 uu = *(const u32x2*)(lds + HY_LDS_U + bb * HY_URS + t * 2);
            bf16* xp = x0T + ((size_t)c * B + bb) * S + t; const u32x2 xx = *(const u32x2*)xp;
            const float u0 = __uint_as_float(uu.x << 16), u1 = __uint_as_float(uu.x & 0xffff0000u), u2 = __uint_as_float(uu.y << 16), u3 = __uint_as_float(uu.y & 0xffff0000u);
            const float a0 = __uint_as_float(xx.x << 16), a1 = __uint_as_float(xx.x & 0xffff0000u), a2 = __uint_as_float(xx.y << 16), a3 = __uint_as_float(xx.y & 0xffff0000u);
            u32x2 o; o.x = pack_bf16(a0 * (acc[qq][4 * g] + hbc * u0), a1 * (acc[qq][4 * g + 1] + hbc * u1)); o.y = pack_bf16(a2 * (acc[qq][4 * g + 2] + hbc * u2), a3 * (acc[qq][4 * g + 3] + hbc * u3));
            *(u32x2*)xp = o;
        }
    }
}
__device__ __forceinline__ void hy_fin_item(char* lds, const bf16* yT, bf16* ycat, int b, int ch) {
    int tid = threadIdx.x; asm volatile("" : "+v"(tid));
    bf16* ly = (bf16*)lds;
    __syncthreads();
    for (int i = tid; i < 2048; i += NTHREADS) {
        const int c = i >> 3, k = i & 7;
        const u32x4 v = *(const u32x4*)(yT + ((size_t)c * B + b) * S + ch * 64 + k * 8);
#pragma unroll
        for (int q = 0; q < 4; ++q) { ly[(k * 8 + 2 * q) * 264 + c] = (bf16)(v[q] & 0xffffu); ly[(k * 8 + 2 * q + 1) * 264 + c] = (bf16)(v[q] >> 16); }
    }
    __syncthreads();
    for (int i = tid; i < 2048; i += NTHREADS) {
        const int t = i >> 5, k = i & 31;
        *(u32x4*)(ycat + ((size_t)b * S + ch * 64 + t) * 1024 + k * 8) = *(const u32x4*)(ly + t * 264 + k * 8);
    }
}
#endif
#ifndef HOST_SIM
constexpr int GD_NC = 36;
__device__ __forceinline__ size_t gd_tok0(int b, int cc) { return cc < 4 ? (size_t)TL + (size_t)b * LC + cc * 64 : (size_t)b * S + (size_t)(cc - 4) * 64; }

constexpr int GP_K = 0, GP_V = 8192, GP_L0 = 16384, GP_T0 = GP_L0 + 2 * 16384, GP_VB0 = GP_T0 + 2 * 8192  , GP_G = GP_VB0 + 2 * 8192  ,
              GP_SM = GP_VB0 + 4 * 8192  , GP_LB = GP_SM + 6 * 256  , GP_END = GP_LB + 2 * 2048;

__device__ __forceinline__ void gdn_pre_item(char* lds, const WS& w, const float* cw  , const float* a_log, const float* dt_bias, int b, int cc, int h) {
    int tid = threadIdx.x; asm volatile("" : "+v"(tid));
    const int lane = tid & 63, wv = tid >> 6, fr = lane & 31, fh = lane >> 5;
    const bf16* p = w.p;
    const int L = cc < 4 ? LC : S; const int tin0 = cc < 4 ? cc * 64 : (cc - 4) * 64; const size_t tok0 = gd_tok0(b, cc);
    float* sm = (float*)(lds + GP_SM);
    __syncthreads();
    {
        const int tl = tid >> 3, dg = tid & 7;
        float q8[8], k8[8], v8[8];
#pragma unroll
        for (int x = 0; x < 8; ++x) { q8[x] = 0.f; k8[x] = 0.f; v8[x] = 0.f; }
#pragma unroll
        for (int i = 0; i < 4; ++i) {
            const int tt = tin0 + tl + i - 2;
            if (tt < 0 || tt >= L) continue;
            const bf16* r = p + (tok0 + tl + i - 2) * DIN + O3 + h * 64 + dg * 8;
            const u32x4 a = *(const u32x4*)r, bq = *(const u32x4*)(r + 256), cq = *(const u32x4*)(r + 512);
            const float* wq = cw + i * 768 + h * 64 + dg * 8;
#pragma unroll
            for (int x = 0; x < 4; ++x) {
                q8[2 * x] += wq[2 * x] * __uint_as_float(a[x] << 16); q8[2 * x + 1] += wq[2 * x + 1] * __uint_as_float(a[x] & 0xffff0000u);
                k8[2 * x] += wq[256 + 2 * x] * __uint_as_float(bq[x] << 16); k8[2 * x + 1] += wq[256 + 2 * x + 1] * __uint_as_float(bq[x] & 0xffff0000u);
                v8[2 * x] += wq[512 + 2 * x] * __uint_as_float(cq[x] << 16); v8[2 * x + 1] += wq[512 + 2 * x + 1] * __uint_as_float(cq[x] & 0xffff0000u);
            }
        }
        float sq = 0.f, sk = 0.f;
#pragma unroll
        for (int x = 0; x < 8; ++x) { q8[x] = q8[x] / (1.0f + __expf(-q8[x])); k8[x] = k8[x] / (1.0f + __expf(-k8[x])); v8[x] = v8[x] / (1.0f + __expf(-v8[x])); sq += q8[x] * q8[x]; sk += k8[x] * k8[x]; }
        sq += __shfl_xor(sq, 1); sq += __shfl_xor(sq, 2); sq += __shfl_xor(sq, 4);
        sk += __shfl_xor(sk, 1); sk += __shfl_xor(sk, 2); sk += __shfl_xor(sk, 4);
        const float rq = 0.125f / sqrtf(sq + EPS), rk = 1.0f / sqrtf(sk + EPS);
        u32x4 qo, ko, vo;
#pragma unroll
        for (int x = 0; x < 4; ++x) { qo[x] = pack_bf16(q8[2 * x] * rq, q8[2 * x + 1] * rq); ko[x] = pack_bf16(k8[2 * x] * rk, k8[2 * x + 1] * rk); vo[x] = pack_bf16(v8[2 * x], v8[2 * x + 1]); }
        bf16* qkg = w.qk + ((size_t)((b * 4 + h) * GD_NC + cc) * 2) * 4096;
        *(u32x4*)(qkg + tl * 64 + dg * 8) = qo; *(u32x4*)(qkg + 4096 + tl * 64 + dg * 8) = ko;
        *(u32x4*)(lds + GP_K + g_lds_off(tl, dg)) = ko;
        *(u32x4*)(lds + GP_V + at_voff(tl, dg * 8)) = vo;
        if (tid < 128) {
            const int dir = tid >> 6, t = tid & 63; const bf16* r = p + (tok0 + t) * DIN + O3 + 1024 + dir * 4 + h;
            const float a = bf2f(r[0]), bbv = bf2f(r[8]); const float x = a + dt_bias[dir * 4 + h]; const float sp = x > 20.f ? x : log1pf(expf(x));
            sm[dir * 64 + t] = -expf(a_log[dir * 4 + h]) * sp; sm[128 + dir * 64 + t] = 1.0f / (1.0f + expf(-bbv));
        }
    }
    __syncthreads();
    if (wv < 4) {
        const int ta = wv >> 1, tb = wv & 1; f32x16 g;
#pragma unroll
        for (int r = 0; r < 16; ++r) g[r] = 0.f;
#pragma unroll
        for (int ks = 0; ks < 4; ++ks) {
            const bf16x8 fa = *(const bf16x8*)(lds + GP_K + g_lds_off(32 * ta + fr, ks * 2 + fh)), fb = *(const bf16x8*)(lds + GP_K + g_lds_off(32 * tb + fr, ks * 2 + fh));
            g = __builtin_amdgcn_mfma_f32_32x32x16_bf16(fa, fb, g, 0, 0, 0);
        }
        float* G = (float*)(lds + GP_G);
#pragma unroll
        for (int r = 0; r < 16; ++r) G[(32 * ta + (r & 3) + 8 * (r >> 2) + 4 * fh) * 64 + 32 * tb + fr] = g[r];
    } else if (wv < 6) {
        const int dir = wv - 4; float v = sm[dir * 64 + (dir ? 63 - lane : lane)];
#pragma unroll
        for (int o = 1; o < 64; o <<= 1) { const float t = __shfl_up(v, o); if (lane >= o) v += t; }
        sm[256 + dir * 64 + lane] = v;
        float* gcg = w.gc + ((size_t)((b * 4 + h) * 2 + dir) * GD_NC + cc) * 64; gcg[lane] = v;
    }
    __syncthreads();
    const int dir = wv >> 2, t4 = tid & 255;
    {
        const float* G = (const float*)(lds + GP_G); float* Lm = (float*)(lds + GP_L0 + dir * 16384);
        for (int e = t4; e < 4096; e += 256) {
            const int i = e >> 6, j = e & 63; const int ti = dir ? 63 - i : i, tj = dir ? 63 - j : j;
            const float lv = j < i ? sm[128 + dir * 64 + ti] * G[ti * 64 + tj] * __expf(sm[256 + dir * 64 + i] - sm[256 + dir * 64 + j]) : 0.f;
            Lm[e] = lv;
            if (i >= 32 && j < 32) ((bf16*)(lds + GP_LB + dir * 2048))[(i - 32) * 32 + j] = f2bf(lv);
        }
    }
    __syncthreads();
    if ((__builtin_amdgcn_readfirstlane(wv) & 3) == 0) {
        const float* Lm = (const float*)(lds + GP_L0 + dir * 16384);
        char* Tm = lds + GP_T0 + dir * 8192;
        const int blk = lane >> 5, c = lane & 31;
        const LAS float* Lb = (const LAS float*)(Lm + (32 * blk) * 64 + 32 * blk);
        float Tc[32];
#pragma unroll
        for (int i = 0; i < 32; ++i) {
            const LAS float* Lr = Lb + i * 64;
            if (i >= 2) asm volatile("" : "+v"(Lr) : "v"(Tc[i - 2]));
            float a0 = (c == i) ? 1.0f : 0.f, a1 = 0.f, a2 = 0.f, a3 = 0.f;
#pragma unroll
            for (int j4 = 0; j4 < (i & ~3); j4 += 4) {
                const f32x4 l4 = *(const LAS f32x4*)(Lr + j4);
                a0 -= l4[0] * Tc[j4]; a1 -= l4[1] * Tc[j4 + 1]; a2 -= l4[2] * Tc[j4 + 2]; a3 -= l4[3] * Tc[j4 + 3];
            }
#pragma unroll
            for (int j = (i & ~3); j < i; ++j) a0 -= Lr[j] * Tc[j];
            Tc[i] = (a0 + a1) + (a2 + a3);
        }
        {
            int rb = 32 * blk; const int cb = (32 * blk + c) >> 3, cz = (32 * (1 - blk) + c) >> 3, co = (c & 7) * 2;
#pragma unroll
            for (int i = 0; i < 32; ++i) {
                asm volatile("" : "+v"(rb));
                const int row = rb + i, sw = (row >> 1) & 7;
                *(bf16*)(Tm + row * 128 + ((cb ^ sw) << 4) + co) = f2bf(Tc[i]);
                if (blk == 0) *(bf16*)(Tm + row * 128 + ((cz ^ sw) << 4) + co) = (bf16)0;
            }
        }
        asm volatile("s_waitcnt lgkmcnt(0)" ::: "memory");
        const char* Lq = lds + GP_LB + dir * 2048;
        f32x16 X;
#pragma unroll
        for (int r = 0; r < 16; ++r) X[r] = 0.f;
        const int i16 = lane & 15, g1 = (lane >> 4) & 1;
#pragma unroll
        for (int ks = 0; ks < 2; ++ks) {
            const bf16x8 fa = *(const bf16x8*)(Lq + fr * 64 + (ks * 2 + fh) * 16);
            const int jr = 16 * ks + 8 * fh + (i16 >> 2), dc = 16 * g1 + 4 * (i16 & 3);
            const s16x4 t0 = __builtin_amdgcn_ds_read_tr16_b64_v4i16((LAS s16x4*)(Tm + g_lds_off(jr, dc >> 3) + (dc & 7) * 2));
            const s16x4 t1 = __builtin_amdgcn_ds_read_tr16_b64_v4i16((LAS s16x4*)(Tm + g_lds_off(jr + 4, dc >> 3) + (dc & 7) * 2));
            bf16x8 fb; fb[0] = t0[0]; fb[1] = t0[1]; fb[2] = t0[2]; fb[3] = t0[3]; fb[4] = t1[0]; fb[5] = t1[1]; fb[6] = t1[2]; fb[7] = t1[3];
            X = __builtin_amdgcn_mfma_f32_32x32x16_bf16(fa, fb, X, 0, 0, 0);
        }
        f32x16 Y;
#pragma unroll
        for (int r = 0; r < 16; ++r) Y[r] = 0.f;
#pragma unroll
        for (int ks = 0; ks < 2; ++ks) {
            union { bf16x8 v; unsigned u[4]; } xb;
#pragma unroll
            for (int j = 0; j < 4; ++j) xb.u[j] = pack_bf16(X[8 * ks + 2 * j], X[8 * ks + 2 * j + 1]);
            const int c0 = 32 + 16 * ks + 4 * fh, c1 = c0 + 8;
            const u32x2 p0 = *(const u32x2*)(Tm + g_lds_off(32 + fr, c0 >> 3) + (c0 & 7) * 2), p1 = *(const u32x2*)(Tm + g_lds_off(32 + fr, c1 >> 3) + (c1 & 7) * 2);
            union { bf16x8 v; unsigned u[4]; } ta_; ta_.u[0] = p0.x; ta_.u[1] = p0.y; ta_.u[2] = p1.x; ta_.u[3] = p1.y;
            Y = __builtin_amdgcn_mfma_f32_32x32x16_bf16(ta_.v, xb.v, Y, 0, 0, 0);
        }
#pragma unroll
        for (int r = 0; r < 16; ++r) { const int row = 32 + (r & 3) + 8 * (r >> 2) + 4 * fh; *(bf16*)(Tm + g_lds_off(row, fr >> 3) + (fr & 7) * 2) = f2bf(-Y[r]); }
    } else {
        const int t3 = t4 - 64;
        for (int e = t3; e < 1024; e += 192) {
            const int mat = e >> 9, j = (e >> 3) & 63, c8 = e & 7; const int tj = dir ? 63 - j : j;
            const float sc = sm[128 + dir * 64 + tj] * (mat ? __expf(sm[256 + dir * 64 + j]) : 1.0f);
            const u32x4 src = mat ? *(const u32x4*)(lds + GP_K + g_lds_off(tj, c8)) : *(const u32x4*)(lds + GP_V + at_voff(tj, c8 * 8));
            u32x4 d;
#pragma unroll
            for (int x = 0; x < 4; ++x) d[x] = pack_bf16(sc * __uint_as_float(src[x] << 16), sc * __uint_as_float(src[x] & 0xffff0000u));
            *(u32x4*)(lds + GP_VB0 + (dir * 2 + mat) * 8192 + at_voff(j, c8 * 8)) = d;
        }
    }
    __syncthreads();
    {
        const int w4 = wv & 3, ta = w4 >> 1, tb = w4 & 1; const int i16 = lane & 15, g1 = (lane >> 4) & 1;
        const char* Tm = lds + GP_T0 + dir * 8192; const char* vb = lds + GP_VB0 + (dir * 2) * 8192; const char* kbe = vb + 8192;
        f32x16 aw, au;
#pragma unroll
        for (int r = 0; r < 16; ++r) { aw[r] = 0.f; au[r] = 0.f; }
#pragma unroll
        for (int ks = 0; ks < 4; ++ks) {
            const int jr = 16 * ks + 8 * fh + (i16 >> 2), dc = 32 * ta + 16 * g1 + 4 * (i16 & 3);
            const s16x4 k0 = __builtin_amdgcn_ds_read_tr16_b64_v4i16((LAS s16x4*)(kbe + at_voff(jr, dc))), k1 = __builtin_amdgcn_ds_read_tr16_b64_v4i16((LAS s16x4*)(kbe + at_voff(jr + 4, dc)));
            bf16x8 fa; fa[0] = k0[0]; fa[1] = k0[1]; fa[2] = k0[2]; fa[3] = k0[3]; fa[4] = k1[0]; fa[5] = k1[1]; fa[6] = k1[2]; fa[7] = k1[3];
            const bf16x8 fbT = *(const bf16x8*)(Tm + g_lds_off(32 * tb + fr, ks * 2 + fh));
            aw = __builtin_amdgcn_mfma_f32_32x32x16_bf16(fa, fbT, aw, 0, 0, 0);
            const bf16x8 faT = *(const bf16x8*)(Tm + g_lds_off(32 * ta + fr, ks * 2 + fh));
            const int dc2 = 32 * tb + 16 * g1 + 4 * (i16 & 3);
            const s16x4 v0 = __builtin_amdgcn_ds_read_tr16_b64_v4i16((LAS s16x4*)(vb + at_voff(jr, dc2))), v1 = __builtin_amdgcn_ds_read_tr16_b64_v4i16((LAS s16x4*)(vb + at_voff(jr + 4, dc2)));
            bf16x8 fv; fv[0] = v0[0]; fv[1] = v0[1]; fv[2] = v0[2]; fv[3] = v0[3]; fv[4] = v1[0]; fv[5] = v1[1]; fv[6] = v1[2]; fv[7] = v1[3];
            au = __builtin_amdgcn_mfma_f32_32x32x16_bf16(faT, fv, au, 0, 0, 0);
        }
        bf16* uwg = w.uw + ((size_t)(((b * 4 + h) * 2 + dir) * GD_NC + cc) * 2) * 4096;
#pragma unroll
        for (int g = 0; g < 4; ++g) {
            const int rr = 32 * ta + 8 * g + 4 * fh;
            u32x2 o1; o1.x = pack_bf16(-aw[4 * g], -aw[4 * g + 1]); o1.y = pack_bf16(-aw[4 * g + 2], -aw[4 * g + 3]);
            *(u32x2*)(uwg + (32 * tb + fr) * 64 + rr) = o1;
            u32x2 o2; o2.x = pack_bf16(au[4 * g], au[4 * g + 1]); o2.y = pack_bf16(au[4 * g + 2], au[4 * g + 3]);
            *(u32x2*)(uwg + 4096 + (32 * tb + fr) * 64 + rr) = o2;
        }
    }
}
#endif
#ifndef HOST_SIM
constexpr int GS_IN = 0  , GS_ST = 65536  , GS_U1 = GS_ST + 16384, GS_U2 = GS_U1 + 8192, GS_AT = GS_U2 + 8192,
              GS_TB = GS_AT + 8192  , GS_END = GS_TB + 2 * 1024;
__device__ __forceinline__ int gd_chunk_of_step(int dir, int n) { return dir ? (n < 4 ? 3 - n : 39 - n) : n; }

__device__ __forceinline__ void gdn_scan_chain(char* lds, const WS& w, int b, int h, int dir, bool emit_ctx) {
    int tid = threadIdx.x; asm volatile("" : "+v"(tid));
    const int lane = tid & 63, wv = tid >> 6, fr = lane & 31, fh = lane >> 5, w4 = wv & 3, ta = w4 >> 1, tb = w4 & 1;
    const int i16 = lane & 15, g1 = (lane >> 4) & 1;
    const bool lo = wv < 4;
    const size_t chain = (size_t)((b * 4 + h) * 2 + dir) * GD_NC;
    const bf16* qkb = w.qk + (size_t)(b * 4 + h) * GD_NC * 2 * 4096;
    bf16* uwb = w.uw + chain * 2 * 4096; const float* gcb = w.gc + chain * 64;
    const int lrow = tid >> 3, lch = tid & 7;
    const int qrow = dir ? 63 - lrow : lrow;
    __syncthreads();
    *(u32x4*)(lds + GS_ST + tid * 16) = (u32x4){0u, 0u, 0u, 0u};
    f32x16 Sacc;
#pragma unroll
    for (int r = 0; r < 16; ++r) Sacc[r] = 0.f;
    struct Pre { u32x4 rw, rq, rk; float rg; u32x2 uc[4]; };
    Pre pa, pb, pc;
    auto prefetch = [&](int n, Pre& r) {
        const int cc = gd_chunk_of_step(dir, n);
        const bf16* uwp = uwb + (size_t)cc * 2 * 4096; const bf16* qkp = qkb + (size_t)cc * 2 * 4096;
        r.rw = *(const u32x4*)(uwp + lrow * 64 + lch * 8);
        r.rq = *(const u32x4*)(qkp + lrow * 64 + lch * 8); r.rk = *(const u32x4*)(qkp + 4096 + lrow * 64 + lch * 8);
        r.rg = 0.f; if (tid < 64) r.rg = gcb[(size_t)cc * 64 + tid];
        if (lo) { const bf16* up = uwp + 4096 + (32 * tb + fr) * 64 + 32 * ta + 4 * fh;
#pragma unroll
            for (int g = 0; g < 4; ++g) r.uc[g] = *(const u32x2*)(up + 8 * g); }
    };
    auto stage = [&](int buf, const Pre& r) {
        char* ib = lds + GS_IN + buf * 32768;
        *(u32x4*)(ib + g_lds_off(lrow, lch)) = r.rw;
        *(u32x4*)(ib + 8192 + g_lds_off(qrow, lch)) = r.rq;
        *(u32x4*)(ib + 16384 + g_lds_off(qrow, lch)) = r.rk;
        *(u32x4*)(ib + 24576 + at_voff(qrow, lch * 8)) = r.rk;
        float* tbp = (float*)(lds + GS_TB + buf * 1024);
        if (tid < 64) { const float g63 = __shfl(r.rg, 63); tbp[tid] = r.rg; tbp[64 + tid] = __expf(r.rg); tbp[128 + tid] = __expf(g63 - r.rg); if (tid == 0) tbp[192] = __expf(g63); }
    };
    auto step = [&](int n, Pre& cur, const Pre& nx) {
        const int buf = n & 1; const char* ib = lds + GS_IN + buf * 32768; const float* tbp = (const float*)(lds + GS_TB + buf * 1024);
        const char* St = lds + GS_ST + buf * 8192; char* Stn = lds + GS_ST + (buf ^ 1) * 8192;
        const int cc = gd_chunk_of_step(dir, n);
        if (lo) {
            f32x16 acc;
#pragma unroll
            for (int g = 0; g < 4; ++g) { acc[4 * g] = __uint_as_float(cur.uc[g].x << 16); acc[4 * g + 1] = __uint_as_float(cur.uc[g].x & 0xffff0000u); acc[4 * g + 2] = __uint_as_float(cur.uc[g].y << 16); acc[4 * g + 3] = __uint_as_float(cur.uc[g].y & 0xffff0000u); }
#pragma unroll
            for (int ks = 0; ks < 4; ++ks) {
                const bf16x8 fa = *(const bf16x8*)(ib + g_lds_off(32 * ta + fr, ks * 2 + fh)), fb = *(const bf16x8*)(St + g_lds_off(32 * tb + fr, ks * 2 + fh));
                acc = __builtin_amdgcn_mfma_f32_32x32x16_bf16(fa, fb, acc, 0, 0, 0);
            }
#pragma unroll
            for (int g = 0; g < 4; ++g) {
                const int i0 = 32 * ta + 8 * g + 4 * fh; const f32x4 fc = *(const f32x4*)(tbp + 128 + i0);
                u32x2 o1; o1.x = pack_bf16(acc[4 * g], acc[4 * g + 1]); o1.y = pack_bf16(acc[4 * g + 2], acc[4 * g + 3]);
                u32x2 o2; o2.x = pack_bf16(acc[4 * g] * fc[0], acc[4 * g + 1] * fc[1]); o2.y = pack_bf16(acc[4 * g + 2] * fc[2], acc[4 * g + 3] * fc[3]);
                const int off = g_lds_off(32 * tb + fr, i0 >> 3) + (i0 & 7) * 2;
                *(u32x2*)(lds + GS_U1 + off) = o1; *(u32x2*)(lds + GS_U2 + off) = o2;
            }
        } else {
            f32x16 acc;
#pragma unroll
            for (int r = 0; r < 16; ++r) acc[r] = 0.f;
#pragma unroll
            for (int ks = 0; ks < 4; ++ks) {
                const bf16x8 fa = *(const bf16x8*)(ib + 16384 + g_lds_off(32 * ta + fr, ks * 2 + fh)), fb = *(const bf16x8*)(ib + 8192 + g_lds_off(32 * tb + fr, ks * 2 + fh));
                acc = __builtin_amdgcn_mfma_f32_32x32x16_bf16(fa, fb, acc, 0, 0, 0);
            }
            const int i = 32 * tb + fr; const float gi = tbp[i];
#pragma unroll
            for (int g = 0; g < 4; ++g) {
                const int j0 = 32 * ta + 8 * g + 4 * fh; const f32x4 gj = *(const f32x4*)(tbp + j0);
                float v[4];
#pragma unroll
                for (int x = 0; x < 4; ++x) v[x] = (j0 + x <= i) ? acc[4 * g + x] * __expf(gi - gj[x]) : 0.f;
                u32x2 o; o.x = pack_bf16(v[0], v[1]); o.y = pack_bf16(v[2], v[3]);
                *(u32x2*)(lds + GS_AT + g_lds_off(i, j0 >> 3) + (j0 & 7) * 2) = o;
            }
        }
        __syncthreads();
        if (lo) {
            f32x16 acc;
#pragma unroll
            for (int r = 0; r < 16; ++r) acc[r] = 0.f;
#pragma unroll
            for (int ks = 0; ks < 4; ++ks) {
                const bf16x8 fa = *(const bf16x8*)(ib + 8192 + g_lds_off(32 * ta + fr, ks * 2 + fh)), fb = *(const bf16x8*)(St + g_lds_off(32 * tb + fr, ks * 2 + fh));
                acc = __builtin_amdgcn_mfma_f32_32x32x16_bf16(fa, fb, acc, 0, 0, 0);
            }
#pragma unroll
            for (int g = 0; g < 4; ++g) { const f32x4 eg = *(const f32x4*)(tbp + 64 + 32 * ta + 8 * g + 4 * fh); acc[4 * g] *= eg[0]; acc[4 * g + 1] *= eg[1]; acc[4 * g + 2] *= eg[2]; acc[4 * g + 3] *= eg[3]; }
#pragma unroll
            for (int ks = 0; ks < 4; ++ks) {
                const bf16x8 fa = *(const bf16x8*)(lds + GS_AT + g_lds_off(32 * ta + fr, ks * 2 + fh)), fb = *(const bf16x8*)(lds + GS_U1 + g_lds_off(32 * tb + fr, ks * 2 + fh));
                acc = __builtin_amdgcn_mfma_f32_32x32x16_bf16(fa, fb, acc, 0, 0, 0);
            }
            if (cc >= 4 || emit_ctx) {
                bf16* op = uwb + (size_t)cc * 2 * 4096 + 4096 + (32 * tb + fr) * 64 + 32 * ta + 4 * fh;
#pragma unroll
                for (int g = 0; g < 4; ++g) { u32x2 o; o.x = pack_bf16(acc[4 * g], acc[4 * g + 1]); o.y = pack_bf16(acc[4 * g + 2], acc[4 * g + 3]); *(u32x2*)(op + 8 * g) = o; }
            }
        } else {
            const float e63 = tbp[192];
#pragma unroll
            for (int r = 0; r < 16; ++r) Sacc[r] *= e63;
#pragma unroll
            for (int ks = 0; ks < 4; ++ks) {
                const int ir = 16 * ks + 8 * fh + (i16 >> 2), dc = 32 * ta + 16 * g1 + 4 * (i16 & 3);
                const s16x4 k0 = __builtin_amdgcn_ds_read_tr16_b64_v4i16((LAS s16x4*)(ib + 24576 + at_voff(ir, dc))), k1 = __builtin_amdgcn_ds_read_tr16_b64_v4i16((LAS s16x4*)(ib + 24576 + at_voff(ir + 4, dc)));
                bf16x8 fa; fa[0] = k0[0]; fa[1] = k0[1]; fa[2] = k0[2]; fa[3] = k0[3]; fa[4] = k1[0]; fa[5] = k1[1]; fa[6] = k1[2]; fa[7] = k1[3];
                const bf16x8 fb = *(const bf16x8*)(lds + GS_U2 + g_lds_off(32 * tb + fr, ks * 2 + fh));
                Sacc = __builtin_amdgcn_mfma_f32_32x32x16_bf16(fa, fb, Sacc, 0, 0, 0);
            }
#pragma unroll
            for (int g = 0; g < 4; ++g) {
                const int d0 = 32 * ta + 8 * g + 4 * fh; u32x2 o; o.x = pack_bf16(Sacc[4 * g], Sacc[4 * g + 1]); o.y = pack_bf16(Sacc[4 * g + 2], Sacc[4 * g + 3]);
                *(u32x2*)(Stn + g_lds_off(32 * tb + fr, d0 >> 3) + (d0 & 7) * 2) = o;
            }
        }
        if (n + 1 < GD_NC) stage(buf ^ 1, nx);
        if (n + 3 < GD_NC) prefetch(n + 3, cur);
        __syncthreads();
    };
    prefetch(0, pa); prefetch(1, pb); prefetch(2, pc);
    stage(0, pa);
    __syncthreads();
    for (int n = 0; n < GD_NC; n += 3) { step(n, pa, pb); step(n + 1, pb, pc); step(n + 2, pc, pa); }
}

__device__ __forceinline__ void gdn_fin_item(char* lds, const WS& w, const float* ng, int b, int cc, int h) {
    int tid = threadIdx.x; asm volatile("" : "+v"(tid));
    bf16* lo_ = (bf16*)lds;
    __syncthreads();
    for (int i = tid; i < 1024; i += NTHREADS) {
        const int dir = i >> 9, dv = (i >> 3) & 63, k = i & 7;
        const bf16* src = w.uw + ((size_t)(((b * 4 + h) * 2 + dir) * GD_NC + cc) * 2 + 1) * 4096 + dv * 64 + k * 8;
        *(u32x4*)(lo_ + (dir * 64 + dv) * 72 + k * 8) = *(const u32x4*)src;
    }
    __syncthreads();
    const int tl = tid >> 3, dg = tid & 7; const size_t tok = gd_tok0(b, cc) + tl;
    float o[8]; float ss = 0.f;
#pragma unroll
    for (int x = 0; x < 8; ++x) { const int dv = dg * 8 + x; o[x] = bf2f(lo_[dv * 72 + tl]) + bf2f(lo_[(64 + dv) * 72 + 63 - tl]); ss += o[x] * o[x]; }
    ss += __shfl_xor(ss, 1); ss += __shfl_xor(ss, 2); ss += __shfl_xor(ss, 4);
    const float rs = 1.0f / sqrtf(ss * (1.0f / 64.0f) + EPS);
    const u32x4 gt = *(const u32x4*)(w.p + tok * DIN + O3 + 768 + h * 64 + dg * 8);
    u32x4 out;
#pragma unroll
    for (int x = 0; x < 4; ++x) {
        const float g0 = __uint_as_float(gt[x] << 16), g1v = __uint_as_float(gt[x] & 0xffff0000u);
        const float y0 = o[2 * x] * rs * ng[dg * 8 + 2 * x] * (g0 / (1.0f + __expf(-g0))), y1 = o[2 * x + 1] * rs * ng[dg * 8 + 2 * x + 1] * (g1v / (1.0f + __expf(-g1v)));
        out[x] = pack_bf16(y0, y1);
    }
    *(u32x4*)(w.ycat + tok * 1024 + 768 + h * 64 + dg * 8) = out;
}
#endif
#ifndef HOST_SIM
#ifndef REP_INPROJ
#define REP_INPROJ 1
#endif
#ifndef REP_GPRE
#define REP_GPRE 1
#endif
#ifndef REP_HPREP
#define REP_HPREP 1
#endif
#ifndef REP_ATTN
#define REP_ATTN 1
#endif
#ifndef REP_FIN
#define REP_FIN 1
#endif
#ifndef REP_CVT
#define REP_CVT 1
#endif
#ifndef REP_NORM2
#define REP_NORM2 1
#endif
#ifndef REP_UP
#define REP_UP 1
#endif
#ifndef REP_PRO
#define REP_PRO 1
#endif
namespace cg = cooperative_groups;
struct MP { Inputs in; float* out; WS w; };

template <class F> __device__ __forceinline__ void dev_run(const F& f, long n) {
    int t0 = threadIdx.x; asm volatile("" : "+v"(t0));
    for (long i = (long)blockIdx.x * NTHREADS + t0; i < n; i += (long)gridDim.x * NTHREADS) f(i);
}

struct TLInProj {
    const bf16* A; const bf16* Bt; EpiInProj e; static constexpr int K = 1024;
    struct Tile { int m0, n0; };
    __device__ __forceinline__ bool tile(int idx, Tile& t) const {
        constexpr int MT = T / GBM, NT = 3072 / GBN;
        if (idx >= MT * NT) return false;
        const int mg = idx / (8 * NT), rem = idx % (8 * NT); t.n0 = (rem / 8) * GBN; t.m0 = (mg * 8 + (rem & 7)) * GBM; return true;
    }
    __device__ __forceinline__ const bf16* arow(const Tile& t, int r) const { return A + (size_t)(t.m0 + r) * D; }
    __device__ __forceinline__ const bf16* brow(const Tile& t, int r) const { return Bt + (size_t)(t.n0 + r) * 1024; }
    __device__ __forceinline__ void epi(const Tile& t, f32x16 (&acc)[2][2], int mr, int nc) const { e(acc, t.m0 + mr, t.n0 + nc); }
};
struct TLOutProj {
    const bf16* A; const bf16* Bt; EpiOutProj e; int ntiles; static constexpr int K = 1024;
    struct Tile { int m0, n0; };
    __device__ __forceinline__ bool tile(int idx, Tile& t) const { if (idx >= ntiles) return false; t.m0 = (idx >> 3) * GBM; t.n0 = (idx & 7) * GBN; return true; }
    __device__ __forceinline__ const bf16* arow(const Tile& t, int r) const { return A + (size_t)(t.m0 + r) * 1024; }
    __device__ __forceinline__ const bf16* brow(const Tile& t, int r) const { return Bt + (size_t)(t.n0 + r) * 1024; }
    __device__ __forceinline__ void epi(const Tile& t, f32x16 (&acc)[2][2], int mr, int nc) const { e(acc, t.m0 + mr, t.n0 + nc); }
};
__device__ __forceinline__ void phase_ab(const WS& w, const bf16* A, const bf16* Bt  , int first_block) {
    int tid = threadIdx.x; asm volatile("" : "+v"(tid));
    const int lane = tid & 63, wv = tid >> 6, fr = lane & 15, fq = lane >> 4;
    const int nb = (int)gridDim.x - first_block;
    if ((int)blockIdx.x < first_block) return;
    for (int t0 = (((int)blockIdx.x - first_block) * 8 + wv) * 16; t0 < T; t0 += nb * 8 * 16) {
        f32x4 acc = {0.f, 0.f, 0.f, 0.f};
        const bf16* ar = A + (size_t)(t0 + fr) * D + fq * 8; const bf16* br = Bt + (size_t)fr * 1024 + fq * 8;
#pragma unroll 8
        for (int ks = 0; ks < 32; ++ks) acc = __builtin_amdgcn_mfma_f32_16x16x32_bf16(*(const bf16x8*)(ar + ks * 32), *(const bf16x8*)(br + ks * 32), acc, 0, 0, 0);
#pragma unroll
        for (int j = 0; j < 4; ++j) w.p[(size_t)(t0 + 4 * fq + j) * DIN + 3072 + fr] = f2bf(acc[j]);
    }
}
__device__ __forceinline__ void phase_inproj(char* lds, const WS& w, int l) {
    phase_ab(w, l == 0 ? w.h : w.hid2, w.winT + ((size_t)l * 3200 + 3072) * 1024, ((T / GBM) * (3072 / GBN)) % (int)gridDim.x);
    gemm_stream(lds, TLInProj{l == 0 ? w.h : w.hid2, w.winT + (size_t)l * 3200 * 1024, EpiInProj{w.p, w.rope}});
}
__device__ __forceinline__ void phase_outproj(char* lds, const WS& w, int l, const float* mod, int ntok) {
    gemm_stream(lds, TLOutProj{w.ycat, w.woutT + (size_t)l * 1024 * 1024, EpiOutProj{w.xr, mod}, (ntok / GBM) * 8});
}
struct EpiStoreP { bf16* p;
    __device__ __forceinline__ void operator()(f32x16 (&acc)[2][2], int mrow, int ncol) const {
#pragma unroll
        for (int mi = 0; mi < 2; ++mi)
#pragma unroll
            for (int ni = 0; ni < 2; ++ni)
#pragma unroll
                for (int g = 0; g < 4; ++g) { u32x2 v; v.x = pack_bf16(acc[mi][ni][4 * g], acc[mi][ni][4 * g + 1]); v.y = pack_bf16(acc[mi][ni][4 * g + 2], acc[mi][ni][4 * g + 3]);
                    *(u32x2*)(p + (size_t)(mrow + mi * 32) * 1024 + ncol + ni * 32 + 8 * g) = v; }
    } };
__device__ __forceinline__ void phase_outproj_dup(char* lds, const WS& w, int l, int ntok) {
    const int MT = ntok / GBM, NT = D / GBN;
    const bf16* Bt = w.woutT + (size_t)l * 1024 * 1024;
    for (int tile = blockIdx.x; tile < MT * NT; tile += gridDim.x) {
        const int mt = tile / NT, nt = tile % NT;
        gemm_tile(lds, ARowDense{w.ycat, 1024, mt * GBM}, Bt, 1024, 1024, mt * GBM, nt * GBN, EpiStoreP{w.p});
    }
}
__device__ __forceinline__ int q_next(int* head, int* slot  ) {
    __syncthreads();
    if (threadIdx.x == 0) *slot = __hip_atomic_fetch_add(head, 1, __ATOMIC_RELAXED, __HIP_MEMORY_SCOPE_AGENT);
    __syncthreads();
    return *slot;
}
__global__ void __launch_bounds__(NTHREADS) mega_kernel(MP mp) {
    extern __shared__ __attribute__((aligned(16))) char lds[];
    __shared__ uint4 xb_words;
    __shared__ int q_slot[4];
    cg::grid_group grid = cg::this_grid();
    const Inputs& in = mp.in; const WS& w = mp.w;
    if (threadIdx.x == 0) xb_words = make_uint4(0u, 0u, 0u, 0u);
    __syncthreads();
    XcdBarrier xb = xcd_barrier_post(w.bar, (volatile LAS unsigned*)&xb_words);
#ifndef PROBE
#define PROBE -1
#endif
    unsigned long long tprobe = 0, t0probe = 0; int gs_count = 0;
    if (PROBE >= 0 && blockIdx.x == 0 && threadIdx.x == 0) t0probe = __builtin_amdgcn_s_memrealtime();
#define GSYNC(id) do { xcd_barrier(xb); if (PROBE >= 0) { if (gs_count == PROBE && blockIdx.x == 0 && threadIdx.x == 0) tprobe = __builtin_amdgcn_s_memrealtime(); ++gs_count; } } while (0)
    phase_ada(lds, w, in);
    dev_run(NkRopeTab{w.rope}, NkRopeTab::count());
    dev_run(NkZeroI{w.cnt}, 4 * 32 * 32);
    dev_run(NkZeroI{w.qctr}, 64 * 64);
    for (int rep = 0; rep < REP_PRO; ++rep) for (int l = 0; l < 2; ++l) {
        for (int it = blockIdx.x; it < 16 * 50; it += gridDim.x) cvt_tile(lds, in.w_in + (size_t)l * D * DIN, DIN, w.winT + (size_t)l * 3200 * 1024, 1024, (it / 50) * 64, (it % 50) * 64, DIN, 3200, NMapId{});
        for (int it = blockIdx.x; it < 16 * 16; it += gridDim.x) cvt_tile(lds, in.w_out + (size_t)l * 1024 * D, D, w.woutT + (size_t)l * 1024 * 1024, 1024, (it >> 4) * 64, (it & 15) * 64, D, D, NMapId{});
        NkCvtT c3{in.moe_router + (size_t)l * D * 32, w.wrT + (size_t)l * 32 * 1024, 1024, 32, 32}; dev_run(c3, c3.count());
        dev_run(NkHyF1{in.hy_w1 + l * 33 * 64, in.hy_b1 + l * 64, in.hy_freq + l * 64, w.hyf1 + (size_t)l * (S + LC) * 64}, NkHyF1::count());
    }
    if (mp.out == nullptr) grid.sync();
    xcd_barrier(xb);
    for (int l = 0; l < 2; ++l)
        dev_run(NkHyF2{in.hy_w2 + l * 64 * 64, in.hy_b2 + l * 64, in.hy_freq + l * 64, w.hyf1 + (size_t)l * (S + LC) * 64, w.hyf2 + (size_t)l * (S + LC) * 64}, NkHyF2::count());
    row_pass<0, 1>(w, in, T, w.mod, w.mod, in.norm1, 0, 1, nullptr, nullptr, nullptr, w.h);
    GSYNC(0);
    for (int l = 0; l < 2; ++l) {
        const bool need_ctx = l == 0;
        const float* mod = w.mod + (size_t)l * 9 * 6144;
        const long ntok = need_ctx ? T : TL;
        const float* filt = w.filt + (size_t)l * (S + LC) * 512;
        for (int rep = 0; rep < REP_INPROJ; ++rep) phase_inproj(lds, w, l);
        dev_run(NkHyF3{in.hy_w3 + l * 64 * 512, w.hyf2 + (size_t)l * (S + LC) * 64, w.filt + (size_t)l * (S + LC) * 512}, NkHyF3::count());
        GSYNC(2);
        const float* hcw = in.hy_conv + l * 3 * 768;
#ifdef XAB
        for (int it = blockIdx.x; it < B * GD_NC * 4; it += gridDim.x) gdn_pre_item(lds, w, in.gdn_conv + l * 4 * 768, in.gdn_a_log + l * 8, in.gdn_dt_bias + l * 8, it / (GD_NC * 4), (it >> 2) % GD_NC, it & 3);
        for (int it = blockIdx.x; it < B * 32; it += gridDim.x) hy_prep_item(lds, w.p, hcw, w.x0T, w.uvT, it >> 5, it & 31);
        xcd_barrier(xb);
        {
            const int natt = 512 + (need_ctx ? 64 : 0);
            int* head = w.qctr + l * 64 + 1024;
            for (;;) {
                const int it = q_next(head, q_slot);
                if (it >= 64 + 256 + natt) break;
                if (it < 64) gdn_scan_chain(lds, w, it >> 3, (it >> 1) & 3, it & 1, need_ctx);
                else if (it < 320) hy_conv_item(lds, filt, in.hy_bias + l * 256, w.uvT, w.x0T, it - 64);
                else attn_item(lds, w, in, l, it - 320);
            }
        }
        xcd_barrier(xb);
#endif
        for (int it = blockIdx.x; it < B * GD_NC * 4; it += gridDim.x) gdn_pre_item(lds, w, in.gdn_conv + l * 4 * 768, in.gdn_a_log + l * 8, in.gdn_dt_bias + l * 8, it / (GD_NC * 4), (it >> 2) % GD_NC, it & 3);
        for (int it = blockIdx.x; it < B * 32; it += gridDim.x) hy_prep_item(lds, w.p, hcw, w.x0T, w.uvT, it >> 5, it & 31);
        if (need_ctx) dev_run(NkHyUV{w.p, hcw, w.uv, TL, TC, LC}, (long)TC * 256);
#ifdef XPA
        xcd_barrier(xb);
        for (int it = blockIdx.x; it < B * GD_NC * 4; it += gridDim.x) gdn_pre_item(lds, w, in.gdn_conv + l * 4 * 768, in.gdn_a_log + l * 8, in.gdn_dt_bias + l * 8, it / (GD_NC * 4), (it >> 2) % GD_NC, it & 3);
        for (int it = blockIdx.x; it < B * 32; it += gridDim.x) hy_prep_item(lds, w.p, hcw, w.x0T, w.uvT, it >> 5, it & 31);
#endif
        GSYNC(90);
#ifdef XSCAN
        if (blockIdx.x < 64) gdn_scan_chain(lds, w, blockIdx.x >> 3, (blockIdx.x >> 1) & 3, blockIdx.x & 1, need_ctx);
        xcd_barrier(xb);
        for (int it = blockIdx.x; it < B * GD_NC * 4; it += gridDim.x) gdn_pre_item(lds, w, in.gdn_conv + l * 4 * 768, in.gdn_a_log + l * 8, in.gdn_dt_bias + l * 8, it / (GD_NC * 4), (it >> 2) % GD_NC, it & 3);
        xcd_barrier(xb);
#endif
#ifdef XATT
        for (int it = blockIdx.x; it < 512 + (need_ctx ? 64 : 0); it += gridDim.x) attn_item(lds, w, in, l, it);
        xcd_barrier(xb);
#endif
#ifdef XCONV
        for (int c = blockIdx.x; c < 256; c += gridDim.x) hy_conv_item(lds, filt, in.hy_bias + l * 256, w.uvT, w.x0T, c);
        xcd_barrier(xb);
        for (int it = blockIdx.x; it < B * 32; it += gridDim.x) hy_prep_item(lds, w.p, hcw, w.x0T, w.uvT, it >> 5, it & 31);
        xcd_barrier(xb);
#endif
        {
            const int natt = 512 + (need_ctx ? 64 : 0);
            int* head = w.qctr + l * 64;
            for (;;) {
                const int it = q_next(head, q_slot);
                if (it >= 64 + 256 + natt) break;
                if (it < 64) gdn_scan_chain(lds, w, it >> 3, (it >> 1) & 3, it & 1, need_ctx);
                else if (it < 320) hy_conv_item(lds, filt, in.hy_bias + l * 256, w.uvT, w.x0T, it - 64);
                else attn_item(lds, w, in, l, it - 320);
            }
        }
        GSYNC(91);
        for (int rep = 0; rep < REP_FIN; ++rep) for (int it = blockIdx.x; it < B * 32; it += gridDim.x) hy_fin_item(lds, w.x0T, w.ycat, it >> 5, it & 31);
        if (need_ctx) dev_run(NkHyConv{w.p, hcw, w.uv, filt, in.hy_bias + l * 256, w.ycat, TL, LC, S}, (long)TC * 256);
        for (int rep = 0; rep < REP_FIN; ++rep) for (int it = blockIdx.x; it < B * GD_NC * 4; it += gridDim.x) { const int cc = (it >> 2) % GD_NC; if (cc >= 4 || need_ctx) gdn_fin_item(lds, w, in.gdn_norm + l * 64, it / (GD_NC * 4), cc, it & 3); }
        GSYNC(5);
#ifdef XOUT
        for (int rep = 0; rep < 2; ++rep) phase_outproj_dup(lds, w, l, (int)ntok);
#endif
        phase_outproj(lds, w, l, mod, (int)ntok);
        for (int rep = 0; rep < REP_CVT; ++rep) {
            for (int it = blockIdx.x; it < 33 * 2 * 64; it += gridDim.x) {
                const int e = it / 128, which = (it >> 6) & 1, kt = (it >> 2) & 15, nt = it & 3;
                const float* src = e < 32 ? (which ? in.moe_up : in.moe_gate) + ((size_t)l * 32 + e) * D * 256 : (which ? in.sh_up : in.sh_gate) + (size_t)l * D * 256;
                cvt_tile(lds, src, 256, w.moeUpT + (size_t)e * 512 * 1024, 1024, kt * 64, nt * 64, 256, 256, NMapUp{which});
            }
            for (int it = blockIdx.x; it < 33 * 64; it += gridDim.x) {
                const int e = it >> 6, kt = (it >> 4) & 3, nt = it & 15;
                const float* src = e < 32 ? in.moe_down + ((size_t)l * 32 + e) * 256 * D : in.sh_down + (size_t)l * 256 * D;
                cvt_tile(lds, src, D, w.moeDownT + (size_t)e * 1024 * 256, 256, kt * 64, nt * 64, D, D, NMapId{});
            }
        }
        GSYNC(6);
        for (int rep = 0; rep < REP_NORM2; ++rep) row_pass<1, 1>(w, in, (int)ntok, mod, mod, in.norm2 + l * D, 3, 4, nullptr, nullptr, nullptr, w.h);
        GSYNC(7);
#ifdef XROUT
        { WS w2 = w; w2.cnt = w.cnt + 2 * 32 * 32; w2.list = (int*)w.x0T; for (int rep = 0; rep < 2; ++rep) phase_router(lds, w2, in.moe_bias + l * 32, (int)ntok, l); }
#endif
#ifdef XBAR
        for (int rep = 0; rep < 10; ++rep) xcd_barrier(xb);
#endif
        phase_router(lds, w, in.moe_bias + l * 32, (int)ntok, l);
        GSYNC(8);
        for (int rep = 0; rep < REP_UP; ++rep) phase_moe_up(lds, w, l, (int)ntok);
        GSYNC(9);
#ifdef XDOWN
        for (int rep = 0; rep < 2; ++rep) phase_moe_down_routed(lds, w, l, (int)ntok, mod);
#endif
        phase_moe_down(lds, w, l, (int)ntok, mod);
#ifdef XCOMB
        dev_run(NkZeroI{(int*)w.moeUpT}, 9 * 6144);
#endif
        GSYNC(10);
#ifdef XCOMB
        for (int rep = 0; rep < 2; ++rep) row_pass<2, 0>(w, in, (int)ntok, (const float*)w.moeUpT, mod, nullptr, 0, 0, (const bf16*)w.h, w.topw, nullptr, nullptr);
#endif
        if (l == 0) row_pass<2, 1>(w, in, (int)ntok, mod, w.mod + (size_t)9 * 6144, in.norm1 + D, 0, 1, (const bf16*)w.h, w.topw, nullptr, w.hid2);
        else row_pass<2, 2>(w, in, (int)ntok, mod, mod, in.norm_f, 0, 0, (const bf16*)w.h, w.topw, mp.out, nullptr);
        GSYNC(11);
    }
    if (PROBE >= 0 && blockIdx.x == 0 && threadIdx.x == 0) { const float us = (float)(tprobe - t0probe) * 0.01f; mp.out[0] = sqrtf((float)TL * D * us * 1e-4f); }
}

constexpr size_t kDynLds = G_LDS3;
static_assert( HY_LDS_END <= kDynLds && AT_RING * AT_STAGE + 2048 <= kDynLds && GP_END <= kDynLds && GS_END <= kDynLds, "LDS budget");
extern "C" void kernel_launch(void* const* d_in, const int* in_sizes, int n_in, void* d_out, int out_size, void* d_ws, size_t ws_size, hipStream_t stream) {
    static int grid_blocks = 0;
    if (!grid_blocks) {
        int dev = 0, cus = 0, per_cu = 0;
        hipGetDevice(&dev);
        hipDeviceGetAttribute(&cus, hipDeviceAttributeMultiprocessorCount, dev);
        hipFuncSetAttribute((const void*)mega_kernel, hipFuncAttributeMaxDynamicSharedMemorySize, (int)kDynLds);
        hipOccupancyMaxActiveBlocksPerMultiprocessor(&per_cu, mega_kernel, NTHREADS, kDynLds);
        if (per_cu < 1) per_cu = 1;
        grid_blocks = cus;
    }
    MP mp; memset(&mp, 0, sizeof(mp));
    const float** ip = (const float**)&mp.in;
    for (int i = 0; i < 33; ++i) ip[i] = (const float*)d_in[i];
    mp.out = (float*)d_out; mp.w = make_ws(d_ws);
    hipMemsetAsync(mp.w.bar, 0, 4096 * 4, stream);
    void* args[] = {&mp};
    hipError_t e = hipLaunchCooperativeKernel((void*)mega_kernel, dim3(grid_blocks), dim3(NTHREADS), args, kDynLds, stream);
    if (e != hipSuccess) fprintf(stderr, "cooperative launch failed: %s (grid %d)\n", hipGetErrorString(e), grid_blocks);
}
#endif
```

```cpp
#ifndef HOST_SIM
#include <hip/hip_runtime.h>
#include <hip/hip_cooperative_groups.h>
#include <cstdio>
#include <cstring>
#define HD __host__ __device__ __forceinline__
#else
#include <cmath>
#include <cstdio>
#include <cstdlib>
#include <cstring>
#define HD inline
typedef void* hipStream_t;
#endif
#include <cstdint>
#include <cstddef>

#ifndef BATCH
#define BATCH 8
#endif
constexpr int B = BATCH, S = 2048, D = 1024, LC = 256, GRID_W = 64;
constexpr int TL = B * S, TC = B * LC, T = TL + TC;
constexpr int DIN = 3088, O1 = 768, O2 = 1280, O3 = 2048;
constexpr int WINDOW = 128, NA_KR = 8, NA_KC = 16;
constexpr float EPS = 1e-6f, ROPE_BASE = 10000.0f, ROUTED_SCALE = 2.5f;
constexpr float HY_DECAY_MIN = 3.0701134573253946f;
constexpr float HY_DECAY_MAX = 15.350567286626973f;
typedef unsigned short bf16;

HD float bf2f(bf16 h) { union { unsigned u; float f; } v; v.u = (unsigned)h << 16; return v.f; }
HD bf16 f2bf(float f) { union { float f; unsigned u; } v; v.f = f; unsigned u = v.u; u += 0x7fffu + ((u >> 16) & 1u); return (bf16)(u >> 16); }
HD float siluf(float x) { return x / (1.0f + expf(-x)); }

struct NkCopyX {
    const float* x; const float* ctx; float* xr;
    HD void operator()(long i) const { xr[i] = i < (long)TL * D ? x[i] : ctx[i - (long)TL * D]; }
    static HD long count() { return (long)T * D; }
};

struct NkAda {
    const float* c; const float* cctx; const float* w_ada; const float* b_ada; float* mod;
    HD void operator()(long i) const {
        int n = (int)(i % 6144); int r = (int)((i / 6144) % 9); int l = (int)(i / (6144 * 9));
        const float* cv = r < 8 ? c + (long)(r % B) * D : cctx;
        const float* w = w_ada + (long)l * D * 6144 + n;
        float acc = 0.f;
        for (int k = 0; k < D; ++k) { float v = cv[k]; acc += siluf(v) * w[(long)k * 6144]; }
        mod[i] = acc + b_ada[l * 6144 + n];
    }
    static HD long count() { return 2L * 9 * 6144; }
};

struct NkRstd {
    const float* xr; float* rstd; int nrows;
    HD void operator()(long t) const {
        const float* r = xr + t * D; float s = 0.f;
        for (int k = 0; k < D; ++k) s += r[k] * r[k];
        rstd[t] = 1.0f / sqrtf(s * (1.0f / D) + EPS);
    }
};

struct NkModNorm {
    const float* xr; const float* rstd; const float* g; const float* mod;   int sh_chunk, sc_chunk; bf16* h;
    HD void operator()(long i) const {
        long t = i / D; int k = (int)(i % D); int r = t < TL ? (int)(t / S) : 8;
        const float* m = mod + (long)r * 6144;
        float v = xr[i] * rstd[t] * g[k];
        h[i] = f2bf(v * (1.0f + m[sc_chunk * D + k]) + m[sh_chunk * D + k]);
    }
};

struct NkInProj {
    const bf16* h; const float* w; bf16* p;
    HD void operator()(long i) const {
        long t = i / DIN; int n = (int)(i % DIN);
        const bf16* hr = h + t * D; float acc = 0.f;
        for (int k = 0; k < D; ++k) acc += bf2f(hr[k]) * w[(long)k * DIN + n];
        p[i] = f2bf(acc);
    }
    static HD long count() { return (long)T * DIN; }
};

struct NkRope {
    bf16* p;
    HD void operator()(long i) const {
        int pr = (int)(i % 32); int hd = (int)((i / 32) % 6); long t = i / (32 * 6);
        int s = (int)(t % S); int row = s / GRID_W, col = s % GRID_W;
        int axis = pr >> 4, j = pr & 15;
        float pos = axis == 0 ? (float)row : (float)col;
        float inv = powf(ROPE_BASE, -(float)j / 16.0f);
        float ang = pos * inv; float cs = cosf(ang), sn = sinf(ang);
        bf16* q = p + t * DIN + O1 + hd * 64 + axis * 32;
        float x1 = bf2f(q[j]), x2 = bf2f(q[j + 16]);
        q[j] = f2bf(x1 * cs - x2 * sn); q[j + 16] = f2bf(x1 * sn + x2 * cs);
    }
    static HD long count() { return (long)TL * 6 * 32; }
};

struct NkHyF1 {
    const float* w1; const float* b1; const float* freq; float* f1;
    HD void operator()(long i) const {
        int j = (int)(i % 64); int tt = (int)(i / 64); int L = tt < S ? S : LC; int t = tt < S ? tt : tt - S;
        float tn = (float)t / (float)(L - 1);
        float acc = tn * w1[j];
        for (int bnd = 0; bnd < 16; ++bnd) {
            float band = 1e-4f + (float)bnd * ((15.0f - 1e-4f) / 15.0f);
            float ang = (6.283185307179586f / (float)L) * (float)t * band;
            acc += cosf(ang) * w1[(1 + bnd) * 64 + j] - sinf(ang) * w1[(17 + bnd) * 64 + j];
        }
        f1[i] = sinf(freq[j] * (acc + b1[j]));
    }
    static HD long count() { return (long)(S + LC) * 64; }
};
struct NkHyF2 {
    const float* w2; const float* b2; const float* freq; const float* f1; float* f2;
    HD void operator()(long i) const {
        int j = (int)(i % 64); long tt = i / 64; float acc = 0.f;
        for (int k = 0; k < 64; ++k) acc += f1[tt * 64 + k] * w2[k * 64 + j];
        f2[i] = sinf(freq[j] * (acc + b2[j]));
    }
    static HD long count() { return (long)(S + LC) * 64; }
};
struct NkHyF3 {
    const float* w3; const float* f2; float* filt;
    HD void operator()(long i) const {
        int tt = (int)(i % (S + LC)); int c = (int)(i / (S + LC)); int L = tt < S ? S : LC; int t = tt < S ? tt : tt - S;
        float tn = (float)t / (float)(L - 1);
        float acc = 0.f;
        for (int k = 0; k < 64; ++k) acc += f2[(long)tt * 64 + k] * w3[k * 512 + c];
        int cc = c & 255;
        float decay = HY_DECAY_MIN + (float)cc * ((HY_DECAY_MAX - HY_DECAY_MIN) / 255.0f);
        filt[(long)c * (S + LC) + tt] = acc * expf(-tn * decay);
    }
    static HD long count() { return (long)(S + LC) * 512; }
};
HD float hy_conv3(const bf16* p, long t, int tin, int L, int col, const float* cw) {
    float acc = cw[768 + col] * bf2f(p[t * DIN + col]);
    if (tin > 0) acc += cw[col] * bf2f(p[(t - 1) * DIN + col]);
    if (tin < L - 1) acc += cw[2 * 768 + col] * bf2f(p[(t + 1) * DIN + col]);
    return acc;
}
struct NkHyUV {
    const bf16* p; const float* cw; bf16* uv; long tbase; long ntok; int L;
    HD void operator()(long i) const {
        int c = (int)(i % 256); long t = tbase + i / 256; int tin = (int)((t - tbase) % L);
        float x1 = hy_conv3(p, t, tin, L, 256 + c, cw), v = hy_conv3(p, t, tin, L, 512 + c, cw);
        uv[t * 256 + c] = f2bf(x1 * v);
    }
};
struct NkHyConv {
    const bf16* p; const float* cw; const bf16* uv; const float* filt; const float* hbias; bf16* ycat; long tbase; int L; int foff;
    HD void operator()(long i) const {
        int tin = (int)(i % L); int c = (int)((i / L) % 256); long seq = i / ((long)L * 256); long t0 = tbase + seq * L; long t = t0 + tin;
        const float* f = filt + foff;
        float acc = 0.f;
        for (int s = 0; s < L; ++s) {
            int d = tin - s; float k = d >= 0 ? f[(long)c * (S + LC) + d] : f[(long)(256 + c) * (S + LC) - d];
            acc += k * bf2f(uv[(t0 + s) * 256 + c]);
        }
        acc += hbias[c] * bf2f(uv[t * 256 + c]);
        float x0 = hy_conv3(p, t, tin, L, c, cw);
        ycat[t * 1024 + c] = f2bf(x0 * acc);
    }
};

HD void attn_key(const float (&q)[64], const bf16* kr, const bf16* vr, float bias, float& m, float& l, float (&acc)[64]) {
    float sc = 0.f;
#pragma unroll
    for (int d = 0; d < 64; ++d) sc += q[d] * bf2f(kr[d]);
    sc = sc * 0.125f + bias;
    float mn = fmaxf(m, sc); float ca = expf(m - mn), cb = expf(sc - mn);
    l = l * ca + cb; m = mn;
#pragma unroll
    for (int d = 0; d < 64; ++d) acc[d] = acc[d] * ca + cb * bf2f(vr[d]);
}
struct NkWA {
    const bf16* p; const float* sink; bf16* ycat;
    HD void operator()(long i) const {
        int hq = (int)(i % 4); long t = i / 4; int b = (int)(t / S), s = (int)(t % S); int hk = hq >> 1;
        const bf16* qp = p + t * DIN + O1 + hq * 64;
        float q[64], acc[64];
#pragma unroll
        for (int d = 0; d < 64; ++d) { q[d] = bf2f(qp[d]); acc[d] = 0.f; }
        float m = sink[hq], l = 1.0f;
        for (int j = 0; j < LC; ++j) {
            const bf16* kr = p + ((long)TL + (long)b * LC + j) * DIN + O1 + 256 + hk * 64;
            attn_key(q, kr, kr + 128, 0.f, m, l, acc);
        }
        int j0 = s - WINDOW < 0 ? 0 : s - WINDOW, j1 = s + WINDOW > S - 1 ? S - 1 : s + WINDOW;
        for (int j = j0; j <= j1; ++j) {
            const bf16* kr = p + ((long)b * S + j) * DIN + O1 + 256 + hk * 64;
            attn_key(q, kr, kr + 128, 0.f, m, l, acc);
        }
        float il = 1.0f / l;
#pragma unroll
        for (int d = 0; d < 64; ++d) ycat[t * 1024 + 256 + hq * 64 + d] = f2bf(acc[d] * il);
    }
    static HD long count() { return (long)TL * 4; }
};
struct NkWACtx {
    const bf16* p; const float* sink; bf16* ycat;
    HD void operator()(long i) const {
        int hq = (int)(i % 4); long tc = i / 4; int b = (int)(tc / LC); int hk = hq >> 1; long t = TL + tc;
        const bf16* qp = p + t * DIN + O1 + hq * 64;
        float q[64], acc[64];
#pragma unroll
        for (int d = 0; d < 64; ++d) { q[d] = bf2f(qp[d]); acc[d] = 0.f; }
        float m = sink[hq], l = 1.0f;
        for (int j = 0; j < LC; ++j) {
            const bf16* kr = p + ((long)TL + (long)b * LC + j) * DIN + O1 + 256 + hk * 64;
            attn_key(q, kr, kr + 128, 0.f, m, l, acc);
        }
        float il = 1.0f / l;
#pragma unroll
        for (int d = 0; d < 64; ++d) ycat[t * 1024 + 256 + hq * 64 + d] = f2bf(acc[d] * il);
    }
    static HD long count() { return (long)TC * 4; }
};
struct NkNA {
    const bf16* p; const float* rpb; bf16* ycat;
    HD void operator()(long i) const {
        int h = (int)(i % 4); long t = i / 4; int b = (int)(t / S), s = (int)(t % S);
        int r = s / GRID_W, cq = s % GRID_W;
        const bf16* qp = p + t * DIN + O2 + h * 64;
        float q[64], acc[64];
#pragma unroll
        for (int d = 0; d < 64; ++d) { q[d] = bf2f(qp[d]); acc[d] = 0.f; }
        float m = -1e30f, l = 0.f;
        for (int j = 0; j < LC; ++j) {
            const bf16* kr = p + ((long)TL + (long)b * LC + j) * DIN + O2 + 256 + h * 64;
            attn_key(q, kr, kr + 256, 0.f, m, l, acc);
        }
        int r0 = r - NA_KR / 2; r0 = r0 < 0 ? 0 : (r0 > S / GRID_W - NA_KR ? S / GRID_W - NA_KR : r0);
        int c0 = cq - NA_KC / 2; c0 = c0 < 0 ? 0 : (c0 > GRID_W - NA_KC ? GRID_W - NA_KC : c0);
        for (int kk = 0; kk < NA_KR * NA_KC; ++kk) {
            int kr_ = r0 + kk / NA_KC, kc_ = c0 + kk % NA_KC;
            const bf16* kr = p + ((long)b * S + kr_ * GRID_W + kc_) * DIN + O2 + 256 + h * 64;
            attn_key(q, kr, kr + 256, rpb[(h * 15 + (kr_ - r + 7)) * 31 + (kc_ - cq + 15)], m, l, acc);
        }
        float il = 1.0f / l;
#pragma unroll
        for (int d = 0; d < 64; ++d) ycat[t * 1024 + 512 + h * 64 + d] = f2bf(acc[d] * il);
    }
    static HD long count() { return (long)TL * 4; }
};
struct NkNACtx {
    const bf16* p; bf16* ycat;
    HD void operator()(long i) const {
        int h = (int)(i % 4); long tc = i / 4; int b = (int)(tc / LC); long t = TL + tc;
        const bf16* qp = p + t * DIN + O2 + h * 64;
        float q[64], acc[64];
#pragma unroll
        for (int d = 0; d < 64; ++d) { q[d] = bf2f(qp[d]); acc[d] = 0.f; }
        float m = -1e30f, l = 0.f;
        for (int j = 0; j < LC; ++j) {
            const bf16* kr = p + ((long)TL + (long)b * LC + j) * DIN + O2 + 256 + h * 64;
            attn_key(q, kr, kr + 256, 0.f, m, l, acc);
        }
        float il = 1.0f / l;
#pragma unroll
        for (int d = 0; d < 64; ++d) ycat[t * 1024 + 512 + h * 64 + d] = f2bf(acc[d] * il);
    }
    static HD long count() { return (long)TC * 4; }
};

HD float gdn_conv4(const bf16* p, long t, int tin, int L, int col, const float* cw) {
    float acc = 0.f;
    for (int i = 0; i < 4; ++i) { int o = i - 2; if (tin + o >= 0 && tin + o < L) acc += cw[i * 768 + col] * bf2f(p[(t + o) * DIN + O3 + col]); }
    return siluf(acc);
}
struct NkGdnPrep {
    const bf16* p; const float* cw; bf16* qkv;
    HD void operator()(long i) const {
        int e = (int)(i % 64); int wh = (int)((i / 64) % 12); long t = i / 768; int which = wh / 4;
        int L = t < TL ? S : LC; int tin = t < TL ? (int)(t % S) : (int)((t - TL) % LC);
        int col0 = wh * 64;
        float v = gdn_conv4(p, t, tin, L, col0 + e, cw);
        if (which < 2) {
            float ss = 0.f; for (int d = 0; d < 64; ++d) { float u = gdn_conv4(p, t, tin, L, col0 + d, cw); ss += u * u; }
            v *= 1.0f / sqrtf(ss + EPS); if (which == 0) v *= 0.125f;
        }
        qkv[t * 768 + col0 + e] = f2bf(v);
    }
    static HD long count() { return (long)T * 768; }
};
struct NkGdnGate {
    const bf16* p; const float* a_log; const float* dt_bias; float* gb;
    HD void operator()(long i) const {
        int dh = (int)(i % 8); long t = i / 8;
        float a = bf2f(p[t * DIN + O3 + 1024 + dh]), bb = bf2f(p[t * DIN + O3 + 1032 + dh]);
        float x = a + dt_bias[dh]; float sp = x > 20.f ? x : log1pf(expf(x));
        gb[t * 16 + dh] = -expf(a_log[dh]) * sp; gb[t * 16 + 8 + dh] = 1.0f / (1.0f + expf(-bb));
    }
    static HD long count() { return (long)T * 8; }
};
struct NkGdnRec {
    const bf16* qkv; const float* gb; bf16* o;
    HD void operator()(long i) const {
        int e = (int)(i % 64); int dir = (int)((i / 64) % 2); int h = (int)((i / 128) % 4); int b = (int)(i / 512);
        float Sc[64];
#pragma unroll
        for (int d = 0; d < 64; ++d) Sc[d] = 0.f;
        for (int step = 0; step < LC + S; ++step) {
            long t;
            if (step < LC) { int j = dir ? LC - 1 - step : step; t = (long)TL + (long)b * LC + j; }
            else { int s = step - LC; s = dir ? S - 1 - s : s; t = (long)b * S + s; }
            const bf16* qr = qkv + t * 768 + h * 64; const bf16* kr = qr + 256; float v = bf2f(qr[512 + e]);
            float a = expf(gb[t * 16 + dir * 4 + h]), beta = gb[t * 16 + 8 + dir * 4 + h];
            float kS = 0.f;
#pragma unroll
            for (int c = 0; c < 4; ++c) {
#pragma unroll
                for (int d = c * 16; d < c * 16 + 16; ++d) kS += bf2f(kr[d]) * Sc[d];
                asm volatile("" ::: "memory");
            }
            float w = beta * (v - a * kS); float oo = 0.f;
#pragma unroll
            for (int c = 0; c < 4; ++c) {
#pragma unroll
                for (int d = c * 16; d < c * 16 + 16; ++d) { Sc[d] = a * Sc[d] + bf2f(kr[d]) * w; oo += bf2f(qr[d]) * Sc[d]; }
                asm volatile("" ::: "memory");
            }
            o[((long)dir * T + t) * 256 + h * 64 + e] = f2bf(oo);
        }
    }
    static HD long count() { return (long)B * 4 * 2 * 64; }
};
struct NkGdnFin {
    const bf16* p; const bf16* o; const float* ng; bf16* ycat;
    HD void operator()(long i) const {
        int e = (int)(i % 64); int h = (int)((i / 64) % 4); long t = i / 256;
        const bf16* o0 = o + t * 256 + h * 64; const bf16* o1 = o + ((long)T + t) * 256 + h * 64;
        float ss = 0.f; for (int d = 0; d < 64; ++d) { float u = bf2f(o0[d]) + bf2f(o1[d]); ss += u * u; }
        float v = (bf2f(o0[e]) + bf2f(o1[e])) * (1.0f / sqrtf(ss * (1.0f / 64.0f) + EPS)) * ng[e];
        float gt = bf2f(p[t * DIN + O3 + 768 + h * 64 + e]);
        ycat[t * 1024 + 768 + h * 64 + e] = f2bf(v * siluf(gt));
    }
    static HD long count() { return (long)T * 256; }
};

struct NkOutProj {
    const bf16* ycat; const float* w; const float* mod; float* xr; long ntok;
    HD void operator()(long i) const {
        long t = i / D; int n = (int)(i % D); int r = t < TL ? (int)(t / S) : 8;
        const bf16* yr = ycat + t * 1024; float acc = 0.f;
        for (int k = 0; k < 1024; ++k) acc += bf2f(yr[k]) * w[(long)k * D + n];
        xr[i] += mod[(long)r * 6144 + 2 * D + n] * acc;
    }
};

struct NkRouter {
    const bf16* h; const float* wr; float* scores;
    HD void operator()(long i) const {
        int e = (int)(i % 32); long t = i / 32; float acc = 0.f;
        for (int k = 0; k < D; ++k) acc += bf2f(h[t * D + k]) * wr[k * 32 + e];
        scores[i] = 1.0f / (1.0f + expf(-acc));
    }
};
struct NkTopK {
    const float* scores; const float* ebias; int* topi; float* topw;
    HD void operator()(long t) const {
        int sel[4]; float ss[4]; float sum = 0.f;
#pragma unroll
        for (int k = 0; k < 4; ++k) {
            int best = -1; float bv = -1e30f;
            for (int e = 0; e < 32; ++e) {
                bool used = false;
#pragma unroll
                for (int q = 0; q < 4; ++q) if (q < k && sel[q] == e) used = true;
                float v = scores[t * 32 + e] + ebias[e];
                if (!used && v > bv) { bv = v; best = e; }
            }
            sel[k] = best; ss[k] = scores[t * 32 + best]; sum += ss[k];
        }
#pragma unroll
        for (int k = 0; k < 4; ++k) { topi[t * 4 + k] = sel[k]; topw[t * 4 + k] = ss[k] / sum * ROUTED_SCALE; }
    }
};
struct NkMoeHid {
    const bf16* h; const int* topi; const float* wg; const float* wu; const float* sg; const float* su; bf16* hid;
    HD void operator()(long i) const {
        int j = (int)(i % 256); int slot = (int)((i / 256) % 5); long t = i / 1280;
        const float* g; const float* u;
        if (slot < 4) { int e = topi[t * 4 + slot]; g = wg + (long)e * D * 256; u = wu + (long)e * D * 256; } else { g = sg; u = su; }
        float ag = 0.f, au = 0.f;
        for (int k = 0; k < D; ++k) { float x = bf2f(h[t * D + k]); ag += x * g[(long)k * 256 + j]; au += x * u[(long)k * 256 + j]; }
        hid[i] = f2bf(siluf(ag) * au);
    }
};
struct NkMoeOut {
    const bf16* hid; const int* topi; const float* topw; const float* wd; const float* sd; const float* mod; float* xr;
    HD void operator()(long i) const {
        long t = i / D; int n = (int)(i % D); int r = t < TL ? (int)(t / S) : 8;
        float f = 0.f;
        for (int slot = 0; slot < 5; ++slot) {
            const float* w; float wt;
            if (slot < 4) { w = wd + (long)topi[t * 4 + slot] * 256 * D; wt = topw[t * 4 + slot]; } else { w = sd; wt = 1.0f; }
            float acc = 0.f;
            for (int j = 0; j < 256; ++j) acc += bf2f(hid[(t * 5 + slot) * 256 + j]) * w[(long)j * D + n];
            f += wt * acc;
        }
        xr[i] += mod[(long)r * 6144 + 5 * D + n] * f;
    }
};
struct NkFinal {
    const float* xr; const float* rstd; const float* g; float* out;
    HD void operator()(long i) const { long t = i / D; int k = (int)(i % D); out[i] = xr[i] * rstd[t] * g[k]; }
    static HD long count() { return (long)TL * D; }
};

struct NkCvtT {
    const float* src; bf16* dst; int K, N, Npad;
    HD void operator()(long i) const {
        int n = (int)(i % Npad); int k0 = (int)(i / Npad) * 8;
        bf16 v[8];
#pragma unroll
        for (int j = 0; j < 8; ++j) v[j] = n < N ? f2bf(src[(long)(k0 + j) * N + n]) : (bf16)0;
        bf16* d = dst + (long)n * K + k0;
#pragma unroll
        for (int j = 0; j < 8; ++j) d[j] = v[j];
    }
    HD long count() const { return (long)Npad * (K / 8); }
};
struct NkRopeTab {
    float* rope;
    HD void operator()(long i) const {
        int j = (int)(i % 16); int pos = (int)(i / 16);
        float ang = (float)pos * powf(ROPE_BASE, -(float)j / 16.0f);
        rope[i * 2] = cosf(ang); rope[i * 2 + 1] = sinf(ang);
    }
    static HD long count() { return 64 * 16; }
};

struct NkCvtUp {
    const float* wg; const float* wu; const float* sg; const float* su; bf16* dst;
    HD void operator()(long i) const {
        int j = (int)(i % 256); int k0 = (int)((i / 256) % 128) * 8; int which = (int)((i / (256 * 128)) % 2); int e = (int)(i / (256 * 128 * 2));
        const float* src = e < 32 ? (which ? wu : wg) + (long)e * D * 256 : (which ? su : sg);
        int np = (j >> 6) * 128 + ((j >> 5) & 1) * 64 + which * 32 + (j & 31);
        bf16* d = dst + ((long)e * 512 + np) * 1024 + k0;
#pragma unroll
        for (int q = 0; q < 8; ++q) d[q] = f2bf(src[(long)(k0 + q) * 256 + j]);
    }
    static HD long count() { return 33L * 2 * 128 * 256; }
};
struct NkCvtDown {
    const float* wd; const float* sd; bf16* dst;
    HD void operator()(long i) const {
        int n = (int)(i % 1024); int j0 = (int)((i / 1024) % 32) * 8; int e = (int)(i / (1024 * 32));
        const float* src = e < 32 ? wd + (long)e * 256 * D : sd;
        bf16* d = dst + ((long)e * 1024 + n) * 256 + j0;
#pragma unroll
        for (int q = 0; q < 8; ++q) d[q] = f2bf(src[(long)(j0 + q) * D + n]);
    }
    static HD long count() { return 33L * 32 * 1024; }
};
struct NkZeroI { int* p; HD void operator()(long i) const { p[i] = 0; } };
struct WS {
    float* mod; float* rstd; float* xr; bf16* h; bf16* p; bf16* ycat; float* hyf1; float* hyf2; float* filt; bf16* uv;
    bf16* qkv; float* gb; bf16* o; float* scores; int* topi; float* topw; bf16* hid;
    bf16* winT; bf16* woutT; bf16* wrT; float* rope; unsigned* bar; int* cnt; int* list;
    bf16* moeUpT; bf16* hid2; bf16* moeDownT;
    bf16* qk; bf16* uw; float* gc; bf16* x0T; bf16* uvT; int* qctr;
};
static inline WS make_ws(void* d_ws) {
    char* base = (char*)d_ws; size_t off = 0;
    auto take = [&](size_t bytes) { char* r = base + off; off += (bytes + 255) & ~(size_t)255; return r; };
    WS w;
    w.mod = (float*)take(2ul * 9 * 6144 * 4);
    w.rstd = (float*)take((size_t)T * 4);
    w.hyf1 = (float*)take(2 * (size_t)(S + LC) * 64 * 4);
    w.hyf2 = (float*)take(2 * (size_t)(S + LC) * 64 * 4);
    w.filt = (float*)take(2 * (size_t)(S + LC) * 512 * 4);
    w.gb = (float*)take((size_t)T * 16 * 4);
#ifdef HOST_SIM
    w.scores = (float*)take((size_t)T * 32 * 4); w.topi = (int*)take((size_t)T * 4 * 4);
#else
    w.scores = nullptr; w.topi = nullptr;
#endif
    w.topw = (float*)take((size_t)T * 4 * 4);
    w.winT = (bf16*)take(2ul * 3328 * 1024 * 2);
    w.woutT = (bf16*)take(2ul * 1024 * 1024 * 2);
    w.wrT = (bf16*)take(2ul * 32 * 1024 * 2);
    w.rope = (float*)take(64 * 16 * 2 * 4);
    w.bar = (unsigned*)take(4096 * 4);
    w.cnt = (int*)take(4 * 32 * 32 * 4);
    w.list = (int*)take((size_t)32 * T * 4);
    w.qctr = (int*)take(64 * 64 * 4);
    w.xr = (float*)take((size_t)T * D * 4);
    w.h = (bf16*)take((size_t)T * D * 2);
    w.p = (bf16*)take((size_t)T * DIN * 2);
    w.hid = (bf16*)w.p;
    char* R = take(0);
    const size_t szUp = 33ul * 512 * 1024 * 2, szHid = ((size_t)5 * T + 256) * 256 * 2, szDown = 33ul * 1024 * 256 * 2;
    w.moeUpT = (bf16*)R; w.hid2 = (bf16*)(R + szUp); w.moeDownT = (bf16*)(R + szUp + szHid);
    w.qkv = (bf16*)R;
    w.qk = (bf16*)R;
    w.ycat = w.hid2;
    w.o = (bf16*)((char*)w.ycat + (size_t)T * 1024 * 2);
    w.x0T = (bf16*)((char*)w.ycat + (size_t)T * 1024 * 2);
    w.uvT = w.x0T + (size_t)256 * B * S;
    w.uv = w.uvT + (size_t)256 * B * S;
    w.uw = w.h; w.gc = w.gb;
    size_t rsz = szUp + szHid + szDown; const size_t rsz2 = szUp + (size_t)T * 1024 * 2 + (size_t)2 * 256 * B * S * 2 + (size_t)T * 256 * 2;
    if (rsz2 > rsz) rsz = rsz2;
    (void)take(rsz);
    return w;
}
#ifdef HOST_SIM
template <class F> static inline void run(F f, long n, hipStream_t) {
#pragma omp parallel for schedule(dynamic, 256)
    for (long i = 0; i < n; ++i) f(i);
}
#endif

struct Inputs {
    const float *x, *c, *ctx, *c_ctx, *w_ada, *b_ada, *norm1, *norm2, *norm_f, *w_in, *w_out, *hy_conv, *hy_w1, *hy_b1, *hy_w2, *hy_b2, *hy_w3, *hy_freq, *hy_bias,
        *wa_sink, *na_rpb, *gdn_conv, *gdn_a_log, *gdn_dt_bias, *gdn_norm, *moe_router, *moe_bias, *moe_gate, *moe_up, *moe_down, *sh_gate, *sh_up, *sh_down;
};

#ifdef HOST_SIM
static void forward_naive(const Inputs& in, float* out, const WS& w, hipStream_t st) {
    run(NkCopyX{in.x, in.ctx, w.xr}, NkCopyX::count(), st);
    run(NkAda{in.c, in.c_ctx, in.w_ada, in.b_ada, w.mod}, NkAda::count(), st);
    for (int l = 0; l < 2; ++l) {
        const bool need_ctx = l == 0;
        const float* mod = w.mod + (size_t)l * 9 * 6144;
        run(NkRstd{w.xr, w.rstd, T}, T, st);
        run(NkModNorm{w.xr, w.rstd, in.norm1 + l * D, mod, 0, 1, w.h}, (long)T * D, st);
        run(NkInProj{w.h, in.w_in + (size_t)l * D * DIN, w.p}, NkInProj::count(), st);
        run(NkRope{w.p}, NkRope::count(), st);
        run(NkHyF1{in.hy_w1 + l * 33 * 64, in.hy_b1 + l * 64, in.hy_freq + l * 64, w.hyf1}, NkHyF1::count(), st);
        run(NkHyF2{in.hy_w2 + l * 64 * 64, in.hy_b2 + l * 64, in.hy_freq + l * 64, w.hyf1, w.hyf2}, NkHyF2::count(), st);
        run(NkHyF3{in.hy_w3 + l * 64 * 512, w.hyf2, w.filt}, NkHyF3::count(), st);
        const float* hcw = in.hy_conv + l * 3 * 768;
        run(NkHyUV{w.p, hcw, w.uv, 0, TL, S}, (long)TL * 256, st);
        run(NkHyConv{w.p, hcw, w.uv, w.filt, in.hy_bias + l * 256, w.ycat, 0, S, 0}, (long)TL * 256, st);
        if (need_ctx) {
            run(NkHyUV{w.p, hcw, w.uv, TL, TC, LC}, (long)TC * 256, st);
            run(NkHyConv{w.p, hcw, w.uv, w.filt, in.hy_bias + l * 256, w.ycat, TL, LC, S}, (long)TC * 256, st);
        }
        run(NkWA{w.p, in.wa_sink + l * 4, w.ycat}, NkWA::count(), st);
        if (need_ctx) run(NkWACtx{w.p, in.wa_sink + l * 4, w.ycat}, NkWACtx::count(), st);
        run(NkNA{w.p, in.na_rpb + l * 4 * 15 * 31, w.ycat}, NkNA::count(), st);
        if (need_ctx) run(NkNACtx{w.p, w.ycat}, NkNACtx::count(), st);
        run(NkGdnPrep{w.p, in.gdn_conv + l * 4 * 768, w.qkv}, NkGdnPrep::count(), st);
        run(NkGdnGate{w.p, in.gdn_a_log + l * 8, in.gdn_dt_bias + l * 8, w.gb}, NkGdnGate::count(), st);
        run(NkGdnRec{w.qkv, w.gb, w.o}, NkGdnRec::count(), st);
        run(NkGdnFin{w.p, w.o, in.gdn_norm + l * 64, w.ycat}, need_ctx ? (long)T * 256 : (long)TL * 256, st);
        const long ntok = need_ctx ? T : TL;
        run(NkOutProj{w.ycat, in.w_out + (size_t)l * 1024 * D, mod, w.xr, ntok}, ntok * D, st);
        run(NkRstd{w.xr, w.rstd, (int)ntok}, ntok, st);
        run(NkModNorm{w.xr, w.rstd, in.norm2 + l * D, mod, 3, 4, w.h}, ntok * D, st);
        run(NkRouter{w.h, in.moe_router + l * D * 32, w.scores}, ntok * 32, st);
        run(NkTopK{w.scores, in.moe_bias + l * 32, w.topi, w.topw}, ntok, st);
        run(NkMoeHid{w.h, w.topi, in.moe_gate + (size_t)l * 32 * D * 256, in.moe_up + (size_t)l * 32 * D * 256, in.sh_gate + (size_t)l * D * 256, in.sh_up + (size_t)l * D * 256, w.hid}, ntok * 1280, st);
        run(NkMoeOut{w.hid, w.topi, w.topw, in.moe_down + (size_t)l * 32 * 256 * D, in.sh_down + (size_t)l * 256 * D, mod, w.xr}, ntok * D, st);
    }
    run(NkRstd{w.xr, w.rstd, TL}, TL, st);
    run(NkFinal{w.xr, w.rstd, in.norm_f, out}, NkFinal::count(), st);
}


#endif
#ifdef HOST_SIM
extern "C" void kernel_launch(void* const* d_in, const int* in_sizes, int n_in, void* d_out, int out_size, void* d_ws, size_t ws_size, hipStream_t stream) {
    Inputs in;
    const float** ip = (const float**)&in;
    for (int i = 0; i < 33; ++i) ip[i] = (const float*)d_in[i];
    WS w = make_ws(d_ws);
    forward_naive(in, (float*)d_out, w, stream);
}

#endif
#ifndef HOST_SIM
#define XB_TMO      128
#define XB_XCNT(j)  (256  + 64 * (j))
#define XB_XSUB(j)  (1280 + 64 * (j))
#define XB_XGEN(j)  (2304 + 64 * (j))
#define XB_TOP      3328
#define XB_TOPGEN   3392
#define XCD_BAR_WORDS 3456
#define XB_SPIN_CAP (1u << 26)
#define LAS __attribute__((address_space(3)))
__device__ __forceinline__ unsigned xb_ld(unsigned* p)              { return __hip_atomic_load(p, __ATOMIC_RELAXED, __HIP_MEMORY_SCOPE_AGENT); }
__device__ __forceinline__ unsigned xb_add(unsigned* p, unsigned v) { return __hip_atomic_fetch_add(p, v, __ATOMIC_RELAXED, __HIP_MEMORY_SCOPE_AGENT); }
__device__ __forceinline__ unsigned xb_xcc_id() { return (unsigned)__builtin_amdgcn_s_getreg((3 << 11) | 20) & 0xFu; }
#define XB_SPIN(cond, bar) do { unsigned _sp = 0; while (cond) { __builtin_amdgcn_s_sleep(1); \
    if ((++_sp & 255u) == 0u) { if (xb_ld(&(bar)[XB_TMO])) break; if (_sp > XB_SPIN_CAP) { atomicAdd(&(bar)[XB_TMO], 1u); break; } } } } while (0)
struct XcdBarrier { unsigned* bar; unsigned x; volatile LAS unsigned* st; };
__device__ __forceinline__ XcdBarrier xcd_barrier_post(unsigned* bar, volatile LAS unsigned* st) {
    XcdBarrier b; b.bar = bar; b.x = xb_xcc_id(); b.st = st;
    if (threadIdx.x == 0) (void)xb_add(&bar[XB_XCNT(b.x)], 1u);
    return b;
}
__device__ __forceinline__ void xcd_barrier_complete(unsigned* bar, unsigned x, unsigned& nloc, unsigned& nx) {
    const unsigned G = gridDim.x * gridDim.y * gridDim.z;
    unsigned sum, cnt, mine, sp = 0u;
    for (;;) {
        sum = 0u; cnt = 0u; mine = 0u;
#pragma unroll
        for (unsigned j = 0; j < 16; ++j) { const unsigned c = xb_ld(&bar[XB_XCNT(j)]); sum += c; cnt += (c > 0u) ? 1u : 0u; mine = (j == x) ? c : mine; }
        if (sum == G) break;
        __builtin_amdgcn_s_sleep(1);
        if ((++sp & 255u) == 0u) { if (xb_ld(&bar[XB_TMO])) break; if (sp > XB_SPIN_CAP) { atomicAdd(&bar[XB_TMO], 1u); break; } }
    }
    nloc = mine > 0u ? mine : 1u; nx = cnt > 0u ? cnt : 1u;
}
__device__ __forceinline__ void xcd_barrier(const XcdBarrier& b) {
    asm volatile("s_waitcnt vmcnt(0)" ::: "memory");
    __syncthreads();
    if (threadIdx.x == 0) {
        unsigned* bar = b.bar;
        __builtin_amdgcn_s_waitcnt(0);
        unsigned nloc = b.st[0], nx = b.st[1];
        if (nloc == 0u) { xcd_barrier_complete(bar, b.x, nloc, nx); b.st[0] = nloc; b.st[1] = nx; }
        const unsigned old = xb_add(&bar[XB_XSUB(b.x)], 1u);
        const unsigned gen = old / nloc;
        if (old + 1u == (gen + 1u) * nloc) {
            __builtin_amdgcn_fence(__ATOMIC_RELEASE, "agent");
            asm volatile("s_waitcnt vmcnt(0)" ::: "memory");
            const unsigned og = xb_add(&bar[XB_TOP], 1u);
            const unsigned tg = og / nx;
            if (og + 1u == (tg + 1u) * nx) xb_add(&bar[XB_TOPGEN], 1u);
            else XB_SPIN(xb_ld(&bar[XB_TOPGEN]) == tg, bar);
            __builtin_amdgcn_fence(__ATOMIC_ACQUIRE, "agent");
            xb_add(&bar[XB_XGEN(b.x)], 1u);
            asm volatile("s_waitcnt vmcnt(0)" ::: "memory");
        } else {
            XB_SPIN(xb_ld(&bar[XB_XGEN(b.x)]) == gen, bar);
            __builtin_amdgcn_fence(__ATOMIC_ACQUIRE, "agent");
            asm volatile("s_waitcnt vmcnt(0)" ::: "memory");
        }
    }
    __syncthreads();
}
#endif
#ifndef HOST_SIM
typedef short bf16x8 __attribute__((ext_vector_type(8)));
typedef float f32x16 __attribute__((ext_vector_type(16)));
typedef float f32x4 __attribute__((ext_vector_type(4)));
typedef unsigned u32x4 __attribute__((ext_vector_type(4)));
typedef unsigned u32x2 __attribute__((ext_vector_type(2)));
#define NTHREADS 512

__device__ __forceinline__ void st_wt8(void* p, u32x2 v) { __hip_atomic_store((unsigned long long*)p, ((unsigned long long)v.y << 32) | v.x, __ATOMIC_RELAXED, __HIP_MEMORY_SCOPE_AGENT); }
__device__ __forceinline__ void st_wt16(void* p, f32x4 v) { asm volatile("global_store_dwordx4 %0, %1, off sc1\n\ts_nop 1" :: "v"(p), "v"(v) : "memory"); }
typedef __bf16 bf16x2n __attribute__((ext_vector_type(2)));
typedef float f32x2n __attribute__((ext_vector_type(2)));
__device__ __forceinline__ unsigned pack_bf16(float lo, float hi) { f32x2n f = {lo, hi}; bf16x2n r = __builtin_convertvector(f, bf16x2n); return __builtin_bit_cast(unsigned, r); }

constexpr int GBM = 256, GBN = 128, GBK = 64;
constexpr int G_ASTAGE = GBM * GBK * 2, G_BSTAGE = GBN * GBK * 2, G_STAGE = G_ASTAGE + G_BSTAGE;
constexpr int G_LDS = 2 * G_STAGE;
__device__ __forceinline__ int g_lds_off(int r, int c) { return r * 128 + ((c ^ ((r >> 1) & 7)) << 4); }

template <class ARow, class Epi>
__device__ __forceinline__ void gemm_tile(char* lds, const ARow& arow, const bf16* __restrict__ Bt, int ldb, int K, int m0, int n0, const Epi& epi) {
    int tid = threadIdx.x; asm volatile("" : "+v"(tid));
    const int lane = tid & 63, wid = __builtin_amdgcn_readfirstlane(tid >> 6), wm = wid >> 1, wn = wid & 1;
    const bf16* ap[4]; const bf16* bp[2];
#pragma unroll
    for (int j = 0; j < 4; ++j) { const int r = 8 * (wid * 4 + j) + (lane >> 3); ap[j] = arow(r) + 8 * ((lane & 7) ^ ((r >> 1) & 7)); }
#pragma unroll
    for (int j = 0; j < 2; ++j) { const int r = 8 * (wid * 2 + j) + (lane >> 3); bp[j] = Bt + (size_t)(n0 + r) * ldb + 8 * ((lane & 7) ^ ((r >> 1) & 7)); }
    f32x16 acc[2][2];
#pragma unroll
    for (int a = 0; a < 2; ++a)
#pragma unroll
        for (int b = 0; b < 2; ++b)
#pragma unroll
            for (int r = 0; r < 16; ++r) acc[a][b][r] = 0.f;
    const int nk = K / GBK;
    __syncthreads();
#define G_DMA(kt_, stage_) do { \
        _Pragma("unroll") for (int j = 0; j < 4; ++j) __builtin_amdgcn_global_load_lds((const unsigned*)(ap[j] + (kt_) * GBK), (LAS unsigned*)((stage_) + (wid * 4 + j) * 1024), 16, 0, 0); \
        _Pragma("unroll") for (int j = 0; j < 2; ++j) __builtin_amdgcn_global_load_lds((const unsigned*)(bp[j] + (kt_) * GBK), (LAS unsigned*)((stage_) + G_ASTAGE + (wid * 2 + j) * 1024), 16, 0, 0); } while (0)
    G_DMA(0, lds);
    __syncthreads();
    const int fr = lane & 31, fh = lane >> 5;
    for (int kt = 0; kt < nk; ++kt) {
        char* cur = lds + (kt & 1) * G_STAGE;
        if (kt + 1 < nk) { char* nxt = lds + ((kt + 1) & 1) * G_STAGE; G_DMA(kt + 1, nxt); }
#pragma unroll
        for (int kk = 0; kk < 4; ++kk) {
            bf16x8 fa[2], fb[2];
#pragma unroll
            for (int mi = 0; mi < 2; ++mi) fa[mi] = *(const bf16x8*)(cur + g_lds_off(wm * 64 + mi * 32 + fr, kk * 2 + fh));
#pragma unroll
            for (int ni = 0; ni < 2; ++ni) fb[ni] = *(const bf16x8*)(cur + G_ASTAGE + g_lds_off(wn * 64 + ni * 32 + fr, kk * 2 + fh));
#pragma unroll
            for (int mi = 0; mi < 2; ++mi)
#pragma unroll
                for (int ni = 0; ni < 2; ++ni) acc[mi][ni] = __builtin_amdgcn_mfma_f32_32x32x16_bf16(fb[ni], fa[mi], acc[mi][ni], 0, 0, 0);
        }
        __syncthreads();
    }
#undef G_DMA
    epi(acc, m0 + wm * 64 + fr, n0 + wn * 64 + 4 * fh);
}


constexpr int G_LDS3 = 3 * G_STAGE;
struct GPtrs { const bf16* a[4]; const bf16* b[2]; };
template <class TL> __device__ __forceinline__ void g_ptrs(const TL& tl, const typename TL::Tile& t, int wid, int lane, GPtrs& P) {
#pragma unroll
    for (int j = 0; j < 4; ++j) { const int r = 8 * (wid * 4 + j) + (lane >> 3); P.a[j] = tl.arow(t, r) + 8 * ((lane & 7) ^ ((r >> 1) & 7)); }
#pragma unroll
    for (int j = 0; j < 2; ++j) { const int r = 8 * (wid * 2 + j) + (lane >> 3); P.b[j] = tl.brow(t, r) + 8 * ((lane & 7) ^ ((r >> 1) & 7)); }
}
__device__ __forceinline__ void g_dma(char* lds, const GPtrs& P, int kt, int stage, int wid) {
    char* st = lds + stage * G_STAGE;
#pragma unroll
    for (int j = 0; j < 4; ++j) __builtin_amdgcn_global_load_lds((const unsigned*)(P.a[j] + kt * GBK), (LAS unsigned*)(st + (wid * 4 + j) * 1024), 16, 0, 0);
#pragma unroll
    for (int j = 0; j < 2; ++j) __builtin_amdgcn_global_load_lds((const unsigned*)(P.b[j] + kt * GBK), (LAS unsigned*)(st + G_ASTAGE + (wid * 2 + j) * 1024), 16, 0, 0);
}
template <class TL, int XF = 0>
__device__ __forceinline__ void gemm_stream(char* lds, const TL& tl) {
    int tid = threadIdx.x; asm volatile("" : "+v"(tid));
    const int lane = tid & 63, wid = __builtin_amdgcn_readfirstlane(tid >> 6), wm = wid >> 1, wn = wid & 1, fr = lane & 31, fh = lane >> 5;
    constexpr int nk = TL::K / GBK;
    static_assert(nk >= 2, "K too small");
    int idx = blockIdx.x;
    typename TL::Tile cur, nxt;
    if (!tl.tile(idx, cur)) return;
    GPtrs P, Pn;
    g_ptrs(tl, cur, wid, lane, P);
    bool has_next = tl.tile(idx + (int)gridDim.x, nxt);
    if (has_next) g_ptrs(tl, nxt, wid, lane, Pn);
    __syncthreads();
    if (!(XF & 1)) { g_dma(lds, P, 0, 0, wid); g_dma(lds, P, 1, 1, wid); }
    int sg = 0;
    for (;;) {
        f32x16 acc[2][2];
#pragma unroll
        for (int a = 0; a < 2; ++a)
#pragma unroll
            for (int b = 0; b < 2; ++b)
#pragma unroll
                for (int r = 0; r < 16; ++r) acc[a][b][r] = 0.f;
        for (int kt = 0; kt < nk; ++kt) {
            if (!(XF & 2)) { if (kt + 1 < nk || has_next) asm volatile("s_waitcnt vmcnt(6)" ::: "memory"); else asm volatile("s_waitcnt vmcnt(0)" ::: "memory");
            __builtin_amdgcn_s_barrier(); }
            asm volatile("" ::: "memory");
            const int s2 = sg >= 1 ? sg - 1 : 2;
            if (!(XF & 1)) { if (kt + 2 < nk) g_dma(lds, P, kt + 2, s2, wid);
            else if (has_next) g_dma(lds, Pn, kt + 2 - nk, s2, wid); }
            const char* cs = lds + sg * G_STAGE;
#pragma unroll
            for (int kk = 0; kk < 4; ++kk) {
                bf16x8 fa[2], fb[2];
#pragma unroll
                for (int mi = 0; mi < 2; ++mi) fa[mi] = *(const bf16x8*)(cs + g_lds_off(wm * 64 + mi * 32 + fr, kk * 2 + fh));
#pragma unroll
                for (int ni = 0; ni < 2; ++ni) fb[ni] = *(const bf16x8*)(cs + G_ASTAGE + g_lds_off(wn * 64 + ni * 32 + fr, kk * 2 + fh));
#pragma unroll
                for (int mi = 0; mi < 2; ++mi)
#pragma unroll
                    for (int ni = 0; ni < 2; ++ni) acc[mi][ni] = __builtin_amdgcn_mfma_f32_32x32x16_bf16(fb[ni], fa[mi], acc[mi][ni], 0, 0, 0);
            }
            sg = sg == 2 ? 0 : sg + 1;
        }
        tl.epi(cur, acc, wm * 64 + fr, wn * 64 + 4 * fh);
        if (!has_next) break;
        asm volatile("s_waitcnt vmcnt(0)" ::: "memory");
        cur = nxt; P = Pn; idx += (int)gridDim.x;
        has_next = tl.tile(idx + (int)gridDim.x, nxt);
        if (has_next) g_ptrs(tl, nxt, wid, lane, Pn);
    }
    asm volatile("s_waitcnt vmcnt(0)" ::: "memory");
}

constexpr int HBK = 32, H_ASTG = 256 * HBK * 2, H_STG = 2 * H_ASTG, H_RING = 4, H_LDS = H_RING * H_STG;
__device__ __forceinline__ int h_lds_off(int r, int c) { return r * 64 + ((c ^ ((r >> 2) & 3)) << 4); }
struct HPtrs { const bf16* a[2]; const bf16* b[2]; };
template <class TL> __device__ __forceinline__ void h_ptrs(const TL& tl, const typename TL::Tile& t, int wid, int lane, HPtrs& P) {
#pragma unroll
    for (int j = 0; j < 2; ++j) { const int r = 16 * (wid * 2 + j) + (lane >> 2); const int c = (lane & 3) ^ ((r >> 2) & 3); P.a[j] = tl.arow(t, r) + 8 * c; P.b[j] = tl.brow(t, r) + 8 * c; }
}
__device__ __forceinline__ void h_dma(char* lds, const HPtrs& P, int kt, int stage, int wid) {
    char* st = lds + stage * H_STG;
#pragma unroll
    for (int j = 0; j < 2; ++j) __builtin_amdgcn_global_load_lds((const unsigned*)(P.a[j] + kt * HBK), (LAS unsigned*)(st + (wid * 2 + j) * 1024), 16, 0, 0);
#pragma unroll
    for (int j = 0; j < 2; ++j) __builtin_amdgcn_global_load_lds((const unsigned*)(P.b[j] + kt * HBK), (LAS unsigned*)(st + H_ASTG + (wid * 2 + j) * 1024), 16, 0, 0);
}
template <class TL>
__device__ __forceinline__ void gemm_stream256(char* lds, const TL& tl) {
    int tid = threadIdx.x; asm volatile("" : "+v"(tid));
    const int lane = tid & 63, wid = __builtin_amdgcn_readfirstlane(tid >> 6), wm = wid >> 1, wn = wid & 1, fr = lane & 31, fh = lane >> 5;
    constexpr int nk = TL::K / HBK;
    static_assert(nk >= 4, "K too small");
    int idx = blockIdx.x;
    typename TL::Tile cur, nxt;
    if (!tl.tile(idx, cur)) return;
    HPtrs P, Pn;
    h_ptrs(tl, cur, wid, lane, P);
    bool has_next = tl.tile(idx + (int)gridDim.x, nxt);
    if (has_next) h_ptrs(tl, nxt, wid, lane, Pn);
    asm volatile("s_waitcnt vmcnt(0)" ::: "memory");
    __syncthreads();
    h_dma(lds, P, 0, 0, wid); h_dma(lds, P, 1, 1, wid); h_dma(lds, P, 2, 2, wid);
    int sg = 0;
    for (;;) {
        f32x16 acc[2][4];
#pragma unroll
        for (int a = 0; a < 2; ++a)
#pragma unroll
            for (int b = 0; b < 4; ++b)
#pragma unroll
                for (int r = 0; r < 16; ++r) acc[a][b][r] = 0.f;
        const unsigned act = tl.active(cur, wn);
        for (int kt = 0; kt < nk; ++kt) {
            const int ahead = (nk - 1 - kt) + (has_next ? 3 : 0);
            if (ahead >= 2) asm volatile("s_waitcnt vmcnt(8)" ::: "memory"); else if (ahead == 1) asm volatile("s_waitcnt vmcnt(4)" ::: "memory"); else asm volatile("s_waitcnt vmcnt(0)" ::: "memory");
            __builtin_amdgcn_s_barrier();
            asm volatile("" ::: "memory");
            const int s3 = (sg + 3) & 3;
            if (kt + 3 < nk) h_dma(lds, P, kt + 3, s3, wid);
            else if (has_next) h_dma(lds, Pn, kt + 3 - nk, s3, wid);
            const char* cs = lds + sg * H_STG;
#pragma unroll
            for (int kk = 0; kk < 2; ++kk) {
                bf16x8 fa[2], fb[4];
#pragma unroll
                for (int mi = 0; mi < 2; ++mi) fa[mi] = *(const bf16x8*)(cs + h_lds_off(wm * 64 + mi * 32 + fr, kk * 2 + fh));
#pragma unroll
                for (int ni = 0; ni < 4; ++ni) fb[ni] = *(const bf16x8*)(cs + H_ASTG + h_lds_off(wn * 128 + ni * 32 + fr, kk * 2 + fh));
#pragma unroll
                for (int ni = 0; ni < 4; ++ni)
                    if (act & (1u << ni)) {
#pragma unroll
                        for (int mi = 0; mi < 2; ++mi) acc[mi][ni] = __builtin_amdgcn_mfma_f32_32x32x16_bf16(fb[ni], fa[mi], acc[mi][ni], 0, 0, 0);
                    }
            }
            sg = (sg + 1) & 3;
        }
        tl.epi(cur, acc, wm * 64 + fr, wn * 128 + 4 * fh);
        if (!has_next) break;
        asm volatile("s_waitcnt vmcnt(0)" ::: "memory");
        cur = nxt; P = Pn; idx += (int)gridDim.x;
        has_next = tl.tile(idx + (int)gridDim.x, nxt);
        if (has_next) h_ptrs(tl, nxt, wid, lane, Pn);
    }
    asm volatile("s_waitcnt vmcnt(0)" ::: "memory");
}

struct ARowDense { const bf16* A; int lda; int m0; __device__ __forceinline__ const bf16* operator()(int i) const { return A + (size_t)(m0 + i) * lda; } };

struct EpiInProj {
    bf16* p; const float* rope;
    __device__ __forceinline__ void operator()(f32x16 (&acc)[2][2], int mrow, int ncol) const {
#pragma unroll
        for (int mi = 0; mi < 2; ++mi) {
            const int m = mrow + mi * 32;
#pragma unroll
            for (int ni = 0; ni < 2; ++ni) {
                const int nb = ncol + ni * 32;
                if (nb >= O1 && nb < O1 + 384 && m < TL) {
                    const int s = m & (S - 1); const int pos = ni == 0 ? (s >> 6) : (s & 63);
                    const int jb = (nb & 31);
#pragma unroll
                    for (int r = 0; r < 8; ++r) {
                        const int j = jb + (r & 3) + 8 * (r >> 2);
                        const float cs = rope[(pos * 16 + j) * 2], sn = rope[(pos * 16 + j) * 2 + 1];
                        const float x1 = acc[mi][ni][r], x2 = acc[mi][ni][r + 8];
                        acc[mi][ni][r] = x1 * cs - x2 * sn; acc[mi][ni][r + 8] = x1 * sn + x2 * cs;
                    }
                }
#pragma unroll
                for (int g = 0; g < 4; ++g) {
                    const int n = nb + 8 * g;
                    if (n < DIN) {
                        u32x2 v; v.x = pack_bf16(acc[mi][ni][4 * g], acc[mi][ni][4 * g + 1]); v.y = pack_bf16(acc[mi][ni][4 * g + 2], acc[mi][ni][4 * g + 3]);
                        *(u32x2*)(p + (size_t)m * DIN + n) = v;
                    }
                }
            }
        }
    }
};

struct EpiInProjH {
    bf16* p; const float* rope;
    __device__ __forceinline__ void operator()(f32x16 (&acc)[2][4], int mrow, int ncol) const {
#pragma unroll
        for (int mi = 0; mi < 2; ++mi) {
            const int m = mrow + mi * 32;
#pragma unroll
            for (int ni = 0; ni < 4; ++ni) {
                const int nb = ncol + ni * 32;
                if (nb >= DIN) continue;
                if (nb >= O1 && nb < O1 + 384 && m < TL) {
                    const int s = m & (S - 1); const int pos = (ni & 1) == 0 ? (s >> 6) : (s & 63);
                    const int jb = (nb & 31);
#pragma unroll
                    for (int r = 0; r < 8; ++r) {
                        const int j = jb + (r & 3) + 8 * (r >> 2);
                        const float cs = rope[(pos * 16 + j) * 2], sn = rope[(pos * 16 + j) * 2 + 1];
                        const float x1 = acc[mi][ni][r], x2 = acc[mi][ni][r + 8];
                        acc[mi][ni][r] = x1 * cs - x2 * sn; acc[mi][ni][r + 8] = x1 * sn + x2 * cs;
                    }
                }
#pragma unroll
                for (int g = 0; g < 4; ++g) {
                    const int n = nb + 8 * g;
                    if (n < DIN) { u32x2 v; v.x = pack_bf16(acc[mi][ni][4 * g], acc[mi][ni][4 * g + 1]); v.y = pack_bf16(acc[mi][ni][4 * g + 2], acc[mi][ni][4 * g + 3]); *(u32x2*)(p + (size_t)m * DIN + n) = v; }
                }
            }
        }
    }
};
struct EpiOutProjH {
    float* xr; const float* mod;
    __device__ __forceinline__ void operator()(f32x16 (&acc)[2][4], int mrow, int ncol) const {
#pragma unroll
        for (int mi = 0; mi < 2; ++mi) {
            const int m = mrow + mi * 32; const int rb = m < TL ? m / S : 8;
            const float* g1 = mod + (size_t)rb * 6144 + 2 * D;
#pragma unroll
            for (int ni = 0; ni < 4; ++ni)
#pragma unroll
                for (int g = 0; g < 4; ++g) {
                    const int n = ncol + ni * 32 + 8 * g;
                    f32x4 gv = *(const f32x4*)(g1 + n); float* xp = xr + (size_t)m * D + n; f32x4 xv = *(const f32x4*)xp;
                    xv[0] += gv[0] * acc[mi][ni][4 * g]; xv[1] += gv[1] * acc[mi][ni][4 * g + 1]; xv[2] += gv[2] * acc[mi][ni][4 * g + 2]; xv[3] += gv[3] * acc[mi][ni][4 * g + 3];
                    *(f32x4*)xp = xv;
                }
        }
    }
};
struct EpiOutProj {
    float* xr; const float* mod;
    __device__ __forceinline__ void operator()(f32x16 (&acc)[2][2], int mrow, int ncol) const {
#pragma unroll
        for (int mi = 0; mi < 2; ++mi) {
            const int m = mrow + mi * 32; const int rb = m < TL ? m / S : 8;
            const float* g1 = mod + (size_t)rb * 6144 + 2 * D;
#pragma unroll
            for (int ni = 0; ni < 2; ++ni)
#pragma unroll
                for (int g = 0; g < 4; ++g) {
                    const int n = ncol + ni * 32 + 8 * g;
                    f32x4 gv = *(const f32x4*)(g1 + n); float* xp = xr + (size_t)m * D + n; f32x4 xv = *(const f32x4*)xp;
                    xv[0] += gv[0] * acc[mi][ni][4 * g]; xv[1] += gv[1] * acc[mi][ni][4 * g + 1]; xv[2] += gv[2] * acc[mi][ni][4 * g + 2]; xv[3] += gv[3] * acc[mi][ni][4 * g + 3];
                    *(f32x4*)xp = xv;
                }
        }
    }
};
#endif
#ifndef HOST_SIM
template <class NMap>
__device__ __forceinline__ void cvt_tile(char* lds, const float* __restrict__ src, int srcN, bf16* __restrict__ dst, int dstK, int k0, int n0, int nvalid  , int nrows  , const NMap& nmap) {
    int tid = threadIdx.x; asm volatile("" : "+v"(tid));
    bf16* t = (bf16*)lds;
    __syncthreads();
#pragma unroll
    for (int i = 0; i < 2; ++i) {
        const int c = tid + i * NTHREADS, k = c >> 4, n4 = (c & 15) * 4;
        f32x4 v = {0.f, 0.f, 0.f, 0.f};
        if (n0 + n4 < nvalid) v = *(const f32x4*)(src + (size_t)(k0 + k) * srcN + n0 + n4);
#pragma unroll
        for (int q = 0; q < 4; ++q) t[(n4 + q) * 66 + k] = f2bf(v[q]);
    }
    __syncthreads();
    {
        const int n = tid >> 3, kc = tid & 7;
        if (n0 + n < nrows) {
            const unsigned* s = (const unsigned*)(t + n * 66 + kc * 8);
            u32x4 o; o.x = s[0]; o.y = s[1]; o.z = s[2]; o.w = s[3];
            *(u32x4*)(dst + (size_t)nmap(n0 + n) * dstK + k0 + kc * 8) = o;
        }
    }
}
struct NMapId { __device__ __forceinline__ int operator()(int n) const { return n; } };
struct NMapUp { int which; __device__ __forceinline__ int operator()(int j) const { return (j >> 7) * 256 + ((j >> 6) & 1) * 128 + which * 64 + (j & 63); } };
#endif
#ifndef HOST_SIM
__device__ __forceinline__ float wave_sum(float v) {
#pragma unroll
    for (int o = 32; o > 0; o >>= 1) v += __shfl_xor(v, o);
    return v;
}
template <int MODE, int NORM>
__device__ __forceinline__ void row_pass(const WS& w, const Inputs& in, int ntok, const float* mod_cur  , const float* mod_nrm  ,
                                         const float* gnorm, int shc, int scc, const bf16* y, const float* topw, float* out, bf16* hout) {
    int tid = threadIdx.x; asm volatile("" : "+v"(tid));
    const int lane = tid & 63, wv = tid >> 6;
    for (int t = blockIdx.x * 8 + wv; t < ntok; t += gridDim.x * 8) {
        const int rb = t < TL ? t / S : 8;
        f32x4 v[4];
        float* xrow = w.xr + (size_t)t * D;
        if (MODE == 0) {
            const float* src = t < TL ? in.x + (size_t)t * D : in.ctx + (size_t)(t - TL) * D;
#pragma unroll
            for (int j = 0; j < 4; ++j) { v[j] = *(const f32x4*)(src + j * 256 + lane * 4); st_wt16(xrow + j * 256 + lane * 4, v[j]); }
        } else {
#pragma unroll
            for (int j = 0; j < 4; ++j) v[j] = *(const f32x4*)(xrow + j * 256 + lane * 4);
        }
        if (MODE == 2) {
            const float* g2 = mod_cur + (size_t)rb * 6144 + 5 * D;
            f32x4 f[4];
#pragma unroll
            for (int j = 0; j < 4; ++j) f[j] = (f32x4){0.f, 0.f, 0.f, 0.f};
#pragma unroll
            for (int k = 0; k < 4; ++k) {
                const float wk = topw[(size_t)t * 4 + k]; const bf16* yr = y + ((size_t)t * 4 + k) * D;
#pragma unroll
                for (int j = 0; j < 4; ++j) { u32x2 u = *(const u32x2*)(yr + j * 256 + lane * 4);
                    f[j][0] += wk * __uint_as_float(u.x << 16); f[j][1] += wk * __uint_as_float(u.x & 0xffff0000u); f[j][2] += wk * __uint_as_float(u.y << 16); f[j][3] += wk * __uint_as_float(u.y & 0xffff0000u); }
            }
#pragma unroll
            for (int j = 0; j < 4; ++j) { f32x4 g = *(const f32x4*)(g2 + j * 256 + lane * 4); v[j] += g * f[j]; st_wt16(xrow + j * 256 + lane * 4, v[j]); }
        }
        if (NORM == 0) continue;
        if (NORM == 2 && t >= TL) continue;
        float ss = 0.f;
#pragma unroll
        for (int j = 0; j < 4; ++j) ss += v[j][0] * v[j][0] + v[j][1] * v[j][1] + v[j][2] * v[j][2] + v[j][3] * v[j][3];
        ss = wave_sum(ss);
        const float rstd = 1.0f / sqrtf(ss * (1.0f / D) + EPS);
        if (NORM == 1) {
            const float* m = mod_nrm + (size_t)rb * 6144;
#pragma unroll
            for (int j = 0; j < 4; ++j) {
                const int c = j * 256 + lane * 4;
                f32x4 g = *(const f32x4*)(gnorm + c), sc = *(const f32x4*)(m + scc * D + c), sh = *(const f32x4*)(m + shc * D + c);
                f32x4 hv = v[j] * rstd * g * (sc + 1.0f) + sh;
                u32x2 u; u.x = pack_bf16(hv[0], hv[1]); u.y = pack_bf16(hv[2], hv[3]);
                *(u32x2*)(hout + (size_t)t * D + c) = u;
            }
        } else {
#pragma unroll
            for (int j = 0; j < 4; ++j) { const int c = j * 256 + lane * 4; f32x4 g = *(const f32x4*)(gnorm + c); st_wt16(out + (size_t)t * D + c, v[j] * rstd * g); }
        }
    }
}

constexpr int CNT_PAD = 32;
__device__ __forceinline__ void phase_router(char* lds, const WS& w, const float* ebias, int ntok, int l) {
    int tid = threadIdx.x; asm volatile("" : "+v"(tid));
    const int lane = tid & 63, wv = tid >> 6, fr = lane & 15, fq = lane >> 4;
    float* sl = (float*)lds + wv * (16 * 33);
    int* lcnt = (int*)(lds + 8 * 16 * 33 * 4);
    const bf16* Bt = w.wrT + (size_t)l * 32 * 1024;
    int* cnt = w.cnt + l * 32 * CNT_PAD; int* list = w.list;
    for (int tb0 = blockIdx.x * 128; tb0 < ntok; tb0 += gridDim.x * 128) {
        const int t0 = tb0 + wv * 16;
        if (tid < 32) lcnt[tid] = 0;
        f32x4 a0 = {0.f, 0.f, 0.f, 0.f}, a1 = {0.f, 0.f, 0.f, 0.f};
        const bf16* ar = w.h + (size_t)(t0 + fr) * D + fq * 8;
        const bf16* b0 = Bt + (size_t)fr * 1024 + fq * 8; const bf16* b1 = b0 + 16 * 1024;
#pragma unroll 8
        for (int ks = 0; ks < 32; ++ks) {
            bf16x8 fa = *(const bf16x8*)(ar + ks * 32), fb0 = *(const bf16x8*)(b0 + ks * 32), fb1 = *(const bf16x8*)(b1 + ks * 32);
            a0 = __builtin_amdgcn_mfma_f32_16x16x32_bf16(fa, fb0, a0, 0, 0, 0);
            a1 = __builtin_amdgcn_mfma_f32_16x16x32_bf16(fa, fb1, a1, 0, 0, 0);
        }
#pragma unroll
        for (int j = 0; j < 4; ++j) { sl[(4 * fq + j) * 33 + fr] = a0[j]; sl[(4 * fq + j) * 33 + 16 + fr] = a1[j]; }
        __syncthreads();
        int sel[4]; int lpos[4];
        if (lane < 16) {
            const int t = t0 + lane; const float* sr = sl + lane * 33;
            float ss[4]; float sum = 0.f;
#pragma unroll
            for (int k = 0; k < 4; ++k) {
                int best = 0; float bv = -1e30f, bs = 0.f;
                for (int e = 0; e < 32; ++e) {
                    bool used = false;
#pragma unroll
                    for (int q = 0; q < 4; ++q) if (q < k && sel[q] == e) used = true;
                    const float sg = 1.0f / (1.0f + expf(-sr[e])); const float vv = sg + ebias[e];
                    if (!used && vv > bv) { bv = vv; best = e; bs = sg; }
                }
                sel[k] = best; ss[k] = bs; sum += bs;
            }
            const float inv = ROUTED_SCALE / sum;
#pragma unroll
            for (int k = 0; k < 4; ++k) { w.topw[(size_t)t * 4 + k] = ss[k] * inv; lpos[k] = atomicAdd(&lcnt[sel[k]], 1); }
        }
        __syncthreads();
        if (tid < 32) lcnt[32 + tid] = atomicAdd(&cnt[tid * CNT_PAD], lcnt[tid]);
        __syncthreads();
        if (lane < 16) {
            const int t = t0 + lane;
#pragma unroll
            for (int k = 0; k < 4; ++k) list[(size_t)sel[k] * T + lcnt[32 + sel[k]] + lpos[k]] = t * 4 + k;
        }
        __syncthreads();
    }
}

__device__ __forceinline__ bool moe_decode(int tile, int NT, const int* cnt, int ntok, int& e, int& mt, int& nt, int& base, int& rows) {
    int t = tile / NT; nt = tile % NT; int b = 0;
    for (int i = 0; i < 33; ++i) {
        const int c = i < 32 ? cnt[i * CNT_PAD] : ntok; const int m = (c + GBM - 1) / GBM;
        if (t < m) { e = i; mt = t; rows = c; base = b; return true; }
        t -= m; b += c;
    }
    return false;
}
struct ARowGather {
    const bf16* A; const int* list; int rows; int r0; bool ident;
    __device__ __forceinline__ const bf16* operator()(int i) const {
        const int idx = r0 + i; int tok = 0;
        if (idx < rows) tok = ident ? idx : (list[idx] >> 2);
        return A + (size_t)tok * D;
    }
};
struct EpiUp {
    bf16* hid; int base; int rows;
    __device__ __forceinline__ void operator()(f32x16 (&acc)[2][2], int mrow, int ncol) const {
        const int hc = (ncol >> 7) * 64 + ((ncol >> 6) & 1) * 32 + (ncol & 63);
#pragma unroll
        for (int mi = 0; mi < 2; ++mi) {
            const int idx = mrow + mi * 32;
            if (idx < rows) {
#pragma unroll
                for (int g = 0; g < 4; ++g) {
                    float o[4];
#pragma unroll
                    for (int q = 0; q < 4; ++q) { const float gt = acc[mi][0][4 * g + q], up = acc[mi][1][4 * g + q]; o[q] = gt / (1.0f + expf(-gt)) * up; }
                    u32x2 v; v.x = pack_bf16(o[0], o[1]); v.y = pack_bf16(o[2], o[3]);
                    *(u32x2*)(hid + (size_t)(base + idx) * 256 + hc + 8 * g) = v;
                }
            }
        }
    }
};
struct EpiDown {
    bf16* y; const int* list; int rows; bool shared; float* xr; const float* mod;
    __device__ __forceinline__ void operator()(f32x16 (&acc)[2][2], int mrow, int ncol) const {
#pragma unroll
        for (int mi = 0; mi < 2; ++mi) {
            const int idx = mrow + mi * 32;
            if (idx < rows) {
                if (!shared) {
                    const int asg = list[idx];
#pragma unroll
                    for (int ni = 0; ni < 2; ++ni)
#pragma unroll
                        for (int g = 0; g < 4; ++g) {
                            u32x2 v; v.x = pack_bf16(acc[mi][ni][4 * g], acc[mi][ni][4 * g + 1]); v.y = pack_bf16(acc[mi][ni][4 * g + 2], acc[mi][ni][4 * g + 3]);
                            *(u32x2*)(y + (size_t)asg * D + ncol + ni * 32 + 8 * g) = v;
                        }
                } else {
                    const int rb = idx < TL ? idx / S : 8; const float* g2 = mod + (size_t)rb * 6144 + 5 * D;
#pragma unroll
                    for (int ni = 0; ni < 2; ++ni)
#pragma unroll
                        for (int g = 0; g < 4; ++g) {
                            const int n = ncol + ni * 32 + 8 * g;
                            f32x4 gv = *(const f32x4*)(g2 + n); float* xp = xr + (size_t)idx * D + n; f32x4 xv = *(const f32x4*)xp;
                            xv[0] += gv[0] * acc[mi][ni][4 * g]; xv[1] += gv[1] * acc[mi][ni][4 * g + 1]; xv[2] += gv[2] * acc[mi][ni][4 * g + 2]; xv[3] += gv[3] * acc[mi][ni][4 * g + 3];
                            *(f32x4*)xp = xv;
                        }
                }
            }
        }
    }
};
struct EpiUpH {
    bf16* hid; int base; int rows;
    __device__ __forceinline__ void operator()(f32x16 (&acc)[2][4], int mrow, int ncol) const {
        const int hc = (ncol >> 8) * 128 + ((ncol >> 7) & 1) * 64 + (ncol & 127);
#pragma unroll
        for (int mi = 0; mi < 2; ++mi) {
            const int idx = mrow + mi * 32;
            if (idx < rows) {
#pragma unroll
                for (int nh = 0; nh < 2; ++nh)
#pragma unroll
                    for (int g = 0; g < 4; ++g) {
                        float o[4];
#pragma unroll
                        for (int q = 0; q < 4; ++q) { const float gt = acc[mi][nh][4 * g + q], up = acc[mi][nh + 2][4 * g + q]; o[q] = gt / (1.0f + __expf(-gt)) * up; }
                        u32x2 v; v.x = pack_bf16(o[0], o[1]); v.y = pack_bf16(o[2], o[3]);
                        *(u32x2*)(hid + (size_t)(base + idx) * 256 + hc + nh * 32 + 8 * g) = v;
                    }
            }
        }
    }
};
struct EpiDownH {
    bf16* y; const int* list; int rows; bool shared; float* xr; const float* mod;
    __device__ __forceinline__ void operator()(f32x16 (&acc)[2][4], int mrow, int ncol) const {
#pragma unroll
        for (int mi = 0; mi < 2; ++mi) {
            const int idx = mrow + mi * 32;
            if (idx < rows) {
                if (!shared) {
                    const int asg = list[idx];
#pragma unroll
                    for (int ni = 0; ni < 4; ++ni)
#pragma unroll
                        for (int g = 0; g < 4; ++g) {
                            u32x2 v; v.x = pack_bf16(acc[mi][ni][4 * g], acc[mi][ni][4 * g + 1]); v.y = pack_bf16(acc[mi][ni][4 * g + 2], acc[mi][ni][4 * g + 3]);
                            *(u32x2*)(y + (size_t)asg * D + ncol + ni * 32 + 8 * g) = v;
                        }
                } else {
                    const int rb = idx < TL ? idx / S : 8; const float* g2 = mod + (size_t)rb * 6144 + 5 * D;
#pragma unroll
                    for (int ni = 0; ni < 4; ++ni)
#pragma unroll
                        for (int g = 0; g < 4; ++g) {
                            const int n = ncol + ni * 32 + 8 * g;
                            f32x4 gv = *(const f32x4*)(g2 + n); float* xp = xr + (size_t)idx * D + n; f32x4 xv = *(const f32x4*)xp;
                            xv[0] += gv[0] * acc[mi][ni][4 * g]; xv[1] += gv[1] * acc[mi][ni][4 * g + 1]; xv[2] += gv[2] * acc[mi][ni][4 * g + 2]; xv[3] += gv[3] * acc[mi][ni][4 * g + 3];
                            *(f32x4*)xp = xv;
                        }
                }
            }
        }
    }
};
struct TLMoeUp {
    const WS* w; const int* cnt; int ntok; static constexpr int K = 1024;
    struct Tile { int e, mt, nt, base, rows; };
    __device__ __forceinline__ bool tile(int idx, Tile& t) const { return moe_decode(idx, 2, cnt, ntok, t.e, t.mt, t.nt, t.base, t.rows); }
    __device__ __forceinline__ unsigned active(const Tile&, int) const { return 15u; }
    __device__ __forceinline__ const bf16* arow(const Tile& t, int r) const {
        const int i = t.mt * GBM + r; int tok = 0;
        if (i < t.rows) tok = t.e == 32 ? i : (w->list[(size_t)t.e * T + i] >> 2);
        return w->h + (size_t)tok * D;
    }
    __device__ __forceinline__ const bf16* brow(const Tile& t, int r) const { return w->moeUpT + ((size_t)t.e * 512 + t.nt * 256 + r) * 1024; }
    __device__ __forceinline__ void epi(const Tile& t, f32x16 (&acc)[2][4], int mr, int nc) const { EpiUpH{w->hid2, t.base, t.rows}(acc, t.mt * GBM + mr, t.nt * 256 + nc); }
};
struct TLMoeDown {
    const WS* w; const int* cnt; int ntok; const float* mod; static constexpr int K = 256;
    struct Tile { int e, mt, nt, base, rows; };
    __device__ __forceinline__ bool tile(int idx, Tile& t) const { return moe_decode(idx, 4, cnt, ntok, t.e, t.mt, t.nt, t.base, t.rows); }
    __device__ __forceinline__ unsigned active(const Tile&, int) const { return 15u; }
    __device__ __forceinline__ const bf16* arow(const Tile& t, int r) const { return w->hid2 + (size_t)(t.base + t.mt * GBM + r) * 256; }
    __device__ __forceinline__ const bf16* brow(const Tile& t, int r) const { return w->moeDownT + ((size_t)t.e * 1024 + t.nt * 256 + r) * 256; }
    __device__ __forceinline__ void epi(const Tile& t, f32x16 (&acc)[2][4], int mr, int nc) const {
        EpiDownH{(bf16*)w->h, w->list + (size_t)t.e * T, t.rows, t.e == 32, w->xr, mod}(acc, t.mt * GBM + mr, t.nt * 256 + nc);
    }
};
struct TLMoeDownR : TLMoeDown {
    __device__ __forceinline__ bool tile(int idx, Tile& t) const { return moe_decode(idx, 4, cnt, ntok, t.e, t.mt, t.nt, t.base, t.rows) && t.e < 32; }
};
__device__ __forceinline__ void phase_moe_down_routed(char* lds, const WS& w, int l, int ntok, const float* mod) { TLMoeDownR tl; tl.w = &w; tl.cnt = w.cnt + l * 32 * CNT_PAD; tl.ntok = ntok; tl.mod = mod; gemm_stream256(lds, tl); }
__device__ __forceinline__ void phase_moe_up(char* lds, const WS& w, int l, int ntok) { gemm_stream256(lds, TLMoeUp{&w, w.cnt + l * 32 * CNT_PAD, ntok}); }
__device__ __forceinline__ void phase_moe_down(char* lds, const WS& w, int l, int ntok, const float* mod) { gemm_stream256(lds, TLMoeDown{&w, w.cnt + l * 32 * CNT_PAD, ntok, mod}); }
#endif
#ifndef HOST_SIM
__device__ __forceinline__ void phase_ada(char* lds, const WS& w, const Inputs& in) {
    int tid = threadIdx.x; asm volatile("" : "+v"(tid));
    const int lane = tid & 63, wv = tid >> 6;
    float* sc = (float*)lds;
    float* red = sc + 9 * 1024;
    if ((int)blockIdx.x >= 192) return;
    __syncthreads();
    for (int i = tid; i < 9 * 1024; i += NTHREADS) { const int r = i >> 10, k = i & 1023; const float v = r < 8 ? in.c[(size_t)(r % B) * D + k] : in.c_ctx[k]; sc[i] = v / (1.0f + __expf(-v)); }
    __syncthreads();
    for (int it = blockIdx.x; it < 192; it += gridDim.x) {
        const int l = it / 96, n = (it % 96) * 64 + lane;
        const float* wp = in.w_ada + (size_t)l * D * 6144 + (size_t)(wv * 128) * 6144 + n;
        float acc[9];
#pragma unroll
        for (int r = 0; r < 9; ++r) acc[r] = 0.f;
#pragma unroll 8
        for (int k = 0; k < 128; ++k) {
            const float wvv = wp[(size_t)k * 6144];
#pragma unroll
            for (int r = 0; r < 9; ++r) acc[r] += sc[r * 1024 + wv * 128 + k] * wvv;
        }
#pragma unroll
        for (int r = 0; r < 9; ++r) red[(wv * 9 + r) * 64 + lane] = acc[r];
        __syncthreads();
        for (int i = tid; i < 9 * 64; i += NTHREADS) {
            const int r = i >> 6, c = i & 63; float s = 0.f;
#pragma unroll
            for (int q = 0; q < 8; ++q) s += red[(q * 9 + r) * 64 + c];
            const int nn = (it % 96) * 64 + c;
            w.mod[((size_t)l * 9 + r) * 6144 + nn] = s + in.b_ada[l * 6144 + nn];
        }
        __syncthreads();
    }
}
#endif
#ifndef HOST_SIM
typedef short s16x4 __attribute__((ext_vector_type(4)));
constexpr int AT_KV = 64 * 128;
constexpr int AT_STAGE = 2 * AT_KV;
__device__ __forceinline__ int at_voff(int key, int dcol) { return key * 128 + ((((dcol >> 5) ^ ((key >> 1) & 1))) << 6) + ((dcol & 31) << 1); }
__device__ __forceinline__ int at_kappa(int r) { return (r & ~12) | ((r & 4) << 1) | ((r & 8) >> 1); }

struct AttnState { f32x16 o[2]; float m, l; };

__device__ __forceinline__ void at_qk(const char* st, const bf16x8 (&qf)[4], f32x16 (&s)[2], int lane) {
    const int fr = lane & 31, fh = lane >> 5, kr = at_kappa(fr);
#pragma unroll
    for (int tt = 0; tt < 2; ++tt) {
#pragma unroll
        for (int r = 0; r < 16; ++r) s[tt][r] = 0.f;
#pragma unroll
        for (int ks = 0; ks < 4; ++ks) {
            const bf16x8 kf = *(const bf16x8*)(st + g_lds_off(32 * tt + kr, ks * 2 + fh));
            s[tt] = __builtin_amdgcn_mfma_f32_32x32x16_bf16(kf, qf[ks], s[tt], 0, 0, 0);
        }
    }
}
__device__ __forceinline__ void at_softmax_pv(const char* st, f32x16 (&s)[2], AttnState& a, int lane) {
    float mx = -1e30f;
#pragma unroll
    for (int tt = 0; tt < 2; ++tt)
#pragma unroll
        for (int r = 0; r < 16; ++r) mx = fmaxf(mx, s[tt][r]);
    mx = fmaxf(mx, __shfl_xor(mx, 32));
    const float mn = fmaxf(a.m, mx), alpha = __builtin_amdgcn_exp2f(a.m - mn);
    float rs = 0.f;
#pragma unroll
    for (int tt = 0; tt < 2; ++tt)
#pragma unroll
        for (int r = 0; r < 16; ++r) { const float p = __builtin_amdgcn_exp2f(s[tt][r] - mn); s[tt][r] = p; rs += p; }
    rs += __shfl_xor(rs, 32);
    a.l = a.l * alpha + rs; a.m = mn;
#pragma unroll
    for (int dt = 0; dt < 2; ++dt)
#pragma unroll
        for (int r = 0; r < 16; ++r) a.o[dt][r] *= alpha;
    const int fh = lane >> 5, i16 = lane & 15, g1 = (lane >> 4) & 1;
    const char* vb = st + AT_KV;
#pragma unroll
    for (int tt = 0; tt < 2; ++tt)
#pragma unroll
        for (int sp = 0; sp < 2; ++sp) {
            union { bf16x8 v; unsigned u[4]; } pu;
#pragma unroll
            for (int j = 0; j < 4; ++j) pu.u[j] = pack_bf16(s[tt][8 * sp + 2 * j], s[tt][8 * sp + 2 * j + 1]);
            const bf16x8 pf = pu.v;
#pragma unroll
            for (int dt = 0; dt < 2; ++dt) {
                const int kb = 32 * tt + 16 * sp + 8 * fh + (i16 >> 2), dc = 32 * dt + 16 * g1 + 4 * (i16 & 3);
                const s16x4 v0 = __builtin_amdgcn_ds_read_tr16_b64_v4i16((LAS s16x4*)(vb + at_voff(kb, dc)));
                const s16x4 v1 = __builtin_amdgcn_ds_read_tr16_b64_v4i16((LAS s16x4*)(vb + at_voff(kb + 4, dc)));
                bf16x8 vf; vf[0] = v0[0]; vf[1] = v0[1]; vf[2] = v0[2]; vf[3] = v0[3]; vf[4] = v1[0]; vf[5] = v1[1]; vf[6] = v1[2]; vf[7] = v1[3];
                a.o[dt] = __builtin_amdgcn_mfma_f32_32x32x16_bf16(vf, pf, a.o[dt], 0, 0, 0);
            }
        }
}
__device__ __forceinline__ void at_store(const AttnState& a, bf16* orow  , int lane) {
    const float il = 1.0f / a.l; const int fh = lane >> 5;
#pragma unroll
    for (int dt = 0; dt < 2; ++dt)
#pragma unroll
        for (int g = 0; g < 4; ++g) {
            u32x2 v; v.x = pack_bf16(a.o[dt][4 * g] * il, a.o[dt][4 * g + 1] * il); v.y = pack_bf16(a.o[dt][4 * g + 2] * il, a.o[dt][4 * g + 3] * il);
            *(u32x2*)(orow + 32 * dt + 8 * g + 4 * fh) = v;
        }
}
struct AtRegs { u32x4 k, v; };
__device__ __forceinline__ AtRegs at_load(const bf16* kbase, const bf16* vbase, int tid) {
    const int key = tid >> 3, c = tid & 7; AtRegs r;
    r.k = *(const u32x4*)(kbase + (size_t)key * DIN + c * 8); r.v = *(const u32x4*)(vbase + (size_t)key * DIN + c * 8); return r;
}
__device__ __forceinline__ void at_write(char* st, const AtRegs& r, int tid) {
    const int key = tid >> 3, c = tid & 7;
    *(u32x4*)(st + g_lds_off(key, c)) = r.k; *(u32x4*)(st + AT_KV + at_voff(key, c * 8)) = r.v;
}
__device__ __forceinline__ void at_dma(char* st, const bf16* kbase, int voff, int wid, int lane) {
    const int r = 8 * wid + (lane >> 3), pos = lane & 7;
    const bf16* kr = kbase + (size_t)r * DIN;
    const int ck = pos ^ ((r >> 1) & 7), cv = 4 * ((pos >> 2) ^ ((r >> 1) & 1)) + (pos & 3);
    __builtin_amdgcn_global_load_lds((const unsigned*)(kr + 8 * ck), (LAS unsigned*)(st + wid * 1024), 16, 0, 0);
    __builtin_amdgcn_global_load_lds((const unsigned*)(kr + voff + 8 * cv), (LAS unsigned*)(st + AT_KV + wid * 1024), 16, 0, 0);
}
#define AT_WAIT(n) asm volatile("s_waitcnt vmcnt(" #n ")" ::: "memory")
__device__ __forceinline__ void at_wait_tile(int remaining_after  ) {
    if (remaining_after >= 2) AT_WAIT(4); else if (remaining_after == 1) AT_WAIT(2); else AT_WAIT(0);
    __builtin_amdgcn_s_barrier();
    asm volatile("" ::: "memory");
}
constexpr int AT_RING = 4;
__device__ __forceinline__ void at_loadq(bf16x8 (&qf)[4], const bf16* qrow, int lane) {
    const int fh = lane >> 5;
#pragma unroll
    for (int ks = 0; ks < 4; ++ks) qf[ks] = *(const bf16x8*)(qrow + ks * 16 + fh * 8);
}
__device__ __forceinline__ int at_key(int tt, int r, int fh) { return 32 * tt + (r & 3) + 8 * fh + 4 * ((r >> 2) & 1) + 16 * (r >> 3); }

__device__ __forceinline__ void attn_wa_item(char* lds, const bf16* p, bf16* ycat, const float* sink, int b, int hk, int qb, bool ctxq) {
    int tid = threadIdx.x; asm volatile("" : "+v"(tid));
    const int lane = tid & 63, wv = tid >> 6, fr = lane & 31, fh = lane >> 5;
    const int hq = 2 * hk + (wv >> 2);
    const int qpos = qb * 128 + (wv & 3) * 32 + fr;
    const size_t qtok = ctxq ? (size_t)TL + (size_t)b * LC + qpos : (size_t)b * S + qpos;
    bf16x8 qf[4]; at_loadq(qf, p + qtok * DIN + O1 + hq * 64, lane);
    AttnState a;
#pragma unroll
    for (int dt = 0; dt < 2; ++dt)
#pragma unroll
        for (int r = 0; r < 16; ++r) a.o[dt][r] = 0.f;
    a.m = sink[hq] * 1.4426950408889634f; a.l = 1.0f;
    int lo = qb * 128 - 128, hi = qb * 128 + 256; if (lo < 0) lo = 0; if (hi > S) hi = S;
    const int nloc = ctxq ? 0 : (hi - lo) / 64, nt = 4 + nloc;
    const bf16* kc = p + ((size_t)TL + (size_t)b * LC) * DIN + O1 + 256 + hk * 64;
    const bf16* kl = p + ((size_t)b * S + lo) * DIN + O1 + 256 + hk * 64;
    const int wid = __builtin_amdgcn_readfirstlane(wv);
    asm volatile("s_waitcnt vmcnt(0)" ::: "memory");
    __syncthreads();
#define AT_TILE_K(i_) ((i_) < 4 ? kc + (size_t)(i_) * 64 * DIN : kl + (size_t)((i_) - 4) * 64 * DIN)
    for (int i = 0; i < 3 && i < nt; ++i) at_dma(lds + i * AT_STAGE, AT_TILE_K(i), 128, wid, lane);
    for (int i = 0; i < nt; ++i) {
        const char* st = lds + (i & 3) * AT_STAGE;
        at_wait_tile(nt - 1 - i);
        if (i + 3 < nt) at_dma(lds + ((i + 3) & 3) * AT_STAGE, AT_TILE_K(i + 3), 128, wid, lane);
        f32x16 s[2]; at_qk(st, qf, s, lane);
        if (i < 4) {
#pragma unroll
            for (int tt = 0; tt < 2; ++tt)
#pragma unroll
                for (int r = 0; r < 16; ++r) s[tt][r] *= 0.125f * 1.4426950408889634f;
        } else {
            const int kb0 = lo + (i - 4) * 64;
#pragma unroll
            for (int tt = 0; tt < 2; ++tt)
#pragma unroll
                for (int r = 0; r < 16; ++r) { const int d = kb0 + at_key(tt, r, fh) - qpos; s[tt][r] = (d >= -WINDOW && d <= WINDOW) ? s[tt][r] * (0.125f * 1.4426950408889634f) : -1e30f; }
        }
        at_softmax_pv(st, s, a, lane);
    }
    at_store(a, ycat + qtok * 1024 + 256 + hq * 64, lane);
}
__device__ __forceinline__ void attn_na_item(char* lds, const bf16* p, bf16* ycat, const float* rpb  , int b, int h, int rg4, bool ctxq) {
    int tid = threadIdx.x; asm volatile("" : "+v"(tid));
    const int lane = tid & 63, wv = tid >> 6, fr = lane & 31, fh = lane >> 5;
    const int r = rg4 * 4 + (wv >> 1), cq = (wv & 1) * 32 + fr;
    const size_t qtok = ctxq ? (size_t)TL + (size_t)b * LC + wv * 32 + fr : (size_t)b * S + r * 64 + cq;
    bf16x8 qf[4]; at_loadq(qf, p + qtok * DIN + O2 + h * 64, lane);
    AttnState a;
#pragma unroll
    for (int dt = 0; dt < 2; ++dt)
#pragma unroll
        for (int rr = 0; rr < 16; ++rr) a.o[dt][rr] = 0.f;
    a.m = -1e30f; a.l = 0.f;
    constexpr int ROWS = S / GRID_W;
    int klo = rg4 * 4 - 4; if (klo < 0) klo = 0; int khi = rg4 * 4 + 3 - 4; if (khi < 0) khi = 0; if (khi > ROWS - NA_KR) khi = ROWS - NA_KR; khi += NA_KR;
    if (klo > ROWS - NA_KR) klo = ROWS - NA_KR;
    const int nloc = ctxq ? 0 : khi - klo, nt = 4 + nloc;
    int myr0 = r - 4; myr0 = myr0 < 0 ? 0 : (myr0 > ROWS - NA_KR ? ROWS - NA_KR : myr0);
    int c0 = cq - 8; c0 = c0 < 0 ? 0 : (c0 > GRID_W - NA_KC ? GRID_W - NA_KC : c0);
    const bf16* kc = p + ((size_t)TL + (size_t)b * LC) * DIN + O2 + 256 + h * 64;
    const bf16* kl = p + ((size_t)b * S + (size_t)klo * 64) * DIN + O2 + 256 + h * 64;
    float* bl = (float*)(lds + AT_RING * AT_STAGE);
    __syncthreads();
    const int wid = __builtin_amdgcn_readfirstlane(wv);
    if (tid < 15 * 31) bl[(tid / 31) * 32 + (tid % 31)] = rpb[h * 15 * 31 + tid];
    asm volatile("s_waitcnt vmcnt(0) lgkmcnt(0)" ::: "memory");
    for (int i = 0; i < 3 && i < nt; ++i) at_dma(lds + i * AT_STAGE, AT_TILE_K(i), 256, wid, lane);
    for (int i = 0; i < nt; ++i) {
        const char* st = lds + (i & 3) * AT_STAGE;
        at_wait_tile(nt - 1 - i);
        if (i + 3 < nt) at_dma(lds + ((i + 3) & 3) * AT_STAGE, AT_TILE_K(i + 3), 256, wid, lane);
        const int krow = klo + (i - 4);
        const bool act = i < 4 || (krow >= myr0 && krow < myr0 + NA_KR);
        if (act) {
            f32x16 s[2]; at_qk(st, qf, s, lane);
            if (i < 4) {
#pragma unroll
                for (int tt = 0; tt < 2; ++tt)
#pragma unroll
                    for (int rr = 0; rr < 16; ++rr) s[tt][rr] *= 0.125f * 1.4426950408889634f;
            } else {
                const float* brow = bl + (krow - r + 7) * 32 + 15 - cq;
#pragma unroll
                for (int tt = 0; tt < 2; ++tt)
#pragma unroll
                    for (int rr = 0; rr < 16; ++rr) { const int kcol = at_key(tt, rr, fh); const bool ok = kcol >= c0 && kcol < c0 + NA_KC;
                        const float bias = ok ? brow[kcol] : 0.f; s[tt][rr] = ok ? (s[tt][rr] * 0.125f + bias) * 1.4426950408889634f : -1e30f; }
            }
            at_softmax_pv(st, s, a, lane);
        }
    }
    at_store(a, ycat + qtok * 1024 + 512 + h * 64, lane);
}
__device__ __forceinline__ void attn_item(char* lds, const WS& w, const Inputs& in, int l, int it) {
    if (it < 256) attn_wa_item(lds, w.p, w.ycat, in.wa_sink + l * 4, it >> 5, (it >> 4) & 1, it & 15, false);
    else if (it < 512) { const int j = it - 256; attn_na_item(lds, w.p, w.ycat, in.na_rpb + l * 4 * 15 * 31, j >> 5, (j >> 3) & 3, j & 7, false); }
    else if (it < 544) { const int j = it - 512; attn_wa_item(lds, w.p, w.ycat, in.wa_sink + l * 4, j >> 2, (j >> 1) & 1, j & 1, true); }
    else { const int j = it - 544; attn_na_item(lds, w.p, w.ycat, in.na_rpb + l * 4 * 15 * 31, j >> 2, j & 3, 0, true); }
}
#endif
#ifndef HOST_SIM
__device__ __forceinline__ float hy_c3(const bf16* pr, int tin, int col, const float* cw) {
    float acc = cw[768 + col] * bf2f(pr[col]);
    if (tin > 0) acc += cw[col] * bf2f(pr[col - DIN]);
    if (tin < S - 1) acc += cw[2 * 768 + col] * bf2f(pr[col + DIN]);
    return acc;
}
__device__ __forceinline__ void hy_prep_item(char* lds, const bf16* p, const float* cw, bf16* x0T, bf16* uvT, int b, int ch) {
    int tid = threadIdx.x; asm volatile("" : "+v"(tid));
    bf16* lx = (bf16*)lds;
    bf16* lu = lx + 256 * 72;
    __syncthreads();
    const int tl = tid & 63, cg = tid >> 6;
    const int tin = ch * 64 + tl; const bf16* pr = p + ((size_t)b * S + tin) * DIN;
    for (int it = 0; it < 4; ++it) {
        const int c0 = (it * 8 + cg) * 8;
        float x0[8], x1[8], vv[8];
#pragma unroll
        for (int q = 0; q < 8; ++q) { x0[q] = 0.f; x1[q] = 0.f; vv[q] = 0.f; }
#pragma unroll
        for (int dr = -1; dr <= 1; ++dr) {
            if (tin + dr < 0 || tin + dr >= S) continue;
            const bf16* r = pr + (ptrdiff_t)dr * DIN;
            const u32x4 a = *(const u32x4*)(r + c0), bq = *(const u32x4*)(r + 256 + c0), cq = *(const u32x4*)(r + 512 + c0);
            const float* w0 = cw + (dr + 1) * 768;
#pragma unroll
            for (int q = 0; q < 4; ++q) {
                x0[2 * q] += w0[c0 + 2 * q] * __uint_as_float(a[q] << 16); x0[2 * q + 1] += w0[c0 + 2 * q + 1] * __uint_as_float(a[q] & 0xffff0000u);
                x1[2 * q] += w0[256 + c0 + 2 * q] * __uint_as_float(bq[q] << 16); x1[2 * q + 1] += w0[256 + c0 + 2 * q + 1] * __uint_as_float(bq[q] & 0xffff0000u);
                vv[2 * q] += w0[512 + c0 + 2 * q] * __uint_as_float(cq[q] << 16); vv[2 * q + 1] += w0[512 + c0 + 2 * q + 1] * __uint_as_float(cq[q] & 0xffff0000u);
            }
        }
#pragma unroll
        for (int q = 0; q < 8; ++q) { lx[(c0 + q) * 72 + tl] = f2bf(x0[q]); lu[(c0 + q) * 72 + tl] = f2bf(x1[q] * vv[q]); }
    }
    __syncthreads();
    for (int i = tid; i < 2048; i += NTHREADS) {
        const int c = i >> 3, k = i & 7;
        const size_t g = ((size_t)c * B + b) * S + ch * 64 + k * 8;
        *(u32x4*)(x0T + g) = *(const u32x4*)(lx + c * 72 + k * 8);
        *(u32x4*)(uvT + g) = *(const u32x4*)(lu + c * 72 + k * 8);
    }
}
constexpr int HY_NOFF = 2072, HY_NE = 4128, HY_CS = HY_NE * 2 + 32;
constexpr int HY_URS = S * 2 + 16;
constexpr int HY_LDS_U = 8 * HY_CS, HY_LDS_Z = HY_LDS_U + 8 * HY_URS, HY_LDS_REV = HY_LDS_Z + 64, HY_LDS_END = HY_LDS_REV + (HY_NE + 8) * 2;
__device__ __forceinline__ void hy_conv_item(char* lds, const float* filtT, const float* hbias, const bf16* uvT, bf16* x0T  , int c) {
    static_assert(B == 8, "hyena conv assumes batch 8");
    int tid = threadIdx.x; asm volatile("" : "+v"(tid));
    const int lane = tid & 63, wv = tid >> 6, fr = lane & 31, fh = lane >> 5;
    bf16* rev = (bf16*)(lds + HY_LDS_REV);
    __syncthreads();
    const float* hf = filtT + (size_t)c * (S + LC); const float* hb = filtT + (size_t)(256 + c) * (S + LC);
    for (int e = tid; e < HY_NE + 8; e += NTHREADS) {
        const int n = e - HY_NOFF; float v = 0.f;
        if (n > 0 && n < S) v = hb[n]; else if (n <= 0 && n > -S) v = hf[-n];
        rev[e] = f2bf(v);
    }
    for (int i = tid; i < 8 * 256; i += NTHREADS) { const int bb = i >> 8, k = i & 255; *(u32x4*)(lds + HY_LDS_U + bb * HY_URS + k * 16) = *(const u32x4*)(uvT + ((size_t)c * B + bb) * S + k * 8); }
    if (tid < 4) ((unsigned*)(lds + HY_LDS_Z))[tid] = 0u;
    __syncthreads();
    for (int i = tid; i < 8 * (HY_NE / 2); i += NTHREADS) {
        const int m = i / (HY_NE / 2), d = i % (HY_NE / 2);
        const unsigned lo = rev[2 * d + m], hi = rev[2 * d + 1 + m];
        *(unsigned*)(lds + m * HY_CS + d * 4) = lo | (hi << 16);
    }
    __syncthreads();
    f32x16 acc[2];
#pragma unroll
    for (int q = 0; q < 2; ++q)
#pragma unroll
        for (int r = 0; r < 16; ++r) acc[q][r] = 0.f;
    const int bb = fr >> 2, pp = fr & 3;
    const int m = (-fr) & 7;
    const char* abase = lds + m * HY_CS;
    const char* ubase = lds + HY_LDS_U + bb * HY_URS + fh * 16;
    auto hstep = [&](int dl, bool a0, bool a1) {
        const int n0 = 8 * fh - fr - 16 * dl;
        const bf16x8 af = *(const bf16x8*)(abase + (n0 - m + HY_NOFF) * 2);
        if (a0) { const int sj = 16 * wv - dl + 2 * pp; const char* up = (sj >= 0 && sj < 128) ? ubase + sj * 32 : lds + HY_LDS_Z;
            acc[0] = __builtin_amdgcn_mfma_f32_32x32x16_bf16(af, *(const bf16x8*)up, acc[0], 0, 0, 0); }
        if (a1) { const int sj = 16 * wv + 8 - dl + 2 * pp; const char* up = (sj >= 0 && sj < 128) ? ubase + sj * 32 : lds + HY_LDS_Z;
            acc[1] = __builtin_amdgcn_mfma_f32_32x32x16_bf16(af, *(const bf16x8*)up, acc[1], 0, 0, 0); }
    };
#pragma unroll
    for (int dl = 16 * wv - 127; dl < 16 * wv - 119; ++dl) hstep(dl, true, false);
#pragma unroll 6
    for (int dl = 16 * wv - 119; dl <= 16 * wv + 6; ++dl) hstep(dl, true, true);
#pragma unroll
    for (int dl = 16 * wv + 7; dl <= 16 * wv + 14; ++dl) hstep(dl, false, true);
    const float hbc = hbias[c];
#pragma unroll
    for (int qq = 0; qq < 2; ++qq) {
        const int tb = 32 * (4 * (2 * wv + qq) + pp) + 4 * fh;
#pragma unroll
        for (int g = 0; g < 4; ++g) {
            const int t = tb + 8 * g;
            const u32x2 uu = *(const u32x2*)(lds + HY_LDS_U + bb * HY_URS + t * 2);
            bf16* xp = x0T + ((size_t)c * B + bb) * S + t; const u32x2 xx = *(const u32x2*)xp;
            const float u0 = __uint_as_float(uu.x << 16), u1 = __uint_as_float(uu.x & 0xffff0000u), u2 = __uint_as_float(uu.y << 16), u3 = __uint_as_float(uu.y & 0xffff0000u);
            const float a0 = __uint_as_float(xx.x << 16), a1 = __uint_as_float(xx.x & 0xffff0000u), a2 = __uint_as_float(xx.y << 16), a3 = __uint_as_float(xx.y & 0xffff0000u);
            u32x2 o; o.x = pack_bf16(a0 * (acc[qq][4 * g] + hbc * u0), a1 * (acc[qq][4 * g + 1] + hbc * u1)); o.y = pack_bf16(a2 * (acc[qq][4 * g + 2] + hbc * u2), a3 * (acc[qq][4 * g + 3] + hbc * u3));
            *(u32x2*)xp = o;
        }
    }
}
__device__ __forceinline__ void hy_fin_item(char* lds, const bf16* yT, bf16* ycat, int b, int ch) {
    int tid = threadIdx.x; asm volatile("" : "+v"(tid));
    bf16* ly = (bf16*)lds;
    __syncthreads();
    for (int i = tid; i < 2048; i += NTHREADS) {
        const int c = i >> 3, k = i & 7;
        const u32x4 v = *(const u32x4*)(yT + ((size_t)c * B + b) * S + ch * 64 + k * 8);
#pragma unroll
        for (int q = 0; q < 4; ++q) { ly[(k * 8 + 2 * q) * 264 + c] = (bf16)(v[q] & 0xffffu); ly[(k * 8 + 2 * q + 1) * 264 + c] = (bf16)(v[q] >> 16); }
    }
    __syncthreads();
    for (int i = tid; i < 2048; i += NTHREADS) {
        const int t = i >> 5, k = i & 31;
        *(u32x4*)(ycat + ((size_t)b * S + ch * 64 + t) * 1024 + k * 8) = *(const u32x4*)(ly + t * 264 + k * 8);
    }
}
#endif
#ifndef HOST_SIM
constexpr int GD_NC = 36;
__device__ __forceinline__ size_t gd_tok0(int b, int cc) { return cc < 4 ? (size_t)TL + (size_t)b * LC + cc * 64 : (size_t)b * S + (size_t)(cc - 4) * 64; }

constexpr int GP_K = 0, GP_V = 8192, GP_L0 = 16384, GP_T0 = GP_L0 + 2 * 16384, GP_VB0 = GP_T0 + 2 * 8192  , GP_G = GP_VB0 + 2 * 8192  ,
              GP_SM = GP_VB0 + 4 * 8192  , GP_LB = GP_SM + 6 * 256  , GP_END = GP_LB + 2 * 2048;

__device__ __forceinline__ void gdn_pre_item(char* lds, const WS& w, const float* cw  , const float* a_log, const float* dt_bias, int b, int cc, int h) {
    int tid = threadIdx.x; asm volatile("" : "+v"(tid));
    const int lane = tid & 63, wv = tid >> 6, fr = lane & 31, fh = lane >> 5;
    const bf16* p = w.p;
    const int L = cc < 4 ? LC : S; const int tin0 = cc < 4 ? cc * 64 : (cc - 4) * 64; const size_t tok0 = gd_tok0(b, cc);
    float* sm = (float*)(lds + GP_SM);
    __syncthreads();
    {
        const int tl = tid >> 3, dg = tid & 7;
        float q8[8], k8[8], v8[8];
#pragma unroll
        for (int x = 0; x < 8; ++x) { q8[x] = 0.f; k8[x] = 0.f; v8[x] = 0.f; }
#pragma unroll
        for (int i = 0; i < 4; ++i) {
            const int tt = tin0 + tl + i - 2;
            if (tt < 0 || tt >= L) continue;
            const bf16* r = p + (tok0 + tl + i - 2) * DIN + O3 + h * 64 + dg * 8;
            const u32x4 a = *(const u32x4*)r, bq = *(const u32x4*)(r + 256), cq = *(const u32x4*)(r + 512);
            const float* wq = cw + i * 768 + h * 64 + dg * 8;
#pragma unroll
            for (int x = 0; x < 4; ++x) {
                q8[2 * x] += wq[2 * x] * __uint_as_float(a[x] << 16); q8[2 * x + 1] += wq[2 * x + 1] * __uint_as_float(a[x] & 0xffff0000u);
                k8[2 * x] += wq[256 + 2 * x] * __uint_as_float(bq[x] << 16); k8[2 * x + 1] += wq[256 + 2 * x + 1] * __uint_as_float(bq[x] & 0xffff0000u);
                v8[2 * x] += wq[512 + 2 * x] * __uint_as_float(cq[x] << 16); v8[2 * x + 1] += wq[512 + 2 * x + 1] * __uint_as_float(cq[x] & 0xffff0000u);
            }
        }
        float sq = 0.f, sk = 0.f;
#pragma unroll
        for (int x = 0; x < 8; ++x) { q8[x] = q8[x] / (1.0f + __expf(-q8[x])); k8[x] = k8[x] / (1.0f + __expf(-k8[x])); v8[x] = v8[x] / (1.0f + __expf(-v8[x])); sq += q8[x] * q8[x]; sk += k8[x] * k8[x]; }
        sq += __shfl_xor(sq, 1); sq += __shfl_xor(sq, 2); sq += __shfl_xor(sq, 4);
        sk += __shfl_xor(sk, 1); sk += __shfl_xor(sk, 2); sk += __shfl_xor(sk, 4);
        const float rq = 0.125f / sqrtf(sq + EPS), rk = 1.0f / sqrtf(sk + EPS);
        u32x4 qo, ko, vo;
#pragma unroll
        for (int x = 0; x < 4; ++x) { qo[x] = pack_bf16(q8[2 * x] * rq, q8[2 * x + 1] * rq); ko[x] = pack_bf16(k8[2 * x] * rk, k8[2 * x + 1] * rk); vo[x] = pack_bf16(v8[2 * x], v8[2 * x + 1]); }
        bf16* qkg = w.qk + ((size_t)((b * 4 + h) * GD_NC + cc) * 2) * 4096;
        *(u32x4*)(qkg + tl * 64 + dg * 8) = qo; *(u32x4*)(qkg + 4096 + tl * 64 + dg * 8) = ko;
        *(u32x4*)(lds + GP_K + g_lds_off(tl, dg)) = ko;
        *(u32x4*)(lds + GP_V + at_voff(tl, dg * 8)) = vo;
        if (tid < 128) {
            const int dir = tid >> 6, t = tid & 63; const bf16* r = p + (tok0 + t) * DIN + O3 + 1024 + dir * 4 + h;
            const float a = bf2f(r[0]), bbv = bf2f(r[8]); const float x = a + dt_bias[dir * 4 + h]; const float sp = x > 20.f ? x : log1pf(expf(x));
            sm[dir * 64 + t] = -expf(a_log[dir * 4 + h]) * sp; sm[128 + dir * 64 + t] = 1.0f / (1.0f + expf(-bbv));
        }
    }
    __syncthreads();
    if (wv < 4) {
        const int ta = wv >> 1, tb = wv & 1; f32x16 g;
#pragma unroll
        for (int r = 0; r < 16; ++r) g[r] = 0.f;
#pragma unroll
        for (int ks = 0; ks < 4; ++ks) {
            const bf16x8 fa = *(const bf16x8*)(lds + GP_K + g_lds_off(32 * ta + fr, ks * 2 + fh)), fb = *(const bf16x8*)(lds + GP_K + g_lds_off(32 * tb + fr, ks * 2 + fh));
            g = __builtin_amdgcn_mfma_f32_32x32x16_bf16(fa, fb, g, 0, 0, 0);
        }
        float* G = (float*)(lds + GP_G);
#pragma unroll
        for (int r = 0; r < 16; ++r) G[(32 * ta + (r & 3) + 8 * (r >> 2) + 4 * fh) * 64 + 32 * tb + fr] = g[r];
    } else if (wv < 6) {
        const int dir = wv - 4; float v = sm[dir * 64 + (dir ? 63 - lane : lane)];
#pragma unroll
        for (int o = 1; o < 64; o <<= 1) { const float t = __shfl_up(v, o); if (lane >= o) v += t; }
        sm[256 + dir * 64 + lane] = v;
        float* gcg = w.gc + ((size_t)((b * 4 + h) * 2 + dir) * GD_NC + cc) * 64; gcg[lane] = v;
    }
    __syncthreads();
    const int dir = wv >> 2, t4 = tid & 255;
    {
        const float* G = (const float*)(lds + GP_G); float* Lm = (float*)(lds + GP_L0 + dir * 16384);
        for (int e = t4; e < 4096; e += 256) {
            const int i = e >> 6, j = e & 63; const int ti = dir ? 63 - i : i, tj = dir ? 63 - j : j;
            const float lv = j < i ? sm[128 + dir * 64 + ti] * G[ti * 64 + tj] * __expf(sm[256 + dir * 64 + i] - sm[256 + dir * 64 + j]) : 0.f;
            Lm[e] = lv;
            if (i >= 32 && j < 32) ((bf16*)(lds + GP_LB + dir * 2048))[(i - 32) * 32 + j] = f2bf(lv);
        }
    }
    __syncthreads();
    if ((__builtin_amdgcn_readfirstlane(wv) & 3) == 0) {
        const float* Lm = (const float*)(lds + GP_L0 + dir * 16384);
        char* Tm = lds + GP_T0 + dir * 8192;
        const int blk = lane >> 5, c = lane & 31;
        const LAS float* Lb = (const LAS float*)(Lm + (32 * blk) * 64 + 32 * blk);
        float Tc[32];
#pragma unroll
        for (int i = 0; i < 32; ++i) {
            const LAS float* Lr = Lb + i * 64;
            if (i >= 2) asm volatile("" : "+v"(Lr) : "v"(Tc[i - 2]));
            float a0 = (c == i) ? 1.0f : 0.f, a1 = 0.f, a2 = 0.f, a3 = 0.f;
#pragma unroll
            for (int j4 = 0; j4 < (i & ~3); j4 += 4) {
                const f32x4 l4 = *(const LAS f32x4*)(Lr + j4);
                a0 -= l4[0] * Tc[j4]; a1 -= l4[1] * Tc[j4 + 1]; a2 -= l4[2] * Tc[j4 + 2]; a3 -= l4[3] * Tc[j4 + 3];
            }
#pragma unroll
            for (int j = (i & ~3); j < i; ++j) a0 -= Lr[j] * Tc[j];
            Tc[i] = (a0 + a1) + (a2 + a3);
        }
        {
            int rb = 32 * blk; const int cb = (32 * blk + c) >> 3, cz = (32 * (1 - blk) + c) >> 3, co = (c & 7) * 2;
#pragma unroll
            for (int i = 0; i < 32; ++i) {
                asm volatile("" : "+v"(rb));
                const int row = rb + i, sw = (row >> 1) & 7;
                *(bf16*)(Tm + row * 128 + ((cb ^ sw) << 4) + co) = f2bf(Tc[i]);
                if (blk == 0) *(bf16*)(Tm + row * 128 + ((cz ^ sw) << 4) + co) = (bf16)0;
            }
        }
        asm volatile("s_waitcnt lgkmcnt(0)" ::: "memory");
        const char* Lq = lds + GP_LB + dir * 2048;
        f32x16 X;
#pragma unroll
        for (int r = 0; r < 16; ++r) X[r] = 0.f;
        const int i16 = lane & 15, g1 = (lane >> 4) & 1;
#pragma unroll
        for (int ks = 0; ks < 2; ++ks) {
            const bf16x8 fa = *(const bf16x8*)(Lq + fr * 64 + (ks * 2 + fh) * 16);
            const int jr = 16 * ks + 8 * fh + (i16 >> 2), dc = 16 * g1 + 4 * (i16 & 3);
            const s16x4 t0 = __builtin_amdgcn_ds_read_tr16_b64_v4i16((LAS s16x4*)(Tm + g_lds_off(jr, dc >> 3) + (dc & 7) * 2));
            const s16x4 t1 = __builtin_amdgcn_ds_read_tr16_b64_v4i16((LAS s16x4*)(Tm + g_lds_off(jr + 4, dc >> 3) + (dc & 7) * 2));
            bf16x8 fb; fb[0] = t0[0]; fb[1] = t0[1]; fb[2] = t0[2]; fb[3] = t0[3]; fb[4] = t1[0]; fb[5] = t1[1]; fb[6] = t1[2]; fb[7] = t1[3];
            X = __builtin_amdgcn_mfma_f32_32x32x16_bf16(fa, fb, X, 0, 0, 0);
        }
        f32x16 Y;
#pragma unroll
        for (int r = 0; r < 16; ++r) Y[r] = 0.f;
#pragma unroll
        for (int ks = 0; ks < 2; ++ks) {
            union { bf16x8 v; unsigned u[4]; } xb;
#pragma unroll
            for (int j = 0; j < 4; ++j) xb.u[j] = pack_bf16(X[8 * ks + 2 * j], X[8 * ks + 2 * j + 1]);
            const int c0 = 32 + 16 * ks + 4 * fh, c1 = c0 + 8;
            const u32x2 p0 = *(const u32x2*)(Tm + g_lds_off(32 + fr, c0 >> 3) + (c0 & 7) * 2), p1 = *(const u32x2*)(Tm + g_lds_off(32 + fr, c1 >> 3) + (c1 & 7) * 2);
            union { bf16x8 v; unsigned u[4]; } ta_; ta_.u[0] = p0.x; ta_.u[1] = p0.y; ta_.u[2] = p1.x; ta_.u[3] = p1.y;
            Y = __builtin_amdgcn_mfma_f32_32x32x16_bf16(ta_.v, xb.v, Y, 0, 0, 0);
        }
#pragma unroll
        for (int r = 0; r < 16; ++r) { const int row = 32 + (r & 3) + 8 * (r >> 2) + 4 * fh; *(bf16*)(Tm + g_lds_off(row, fr >> 3) + (fr & 7) * 2) = f2bf(-Y[r]); }
    } else {
        const int t3 = t4 - 64;
        for (int e = t3; e < 1024; e += 192) {
            const int mat = e >> 9, j = (e >> 3) & 63, c8 = e & 7; const int tj = dir ? 63 - j : j;
            const float sc = sm[128 + dir * 64 + tj] * (mat ? __expf(sm[256 + dir * 64 + j]) : 1.0f);
            const u32x4 src = mat ? *(const u32x4*)(lds + GP_K + g_lds_off(tj, c8)) : *(const u32x4*)(lds + GP_V + at_voff(tj, c8 * 8));
            u32x4 d;
#pragma unroll
            for (int x = 0; x < 4; ++x) d[x] = pack_bf16(sc * __uint_as_float(src[x] << 16), sc * __uint_as_float(src[x] & 0xffff0000u));
            *(u32x4*)(lds + GP_VB0 + (dir * 2 + mat) * 8192 + at_voff(j, c8 * 8)) = d;
        }
    }
    __syncthreads();
    {
        const int w4 = wv & 3, ta = w4 >> 1, tb = w4 & 1; const int i16 = lane & 15, g1 = (lane >> 4) & 1;
        const char* Tm = lds + GP_T0 + dir * 8192; const char* vb = lds + GP_VB0 + (dir * 2) * 8192; const char* kbe = vb + 8192;
        f32x16 aw, au;
#pragma unroll
        for (int r = 0; r < 16; ++r) { aw[r] = 0.f; au[r] = 0.f; }
#pragma unroll
        for (int ks = 0; ks < 4; ++ks) {
            const int jr = 16 * ks + 8 * fh + (i16 >> 2), dc = 32 * ta + 16 * g1 + 4 * (i16 & 3);
            const s16x4 k0 = __builtin_amdgcn_ds_read_tr16_b64_v4i16((LAS s16x4*)(kbe + at_voff(jr, dc))), k1 = __builtin_amdgcn_ds_read_tr16_b64_v4i16((LAS s16x4*)(kbe + at_voff(jr + 4, dc)));
            bf16x8 fa; fa[0] = k0[0]; fa[1] = k0[1]; fa[2] = k0[2]; fa[3] = k0[3]; fa[4] = k1[0]; fa[5] = k1[1]; fa[6] = k1[2]; fa[7] = k1[3];
            const bf16x8 fbT = *(const bf16x8*)(Tm + g_lds_off(32 * tb + fr, ks * 2 + fh));
            aw = __builtin_amdgcn_mfma_f32_32x32x16_bf16(fa, fbT, aw, 0, 0, 0);
            const bf16x8 faT = *(const bf16x8*)(Tm + g_lds_off(32 * ta + fr, ks * 2 + fh));
            const int dc2 = 32 * tb + 16 * g1 + 4 * (i16 & 3);
            const s16x4 v0 = __builtin_amdgcn_ds_read_tr16_b64_v4i16((LAS s16x4*)(vb + at_voff(jr, dc2))), v1 = __builtin_amdgcn_ds_read_tr16_b64_v4i16((LAS s16x4*)(vb + at_voff(jr + 4, dc2)));
            bf16x8 fv; fv[0] = v0[0]; fv[1] = v0[1]; fv[2] = v0[2]; fv[3] = v0[3]; fv[4] = v1[0]; fv[5] = v1[1]; fv[6] = v1[2]; fv[7] = v1[3];
            au = __builtin_amdgcn_mfma_f32_32x32x16_bf16(faT, fv, au, 0, 0, 0);
        }
        bf16* uwg = w.uw + ((size_t)(((b * 4 + h) * 2 + dir) * GD_NC + cc) * 2) * 4096;
#pragma unroll
        for (int g = 0; g < 4; ++g) {
            const int rr = 32 * ta + 8 * g + 4 * fh;
            u32x2 o1; o1.x = pack_bf16(-aw[4 * g], -aw[4 * g + 1]); o1.y = pack_bf16(-aw[4 * g + 2], -aw[4 * g + 3]);
            *(u32x2*)(uwg + (32 * tb + fr) * 64 + rr) = o1;
            u32x2 o2; o2.x = pack_bf16(au[4 * g], au[4 * g + 1]); o2.y = pack_bf16(au[4 * g + 2], au[4 * g + 3]);
            *(u32x2*)(uwg + 4096 + (32 * tb + fr) * 64 + rr) = o2;
        }
    }
}
#endif
#ifndef HOST_SIM
constexpr int GS_IN = 0  , GS_ST = 65536  , GS_U1 = GS_ST + 16384, GS_U2 = GS_U1 + 8192, GS_AT = GS_U2 + 8192,
              GS_TB = GS_AT + 8192  , GS_END = GS_TB + 2 * 1024;
__device__ __forceinline__ int gd_chunk_of_step(int dir, int n) { return dir ? (n < 4 ? 3 - n : 39 - n) : n; }

__device__ __forceinline__ void gdn_scan_chain(char* lds, const WS& w, int b, int h, int dir, bool emit_ctx) {
    int tid = threadIdx.x; asm volatile("" : "+v"(tid));
    const int lane = tid & 63, wv = tid >> 6, fr = lane & 31, fh = lane >> 5, w4 = wv & 3, ta = w4 >> 1, tb = w4 & 1;
    const int i16 = lane & 15, g1 = (lane >> 4) & 1;
    const bool lo = wv < 4;
    const size_t chain = (size_t)((b * 4 + h) * 2 + dir) * GD_NC;
    const bf16* qkb = w.qk + (size_t)(b * 4 + h) * GD_NC * 2 * 4096;
    bf16* uwb = w.uw + chain * 2 * 4096; const float* gcb = w.gc + chain * 64;
    const int lrow = tid >> 3, lch = tid & 7;
    const int qrow = dir ? 63 - lrow : lrow;
    __syncthreads();
    *(u32x4*)(lds + GS_ST + tid * 16) = (u32x4){0u, 0u, 0u, 0u};
    f32x16 Sacc;
#pragma unroll
    for (int r = 0; r < 16; ++r) Sacc[r] = 0.f;
    struct Pre { u32x4 rw, rq, rk; float rg; u32x2 uc[4]; };
    Pre pa, pb, pc;
    auto prefetch = [&](int n, Pre& r) {
        const int cc = gd_chunk_of_step(dir, n);
        const bf16* uwp = uwb + (size_t)cc * 2 * 4096; const bf16* qkp = qkb + (size_t)cc * 2 * 4096;
        r.rw = *(const u32x4*)(uwp + lrow * 64 + lch * 8);
        r.rq = *(const u32x4*)(qkp + lrow * 64 + lch * 8); r.rk = *(const u32x4*)(qkp + 4096 + lrow * 64 + lch * 8);
        r.rg = 0.f; if (tid < 64) r.rg = gcb[(size_t)cc * 64 + tid];
        if (lo) { const bf16* up = uwp + 4096 + (32 * tb + fr) * 64 + 32 * ta + 4 * fh;
#pragma unroll
            for (int g = 0; g < 4; ++g) r.uc[g] = *(const u32x2*)(up + 8 * g); }
    };
    auto stage = [&](int buf, const Pre& r) {
        char* ib = lds + GS_IN + buf * 32768;
        *(u32x4*)(ib + g_lds_off(lrow, lch)) = r.rw;
        *(u32x4*)(ib + 8192 + g_lds_off(qrow, lch)) = r.rq;
        *(u32x4*)(ib + 16384 + g_lds_off(qrow, lch)) = r.rk;
        *(u32x4*)(ib + 24576 + at_voff(qrow, lch * 8)) = r.rk;
        float* tbp = (float*)(lds + GS_TB + buf * 1024);
        if (tid < 64) { const float g63 = __shfl(r.rg, 63); tbp[tid] = r.rg; tbp[64 + tid] = __expf(r.rg); tbp[128 + tid] = __expf(g63 - r.rg); if (tid == 0) tbp[192] = __expf(g63); }
    };
    auto step = [&](int n, Pre& cur, const Pre& nx) {
        const int buf = n & 1; const char* ib = lds + GS_IN + buf * 32768; const float* tbp = (const float*)(lds + GS_TB + buf * 1024);
        const char* St = lds + GS_ST + buf * 8192; char* Stn = lds + GS_ST + (buf ^ 1) * 8192;
        const int cc = gd_chunk_of_step(dir, n);
        if (lo) {
            f32x16 acc;
#pragma unroll
            for (int g = 0; g < 4; ++g) { acc[4 * g] = __uint_as_float(cur.uc[g].x << 16); acc[4 * g + 1] = __uint_as_float(cur.uc[g].x & 0xffff0000u); acc[4 * g + 2] = __uint_as_float(cur.uc[g].y << 16); acc[4 * g + 3] = __uint_as_float(cur.uc[g].y & 0xffff0000u); }
#pragma unroll
            for (int ks = 0; ks < 4; ++ks) {
                const bf16x8 fa = *(const bf16x8*)(ib + g_lds_off(32 * ta + fr, ks * 2 + fh)), fb = *(const bf16x8*)(St + g_lds_off(32 * tb + fr, ks * 2 + fh));
                acc = __builtin_amdgcn_mfma_f32_32x32x16_bf16(fa, fb, acc, 0, 0, 0);
            }
#pragma unroll
            for (int g = 0; g < 4; ++g) {
                const int i0 = 32 * ta + 8 * g + 4 * fh; const f32x4 fc = *(const f32x4*)(tbp + 128 + i0);
                u32x2 o1; o1.x = pack_bf16(acc[4 * g], acc[4 * g + 1]); o1.y = pack_bf16(acc[4 * g + 2], acc[4 * g + 3]);
                u32x2 o2; o2.x = pack_bf16(acc[4 * g] * fc[0], acc[4 * g + 1] * fc[1]); o2.y = pack_bf16(acc[4 * g + 2] * fc[2], acc[4 * g + 3] * fc[3]);
                const int off = g_lds_off(32 * tb + fr, i0 >> 3) + (i0 & 7) * 2;
                *(u32x2*)(lds + GS_U1 + off) = o1; *(u32x2*)(lds + GS_U2 + off) = o2;
            }
        } else {
            f32x16 acc;
#pragma unroll
            for (int r = 0; r < 16; ++r) acc[r] = 0.f;
#pragma unroll
            for (int ks = 0; ks < 4; ++ks) {
                const bf16x8 fa = *(const bf16x8*)(ib + 16384 + g_lds_off(32 * ta + fr, ks * 2 + fh)), fb = *(const bf16x8*)(ib + 8192 + g_lds_off(32 * tb + fr, ks * 2 + fh));
                acc = __builtin_amdgcn_mfma_f32_32x32x16_bf16(fa, fb, acc, 0, 0, 0);
            }
            const int i = 32 * tb + fr; const float gi = tbp[i];
#pragma unroll
            for (int g = 0; g < 4; ++g) {
                const int j0 = 32 * ta + 8 * g + 4 * fh; const f32x4 gj = *(const f32x4*)(tbp + j0);
                float v[4];
#pragma unroll
                for (int x = 0; x < 4; ++x) v[x] = (j0 + x <= i) ? acc[4 * g + x] * __expf(gi - gj[x]) : 0.f;
                u32x2 o; o.x = pack_bf16(v[0], v[1]); o.y = pack_bf16(v[2], v[3]);
                *(u32x2*)(lds + GS_AT + g_lds_off(i, j0 >> 3) + (j0 & 7) * 2) = o;
            }
        }
        __syncthreads();
        if (lo) {
            f32x16 acc;
#pragma unroll
            for (int r = 0; r < 16; ++r) acc[r] = 0.f;
#pragma unroll
            for (int ks = 0; ks < 4; ++ks) {
                const bf16x8 fa = *(const bf16x8*)(ib + 8192 + g_lds_off(32 * ta + fr, ks * 2 + fh)), fb = *(const bf16x8*)(St + g_lds_off(32 * tb + fr, ks * 2 + fh));
                acc = __builtin_amdgcn_mfma_f32_32x32x16_bf16(fa, fb, acc, 0, 0, 0);
            }
#pragma unroll
            for (int g = 0; g < 4; ++g) { const f32x4 eg = *(const f32x4*)(tbp + 64 + 32 * ta + 8 * g + 4 * fh); acc[4 * g] *= eg[0]; acc[4 * g + 1] *= eg[1]; acc[4 * g + 2] *= eg[2]; acc[4 * g + 3] *= eg[3]; }
#pragma unroll
            for (int ks = 0; ks < 4; ++ks) {
                const bf16x8 fa = *(const bf16x8*)(lds + GS_AT + g_lds_off(32 * ta + fr, ks * 2 + fh)), fb = *(const bf16x8*)(lds + GS_U1 + g_lds_off(32 * tb + fr, ks * 2 + fh));
                acc = __builtin_amdgcn_mfma_f32_32x32x16_bf16(fa, fb, acc, 0, 0, 0);
            }
            if (cc >= 4 || emit_ctx) {
                bf16* op = uwb + (size_t)cc * 2 * 4096 + 4096 + (32 * tb + fr) * 64 + 32 * ta + 4 * fh;
#pragma unroll
                for (int g = 0; g < 4; ++g) { u32x2 o; o.x = pack_bf16(acc[4 * g], acc[4 * g + 1]); o.y = pack_bf16(acc[4 * g + 2], acc[4 * g + 3]); *(u32x2*)(op + 8 * g) = o; }
            }
        } else {
            const float e63 = tbp[192];
#pragma unroll
            for (int r = 0; r < 16; ++r) Sacc[r] *= e63;
#pragma unroll
            for (int ks = 0; ks < 4; ++ks) {
                const int ir = 16 * ks + 8 * fh + (i16 >> 2), dc = 32 * ta + 16 * g1 + 4 * (i16 & 3);
                const s16x4 k0 = __builtin_amdgcn_ds_read_tr16_b64_v4i16((LAS s16x4*)(ib + 24576 + at_voff(ir, dc))), k1 = __builtin_amdgcn_ds_read_tr16_b64_v4i16((LAS s16x4*)(ib + 24576 + at_voff(ir + 4, dc)));
                bf16x8 fa; fa[0] = k0[0]; fa[1] = k0[1]; fa[2] = k0[2]; fa[3] = k0[3]; fa[4] = k1[0]; fa[5] = k1[1]; fa[6] = k1[2]; fa[7] = k1[3];
                const bf16x8 fb = *(const bf16x8*)(lds + GS_U2 + g_lds_off(32 * tb + fr, ks * 2 + fh));
                Sacc = __builtin_amdgcn_mfma_f32_32x32x16_bf16(fa, fb, Sacc, 0, 0, 0);
            }
#pragma unroll
            for (int g = 0; g < 4; ++g) {
                const int d0 = 32 * ta + 8 * g + 4 * fh; u32x2 o; o.x = pack_bf16(Sacc[4 * g], Sacc[4 * g + 1]); o.y = pack_bf16(Sacc[4 * g + 2], Sacc[4 * g + 3]);
                *(u32x2*)(Stn + g_lds_off(32 * tb + fr, d0 >> 3) + (d0 & 7) * 2) = o;
            }
        }
        if (n + 1 < GD_NC) stage(buf ^ 1, nx);
        if (n + 3 < GD_NC) prefetch(n + 3, cur);
        __syncthreads();
    };
    prefetch(0, pa); prefetch(1, pb); prefetch(2, pc);
    stage(0, pa);
    __syncthreads();
    for (int n = 0; n < GD_NC; n += 3) { step(n, pa, pb); step(n + 1, pb, pc); step(n + 2, pc, pa); }
}

__device__ __forceinline__ void gdn_fin_item(char* lds, const WS& w, const float* ng, int b, int cc, int h) {
    int tid = threadIdx.x; asm volatile("" : "+v"(tid));
    bf16* lo_ = (bf16*)lds;
    __syncthreads();
    for (int i = tid; i < 1024; i += NTHREADS) {
        const int dir = i >> 9, dv = (i >> 3) & 63, k = i & 7;
        const bf16* src = w.uw + ((size_t)(((b * 4 + h) * 2 + dir) * GD_NC + cc) * 2 + 1) * 4096 + dv * 64 + k * 8;
        *(u32x4*)(lo_ + (dir * 64 + dv) * 72 + k * 8) = *(const u32x4*)src;
    }
    __syncthreads();
    const int tl = tid >> 3, dg = tid & 7; const size_t tok = gd_tok0(b, cc) + tl;
    float o[8]; float ss = 0.f;
#pragma unroll
    for (int x = 0; x < 8; ++x) { const int dv = dg * 8 + x; o[x] = bf2f(lo_[dv * 72 + tl]) + bf2f(lo_[(64 + dv) * 72 + 63 - tl]); ss += o[x] * o[x]; }
    ss += __shfl_xor(ss, 1); ss += __shfl_xor(ss, 2); ss += __shfl_xor(ss, 4);
    const float rs = 1.0f / sqrtf(ss * (1.0f / 64.0f) + EPS);
    const u32x4 gt = *(const u32x4*)(w.p + tok * DIN + O3 + 768 + h * 64 + dg * 8);
    u32x4 out;
#pragma unroll
    for (int x = 0; x < 4; ++x) {
        const float g0 = __uint_as_float(gt[x] << 16), g1v = __uint_as_float(gt[x] & 0xffff0000u);
        const float y0 = o[2 * x] * rs * ng[dg * 8 + 2 * x] * (g0 / (1.0f + __expf(-g0))), y1 = o[2 * x + 1] * rs * ng[dg * 8 + 2 * x + 1] * (g1v / (1.0f + __expf(-g1v)));
        out[x] = pack_bf16(y0, y1);
    }
    *(u32x4*)(w.ycat + tok * 1024 + 768 + h * 64 + dg * 8) = out;
}
#endif
#ifndef HOST_SIM
#ifndef REP_INPROJ
#define REP_INPROJ 1
#endif
#ifndef REP_GPRE
#define REP_GPRE 1
#endif
#ifndef REP_HPREP
#define REP_HPREP 1
#endif
#ifndef REP_ATTN
#define REP_ATTN 1
#endif
#ifndef REP_FIN
#define REP_FIN 1
#endif
#ifndef REP_CVT
#define REP_CVT 1
#endif
#ifndef REP_NORM2
#define REP_NORM2 1
#endif
#ifndef REP_UP
#define REP_UP 1
#endif
#ifndef REP_PRO
#define REP_PRO 1
#endif
namespace cg = cooperative_groups;
struct MP { Inputs in; float* out; WS w; };

template <class F> __device__ __forceinline__ void dev_run(const F& f, long n) {
    int t0 = threadIdx.x; asm volatile("" : "+v"(t0));
    for (long i = (long)blockIdx.x * NTHREADS + t0; i < n; i += (long)gridDim.x * NTHREADS) f(i);
}

struct TLInProj {
    const bf16* A; const bf16* Bt; EpiInProj e; static constexpr int K = 1024;
    struct Tile { int m0, n0; };
    __device__ __forceinline__ bool tile(int idx, Tile& t) const {
        constexpr int MT = T / GBM, NT = (DIN + GBN - 1) / GBN;
        if (idx >= MT * NT) return false;
        const int mg = idx / (8 * NT), rem = idx % (8 * NT); t.n0 = (rem / 8) * GBN; t.m0 = (mg * 8 + (rem & 7)) * GBM; return true;
    }
    __device__ __forceinline__ const bf16* arow(const Tile& t, int r) const { return A + (size_t)(t.m0 + r) * D; }
    __device__ __forceinline__ const bf16* brow(const Tile& t, int r) const { return Bt + (size_t)(t.n0 + r) * 1024; }
    __device__ __forceinline__ void epi(const Tile& t, f32x16 (&acc)[2][2], int mr, int nc) const { e(acc, t.m0 + mr, t.n0 + nc); }
};
struct TLOutProj {
    const bf16* A; const bf16* Bt; EpiOutProj e; int ntiles; static constexpr int K = 1024;
    struct Tile { int m0, n0; };
    __device__ __forceinline__ bool tile(int idx, Tile& t) const { if (idx >= ntiles) return false; t.m0 = (idx >> 3) * GBM; t.n0 = (idx & 7) * GBN; return true; }
    __device__ __forceinline__ const bf16* arow(const Tile& t, int r) const { return A + (size_t)(t.m0 + r) * 1024; }
    __device__ __forceinline__ const bf16* brow(const Tile& t, int r) const { return Bt + (size_t)(t.n0 + r) * 1024; }
    __device__ __forceinline__ void epi(const Tile& t, f32x16 (&acc)[2][2], int mr, int nc) const { e(acc, t.m0 + mr, t.n0 + nc); }
};
__device__ __forceinline__ void phase_inproj(char* lds, const WS& w, int l) {
    gemm_stream(lds, TLInProj{l == 0 ? w.h : w.hid2, w.winT + (size_t)l * 3328 * 1024, EpiInProj{w.p, w.rope}});
}
__device__ __forceinline__ void phase_outproj(char* lds, const WS& w, int l, const float* mod, int ntok) {
    gemm_stream(lds, TLOutProj{w.ycat, w.woutT + (size_t)l * 1024 * 1024, EpiOutProj{w.xr, mod}, (ntok / GBM) * 8});
}
struct EpiStoreP { bf16* p;
    __device__ __forceinline__ void operator()(f32x16 (&acc)[2][2], int mrow, int ncol) const {
#pragma unroll
        for (int mi = 0; mi < 2; ++mi)
#pragma unroll
            for (int ni = 0; ni < 2; ++ni)
#pragma unroll
                for (int g = 0; g < 4; ++g) { u32x2 v; v.x = pack_bf16(acc[mi][ni][4 * g], acc[mi][ni][4 * g + 1]); v.y = pack_bf16(acc[mi][ni][4 * g + 2], acc[mi][ni][4 * g + 3]);
                    *(u32x2*)(p + (size_t)(mrow + mi * 32) * 1024 + ncol + ni * 32 + 8 * g) = v; }
    } };
__device__ __forceinline__ void phase_outproj_dup(char* lds, const WS& w, int l, int ntok) {
    const int MT = ntok / GBM, NT = D / GBN;
    const bf16* Bt = w.woutT + (size_t)l * 1024 * 1024;
    for (int tile = blockIdx.x; tile < MT * NT; tile += gridDim.x) {
        const int mt = tile / NT, nt = tile % NT;
        gemm_tile(lds, ARowDense{w.ycat, 1024, mt * GBM}, Bt, 1024, 1024, mt * GBM, nt * GBN, EpiStoreP{w.p});
    }
}
__device__ __forceinline__ int q_next(int* head, int* slot  ) {
    __syncthreads();
    if (threadIdx.x == 0) *slot = __hip_atomic_fetch_add(head, 1, __ATOMIC_RELAXED, __HIP_MEMORY_SCOPE_AGENT);
    __syncthreads();
    return *slot;
}
__global__ void __launch_bounds__(NTHREADS) mega_kernel(MP mp) {
    extern __shared__ __attribute__((aligned(16))) char lds[];
    __shared__ uint4 xb_words;
    __shared__ int q_slot[4];
    cg::grid_group grid = cg::this_grid();
    const Inputs& in = mp.in; const WS& w = mp.w;
    if (threadIdx.x == 0) xb_words = make_uint4(0u, 0u, 0u, 0u);
    __syncthreads();
    XcdBarrier xb = xcd_barrier_post(w.bar, (volatile LAS unsigned*)&xb_words);
#ifndef PROBE
#define PROBE -1
#endif
    unsigned long long tprobe = 0, t0probe = 0; int gs_count = 0;
    if (PROBE >= 0 && blockIdx.x == 0 && threadIdx.x == 0) t0probe = __builtin_amdgcn_s_memrealtime();
#define GSYNC(id) do { xcd_barrier(xb); if (PROBE >= 0) { if (gs_count == PROBE && blockIdx.x == 0 && threadIdx.x == 0) tprobe = __builtin_amdgcn_s_memrealtime(); ++gs_count; } } while (0)
    phase_ada(lds, w, in);
    dev_run(NkRopeTab{w.rope}, NkRopeTab::count());
    dev_run(NkZeroI{w.cnt}, 4 * 32 * 32);
    dev_run(NkZeroI{w.qctr}, 64 * 64);
    for (int rep = 0; rep < REP_PRO; ++rep) for (int l = 0; l < 2; ++l) {
        for (int it = blockIdx.x; it < 16 * 52; it += gridDim.x) cvt_tile(lds, in.w_in + (size_t)l * D * DIN, DIN, w.winT + (size_t)l * 3328 * 1024, 1024, (it / 52) * 64, (it % 52) * 64, DIN, 3328, NMapId{});
        for (int it = blockIdx.x; it < 16 * 16; it += gridDim.x) cvt_tile(lds, in.w_out + (size_t)l * 1024 * D, D, w.woutT + (size_t)l * 1024 * 1024, 1024, (it >> 4) * 64, (it & 15) * 64, D, D, NMapId{});
        NkCvtT c3{in.moe_router + (size_t)l * D * 32, w.wrT + (size_t)l * 32 * 1024, 1024, 32, 32}; dev_run(c3, c3.count());
        dev_run(NkHyF1{in.hy_w1 + l * 33 * 64, in.hy_b1 + l * 64, in.hy_freq + l * 64, w.hyf1 + (size_t)l * (S + LC) * 64}, NkHyF1::count());
    }
    if (mp.out == nullptr) grid.sync();
    xcd_barrier(xb);
    for (int l = 0; l < 2; ++l)
        dev_run(NkHyF2{in.hy_w2 + l * 64 * 64, in.hy_b2 + l * 64, in.hy_freq + l * 64, w.hyf1 + (size_t)l * (S + LC) * 64, w.hyf2 + (size_t)l * (S + LC) * 64}, NkHyF2::count());
    row_pass<0, 1>(w, in, T, w.mod, w.mod, in.norm1, 0, 1, nullptr, nullptr, nullptr, w.h);
    GSYNC(0);
    for (int l = 0; l < 2; ++l) {
        const bool need_ctx = l == 0;
        const float* mod = w.mod + (size_t)l * 9 * 6144;
        const long ntok = need_ctx ? T : TL;
        const float* filt = w.filt + (size_t)l * (S + LC) * 512;
#ifdef XINP2
        phase_inproj(lds, w, l); xcd_barrier(xb); phase_inproj(lds, w, l); xcd_barrier(xb);
#endif
        for (int rep = 0; rep < REP_INPROJ; ++rep) phase_inproj(lds, w, l);
        dev_run(NkHyF3{in.hy_w3 + l * 64 * 512, w.hyf2 + (size_t)l * (S + LC) * 64, w.filt + (size_t)l * (S + LC) * 512}, NkHyF3::count());
        GSYNC(2);
        const float* hcw = in.hy_conv + l * 3 * 768;
#ifdef XAB
        for (int it = blockIdx.x; it < B * GD_NC * 4; it += gridDim.x) gdn_pre_item(lds, w, in.gdn_conv + l * 4 * 768, in.gdn_a_log + l * 8, in.gdn_dt_bias + l * 8, it / (GD_NC * 4), (it >> 2) % GD_NC, it & 3);
        for (int it = blockIdx.x; it < B * 32; it += gridDim.x) hy_prep_item(lds, w.p, hcw, w.x0T, w.uvT, it >> 5, it & 31);
        xcd_barrier(xb);
        {
            const int natt = 512 + (need_ctx ? 64 : 0);
            int* head = w.qctr + l * 64 + 1024;
            for (;;) {
                const int it = q_next(head, q_slot);
                if (it >= 64 + 256 + natt) break;
                if (it < 64) gdn_scan_chain(lds, w, it >> 3, (it >> 1) & 3, it & 1, need_ctx);
                else if (it < 320) hy_conv_item(lds, filt, in.hy_bias + l * 256, w.uvT, w.x0T, it - 64);
                else attn_item(lds, w, in, l, it - 320);
            }
        }
        xcd_barrier(xb);
#endif
        for (int it = blockIdx.x; it < B * GD_NC * 4; it += gridDim.x) gdn_pre_item(lds, w, in.gdn_conv + l * 4 * 768, in.gdn_a_log + l * 8, in.gdn_dt_bias + l * 8, it / (GD_NC * 4), (it >> 2) % GD_NC, it & 3);
        for (int it = blockIdx.x; it < B * 32; it += gridDim.x) hy_prep_item(lds, w.p, hcw, w.x0T, w.uvT, it >> 5, it & 31);
        if (need_ctx) dev_run(NkHyUV{w.p, hcw, w.uv, TL, TC, LC}, (long)TC * 256);
#ifdef XPA
        xcd_barrier(xb);
        for (int it = blockIdx.x; it < B * GD_NC * 4; it += gridDim.x) gdn_pre_item(lds, w, in.gdn_conv + l * 4 * 768, in.gdn_a_log + l * 8, in.gdn_dt_bias + l * 8, it / (GD_NC * 4), (it >> 2) % GD_NC, it & 3);
        for (int it = blockIdx.x; it < B * 32; it += gridDim.x) hy_prep_item(lds, w.p, hcw, w.x0T, w.uvT, it >> 5, it & 31);
#endif
        GSYNC(90);
#ifdef XSCAN
        if (blockIdx.x < 64) gdn_scan_chain(lds, w, blockIdx.x >> 3, (blockIdx.x >> 1) & 3, blockIdx.x & 1, need_ctx);
        xcd_barrier(xb);
        for (int it = blockIdx.x; it < B * GD_NC * 4; it += gridDim.x) gdn_pre_item(lds, w, in.gdn_conv + l * 4 * 768, in.gdn_a_log + l * 8, in.gdn_dt_bias + l * 8, it / (GD_NC * 4), (it >> 2) % GD_NC, it & 3);
        xcd_barrier(xb);
#endif
#ifdef XATT
        for (int it = blockIdx.x; it < 512 + (need_ctx ? 64 : 0); it += gridDim.x) attn_item(lds, w, in, l, it);
        xcd_barrier(xb);
#endif
#ifdef XCONV
        for (int c = blockIdx.x; c < 256; c += gridDim.x) hy_conv_item(lds, filt, in.hy_bias + l * 256, w.uvT, w.x0T, c);
        xcd_barrier(xb);
        for (int it = blockIdx.x; it < B * 32; it += gridDim.x) hy_prep_item(lds, w.p, hcw, w.x0T, w.uvT, it >> 5, it & 31);
        xcd_barrier(xb);
#endif
        {
            const int natt = 512 + (need_ctx ? 64 : 0);
            int* head = w.qctr + l * 64;
            for (;;) {
                const int it = q_next(head, q_slot);
                if (it >= 64 + 256 + natt) break;
                if (it < 64) gdn_scan_chain(lds, w, it >> 3, (it >> 1) & 3, it & 1, need_ctx);
                else if (it < 320) hy_conv_item(lds, filt, in.hy_bias + l * 256, w.uvT, w.x0T, it - 64);
                else attn_item(lds, w, in, l, it - 320);
            }
        }
        GSYNC(91);
        for (int rep = 0; rep < REP_FIN; ++rep) for (int it = blockIdx.x; it < B * 32; it += gridDim.x) hy_fin_item(lds, w.x0T, w.ycat, it >> 5, it & 31);
        if (need_ctx) dev_run(NkHyConv{w.p, hcw, w.uv, filt, in.hy_bias + l * 256, w.ycat, TL, LC, S}, (long)TC * 256);
        for (int rep = 0; rep < REP_FIN; ++rep) for (int it = blockIdx.x; it < B * GD_NC * 4; it += gridDim.x) { const int cc = (it >> 2) % GD_NC; if (cc >= 4 || need_ctx) gdn_fin_item(lds, w, in.gdn_norm + l * 64, it / (GD_NC * 4), cc, it & 3); }
        GSYNC(5);
#ifdef XOUT
        for (int rep = 0; rep < 2; ++rep) phase_outproj_dup(lds, w, l, (int)ntok);
#endif
        phase_outproj(lds, w, l, mod, (int)ntok);
        for (int rep = 0; rep < REP_CVT; ++rep) {
            for (int it = blockIdx.x; it < 33 * 2 * 64; it += gridDim.x) {
                const int e = it / 128, which = (it >> 6) & 1, kt = (it >> 2) & 15, nt = it & 3;
                const float* src = e < 32 ? (which ? in.moe_up : in.moe_gate) + ((size_t)l * 32 + e) * D * 256 : (which ? in.sh_up : in.sh_gate) + (size_t)l * D * 256;
                cvt_tile(lds, src, 256, w.moeUpT + (size_t)e * 512 * 1024, 1024, kt * 64, nt * 64, 256, 256, NMapUp{which});
            }
            for (int it = blockIdx.x; it < 33 * 64; it += gridDim.x) {
                const int e = it >> 6, kt = (it >> 4) & 3, nt = it & 15;
                const float* src = e < 32 ? in.moe_down + ((size_t)l * 32 + e) * 256 * D : in.sh_down + (size_t)l * 256 * D;
                cvt_tile(lds, src, D, w.moeDownT + (size_t)e * 1024 * 256, 256, kt * 64, nt * 64, D, D, NMapId{});
            }
        }
        GSYNC(6);
        for (int rep = 0; rep < REP_NORM2; ++rep) row_pass<1, 1>(w, in, (int)ntok, mod, mod, in.norm2 + l * D, 3, 4, nullptr, nullptr, nullptr, w.h);
        GSYNC(7);
#ifdef XROUT
        { WS w2 = w; w2.cnt = w.cnt + 2 * 32 * 32; w2.list = (int*)w.x0T; for (int rep = 0; rep < 2; ++rep) phase_router(lds, w2, in.moe_bias + l * 32, (int)ntok, l); }
#endif
#ifdef XBAR
        for (int rep = 0; rep < 10; ++rep) xcd_barrier(xb);
#endif
        phase_router(lds, w, in.moe_bias + l * 32, (int)ntok, l);
        GSYNC(8);
        for (int rep = 0; rep < REP_UP; ++rep) phase_moe_up(lds, w, l, (int)ntok);
        GSYNC(9);
#ifdef XDOWN
        for (int rep = 0; rep < 2; ++rep) phase_moe_down_routed(lds, w, l, (int)ntok, mod);
#endif
        phase_moe_down(lds, w, l, (int)ntok, mod);
#ifdef XCOMB
        dev_run(NkZeroI{(int*)w.moeUpT}, 9 * 6144);
#endif
        GSYNC(10);
#ifdef XCOMB
        for (int rep = 0; rep < 2; ++rep) row_pass<2, 0>(w, in, (int)ntok, (const float*)w.moeUpT, mod, nullptr, 0, 0, (const bf16*)w.h, w.topw, nullptr, nullptr);
#endif
        if (l == 0) row_pass<2, 1>(w, in, (int)ntok, mod, w.mod + (size_t)9 * 6144, in.norm1 + D, 0, 1, (const bf16*)w.h, w.topw, nullptr, w.hid2);
        else row_pass<2, 2>(w, in, (int)ntok, mod, mod, in.norm_f, 0, 0, (const bf16*)w.h, w.topw, mp.out, nullptr);
        GSYNC(11);
    }
    if (PROBE >= 0 && blockIdx.x == 0 && threadIdx.x == 0) { const float us = (float)(tprobe - t0probe) * 0.01f; mp.out[0] = sqrtf((float)TL * D * us * 1e-4f); }
}

constexpr size_t kDynLds = G_LDS3;
static_assert(H_LDS <= kDynLds &&  HY_LDS_END <= kDynLds && AT_RING * AT_STAGE + 2048 <= kDynLds && GP_END <= kDynLds && GS_END <= kDynLds, "LDS budget");
extern "C" void kernel_launch(void* const* d_in, const int* in_sizes, int n_in, void* d_out, int out_size, void* d_ws, size_t ws_size, hipStream_t stream) {
    static int grid_blocks = 0;
    if (!grid_blocks) {
        int dev = 0, cus = 0, per_cu = 0;
        hipGetDevice(&dev);
        hipDeviceGetAttribute(&cus, hipDeviceAttributeMultiprocessorCount, dev);
        hipFuncSetAttribute((const void*)mega_kernel, hipFuncAttributeMaxDynamicSharedMemorySize, (int)kDynLds);
        hipOccupancyMaxActiveBlocksPerMultiprocessor(&per_cu, mega_kernel, NTHREADS, kDynLds);
        if (per_cu < 1) per_cu = 1;
        grid_blocks = cus;
    }
    MP mp; memset(&mp, 0, sizeof(mp));
    const float** ip = (const float**)&mp.in;
    for (int i = 0; i < 33; ++i) ip[i] = (const float*)d_in[i];
    mp.out = (float*)d_out; mp.w = make_ws(d_ws);
    hipMemsetAsync(mp.w.bar, 0, 4096 * 4, stream);
    void* args[] = {&mp};
    hipError_t e = hipLaunchCooperativeKernel((void*)mega_kernel, dim3(grid_blocks), dim3(NTHREADS), args, kDynLds, stream);
    if (e != hipSuccess) fprintf(stderr, "cooperative launch failed: %s (grid %d)\n", hipGetErrorString(e), grid_blocks);
}
#endif
```

```cpp
#ifndef HOST_SIM
#include <hip/hip_runtime.h>
#include <hip/hip_cooperative_groups.h>
#include <cstdio>
#include <cstring>
#define HD __host__ __device__ __forceinline__
#else
#include <cmath>
#include <cstdio>
#include <cstdlib>
#include <cstring>
#define HD inline
typedef void* hipStream_t;
#endif
#include <cstdint>
#include <cstddef>

#ifndef BATCH
#define BATCH 8
#endif
constexpr int B = BATCH, S = 2048, D = 1024, LC = 256, GRID_W = 64;
constexpr int TL = B * S, TC = B * LC, T = TL + TC;
constexpr int DIN = 3088, O1 = 768, O2 = 1280, O3 = 2048;
constexpr int WINDOW = 128, NA_KR = 8, NA_KC = 16;
constexpr float EPS = 1e-6f, ROPE_BASE = 10000.0f, ROUTED_SCALE = 2.5f;
constexpr float HY_DECAY_MIN = 3.0701134573253946f;
constexpr float HY_DECAY_MAX = 15.350567286626973f;
typedef unsigned short bf16;

HD float bf2f(bf16 h) { union { unsigned u; float f; } v; v.u = (unsigned)h << 16; return v.f; }
HD bf16 f2bf(float f) { union { float f; unsigned u; } v; v.f = f; unsigned u = v.u; u += 0x7fffu + ((u >> 16) & 1u); return (bf16)(u >> 16); }
HD float siluf(float x) { return x / (1.0f + expf(-x)); }

struct NkCopyX {
    const float* x; const float* ctx; float* xr;
    HD void operator()(long i) const { xr[i] = i < (long)TL * D ? x[i] : ctx[i - (long)TL * D]; }
    static HD long count() { return (long)T * D; }
};

struct NkAda {
    const float* c; const float* cctx; const float* w_ada; const float* b_ada; float* mod;
    HD void operator()(long i) const {
        int n = (int)(i % 6144); int r = (int)((i / 6144) % 9); int l = (int)(i / (6144 * 9));
        const float* cv = r < 8 ? c + (long)(r % B) * D : cctx;
        const float* w = w_ada + (long)l * D * 6144 + n;
        float acc = 0.f;
        for (int k = 0; k < D; ++k) { float v = cv[k]; acc += siluf(v) * w[(long)k * 6144]; }
        mod[i] = acc + b_ada[l * 6144 + n];
    }
    static HD long count() { return 2L * 9 * 6144; }
};

struct NkRstd {
    const float* xr; float* rstd; int nrows;
    HD void operator()(long t) const {
        const float* r = xr + t * D; float s = 0.f;
        for (int k = 0; k < D; ++k) s += r[k] * r[k];
        rstd[t] = 1.0f / sqrtf(s * (1.0f / D) + EPS);
    }
};

struct NkModNorm {
    const float* xr; const float* rstd; const float* g; const float* mod;   int sh_chunk, sc_chunk; bf16* h;
    HD void operator()(long i) const {
        long t = i / D; int k = (int)(i % D); int r = t < TL ? (int)(t / S) : 8;
        const float* m = mod + (long)r * 6144;
        float v = xr[i] * rstd[t] * g[k];
        h[i] = f2bf(v * (1.0f + m[sc_chunk * D + k]) + m[sh_chunk * D + k]);
    }
};

struct NkInProj {
    const bf16* h; const float* w; bf16* p;
    HD void operator()(long i) const {
        long t = i / DIN; int n = (int)(i % DIN);
        const bf16* hr = h + t * D; float acc = 0.f;
        for (int k = 0; k < D; ++k) acc += bf2f(hr[k]) * w[(long)k * DIN + n];
        p[i] = f2bf(acc);
    }
    static HD long count() { return (long)T * DIN; }
};

struct NkRope {
    bf16* p;
    HD void operator()(long i) const {
        int pr = (int)(i % 32); int hd = (int)((i / 32) % 6); long t = i / (32 * 6);
        int s = (int)(t % S); int row = s / GRID_W, col = s % GRID_W;
        int axis = pr >> 4, j = pr & 15;
        float pos = axis == 0 ? (float)row : (float)col;
        float inv = powf(ROPE_BASE, -(float)j / 16.0f);
        float ang = pos * inv; float cs = cosf(ang), sn = sinf(ang);
        bf16* q = p + t * DIN + O1 + hd * 64 + axis * 32;
        float x1 = bf2f(q[j]), x2 = bf2f(q[j + 16]);
        q[j] = f2bf(x1 * cs - x2 * sn); q[j + 16] = f2bf(x1 * sn + x2 * cs);
    }
    static HD long count() { return (long)TL * 6 * 32; }
};

struct NkHyF1 {
    const float* w1; const float* b1; const float* freq; float* f1;
    HD void operator()(long i) const {
        int j = (int)(i % 64); int tt = (int)(i / 64); int L = tt < S ? S : LC; int t = tt < S ? tt : tt - S;
        float tn = (float)t / (float)(L - 1);
        float acc = tn * w1[j];
        for (int bnd = 0; bnd < 16; ++bnd) {
            float band = 1e-4f + (float)bnd * ((15.0f - 1e-4f) / 15.0f);
            float ang = (6.283185307179586f / (float)L) * (float)t * band;
            acc += cosf(ang) * w1[(1 + bnd) * 64 + j] - sinf(ang) * w1[(17 + bnd) * 64 + j];
        }
        f1[i] = sinf(freq[j] * (acc + b1[j]));
    }
    static HD long count() { return (long)(S + LC) * 64; }
};
struct NkHyF2 {
    const float* w2; const float* b2; const float* freq; const float* f1; float* f2; bf16* f2b;
    HD void operator()(long i) const {
        int j = (int)(i % 64); long tt = i / 64; float acc = 0.f;
        for (int k = 0; k < 64; ++k) acc += f1[tt * 64 + k] * w2[k * 64 + j];
        const float v = sinf(freq[j] * (acc + b2[j]));
        f2[i] = v; if (f2b) f2b[i] = f2bf(v);
    }
    static HD long count() { return (long)(S + LC) * 64; }
};
struct NkHyF3 {
    const float* w3; const float* f2; float* filt;
    HD void operator()(long i) const {
        int tt = (int)(i % (S + LC)); int c = (int)(i / (S + LC)); int L = tt < S ? S : LC; int t = tt < S ? tt : tt - S;
        float tn = (float)t / (float)(L - 1);
        float acc = 0.f;
        for (int k = 0; k < 64; ++k) acc += f2[(long)tt * 64 + k] * w3[k * 512 + c];
        int cc = c & 255;
        float decay = HY_DECAY_MIN + (float)cc * ((HY_DECAY_MAX - HY_DECAY_MIN) / 255.0f);
        filt[(long)c * (S + LC) + tt] = acc * expf(-tn * decay);
    }
    static HD long count() { return (long)(S + LC) * 512; }
};
HD float hy_conv3(const bf16* p, long t, int tin, int L, int col, const float* cw) {
    float acc = cw[768 + col] * bf2f(p[t * DIN + col]);
    if (tin > 0) acc += cw[col] * bf2f(p[(t - 1) * DIN + col]);
    if (tin < L - 1) acc += cw[2 * 768 + col] * bf2f(p[(t + 1) * DIN + col]);
    return acc;
}
struct NkHyUV {
    const bf16* p; const float* cw; bf16* uv; long tbase; long ntok; int L;
    HD void operator()(long i) const {
        int c = (int)(i % 256); long t = tbase + i / 256; int tin = (int)((t - tbase) % L);
        float x1 = hy_conv3(p, t, tin, L, 256 + c, cw), v = hy_conv3(p, t, tin, L, 512 + c, cw);
        uv[t * 256 + c] = f2bf(x1 * v);
    }
};
struct NkHyConv {
    const bf16* p; const float* cw; const bf16* uv; const float* filt; const float* hbias; bf16* ycat; long tbase; int L; int foff;
    HD void operator()(long i) const {
        int tin = (int)(i % L); int c = (int)((i / L) % 256); long seq = i / ((long)L * 256); long t0 = tbase + seq * L; long t = t0 + tin;
        const float* f = filt + foff;
        float acc = 0.f;
        for (int s = 0; s < L; ++s) {
            int d = tin - s; float k = d >= 0 ? f[(long)c * (S + LC) + d] : f[(long)(256 + c) * (S + LC) - d];
            acc += k * bf2f(uv[(t0 + s) * 256 + c]);
        }
        acc += hbias[c] * bf2f(uv[t * 256 + c]);
        float x0 = hy_conv3(p, t, tin, L, c, cw);
        ycat[t * 1024 + c] = f2bf(x0 * acc);
    }
};

HD void attn_key(const float (&q)[64], const bf16* kr, const bf16* vr, float bias, float& m, float& l, float (&acc)[64]) {
    float sc = 0.f;
#pragma unroll
    for (int d = 0; d < 64; ++d) sc += q[d] * bf2f(kr[d]);
    sc = sc * 0.125f + bias;
    float mn = fmaxf(m, sc); float ca = expf(m - mn), cb = expf(sc - mn);
    l = l * ca + cb; m = mn;
#pragma unroll
    for (int d = 0; d < 64; ++d) acc[d] = acc[d] * ca + cb * bf2f(vr[d]);
}
struct NkWA {
    const bf16* p; const float* sink; bf16* ycat;
    HD void operator()(long i) const {
        int hq = (int)(i % 4); long t = i / 4; int b = (int)(t / S), s = (int)(t % S); int hk = hq >> 1;
        const bf16* qp = p + t * DIN + O1 + hq * 64;
        float q[64], acc[64];
#pragma unroll
        for (int d = 0; d < 64; ++d) { q[d] = bf2f(qp[d]); acc[d] = 0.f; }
        float m = sink[hq], l = 1.0f;
        for (int j = 0; j < LC; ++j) {
            const bf16* kr = p + ((long)TL + (long)b * LC + j) * DIN + O1 + 256 + hk * 64;
            attn_key(q, kr, kr + 128, 0.f, m, l, acc);
        }
        int j0 = s - WINDOW < 0 ? 0 : s - WINDOW, j1 = s + WINDOW > S - 1 ? S - 1 : s + WINDOW;
        for (int j = j0; j <= j1; ++j) {
            const bf16* kr = p + ((long)b * S + j) * DIN + O1 + 256 + hk * 64;
            attn_key(q, kr, kr + 128, 0.f, m, l, acc);
        }
        float il = 1.0f / l;
#pragma unroll
        for (int d = 0; d < 64; ++d) ycat[t * 1024 + 256 + hq * 64 + d] = f2bf(acc[d] * il);
    }
    static HD long count() { return (long)TL * 4; }
};
struct NkWACtx {
    const bf16* p; const float* sink; bf16* ycat;
    HD void operator()(long i) const {
        int hq = (int)(i % 4); long tc = i / 4; int b = (int)(tc / LC); int hk = hq >> 1; long t = TL + tc;
        const bf16* qp = p + t * DIN + O1 + hq * 64;
        float q[64], acc[64];
#pragma unroll
        for (int d = 0; d < 64; ++d) { q[d] = bf2f(qp[d]); acc[d] = 0.f; }
        float m = sink[hq], l = 1.0f;
        for (int j = 0; j < LC; ++j) {
            const bf16* kr = p + ((long)TL + (long)b * LC + j) * DIN + O1 + 256 + hk * 64;
            attn_key(q, kr, kr + 128, 0.f, m, l, acc);
        }
        float il = 1.0f / l;
#pragma unroll
        for (int d = 0; d < 64; ++d) ycat[t * 1024 + 256 + hq * 64 + d] = f2bf(acc[d] * il);
    }
    static HD long count() { return (long)TC * 4; }
};
struct NkNA {
    const bf16* p; const float* rpb; bf16* ycat;
    HD void operator()(long i) const {
        int h = (int)(i % 4); long t = i / 4; int b = (int)(t / S), s = (int)(t % S);
        int r = s / GRID_W, cq = s % GRID_W;
        const bf16* qp = p + t * DIN + O2 + h * 64;
        float q[64], acc[64];
#pragma unroll
        for (int d = 0; d < 64; ++d) { q[d] = bf2f(qp[d]); acc[d] = 0.f; }
        float m = -1e30f, l = 0.f;
        for (int j = 0; j < LC; ++j) {
            const bf16* kr = p + ((long)TL + (long)b * LC + j) * DIN + O2 + 256 + h * 64;
            attn_key(q, kr, kr + 256, 0.f, m, l, acc);
        }
        int r0 = r - NA_KR / 2; r0 = r0 < 0 ? 0 : (r0 > S / GRID_W - NA_KR ? S / GRID_W - NA_KR : r0);
        int c0 = cq - NA_KC / 2; c0 = c0 < 0 ? 0 : (c0 > GRID_W - NA_KC ? GRID_W - NA_KC : c0);
        for (int kk = 0; kk < NA_KR * NA_KC; ++kk) {
            int kr_ = r0 + kk / NA_KC, kc_ = c0 + kk % NA_KC;
            const bf16* kr = p + ((long)b * S + kr_ * GRID_W + kc_) * DIN + O2 + 256 + h * 64;
            attn_key(q, kr, kr + 256, rpb[(h * 15 + (kr_ - r + 7)) * 31 + (kc_ - cq + 15)], m, l, acc);
        }
        float il = 1.0f / l;
#pragma unroll
        for (int d = 0; d < 64; ++d) ycat[t * 1024 + 512 + h * 64 + d] = f2bf(acc[d] * il);
    }
    static HD long count() { return (long)TL * 4; }
};
struct NkNACtx {
    const bf16* p; bf16* ycat;
    HD void operator()(long i) const {
        int h = (int)(i % 4); long tc = i / 4; int b = (int)(tc / LC); long t = TL + tc;
        const bf16* qp = p + t * DIN + O2 + h * 64;
        float q[64], acc[64];
#pragma unroll
        for (int d = 0; d < 64; ++d) { q[d] = bf2f(qp[d]); acc[d] = 0.f; }
        float m = -1e30f, l = 0.f;
        for (int j = 0; j < LC; ++j) {
            const bf16* kr = p + ((long)TL + (long)b * LC + j) * DIN + O2 + 256 + h * 64;
            attn_key(q, kr, kr + 256, 0.f, m, l, acc);
        }
        float il = 1.0f / l;
#pragma unroll
        for (int d = 0; d < 64; ++d) ycat[t * 1024 + 512 + h * 64 + d] = f2bf(acc[d] * il);
    }
    static HD long count() { return (long)TC * 4; }
};

HD float gdn_conv4(const bf16* p, long t, int tin, int L, int col, const float* cw) {
    float acc = 0.f;
    for (int i = 0; i < 4; ++i) { int o = i - 2; if (tin + o >= 0 && tin + o < L) acc += cw[i * 768 + col] * bf2f(p[(t + o) * DIN + O3 + col]); }
    return siluf(acc);
}
struct NkGdnPrep {
    const bf16* p; const float* cw; bf16* qkv;
    HD void operator()(long i) const {
        int e = (int)(i % 64); int wh = (int)((i / 64) % 12); long t = i / 768; int which = wh / 4;
        int L = t < TL ? S : LC; int tin = t < TL ? (int)(t % S) : (int)((t - TL) % LC);
        int col0 = wh * 64;
        float v = gdn_conv4(p, t, tin, L, col0 + e, cw);
        if (which < 2) {
            float ss = 0.f; for (int d = 0; d < 64; ++d) { float u = gdn_conv4(p, t, tin, L, col0 + d, cw); ss += u * u; }
            v *= 1.0f / sqrtf(ss + EPS); if (which == 0) v *= 0.125f;
        }
        qkv[t * 768 + col0 + e] = f2bf(v);
    }
    static HD long count() { return (long)T * 768; }
};
struct NkGdnGate {
    const bf16* p; const float* a_log; const float* dt_bias; float* gb;
    HD void operator()(long i) const {
        int dh = (int)(i % 8); long t = i / 8;
        float a = bf2f(p[t * DIN + O3 + 1024 + dh]), bb = bf2f(p[t * DIN + O3 + 1032 + dh]);
        float x = a + dt_bias[dh]; float sp = x > 20.f ? x : log1pf(expf(x));
        gb[t * 16 + dh] = -expf(a_log[dh]) * sp; gb[t * 16 + 8 + dh] = 1.0f / (1.0f + expf(-bb));
    }
    static HD long count() { return (long)T * 8; }
};
struct NkGdnRec {
    const bf16* qkv; const float* gb; bf16* o;
    HD void operator()(long i) const {
        int e = (int)(i % 64); int dir = (int)((i / 64) % 2); int h = (int)((i / 128) % 4); int b = (int)(i / 512);
        float Sc[64];
#pragma unroll
        for (int d = 0; d < 64; ++d) Sc[d] = 0.f;
        for (int step = 0; step < LC + S; ++step) {
            long t;
            if (step < LC) { int j = dir ? LC - 1 - step : step; t = (long)TL + (long)b * LC + j; }
            else { int s = step - LC; s = dir ? S - 1 - s : s; t = (long)b * S + s; }
            const bf16* qr = qkv + t * 768 + h * 64; const bf16* kr = qr + 256; float v = bf2f(qr[512 + e]);
            float a = expf(gb[t * 16 + dir * 4 + h]), beta = gb[t * 16 + 8 + dir * 4 + h];
            float kS = 0.f;
#pragma unroll
            for (int c = 0; c < 4; ++c) {
#pragma unroll
                for (int d = c * 16; d < c * 16 + 16; ++d) kS += bf2f(kr[d]) * Sc[d];
                asm volatile("" ::: "memory");
            }
            float w = beta * (v - a * kS); float oo = 0.f;
#pragma unroll
            for (int c = 0; c < 4; ++c) {
#pragma unroll
                for (int d = c * 16; d < c * 16 + 16; ++d) { Sc[d] = a * Sc[d] + bf2f(kr[d]) * w; oo += bf2f(qr[d]) * Sc[d]; }
                asm volatile("" ::: "memory");
            }
            o[((long)dir * T + t) * 256 + h * 64 + e] = f2bf(oo);
        }
    }
    static HD long count() { return (long)B * 4 * 2 * 64; }
};
struct NkGdnFin {
    const bf16* p; const bf16* o; const float* ng; bf16* ycat;
    HD void operator()(long i) const {
        int e = (int)(i % 64); int h = (int)((i / 64) % 4); long t = i / 256;
        const bf16* o0 = o + t * 256 + h * 64; const bf16* o1 = o + ((long)T + t) * 256 + h * 64;
        float ss = 0.f; for (int d = 0; d < 64; ++d) { float u = bf2f(o0[d]) + bf2f(o1[d]); ss += u * u; }
        float v = (bf2f(o0[e]) + bf2f(o1[e])) * (1.0f / sqrtf(ss * (1.0f / 64.0f) + EPS)) * ng[e];
        float gt = bf2f(p[t * DIN + O3 + 768 + h * 64 + e]);
        ycat[t * 1024 + 768 + h * 64 + e] = f2bf(v * siluf(gt));
    }
    static HD long count() { return (long)T * 256; }
};

struct NkOutProj {
    const bf16* ycat; const float* w; const float* mod; float* xr; long ntok;
    HD void operator()(long i) const {
        long t = i / D; int n = (int)(i % D); int r = t < TL ? (int)(t / S) : 8;
        const bf16* yr = ycat + t * 1024; float acc = 0.f;
        for (int k = 0; k < 1024; ++k) acc += bf2f(yr[k]) * w[(long)k * D + n];
        xr[i] += mod[(long)r * 6144 + 2 * D + n] * acc;
    }
};

struct NkRouter {
    const bf16* h; const float* wr; float* scores;
    HD void operator()(long i) const {
        int e = (int)(i % 32); long t = i / 32; float acc = 0.f;
        for (int k = 0; k < D; ++k) acc += bf2f(h[t * D + k]) * wr[k * 32 + e];
        scores[i] = 1.0f / (1.0f + expf(-acc));
    }
};
struct NkTopK {
    const float* scores; const float* ebias; int* topi; float* topw;
    HD void operator()(long t) const {
        int sel[4]; float ss[4]; float sum = 0.f;
#pragma unroll
        for (int k = 0; k < 4; ++k) {
            int best = -1; float bv = -1e30f;
            for (int e = 0; e < 32; ++e) {
                bool used = false;
#pragma unroll
                for (int q = 0; q < 4; ++q) if (q < k && sel[q] == e) used = true;
                float v = scores[t * 32 + e] + ebias[e];
                if (!used && v > bv) { bv = v; best = e; }
            }
            sel[k] = best; ss[k] = scores[t * 32 + best]; sum += ss[k];
        }
#pragma unroll
        for (int k = 0; k < 4; ++k) { topi[t * 4 + k] = sel[k]; topw[t * 4 + k] = ss[k] / sum * ROUTED_SCALE; }
    }
};
struct NkMoeHid {
    const bf16* h; const int* topi; const float* wg; const float* wu; const float* sg; const float* su; bf16* hid;
    HD void operator()(long i) const {
        int j = (int)(i % 256); int slot = (int)((i / 256) % 5); long t = i / 1280;
        const float* g; const float* u;
        if (slot < 4) { int e = topi[t * 4 + slot]; g = wg + (long)e * D * 256; u = wu + (long)e * D * 256; } else { g = sg; u = su; }
        float ag = 0.f, au = 0.f;
        for (int k = 0; k < D; ++k) { float x = bf2f(h[t * D + k]); ag += x * g[(long)k * 256 + j]; au += x * u[(long)k * 256 + j]; }
        hid[i] = f2bf(siluf(ag) * au);
    }
};
struct NkMoeOut {
    const bf16* hid; const int* topi; const float* topw; const float* wd; const float* sd; const float* mod; float* xr;
    HD void operator()(long i) const {
        long t = i / D; int n = (int)(i % D); int r = t < TL ? (int)(t / S) : 8;
        float f = 0.f;
        for (int slot = 0; slot < 5; ++slot) {
            const float* w; float wt;
            if (slot < 4) { w = wd + (long)topi[t * 4 + slot] * 256 * D; wt = topw[t * 4 + slot]; } else { w = sd; wt = 1.0f; }
            float acc = 0.f;
            for (int j = 0; j < 256; ++j) acc += bf2f(hid[(t * 5 + slot) * 256 + j]) * w[(long)j * D + n];
            f += wt * acc;
        }
        xr[i] += mod[(long)r * 6144 + 5 * D + n] * f;
    }
};
struct NkFinal {
    const float* xr; const float* rstd; const float* g; float* out;
    HD void operator()(long i) const { long t = i / D; int k = (int)(i % D); out[i] = xr[i] * rstd[t] * g[k]; }
    static HD long count() { return (long)TL * D; }
};

struct NkCvtT {
    const float* src; bf16* dst; int K, N, Npad;
    HD void operator()(long i) const {
        int n = (int)(i % Npad); int k0 = (int)(i / Npad) * 8;
        bf16 v[8];
#pragma unroll
        for (int j = 0; j < 8; ++j) v[j] = n < N ? f2bf(src[(long)(k0 + j) * N + n]) : (bf16)0;
        bf16* d = dst + (long)n * K + k0;
#pragma unroll
        for (int j = 0; j < 8; ++j) d[j] = v[j];
    }
    HD long count() const { return (long)Npad * (K / 8); }
};
struct NkRopeTab {
    float* rope;
    HD void operator()(long i) const {
        int j = (int)(i % 16); int pos = (int)(i / 16);
        float ang = (float)pos * powf(ROPE_BASE, -(float)j / 16.0f);
        rope[i * 2] = cosf(ang); rope[i * 2 + 1] = sinf(ang);
    }
    static HD long count() { return 64 * 16; }
};

struct NkCvtUp {
    const float* wg; const float* wu; const float* sg; const float* su; bf16* dst;
    HD void operator()(long i) const {
        int j = (int)(i % 256); int k0 = (int)((i / 256) % 128) * 8; int which = (int)((i / (256 * 128)) % 2); int e = (int)(i / (256 * 128 * 2));
        const float* src = e < 32 ? (which ? wu : wg) + (long)e * D * 256 : (which ? su : sg);
        int np = (j >> 6) * 128 + ((j >> 5) & 1) * 64 + which * 32 + (j & 31);
        bf16* d = dst + ((long)e * 512 + np) * 1024 + k0;
#pragma unroll
        for (int q = 0; q < 8; ++q) d[q] = f2bf(src[(long)(k0 + q) * 256 + j]);
    }
    static HD long count() { return 33L * 2 * 128 * 256; }
};
struct NkCvtDown {
    const float* wd; const float* sd; bf16* dst;
    HD void operator()(long i) const {
        int n = (int)(i % 1024); int j0 = (int)((i / 1024) % 32) * 8; int e = (int)(i / (1024 * 32));
        const float* src = e < 32 ? wd + (long)e * 256 * D : sd;
        bf16* d = dst + ((long)e * 1024 + n) * 256 + j0;
#pragma unroll
        for (int q = 0; q < 8; ++q) d[q] = f2bf(src[(long)(j0 + q) * D + n]);
    }
    static HD long count() { return 33L * 32 * 1024; }
};
struct NkZeroI { int* p; HD void operator()(long i) const { p[i] = 0; } };
struct WS {
    float* mod; float* rstd; float* xr; bf16* h; bf16* p; bf16* ycat; float* hyf1; float* hyf2; float* filt; bf16* uv;
    bf16* qkv; float* gb; bf16* o; float* scores; int* topi; float* topw; bf16* hid;
    bf16* winT; bf16* woutT; bf16* wrT; float* rope; unsigned* bar; int* cnt; int* list;
    bf16* moeUpT; bf16* hid2; bf16* moeDownT;
    bf16* qk; bf16* uw; float* gc; bf16* x0T; bf16* uvT; int* qctr; bf16* x0Tc; bf16* uvTc; bf16* w3T; bf16* f2b;
};
static inline WS make_ws(void* d_ws) {
    char* base = (char*)d_ws; size_t off = 0;
    auto take = [&](size_t bytes) { char* r = base + off; off += (bytes + 255) & ~(size_t)255; return r; };
    WS w;
    w.mod = (float*)take(2ul * 9 * 6144 * 4);
    w.rstd = (float*)take((size_t)T * 4);
    w.hyf1 = (float*)take(2 * (size_t)(S + LC) * 64 * 4);
    w.hyf2 = (float*)take(2 * (size_t)(S + LC) * 64 * 4);
    w.filt = (float*)take(2 * (size_t)(S + LC) * 512 * 4);
    w.gb = (float*)take((size_t)T * 16 * 4);
#ifdef HOST_SIM
    w.scores = (float*)take((size_t)T * 32 * 4); w.topi = (int*)take((size_t)T * 4 * 4);
#else
    w.scores = nullptr; w.topi = nullptr;
#endif
    w.topw = (float*)take((size_t)T * 4 * 4);
    w.winT = (bf16*)take(2ul * 3328 * 1024 * 2);
    w.woutT = (bf16*)take(2ul * 1024 * 1024 * 2);
    w.wrT = (bf16*)take(2ul * 32 * 1024 * 2);
    w.rope = (float*)take(64 * 16 * 2 * 4);
    w.bar = (unsigned*)take(4096 * 4);
    w.cnt = (int*)take(4 * 32 * 32 * 4);
    w.list = (int*)take((size_t)32 * T * 4);
    w.qctr = (int*)take(64 * 64 * 4);
    w.w3T = (bf16*)take(2ul * 512 * 64 * 2);
    w.f2b = (bf16*)take(2ul * (S + LC) * 64 * 2);
    w.xr = (float*)take((size_t)T * D * 4);
    w.h = (bf16*)take((size_t)T * D * 2);
    w.p = (bf16*)take((size_t)T * DIN * 2);
    w.hid = (bf16*)w.p;
    char* R = take(0);
    const size_t szUp = 33ul * 512 * 1024 * 2, szHid = ((size_t)5 * T + 256) * 256 * 2, szDown = 33ul * 1024 * 256 * 2;
    w.moeUpT = (bf16*)R; w.hid2 = (bf16*)(R + szUp); w.moeDownT = (bf16*)(R + szUp + szHid);
    w.qkv = (bf16*)R;
    w.qk = (bf16*)R;
    w.ycat = w.hid2;
    w.o = (bf16*)((char*)w.ycat + (size_t)T * 1024 * 2);
    w.x0T = (bf16*)((char*)w.ycat + (size_t)T * 1024 * 2);
    w.uvT = w.x0T + (size_t)256 * B * S;
    w.uv = w.uvT + (size_t)256 * B * S;
    w.uw = w.h; w.gc = w.gb;
    w.x0Tc = w.uv; w.uvTc = w.uv + (size_t)256 * B * LC;
    size_t rsz = szUp + szHid + szDown; const size_t rsz2 = szUp + (size_t)T * 1024 * 2 + (size_t)2 * 256 * B * S * 2 + (size_t)T * 256 * 2;
    if (rsz2 > rsz) rsz = rsz2;
    (void)take(rsz);
    return w;
}
#ifdef HOST_SIM
template <class F> static inline void run(F f, long n, hipStream_t) {
#pragma omp parallel for schedule(dynamic, 256)
    for (long i = 0; i < n; ++i) f(i);
}
#endif

struct Inputs {
    const float *x, *c, *ctx, *c_ctx, *w_ada, *b_ada, *norm1, *norm2, *norm_f, *w_in, *w_out, *hy_conv, *hy_w1, *hy_b1, *hy_w2, *hy_b2, *hy_w3, *hy_freq, *hy_bias,
        *wa_sink, *na_rpb, *gdn_conv, *gdn_a_log, *gdn_dt_bias, *gdn_norm, *moe_router, *moe_bias, *moe_gate, *moe_up, *moe_down, *sh_gate, *sh_up, *sh_down;
};

#ifdef HOST_SIM
static void forward_naive(const Inputs& in, float* out, const WS& w, hipStream_t st) {
    run(NkCopyX{in.x, in.ctx, w.xr}, NkCopyX::count(), st);
    run(NkAda{in.c, in.c_ctx, in.w_ada, in.b_ada, w.mod}, NkAda::count(), st);
    for (int l = 0; l < 2; ++l) {
        const bool need_ctx = l == 0;
        const float* mod = w.mod + (size_t)l * 9 * 6144;
        run(NkRstd{w.xr, w.rstd, T}, T, st);
        run(NkModNorm{w.xr, w.rstd, in.norm1 + l * D, mod, 0, 1, w.h}, (long)T * D, st);
        run(NkInProj{w.h, in.w_in + (size_t)l * D * DIN, w.p}, NkInProj::count(), st);
        run(NkRope{w.p}, NkRope::count(), st);
        run(NkHyF1{in.hy_w1 + l * 33 * 64, in.hy_b1 + l * 64, in.hy_freq + l * 64, w.hyf1}, NkHyF1::count(), st);
        run(NkHyF2{in.hy_w2 + l * 64 * 64, in.hy_b2 + l * 64, in.hy_freq + l * 64, w.hyf1, w.hyf2, nullptr}, NkHyF2::count(), st);
        run(NkHyF3{in.hy_w3 + l * 64 * 512, w.hyf2, w.filt}, NkHyF3::count(), st);
        const float* hcw = in.hy_conv + l * 3 * 768;
        run(NkHyUV{w.p, hcw, w.uv, 0, TL, S}, (long)TL * 256, st);
        run(NkHyConv{w.p, hcw, w.uv, w.filt, in.hy_bias + l * 256, w.ycat, 0, S, 0}, (long)TL * 256, st);
        if (need_ctx) {
            run(NkHyUV{w.p, hcw, w.uv, TL, TC, LC}, (long)TC * 256, st);
            run(NkHyConv{w.p, hcw, w.uv, w.filt, in.hy_bias + l * 256, w.ycat, TL, LC, S}, (long)TC * 256, st);
        }
        run(NkWA{w.p, in.wa_sink + l * 4, w.ycat}, NkWA::count(), st);
        if (need_ctx) run(NkWACtx{w.p, in.wa_sink + l * 4, w.ycat}, NkWACtx::count(), st);
        run(NkNA{w.p, in.na_rpb + l * 4 * 15 * 31, w.ycat}, NkNA::count(), st);
        if (need_ctx) run(NkNACtx{w.p, w.ycat}, NkNACtx::count(), st);
        run(NkGdnPrep{w.p, in.gdn_conv + l * 4 * 768, w.qkv}, NkGdnPrep::count(), st);
        run(NkGdnGate{w.p, in.gdn_a_log + l * 8, in.gdn_dt_bias + l * 8, w.gb}, NkGdnGate::count(), st);
        run(NkGdnRec{w.qkv, w.gb, w.o}, NkGdnRec::count(), st);
        run(NkGdnFin{w.p, w.o, in.gdn_norm + l * 64, w.ycat}, need_ctx ? (long)T * 256 : (long)TL * 256, st);
        const long ntok = need_ctx ? T : TL;
        run(NkOutProj{w.ycat, in.w_out + (size_t)l * 1024 * D, mod, w.xr, ntok}, ntok * D, st);
        run(NkRstd{w.xr, w.rstd, (int)ntok}, ntok, st);
        run(NkModNorm{w.xr, w.rstd, in.norm2 + l * D, mod, 3, 4, w.h}, ntok * D, st);
        run(NkRouter{w.h, in.moe_router + l * D * 32, w.scores}, ntok * 32, st);
        run(NkTopK{w.scores, in.moe_bias + l * 32, w.topi, w.topw}, ntok, st);
        run(NkMoeHid{w.h, w.topi, in.moe_gate + (size_t)l * 32 * D * 256, in.moe_up + (size_t)l * 32 * D * 256, in.sh_gate + (size_t)l * D * 256, in.sh_up + (size_t)l * D * 256, w.hid}, ntok * 1280, st);
        run(NkMoeOut{w.hid, w.topi, w.topw, in.moe_down + (size_t)l * 32 * 256 * D, in.sh_down + (size_t)l * 256 * D, mod, w.xr}, ntok * D, st);
    }
    run(NkRstd{w.xr, w.rstd, TL}, TL, st);
    run(NkFinal{w.xr, w.rstd, in.norm_f, out}, NkFinal::count(), st);
}


#endif
#ifdef HOST_SIM
extern "C" void kernel_launch(void* const* d_in, const int* in_sizes, int n_in, void* d_out, int out_size, void* d_ws, size_t ws_size, hipStream_t stream) {
    Inputs in;
    const float** ip = (const float**)&in;
    for (int i = 0; i < 33; ++i) ip[i] = (const float*)d_in[i];
    WS w = make_ws(d_ws);
    forward_naive(in, (float*)d_out, w, stream);
}

#endif
#ifndef HOST_SIM
#define XB_TMO      128
#define XB_XCNT(j)  (256  + 64 * (j))
#define XB_XSUB(j)  (1280 + 64 * (j))
#define XB_XGEN(j)  (2304 + 64 * (j))
#define XB_TOP      3328
#define XB_TOPGEN   3392
#define XCD_BAR_WORDS 3456
#define XB_SPIN_CAP (1u << 26)
#define LAS __attribute__((address_space(3)))
__device__ __forceinline__ unsigned xb_ld(unsigned* p)              { return __hip_atomic_load(p, __ATOMIC_RELAXED, __HIP_MEMORY_SCOPE_AGENT); }
__device__ __forceinline__ unsigned xb_add(unsigned* p, unsigned v) { return __hip_atomic_fetch_add(p, v, __ATOMIC_RELAXED, __HIP_MEMORY_SCOPE_AGENT); }
__device__ __forceinline__ unsigned xb_xcc_id() { return (unsigned)__builtin_amdgcn_s_getreg((3 << 11) | 20) & 0xFu; }
#define XB_SPIN(cond, bar) do { unsigned _sp = 0; while (cond) { __builtin_amdgcn_s_sleep(1); \
    if ((++_sp & 255u) == 0u) { if (xb_ld(&(bar)[XB_TMO])) break; if (_sp > XB_SPIN_CAP) { atomicAdd(&(bar)[XB_TMO], 1u); break; } } } } while (0)
struct XcdBarrier { unsigned* bar; unsigned x; volatile LAS unsigned* st; };
__device__ __forceinline__ XcdBarrier xcd_barrier_post(unsigned* bar, volatile LAS unsigned* st) {
    XcdBarrier b; b.bar = bar; b.x = xb_xcc_id(); b.st = st;
    if (threadIdx.x == 0) (void)xb_add(&bar[XB_XCNT(b.x)], 1u);
    return b;
}
__device__ __forceinline__ void xcd_barrier_complete(unsigned* bar, unsigned x, unsigned& nloc, unsigned& nx) {
    const unsigned G = gridDim.x * gridDim.y * gridDim.z;
    unsigned sum, cnt, mine, sp = 0u;
    for (;;) {
        sum = 0u; cnt = 0u; mine = 0u;
#pragma unroll
        for (unsigned j = 0; j < 16; ++j) { const unsigned c = xb_ld(&bar[XB_XCNT(j)]); sum += c; cnt += (c > 0u) ? 1u : 0u; mine = (j == x) ? c : mine; }
        if (sum == G) break;
        __builtin_amdgcn_s_sleep(1);
        if ((++sp & 255u) == 0u) { if (xb_ld(&bar[XB_TMO])) break; if (sp > XB_SPIN_CAP) { atomicAdd(&bar[XB_TMO], 1u); break; } }
    }
    nloc = mine > 0u ? mine : 1u; nx = cnt > 0u ? cnt : 1u;
}
__device__ __forceinline__ void xcd_barrier(const XcdBarrier& b) {
    asm volatile("s_waitcnt vmcnt(0)" ::: "memory");
    __syncthreads();
    if (threadIdx.x == 0) {
        unsigned* bar = b.bar;
        __builtin_amdgcn_s_waitcnt(0);
        unsigned nloc = b.st[0], nx = b.st[1];
        if (nloc == 0u) { xcd_barrier_complete(bar, b.x, nloc, nx); b.st[0] = nloc; b.st[1] = nx; }
        const unsigned old = xb_add(&bar[XB_XSUB(b.x)], 1u);
        const unsigned gen = old / nloc;
        if (old + 1u == (gen + 1u) * nloc) {
            __builtin_amdgcn_fence(__ATOMIC_RELEASE, "agent");
            asm volatile("s_waitcnt vmcnt(0)" ::: "memory");
            const unsigned og = xb_add(&bar[XB_TOP], 1u);
            const unsigned tg = og / nx;
            if (og + 1u == (tg + 1u) * nx) xb_add(&bar[XB_TOPGEN], 1u);
            else XB_SPIN(xb_ld(&bar[XB_TOPGEN]) == tg, bar);
            __builtin_amdgcn_fence(__ATOMIC_ACQUIRE, "agent");
            xb_add(&bar[XB_XGEN(b.x)], 1u);
            asm volatile("s_waitcnt vmcnt(0)" ::: "memory");
        } else {
            XB_SPIN(xb_ld(&bar[XB_XGEN(b.x)]) == gen, bar);
            __builtin_amdgcn_fence(__ATOMIC_ACQUIRE, "agent");
            asm volatile("s_waitcnt vmcnt(0)" ::: "memory");
        }
    }
    __syncthreads();
}
#endif
#ifndef HOST_SIM
typedef short bf16x8 __attribute__((ext_vector_type(8)));
typedef float f32x16 __attribute__((ext_vector_type(16)));
typedef float f32x4 __attribute__((ext_vector_type(4)));
typedef unsigned u32x4 __attribute__((ext_vector_type(4)));
typedef unsigned u32x2 __attribute__((ext_vector_type(2)));
#define NTHREADS 512

__device__ __forceinline__ void st_wt8(void* p, u32x2 v) { __hip_atomic_store((unsigned long long*)p, ((unsigned long long)v.y << 32) | v.x, __ATOMIC_RELAXED, __HIP_MEMORY_SCOPE_AGENT); }
__device__ __forceinline__ void st_wt16(void* p, f32x4 v) { asm volatile("global_store_dwordx4 %0, %1, off sc1\n\ts_nop 1" :: "v"(p), "v"(v) : "memory"); }
typedef __bf16 bf16x2n __attribute__((ext_vector_type(2)));
typedef float f32x2n __attribute__((ext_vector_type(2)));
__device__ __forceinline__ unsigned pack_bf16(float lo, float hi) { f32x2n f = {lo, hi}; bf16x2n r = __builtin_convertvector(f, bf16x2n); return __builtin_bit_cast(unsigned, r); }

constexpr int GBM = 256, GBN = 128, GBK = 64;
constexpr int G_ASTAGE = GBM * GBK * 2, G_BSTAGE = GBN * GBK * 2, G_STAGE = G_ASTAGE + G_BSTAGE;
constexpr int G_LDS = 2 * G_STAGE;
__device__ __forceinline__ int g_lds_off(int r, int c) { return r * 128 + ((c ^ ((r >> 1) & 7)) << 4); }

template <class ARow, class Epi>
__device__ __forceinline__ void gemm_tile(char* lds, const ARow& arow, const bf16* __restrict__ Bt, int ldb, int K, int m0, int n0, const Epi& epi) {
    int tid = threadIdx.x; asm volatile("" : "+v"(tid));
    const int lane = tid & 63, wid = __builtin_amdgcn_readfirstlane(tid >> 6), wm = wid >> 1, wn = wid & 1;
    const bf16* ap[4]; const bf16* bp[2];
#pragma unroll
    for (int j = 0; j < 4; ++j) { const int r = 8 * (wid * 4 + j) + (lane >> 3); ap[j] = arow(r) + 8 * ((lane & 7) ^ ((r >> 1) & 7)); }
#pragma unroll
    for (int j = 0; j < 2; ++j) { const int r = 8 * (wid * 2 + j) + (lane >> 3); bp[j] = Bt + (size_t)(n0 + r) * ldb + 8 * ((lane & 7) ^ ((r >> 1) & 7)); }
    f32x16 acc[2][2];
#pragma unroll
    for (int a = 0; a < 2; ++a)
#pragma unroll
        for (int b = 0; b < 2; ++b)
#pragma unroll
            for (int r = 0; r < 16; ++r) acc[a][b][r] = 0.f;
    const int nk = K / GBK;
    __syncthreads();
#define G_DMA(kt_, stage_) do { \
        _Pragma("unroll") for (int j = 0; j < 4; ++j) __builtin_amdgcn_global_load_lds((const unsigned*)(ap[j] + (kt_) * GBK), (LAS unsigned*)((stage_) + (wid * 4 + j) * 1024), 16, 0, 0); \
        _Pragma("unroll") for (int j = 0; j < 2; ++j) __builtin_amdgcn_global_load_lds((const unsigned*)(bp[j] + (kt_) * GBK), (LAS unsigned*)((stage_) + G_ASTAGE + (wid * 2 + j) * 1024), 16, 0, 0); } while (0)
    G_DMA(0, lds);
    __syncthreads();
    const int fr = lane & 31, fh = lane >> 5;
    for (int kt = 0; kt < nk; ++kt) {
        char* cur = lds + (kt & 1) * G_STAGE;
        if (kt + 1 < nk) { char* nxt = lds + ((kt + 1) & 1) * G_STAGE; G_DMA(kt + 1, nxt); }
#pragma unroll
        for (int kk = 0; kk < 4; ++kk) {
            bf16x8 fa[2], fb[2];
#pragma unroll
            for (int mi = 0; mi < 2; ++mi) fa[mi] = *(const bf16x8*)(cur + g_lds_off(wm * 64 + mi * 32 + fr, kk * 2 + fh));
#pragma unroll
            for (int ni = 0; ni < 2; ++ni) fb[ni] = *(const bf16x8*)(cur + G_ASTAGE + g_lds_off(wn * 64 + ni * 32 + fr, kk * 2 + fh));
#pragma unroll
            for (int mi = 0; mi < 2; ++mi)
#pragma unroll
                for (int ni = 0; ni < 2; ++ni) acc[mi][ni] = __builtin_amdgcn_mfma_f32_32x32x16_bf16(fb[ni], fa[mi], acc[mi][ni], 0, 0, 0);
        }
        __syncthreads();
    }
#undef G_DMA
    epi(acc, m0 + wm * 64 + fr, n0 + wn * 64 + 4 * fh);
}


constexpr int G_LDS3 = 3 * G_STAGE;
struct GPtrs { const bf16* a[4]; const bf16* b[2]; };
template <class TL> __device__ __forceinline__ void g_ptrs(const TL& tl, const typename TL::Tile& t, int wid, int lane, GPtrs& P) {
#pragma unroll
    for (int j = 0; j < 4; ++j) { const int r = 8 * (wid * 4 + j) + (lane >> 3); P.a[j] = tl.arow(t, r) + 8 * ((lane & 7) ^ ((r >> 1) & 7)); }
#pragma unroll
    for (int j = 0; j < 2; ++j) { const int r = 8 * (wid * 2 + j) + (lane >> 3); P.b[j] = tl.brow(t, r) + 8 * ((lane & 7) ^ ((r >> 1) & 7)); }
}
__device__ __forceinline__ void g_dma(char* lds, const GPtrs& P, int kt, int stage, int wid) {
    char* st = lds + stage * G_STAGE;
#pragma unroll
    for (int j = 0; j < 4; ++j) __builtin_amdgcn_global_load_lds((const unsigned*)(P.a[j] + kt * GBK), (LAS unsigned*)(st + (wid * 4 + j) * 1024), 16, 0, 0);
#pragma unroll
    for (int j = 0; j < 2; ++j) __builtin_amdgcn_global_load_lds((const unsigned*)(P.b[j] + kt * GBK), (LAS unsigned*)(st + G_ASTAGE + (wid * 2 + j) * 1024), 16, 0, 0);
}
template <class TL, int XF = 0>
__device__ __forceinline__ void gemm_stream(char* lds, const TL& tl) {
    int tid = threadIdx.x; asm volatile("" : "+v"(tid));
    const int lane = tid & 63, wid = __builtin_amdgcn_readfirstlane(tid >> 6), wm = wid >> 1, wn = wid & 1, fr = lane & 31, fh = lane >> 5;
    constexpr int nk = TL::K / GBK;
    static_assert(nk >= 2, "K too small");
    int idx = blockIdx.x;
    typename TL::Tile cur, nxt;
    if (!tl.tile(idx, cur)) return;
    GPtrs P, Pn;
    g_ptrs(tl, cur, wid, lane, P);
    bool has_next = tl.tile(idx + (int)gridDim.x, nxt);
    if (has_next) g_ptrs(tl, nxt, wid, lane, Pn);
    __syncthreads();
    if (!(XF & 1)) { g_dma(lds, P, 0, 0, wid); g_dma(lds, P, 1, 1, wid); }
    int sg = 0;
    for (;;) {
        f32x16 acc[2][2];
#pragma unroll
        for (int a = 0; a < 2; ++a)
#pragma unroll
            for (int b = 0; b < 2; ++b)
#pragma unroll
                for (int r = 0; r < 16; ++r) acc[a][b][r] = 0.f;
        for (int kt = 0; kt < nk; ++kt) {
            if (!(XF & 2)) { if (kt + 1 < nk || has_next) asm volatile("s_waitcnt vmcnt(6)" ::: "memory"); else asm volatile("s_waitcnt vmcnt(0)" ::: "memory");
            __builtin_amdgcn_s_barrier(); }
            asm volatile("" ::: "memory");
            const int s2 = sg >= 1 ? sg - 1 : 2;
            if (!(XF & 1)) { if (kt + 2 < nk) g_dma(lds, P, kt + 2, s2, wid);
            else if (has_next) g_dma(lds, Pn, kt + 2 - nk, s2, wid); }
            const char* cs = lds + sg * G_STAGE;
#pragma unroll
            for (int kk = 0; kk < 4; ++kk) {
                bf16x8 fa[2], fb[2];
#pragma unroll
                for (int mi = 0; mi < 2; ++mi) fa[mi] = *(const bf16x8*)(cs + g_lds_off(wm * 64 + mi * 32 + fr, kk * 2 + fh));
#pragma unroll
                for (int ni = 0; ni < 2; ++ni) fb[ni] = *(const bf16x8*)(cs + G_ASTAGE + g_lds_off(wn * 64 + ni * 32 + fr, kk * 2 + fh));
#pragma unroll
                for (int mi = 0; mi < 2; ++mi)
#pragma unroll
                    for (int ni = 0; ni < 2; ++ni) acc[mi][ni] = __builtin_amdgcn_mfma_f32_32x32x16_bf16(fb[ni], fa[mi], acc[mi][ni], 0, 0, 0);
            }
            sg = sg == 2 ? 0 : sg + 1;
        }
        tl.epi(cur, acc, wm * 64 + fr, wn * 64 + 4 * fh);
        if (!has_next) break;
        asm volatile("s_waitcnt vmcnt(0)" ::: "memory");
        cur = nxt; P = Pn; idx += (int)gridDim.x;
        has_next = tl.tile(idx + (int)gridDim.x, nxt);
        if (has_next) g_ptrs(tl, nxt, wid, lane, Pn);
    }
    asm volatile("s_waitcnt vmcnt(0)" ::: "memory");
}

constexpr int HBK = 32, H_ASTG = 256 * HBK * 2, H_STG = 2 * H_ASTG, H_RING = 4, H_LDS = H_RING * H_STG;
__device__ __forceinline__ int h_lds_off(int r, int c) { return r * 64 + ((c ^ ((r >> 2) & 3)) << 4); }
struct HPtrs { const bf16* a[2]; const bf16* b[2]; };
template <class TL> __device__ __forceinline__ void h_ptrs(const TL& tl, const typename TL::Tile& t, int wid, int lane, HPtrs& P) {
#pragma unroll
    for (int j = 0; j < 2; ++j) { const int r = 16 * (wid * 2 + j) + (lane >> 2); const int c = (lane & 3) ^ ((r >> 2) & 3); P.a[j] = tl.arow(t, r) + 8 * c; P.b[j] = tl.brow(t, r) + 8 * c; }
}
__device__ __forceinline__ void h_dma(char* lds, const HPtrs& P, int kt, int stage, int wid) {
    char* st = lds + stage * H_STG;
#pragma unroll
    for (int j = 0; j < 2; ++j) __builtin_amdgcn_global_load_lds((const unsigned*)(P.a[j] + kt * HBK), (LAS unsigned*)(st + (wid * 2 + j) * 1024), 16, 0, 0);
#pragma unroll
    for (int j = 0; j < 2; ++j) __builtin_amdgcn_global_load_lds((const unsigned*)(P.b[j] + kt * HBK), (LAS unsigned*)(st + H_ASTG + (wid * 2 + j) * 1024), 16, 0, 0);
}
template <class TL>
__device__ __forceinline__ void gemm_stream256(char* lds, const TL& tl) {
    int tid = threadIdx.x; asm volatile("" : "+v"(tid));
    const int lane = tid & 63, wid = __builtin_amdgcn_readfirstlane(tid >> 6), wm = wid >> 1, wn = wid & 1, fr = lane & 31, fh = lane >> 5;
    constexpr int nk = TL::K / HBK;
    static_assert(nk >= 4, "K too small");
    int idx = blockIdx.x;
    typename TL::Tile cur, nxt;
    if (!tl.tile(idx, cur)) return;
    HPtrs P, Pn;
    h_ptrs(tl, cur, wid, lane, P);
    bool has_next = tl.tile(idx + (int)gridDim.x, nxt);
    if (has_next) h_ptrs(tl, nxt, wid, lane, Pn);
    asm volatile("s_waitcnt vmcnt(0)" ::: "memory");
    __syncthreads();
    h_dma(lds, P, 0, 0, wid); h_dma(lds, P, 1, 1, wid); h_dma(lds, P, 2, 2, wid);
    int sg = 0;
    for (;;) {
        f32x16 acc[2][4];
#pragma unroll
        for (int a = 0; a < 2; ++a)
#pragma unroll
            for (int b = 0; b < 4; ++b)
#pragma unroll
                for (int r = 0; r < 16; ++r) acc[a][b][r] = 0.f;
        const unsigned act = tl.active(cur, wn);
        for (int kt = 0; kt < nk; ++kt) {
            const int ahead = (nk - 1 - kt) + (has_next ? 3 : 0);
            if (ahead >= 2) asm volatile("s_waitcnt vmcnt(8)" ::: "memory"); else if (ahead == 1) asm volatile("s_waitcnt vmcnt(4)" ::: "memory"); else asm volatile("s_waitcnt vmcnt(0)" ::: "memory");
            __builtin_amdgcn_s_barrier();
            asm volatile("" ::: "memory");
            const int s3 = (sg + 3) & 3;
            if (kt + 3 < nk) h_dma(lds, P, kt + 3, s3, wid);
            else if (has_next) h_dma(lds, Pn, kt + 3 - nk, s3, wid);
            const char* cs = lds + sg * H_STG;
#pragma unroll
            for (int kk = 0; kk < 2; ++kk) {
                bf16x8 fa[2], fb[4];
#pragma unroll
                for (int mi = 0; mi < 2; ++mi) fa[mi] = *(const bf16x8*)(cs + h_lds_off(wm * 64 + mi * 32 + fr, kk * 2 + fh));
#pragma unroll
                for (int ni = 0; ni < 4; ++ni) fb[ni] = *(const bf16x8*)(cs + H_ASTG + h_lds_off(wn * 128 + ni * 32 + fr, kk * 2 + fh));
#pragma unroll
                for (int ni = 0; ni < 4; ++ni)
                    if (act & (1u << ni)) {
#pragma unroll
                        for (int mi = 0; mi < 2; ++mi) acc[mi][ni] = __builtin_amdgcn_mfma_f32_32x32x16_bf16(fb[ni], fa[mi], acc[mi][ni], 0, 0, 0);
                    }
            }
            sg = (sg + 1) & 3;
        }
        tl.epi(cur, acc, wm * 64 + fr, wn * 128 + 4 * fh);
        if (!has_next) break;
        asm volatile("s_waitcnt vmcnt(0)" ::: "memory");
        cur = nxt; P = Pn; idx += (int)gridDim.x;
        has_next = tl.tile(idx + (int)gridDim.x, nxt);
        if (has_next) h_ptrs(tl, nxt, wid, lane, Pn);
    }
    asm volatile("s_waitcnt vmcnt(0)" ::: "memory");
}

struct ARowDense { const bf16* A; int lda; int m0; __device__ __forceinline__ const bf16* operator()(int i) const { return A + (size_t)(m0 + i) * lda; } };

struct EpiInProj {
    bf16* p; const float* rope;
    __device__ __forceinline__ void operator()(f32x16 (&acc)[2][2], int mrow, int ncol) const {
#pragma unroll
        for (int mi = 0; mi < 2; ++mi) {
            const int m = mrow + mi * 32;
#pragma unroll
            for (int ni = 0; ni < 2; ++ni) {
                const int nb = ncol + ni * 32;
                if (nb >= O1 && nb < O1 + 384 && m < TL) {
                    const int s = m & (S - 1); const int pos = ni == 0 ? (s >> 6) : (s & 63);
                    const int jb = (nb & 31);
#pragma unroll
                    for (int r = 0; r < 8; ++r) {
                        const int j = jb + (r & 3) + 8 * (r >> 2);
                        const float cs = rope[(pos * 16 + j) * 2], sn = rope[(pos * 16 + j) * 2 + 1];
                        const float x1 = acc[mi][ni][r], x2 = acc[mi][ni][r + 8];
                        acc[mi][ni][r] = x1 * cs - x2 * sn; acc[mi][ni][r + 8] = x1 * sn + x2 * cs;
                    }
                }
#pragma unroll
                for (int g = 0; g < 4; ++g) {
                    const int n = nb + 8 * g;
                    if (n < DIN) {
                        u32x2 v; v.x = pack_bf16(acc[mi][ni][4 * g], acc[mi][ni][4 * g + 1]); v.y = pack_bf16(acc[mi][ni][4 * g + 2], acc[mi][ni][4 * g + 3]);
                        *(u32x2*)(p + (size_t)m * DIN + n) = v;
                    }
                }
            }
        }
    }
};

struct EpiInProjH {
    bf16* p; const float* rope;
    __device__ __forceinline__ void operator()(f32x16 (&acc)[2][4], int mrow, int ncol) const {
#pragma unroll
        for (int mi = 0; mi < 2; ++mi) {
            const int m = mrow + mi * 32;
#pragma unroll
            for (int ni = 0; ni < 4; ++ni) {
                const int nb = ncol + ni * 32;
                if (nb >= DIN) continue;
                if (nb >= O1 && nb < O1 + 384 && m < TL) {
                    const int s = m & (S - 1); const int pos = (ni & 1) == 0 ? (s >> 6) : (s & 63);
                    const int jb = (nb & 31);
#pragma unroll
                    for (int r = 0; r < 8; ++r) {
                        const int j = jb + (r & 3) + 8 * (r >> 2);
                        const float cs = rope[(pos * 16 + j) * 2], sn = rope[(pos * 16 + j) * 2 + 1];
                        const float x1 = acc[mi][ni][r], x2 = acc[mi][ni][r + 8];
                        acc[mi][ni][r] = x1 * cs - x2 * sn; acc[mi][ni][r + 8] = x1 * sn + x2 * cs;
                    }
                }
#pragma unroll
                for (int g = 0; g < 4; ++g) {
                    const int n = nb + 8 * g;
                    if (n < DIN) { u32x2 v; v.x = pack_bf16(acc[mi][ni][4 * g], acc[mi][ni][4 * g + 1]); v.y = pack_bf16(acc[mi][ni][4 * g + 2], acc[mi][ni][4 * g + 3]); *(u32x2*)(p + (size_t)m * DIN + n) = v; }
                }
            }
        }
    }
};
struct EpiOutProjH {
    float* xr; const float* mod;
    __device__ __forceinline__ void operator()(f32x16 (&acc)[2][4], int mrow, int ncol) const {
#pragma unroll
        for (int mi = 0; mi < 2; ++mi) {
            const int m = mrow + mi * 32; const int rb = m < TL ? m / S : 8;
            const float* g1 = mod + (size_t)rb * 6144 + 2 * D;
#pragma unroll
            for (int ni = 0; ni < 4; ++ni)
#pragma unroll
                for (int g = 0; g < 4; ++g) {
                    const int n = ncol + ni * 32 + 8 * g;
                    f32x4 gv = *(const f32x4*)(g1 + n); float* xp = xr + (size_t)m * D + n; f32x4 xv = *(const f32x4*)xp;
                    xv[0] += gv[0] * acc[mi][ni][4 * g]; xv[1] += gv[1] * acc[mi][ni][4 * g + 1]; xv[2] += gv[2] * acc[mi][ni][4 * g + 2]; xv[3] += gv[3] * acc[mi][ni][4 * g + 3];
                    *(f32x4*)xp = xv;
                }
        }
    }
};
struct EpiOutProj {
    float* xr; const float* mod; const float* xin; const float* cin;
    __device__ __forceinline__ void operator()(f32x16 (&acc)[2][2], int mrow, int ncol) const {
#pragma unroll
        for (int mi = 0; mi < 2; ++mi) {
            const int m = mrow + mi * 32; const int rb = m < TL ? m / S : 8;
            const float* g1 = mod + (size_t)rb * 6144 + 2 * D;
            const float* src = xin ? (m < TL ? xin + (size_t)m * D : cin + (size_t)(m - TL) * D) : xr + (size_t)m * D;
#pragma unroll
            for (int ni = 0; ni < 2; ++ni)
#pragma unroll
                for (int g = 0; g < 4; ++g) {
                    const int n = ncol + ni * 32 + 8 * g;
                    f32x4 gv = *(const f32x4*)(g1 + n); f32x4 xv = *(const f32x4*)(src + n);
                    xv[0] += gv[0] * acc[mi][ni][4 * g]; xv[1] += gv[1] * acc[mi][ni][4 * g + 1]; xv[2] += gv[2] * acc[mi][ni][4 * g + 2]; xv[3] += gv[3] * acc[mi][ni][4 * g + 3];
                    *(f32x4*)(xr + (size_t)m * D + n) = xv;
                }
        }
    }
};
#endif
#ifndef HOST_SIM
template <class NMap>
__device__ __forceinline__ void cvt_tile(char* lds, const float* __restrict__ src, int srcN, bf16* __restrict__ dst, int dstK, int k0, int n0, int nvalid  , int nrows  , const NMap& nmap) {
    int tid = threadIdx.x; asm volatile("" : "+v"(tid));
    bf16* t = (bf16*)lds;
    __syncthreads();
#pragma unroll
    for (int i = 0; i < 2; ++i) {
        const int c = tid + i * NTHREADS, k = c >> 4, n4 = (c & 15) * 4;
        f32x4 v = {0.f, 0.f, 0.f, 0.f};
        if (n0 + n4 < nvalid) v = *(const f32x4*)(src + (size_t)(k0 + k) * srcN + n0 + n4);
#pragma unroll
        for (int q = 0; q < 4; ++q) t[(n4 + q) * 66 + k] = f2bf(v[q]);
    }
    __syncthreads();
    {
        const int n = tid >> 3, kc = tid & 7;
        if (n0 + n < nrows) {
            const unsigned* s = (const unsigned*)(t + n * 66 + kc * 8);
            u32x4 o; o.x = s[0]; o.y = s[1]; o.z = s[2]; o.w = s[3];
            *(u32x4*)(dst + (size_t)nmap(n0 + n) * dstK + k0 + kc * 8) = o;
        }
    }
}

template <class NMap>
__device__ __forceinline__ void cvt_strip(char* lds, const float* __restrict__ src, int srcN, bf16* __restrict__ dst, int dstK, int k0, int n0, int nvalid, int nrows, const NMap& nmap) {
    int tid = threadIdx.x; asm volatile("" : "+v"(tid));
    bf16* t = (bf16*)lds;
    __syncthreads();
    f32x4 v[8];
#pragma unroll
    for (int i = 0; i < 8; ++i) {
        const int c = tid + i * NTHREADS, k = c >> 6, n4 = (c & 63) * 4;
        v[i] = (f32x4){0.f, 0.f, 0.f, 0.f};
        if (n0 + n4 < nvalid) v[i] = *(const f32x4*)(src + (size_t)(k0 + k) * srcN + n0 + n4);
    }
#pragma unroll
    for (int i = 0; i < 8; ++i) {
        const int c = tid + i * NTHREADS, k = c >> 6, n4 = (c & 63) * 4;
#pragma unroll
        for (int q = 0; q < 4; ++q) t[(n4 + q) * 66 + k] = f2bf(v[i][q]);
    }
    __syncthreads();
#pragma unroll
    for (int i = 0; i < 4; ++i) {
        const int n = (tid >> 3) + i * 64, kc = tid & 7;
        if (n0 + n < nrows) {
            const unsigned* s = (const unsigned*)(t + n * 66 + kc * 8);
            u32x4 o; o.x = s[0]; o.y = s[1]; o.z = s[2]; o.w = s[3];
            *(u32x4*)(dst + (size_t)nmap(n0 + n) * dstK + k0 + kc * 8) = o;
        }
    }
}
struct NMapId { __device__ __forceinline__ int operator()(int n) const { return n; } };
struct NMapUp { int which; __device__ __forceinline__ int operator()(int j) const { return (j >> 7) * 256 + ((j >> 6) & 1) * 128 + which * 64 + (j & 63); } };
#endif
#ifndef HOST_SIM
__device__ __forceinline__ float wave_sum(float v) {
#pragma unroll
    for (int o = 32; o > 0; o >>= 1) v += __shfl_xor(v, o);
    return v;
}
template <int MODE, int NORM>
__device__ __forceinline__ void row_pass(const WS& w, const Inputs& in, int ntok, const float* mod_cur  , const float* mod_nrm  ,
                                         const float* gnorm, int shc, int scc, const bf16* y, const float* topw, float* out, bf16* hout, int t_first = -1, int t_end = 0, int t_step = 0) {
    int tid = threadIdx.x; asm volatile("" : "+v"(tid));
    const int lane = tid & 63, wv = tid >> 6;
    if (t_first < 0) { t_first = blockIdx.x * 8 + wv; t_end = ntok; t_step = gridDim.x * 8; }
    for (int t = t_first; t < t_end; t += t_step) {
        const int rb = t < TL ? t / S : 8;
        f32x4 v[4];
        float* xrow = w.xr + (size_t)t * D;
        if (MODE == 0 || MODE == 3) {
            const float* src = t < TL ? in.x + (size_t)t * D : in.ctx + (size_t)(t - TL) * D;
#pragma unroll
            for (int j = 0; j < 4; ++j) { v[j] = *(const f32x4*)(src + j * 256 + lane * 4); if (MODE == 0) st_wt16(xrow + j * 256 + lane * 4, v[j]); }
        } else {
#pragma unroll
            for (int j = 0; j < 4; ++j) v[j] = *(const f32x4*)(xrow + j * 256 + lane * 4);
        }
        if (MODE == 2) {
            const float* g2 = mod_cur + (size_t)rb * 6144 + 5 * D;
            f32x4 f[4];
#pragma unroll
            for (int j = 0; j < 4; ++j) f[j] = (f32x4){0.f, 0.f, 0.f, 0.f};
#pragma unroll
            for (int k = 0; k < 4; ++k) {
                const float wk = topw[(size_t)t * 4 + k]; const bf16* yr = y + ((size_t)t * 4 + k) * D;
#pragma unroll
                for (int j = 0; j < 4; ++j) { u32x2 u = *(const u32x2*)(yr + j * 256 + lane * 4);
                    f[j][0] += wk * __uint_as_float(u.x << 16); f[j][1] += wk * __uint_as_float(u.x & 0xffff0000u); f[j][2] += wk * __uint_as_float(u.y << 16); f[j][3] += wk * __uint_as_float(u.y & 0xffff0000u); }
            }
#pragma unroll
            for (int j = 0; j < 4; ++j) { f32x4 g = *(const f32x4*)(g2 + j * 256 + lane * 4); v[j] += g * f[j]; st_wt16(xrow + j * 256 + lane * 4, v[j]); }
        }
        if (NORM == 0) continue;
        if (NORM == 2 && t >= TL) continue;
        float ss = 0.f;
#pragma unroll
        for (int j = 0; j < 4; ++j) ss += v[j][0] * v[j][0] + v[j][1] * v[j][1] + v[j][2] * v[j][2] + v[j][3] * v[j][3];
        ss = wave_sum(ss);
        const float rstd = 1.0f / sqrtf(ss * (1.0f / D) + EPS);
        if (NORM == 1) {
            const float* m = mod_nrm + (size_t)rb * 6144;
#pragma unroll
            for (int j = 0; j < 4; ++j) {
                const int c = j * 256 + lane * 4;
                f32x4 g = *(const f32x4*)(gnorm + c), sc = *(const f32x4*)(m + scc * D + c), sh = *(const f32x4*)(m + shc * D + c);
                f32x4 hv = v[j] * rstd * g * (sc + 1.0f) + sh;
                u32x2 u; u.x = pack_bf16(hv[0], hv[1]); u.y = pack_bf16(hv[2], hv[3]);
                *(u32x2*)(hout + (size_t)t * D + c) = u;
            }
        } else {
#pragma unroll
            for (int j = 0; j < 4; ++j) { const int c = j * 256 + lane * 4; f32x4 g = *(const f32x4*)(gnorm + c); st_wt16(out + (size_t)t * D + c, v[j] * rstd * g); }
        }
    }
}

constexpr int CNT_PAD = 32;
__device__ __forceinline__ void router_rows(char* lds, const WS& w, const float* ebias, int r0, int r1, int l) {
    int tid = threadIdx.x; asm volatile("" : "+v"(tid));
    const int lane = tid & 63, wv = tid >> 6, fr = lane & 15, fq = lane >> 4;
    float* sl = (float*)lds + wv * (16 * 33);
    int* lcnt = (int*)(lds + 8 * 16 * 33 * 4);
    const bf16* Bt = w.wrT + (size_t)l * 32 * 1024;
    int* cnt = w.cnt + l * 32 * CNT_PAD; int* list = w.list;
    const int t0 = r0 + wv * 16;
    if (tid < 32) lcnt[tid] = 0;
    if (t0 < r1) {
        f32x4 a0 = {0.f, 0.f, 0.f, 0.f}, a1 = {0.f, 0.f, 0.f, 0.f};
        const int ra = t0 + fr < r1 ? t0 + fr : r1 - 1;
        const bf16* ar = w.h + (size_t)ra * D + fq * 8;
        const bf16* b0 = Bt + (size_t)fr * 1024 + fq * 8; const bf16* b1 = b0 + 16 * 1024;
#pragma unroll 8
        for (int ks = 0; ks < 32; ++ks) {
            bf16x8 fa = *(const bf16x8*)(ar + ks * 32), fb0 = *(const bf16x8*)(b0 + ks * 32), fb1 = *(const bf16x8*)(b1 + ks * 32);
            a0 = __builtin_amdgcn_mfma_f32_16x16x32_bf16(fa, fb0, a0, 0, 0, 0);
            a1 = __builtin_amdgcn_mfma_f32_16x16x32_bf16(fa, fb1, a1, 0, 0, 0);
        }
#pragma unroll
        for (int j = 0; j < 4; ++j) { sl[(4 * fq + j) * 33 + fr] = a0[j]; sl[(4 * fq + j) * 33 + 16 + fr] = a1[j]; }
    }
    __syncthreads();
    int sel[4]; int lpos[4];
    const bool mine = lane < 16 && t0 + lane < r1;
    if (mine) {
        const int t = t0 + lane; const float* sr = sl + lane * 33;
        float ss[4]; float sum = 0.f;
#pragma unroll
        for (int k = 0; k < 4; ++k) {
            int best = 0; float bv = -1e30f, bs = 0.f;
            for (int e = 0; e < 32; ++e) {
                bool used = false;
#pragma unroll
                for (int q = 0; q < 4; ++q) if (q < k && sel[q] == e) used = true;
                const float sg = 1.0f / (1.0f + expf(-sr[e])); const float vv = sg + ebias[e];
                if (!used && vv > bv) { bv = vv; best = e; bs = sg; }
            }
            sel[k] = best; ss[k] = bs; sum += bs;
        }
        const float inv = ROUTED_SCALE / sum;
#pragma unroll
        for (int k = 0; k < 4; ++k) { w.topw[(size_t)t * 4 + k] = ss[k] * inv; lpos[k] = atomicAdd(&lcnt[sel[k]], 1); }
    }
    __syncthreads();
    if (tid < 32) lcnt[32 + tid] = atomicAdd(&cnt[tid * CNT_PAD], lcnt[tid]);
    __syncthreads();
    if (mine) {
        const int t = t0 + lane;
#pragma unroll
        for (int k = 0; k < 4; ++k) list[(size_t)sel[k] * T + lcnt[32 + sel[k]] + lpos[k]] = t * 4 + k;
    }
    __syncthreads();
}
__device__ __forceinline__ void phase_norm2_router(char* lds, const WS& w, const Inputs& in, int ntok, const float* mod, const float* gnorm, const float* ebias, int l) {
    int rpb = (ntok + (int)gridDim.x - 1) / (int)gridDim.x; if (rpb > 128) rpb = 128;
    for (int r0 = blockIdx.x * rpb; r0 < ntok; r0 += gridDim.x * rpb) {
        const int r1 = r0 + rpb < ntok ? r0 + rpb : ntok;
        row_pass<1, 1>(w, in, ntok, mod, mod, gnorm, 3, 4, nullptr, nullptr, nullptr, w.h, r0 + (int)(threadIdx.x >> 6), r1, 8);
        asm volatile("s_waitcnt vmcnt(0)" ::: "memory");
        __syncthreads();
        router_rows(lds, w, ebias, r0, r1, l);
    }
}

__device__ __forceinline__ bool moe_decode(int tile, int NT, const int* cnt, int ntok, int& e, int& mt, int& nt, int& base, int& rows) {
    int t = tile / NT; nt = tile % NT; int b = 0;
    for (int i = 0; i < 33; ++i) {
        const int c = i < 32 ? cnt[i * CNT_PAD] : ntok; const int m = (c + GBM - 1) / GBM;
        if (t < m) { e = i; mt = t; rows = c; base = b; return true; }
        t -= m; b += c;
    }
    return false;
}
struct ARowGather {
    const bf16* A; const int* list; int rows; int r0; bool ident;
    __device__ __forceinline__ const bf16* operator()(int i) const {
        const int idx = r0 + i; int tok = 0;
        if (idx < rows) tok = ident ? idx : (list[idx] >> 2);
        return A + (size_t)tok * D;
    }
};
struct EpiUp {
    bf16* hid; int base; int rows;
    __device__ __forceinline__ void operator()(f32x16 (&acc)[2][2], int mrow, int ncol) const {
        const int hc = (ncol >> 7) * 64 + ((ncol >> 6) & 1) * 32 + (ncol & 63);
#pragma unroll
        for (int mi = 0; mi < 2; ++mi) {
            const int idx = mrow + mi * 32;
            if (idx < rows) {
#pragma unroll
                for (int g = 0; g < 4; ++g) {
                    float o[4];
#pragma unroll
                    for (int q = 0; q < 4; ++q) { const float gt = acc[mi][0][4 * g + q], up = acc[mi][1][4 * g + q]; o[q] = gt / (1.0f + expf(-gt)) * up; }
                    u32x2 v; v.x = pack_bf16(o[0], o[1]); v.y = pack_bf16(o[2], o[3]);
                    *(u32x2*)(hid + (size_t)(base + idx) * 256 + hc + 8 * g) = v;
                }
            }
        }
    }
};
struct EpiDown {
    bf16* y; const int* list; int rows; bool shared; float* xr; const float* mod;
    __device__ __forceinline__ void operator()(f32x16 (&acc)[2][2], int mrow, int ncol) const {
#pragma unroll
        for (int mi = 0; mi < 2; ++mi) {
            const int idx = mrow + mi * 32;
            if (idx < rows) {
                if (!shared) {
                    const int asg = list[idx];
#pragma unroll
                    for (int ni = 0; ni < 2; ++ni)
#pragma unroll
                        for (int g = 0; g < 4; ++g) {
                            u32x2 v; v.x = pack_bf16(acc[mi][ni][4 * g], acc[mi][ni][4 * g + 1]); v.y = pack_bf16(acc[mi][ni][4 * g + 2], acc[mi][ni][4 * g + 3]);
                            *(u32x2*)(y + (size_t)asg * D + ncol + ni * 32 + 8 * g) = v;
                        }
                } else {
                    const int rb = idx < TL ? idx / S : 8; const float* g2 = mod + (size_t)rb * 6144 + 5 * D;
#pragma unroll
                    for (int ni = 0; ni < 2; ++ni)
#pragma unroll
                        for (int g = 0; g < 4; ++g) {
                            const int n = ncol + ni * 32 + 8 * g;
                            f32x4 gv = *(const f32x4*)(g2 + n); float* xp = xr + (size_t)idx * D + n; f32x4 xv = *(const f32x4*)xp;
                            xv[0] += gv[0] * acc[mi][ni][4 * g]; xv[1] += gv[1] * acc[mi][ni][4 * g + 1]; xv[2] += gv[2] * acc[mi][ni][4 * g + 2]; xv[3] += gv[3] * acc[mi][ni][4 * g + 3];
                            *(f32x4*)xp = xv;
                        }
                }
            }
        }
    }
};
struct EpiUpH {
    bf16* hid; int base; int rows;
    __device__ __forceinline__ void operator()(f32x16 (&acc)[2][4], int mrow, int ncol) const {
        const int hc = (ncol >> 8) * 128 + ((ncol >> 7) & 1) * 64 + (ncol & 127);
#pragma unroll
        for (int mi = 0; mi < 2; ++mi) {
            const int idx = mrow + mi * 32;
            if (idx < rows) {
#pragma unroll
                for (int nh = 0; nh < 2; ++nh)
#pragma unroll
                    for (int g = 0; g < 4; ++g) {
                        float o[4];
#pragma unroll
                        for (int q = 0; q < 4; ++q) { const float gt = acc[mi][nh][4 * g + q], up = acc[mi][nh + 2][4 * g + q]; o[q] = gt / (1.0f + __expf(-gt)) * up; }
                        u32x2 v; v.x = pack_bf16(o[0], o[1]); v.y = pack_bf16(o[2], o[3]);
                        *(u32x2*)(hid + (size_t)(base + idx) * 256 + hc + nh * 32 + 8 * g) = v;
                    }
            }
        }
    }
};
struct EpiDownH {
    bf16* y; const int* list; int rows; bool shared; float* xr; const float* mod;
    __device__ __forceinline__ void operator()(f32x16 (&acc)[2][4], int mrow, int ncol) const {
#pragma unroll
        for (int mi = 0; mi < 2; ++mi) {
            const int idx = mrow + mi * 32;
            if (idx < rows) {
                if (!shared) {
                    const int asg = list[idx];
#pragma unroll
                    for (int ni = 0; ni < 4; ++ni)
#pragma unroll
                        for (int g = 0; g < 4; ++g) {
                            u32x2 v; v.x = pack_bf16(acc[mi][ni][4 * g], acc[mi][ni][4 * g + 1]); v.y = pack_bf16(acc[mi][ni][4 * g + 2], acc[mi][ni][4 * g + 3]);
                            *(u32x2*)(y + (size_t)asg * D + ncol + ni * 32 + 8 * g) = v;
                        }
                } else {
                    const int rb = idx < TL ? idx / S : 8; const float* g2 = mod + (size_t)rb * 6144 + 5 * D;
#pragma unroll
                    for (int ni = 0; ni < 4; ++ni)
#pragma unroll
                        for (int g = 0; g < 4; ++g) {
                            const int n = ncol + ni * 32 + 8 * g;
                            f32x4 gv = *(const f32x4*)(g2 + n); float* xp = xr + (size_t)idx * D + n; f32x4 xv = *(const f32x4*)xp;
                            xv[0] += gv[0] * acc[mi][ni][4 * g]; xv[1] += gv[1] * acc[mi][ni][4 * g + 1]; xv[2] += gv[2] * acc[mi][ni][4 * g + 2]; xv[3] += gv[3] * acc[mi][ni][4 * g + 3];
                            *(f32x4*)xp = xv;
                        }
                }
            }
        }
    }
};
struct TLMoeUp {
    const WS* w; const int* cnt; int ntok; static constexpr int K = 1024;
    struct Tile { int e, mt, nt, base, rows; };
    __device__ __forceinline__ bool tile(int idx, Tile& t) const { return moe_decode(idx, 2, cnt, ntok, t.e, t.mt, t.nt, t.base, t.rows); }
    __device__ __forceinline__ unsigned active(const Tile&, int) const { return 15u; }
    __device__ __forceinline__ const bf16* arow(const Tile& t, int r) const {
        const int i = t.mt * GBM + r; int tok = 0;
        if (i < t.rows) tok = t.e == 32 ? i : (w->list[(size_t)t.e * T + i] >> 2);
        return w->h + (size_t)tok * D;
    }
    __device__ __forceinline__ const bf16* brow(const Tile& t, int r) const { return w->moeUpT + ((size_t)t.e * 512 + t.nt * 256 + r) * 1024; }
    __device__ __forceinline__ void epi(const Tile& t, f32x16 (&acc)[2][4], int mr, int nc) const { EpiUpH{w->hid2, t.base, t.rows}(acc, t.mt * GBM + mr, t.nt * 256 + nc); }
};
struct TLMoeDown {
    const WS* w; const int* cnt; int ntok; const float* mod; static constexpr int K = 256;
    struct Tile { int e, mt, nt, base, rows; };
    __device__ __forceinline__ bool tile(int idx, Tile& t) const { return moe_decode(idx, 4, cnt, ntok, t.e, t.mt, t.nt, t.base, t.rows); }
    __device__ __forceinline__ unsigned active(const Tile&, int) const { return 15u; }
    __device__ __forceinline__ const bf16* arow(const Tile& t, int r) const { return w->hid2 + (size_t)(t.base + t.mt * GBM + r) * 256; }
    __device__ __forceinline__ const bf16* brow(const Tile& t, int r) const { return w->moeDownT + ((size_t)t.e * 1024 + t.nt * 256 + r) * 256; }
    __device__ __forceinline__ void epi(const Tile& t, f32x16 (&acc)[2][4], int mr, int nc) const {
        EpiDownH{(bf16*)w->h, w->list + (size_t)t.e * T, t.rows, t.e == 32, w->xr, mod}(acc, t.mt * GBM + mr, t.nt * 256 + nc);
    }
};
struct TLMoeDownR : TLMoeDown {
    __device__ __forceinline__ bool tile(int idx, Tile& t) const { return moe_decode(idx, 4, cnt, ntok, t.e, t.mt, t.nt, t.base, t.rows) && t.e < 32; }
};
__device__ __forceinline__ void phase_moe_down_routed(char* lds, const WS& w, int l, int ntok, const float* mod) { TLMoeDownR tl; tl.w = &w; tl.cnt = w.cnt + l * 32 * CNT_PAD; tl.ntok = ntok; tl.mod = mod; gemm_stream256(lds, tl); }
__device__ __forceinline__ void phase_moe_up(char* lds, const WS& w, int l, int ntok) { gemm_stream256(lds, TLMoeUp{&w, w.cnt + l * 32 * CNT_PAD, ntok}); }
__device__ __forceinline__ void phase_moe_down(char* lds, const WS& w, int l, int ntok, const float* mod) { gemm_stream256(lds, TLMoeDown{&w, w.cnt + l * 32 * CNT_PAD, ntok, mod}); }
#endif
#ifndef HOST_SIM
__device__ __forceinline__ void phase_ada(char* lds, const WS& w, const Inputs& in) {
    int tid = threadIdx.x; asm volatile("" : "+v"(tid));
    const int lane = tid & 63, wv = tid >> 6;
    float* sc = (float*)lds;
    float* red = sc + 9 * 1024;
    if ((int)blockIdx.x >= 192) return;
    __syncthreads();
    for (int i = tid; i < 9 * 1024; i += NTHREADS) { const int r = i >> 10, k = i & 1023; const float v = r < 8 ? in.c[(size_t)(r % B) * D + k] : in.c_ctx[k]; sc[i] = v / (1.0f + __expf(-v)); }
    __syncthreads();
    for (int it = blockIdx.x; it < 192; it += gridDim.x) {
        const int l = it / 96, n = (it % 96) * 64 + lane;
        const float* wp = in.w_ada + (size_t)l * D * 6144 + (size_t)(wv * 128) * 6144 + n;
        float acc[9];
#pragma unroll
        for (int r = 0; r < 9; ++r) acc[r] = 0.f;
#pragma unroll 32
        for (int k = 0; k < 128; ++k) {
            const float wvv = wp[(size_t)k * 6144];
#pragma unroll
            for (int r = 0; r < 9; ++r) acc[r] += sc[r * 1024 + wv * 128 + k] * wvv;
        }
#pragma unroll
        for (int r = 0; r < 9; ++r) red[(wv * 9 + r) * 64 + lane] = acc[r];
        __syncthreads();
        for (int i = tid; i < 9 * 64; i += NTHREADS) {
            const int r = i >> 6, c = i & 63; float s = 0.f;
#pragma unroll
            for (int q = 0; q < 8; ++q) s += red[(q * 9 + r) * 64 + c];
            const int nn = (it % 96) * 64 + c;
            w.mod[((size_t)l * 9 + r) * 6144 + nn] = s + in.b_ada[l * 6144 + nn];
        }
        __syncthreads();
    }
}
#endif
#ifndef HOST_SIM
typedef short s16x4 __attribute__((ext_vector_type(4)));
constexpr int AT_KV = 64 * 128;
constexpr int AT_STAGE = 2 * AT_KV;
__device__ __forceinline__ int at_voff(int key, int dcol) { return key * 128 + ((((dcol >> 5) ^ ((key >> 1) & 1))) << 6) + ((dcol & 31) << 1); }
__device__ __forceinline__ int at_kappa(int r) { return (r & ~12) | ((r & 4) << 1) | ((r & 8) >> 1); }

struct AttnState { f32x16 o[2]; float m, l; };

__device__ __forceinline__ void at_qk(const char* st, const bf16x8 (&qf)[4], f32x16 (&s)[2], int lane) {
    const int fr = lane & 31, fh = lane >> 5, kr = at_kappa(fr);
#pragma unroll
    for (int tt = 0; tt < 2; ++tt) {
#pragma unroll
        for (int r = 0; r < 16; ++r) s[tt][r] = 0.f;
#pragma unroll
        for (int ks = 0; ks < 4; ++ks) {
            const bf16x8 kf = *(const bf16x8*)(st + g_lds_off(32 * tt + kr, ks * 2 + fh));
            s[tt] = __builtin_amdgcn_mfma_f32_32x32x16_bf16(kf, qf[ks], s[tt], 0, 0, 0);
        }
    }
}
__device__ __forceinline__ void at_softmax_pv(const char* st, f32x16 (&s)[2], AttnState& a, int lane) {
    float mx = -1e30f;
#pragma unroll
    for (int tt = 0; tt < 2; ++tt)
#pragma unroll
        for (int r = 0; r < 16; ++r) mx = fmaxf(mx, s[tt][r]);
    mx = fmaxf(mx, __shfl_xor(mx, 32));
    const float mn = fmaxf(a.m, mx), alpha = __builtin_amdgcn_exp2f(a.m - mn);
    float rs = 0.f;
#pragma unroll
    for (int tt = 0; tt < 2; ++tt)
#pragma unroll
        for (int r = 0; r < 16; ++r) { const float p = __builtin_amdgcn_exp2f(s[tt][r] - mn); s[tt][r] = p; rs += p; }
    rs += __shfl_xor(rs, 32);
    a.l = a.l * alpha + rs; a.m = mn;
#pragma unroll
    for (int dt = 0; dt < 2; ++dt)
#pragma unroll
        for (int r = 0; r < 16; ++r) a.o[dt][r] *= alpha;
    const int fh = lane >> 5, i16 = lane & 15, g1 = (lane >> 4) & 1;
    const char* vb = st + AT_KV;
#pragma unroll
    for (int tt = 0; tt < 2; ++tt)
#pragma unroll
        for (int sp = 0; sp < 2; ++sp) {
            union { bf16x8 v; unsigned u[4]; } pu;
#pragma unroll
            for (int j = 0; j < 4; ++j) pu.u[j] = pack_bf16(s[tt][8 * sp + 2 * j], s[tt][8 * sp + 2 * j + 1]);
            const bf16x8 pf = pu.v;
#pragma unroll
            for (int dt = 0; dt < 2; ++dt) {
                const int kb = 32 * tt + 16 * sp + 8 * fh + (i16 >> 2), dc = 32 * dt + 16 * g1 + 4 * (i16 & 3);
                const s16x4 v0 = __builtin_amdgcn_ds_read_tr16_b64_v4i16((LAS s16x4*)(vb + at_voff(kb, dc)));
                const s16x4 v1 = __builtin_amdgcn_ds_read_tr16_b64_v4i16((LAS s16x4*)(vb + at_voff(kb + 4, dc)));
                bf16x8 vf; vf[0] = v0[0]; vf[1] = v0[1]; vf[2] = v0[2]; vf[3] = v0[3]; vf[4] = v1[0]; vf[5] = v1[1]; vf[6] = v1[2]; vf[7] = v1[3];
                a.o[dt] = __builtin_amdgcn_mfma_f32_32x32x16_bf16(vf, pf, a.o[dt], 0, 0, 0);
            }
        }
}
__device__ __forceinline__ void at_store(const AttnState& a, bf16* orow  , int lane) {
    const float il = 1.0f / a.l; const int fh = lane >> 5;
#pragma unroll
    for (int dt = 0; dt < 2; ++dt)
#pragma unroll
        for (int g = 0; g < 4; ++g) {
            u32x2 v; v.x = pack_bf16(a.o[dt][4 * g] * il, a.o[dt][4 * g + 1] * il); v.y = pack_bf16(a.o[dt][4 * g + 2] * il, a.o[dt][4 * g + 3] * il);
            *(u32x2*)(orow + 32 * dt + 8 * g + 4 * fh) = v;
        }
}
struct AtRegs { u32x4 k, v; };
__device__ __forceinline__ AtRegs at_load(const bf16* kbase, const bf16* vbase, int tid) {
    const int key = tid >> 3, c = tid & 7; AtRegs r;
    r.k = *(const u32x4*)(kbase + (size_t)key * DIN + c * 8); r.v = *(const u32x4*)(vbase + (size_t)key * DIN + c * 8); return r;
}
__device__ __forceinline__ void at_write(char* st, const AtRegs& r, int tid) {
    const int key = tid >> 3, c = tid & 7;
    *(u32x4*)(st + g_lds_off(key, c)) = r.k; *(u32x4*)(st + AT_KV + at_voff(key, c * 8)) = r.v;
}
__device__ __forceinline__ void at_dma(char* st, const bf16* kbase, int voff, int wid, int lane) {
    const int r = 8 * wid + (lane >> 3), pos = lane & 7;
    const bf16* kr = kbase + (size_t)r * DIN;
    const int ck = pos ^ ((r >> 1) & 7), cv = 4 * ((pos >> 2) ^ ((r >> 1) & 1)) + (pos & 3);
    __builtin_amdgcn_global_load_lds((const unsigned*)(kr + 8 * ck), (LAS unsigned*)(st + wid * 1024), 16, 0, 0);
    __builtin_amdgcn_global_load_lds((const unsigned*)(kr + voff + 8 * cv), (LAS unsigned*)(st + AT_KV + wid * 1024), 16, 0, 0);
}
#define AT_WAIT(n) asm volatile("s_waitcnt vmcnt(" #n ")" ::: "memory")
__device__ __forceinline__ void at_wait_tile(int remaining_after  ) {
    if (remaining_after >= 2) AT_WAIT(4); else if (remaining_after == 1) AT_WAIT(2); else AT_WAIT(0);
    __builtin_amdgcn_s_barrier();
    asm volatile("" ::: "memory");
}
constexpr int AT_RING = 4;
__device__ __forceinline__ void at_loadq(bf16x8 (&qf)[4], const bf16* qrow, int lane) {
    const int fh = lane >> 5;
#pragma unroll
    for (int ks = 0; ks < 4; ++ks) qf[ks] = *(const bf16x8*)(qrow + ks * 16 + fh * 8);
}
__device__ __forceinline__ int at_key(int tt, int r, int fh) { return 32 * tt + (r & 3) + 8 * fh + 4 * ((r >> 2) & 1) + 16 * (r >> 3); }

__device__ __forceinline__ void attn_wa_item(char* lds, const bf16* p, bf16* ycat, const float* sink, int b, int hk, int qb, bool ctxq) {
    int tid = threadIdx.x; asm volatile("" : "+v"(tid));
    const int lane = tid & 63, wv = tid >> 6, fr = lane & 31, fh = lane >> 5;
    const int hq = 2 * hk + (wv >> 2);
    const int qpos = qb * 128 + (wv & 3) * 32 + fr;
    const size_t qtok = ctxq ? (size_t)TL + (size_t)b * LC + qpos : (size_t)b * S + qpos;
    bf16x8 qf[4]; at_loadq(qf, p + qtok * DIN + O1 + hq * 64, lane);
    AttnState a;
#pragma unroll
    for (int dt = 0; dt < 2; ++dt)
#pragma unroll
        for (int r = 0; r < 16; ++r) a.o[dt][r] = 0.f;
    a.m = sink[hq] * 1.4426950408889634f; a.l = 1.0f;
    int lo = qb * 128 - 128, hi = qb * 128 + 256; if (lo < 0) lo = 0; if (hi > S) hi = S;
    const int nloc = ctxq ? 0 : (hi - lo) / 64, nt = 4 + nloc;
    const bf16* kc = p + ((size_t)TL + (size_t)b * LC) * DIN + O1 + 256 + hk * 64;
    const bf16* kl = p + ((size_t)b * S + lo) * DIN + O1 + 256 + hk * 64;
    const int wid = __builtin_amdgcn_readfirstlane(wv);
    asm volatile("s_waitcnt vmcnt(0)" ::: "memory");
    __syncthreads();
#define AT_TILE_K(i_) ((i_) < 4 ? kc + (size_t)(i_) * 64 * DIN : kl + (size_t)((i_) - 4) * 64 * DIN)
    for (int i = 0; i < 3 && i < nt; ++i) at_dma(lds + i * AT_STAGE, AT_TILE_K(i), 128, wid, lane);
    for (int i = 0; i < nt; ++i) {
        const char* st = lds + (i & 3) * AT_STAGE;
        at_wait_tile(nt - 1 - i);
        if (i + 3 < nt) at_dma(lds + ((i + 3) & 3) * AT_STAGE, AT_TILE_K(i + 3), 128, wid, lane);
        if (i >= 4) { const int kb0w = lo + (i - 4) * 64, q0w = qb * 128 + (wv & 3) * 32; if (kb0w + 63 < q0w - WINDOW || kb0w > q0w + 31 + WINDOW) continue; }
        f32x16 s[2]; at_qk(st, qf, s, lane);
        if (i < 4) {
#pragma unroll
            for (int tt = 0; tt < 2; ++tt)
#pragma unroll
                for (int r = 0; r < 16; ++r) s[tt][r] *= 0.125f * 1.4426950408889634f;
        } else {
            const int kb0 = lo + (i - 4) * 64;
#pragma unroll
            for (int tt = 0; tt < 2; ++tt)
#pragma unroll
                for (int r = 0; r < 16; ++r) { const int d = kb0 + at_key(tt, r, fh) - qpos; s[tt][r] = (d >= -WINDOW && d <= WINDOW) ? s[tt][r] * (0.125f * 1.4426950408889634f) : -1e30f; }
        }
        at_softmax_pv(st, s, a, lane);
    }
    at_store(a, ycat + qtok * 1024 + 256 + hq * 64, lane);
}
__device__ __forceinline__ void attn_na_item(char* lds, const bf16* p, bf16* ycat, const float* rpb  , int b, int h, int rg4, bool ctxq) {
    int tid = threadIdx.x; asm volatile("" : "+v"(tid));
    const int lane = tid & 63, wv = tid >> 6, fr = lane & 31, fh = lane >> 5;
    const int r = rg4 * 4 + (wv >> 1), cq = (wv & 1) * 32 + fr;
    const size_t qtok = ctxq ? (size_t)TL + (size_t)b * LC + wv * 32 + fr : (size_t)b * S + r * 64 + cq;
    bf16x8 qf[4]; at_loadq(qf, p + qtok * DIN + O2 + h * 64, lane);
    AttnState a;
#pragma unroll
    for (int dt = 0; dt < 2; ++dt)
#pragma unroll
        for (int rr = 0; rr < 16; ++rr) a.o[dt][rr] = 0.f;
    a.m = -1e30f; a.l = 0.f;
    constexpr int ROWS = S / GRID_W;
    int klo = rg4 * 4 - 4; if (klo < 0) klo = 0; int khi = rg4 * 4 + 3 - 4; if (khi < 0) khi = 0; if (khi > ROWS - NA_KR) khi = ROWS - NA_KR; khi += NA_KR;
    if (klo > ROWS - NA_KR) klo = ROWS - NA_KR;
    const int nloc = ctxq ? 0 : khi - klo, nt = 4 + nloc;
    int myr0 = r - 4; myr0 = myr0 < 0 ? 0 : (myr0 > ROWS - NA_KR ? ROWS - NA_KR : myr0);
    int c0 = cq - 8; c0 = c0 < 0 ? 0 : (c0 > GRID_W - NA_KC ? GRID_W - NA_KC : c0);
    const bf16* kc = p + ((size_t)TL + (size_t)b * LC) * DIN + O2 + 256 + h * 64;
    const bf16* kl = p + ((size_t)b * S + (size_t)klo * 64) * DIN + O2 + 256 + h * 64;
    float* bl = (float*)(lds + AT_RING * AT_STAGE);
    __syncthreads();
    const int wid = __builtin_amdgcn_readfirstlane(wv);
    if (tid < 15 * 31) bl[(tid / 31) * 32 + (tid % 31)] = rpb[h * 15 * 31 + tid];
    asm volatile("s_waitcnt vmcnt(0) lgkmcnt(0)" ::: "memory");
    for (int i = 0; i < 3 && i < nt; ++i) at_dma(lds + i * AT_STAGE, AT_TILE_K(i), 256, wid, lane);
    for (int i = 0; i < nt; ++i) {
        const char* st = lds + (i & 3) * AT_STAGE;
        at_wait_tile(nt - 1 - i);
        if (i + 3 < nt) at_dma(lds + ((i + 3) & 3) * AT_STAGE, AT_TILE_K(i + 3), 256, wid, lane);
        const int krow = klo + (i - 4);
        const bool act = i < 4 || (krow >= myr0 && krow < myr0 + NA_KR);
        if (act) {
            f32x16 s[2]; at_qk(st, qf, s, lane);
            if (i < 4) {
#pragma unroll
                for (int tt = 0; tt < 2; ++tt)
#pragma unroll
                    for (int rr = 0; rr < 16; ++rr) s[tt][rr] *= 0.125f * 1.4426950408889634f;
            } else {
                const float* brow = bl + (krow - r + 7) * 32 + 15 - cq;
#pragma unroll
                for (int tt = 0; tt < 2; ++tt)
#pragma unroll
                    for (int rr = 0; rr < 16; ++rr) { const int kcol = at_key(tt, rr, fh); const bool ok = kcol >= c0 && kcol < c0 + NA_KC;
                        const float bias = ok ? brow[kcol] : 0.f; s[tt][rr] = ok ? (s[tt][rr] * 0.125f + bias) * 1.4426950408889634f : -1e30f; }
            }
            at_softmax_pv(st, s, a, lane);
        }
    }
    at_store(a, ycat + qtok * 1024 + 512 + h * 64, lane);
}
__device__ __forceinline__ void attn_item(char* lds, const WS& w, const Inputs& in, int l, int it) {
    if (it < 256) attn_wa_item(lds, w.p, w.ycat, in.wa_sink + l * 4, it >> 5, (it >> 4) & 1, it & 15, false);
    else if (it < 512) { const int j = it - 256; attn_na_item(lds, w.p, w.ycat, in.na_rpb + l * 4 * 15 * 31, j >> 5, (j >> 3) & 3, j & 7, false); }
    else if (it < 544) { const int j = it - 512; attn_wa_item(lds, w.p, w.ycat, in.wa_sink + l * 4, j >> 2, (j >> 1) & 1, j & 1, true); }
    else { const int j = it - 544; attn_na_item(lds, w.p, w.ycat, in.na_rpb + l * 4 * 15 * 31, j >> 2, j & 3, 0, true); }
}
#endif
#ifndef HOST_SIM
__device__ __forceinline__ float hy_c3(const bf16* pr, int tin, int col, const float* cw) {
    float acc = cw[768 + col] * bf2f(pr[col]);
    if (tin > 0) acc += cw[col] * bf2f(pr[col - DIN]);
    if (tin < S - 1) acc += cw[2 * 768 + col] * bf2f(pr[col + DIN]);
    return acc;
}
__device__ __forceinline__ void hy_prep_item(char* lds, const bf16* p, const float* cw, bf16* x0T, bf16* uvT, int b, int ch, bool ctx = false) {
    int tid = threadIdx.x; asm volatile("" : "+v"(tid));
    bf16* lx = (bf16*)lds;
    bf16* lu = lx + 256 * 72;
    __syncthreads();
    const int tl = tid & 63, cg = tid >> 6;
    const int L = ctx ? LC : S; const int tin = ch * 64 + tl; const bf16* pr = p + ((ctx ? (size_t)TL + (size_t)b * LC : (size_t)b * S) + tin) * DIN;
    for (int it = 0; it < 4; ++it) {
        const int c0 = (it * 8 + cg) * 8;
        float x0[8], x1[8], vv[8];
#pragma unroll
        for (int q = 0; q < 8; ++q) { x0[q] = 0.f; x1[q] = 0.f; vv[q] = 0.f; }
#pragma unroll
        for (int dr = -1; dr <= 1; ++dr) {
            if (tin + dr < 0 || tin + dr >= L) continue;
            const bf16* r = pr + (ptrdiff_t)dr * DIN;
            const u32x4 a = *(const u32x4*)(r + c0), bq = *(const u32x4*)(r + 256 + c0), cq = *(const u32x4*)(r + 512 + c0);
            const float* w0 = cw + (dr + 1) * 768;
#pragma unroll
            for (int q = 0; q < 4; ++q) {
                x0[2 * q] += w0[c0 + 2 * q] * __uint_as_float(a[q] << 16); x0[2 * q + 1] += w0[c0 + 2 * q + 1] * __uint_as_float(a[q] & 0xffff0000u);
                x1[2 * q] += w0[256 + c0 + 2 * q] * __uint_as_float(bq[q] << 16); x1[2 * q + 1] += w0[256 + c0 + 2 * q + 1] * __uint_as_float(bq[q] & 0xffff0000u);
                vv[2 * q] += w0[512 + c0 + 2 * q] * __uint_as_float(cq[q] << 16); vv[2 * q + 1] += w0[512 + c0 + 2 * q + 1] * __uint_as_float(cq[q] & 0xffff0000u);
            }
        }
#pragma unroll
        for (int q = 0; q < 8; ++q) { lx[(c0 + q) * 72 + tl] = f2bf(x0[q]); lu[(c0 + q) * 72 + tl] = f2bf(x1[q] * vv[q]); }
    }
    __syncthreads();
    for (int i = tid; i < 2048; i += NTHREADS) {
        const int c = i >> 3, k = i & 7;
        const size_t g = ((size_t)c * B + b) * L + ch * 64 + k * 8;
        *(u32x4*)(x0T + g) = *(const u32x4*)(lx + c * 72 + k * 8);
        *(u32x4*)(uvT + g) = *(const u32x4*)(lu + c * 72 + k * 8);
    }
}
constexpr int HY_NOFF = 2072, HY_NE = 4128, HY_CS = HY_NE * 2 + 32;
constexpr int HY_URS = S * 2 + 16;
constexpr int HY_LDS_U = 8 * HY_CS, HY_LDS_Z = HY_LDS_U + 8 * HY_URS, HY_LDS_REV = HY_LDS_Z + 64, HY_LDS_END0 = HY_LDS_REV + (HY_NE + 8) * 2;
constexpr int HC_NOFF = 280, HC_NE = 544, HC_CS = HC_NE * 2 + 32, HC_URS = LC * 2 + 16;
constexpr int HC_LDS_C = (HY_LDS_END0 + 15) & ~15, HC_LDS_U = HC_LDS_C + 8 * HC_CS, HC_LDS_REV = HC_LDS_U + 8 * HC_URS, HY_LDS_END = HC_LDS_REV + (HC_NE + 8) * 2;
__device__ __forceinline__ void hy_conv_item(char* lds, const float* filtT, const float* hbias, const bf16* uvT, bf16* x0T  , int c, const bf16* uvTc = nullptr, bf16* x0Tc = nullptr) {
    static_assert(B == 8, "hyena conv assumes batch 8");
    int tid = threadIdx.x; asm volatile("" : "+v"(tid));
    const int lane = tid & 63, wv = tid >> 6, fr = lane & 31, fh = lane >> 5;
    bf16* rev = (bf16*)(lds + HY_LDS_REV);
    __syncthreads();
    const float* hf = filtT + (size_t)c * (S + LC); const float* hb = filtT + (size_t)(256 + c) * (S + LC);
    for (int e = tid; e < HY_NE + 8; e += NTHREADS) {
        const int n = e - HY_NOFF; float v = 0.f;
        if (n > 0 && n < S) v = hb[n]; else if (n <= 0 && n > -S) v = hf[-n];
        rev[e] = f2bf(v);
    }
    for (int i = tid; i < 8 * 256; i += NTHREADS) { const int bb = i >> 8, k = i & 255; *(u32x4*)(lds + HY_LDS_U + bb * HY_URS + k * 16) = *(const u32x4*)(uvT + ((size_t)c * B + bb) * S + k * 8); }
    if (tid < 4) ((unsigned*)(lds + HY_LDS_Z))[tid] = 0u;
    bf16* revc = (bf16*)(lds + HC_LDS_REV);
    if (uvTc) {
        for (int e = tid; e < HC_NE + 8; e += NTHREADS) { const int n = e - HC_NOFF; float v = 0.f; if (n > 0 && n < LC) v = hb[S + n]; else if (n <= 0 && n > -LC) v = hf[S - n]; revc[e] = f2bf(v); }
        for (int i = tid; i < 8 * 32; i += NTHREADS) { const int bb = i >> 5, k = i & 31; *(u32x4*)(lds + HC_LDS_U + bb * HC_URS + k * 16) = *(const u32x4*)(uvTc + ((size_t)c * B + bb) * LC + k * 8); }
    }
    __syncthreads();
    if (uvTc) for (int i = tid; i < 8 * (HC_NE / 2); i += NTHREADS) { const int m = i / (HC_NE / 2), d = i % (HC_NE / 2); const unsigned lo = revc[2 * d + m], hi = revc[2 * d + 1 + m]; *(unsigned*)(lds + HC_LDS_C + m * HC_CS + d * 4) = lo | (hi << 16); }
    for (int i = tid; i < 8 * (HY_NE / 2); i += NTHREADS) {
        const int m = i / (HY_NE / 2), d = i % (HY_NE / 2);
        const unsigned lo = rev[2 * d + m], hi = rev[2 * d + 1 + m];
        *(unsigned*)(lds + m * HY_CS + d * 4) = lo | (hi << 16);
    }
    __syncthreads();
    f32x16 acc[2];
#pragma unroll
    for (int q = 0; q < 2; ++q)
#pragma unroll
        for (int r = 0; r < 16; ++r) acc[q][r] = 0.f;
    const int bb = fr >> 2, pp = fr & 3;
    const int m = (-fr) & 7;
    const char* abase = lds + m * HY_CS;
    const char* ubase = lds + HY_LDS_U + bb * HY_URS + fh * 16;
    auto hstep = [&](int dl, bool a0, bool a1) {
        const int n0 = 8 * fh - fr - 16 * dl;
        const bf16x8 af = *(const bf16x8*)(abase + (n0 - m + HY_NOFF) * 2);
        if (a0) { const int sj = 16 * wv - dl + 2 * pp; const char* up = (sj >= 0 && sj < 128) ? ubase + sj * 32 : lds + HY_LDS_Z;
            acc[0] = __builtin_amdgcn_mfma_f32_32x32x16_bf16(af, *(const bf16x8*)up, acc[0], 0, 0, 0); }
        if (a1) { const int sj = 16 * wv + 8 - dl + 2 * pp; const char* up = (sj >= 0 && sj < 128) ? ubase + sj * 32 : lds + HY_LDS_Z;
            acc[1] = __builtin_amdgcn_mfma_f32_32x32x16_bf16(af, *(const bf16x8*)up, acc[1], 0, 0, 0); }
    };
#pragma unroll
    for (int dl = 16 * wv - 127; dl < 16 * wv - 119; ++dl) hstep(dl, true, false);
#pragma unroll 6
    for (int dl = 16 * wv - 119; dl <= 16 * wv + 6; ++dl) hstep(dl, true, true);
#pragma unroll
    for (int dl = 16 * wv + 7; dl <= 16 * wv + 14; ++dl) hstep(dl, false, true);
    const float hbc = hbias[c];
#pragma unroll
    for (int qq = 0; qq < 2; ++qq) {
        const int tb = 32 * (4 * (2 * wv + qq) + pp) + 4 * fh;
#pragma unroll
        for (int g = 0; g < 4; ++g) {
            const int t = tb + 8 * g;
            const u32x2 uu = *(const u32x2*)(lds + HY_LDS_U + bb * HY_URS + t * 2);
            bf16* xp = x0T + ((size_t)c * B + bb) * S + t; const u32x2 xx = *(const u32x2*)xp;
            const float u0 = __uint_as_float(uu.x << 16), u1 = __uint_as_float(uu.x & 0xffff0000u), u2 = __uint_as_float(uu.y << 16), u3 = __uint_as_float(uu.y & 0xffff0000u);
            const float a0 = __uint_as_float(xx.x << 16), a1 = __uint_as_float(xx.x & 0xffff0000u), a2 = __uint_as_float(xx.y << 16), a3 = __uint_as_float(xx.y & 0xffff0000u);
            u32x2 o; o.x = pack_bf16(a0 * (acc[qq][4 * g] + hbc * u0), a1 * (acc[qq][4 * g + 1] + hbc * u1)); o.y = pack_bf16(a2 * (acc[qq][4 * g + 2] + hbc * u2), a3 * (acc[qq][4 * g + 3] + hbc * u3));
            *(u32x2*)xp = o;
        }
    }
    if (uvTc && wv < 2) {
        f32x16 ac;
#pragma unroll
        for (int r = 0; r < 16; ++r) ac[r] = 0.f;
        const char* cab = lds + HC_LDS_C + m * HC_CS; const char* cub = lds + HC_LDS_U + bb * HC_URS + fh * 16;
        for (int dl = 8 * wv - 15; dl <= 8 * wv + 6; ++dl) {
            const int n0 = 8 * fh - fr - 16 * dl;
            const bf16x8 af = *(const bf16x8*)(cab + (n0 - m + HC_NOFF) * 2);
            const int sj = 8 * wv - dl + 2 * pp; const char* up = (sj >= 0 && sj < 16) ? cub + sj * 32 : lds + HY_LDS_Z;
            ac = __builtin_amdgcn_mfma_f32_32x32x16_bf16(af, *(const bf16x8*)up, ac, 0, 0, 0);
        }
        const int tb = 32 * (4 * wv + pp) + 4 * fh;
#pragma unroll
        for (int g = 0; g < 4; ++g) {
            const int t = tb + 8 * g;
            const u32x2 uu = *(const u32x2*)(lds + HC_LDS_U + bb * HC_URS + t * 2);
            bf16* xp = x0Tc + ((size_t)c * B + bb) * LC + t; const u32x2 xx = *(const u32x2*)xp;
            const float u0 = __uint_as_float(uu.x << 16), u1 = __uint_as_float(uu.x & 0xffff0000u), u2 = __uint_as_float(uu.y << 16), u3 = __uint_as_float(uu.y & 0xffff0000u);
            const float a0 = __uint_as_float(xx.x << 16), a1 = __uint_as_float(xx.x & 0xffff0000u), a2 = __uint_as_float(xx.y << 16), a3 = __uint_as_float(xx.y & 0xffff0000u);
            u32x2 o; o.x = pack_bf16(a0 * (ac[4 * g] + hbc * u0), a1 * (ac[4 * g + 1] + hbc * u1)); o.y = pack_bf16(a2 * (ac[4 * g + 2] + hbc * u2), a3 * (ac[4 * g + 3] + hbc * u3));
            *(u32x2*)xp = o;
        }
    }
}
__device__ __forceinline__ void hy_filter_mlp(char* lds, const float* w1, const float* b1, const float* w2, const float* b2, const float* freq, bf16* f2b) {
    int tid = threadIdx.x; asm volatile("" : "+v"(tid));
    const int lane = tid & 63, wv = tid >> 6;
    float* zl = (float*)lds + wv * 128;
    __syncthreads();
    const float fj = freq[lane], b1j = b1[lane], b2j = b2[lane];
    for (int tt = blockIdx.x * 8 + wv; tt < S + LC; tt += gridDim.x * 8) {
        const int L = tt < S ? S : LC, t = tt < S ? tt : tt - S;
        if (lane < 33) {
            float z;
            if (lane == 0) z = (float)t / (float)(L - 1);
            else { const int bnd = (lane - 1) & 15; const float band = 1e-4f + (float)bnd * ((15.0f - 1e-4f) / 15.0f); const float ang = (6.283185307179586f / (float)L) * (float)t * band; z = lane <= 16 ? cosf(ang) : -sinf(ang); }
            zl[lane] = z;
        }
        __builtin_amdgcn_wave_barrier(); asm volatile("s_waitcnt lgkmcnt(0)" ::: "memory");
        float acc = 0.f;
#pragma unroll
        for (int i = 0; i < 33; ++i) acc += zl[i] * w1[i * 64 + lane];
        zl[64 + lane] = sinf(fj * (acc + b1j));
        __builtin_amdgcn_wave_barrier(); asm volatile("s_waitcnt lgkmcnt(0)" ::: "memory");
        float a2 = 0.f;
#pragma unroll 16
        for (int k = 0; k < 64; ++k) a2 += zl[64 + k] * w2[k * 64 + lane];
        f2b[(size_t)tt * 64 + lane] = f2bf(sinf(fj * (a2 + b2j)));
        __builtin_amdgcn_wave_barrier(); asm volatile("s_waitcnt lgkmcnt(0)" ::: "memory");
    }
}
__device__ __forceinline__ void hy_filter_out(const bf16* w3T  , const bf16* f2b  , float* filt  ) {
    int tid = threadIdx.x; asm volatile("" : "+v"(tid));
    const int lane = tid & 63, wv = tid >> 6, fr = lane & 31, fh = lane >> 5;
    constexpr int NTT = (S + LC) / 32;
    for (int it = blockIdx.x * 8 + wv; it < 16 * NTT; it += gridDim.x * 8) {
        const int ct = it / NTT, tt0 = (it % NTT) * 32;
        f32x16 acc;
#pragma unroll
        for (int r = 0; r < 16; ++r) acc[r] = 0.f;
#pragma unroll
        for (int ks = 0; ks < 4; ++ks) {
            const bf16x8 fa = *(const bf16x8*)(w3T + (size_t)(ct * 32 + fr) * 64 + ks * 16 + fh * 8), fb = *(const bf16x8*)(f2b + (size_t)(tt0 + fr) * 64 + ks * 16 + fh * 8);
            acc = __builtin_amdgcn_mfma_f32_32x32x16_bf16(fa, fb, acc, 0, 0, 0);
        }
        const int tt = tt0 + fr; const int L = tt < S ? S : LC; const float tn = (float)(tt < S ? tt : tt - S) / (float)(L - 1);
#pragma unroll
        for (int r = 0; r < 16; ++r) {
            const int c = ct * 32 + (r & 3) + 8 * (r >> 2) + 4 * fh; const int cc = c & 255;
            const float decay = HY_DECAY_MIN + (float)cc * ((HY_DECAY_MAX - HY_DECAY_MIN) / 255.0f);
            filt[(size_t)c * (S + LC) + tt] = acc[r] * __expf(-tn * decay);
        }
    }
}
__device__ __forceinline__ void hy_fin_item(char* lds, const bf16* yT, bf16* ycat, int b, int ch, bool ctx = false) {
    int tid = threadIdx.x; asm volatile("" : "+v"(tid));
    bf16* ly = (bf16*)lds;
    __syncthreads();
    for (int i = tid; i < 2048; i += NTHREADS) {
        const int c = i >> 3, k = i & 7;
        const u32x4 v = *(const u32x4*)(yT + ((size_t)c * B + b) * (ctx ? LC : S) + ch * 64 + k * 8);
#pragma unroll
        for (int q = 0; q < 4; ++q) { ly[(k * 8 + 2 * q) * 264 + c] = (bf16)(v[q] & 0xffffu); ly[(k * 8 + 2 * q + 1) * 264 + c] = (bf16)(v[q] >> 16); }
    }
    __syncthreads();
    for (int i = tid; i < 2048; i += NTHREADS) {
        const int t = i >> 5, k = i & 31;
        *(u32x4*)(ycat + ((ctx ? (size_t)TL + (size_t)b * LC : (size_t)b * S) + ch * 64 + t) * 1024 + k * 8) = *(const u32x4*)(ly + t * 264 + k * 8);
    }
}
#endif
#ifndef HOST_SIM
constexpr int GD_NC = 36;
__device__ __forceinline__ size_t gd_tok0(int b, int cc) { return cc < 4 ? (size_t)TL + (size_t)b * LC + cc * 64 : (size_t)b * S + (size_t)(cc - 4) * 64; }

constexpr int GP_K = 0, GP_V = 8192, GP_L0 = 16384, GP_T0 = GP_L0 + 2 * 16384, GP_VB0 = GP_T0 + 2 * 8192  , GP_G = GP_VB0 + 2 * 8192  ,
              GP_SM = GP_VB0 + 4 * 8192  , GP_LB = GP_SM + 6 * 256  , GP_END = GP_LB + 2 * 2048;

__device__ __forceinline__ void gdn_pre_item(char* lds, const WS& w, const float* cw  , const float* a_log, const float* dt_bias, int b, int cc, int h) {
    int tid = threadIdx.x; asm volatile("" : "+v"(tid));
    const int lane = tid & 63, wv = tid >> 6, fr = lane & 31, fh = lane >> 5;
    const bf16* p = w.p;
    const int L = cc < 4 ? LC : S; const int tin0 = cc < 4 ? cc * 64 : (cc - 4) * 64; const size_t tok0 = gd_tok0(b, cc);
    float* sm = (float*)(lds + GP_SM);
    __syncthreads();
    {
        const int tl = tid >> 3, dg = tid & 7;
        float q8[8], k8[8], v8[8];
#pragma unroll
        for (int x = 0; x < 8; ++x) { q8[x] = 0.f; k8[x] = 0.f; v8[x] = 0.f; }
#pragma unroll
        for (int i = 0; i < 4; ++i) {
            const int tt = tin0 + tl + i - 2;
            if (tt < 0 || tt >= L) continue;
            const bf16* r = p + (tok0 + tl + i - 2) * DIN + O3 + h * 64 + dg * 8;
            const u32x4 a = *(const u32x4*)r, bq = *(const u32x4*)(r + 256), cq = *(const u32x4*)(r + 512);
            const float* wq = cw + i * 768 + h * 64 + dg * 8;
#pragma unroll
            for (int x = 0; x < 4; ++x) {
                q8[2 * x] += wq[2 * x] * __uint_as_float(a[x] << 16); q8[2 * x + 1] += wq[2 * x + 1] * __uint_as_float(a[x] & 0xffff0000u);
                k8[2 * x] += wq[256 + 2 * x] * __uint_as_float(bq[x] << 16); k8[2 * x + 1] += wq[256 + 2 * x + 1] * __uint_as_float(bq[x] & 0xffff0000u);
                v8[2 * x] += wq[512 + 2 * x] * __uint_as_float(cq[x] << 16); v8[2 * x + 1] += wq[512 + 2 * x + 1] * __uint_as_float(cq[x] & 0xffff0000u);
            }
        }
        float sq = 0.f, sk = 0.f;
#pragma unroll
        for (int x = 0; x < 8; ++x) { q8[x] = q8[x] / (1.0f + __expf(-q8[x])); k8[x] = k8[x] / (1.0f + __expf(-k8[x])); v8[x] = v8[x] / (1.0f + __expf(-v8[x])); sq += q8[x] * q8[x]; sk += k8[x] * k8[x]; }
        sq += __shfl_xor(sq, 1); sq += __shfl_xor(sq, 2); sq += __shfl_xor(sq, 4);
        sk += __shfl_xor(sk, 1); sk += __shfl_xor(sk, 2); sk += __shfl_xor(sk, 4);
        const float rq = 0.125f / sqrtf(sq + EPS), rk = 1.0f / sqrtf(sk + EPS);
        u32x4 qo, ko, vo;
#pragma unroll
        for (int x = 0; x < 4; ++x) { qo[x] = pack_bf16(q8[2 * x] * rq, q8[2 * x + 1] * rq); ko[x] = pack_bf16(k8[2 * x] * rk, k8[2 * x + 1] * rk); vo[x] = pack_bf16(v8[2 * x], v8[2 * x + 1]); }
        bf16* qkg = w.qk + ((size_t)((b * 4 + h) * GD_NC + cc) * 2) * 4096;
        *(u32x4*)(qkg + tl * 64 + dg * 8) = qo; *(u32x4*)(qkg + 4096 + tl * 64 + dg * 8) = ko;
        *(u32x4*)(lds + GP_K + g_lds_off(tl, dg)) = ko;
        *(u32x4*)(lds + GP_V + at_voff(tl, dg * 8)) = vo;
        if (tid < 128) {
            const int dir = tid >> 6, t = tid & 63; const bf16* r = p + (tok0 + t) * DIN + O3 + 1024 + dir * 4 + h;
            const float a = bf2f(r[0]), bbv = bf2f(r[8]); const float x = a + dt_bias[dir * 4 + h]; const float sp = x > 15.f ? x : __logf(1.0f + __expf(x));
            sm[dir * 64 + t] = -__expf(a_log[dir * 4 + h]) * sp; sm[128 + dir * 64 + t] = 1.0f / (1.0f + __expf(-bbv));
        }
    }
    __syncthreads();
    if (wv < 4) {
        const int ta = wv >> 1, tb = wv & 1; f32x16 g;
#pragma unroll
        for (int r = 0; r < 16; ++r) g[r] = 0.f;
#pragma unroll
        for (int ks = 0; ks < 4; ++ks) {
            const bf16x8 fa = *(const bf16x8*)(lds + GP_K + g_lds_off(32 * ta + fr, ks * 2 + fh)), fb = *(const bf16x8*)(lds + GP_K + g_lds_off(32 * tb + fr, ks * 2 + fh));
            g = __builtin_amdgcn_mfma_f32_32x32x16_bf16(fa, fb, g, 0, 0, 0);
        }
        float* G = (float*)(lds + GP_G);
#pragma unroll
        for (int r = 0; r < 16; ++r) G[(32 * ta + (r & 3) + 8 * (r >> 2) + 4 * fh) * 64 + 32 * tb + fr] = g[r];
    } else if (wv < 6) {
        const int dir = wv - 4; float v = sm[dir * 64 + (dir ? 63 - lane : lane)];
#pragma unroll
        for (int o = 1; o < 64; o <<= 1) { const float t = __shfl_up(v, o); if (lane >= o) v += t; }
        sm[256 + dir * 64 + lane] = v;
        float* gcg = w.gc + ((size_t)((b * 4 + h) * 2 + dir) * GD_NC + cc) * 64; gcg[lane] = v;
    }
    __syncthreads();
    const int dir = wv >> 2, t4 = tid & 255;
    {
        const float* G = (const float*)(lds + GP_G); float* Lm = (float*)(lds + GP_L0 + dir * 16384);
        for (int e = t4; e < 4096; e += 256) {
            const int i = e >> 6, j = e & 63; const int ti = dir ? 63 - i : i, tj = dir ? 63 - j : j;
            const float lv = j < i ? sm[128 + dir * 64 + ti] * G[ti * 64 + tj] * __expf(sm[256 + dir * 64 + i] - sm[256 + dir * 64 + j]) : 0.f;
            Lm[e] = lv;
            if (i >= 32 && j < 32) ((bf16*)(lds + GP_LB + dir * 2048))[(i - 32) * 32 + j] = f2bf(lv);
        }
    }
    __syncthreads();
    if ((__builtin_amdgcn_readfirstlane(wv) & 3) == 0) {
        const float* Lm = (const float*)(lds + GP_L0 + dir * 16384);
        char* Tm = lds + GP_T0 + dir * 8192;
        const int blk = lane >> 5, c = lane & 31;
        const LAS float* Lb = (const LAS float*)(Lm + (32 * blk) * 64 + 32 * blk);
        float Tc[32];
#pragma unroll
        for (int i = 0; i < 32; ++i) {
            const LAS float* Lr = Lb + i * 64;
            if (i >= 2) asm volatile("" : "+v"(Lr) : "v"(Tc[i - 2]));
            float a0 = (c == i) ? 1.0f : 0.f, a1 = 0.f, a2 = 0.f, a3 = 0.f;
#pragma unroll
            for (int j4 = 0; j4 < (i & ~3); j4 += 4) {
                const f32x4 l4 = *(const LAS f32x4*)(Lr + j4);
                a0 -= l4[0] * Tc[j4]; a1 -= l4[1] * Tc[j4 + 1]; a2 -= l4[2] * Tc[j4 + 2]; a3 -= l4[3] * Tc[j4 + 3];
            }
#pragma unroll
            for (int j = (i & ~3); j < i; ++j) a0 -= Lr[j] * Tc[j];
            Tc[i] = (a0 + a1) + (a2 + a3);
        }
        {
            int rb = 32 * blk; const int cb = (32 * blk + c) >> 3, cz = (32 * (1 - blk) + c) >> 3, co = (c & 7) * 2;
#pragma unroll
            for (int i = 0; i < 32; ++i) {
                asm volatile("" : "+v"(rb));
                const int row = rb + i, sw = (row >> 1) & 7;
                *(bf16*)(Tm + row * 128 + ((cb ^ sw) << 4) + co) = f2bf(Tc[i]);
                if (blk == 0) *(bf16*)(Tm + row * 128 + ((cz ^ sw) << 4) + co) = (bf16)0;
            }
        }
        asm volatile("s_waitcnt lgkmcnt(0)" ::: "memory");
        const char* Lq = lds + GP_LB + dir * 2048;
        f32x16 X;
#pragma unroll
        for (int r = 0; r < 16; ++r) X[r] = 0.f;
        const int i16 = lane & 15, g1 = (lane >> 4) & 1;
#pragma unroll
        for (int ks = 0; ks < 2; ++ks) {
            const bf16x8 fa = *(const bf16x8*)(Lq + fr * 64 + (ks * 2 + fh) * 16);
            const int jr = 16 * ks + 8 * fh + (i16 >> 2), dc = 16 * g1 + 4 * (i16 & 3);
            const s16x4 t0 = __builtin_amdgcn_ds_read_tr16_b64_v4i16((LAS s16x4*)(Tm + g_lds_off(jr, dc >> 3) + (dc & 7) * 2));
            const s16x4 t1 = __builtin_amdgcn_ds_read_tr16_b64_v4i16((LAS s16x4*)(Tm + g_lds_off(jr + 4, dc >> 3) + (dc & 7) * 2));
            bf16x8 fb; fb[0] = t0[0]; fb[1] = t0[1]; fb[2] = t0[2]; fb[3] = t0[3]; fb[4] = t1[0]; fb[5] = t1[1]; fb[6] = t1[2]; fb[7] = t1[3];
            X = __builtin_amdgcn_mfma_f32_32x32x16_bf16(fa, fb, X, 0, 0, 0);
        }
        f32x16 Y;
#pragma unroll
        for (int r = 0; r < 16; ++r) Y[r] = 0.f;
#pragma unroll
        for (int ks = 0; ks < 2; ++ks) {
            union { bf16x8 v; unsigned u[4]; } xb;
#pragma unroll
            for (int j = 0; j < 4; ++j) xb.u[j] = pack_bf16(X[8 * ks + 2 * j], X[8 * ks + 2 * j + 1]);
            const int c0 = 32 + 16 * ks + 4 * fh, c1 = c0 + 8;
            const u32x2 p0 = *(const u32x2*)(Tm + g_lds_off(32 + fr, c0 >> 3) + (c0 & 7) * 2), p1 = *(const u32x2*)(Tm + g_lds_off(32 + fr, c1 >> 3) + (c1 & 7) * 2);
            union { bf16x8 v; unsigned u[4]; } ta_; ta_.u[0] = p0.x; ta_.u[1] = p0.y; ta_.u[2] = p1.x; ta_.u[3] = p1.y;
            Y = __builtin_amdgcn_mfma_f32_32x32x16_bf16(ta_.v, xb.v, Y, 0, 0, 0);
        }
#pragma unroll
        for (int r = 0; r < 16; ++r) { const int row = 32 + (r & 3) + 8 * (r >> 2) + 4 * fh; *(bf16*)(Tm + g_lds_off(row, fr >> 3) + (fr & 7) * 2) = f2bf(-Y[r]); }
    } else {
        const int t3 = t4 - 64;
        for (int e = t3; e < 1024; e += 192) {
            const int mat = e >> 9, j = (e >> 3) & 63, c8 = e & 7; const int tj = dir ? 63 - j : j;
            const float sc = sm[128 + dir * 64 + tj] * (mat ? __expf(sm[256 + dir * 64 + j]) : 1.0f);
            const u32x4 src = mat ? *(const u32x4*)(lds + GP_K + g_lds_off(tj, c8)) : *(const u32x4*)(lds + GP_V + at_voff(tj, c8 * 8));
            u32x4 d;
#pragma unroll
            for (int x = 0; x < 4; ++x) d[x] = pack_bf16(sc * __uint_as_float(src[x] << 16), sc * __uint_as_float(src[x] & 0xffff0000u));
            *(u32x4*)(lds + GP_VB0 + (dir * 2 + mat) * 8192 + at_voff(j, c8 * 8)) = d;
        }
    }
    __syncthreads();
    {
        const int w4 = wv & 3, ta = w4 >> 1, tb = w4 & 1; const int i16 = lane & 15, g1 = (lane >> 4) & 1;
        const char* Tm = lds + GP_T0 + dir * 8192; const char* vb = lds + GP_VB0 + (dir * 2) * 8192; const char* kbe = vb + 8192;
        f32x16 aw, au;
#pragma unroll
        for (int r = 0; r < 16; ++r) { aw[r] = 0.f; au[r] = 0.f; }
#pragma unroll
        for (int ks = 0; ks < 4; ++ks) {
            const int jr = 16 * ks + 8 * fh + (i16 >> 2), dc = 32 * ta + 16 * g1 + 4 * (i16 & 3);
            const s16x4 k0 = __builtin_amdgcn_ds_read_tr16_b64_v4i16((LAS s16x4*)(kbe + at_voff(jr, dc))), k1 = __builtin_amdgcn_ds_read_tr16_b64_v4i16((LAS s16x4*)(kbe + at_voff(jr + 4, dc)));
            bf16x8 fa; fa[0] = k0[0]; fa[1] = k0[1]; fa[2] = k0[2]; fa[3] = k0[3]; fa[4] = k1[0]; fa[5] = k1[1]; fa[6] = k1[2]; fa[7] = k1[3];
            const bf16x8 fbT = *(const bf16x8*)(Tm + g_lds_off(32 * tb + fr, ks * 2 + fh));
            aw = __builtin_amdgcn_mfma_f32_32x32x16_bf16(fa, fbT, aw, 0, 0, 0);
            const bf16x8 faT = *(const bf16x8*)(Tm + g_lds_off(32 * ta + fr, ks * 2 + fh));
            const int dc2 = 32 * tb + 16 * g1 + 4 * (i16 & 3);
            const s16x4 v0 = __builtin_amdgcn_ds_read_tr16_b64_v4i16((LAS s16x4*)(vb + at_voff(jr, dc2))), v1 = __builtin_amdgcn_ds_read_tr16_b64_v4i16((LAS s16x4*)(vb + at_voff(jr + 4, dc2)));
            bf16x8 fv; fv[0] = v0[0]; fv[1] = v0[1]; fv[2] = v0[2]; fv[3] = v0[3]; fv[4] = v1[0]; fv[5] = v1[1]; fv[6] = v1[2]; fv[7] = v1[3];
            au = __builtin_amdgcn_mfma_f32_32x32x16_bf16(faT, fv, au, 0, 0, 0);
        }
        bf16* uwg = w.uw + ((size_t)(((b * 4 + h) * 2 + dir) * GD_NC + cc) * 2) * 4096;
#pragma unroll
        for (int g = 0; g < 4; ++g) {
            const int rr = 32 * ta + 8 * g + 4 * fh;
            u32x2 o1; o1.x = pack_bf16(-aw[4 * g], -aw[4 * g + 1]); o1.y = pack_bf16(-aw[4 * g + 2], -aw[4 * g + 3]);
            *(u32x2*)(uwg + (32 * tb + fr) * 64 + rr) = o1;
            u32x2 o2; o2.x = pack_bf16(au[4 * g], au[4 * g + 1]); o2.y = pack_bf16(au[4 * g + 2], au[4 * g + 3]);
            *(u32x2*)(uwg + 4096 + (32 * tb + fr) * 64 + rr) = o2;
        }
    }
}
#endif
#ifndef HOST_SIM
constexpr int GS_IN = 0  , GS_ST = 65536  , GS_U1 = GS_ST + 16384, GS_U2 = GS_U1 + 8192, GS_AT = GS_U2 + 8192,
              GS_TB = GS_AT + 8192  , GS_END = GS_TB + 2 * 1024;
__device__ __forceinline__ int gd_chunk_of_step(int dir, int n) { return dir ? (n < 4 ? 3 - n : 39 - n) : n; }

__device__ __forceinline__ void gdn_scan_chain(char* lds, const WS& w, int b, int h, int dir, bool emit_ctx) {
    int tid = threadIdx.x; asm volatile("" : "+v"(tid));
    const int lane = tid & 63, wv = tid >> 6, fr = lane & 31, fh = lane >> 5, w4 = wv & 3, ta = w4 >> 1, tb = w4 & 1;
    const int i16 = lane & 15, g1 = (lane >> 4) & 1;
    const bool lo = wv < 4;
    const size_t chain = (size_t)((b * 4 + h) * 2 + dir) * GD_NC;
    const bf16* qkb = w.qk + (size_t)(b * 4 + h) * GD_NC * 2 * 4096;
    bf16* uwb = w.uw + chain * 2 * 4096; const float* gcb = w.gc + chain * 64;
    const int lrow = tid >> 3, lch = tid & 7;
    const int qrow = dir ? 63 - lrow : lrow;
    __syncthreads();
    *(u32x4*)(lds + GS_ST + tid * 16) = (u32x4){0u, 0u, 0u, 0u};
    f32x16 Sacc;
#pragma unroll
    for (int r = 0; r < 16; ++r) Sacc[r] = 0.f;
    struct Pre { u32x4 rw, rq, rk; float rg; u32x2 uc[4]; };
    Pre pa, pb, pc;
    auto prefetch = [&](int n, Pre& r) {
        const int cc = gd_chunk_of_step(dir, n);
        const bf16* uwp = uwb + (size_t)cc * 2 * 4096; const bf16* qkp = qkb + (size_t)cc * 2 * 4096;
        r.rw = *(const u32x4*)(uwp + lrow * 64 + lch * 8);
        r.rq = *(const u32x4*)(qkp + lrow * 64 + lch * 8); r.rk = *(const u32x4*)(qkp + 4096 + lrow * 64 + lch * 8);
        r.rg = 0.f; if (tid < 64) r.rg = gcb[(size_t)cc * 64 + tid];
        if (lo) { const bf16* up = uwp + 4096 + (32 * tb + fr) * 64 + 32 * ta + 4 * fh;
#pragma unroll
            for (int g = 0; g < 4; ++g) r.uc[g] = *(const u32x2*)(up + 8 * g); }
    };
    auto stage = [&](int buf, const Pre& r) {
        char* ib = lds + GS_IN + buf * 32768;
        *(u32x4*)(ib + g_lds_off(lrow, lch)) = r.rw;
        *(u32x4*)(ib + 8192 + g_lds_off(qrow, lch)) = r.rq;
        *(u32x4*)(ib + 16384 + g_lds_off(qrow, lch)) = r.rk;
        *(u32x4*)(ib + 24576 + at_voff(qrow, lch * 8)) = r.rk;
        float* tbp = (float*)(lds + GS_TB + buf * 1024);
        if (tid < 64) { const float g63 = __shfl(r.rg, 63); tbp[tid] = r.rg; tbp[64 + tid] = __expf(r.rg); tbp[128 + tid] = __expf(g63 - r.rg); if (tid == 0) tbp[192] = __expf(g63); }
    };
    auto step = [&](int n, Pre& cur, const Pre& nx) {
        const int buf = n & 1; const char* ib = lds + GS_IN + buf * 32768; const float* tbp = (const float*)(lds + GS_TB + buf * 1024);
        const char* St = lds + GS_ST + buf * 8192; char* Stn = lds + GS_ST + (buf ^ 1) * 8192;
        const int cc = gd_chunk_of_step(dir, n);
        if (lo) {
            f32x16 acc;
#pragma unroll
            for (int g = 0; g < 4; ++g) { acc[4 * g] = __uint_as_float(cur.uc[g].x << 16); acc[4 * g + 1] = __uint_as_float(cur.uc[g].x & 0xffff0000u); acc[4 * g + 2] = __uint_as_float(cur.uc[g].y << 16); acc[4 * g + 3] = __uint_as_float(cur.uc[g].y & 0xffff0000u); }
#pragma unroll
            for (int ks = 0; ks < 4; ++ks) {
                const bf16x8 fa = *(const bf16x8*)(ib + g_lds_off(32 * ta + fr, ks * 2 + fh)), fb = *(const bf16x8*)(St + g_lds_off(32 * tb + fr, ks * 2 + fh));
                acc = __builtin_amdgcn_mfma_f32_32x32x16_bf16(fa, fb, acc, 0, 0, 0);
            }
#pragma unroll
            for (int g = 0; g < 4; ++g) {
                const int i0 = 32 * ta + 8 * g + 4 * fh; const f32x4 fc = *(const f32x4*)(tbp + 128 + i0);
                u32x2 o1; o1.x = pack_bf16(acc[4 * g], acc[4 * g + 1]); o1.y = pack_bf16(acc[4 * g + 2], acc[4 * g + 3]);
                u32x2 o2; o2.x = pack_bf16(acc[4 * g] * fc[0], acc[4 * g + 1] * fc[1]); o2.y = pack_bf16(acc[4 * g + 2] * fc[2], acc[4 * g + 3] * fc[3]);
                const int off = g_lds_off(32 * tb + fr, i0 >> 3) + (i0 & 7) * 2;
                *(u32x2*)(lds + GS_U1 + off) = o1; *(u32x2*)(lds + GS_U2 + off) = o2;
            }
        } else {
            f32x16 acc;
#pragma unroll
            for (int r = 0; r < 16; ++r) acc[r] = 0.f;
#pragma unroll
            for (int ks = 0; ks < 4; ++ks) {
                const bf16x8 fa = *(const bf16x8*)(ib + 16384 + g_lds_off(32 * ta + fr, ks * 2 + fh)), fb = *(const bf16x8*)(ib + 8192 + g_lds_off(32 * tb + fr, ks * 2 + fh));
                acc = __builtin_amdgcn_mfma_f32_32x32x16_bf16(fa, fb, acc, 0, 0, 0);
            }
            const int i = 32 * tb + fr; const float gi = tbp[i];
#pragma unroll
            for (int g = 0; g < 4; ++g) {
                const int j0 = 32 * ta + 8 * g + 4 * fh; const f32x4 gj = *(const f32x4*)(tbp + j0);
                float v[4];
#pragma unroll
                for (int x = 0; x < 4; ++x) v[x] = (j0 + x <= i) ? acc[4 * g + x] * __expf(gi - gj[x]) : 0.f;
                u32x2 o; o.x = pack_bf16(v[0], v[1]); o.y = pack_bf16(v[2], v[3]);
                *(u32x2*)(lds + GS_AT + g_lds_off(i, j0 >> 3) + (j0 & 7) * 2) = o;
            }
        }
        __syncthreads();
        if (lo) {
            if (cc >= 4 || emit_ctx) {
                f32x16 acc, acc2;
#pragma unroll
                for (int r = 0; r < 16; ++r) { acc[r] = 0.f; acc2[r] = 0.f; }
#pragma unroll
                for (int ks = 0; ks < 4; ++ks) {
                    const bf16x8 fa = *(const bf16x8*)(ib + 8192 + g_lds_off(32 * ta + fr, ks * 2 + fh)), fb = *(const bf16x8*)(St + g_lds_off(32 * tb + fr, ks * 2 + fh));
                    acc = __builtin_amdgcn_mfma_f32_32x32x16_bf16(fa, fb, acc, 0, 0, 0);
                    const bf16x8 fa2 = *(const bf16x8*)(lds + GS_AT + g_lds_off(32 * ta + fr, ks * 2 + fh)), fb2 = *(const bf16x8*)(lds + GS_U1 + g_lds_off(32 * tb + fr, ks * 2 + fh));
                    acc2 = __builtin_amdgcn_mfma_f32_32x32x16_bf16(fa2, fb2, acc2, 0, 0, 0);
                }
                bf16* op = uwb + (size_t)cc * 2 * 4096 + 4096 + (32 * tb + fr) * 64 + 32 * ta + 4 * fh;
#pragma unroll
                for (int g = 0; g < 4; ++g) {
                    const f32x4 eg = *(const f32x4*)(tbp + 64 + 32 * ta + 8 * g + 4 * fh);
                    u32x2 o; o.x = pack_bf16(acc[4 * g] * eg[0] + acc2[4 * g], acc[4 * g + 1] * eg[1] + acc2[4 * g + 1]); o.y = pack_bf16(acc[4 * g + 2] * eg[2] + acc2[4 * g + 2], acc[4 * g + 3] * eg[3] + acc2[4 * g + 3]);
                    *(u32x2*)(op + 8 * g) = o;
                }
            }
        } else {
            const float e63 = tbp[192];
#pragma unroll
            for (int r = 0; r < 16; ++r) Sacc[r] *= e63;
#pragma unroll
            for (int ks = 0; ks < 4; ++ks) {
                const int ir = 16 * ks + 8 * fh + (i16 >> 2), dc = 32 * ta + 16 * g1 + 4 * (i16 & 3);
                const s16x4 k0 = __builtin_amdgcn_ds_read_tr16_b64_v4i16((LAS s16x4*)(ib + 24576 + at_voff(ir, dc))), k1 = __builtin_amdgcn_ds_read_tr16_b64_v4i16((LAS s16x4*)(ib + 24576 + at_voff(ir + 4, dc)));
                bf16x8 fa; fa[0] = k0[0]; fa[1] = k0[1]; fa[2] = k0[2]; fa[3] = k0[3]; fa[4] = k1[0]; fa[5] = k1[1]; fa[6] = k1[2]; fa[7] = k1[3];
                const bf16x8 fb = *(const bf16x8*)(lds + GS_U2 + g_lds_off(32 * tb + fr, ks * 2 + fh));
                Sacc = __builtin_amdgcn_mfma_f32_32x32x16_bf16(fa, fb, Sacc, 0, 0, 0);
            }
#pragma unroll
            for (int g = 0; g < 4; ++g) {
                const int d0 = 32 * ta + 8 * g + 4 * fh; u32x2 o; o.x = pack_bf16(Sacc[4 * g], Sacc[4 * g + 1]); o.y = pack_bf16(Sacc[4 * g + 2], Sacc[4 * g + 3]);
                *(u32x2*)(Stn + g_lds_off(32 * tb + fr, d0 >> 3) + (d0 & 7) * 2) = o;
            }
        }
        if (n + 1 < GD_NC) stage(buf ^ 1, nx);
        if (n + 3 < GD_NC) prefetch(n + 3, cur);
        __syncthreads();
    };
    prefetch(0, pa); prefetch(1, pb); prefetch(2, pc);
    stage(0, pa);
    __syncthreads();
    for (int n = 0; n < GD_NC; n += 3) { step(n, pa, pb); step(n + 1, pb, pc); step(n + 2, pc, pa); }
}

__device__ __forceinline__ void gdn_fin_item(char* lds, const WS& w, const float* ng, int b, int cc, int h) {
    int tid = threadIdx.x; asm volatile("" : "+v"(tid));
    bf16* lo_ = (bf16*)lds;
    __syncthreads();
    for (int i = tid; i < 1024; i += NTHREADS) {
        const int dir = i >> 9, dv = (i >> 3) & 63, k = i & 7;
        const bf16* src = w.uw + ((size_t)(((b * 4 + h) * 2 + dir) * GD_NC + cc) * 2 + 1) * 4096 + dv * 64 + k * 8;
        *(u32x4*)(lo_ + (dir * 64 + dv) * 72 + k * 8) = *(const u32x4*)src;
    }
    __syncthreads();
    const int tl = tid >> 3, dg = tid & 7; const size_t tok = gd_tok0(b, cc) + tl;
    float o[8]; float ss = 0.f;
#pragma unroll
    for (int x = 0; x < 8; ++x) { const int dv = dg * 8 + x; o[x] = bf2f(lo_[dv * 72 + tl]) + bf2f(lo_[(64 + dv) * 72 + 63 - tl]); ss += o[x] * o[x]; }
    ss += __shfl_xor(ss, 1); ss += __shfl_xor(ss, 2); ss += __shfl_xor(ss, 4);
    const float rs = 1.0f / sqrtf(ss * (1.0f / 64.0f) + EPS);
    const u32x4 gt = *(const u32x4*)(w.p + tok * DIN + O3 + 768 + h * 64 + dg * 8);
    u32x4 out;
#pragma unroll
    for (int x = 0; x < 4; ++x) {
        const float g0 = __uint_as_float(gt[x] << 16), g1v = __uint_as_float(gt[x] & 0xffff0000u);
        const float y0 = o[2 * x] * rs * ng[dg * 8 + 2 * x] * (g0 / (1.0f + __expf(-g0))), y1 = o[2 * x + 1] * rs * ng[dg * 8 + 2 * x + 1] * (g1v / (1.0f + __expf(-g1v)));
        out[x] = pack_bf16(y0, y1);
    }
    *(u32x4*)(w.ycat + tok * 1024 + 768 + h * 64 + dg * 8) = out;
}
#endif
#ifndef HOST_SIM
namespace cg = cooperative_groups;
struct MP { Inputs in; float* out; WS w; };

template <class F> __device__ __forceinline__ void dev_run(const F& f, long n) {
    int t0 = threadIdx.x; asm volatile("" : "+v"(t0));
    for (long i = (long)blockIdx.x * NTHREADS + t0; i < n; i += (long)gridDim.x * NTHREADS) f(i);
}

struct TLInProj {
    const bf16* A; const bf16* Bt; EpiInProj e; static constexpr int K = 1024;
    struct Tile { int m0, n0; };
    __device__ __forceinline__ bool tile(int idx, Tile& t) const {
        constexpr int MT = T / GBM, NT = (DIN + GBN - 1) / GBN;
        if (idx >= MT * NT) return false;
        const int mg = idx / (8 * NT), rem = idx % (8 * NT); t.n0 = (rem / 8) * GBN; t.m0 = (mg * 8 + (rem & 7)) * GBM; return true;
    }
    __device__ __forceinline__ const bf16* arow(const Tile& t, int r) const { return A + (size_t)(t.m0 + r) * D; }
    __device__ __forceinline__ const bf16* brow(const Tile& t, int r) const { return Bt + (size_t)(t.n0 + r) * 1024; }
    __device__ __forceinline__ void epi(const Tile& t, f32x16 (&acc)[2][2], int mr, int nc) const { e(acc, t.m0 + mr, t.n0 + nc); }
};
struct TLOutProj {
    const bf16* A; const bf16* Bt; EpiOutProj e; int ntiles; static constexpr int K = 1024;
    struct Tile { int m0, n0; };
    __device__ __forceinline__ bool tile(int idx, Tile& t) const { if (idx >= ntiles) return false; t.m0 = (idx >> 3) * GBM; t.n0 = (idx & 7) * GBN; return true; }
    __device__ __forceinline__ const bf16* arow(const Tile& t, int r) const { return A + (size_t)(t.m0 + r) * 1024; }
    __device__ __forceinline__ const bf16* brow(const Tile& t, int r) const { return Bt + (size_t)(t.n0 + r) * 1024; }
    __device__ __forceinline__ void epi(const Tile& t, f32x16 (&acc)[2][2], int mr, int nc) const { e(acc, t.m0 + mr, t.n0 + nc); }
};
__device__ __forceinline__ void phase_inproj(char* lds, const WS& w, int l) {
    gemm_stream(lds, TLInProj{l == 0 ? w.h : w.hid2, w.winT + (size_t)l * 3328 * 1024, EpiInProj{w.p, w.rope}});
}
__device__ __forceinline__ void phase_outproj(char* lds, const WS& w, int l, const float* mod, int ntok, const float* xin, const float* cin) {
    gemm_stream(lds, TLOutProj{w.ycat, w.woutT + (size_t)l * 1024 * 1024, EpiOutProj{w.xr, mod, l == 0 ? xin : nullptr, cin}, (ntok / GBM) * 8});
}
struct EpiStoreP { bf16* p;
    __device__ __forceinline__ void operator()(f32x16 (&acc)[2][2], int mrow, int ncol) const {
#pragma unroll
        for (int mi = 0; mi < 2; ++mi)
#pragma unroll
            for (int ni = 0; ni < 2; ++ni)
#pragma unroll
                for (int g = 0; g < 4; ++g) { u32x2 v; v.x = pack_bf16(acc[mi][ni][4 * g], acc[mi][ni][4 * g + 1]); v.y = pack_bf16(acc[mi][ni][4 * g + 2], acc[mi][ni][4 * g + 3]);
                    *(u32x2*)(p + (size_t)(mrow + mi * 32) * 1024 + ncol + ni * 32 + 8 * g) = v; }
    } };
__device__ __forceinline__ void phase_outproj_dup(char* lds, const WS& w, int l, int ntok) {
    const int MT = ntok / GBM, NT = D / GBN;
    const bf16* Bt = w.woutT + (size_t)l * 1024 * 1024;
    for (int tile = blockIdx.x; tile < MT * NT; tile += gridDim.x) {
        const int mt = tile / NT, nt = tile % NT;
        gemm_tile(lds, ARowDense{w.ycat, 1024, mt * GBM}, Bt, 1024, 1024, mt * GBM, nt * GBN, EpiStoreP{w.p});
    }
}
__device__ __forceinline__ int q_next(int* head, int* slot  ) {
    __syncthreads();
    if (threadIdx.x == 0) *slot = __hip_atomic_fetch_add(head, 1, __ATOMIC_RELAXED, __HIP_MEMORY_SCOPE_AGENT);
    __syncthreads();
    return *slot;
}
__global__ void __launch_bounds__(NTHREADS) mega_kernel(MP mp) {
    extern __shared__ __attribute__((aligned(16))) char lds[];
    __shared__ uint4 xb_words;
    __shared__ int q_slot[4];
    cg::grid_group grid = cg::this_grid();
    const Inputs& in = mp.in; const WS& w = mp.w;
    if (threadIdx.x == 0) xb_words = make_uint4(0u, 0u, 0u, 0u);
    __syncthreads();
    XcdBarrier xb = xcd_barrier_post(w.bar, (volatile LAS unsigned*)&xb_words);
#define GSYNC(id) xcd_barrier(xb)
    phase_ada(lds, w, in);
    dev_run(NkRopeTab{w.rope}, NkRopeTab::count());
    dev_run(NkZeroI{w.cnt}, 4 * 32 * 32);
    dev_run(NkZeroI{w.qctr}, 64 * 64);
    for (int it = blockIdx.x; it < 16 * 52; it += gridDim.x) cvt_tile(lds, in.w_in, DIN, w.winT, 1024, (it / 52) * 64, (it % 52) * 64, DIN, 3328, NMapId{});
    for (int l = 0; l < 2; ++l) {
        hy_filter_mlp(lds, in.hy_w1 + l * 33 * 64, in.hy_b1 + l * 64, in.hy_w2 + l * 64 * 64, in.hy_b2 + l * 64, in.hy_freq + l * 64, w.f2b + (size_t)l * (S + LC) * 64);
        { NkCvtT c4{in.hy_w3 + (size_t)l * 64 * 512, w.w3T + (size_t)l * 512 * 64, 64, 512, 512}; dev_run(c4, c4.count()); }
    }
    if (mp.out == nullptr) grid.sync();
    xcd_barrier(xb);
    row_pass<3, 1>(w, in, T, w.mod, w.mod, in.norm1, 0, 1, nullptr, nullptr, nullptr, w.h);
    GSYNC(0);
    for (int l = 0; l < 2; ++l) {
        const bool need_ctx = l == 0;
        const float* mod = w.mod + (size_t)l * 9 * 6144;
        const long ntok = need_ctx ? T : TL;
        const float* filt = w.filt + (size_t)l * (S + LC) * 512;
        phase_inproj(lds, w, l);
        hy_filter_out(w.w3T + (size_t)l * 512 * 64, w.f2b + (size_t)l * (S + LC) * 64, w.filt + (size_t)l * (S + LC) * 512);
        GSYNC(2);
        const float* hcw = in.hy_conv + l * 3 * 768;
        if (l == 0) {
            for (int it = blockIdx.x; it < 16 * 52; it += gridDim.x) cvt_tile(lds, in.w_in + (size_t)D * DIN, DIN, w.winT + (size_t)3328 * 1024, 1024, (it / 52) * 64, (it % 52) * 64, DIN, 3328, NMapId{});
            for (int l2 = 0; l2 < 2; ++l2) {
                for (int it = blockIdx.x; it < 16 * 16; it += gridDim.x) cvt_tile(lds, in.w_out + (size_t)l2 * 1024 * D, D, w.woutT + (size_t)l2 * 1024 * 1024, 1024, (it >> 4) * 64, (it & 15) * 64, D, D, NMapId{});
                NkCvtT c3{in.moe_router + (size_t)l2 * D * 32, w.wrT + (size_t)l2 * 32 * 1024, 1024, 32, 32}; dev_run(c3, c3.count());
            }
        }
        for (int it = blockIdx.x; it < B * GD_NC * 4; it += gridDim.x) gdn_pre_item(lds, w, in.gdn_conv + l * 4 * 768, in.gdn_a_log + l * 8, in.gdn_dt_bias + l * 8, it / (GD_NC * 4), (it >> 2) % GD_NC, it & 3);
        for (int it = blockIdx.x; it < B * 32 + (need_ctx ? B * 4 : 0); it += gridDim.x) { if (it < B * 32) hy_prep_item(lds, w.p, hcw, w.x0T, w.uvT, it >> 5, it & 31); else hy_prep_item(lds, w.p, hcw, w.x0Tc, w.uvTc, (it - B * 32) >> 2, (it - B * 32) & 3, true); }
        GSYNC(90);
        {
            const int natt = 512 + (need_ctx ? 64 : 0);
            int* head = w.qctr + l * 64;
            for (;;) {
                const int it = q_next(head, q_slot);
                if (it >= 64 + 256 + natt) break;
                if (it < 64) gdn_scan_chain(lds, w, it >> 3, (it >> 1) & 3, it & 1, need_ctx);
                else if (it < 320) hy_conv_item(lds, filt, in.hy_bias + l * 256, w.uvT, w.x0T, it - 64, need_ctx ? w.uvTc : nullptr, w.x0Tc);
                else attn_item(lds, w, in, l, it - 320);
            }
        }
        GSYNC(91);
        for (int it = blockIdx.x; it < B * 32 + (need_ctx ? B * 4 : 0); it += gridDim.x) { if (it < B * 32) hy_fin_item(lds, w.x0T, w.ycat, it >> 5, it & 31); else hy_fin_item(lds, w.x0Tc, w.ycat, (it - B * 32) >> 2, (it - B * 32) & 3, true); }
        for (int it = blockIdx.x; it < B * GD_NC * 4; it += gridDim.x) { const int cc = (it >> 2) % GD_NC; if (cc >= 4 || need_ctx) gdn_fin_item(lds, w, in.gdn_norm + l * 64, it / (GD_NC * 4), cc, it & 3); }
        GSYNC(5);
        phase_outproj(lds, w, l, mod, (int)ntok, in.x, in.ctx);
        {
            for (int it = blockIdx.x; it < 33 * 2 * 16; it += gridDim.x) {
                const int e = it >> 5, which = (it >> 4) & 1, kt = it & 15;
                const float* src = e < 32 ? (which ? in.moe_up : in.moe_gate) + ((size_t)l * 32 + e) * D * 256 : (which ? in.sh_up : in.sh_gate) + (size_t)l * D * 256;
                cvt_strip(lds, src, 256, w.moeUpT + (size_t)e * 512 * 1024, 1024, kt * 64, 0, 256, 256, NMapUp{which});
            }
            for (int it = blockIdx.x; it < 33 * 16; it += gridDim.x) {
                const int e = it >> 4, kt = (it >> 2) & 3, st = it & 3;
                const float* src = e < 32 ? in.moe_down + ((size_t)l * 32 + e) * 256 * D : in.sh_down + (size_t)l * 256 * D;
                cvt_strip(lds, src, D, w.moeDownT + (size_t)e * 1024 * 256, 256, kt * 64, st * 256, D, D, NMapId{});
            }
        }
        GSYNC(6);
        phase_norm2_router(lds, w, in, (int)ntok, mod, in.norm2 + l * D, in.moe_bias + l * 32, l);
        GSYNC(7);
        phase_moe_up(lds, w, l, (int)ntok);
        GSYNC(9);
        phase_moe_down(lds, w, l, (int)ntok, mod);
        GSYNC(10);
        if (l == 0) row_pass<2, 1>(w, in, (int)ntok, mod, w.mod + (size_t)9 * 6144, in.norm1 + D, 0, 1, (const bf16*)w.h, w.topw, nullptr, w.hid2);
        else row_pass<2, 2>(w, in, (int)ntok, mod, mod, in.norm_f, 0, 0, (const bf16*)w.h, w.topw, mp.out, nullptr);
        GSYNC(11);
    }
}

constexpr size_t kDynLds = G_LDS3;
static_assert(H_LDS <= kDynLds &&  HY_LDS_END <= kDynLds && AT_RING * AT_STAGE + 2048 <= kDynLds && GP_END <= kDynLds && GS_END <= kDynLds, "LDS budget");
extern "C" void kernel_launch(void* const* d_in, const int* in_sizes, int n_in, void* d_out, int out_size, void* d_ws, size_t ws_size, hipStream_t stream) {
    static int grid_blocks = 0;
    if (!grid_blocks) {
        int dev = 0, cus = 0, per_cu = 0;
        hipGetDevice(&dev);
        hipDeviceGetAttribute(&cus, hipDeviceAttributeMultiprocessorCount, dev);
        hipFuncSetAttribute((const void*)mega_kernel, hipFuncAttributeMaxDynamicSharedMemorySize, (int)kDynLds);
        hipOccupancyMaxActiveBlocksPerMultiprocessor(&per_cu, mega_kernel, NTHREADS, kDynLds);
        if (per_cu < 1) per_cu = 1;
        grid_blocks = cus;
    }
    MP mp; memset(&mp, 0, sizeof(mp));
    const float** ip = (const float**)&mp.in;
    for (int i = 0; i < 33; ++i) ip[i] = (const float*)d_in[i];
    mp.out = (float*)d_out; mp.w = make_ws(d_ws);
    hipMemsetAsync(mp.w.bar, 0, 4096 * 4, stream);
    void* args[] = {&mp};
    hipError_t e = hipLaunchCooperativeKernel((void*)mega_kernel, dim3(grid_blocks), dim3(NTHREADS), args, kDynLds, stream);
    if (e != hipSuccess) fprintf(stderr, "cooperative launch failed: %s (grid %d)\n", hipGetErrorString(e), grid_blocks);
}
#endif
```

```cpp
#ifndef HOST_SIM
#include <hip/hip_runtime.h>
#include <hip/hip_cooperative_groups.h>
#include <cstdio>
#include <cstring>
#define HD __host__ __device__ __forceinline__
#else
#include <cmath>
#include <cstdio>
#include <cstdlib>
#include <cstring>
#define HD inline
typedef void* hipStream_t;
#endif
#include <cstdint>
#include <cstddef>

#ifndef BATCH
#define BATCH 8
#endif
constexpr int B = BATCH, S = 2048, D = 1024, LC = 256, GRID_W = 64;
constexpr int TL = B * S, TC = B * LC, T = TL + TC;
constexpr int DIN = 3088, O1 = 768, O2 = 1280, O3 = 2048;
constexpr int WINDOW = 128, NA_KR = 8, NA_KC = 16;
constexpr float EPS = 1e-6f, ROPE_BASE = 10000.0f, ROUTED_SCALE = 2.5f;
constexpr float HY_DECAY_MIN = 3.0701134573253946f;
constexpr float HY_DECAY_MAX = 15.350567286626973f;
typedef unsigned short bf16;

HD float bf2f(bf16 h) { union { unsigned u; float f; } v; v.u = (unsigned)h << 16; return v.f; }
HD bf16 f2bf(float f) { union { float f; unsigned u; } v; v.f = f; unsigned u = v.u; u += 0x7fffu + ((u >> 16) & 1u); return (bf16)(u >> 16); }
HD float siluf(float x) { return x / (1.0f + expf(-x)); }

struct NkCopyX {
    const float* x; const float* ctx; float* xr;
    HD void operator()(long i) const { xr[i] = i < (long)TL * D ? x[i] : ctx[i - (long)TL * D]; }
    static HD long count() { return (long)T * D; }
};

struct NkAda {
    const float* c; const float* cctx; const float* w_ada; const float* b_ada; float* mod;
    HD void operator()(long i) const {
        int n = (int)(i % 6144); int r = (int)((i / 6144) % 9); int l = (int)(i / (6144 * 9));
        const float* cv = r < 8 ? c + (long)(r % B) * D : cctx;
        const float* w = w_ada + (long)l * D * 6144 + n;
        float acc = 0.f;
        for (int k = 0; k < D; ++k) { float v = cv[k]; acc += siluf(v) * w[(long)k * 6144]; }
        mod[i] = acc + b_ada[l * 6144 + n];
    }
    static HD long count() { return 2L * 9 * 6144; }
};

struct NkRstd {
    const float* xr; float* rstd; int nrows;
    HD void operator()(long t) const {
        const float* r = xr + t * D; float s = 0.f;
        for (int k = 0; k < D; ++k) s += r[k] * r[k];
        rstd[t] = 1.0f / sqrtf(s * (1.0f / D) + EPS);
    }
};

struct NkModNorm {
    const float* xr; const float* rstd; const float* g; const float* mod;   int sh_chunk, sc_chunk; bf16* h;
    HD void operator()(long i) const {
        long t = i / D; int k = (int)(i % D); int r = t < TL ? (int)(t / S) : 8;
        const float* m = mod + (long)r * 6144;
        float v = xr[i] * rstd[t] * g[k];
        h[i] = f2bf(v * (1.0f + m[sc_chunk * D + k]) + m[sh_chunk * D + k]);
    }
};

struct NkInProj {
    const bf16* h; const float* w; bf16* p;
    HD void operator()(long i) const {
        long t = i / DIN; int n = (int)(i % DIN);
        const bf16* hr = h + t * D; float acc = 0.f;
        for (int k = 0; k < D; ++k) acc += bf2f(hr[k]) * w[(long)k * DIN + n];
        p[i] = f2bf(acc);
    }
    static HD long count() { return (long)T * DIN; }
};

struct NkRope {
    bf16* p;
    HD void operator()(long i) const {
        int pr = (int)(i % 32); int hd = (int)((i / 32) % 6); long t = i / (32 * 6);
        int s = (int)(t % S); int row = s / GRID_W, col = s % GRID_W;
        int axis = pr >> 4, j = pr & 15;
        float pos = axis == 0 ? (float)row : (float)col;
        float inv = powf(ROPE_BASE, -(float)j / 16.0f);
        float ang = pos * inv; float cs = cosf(ang), sn = sinf(ang);
        bf16* q = p + t * DIN + O1 + hd * 64 + axis * 32;
        float x1 = bf2f(q[j]), x2 = bf2f(q[j + 16]);
        q[j] = f2bf(x1 * cs - x2 * sn); q[j + 16] = f2bf(x1 * sn + x2 * cs);
    }
    static HD long count() { return (long)TL * 6 * 32; }
};

struct NkHyF1 {
    const float* w1; const float* b1; const float* freq; float* f1;
    HD void operator()(long i) const {
        int j = (int)(i % 64); int tt = (int)(i / 64); int L = tt < S ? S : LC; int t = tt < S ? tt : tt - S;
        float tn = (float)t / (float)(L - 1);
        float acc = tn * w1[j];
        for (int bnd = 0; bnd < 16; ++bnd) {
            float band = 1e-4f + (float)bnd * ((15.0f - 1e-4f) / 15.0f);
            float ang = (6.283185307179586f / (float)L) * (float)t * band;
            acc += cosf(ang) * w1[(1 + bnd) * 64 + j] - sinf(ang) * w1[(17 + bnd) * 64 + j];
        }
        f1[i] = sinf(freq[j] * (acc + b1[j]));
    }
    static HD long count() { return (long)(S + LC) * 64; }
};
struct NkHyF2 {
    const float* w2; const float* b2; const float* freq; const float* f1; float* f2; bf16* f2b;
    HD void operator()(long i) const {
        int j = (int)(i % 64); long tt = i / 64; float acc = 0.f;
        for (int k = 0; k < 64; ++k) acc += f1[tt * 64 + k] * w2[k * 64 + j];
        const float v = sinf(freq[j] * (acc + b2[j]));
        f2[i] = v; if (f2b) f2b[i] = f2bf(v);
    }
    static HD long count() { return (long)(S + LC) * 64; }
};
struct NkHyF3 {
    const float* w3; const float* f2; float* filt;
    HD void operator()(long i) const {
        int tt = (int)(i % (S + LC)); int c = (int)(i / (S + LC)); int L = tt < S ? S : LC; int t = tt < S ? tt : tt - S;
        float tn = (float)t / (float)(L - 1);
        float acc = 0.f;
        for (int k = 0; k < 64; ++k) acc += f2[(long)tt * 64 + k] * w3[k * 512 + c];
        int cc = c & 255;
        float decay = HY_DECAY_MIN + (float)cc * ((HY_DECAY_MAX - HY_DECAY_MIN) / 255.0f);
        filt[(long)c * (S + LC) + tt] = acc * expf(-tn * decay);
    }
    static HD long count() { return (long)(S + LC) * 512; }
};
HD float hy_conv3(const bf16* p, long t, int tin, int L, int col, const float* cw) {
    float acc = cw[768 + col] * bf2f(p[t * DIN + col]);
    if (tin > 0) acc += cw[col] * bf2f(p[(t - 1) * DIN + col]);
    if (tin < L - 1) acc += cw[2 * 768 + col] * bf2f(p[(t + 1) * DIN + col]);
    return acc;
}
struct NkHyUV {
    const bf16* p; const float* cw; bf16* uv; long tbase; long ntok; int L;
    HD void operator()(long i) const {
        int c = (int)(i % 256); long t = tbase + i / 256; int tin = (int)((t - tbase) % L);
        float x1 = hy_conv3(p, t, tin, L, 256 + c, cw), v = hy_conv3(p, t, tin, L, 512 + c, cw);
        uv[t * 256 + c] = f2bf(x1 * v);
    }
};
struct NkHyConv {
    const bf16* p; const float* cw; const bf16* uv; const float* filt; const float* hbias; bf16* ycat; long tbase; int L; int foff;
    HD void operator()(long i) const {
        int tin = (int)(i % L); int c = (int)((i / L) % 256); long seq = i / ((long)L * 256); long t0 = tbase + seq * L; long t = t0 + tin;
        const float* f = filt + foff;
        float acc = 0.f;
        for (int s = 0; s < L; ++s) {
            int d = tin - s; float k = d >= 0 ? f[(long)c * (S + LC) + d] : f[(long)(256 + c) * (S + LC) - d];
            acc += k * bf2f(uv[(t0 + s) * 256 + c]);
        }
        acc += hbias[c] * bf2f(uv[t * 256 + c]);
        float x0 = hy_conv3(p, t, tin, L, c, cw);
        ycat[t * 1024 + c] = f2bf(x0 * acc);
    }
};

HD void attn_key(const float (&q)[64], const bf16* kr, const bf16* vr, float bias, float& m, float& l, float (&acc)[64]) {
    float sc = 0.f;
#pragma unroll
    for (int d = 0; d < 64; ++d) sc += q[d] * bf2f(kr[d]);
    sc = sc * 0.125f + bias;
    float mn = fmaxf(m, sc); float ca = expf(m - mn), cb = expf(sc - mn);
    l = l * ca + cb; m = mn;
#pragma unroll
    for (int d = 0; d < 64; ++d) acc[d] = acc[d] * ca + cb * bf2f(vr[d]);
}
struct NkWA {
    const bf16* p; const float* sink; bf16* ycat;
    HD void operator()(long i) const {
        int hq = (int)(i % 4); long t = i / 4; int b = (int)(t / S), s = (int)(t % S); int hk = hq >> 1;
        const bf16* qp = p + t * DIN + O1 + hq * 64;
        float q[64], acc[64];
#pragma unroll
        for (int d = 0; d < 64; ++d) { q[d] = bf2f(qp[d]); acc[d] = 0.f; }
        float m = sink[hq], l = 1.0f;
        for (int j = 0; j < LC; ++j) {
            const bf16* kr = p + ((long)TL + (long)b * LC + j) * DIN + O1 + 256 + hk * 64;
            attn_key(q, kr, kr + 128, 0.f, m, l, acc);
        }
        int j0 = s - WINDOW < 0 ? 0 : s - WINDOW, j1 = s + WINDOW > S - 1 ? S - 1 : s + WINDOW;
        for (int j = j0; j <= j1; ++j) {
            const bf16* kr = p + ((long)b * S + j) * DIN + O1 + 256 + hk * 64;
            attn_key(q, kr, kr + 128, 0.f, m, l, acc);
        }
        float il = 1.0f / l;
#pragma unroll
        for (int d = 0; d < 64; ++d) ycat[t * 1024 + 256 + hq * 64 + d] = f2bf(acc[d] * il);
    }
    static HD long count() { return (long)TL * 4; }
};
struct NkWACtx {
    const bf16* p; const float* sink; bf16* ycat;
    HD void operator()(long i) const {
        int hq = (int)(i % 4); long tc = i / 4; int b = (int)(tc / LC); int hk = hq >> 1; long t = TL + tc;
        const bf16* qp = p + t * DIN + O1 + hq * 64;
        float q[64], acc[64];
#pragma unroll
        for (int d = 0; d < 64; ++d) { q[d] = bf2f(qp[d]); acc[d] = 0.f; }
        float m = sink[hq], l = 1.0f;
        for (int j = 0; j < LC; ++j) {
            const bf16* kr = p + ((long)TL + (long)b * LC + j) * DIN + O1 + 256 + hk * 64;
            attn_key(q, kr, kr + 128, 0.f, m, l, acc);
        }
        float il = 1.0f / l;
#pragma unroll
        for (int d = 0; d < 64; ++d) ycat[t * 1024 + 256 + hq * 64 + d] = f2bf(acc[d] * il);
    }
    static HD long count() { return (long)TC * 4; }
};
struct NkNA {
    const bf16* p; const float* rpb; bf16* ycat;
    HD void operator()(long i) const {
        int h = (int)(i % 4); long t = i / 4; int b = (int)(t / S), s = (int)(t % S);
        int r = s / GRID_W, cq = s % GRID_W;
        const bf16* qp = p + t * DIN + O2 + h * 64;
        float q[64], acc[64];
#pragma unroll
        for (int d = 0; d < 64; ++d) { q[d] = bf2f(qp[d]); acc[d] = 0.f; }
        float m = -1e30f, l = 0.f;
        for (int j = 0; j < LC; ++j) {
            const bf16* kr = p + ((long)TL + (long)b * LC + j) * DIN + O2 + 256 + h * 64;
            attn_key(q, kr, kr + 256, 0.f, m, l, acc);
        }
        int r0 = r - NA_KR / 2; r0 = r0 < 0 ? 0 : (r0 > S / GRID_W - NA_KR ? S / GRID_W - NA_KR : r0);
        int c0 = cq - NA_KC / 2; c0 = c0 < 0 ? 0 : (c0 > GRID_W - NA_KC ? GRID_W - NA_KC : c0);
        for (int kk = 0; kk < NA_KR * NA_KC; ++kk) {
            int kr_ = r0 + kk / NA_KC, kc_ = c0 + kk % NA_KC;
            const bf16* kr = p + ((long)b * S + kr_ * GRID_W + kc_) * DIN + O2 + 256 + h * 64;
            attn_key(q, kr, kr + 256, rpb[(h * 15 + (kr_ - r + 7)) * 31 + (kc_ - cq + 15)], m, l, acc);
        }
        float il = 1.0f / l;
#pragma unroll
        for (int d = 0; d < 64; ++d) ycat[t * 1024 + 512 + h * 64 + d] = f2bf(acc[d] * il);
    }
    static HD long count() { return (long)TL * 4; }
};
struct NkNACtx {
    const bf16* p; bf16* ycat;
    HD void operator()(long i) const {
        int h = (int)(i % 4); long tc = i / 4; int b = (int)(tc / LC); long t = TL + tc;
        const bf16* qp = p + t * DIN + O2 + h * 64;
        float q[64], acc[64];
#pragma unroll
        for (int d = 0; d < 64; ++d) { q[d] = bf2f(qp[d]); acc[d] = 0.f; }
        float m = -1e30f, l = 0.f;
        for (int j = 0; j < LC; ++j) {
            const bf16* kr = p + ((long)TL + (long)b * LC + j) * DIN + O2 + 256 + h * 64;
            attn_key(q, kr, kr + 256, 0.f, m, l, acc);
        }
        float il = 1.0f / l;
#pragma unroll
        for (int d = 0; d < 64; ++d) ycat[t * 1024 + 512 + h * 64 + d] = f2bf(acc[d] * il);
    }
    static HD long count() { return (long)TC * 4; }
};

HD float gdn_conv4(const bf16* p, long t, int tin, int L, int col, const float* cw) {
    float acc = 0.f;
    for (int i = 0; i < 4; ++i) { int o = i - 2; if (tin + o >= 0 && tin + o < L) acc += cw[i * 768 + col] * bf2f(p[(t + o) * DIN + O3 + col]); }
    return siluf(acc);
}
struct NkGdnPrep {
    const bf16* p; const float* cw; bf16* qkv;
    HD void operator()(long i) const {
        int e = (int)(i % 64); int wh = (int)((i / 64) % 12); long t = i / 768; int which = wh / 4;
        int L = t < TL ? S : LC; int tin = t < TL ? (int)(t % S) : (int)((t - TL) % LC);
        int col0 = wh * 64;
        float v = gdn_conv4(p, t, tin, L, col0 + e, cw);
        if (which < 2) {
            float ss = 0.f; for (int d = 0; d < 64; ++d) { float u = gdn_conv4(p, t, tin, L, col0 + d, cw); ss += u * u; }
            v *= 1.0f / sqrtf(ss + EPS); if (which == 0) v *= 0.125f;
        }
        qkv[t * 768 + col0 + e] = f2bf(v);
    }
    static HD long count() { return (long)T * 768; }
};
struct NkGdnGate {
    const bf16* p; const float* a_log; const float* dt_bias; float* gb;
    HD void operator()(long i) const {
        int dh = (int)(i % 8); long t = i / 8;
        float a = bf2f(p[t * DIN + O3 + 1024 + dh]), bb = bf2f(p[t * DIN + O3 + 1032 + dh]);
        float x = a + dt_bias[dh]; float sp = x > 20.f ? x : log1pf(expf(x));
        gb[t * 16 + dh] = -expf(a_log[dh]) * sp; gb[t * 16 + 8 + dh] = 1.0f / (1.0f + expf(-bb));
    }
    static HD long count() { return (long)T * 8; }
};
struct NkGdnRec {
    const bf16* qkv; const float* gb; bf16* o;
    HD void operator()(long i) const {
        int e = (int)(i % 64); int dir = (int)((i / 64) % 2); int h = (int)((i / 128) % 4); int b = (int)(i / 512);
        float Sc[64];
#pragma unroll
        for (int d = 0; d < 64; ++d) Sc[d] = 0.f;
        for (int step = 0; step < LC + S; ++step) {
            long t;
            if (step < LC) { int j = dir ? LC - 1 - step : step; t = (long)TL + (long)b * LC + j; }
            else { int s = step - LC; s = dir ? S - 1 - s : s; t = (long)b * S + s; }
            const bf16* qr = qkv + t * 768 + h * 64; const bf16* kr = qr + 256; float v = bf2f(qr[512 + e]);
            float a = expf(gb[t * 16 + dir * 4 + h]), beta = gb[t * 16 + 8 + dir * 4 + h];
            float kS = 0.f;
#pragma unroll
            for (int c = 0; c < 4; ++c) {
#pragma unroll
                for (int d = c * 16; d < c * 16 + 16; ++d) kS += bf2f(kr[d]) * Sc[d];
                asm volatile("" ::: "memory");
            }
            float w = beta * (v - a * kS); float oo = 0.f;
#pragma unroll
            for (int c = 0; c < 4; ++c) {
#pragma unroll
                for (int d = c * 16; d < c * 16 + 16; ++d) { Sc[d] = a * Sc[d] + bf2f(kr[d]) * w; oo += bf2f(qr[d]) * Sc[d]; }
                asm volatile("" ::: "memory");
            }
            o[((long)dir * T + t) * 256 + h * 64 + e] = f2bf(oo);
        }
    }
    static HD long count() { return (long)B * 4 * 2 * 64; }
};
struct NkGdnFin {
    const bf16* p; const bf16* o; const float* ng; bf16* ycat;
    HD void operator()(long i) const {
        int e = (int)(i % 64); int h = (int)((i / 64) % 4); long t = i / 256;
        const bf16* o0 = o + t * 256 + h * 64; const bf16* o1 = o + ((long)T + t) * 256 + h * 64;
        float ss = 0.f; for (int d = 0; d < 64; ++d) { float u = bf2f(o0[d]) + bf2f(o1[d]); ss += u * u; }
        float v = (bf2f(o0[e]) + bf2f(o1[e])) * (1.0f / sqrtf(ss * (1.0f / 64.0f) + EPS)) * ng[e];
        float gt = bf2f(p[t * DIN + O3 + 768 + h * 64 + e]);
        ycat[t * 1024 + 768 + h * 64 + e] = f2bf(v * siluf(gt));
    }
    static HD long count() { return (long)T * 256; }
};

struct NkOutProj {
    const bf16* ycat; const float* w; const float* mod; float* xr; long ntok;
    HD void operator()(long i) const {
        long t = i / D; int n = (int)(i % D); int r = t < TL ? (int)(t / S) : 8;
        const bf16* yr = ycat + t * 1024; float acc = 0.f;
        for (int k = 0; k < 1024; ++k) acc += bf2f(yr[k]) * w[(long)k * D + n];
        xr[i] += mod[(long)r * 6144 + 2 * D + n] * acc;
    }
};

struct NkRouter {
    const bf16* h; const float* wr; float* scores;
    HD void operator()(long i) const {
        int e = (int)(i % 32); long t = i / 32; float acc = 0.f;
        for (int k = 0; k < D; ++k) acc += bf2f(h[t * D + k]) * wr[k * 32 + e];
        scores[i] = 1.0f / (1.0f + expf(-acc));
    }
};
struct NkTopK {
    const float* scores; const float* ebias; int* topi; float* topw;
    HD void operator()(long t) const {
        int sel[4]; float ss[4]; float sum = 0.f;
#pragma unroll
        for (int k = 0; k < 4; ++k) {
            int best = -1; float bv = -1e30f;
            for (int e = 0; e < 32; ++e) {
                bool used = false;
#pragma unroll
                for (int q = 0; q < 4; ++q) if (q < k && sel[q] == e) used = true;
                float v = scores[t * 32 + e] + ebias[e];
                if (!used && v > bv) { bv = v; best = e; }
            }
            sel[k] = best; ss[k] = scores[t * 32 + best]; sum += ss[k];
        }
#pragma unroll
        for (int k = 0; k < 4; ++k) { topi[t * 4 + k] = sel[k]; topw[t * 4 + k] = ss[k] / sum * ROUTED_SCALE; }
    }
};
struct NkMoeHid {
    const bf16* h; const int* topi; const float* wg; const float* wu; const float* sg; const float* su; bf16* hid;
    HD void operator()(long i) const {
        int j = (int)(i % 256); int slot = (int)((i / 256) % 5); long t = i / 1280;
        const float* g; const float* u;
        if (slot < 4) { int e = topi[t * 4 + slot]; g = wg + (long)e * D * 256; u = wu + (long)e * D * 256; } else { g = sg; u = su; }
        float ag = 0.f, au = 0.f;
        for (int k = 0; k < D; ++k) { float x = bf2f(h[t * D + k]); ag += x * g[(long)k * 256 + j]; au += x * u[(long)k * 256 + j]; }
        hid[i] = f2bf(siluf(ag) * au);
    }
};
struct NkMoeOut {
    const bf16* hid; const int* topi; const float* topw; const float* wd; const float* sd; const float* mod; float* xr;
    HD void operator()(long i) const {
        long t = i / D; int n = (int)(i % D); int r = t < TL ? (int)(t / S) : 8;
        float f = 0.f;
        for (int slot = 0; slot < 5; ++slot) {
            const float* w; float wt;
            if (slot < 4) { w = wd + (long)topi[t * 4 + slot] * 256 * D; wt = topw[t * 4 + slot]; } else { w = sd; wt = 1.0f; }
            float acc = 0.f;
            for (int j = 0; j < 256; ++j) acc += bf2f(hid[(t * 5 + slot) * 256 + j]) * w[(long)j * D + n];
            f += wt * acc;
        }
        xr[i] += mod[(long)r * 6144 + 5 * D + n] * f;
    }
};
struct NkFinal {
    const float* xr; const float* rstd; const float* g; float* out;
    HD void operator()(long i) const { long t = i / D; int k = (int)(i % D); out[i] = xr[i] * rstd[t] * g[k]; }
    static HD long count() { return (long)TL * D; }
};

struct NkCvtT {
    const float* src; bf16* dst; int K, N, Npad;
    HD void operator()(long i) const {
        int n = (int)(i % Npad); int k0 = (int)(i / Npad) * 8;
        bf16 v[8];
#pragma unroll
        for (int j = 0; j < 8; ++j) v[j] = n < N ? f2bf(src[(long)(k0 + j) * N + n]) : (bf16)0;
        bf16* d = dst + (long)n * K + k0;
#pragma unroll
        for (int j = 0; j < 8; ++j) d[j] = v[j];
    }
    HD long count() const { return (long)Npad * (K / 8); }
};
struct NkRopeTab {
    float* rope;
    HD void operator()(long i) const {
        int j = (int)(i % 16); int pos = (int)(i / 16);
        float ang = (float)pos * powf(ROPE_BASE, -(float)j / 16.0f);
        rope[i * 2] = cosf(ang); rope[i * 2 + 1] = sinf(ang);
    }
    static HD long count() { return 64 * 16; }
};

struct NkCvtUp {
    const float* wg; const float* wu; const float* sg; const float* su; bf16* dst;
    HD void operator()(long i) const {
        int j = (int)(i % 256); int k0 = (int)((i / 256) % 128) * 8; int which = (int)((i / (256 * 128)) % 2); int e = (int)(i / (256 * 128 * 2));
        const float* src = e < 32 ? (which ? wu : wg) + (long)e * D * 256 : (which ? su : sg);
        int np = (j >> 6) * 128 + ((j >> 5) & 1) * 64 + which * 32 + (j & 31);
        bf16* d = dst + ((long)e * 512 + np) * 1024 + k0;
#pragma unroll
        for (int q = 0; q < 8; ++q) d[q] = f2bf(src[(long)(k0 + q) * 256 + j]);
    }
    static HD long count() { return 33L * 2 * 128 * 256; }
};
struct NkCvtDown {
    const float* wd; const float* sd; bf16* dst;
    HD void operator()(long i) const {
        int n = (int)(i % 1024); int j0 = (int)((i / 1024) % 32) * 8; int e = (int)(i / (1024 * 32));
        const float* src = e < 32 ? wd + (long)e * 256 * D : sd;
        bf16* d = dst + ((long)e * 1024 + n) * 256 + j0;
#pragma unroll
        for (int q = 0; q < 8; ++q) d[q] = f2bf(src[(long)(j0 + q) * D + n]);
    }
    static HD long count() { return 33L * 32 * 1024; }
};
struct NkZeroI { int* p; HD void operator()(long i) const { p[i] = 0; } };
struct WS {
    float* mod; float* rstd; float* xr; bf16* h; bf16* p; bf16* ycat; float* hyf1; float* hyf2; float* filt; bf16* uv;
    bf16* qkv; float* gb; bf16* o; float* scores; int* topi; float* topw; bf16* hid;
    bf16* winT; bf16* woutT; bf16* wrT; float* rope; unsigned* bar; int* cnt; int* list;
    bf16* moeUpT; bf16* hid2; bf16* moeDownT;
    bf16* qk; bf16* uw; float* gc; bf16* x0T; bf16* uvT; int* qctr; bf16* x0Tc; bf16* uvTc; bf16* w3T; bf16* f2b;
};
static inline WS make_ws(void* d_ws) {
    char* base = (char*)d_ws; size_t off = 0;
    auto take = [&](size_t bytes) { char* r = base + off; off += (bytes + 255) & ~(size_t)255; return r; };
    WS w;
    w.mod = (float*)take(2ul * 9 * 6144 * 4);
    w.rstd = (float*)take((size_t)T * 4);
    w.hyf1 = (float*)take(2 * (size_t)(S + LC) * 64 * 4);
    w.hyf2 = (float*)take(2 * (size_t)(S + LC) * 64 * 4);
    w.filt = (float*)take(2 * (size_t)(S + LC) * 512 * 4);
    w.gb = (float*)take((size_t)T * 16 * 4);
#ifdef HOST_SIM
    w.scores = (float*)take((size_t)T * 32 * 4); w.topi = (int*)take((size_t)T * 4 * 4);
#else
    w.scores = nullptr; w.topi = nullptr;
#endif
    w.topw = (float*)take((size_t)T * 4 * 4);
    w.winT = (bf16*)take(2ul * 3328 * 1024 * 2);
    w.woutT = (bf16*)take(2ul * 1024 * 1024 * 2);
    w.wrT = (bf16*)take(2ul * 32 * 1024 * 2);
    w.rope = (float*)take(64 * 16 * 2 * 4);
    w.bar = (unsigned*)take(4096 * 4);
    w.cnt = (int*)take(4 * 32 * 32 * 4);
    w.list = (int*)take((size_t)32 * T * 4);
    w.qctr = (int*)take(64 * 64 * 4);
    w.w3T = (bf16*)take(2ul * 512 * 64 * 2);
    w.f2b = (bf16*)take(2ul * (S + LC) * 64 * 2);
    w.xr = (float*)take((size_t)T * D * 4);
    w.h = (bf16*)take((size_t)T * D * 2);
    w.p = (bf16*)take((size_t)T * DIN * 2);
    w.hid = (bf16*)w.p;
    char* R = take(0);
    const size_t szUp = 33ul * 512 * 1024 * 2, szHid = ((size_t)5 * T + 256) * 256 * 2, szDown = 33ul * 1024 * 256 * 2;
    w.moeUpT = (bf16*)R; w.hid2 = (bf16*)(R + szUp); w.moeDownT = (bf16*)(R + szUp + szHid);
    w.qkv = (bf16*)R;
    w.qk = (bf16*)R;
    w.ycat = w.hid2;
    w.o = (bf16*)((char*)w.ycat + (size_t)T * 1024 * 2);
    w.x0T = (bf16*)((char*)w.ycat + (size_t)T * 1024 * 2);
    w.uvT = w.x0T + (size_t)256 * B * S;
    w.uv = w.uvT + (size_t)256 * B * S;
    w.uw = w.h; w.gc = w.gb;
    w.x0Tc = w.uv; w.uvTc = w.uv + (size_t)256 * B * LC;
    size_t rsz = szUp + szHid + szDown; const size_t rsz2 = szUp + (size_t)T * 1024 * 2 + (size_t)2 * 256 * B * S * 2 + (size_t)T * 256 * 2;
    if (rsz2 > rsz) rsz = rsz2;
    (void)take(rsz);
    return w;
}
#ifdef HOST_SIM
template <class F> static inline void run(F f, long n, hipStream_t) {
#pragma omp parallel for schedule(dynamic, 256)
    for (long i = 0; i < n; ++i) f(i);
}
#endif

struct Inputs {
    const float *x, *c, *ctx, *c_ctx, *w_ada, *b_ada, *norm1, *norm2, *norm_f, *w_in, *w_out, *hy_conv, *hy_w1, *hy_b1, *hy_w2, *hy_b2, *hy_w3, *hy_freq, *hy_bias,
        *wa_sink, *na_rpb, *gdn_conv, *gdn_a_log, *gdn_dt_bias, *gdn_norm, *moe_router, *moe_bias, *moe_gate, *moe_up, *moe_down, *sh_gate, *sh_up, *sh_down;
};

#ifdef HOST_SIM
static void forward_naive(const Inputs& in, float* out, const WS& w, hipStream_t st) {
    run(NkCopyX{in.x, in.ctx, w.xr}, NkCopyX::count(), st);
    run(NkAda{in.c, in.c_ctx, in.w_ada, in.b_ada, w.mod}, NkAda::count(), st);
    for (int l = 0; l < 2; ++l) {
        const bool need_ctx = l == 0;
        const float* mod = w.mod + (size_t)l * 9 * 6144;
        run(NkRstd{w.xr, w.rstd, T}, T, st);
        run(NkModNorm{w.xr, w.rstd, in.norm1 + l * D, mod, 0, 1, w.h}, (long)T * D, st);
        run(NkInProj{w.h, in.w_in + (size_t)l * D * DIN, w.p}, NkInProj::count(), st);
        run(NkRope{w.p}, NkRope::count(), st);
        run(NkHyF1{in.hy_w1 + l * 33 * 64, in.hy_b1 + l * 64, in.hy_freq + l * 64, w.hyf1}, NkHyF1::count(), st);
        run(NkHyF2{in.hy_w2 + l * 64 * 64, in.hy_b2 + l * 64, in.hy_freq + l * 64, w.hyf1, w.hyf2, nullptr}, NkHyF2::count(), st);
        run(NkHyF3{in.hy_w3 + l * 64 * 512, w.hyf2, w.filt}, NkHyF3::count(), st);
        const float* hcw = in.hy_conv + l * 3 * 768;
        run(NkHyUV{w.p, hcw, w.uv, 0, TL, S}, (long)TL * 256, st);
        run(NkHyConv{w.p, hcw, w.uv, w.filt, in.hy_bias + l * 256, w.ycat, 0, S, 0}, (long)TL * 256, st);
        if (need_ctx) {
            run(NkHyUV{w.p, hcw, w.uv, TL, TC, LC}, (long)TC * 256, st);
            run(NkHyConv{w.p, hcw, w.uv, w.filt, in.hy_bias + l * 256, w.ycat, TL, LC, S}, (long)TC * 256, st);
        }
        run(NkWA{w.p, in.wa_sink + l * 4, w.ycat}, NkWA::count(), st);
        if (need_ctx) run(NkWACtx{w.p, in.wa_sink + l * 4, w.ycat}, NkWACtx::count(), st);
        run(NkNA{w.p, in.na_rpb + l * 4 * 15 * 31, w.ycat}, NkNA::count(), st);
        if (need_ctx) run(NkNACtx{w.p, w.ycat}, NkNACtx::count(), st);
        run(NkGdnPrep{w.p, in.gdn_conv + l * 4 * 768, w.qkv}, NkGdnPrep::count(), st);
        run(NkGdnGate{w.p, in.gdn_a_log + l * 8, in.gdn_dt_bias + l * 8, w.gb}, NkGdnGate::count(), st);
        run(NkGdnRec{w.qkv, w.gb, w.o}, NkGdnRec::count(), st);
        run(NkGdnFin{w.p, w.o, in.gdn_norm + l * 64, w.ycat}, need_ctx ? (long)T * 256 : (long)TL * 256, st);
        const long ntok = need_ctx ? T : TL;
        run(NkOutProj{w.ycat, in.w_out + (size_t)l * 1024 * D, mod, w.xr, ntok}, ntok * D, st);
        run(NkRstd{w.xr, w.rstd, (int)ntok}, ntok, st);
        run(NkModNorm{w.xr, w.rstd, in.norm2 + l * D, mod, 3, 4, w.h}, ntok * D, st);
        run(NkRouter{w.h, in.moe_router + l * D * 32, w.scores}, ntok * 32, st);
        run(NkTopK{w.scores, in.moe_bias + l * 32, w.topi, w.topw}, ntok, st);
        run(NkMoeHid{w.h, w.topi, in.moe_gate + (size_t)l * 32 * D * 256, in.moe_up + (size_t)l * 32 * D * 256, in.sh_gate + (size_t)l * D * 256, in.sh_up + (size_t)l * D * 256, w.hid}, ntok * 1280, st);
        run(NkMoeOut{w.hid, w.topi, w.topw, in.moe_down + (size_t)l * 32 * 256 * D, in.sh_down + (size_t)l * 256 * D, mod, w.xr}, ntok * D, st);
    }
    run(NkRstd{w.xr, w.rstd, TL}, TL, st);
    run(NkFinal{w.xr, w.rstd, in.norm_f, out}, NkFinal::count(), st);
}


#endif
#ifdef HOST_SIM
extern "C" void kernel_launch(void* const* d_in, const int* in_sizes, int n_in, void* d_out, int out_size, void* d_ws, size_t ws_size, hipStream_t stream) {
    Inputs in;
    const float** ip = (const float**)&in;
    for (int i = 0; i < 33; ++i) ip[i] = (const float*)d_in[i];
    WS w = make_ws(d_ws);
    forward_naive(in, (float*)d_out, w, stream);
}

#endif
#ifndef HOST_SIM
#define XB_TMO      128
#define XB_XCNT(j)  (256  + 64 * (j))
#define XB_XSUB(j)  (1280 + 64 * (j))
#define XB_XGEN(j)  (2304 + 64 * (j))
#define XB_TOP      3328
#define XB_TOPGEN   3392
#define XCD_BAR_WORDS 3456
#define XB_SPIN_CAP (1u << 26)
#define LAS __attribute__((address_space(3)))
__device__ __forceinline__ unsigned xb_ld(unsigned* p)              { return __hip_atomic_load(p, __ATOMIC_RELAXED, __HIP_MEMORY_SCOPE_AGENT); }
__device__ __forceinline__ unsigned xb_add(unsigned* p, unsigned v) { return __hip_atomic_fetch_add(p, v, __ATOMIC_RELAXED, __HIP_MEMORY_SCOPE_AGENT); }
__device__ __forceinline__ unsigned xb_xcc_id() { return (unsigned)__builtin_amdgcn_s_getreg((3 << 11) | 20) & 0xFu; }
#define XB_SPIN(cond, bar) do { unsigned _sp = 0; while (cond) { __builtin_amdgcn_s_sleep(1); \
    if ((++_sp & 255u) == 0u) { if (xb_ld(&(bar)[XB_TMO])) break; if (_sp > XB_SPIN_CAP) { atomicAdd(&(bar)[XB_TMO], 1u); break; } } } } while (0)
struct XcdBarrier { unsigned* bar; unsigned x; volatile LAS unsigned* st; };
__device__ __forceinline__ XcdBarrier xcd_barrier_post(unsigned* bar, volatile LAS unsigned* st) {
    XcdBarrier b; b.bar = bar; b.x = xb_xcc_id(); b.st = st;
    if (threadIdx.x == 0) (void)xb_add(&bar[XB_XCNT(b.x)], 1u);
    return b;
}
__device__ __forceinline__ void xcd_barrier_complete(unsigned* bar, unsigned x, unsigned& nloc, unsigned& nx) {
    const unsigned G = gridDim.x * gridDim.y * gridDim.z;
    unsigned sum, cnt, mine, sp = 0u;
    for (;;) {
        sum = 0u; cnt = 0u; mine = 0u;
#pragma unroll
        for (unsigned j = 0; j < 16; ++j) { const unsigned c = xb_ld(&bar[XB_XCNT(j)]); sum += c; cnt += (c > 0u) ? 1u : 0u; mine = (j == x) ? c : mine; }
        if (sum == G) break;
        __builtin_amdgcn_s_sleep(1);
        if ((++sp & 255u) == 0u) { if (xb_ld(&bar[XB_TMO])) break; if (sp > XB_SPIN_CAP) { atomicAdd(&bar[XB_TMO], 1u); break; } }
    }
    nloc = mine > 0u ? mine : 1u; nx = cnt > 0u ? cnt : 1u;
}
__device__ __forceinline__ void xcd_barrier(const XcdBarrier& b) {
    asm volatile("s_waitcnt vmcnt(0)" ::: "memory");
    __syncthreads();
    if (threadIdx.x == 0) {
        unsigned* bar = b.bar;
        __builtin_amdgcn_s_waitcnt(0);
        unsigned nloc = b.st[0], nx = b.st[1];
        if (nloc == 0u) { xcd_barrier_complete(bar, b.x, nloc, nx); b.st[0] = nloc; b.st[1] = nx; }
        const unsigned old = xb_add(&bar[XB_XSUB(b.x)], 1u);
        const unsigned gen = old / nloc;
        if (old + 1u == (gen + 1u) * nloc) {
            __builtin_amdgcn_fence(__ATOMIC_RELEASE, "agent");
            asm volatile("s_waitcnt vmcnt(0)" ::: "memory");
            const unsigned og = xb_add(&bar[XB_TOP], 1u);
            const unsigned tg = og / nx;
            if (og + 1u == (tg + 1u) * nx) xb_add(&bar[XB_TOPGEN], 1u);
            else XB_SPIN(xb_ld(&bar[XB_TOPGEN]) == tg, bar);
            __builtin_amdgcn_fence(__ATOMIC_ACQUIRE, "agent");
            xb_add(&bar[XB_XGEN(b.x)], 1u);
            asm volatile("s_waitcnt vmcnt(0)" ::: "memory");
        } else {
            XB_SPIN(xb_ld(&bar[XB_XGEN(b.x)]) == gen, bar);
            __builtin_amdgcn_fence(__ATOMIC_ACQUIRE, "agent");
            asm volatile("s_waitcnt vmcnt(0)" ::: "memory");
        }
    }
    __syncthreads();
}
#endif
#ifndef HOST_SIM
typedef short bf16x8 __attribute__((ext_vector_type(8)));
typedef float f32x16 __attribute__((ext_vector_type(16)));
typedef float f32x4 __attribute__((ext_vector_type(4)));
typedef unsigned u32x4 __attribute__((ext_vector_type(4)));
typedef unsigned u32x2 __attribute__((ext_vector_type(2)));
#define NTHREADS 512

__device__ __forceinline__ void st_wt8(void* p, u32x2 v) { __hip_atomic_store((unsigned long long*)p, ((unsigned long long)v.y << 32) | v.x, __ATOMIC_RELAXED, __HIP_MEMORY_SCOPE_AGENT); }
__device__ __forceinline__ void st_wt16(void* p, f32x4 v) { asm volatile("global_store_dwordx4 %0, %1, off sc1\n\ts_nop 1" :: "v"(p), "v"(v) : "memory"); }
typedef __bf16 bf16x2n __attribute__((ext_vector_type(2)));
typedef float f32x2n __attribute__((ext_vector_type(2)));
__device__ __forceinline__ unsigned pack_bf16(float lo, float hi) { f32x2n f = {lo, hi}; bf16x2n r = __builtin_convertvector(f, bf16x2n); return __builtin_bit_cast(unsigned, r); }

constexpr int GBM = 256, GBN = 128, GBK = 64;
constexpr int G_ASTAGE = GBM * GBK * 2, G_BSTAGE = GBN * GBK * 2, G_STAGE = G_ASTAGE + G_BSTAGE;
constexpr int G_LDS = 2 * G_STAGE;
__device__ __forceinline__ int g_lds_off(int r, int c) { return r * 128 + ((c ^ ((r >> 1) & 7)) << 4); }

template <class ARow, class Epi>
__device__ __forceinline__ void gemm_tile(char* lds, const ARow& arow, const bf16* __restrict__ Bt, int ldb, int K, int m0, int n0, const Epi& epi) {
    int tid = threadIdx.x; asm volatile("" : "+v"(tid));
    const int lane = tid & 63, wid = __builtin_amdgcn_readfirstlane(tid >> 6), wm = wid >> 1, wn = wid & 1;
    const bf16* ap[4]; const bf16* bp[2];
#pragma unroll
    for (int j = 0; j < 4; ++j) { const int r = 8 * (wid * 4 + j) + (lane >> 3); ap[j] = arow(r) + 8 * ((lane & 7) ^ ((r >> 1) & 7)); }
#pragma unroll
    for (int j = 0; j < 2; ++j) { const int r = 8 * (wid * 2 + j) + (lane >> 3); bp[j] = Bt + (size_t)(n0 + r) * ldb + 8 * ((lane & 7) ^ ((r >> 1) & 7)); }
    f32x16 acc[2][2];
#pragma unroll
    for (int a = 0; a < 2; ++a)
#pragma unroll
        for (int b = 0; b < 2; ++b)
#pragma unroll
            for (int r = 0; r < 16; ++r) acc[a][b][r] = 0.f;
    const int nk = K / GBK;
    __syncthreads();
#define G_DMA(kt_, stage_) do { \
        _Pragma("unroll") for (int j = 0; j < 4; ++j) __builtin_amdgcn_global_load_lds((const unsigned*)(ap[j] + (kt_) * GBK), (LAS unsigned*)((stage_) + (wid * 4 + j) * 1024), 16, 0, 0); \
        _Pragma("unroll") for (int j = 0; j < 2; ++j) __builtin_amdgcn_global_load_lds((const unsigned*)(bp[j] + (kt_) * GBK), (LAS unsigned*)((stage_) + G_ASTAGE + (wid * 2 + j) * 1024), 16, 0, 0); } while (0)
    G_DMA(0, lds);
    __syncthreads();
    const int fr = lane & 31, fh = lane >> 5;
    for (int kt = 0; kt < nk; ++kt) {
        char* cur = lds + (kt & 1) * G_STAGE;
        if (kt + 1 < nk) { char* nxt = lds + ((kt + 1) & 1) * G_STAGE; G_DMA(kt + 1, nxt); }
#pragma unroll
        for (int kk = 0; kk < 4; ++kk) {
            bf16x8 fa[2], fb[2];
#pragma unroll
            for (int mi = 0; mi < 2; ++mi) fa[mi] = *(const bf16x8*)(cur + g_lds_off(wm * 64 + mi * 32 + fr, kk * 2 + fh));
#pragma unroll
            for (int ni = 0; ni < 2; ++ni) fb[ni] = *(const bf16x8*)(cur + G_ASTAGE + g_lds_off(wn * 64 + ni * 32 + fr, kk * 2 + fh));
#pragma unroll
            for (int mi = 0; mi < 2; ++mi)
#pragma unroll
                for (int ni = 0; ni < 2; ++ni) acc[mi][ni] = __builtin_amdgcn_mfma_f32_32x32x16_bf16(fb[ni], fa[mi], acc[mi][ni], 0, 0, 0);
        }
        __syncthreads();
    }
#undef G_DMA
    epi(acc, m0 + wm * 64 + fr, n0 + wn * 64 + 4 * fh);
}


constexpr int G_LDS3 = 3 * G_STAGE;
struct GPtrs { const bf16* a[4]; const bf16* b[2]; };
template <class TL> __device__ __forceinline__ void g_ptrs(const TL& tl, const typename TL::Tile& t, int wid, int lane, GPtrs& P) {
#pragma unroll
    for (int j = 0; j < 4; ++j) { const int r = 8 * (wid * 4 + j) + (lane >> 3); P.a[j] = tl.arow(t, r) + 8 * ((lane & 7) ^ ((r >> 1) & 7)); }
#pragma unroll
    for (int j = 0; j < 2; ++j) { const int r = 8 * (wid * 2 + j) + (lane >> 3); P.b[j] = tl.brow(t, r) + 8 * ((lane & 7) ^ ((r >> 1) & 7)); }
}
__device__ __forceinline__ void g_dma(char* lds, const GPtrs& P, int kt, int stage, int wid) {
    char* st = lds + stage * G_STAGE;
#pragma unroll
    for (int j = 0; j < 4; ++j) __builtin_amdgcn_global_load_lds((const unsigned*)(P.a[j] + kt * GBK), (LAS unsigned*)(st + (wid * 4 + j) * 1024), 16, 0, 0);
#pragma unroll
    for (int j = 0; j < 2; ++j) __builtin_amdgcn_global_load_lds((const unsigned*)(P.b[j] + kt * GBK), (LAS unsigned*)(st + G_ASTAGE + (wid * 2 + j) * 1024), 16, 0, 0);
}
template <class TL, int XF = 0>
__device__ __forceinline__ void gemm_stream(char* lds, const TL& tl) {
    int tid = threadIdx.x; asm volatile("" : "+v"(tid));
    const int lane = tid & 63, wid = __builtin_amdgcn_readfirstlane(tid >> 6), wm = wid >> 1, wn = wid & 1, fr = lane & 31, fh = lane >> 5;
    constexpr int nk = TL::K / GBK;
    static_assert(nk >= 2, "K too small");
    int idx = blockIdx.x;
    typename TL::Tile cur, nxt;
    if (!tl.tile(idx, cur)) return;
    GPtrs P, Pn;
    g_ptrs(tl, cur, wid, lane, P);
    bool has_next = tl.tile(idx + (int)gridDim.x, nxt);
    if (has_next) g_ptrs(tl, nxt, wid, lane, Pn);
    __syncthreads();
    if (!(XF & 1)) { g_dma(lds, P, 0, 0, wid); g_dma(lds, P, 1, 1, wid); }
    int sg = 0;
    for (;;) {
        f32x16 acc[2][2];
#pragma unroll
        for (int a = 0; a < 2; ++a)
#pragma unroll
            for (int b = 0; b < 2; ++b)
#pragma unroll
                for (int r = 0; r < 16; ++r) acc[a][b][r] = 0.f;
        for (int kt = 0; kt < nk; ++kt) {
            if (!(XF & 2)) { if (kt + 1 < nk || has_next) asm volatile("s_waitcnt vmcnt(6)" ::: "memory"); else asm volatile("s_waitcnt vmcnt(0)" ::: "memory");
            __builtin_amdgcn_s_barrier(); }
            asm volatile("" ::: "memory");
            const int s2 = sg >= 1 ? sg - 1 : 2;
            if (!(XF & 1)) { if (kt + 2 < nk) g_dma(lds, P, kt + 2, s2, wid);
            else if (has_next) g_dma(lds, Pn, kt + 2 - nk, s2, wid); }
            const char* cs = lds + sg * G_STAGE;
#pragma unroll
            for (int kk = 0; kk < 4; ++kk) {
                bf16x8 fa[2], fb[2];
#pragma unroll
                for (int mi = 0; mi < 2; ++mi) fa[mi] = *(const bf16x8*)(cs + g_lds_off(wm * 64 + mi * 32 + fr, kk * 2 + fh));
#pragma unroll
                for (int ni = 0; ni < 2; ++ni) fb[ni] = *(const bf16x8*)(cs + G_ASTAGE + g_lds_off(wn * 64 + ni * 32 + fr, kk * 2 + fh));
#pragma unroll
                for (int mi = 0; mi < 2; ++mi)
#pragma unroll
                    for (int ni = 0; ni < 2; ++ni) acc[mi][ni] = __builtin_amdgcn_mfma_f32_32x32x16_bf16(fb[ni], fa[mi], acc[mi][ni], 0, 0, 0);
            }
            sg = sg == 2 ? 0 : sg + 1;
        }
        tl.epi(cur, acc, wm * 64 + fr, wn * 64 + 4 * fh);
        if (!has_next) break;
        asm volatile("s_waitcnt vmcnt(0)" ::: "memory");
        cur = nxt; P = Pn; idx += (int)gridDim.x;
        has_next = tl.tile(idx + (int)gridDim.x, nxt);
        if (has_next) g_ptrs(tl, nxt, wid, lane, Pn);
    }
    asm volatile("s_waitcnt vmcnt(0)" ::: "memory");
}

constexpr int HBK = 32, H_ASTG = 256 * HBK * 2, H_STG = 2 * H_ASTG, H_RING = 4, H_LDS = H_RING * H_STG;
__device__ __forceinline__ int h_lds_off(int r, int c) { return r * 64 + ((c ^ ((r >> 2) & 3)) << 4); }
struct HPtrs { const bf16* a[2]; const bf16* b[2]; };
template <class TL> __device__ __forceinline__ void h_ptrs(const TL& tl, const typename TL::Tile& t, int wid, int lane, HPtrs& P) {
#pragma unroll
    for (int j = 0; j < 2; ++j) { const int r = 16 * (wid * 2 + j) + (lane >> 2); const int c = (lane & 3) ^ ((r >> 2) & 3); P.a[j] = tl.arow(t, r) + 8 * c; P.b[j] = tl.brow(t, r) + 8 * c; }
}
__device__ __forceinline__ void h_dma(char* lds, const HPtrs& P, int kt, int stage, int wid) {
    char* st = lds + stage * H_STG;
#pragma unroll
    for (int j = 0; j < 2; ++j) __builtin_amdgcn_global_load_lds((const unsigned*)(P.a[j] + kt * HBK), (LAS unsigned*)(st + (wid * 2 + j) * 1024), 16, 0, 0);
#pragma unroll
    for (int j = 0; j < 2; ++j) __builtin_amdgcn_global_load_lds((const unsigned*)(P.b[j] + kt * HBK), (LAS unsigned*)(st + H_ASTG + (wid * 2 + j) * 1024), 16, 0, 0);
}
template <class TL>
__device__ __forceinline__ void gemm_stream256(char* lds, const TL& tl) {
    int tid = threadIdx.x; asm volatile("" : "+v"(tid));
    const int lane = tid & 63, wid = __builtin_amdgcn_readfirstlane(tid >> 6), wm = wid >> 1, wn = wid & 1, fr = lane & 31, fh = lane >> 5;
    constexpr int nk = TL::K / HBK;
    static_assert(nk >= 4, "K too small");
    int idx = blockIdx.x;
    typename TL::Tile cur, nxt;
    if (!tl.tile(idx, cur)) return;
    HPtrs P, Pn;
    h_ptrs(tl, cur, wid, lane, P);
    bool has_next = tl.tile(idx + (int)gridDim.x, nxt);
    if (has_next) h_ptrs(tl, nxt, wid, lane, Pn);
    asm volatile("s_waitcnt vmcnt(0)" ::: "memory");
    __syncthreads();
    h_dma(lds, P, 0, 0, wid); h_dma(lds, P, 1, 1, wid); h_dma(lds, P, 2, 2, wid);
    int sg = 0;
    for (;;) {
        f32x16 acc[2][4];
#pragma unroll
        for (int a = 0; a < 2; ++a)
#pragma unroll
            for (int b = 0; b < 4; ++b)
#pragma unroll
                for (int r = 0; r < 16; ++r) acc[a][b][r] = 0.f;
        const unsigned act = tl.active(cur, wn);
        for (int kt = 0; kt < nk; ++kt) {
            const int ahead = (nk - 1 - kt) + (has_next ? 3 : 0);
            if (ahead >= 2) asm volatile("s_waitcnt vmcnt(8)" ::: "memory"); else if (ahead == 1) asm volatile("s_waitcnt vmcnt(4)" ::: "memory"); else asm volatile("s_waitcnt vmcnt(0)" ::: "memory");
            __builtin_amdgcn_s_barrier();
            asm volatile("" ::: "memory");
            const int s3 = (sg + 3) & 3;
            if (kt + 3 < nk) h_dma(lds, P, kt + 3, s3, wid);
            else if (has_next) h_dma(lds, Pn, kt + 3 - nk, s3, wid);
            const char* cs = lds + sg * H_STG;
#pragma unroll
            for (int kk = 0; kk < 2; ++kk) {
                bf16x8 fa[2], fb[4];
#pragma unroll
                for (int mi = 0; mi < 2; ++mi) fa[mi] = *(const bf16x8*)(cs + h_lds_off(wm * 64 + mi * 32 + fr, kk * 2 + fh));
#pragma unroll
                for (int ni = 0; ni < 4; ++ni) fb[ni] = *(const bf16x8*)(cs + H_ASTG + h_lds_off(wn * 128 + ni * 32 + fr, kk * 2 + fh));
#pragma unroll
                for (int ni = 0; ni < 4; ++ni)
                    if (act & (1u << ni)) {
#pragma unroll
                        for (int mi = 0; mi < 2; ++mi) acc[mi][ni] = __builtin_amdgcn_mfma_f32_32x32x16_bf16(fb[ni], fa[mi], acc[mi][ni], 0, 0, 0);
                    }
            }
            sg = (sg + 1) & 3;
        }
        tl.epi(cur, acc, wm * 64 + fr, wn * 128 + 4 * fh);
        if (!has_next) break;
        asm volatile("s_waitcnt vmcnt(0)" ::: "memory");
        cur = nxt; P = Pn; idx += (int)gridDim.x;
        has_next = tl.tile(idx + (int)gridDim.x, nxt);
        if (has_next) h_ptrs(tl, nxt, wid, lane, Pn);
    }
    asm volatile("s_waitcnt vmcnt(0)" ::: "memory");
}

struct ARowDense { const bf16* A; int lda; int m0; __device__ __forceinline__ const bf16* operator()(int i) const { return A + (size_t)(m0 + i) * lda; } };

__device__ __forceinline__ int perm64(int rho) { const int ni = rho >> 5, g = (rho >> 3) & 3, fh = (rho >> 2) & 1, q = rho & 3; return 16 * g + 8 * fh + 4 * ni + q; }
struct EpiInProj {
    bf16* p; const float* rope;
    __device__ __forceinline__ void operator()(f32x16 (&acc)[2][2], int mrow, int ncol  ) const {
        const int nb = ncol & ~63, fh = (ncol >> 2) & 1;
#pragma unroll
        for (int mi = 0; mi < 2; ++mi) {
            const int m = mrow + mi * 32;
            if (nb >= O1 && nb < O1 + 384 && m < TL) {
                const int s = m & (S - 1);
#pragma unroll
                for (int ax = 0; ax < 2; ++ax) {
                    const int pos = ax == 0 ? (s >> 6) : (s & 63);
#pragma unroll
                    for (int ni = 0; ni < 2; ++ni)
#pragma unroll
                        for (int q = 0; q < 4; ++q) {
                            const int j = 8 * fh + 4 * ni + q;
                            const float cs = rope[(pos * 16 + j) * 2], sn = rope[(pos * 16 + j) * 2 + 1];
                            const float x1 = acc[mi][ni][8 * ax + q], x2 = acc[mi][ni][8 * ax + 4 + q];
                            acc[mi][ni][8 * ax + q] = x1 * cs - x2 * sn; acc[mi][ni][8 * ax + 4 + q] = x1 * sn + x2 * cs;
                        }
                }
            }
#pragma unroll
            for (int g = 0; g < 4; ++g) {
                const int n = nb + 16 * g + 8 * fh;
                if (n < DIN) {
                    u32x4 v; v.x = pack_bf16(acc[mi][0][4 * g], acc[mi][0][4 * g + 1]); v.y = pack_bf16(acc[mi][0][4 * g + 2], acc[mi][0][4 * g + 3]);
                    v.z = pack_bf16(acc[mi][1][4 * g], acc[mi][1][4 * g + 1]); v.w = pack_bf16(acc[mi][1][4 * g + 2], acc[mi][1][4 * g + 3]);
                    *(u32x4*)(p + (size_t)m * DIN + n) = v;
                }
            }
        }
    }
};
struct EpiInProjH {
    bf16* p; const float* rope;
    __device__ __forceinline__ void operator()(f32x16 (&acc)[2][4], int mrow, int ncol) const {
#pragma unroll
        for (int mi = 0; mi < 2; ++mi) {
            const int m = mrow + mi * 32;
#pragma unroll
            for (int ni = 0; ni < 4; ++ni) {
                const int nb = ncol + ni * 32;
                if (nb >= DIN) continue;
                if (nb >= O1 && nb < O1 + 384 && m < TL) {
                    const int s = m & (S - 1); const int pos = (ni & 1) == 0 ? (s >> 6) : (s & 63);
                    const int jb = (nb & 31);
#pragma unroll
                    for (int r = 0; r < 8; ++r) {
                        const int j = jb + (r & 3) + 8 * (r >> 2);
                        const float cs = rope[(pos * 16 + j) * 2], sn = rope[(pos * 16 + j) * 2 + 1];
                        const float x1 = acc[mi][ni][r], x2 = acc[mi][ni][r + 8];
                        acc[mi][ni][r] = x1 * cs - x2 * sn; acc[mi][ni][r + 8] = x1 * sn + x2 * cs;
                    }
                }
#pragma unroll
                for (int g = 0; g < 4; ++g) {
                    const int n = nb + 8 * g;
                    if (n < DIN) { u32x2 v; v.x = pack_bf16(acc[mi][ni][4 * g], acc[mi][ni][4 * g + 1]); v.y = pack_bf16(acc[mi][ni][4 * g + 2], acc[mi][ni][4 * g + 3]); *(u32x2*)(p + (size_t)m * DIN + n) = v; }
                }
            }
        }
    }
};
struct EpiOutProjH {
    float* xr; const float* mod;
    __device__ __forceinline__ void operator()(f32x16 (&acc)[2][4], int mrow, int ncol) const {
#pragma unroll
        for (int mi = 0; mi < 2; ++mi) {
            const int m = mrow + mi * 32; const int rb = m < TL ? m / S : 8;
            const float* g1 = mod + (size_t)rb * 6144 + 2 * D;
#pragma unroll
            for (int ni = 0; ni < 4; ++ni)
#pragma unroll
                for (int g = 0; g < 4; ++g) {
                    const int n = ncol + ni * 32 + 8 * g;
                    f32x4 gv = *(const f32x4*)(g1 + n); float* xp = xr + (size_t)m * D + n; f32x4 xv = *(const f32x4*)xp;
                    xv[0] += gv[0] * acc[mi][ni][4 * g]; xv[1] += gv[1] * acc[mi][ni][4 * g + 1]; xv[2] += gv[2] * acc[mi][ni][4 * g + 2]; xv[3] += gv[3] * acc[mi][ni][4 * g + 3];
                    *(f32x4*)xp = xv;
                }
        }
    }
};
struct EpiOutProj {
    float* xr; const float* mod; const float* xin; const float* cin;
    __device__ __forceinline__ void operator()(f32x16 (&acc)[2][2], int mrow, int ncol) const {
#pragma unroll
        for (int mi = 0; mi < 2; ++mi) {
            const int m = mrow + mi * 32; const int rb = m < TL ? m / S : 8;
            const float* g1 = mod + (size_t)rb * 6144 + 2 * D;
            const float* src = xin ? (m < TL ? xin + (size_t)m * D : cin + (size_t)(m - TL) * D) : xr + (size_t)m * D;
#pragma unroll
            for (int ni = 0; ni < 2; ++ni)
#pragma unroll
                for (int g = 0; g < 4; ++g) {
                    const int n = ncol + ni * 32 + 8 * g;
                    f32x4 gv = *(const f32x4*)(g1 + n); f32x4 xv = *(const f32x4*)(src + n);
                    xv[0] += gv[0] * acc[mi][ni][4 * g]; xv[1] += gv[1] * acc[mi][ni][4 * g + 1]; xv[2] += gv[2] * acc[mi][ni][4 * g + 2]; xv[3] += gv[3] * acc[mi][ni][4 * g + 3];
                    *(f32x4*)(xr + (size_t)m * D + n) = xv;
                }
        }
    }
};
#endif
#ifndef HOST_SIM
template <class NMap>
__device__ __forceinline__ void cvt_tile(char* lds, const float* __restrict__ src, int srcN, bf16* __restrict__ dst, int dstK, int k0, int n0, int nvalid  , int nrows  , const NMap& nmap) {
    int tid = threadIdx.x; asm volatile("" : "+v"(tid));
    bf16* t = (bf16*)lds;
    __syncthreads();
#pragma unroll
    for (int i = 0; i < 2; ++i) {
        const int c = tid + i * NTHREADS, k = c >> 4, n4 = (c & 15) * 4;
        f32x4 v = {0.f, 0.f, 0.f, 0.f};
        if (n0 + n4 < nvalid) v = *(const f32x4*)(src + (size_t)(k0 + k) * srcN + n0 + n4);
#pragma unroll
        for (int q = 0; q < 4; ++q) t[(n4 + q) * 66 + k] = f2bf(v[q]);
    }
    __syncthreads();
    {
        const int n = tid >> 3, kc = tid & 7;
        if (n0 + n < nrows) {
            const unsigned* s = (const unsigned*)(t + n * 66 + kc * 8);
            u32x4 o; o.x = s[0]; o.y = s[1]; o.z = s[2]; o.w = s[3];
            *(u32x4*)(dst + (size_t)nmap(n0 + n) * dstK + k0 + kc * 8) = o;
        }
    }
}

template <class NMap>
__device__ __forceinline__ void cvt_strip(char* lds, const float* __restrict__ src, int srcN, bf16* __restrict__ dst, int dstK, int k0, int n0, int nvalid, int nrows, const NMap& nmap) {
    int tid = threadIdx.x; asm volatile("" : "+v"(tid));
    bf16* t = (bf16*)lds;
    __syncthreads();
    f32x4 v[8];
#pragma unroll
    for (int i = 0; i < 8; ++i) {
        const int c = tid + i * NTHREADS, k = c >> 6, n4 = (c & 63) * 4;
        v[i] = (f32x4){0.f, 0.f, 0.f, 0.f};
        if (n0 + n4 < nvalid) v[i] = *(const f32x4*)(src + (size_t)(k0 + k) * srcN + n0 + n4);
    }
#pragma unroll
    for (int i = 0; i < 8; ++i) {
        const int c = tid + i * NTHREADS, k = c >> 6, n4 = (c & 63) * 4;
#pragma unroll
        for (int q = 0; q < 4; ++q) t[(n4 + q) * 66 + k] = f2bf(v[i][q]);
    }
    __syncthreads();
#pragma unroll
    for (int i = 0; i < 4; ++i) {
        const int n = (tid >> 3) + i * 64, kc = tid & 7;
        if (n0 + n < nrows) {
            const unsigned* s = (const unsigned*)(t + n * 66 + kc * 8);
            u32x4 o; o.x = s[0]; o.y = s[1]; o.z = s[2]; o.w = s[3];
            *(u32x4*)(dst + (size_t)nmap(n0 + n) * dstK + k0 + kc * 8) = o;
        }
    }
}
struct NMapId { __device__ __forceinline__ int operator()(int n) const { return n; } };
struct NMapUp { int which; __device__ __forceinline__ int operator()(int j) const { return (j >> 7) * 256 + ((j >> 6) & 1) * 128 + which * 64 + (j & 63); } };
#endif
#ifndef HOST_SIM
__device__ __forceinline__ float wave_sum(float v) {
#pragma unroll
    for (int o = 32; o > 0; o >>= 1) v += __shfl_xor(v, o);
    return v;
}
template <int MODE, int NORM>
__device__ __forceinline__ void row_pass(const WS& w, const Inputs& in, int ntok, const float* mod_cur  , const float* mod_nrm  ,
                                         const float* gnorm, int shc, int scc, const bf16* y, const float* topw, float* out, bf16* hout, int t_first = -1, int t_end = 0, int t_step = 0) {
    int tid = threadIdx.x; asm volatile("" : "+v"(tid));
    const int lane = tid & 63, wv = tid >> 6;
    if (t_first < 0) { t_first = blockIdx.x * 8 + wv; t_end = ntok; t_step = gridDim.x * 8; }
    for (int t = t_first; t < t_end; t += t_step) {
        const int rb = t < TL ? t / S : 8;
        f32x4 v[4];
        float* xrow = w.xr + (size_t)t * D;
        if (MODE == 0 || MODE == 3) {
            const float* src = t < TL ? in.x + (size_t)t * D : in.ctx + (size_t)(t - TL) * D;
#pragma unroll
            for (int j = 0; j < 4; ++j) { v[j] = *(const f32x4*)(src + j * 256 + lane * 4); if (MODE == 0) st_wt16(xrow + j * 256 + lane * 4, v[j]); }
        } else {
#pragma unroll
            for (int j = 0; j < 4; ++j) v[j] = *(const f32x4*)(xrow + j * 256 + lane * 4);
        }
        if (MODE == 2) {
            const float* g2 = mod_cur + (size_t)rb * 6144 + 5 * D;
            f32x4 f[4];
#pragma unroll
            for (int j = 0; j < 4; ++j) f[j] = (f32x4){0.f, 0.f, 0.f, 0.f};
#pragma unroll
            for (int k = 0; k < 4; ++k) {
                const float wk = topw[(size_t)t * 4 + k]; const bf16* yr = y + ((size_t)t * 4 + k) * D;
#pragma unroll
                for (int j = 0; j < 4; ++j) { u32x2 u = *(const u32x2*)(yr + j * 256 + lane * 4);
                    f[j][0] += wk * __uint_as_float(u.x << 16); f[j][1] += wk * __uint_as_float(u.x & 0xffff0000u); f[j][2] += wk * __uint_as_float(u.y << 16); f[j][3] += wk * __uint_as_float(u.y & 0xffff0000u); }
            }
#pragma unroll
            for (int j = 0; j < 4; ++j) { f32x4 g = *(const f32x4*)(g2 + j * 256 + lane * 4); v[j] += g * f[j]; st_wt16(xrow + j * 256 + lane * 4, v[j]); }
        }
        if (NORM == 0) continue;
        if (NORM == 2 && t >= TL) continue;
        float ss = 0.f;
#pragma unroll
        for (int j = 0; j < 4; ++j) ss += v[j][0] * v[j][0] + v[j][1] * v[j][1] + v[j][2] * v[j][2] + v[j][3] * v[j][3];
        ss = wave_sum(ss);
        const float rstd = 1.0f / sqrtf(ss * (1.0f / D) + EPS);
        if (NORM == 1) {
            const float* m = mod_nrm + (size_t)rb * 6144;
#pragma unroll
            for (int j = 0; j < 4; ++j) {
                const int c = j * 256 + lane * 4;
                f32x4 g = *(const f32x4*)(gnorm + c), sc = *(const f32x4*)(m + scc * D + c), sh = *(const f32x4*)(m + shc * D + c);
                f32x4 hv = v[j] * rstd * g * (sc + 1.0f) + sh;
                u32x2 u; u.x = pack_bf16(hv[0], hv[1]); u.y = pack_bf16(hv[2], hv[3]);
                *(u32x2*)(hout + (size_t)t * D + c) = u;
            }
        } else {
#pragma unroll
            for (int j = 0; j < 4; ++j) { const int c = j * 256 + lane * 4; f32x4 g = *(const f32x4*)(gnorm + c); st_wt16(out + (size_t)t * D + c, v[j] * rstd * g); }
        }
    }
}

constexpr int CNT_PAD = 32;
__device__ __forceinline__ void router_rows(char* lds, const WS& w, const float* ebias, int r0, int r1, int l) {
    int tid = threadIdx.x; asm volatile("" : "+v"(tid));
    const int lane = tid & 63, wv = tid >> 6, fr = lane & 15, fq = lane >> 4;
    float* sl = (float*)lds + wv * (16 * 33);
    int* lcnt = (int*)(lds + 8 * 16 * 33 * 4);
    const bf16* Bt = w.wrT + (size_t)l * 32 * 1024;
    int* cnt = w.cnt + l * 32 * CNT_PAD; int* list = w.list;
    const int t0 = r0 + wv * 16;
    if (tid < 32) lcnt[tid] = 0;
    if (t0 < r1) {
        f32x4 a0 = {0.f, 0.f, 0.f, 0.f}, a1 = {0.f, 0.f, 0.f, 0.f};
        const int ra = t0 + fr < r1 ? t0 + fr : r1 - 1;
        const bf16* ar = w.h + (size_t)ra * D + fq * 8;
        const bf16* b0 = Bt + (size_t)fr * 1024 + fq * 8; const bf16* b1 = b0 + 16 * 1024;
#pragma unroll 8
        for (int ks = 0; ks < 32; ++ks) {
            bf16x8 fa = *(const bf16x8*)(ar + ks * 32), fb0 = *(const bf16x8*)(b0 + ks * 32), fb1 = *(const bf16x8*)(b1 + ks * 32);
            a0 = __builtin_amdgcn_mfma_f32_16x16x32_bf16(fa, fb0, a0, 0, 0, 0);
            a1 = __builtin_amdgcn_mfma_f32_16x16x32_bf16(fa, fb1, a1, 0, 0, 0);
        }
#pragma unroll
        for (int j = 0; j < 4; ++j) { sl[(4 * fq + j) * 33 + fr] = a0[j]; sl[(4 * fq + j) * 33 + 16 + fr] = a1[j]; }
    }
    __builtin_amdgcn_wave_barrier(); asm volatile("s_waitcnt lgkmcnt(0)" ::: "memory");
    float* sb = (float*)lds + 8 * 16 * 33 + 64 + wv * (16 * 33);
    if (t0 < r1) {
#pragma unroll
        for (int q = 0; q < 8; ++q) { const int e = (lane >> 4) * 8 + q; const float sg = 1.0f / (1.0f + __expf(-sl[(lane & 15) * 33 + e])); sl[(lane & 15) * 33 + e] = sg; sb[(lane & 15) * 33 + e] = sg + ebias[e]; }
    }
    __syncthreads();
    int sel[4]; int lpos[4];
    const bool mine = lane < 16 && t0 + lane < r1;
    if (mine) {
        const int t = t0 + lane; const float* sr = sl + lane * 33; const float* br = sb + lane * 33;
        float ss[4]; float sum = 0.f;
#pragma unroll
        for (int k = 0; k < 4; ++k) {
            int best = 0; float bv = -1e30f;
            for (int e = 0; e < 32; ++e) {
                bool used = false;
#pragma unroll
                for (int q = 0; q < 4; ++q) if (q < k && sel[q] == e) used = true;
                const float vv = br[e];
                if (!used && vv > bv) { bv = vv; best = e; }
            }
            sel[k] = best; ss[k] = sr[best]; sum += ss[k];
        }
        const float inv = ROUTED_SCALE / sum;
#pragma unroll
        for (int k = 0; k < 4; ++k) { w.topw[(size_t)t * 4 + k] = ss[k] * inv; lpos[k] = atomicAdd(&lcnt[sel[k]], 1); }
    }
    __syncthreads();
    if (tid < 32) lcnt[32 + tid] = atomicAdd(&cnt[tid * CNT_PAD], lcnt[tid]);
    __syncthreads();
    if (mine) {
        const int t = t0 + lane;
#pragma unroll
        for (int k = 0; k < 4; ++k) list[(size_t)sel[k] * T + lcnt[32 + sel[k]] + lpos[k]] = t * 4 + k;
    }
    __syncthreads();
}
__device__ __forceinline__ void phase_norm2_router(char* lds, const WS& w, const Inputs& in, int ntok, const float* mod, const float* gnorm, const float* ebias, int l) {
    int rpb = (ntok + (int)gridDim.x - 1) / (int)gridDim.x; if (rpb > 128) rpb = 128;
    for (int r0 = blockIdx.x * rpb; r0 < ntok; r0 += gridDim.x * rpb) {
        const int r1 = r0 + rpb < ntok ? r0 + rpb : ntok;
        row_pass<1, 1>(w, in, ntok, mod, mod, gnorm, 3, 4, nullptr, nullptr, nullptr, w.h, r0 + (int)(threadIdx.x >> 6), r1, 8);
        asm volatile("s_waitcnt vmcnt(0)" ::: "memory");
        __syncthreads();
        router_rows(lds, w, ebias, r0, r1, l);
    }
}

__device__ __forceinline__ bool moe_decode(int tile, int NT, const int* cnt, int ntok, int& e, int& mt, int& nt, int& base, int& rows) {
    int t = tile / NT; nt = tile % NT; int b = 0;
    for (int i = 0; i < 33; ++i) {
        const int c = i < 32 ? cnt[i * CNT_PAD] : ntok; const int m = (c + GBM - 1) / GBM;
        if (t < m) { e = i; mt = t; rows = c; base = b; return true; }
        t -= m; b += c;
    }
    return false;
}
struct ARowGather {
    const bf16* A; const int* list; int rows; int r0; bool ident;
    __device__ __forceinline__ const bf16* operator()(int i) const {
        const int idx = r0 + i; int tok = 0;
        if (idx < rows) tok = ident ? idx : (list[idx] >> 2);
        return A + (size_t)tok * D;
    }
};
struct EpiUp {
    bf16* hid; int base; int rows;
    __device__ __forceinline__ void operator()(f32x16 (&acc)[2][2], int mrow, int ncol) const {
        const int hc = (ncol >> 7) * 64 + ((ncol >> 6) & 1) * 32 + (ncol & 63);
#pragma unroll
        for (int mi = 0; mi < 2; ++mi) {
            const int idx = mrow + mi * 32;
            if (idx < rows) {
#pragma unroll
                for (int g = 0; g < 4; ++g) {
                    float o[4];
#pragma unroll
                    for (int q = 0; q < 4; ++q) { const float gt = acc[mi][0][4 * g + q], up = acc[mi][1][4 * g + q]; o[q] = gt / (1.0f + expf(-gt)) * up; }
                    u32x2 v; v.x = pack_bf16(o[0], o[1]); v.y = pack_bf16(o[2], o[3]);
                    *(u32x2*)(hid + (size_t)(base + idx) * 256 + hc + 8 * g) = v;
                }
            }
        }
    }
};
struct EpiDown {
    bf16* y; const int* list; int rows; bool shared; float* xr; const float* mod;
    __device__ __forceinline__ void operator()(f32x16 (&acc)[2][2], int mrow, int ncol) const {
#pragma unroll
        for (int mi = 0; mi < 2; ++mi) {
            const int idx = mrow + mi * 32;
            if (idx < rows) {
                if (!shared) {
                    const int asg = list[idx];
#pragma unroll
                    for (int ni = 0; ni < 2; ++ni)
#pragma unroll
                        for (int g = 0; g < 4; ++g) {
                            u32x2 v; v.x = pack_bf16(acc[mi][ni][4 * g], acc[mi][ni][4 * g + 1]); v.y = pack_bf16(acc[mi][ni][4 * g + 2], acc[mi][ni][4 * g + 3]);
                            *(u32x2*)(y + (size_t)asg * D + ncol + ni * 32 + 8 * g) = v;
                        }
                } else {
                    const int rb = idx < TL ? idx / S : 8; const float* g2 = mod + (size_t)rb * 6144 + 5 * D;
#pragma unroll
                    for (int ni = 0; ni < 2; ++ni)
#pragma unroll
                        for (int g = 0; g < 4; ++g) {
                            const int n = ncol + ni * 32 + 8 * g;
                            f32x4 gv = *(const f32x4*)(g2 + n); float* xp = xr + (size_t)idx * D + n; f32x4 xv = *(const f32x4*)xp;
                            xv[0] += gv[0] * acc[mi][ni][4 * g]; xv[1] += gv[1] * acc[mi][ni][4 * g + 1]; xv[2] += gv[2] * acc[mi][ni][4 * g + 2]; xv[3] += gv[3] * acc[mi][ni][4 * g + 3];
                            *(f32x4*)xp = xv;
                        }
                }
            }
        }
    }
};
struct EpiUpH {
    bf16* hid; int base; int rows;
    __device__ __forceinline__ void operator()(f32x16 (&acc)[2][4], int mrow, int ncol  ) const {
        const int fh = (ncol >> 2) & 1; const int hc = (ncol >> 8) * 128 + ((ncol >> 7) & 1) * 64 + 8 * fh;
#pragma unroll
        for (int mi = 0; mi < 2; ++mi) {
            const int idx = mrow + mi * 32;
            if (idx < rows) {
#pragma unroll
                for (int g = 0; g < 4; ++g) {
                    float o[8];
#pragma unroll
                    for (int nh = 0; nh < 2; ++nh)
#pragma unroll
                        for (int q = 0; q < 4; ++q) { const float gt = acc[mi][nh][4 * g + q], up = acc[mi][nh + 2][4 * g + q]; o[4 * nh + q] = gt / (1.0f + __expf(-gt)) * up; }
                    u32x4 v; v.x = pack_bf16(o[0], o[1]); v.y = pack_bf16(o[2], o[3]); v.z = pack_bf16(o[4], o[5]); v.w = pack_bf16(o[6], o[7]);
                    *(u32x4*)(hid + (size_t)(base + idx) * 256 + hc + 16 * g) = v;
                }
            }
        }
    }
};
__device__ __forceinline__ int down_perm(int rho) { const int ni = rho >> 5, g = (rho >> 3) & 3, fh = (rho >> 2) & 1, q = rho & 3; return 64 * (ni >> 1) + 16 * g + 8 * fh + 4 * (ni & 1) + q; }
struct EpiDownH {
    bf16* y; const int* list; int rows; bool shared; float* xr; const float* mod;
    __device__ __forceinline__ void operator()(f32x16 (&acc)[2][4], int mrow, int ncol  ) const {
        const int nbase = (ncol & ~127), fh = (ncol >> 2) & 1;
#pragma unroll
        for (int mi = 0; mi < 2; ++mi) {
            const int idx = mrow + mi * 32;
            if (idx < rows) {
                if (!shared) {
                    const int asg = list[idx];
#pragma unroll
                    for (int hp = 0; hp < 2; ++hp)
#pragma unroll
                        for (int g = 0; g < 4; ++g) {
                            u32x4 v; v.x = pack_bf16(acc[mi][2 * hp][4 * g], acc[mi][2 * hp][4 * g + 1]); v.y = pack_bf16(acc[mi][2 * hp][4 * g + 2], acc[mi][2 * hp][4 * g + 3]);
                            v.z = pack_bf16(acc[mi][2 * hp + 1][4 * g], acc[mi][2 * hp + 1][4 * g + 1]); v.w = pack_bf16(acc[mi][2 * hp + 1][4 * g + 2], acc[mi][2 * hp + 1][4 * g + 3]);
                            *(u32x4*)(y + (size_t)asg * D + nbase + 64 * hp + 16 * g + 8 * fh) = v;
                        }
                } else {
                    const int rb = idx < TL ? idx / S : 8; const float* g2 = mod + (size_t)rb * 6144 + 5 * D;
#pragma unroll
                    for (int hp = 0; hp < 2; ++hp)
#pragma unroll
                        for (int g = 0; g < 4; ++g)
#pragma unroll
                            for (int nl = 0; nl < 2; ++nl) {
                                const int n = nbase + 64 * hp + 16 * g + 8 * fh + 4 * nl;
                                f32x4 gv = *(const f32x4*)(g2 + n); float* xp = xr + (size_t)idx * D + n; f32x4 xv = *(const f32x4*)xp;
                                xv[0] += gv[0] * acc[mi][2 * hp + nl][4 * g]; xv[1] += gv[1] * acc[mi][2 * hp + nl][4 * g + 1]; xv[2] += gv[2] * acc[mi][2 * hp + nl][4 * g + 2]; xv[3] += gv[3] * acc[mi][2 * hp + nl][4 * g + 3];
                                *(f32x4*)xp = xv;
                            }
                }
            }
        }
    }
};
struct TLMoeUp {
    const WS* w; const int* cnt; int ntok; static constexpr int K = 1024;
    struct Tile { int e, mt, nt, base, rows; };
    __device__ __forceinline__ bool tile(int idx, Tile& t) const { return moe_decode(idx, 2, cnt, ntok, t.e, t.mt, t.nt, t.base, t.rows); }
    __device__ __forceinline__ unsigned active(const Tile&, int) const { return 15u; }
    __device__ __forceinline__ const bf16* arow(const Tile& t, int r) const {
        const int i = t.mt * GBM + r; int tok = 0;
        if (i < t.rows) tok = t.e == 32 ? i : (w->list[(size_t)t.e * T + i] >> 2);
        return w->h + (size_t)tok * D;
    }
    __device__ __forceinline__ const bf16* brow(const Tile& t, int r) const { return w->moeUpT + ((size_t)t.e * 512 + t.nt * 256 + (r & ~63) + perm64(r & 63)) * 1024; }
    __device__ __forceinline__ void epi(const Tile& t, f32x16 (&acc)[2][4], int mr, int nc) const { EpiUpH{w->hid2, t.base, t.rows}(acc, t.mt * GBM + mr, t.nt * 256 + nc); }
};
struct TLMoeDown {
    const WS* w; const int* cnt; int ntok; const float* mod; static constexpr int K = 256;
    struct Tile { int e, mt, nt, base, rows; };
    __device__ __forceinline__ bool tile(int idx, Tile& t) const { return moe_decode(idx, 4, cnt, ntok, t.e, t.mt, t.nt, t.base, t.rows); }
    __device__ __forceinline__ unsigned active(const Tile&, int) const { return 15u; }
    __device__ __forceinline__ const bf16* arow(const Tile& t, int r) const { return w->hid2 + (size_t)(t.base + t.mt * GBM + r) * 256; }
    __device__ __forceinline__ const bf16* brow(const Tile& t, int r) const { return w->moeDownT + ((size_t)t.e * 1024 + t.nt * 256 + (r & 128) + down_perm(r & 127)) * 256; }
    __device__ __forceinline__ void epi(const Tile& t, f32x16 (&acc)[2][4], int mr, int nc) const {
        EpiDownH{(bf16*)w->h, w->list + (size_t)t.e * T, t.rows, t.e == 32, w->xr, mod}(acc, t.mt * GBM + mr, t.nt * 256 + nc);
    }
};
struct TLMoeDownR : TLMoeDown {
    __device__ __forceinline__ bool tile(int idx, Tile& t) const { return moe_decode(idx, 4, cnt, ntok, t.e, t.mt, t.nt, t.base, t.rows) && t.e < 32; }
};
__device__ __forceinline__ void phase_moe_down_routed(char* lds, const WS& w, int l, int ntok, const float* mod) { TLMoeDownR tl; tl.w = &w; tl.cnt = w.cnt + l * 32 * CNT_PAD; tl.ntok = ntok; tl.mod = mod; gemm_stream256(lds, tl); }
__device__ __forceinline__ void phase_moe_up(char* lds, const WS& w, int l, int ntok) { gemm_stream256(lds, TLMoeUp{&w, w.cnt + l * 32 * CNT_PAD, ntok}); }
__device__ __forceinline__ void phase_moe_down(char* lds, const WS& w, int l, int ntok, const float* mod) { gemm_stream256(lds, TLMoeDown{&w, w.cnt + l * 32 * CNT_PAD, ntok, mod}); }
#endif
#ifndef HOST_SIM
__device__ __forceinline__ void phase_ada(char* lds, const WS& w, const Inputs& in) {
    int tid = threadIdx.x; asm volatile("" : "+v"(tid));
    const int lane = tid & 63, wv = tid >> 6;
    float* sc = (float*)lds;
    float* red = sc + 9 * 1024;
    if ((int)blockIdx.x >= 192) return;
    __syncthreads();
    for (int i = tid; i < 9 * 1024; i += NTHREADS) { const int r = i >> 10, k = i & 1023; const float v = r < 8 ? in.c[(size_t)(r % B) * D + k] : in.c_ctx[k]; sc[i] = v / (1.0f + __expf(-v)); }
    __syncthreads();
    for (int it = blockIdx.x; it < 192; it += gridDim.x) {
        const int l = it / 96, n = (it % 96) * 64 + lane;
        const float* wp = in.w_ada + (size_t)l * D * 6144 + (size_t)(wv * 128) * 6144 + n;
        float acc[9];
#pragma unroll
        for (int r = 0; r < 9; ++r) acc[r] = 0.f;
        for (int kb = 0; kb < 128; kb += 16) {
            float wq[16];
#pragma unroll
            for (int i = 0; i < 16; ++i) wq[i] = wp[(size_t)(kb + i) * 6144];
#pragma unroll
            for (int r = 0; r < 9; ++r) {
                const float* sr = sc + r * 1024 + wv * 128 + kb;
#pragma unroll
                for (int i4 = 0; i4 < 4; ++i4) { const f32x4 s4 = *(const f32x4*)(sr + 4 * i4); acc[r] += s4[0] * wq[4 * i4] + s4[1] * wq[4 * i4 + 1] + s4[2] * wq[4 * i4 + 2] + s4[3] * wq[4 * i4 + 3]; }
            }
        }
#pragma unroll
        for (int r = 0; r < 9; ++r) red[(wv * 9 + r) * 64 + lane] = acc[r];
        __syncthreads();
        for (int i = tid; i < 9 * 64; i += NTHREADS) {
            const int r = i >> 6, c = i & 63; float s = 0.f;
#pragma unroll
            for (int q = 0; q < 8; ++q) s += red[(q * 9 + r) * 64 + c];
            const int nn = (it % 96) * 64 + c;
            w.mod[((size_t)l * 9 + r) * 6144 + nn] = s + in.b_ada[l * 6144 + nn];
        }
        __syncthreads();
    }
}
#endif
#ifndef HOST_SIM
typedef short s16x4 __attribute__((ext_vector_type(4)));
constexpr int AT_KV = 64 * 128;
constexpr int AT_STAGE = 2 * AT_KV;
__device__ __forceinline__ int at_voff(int key, int dcol) { return key * 128 + ((((dcol >> 5) ^ ((key >> 1) & 1))) << 6) + ((dcol & 31) << 1); }
__device__ __forceinline__ int at_kappa(int r) { return (r & ~12) | ((r & 4) << 1) | ((r & 8) >> 1); }

struct AttnState { f32x16 o[2]; float m, l; };

__device__ __forceinline__ void at_qk(const char* st, const bf16x8 (&qf)[4], f32x16 (&s)[2], int lane) {
    const int fr = lane & 31, fh = lane >> 5, kr = at_kappa(fr);
#pragma unroll
    for (int tt = 0; tt < 2; ++tt) {
#pragma unroll
        for (int r = 0; r < 16; ++r) s[tt][r] = 0.f;
#pragma unroll
        for (int ks = 0; ks < 4; ++ks) {
            const bf16x8 kf = *(const bf16x8*)(st + g_lds_off(32 * tt + kr, ks * 2 + fh));
            s[tt] = __builtin_amdgcn_mfma_f32_32x32x16_bf16(kf, qf[ks], s[tt], 0, 0, 0);
        }
    }
}
__device__ __forceinline__ void at_softmax_pv(const char* st, f32x16 (&s)[2], AttnState& a, int lane) {
    float mx = -1e30f;
#pragma unroll
    for (int tt = 0; tt < 2; ++tt)
#pragma unroll
        for (int r = 0; r < 16; ++r) mx = fmaxf(mx, s[tt][r]);
    mx = fmaxf(mx, __shfl_xor(mx, 32));
    const float mn = fmaxf(a.m, mx), alpha = __builtin_amdgcn_exp2f(a.m - mn);
    float rs = 0.f;
#pragma unroll
    for (int tt = 0; tt < 2; ++tt)
#pragma unroll
        for (int r = 0; r < 16; ++r) { const float p = __builtin_amdgcn_exp2f(s[tt][r] - mn); s[tt][r] = p; rs += p; }
    rs += __shfl_xor(rs, 32);
    a.l = a.l * alpha + rs; a.m = mn;
#pragma unroll
    for (int dt = 0; dt < 2; ++dt)
#pragma unroll
        for (int r = 0; r < 16; ++r) a.o[dt][r] *= alpha;
    const int fh = lane >> 5, i16 = lane & 15, g1 = (lane >> 4) & 1;
    const char* vb = st + AT_KV;
#pragma unroll
    for (int tt = 0; tt < 2; ++tt)
#pragma unroll
        for (int sp = 0; sp < 2; ++sp) {
            union { bf16x8 v; unsigned u[4]; } pu;
#pragma unroll
            for (int j = 0; j < 4; ++j) pu.u[j] = pack_bf16(s[tt][8 * sp + 2 * j], s[tt][8 * sp + 2 * j + 1]);
            const bf16x8 pf = pu.v;
#pragma unroll
            for (int dt = 0; dt < 2; ++dt) {
                const int kb = 32 * tt + 16 * sp + 8 * fh + (i16 >> 2), dc = 32 * dt + 16 * g1 + 4 * (i16 & 3);
                const s16x4 v0 = __builtin_amdgcn_ds_read_tr16_b64_v4i16((LAS s16x4*)(vb + at_voff(kb, dc)));
                const s16x4 v1 = __builtin_amdgcn_ds_read_tr16_b64_v4i16((LAS s16x4*)(vb + at_voff(kb + 4, dc)));
                bf16x8 vf; vf[0] = v0[0]; vf[1] = v0[1]; vf[2] = v0[2]; vf[3] = v0[3]; vf[4] = v1[0]; vf[5] = v1[1]; vf[6] = v1[2]; vf[7] = v1[3];
                a.o[dt] = __builtin_amdgcn_mfma_f32_32x32x16_bf16(vf, pf, a.o[dt], 0, 0, 0);
            }
        }
}
__device__ __forceinline__ void at_store(const AttnState& a, bf16* orow  , int lane) {
    const float il = 1.0f / a.l; const int fh = lane >> 5;
#pragma unroll
    for (int dt = 0; dt < 2; ++dt)
#pragma unroll
        for (int g = 0; g < 4; ++g) {
            u32x2 v; v.x = pack_bf16(a.o[dt][4 * g] * il, a.o[dt][4 * g + 1] * il); v.y = pack_bf16(a.o[dt][4 * g + 2] * il, a.o[dt][4 * g + 3] * il);
            *(u32x2*)(orow + 32 * dt + 8 * g + 4 * fh) = v;
        }
}
struct AtRegs { u32x4 k, v; };
__device__ __forceinline__ AtRegs at_load(const bf16* kbase, const bf16* vbase, int tid) {
    const int key = tid >> 3, c = tid & 7; AtRegs r;
    r.k = *(const u32x4*)(kbase + (size_t)key * DIN + c * 8); r.v = *(const u32x4*)(vbase + (size_t)key * DIN + c * 8); return r;
}
__device__ __forceinline__ void at_write(char* st, const AtRegs& r, int tid) {
    const int key = tid >> 3, c = tid & 7;
    *(u32x4*)(st + g_lds_off(key, c)) = r.k; *(u32x4*)(st + AT_KV + at_voff(key, c * 8)) = r.v;
}
__device__ __forceinline__ void at_dma(char* st, const bf16* kbase, int voff, int wid, int lane) {
    const int r = 8 * wid + (lane >> 3), pos = lane & 7;
    const bf16* kr = kbase + (size_t)r * DIN;
    const int ck = pos ^ ((r >> 1) & 7), cv = 4 * ((pos >> 2) ^ ((r >> 1) & 1)) + (pos & 3);
    __builtin_amdgcn_global_load_lds((const unsigned*)(kr + 8 * ck), (LAS unsigned*)(st + wid * 1024), 16, 0, 0);
    __builtin_amdgcn_global_load_lds((const unsigned*)(kr + voff + 8 * cv), (LAS unsigned*)(st + AT_KV + wid * 1024), 16, 0, 0);
}
#define AT_WAIT(n) asm volatile("s_waitcnt vmcnt(" #n ")" ::: "memory")
__device__ __forceinline__ void at_wait_tile(int remaining_after  ) {
    if (remaining_after >= 2) AT_WAIT(4); else if (remaining_after == 1) AT_WAIT(2); else AT_WAIT(0);
    __builtin_amdgcn_s_barrier();
    asm volatile("" ::: "memory");
}
constexpr int AT_RING = 4;
__device__ __forceinline__ void at_loadq(bf16x8 (&qf)[4], const bf16* qrow, int lane) {
    const int fh = lane >> 5;
#pragma unroll
    for (int ks = 0; ks < 4; ++ks) qf[ks] = *(const bf16x8*)(qrow + ks * 16 + fh * 8);
}
__device__ __forceinline__ int at_key(int tt, int r, int fh) { return 32 * tt + (r & 3) + 8 * fh + 4 * ((r >> 2) & 1) + 16 * (r >> 3); }

__device__ __forceinline__ void attn_wa_item(char* lds, const bf16* p, bf16* ycat, const float* sink, int b, int hk, int qb, bool ctxq) {
    int tid = threadIdx.x; asm volatile("" : "+v"(tid));
    const int lane = tid & 63, wv = tid >> 6, fr = lane & 31, fh = lane >> 5;
    const int hq = 2 * hk + (wv >> 2);
    const int qpos = qb * 128 + (wv & 3) * 32 + fr;
    const size_t qtok = ctxq ? (size_t)TL + (size_t)b * LC + qpos : (size_t)b * S + qpos;
    bf16x8 qf[4]; at_loadq(qf, p + qtok * DIN + O1 + hq * 64, lane);
    AttnState a;
#pragma unroll
    for (int dt = 0; dt < 2; ++dt)
#pragma unroll
        for (int r = 0; r < 16; ++r) a.o[dt][r] = 0.f;
    a.m = sink[hq] * 1.4426950408889634f; a.l = 1.0f;
    int lo = qb * 128 - 128, hi = qb * 128 + 256; if (lo < 0) lo = 0; if (hi > S) hi = S;
    const int nloc = ctxq ? 0 : (hi - lo) / 64, nt = 4 + nloc;
    const bf16* kc = p + ((size_t)TL + (size_t)b * LC) * DIN + O1 + 256 + hk * 64;
    const bf16* kl = p + ((size_t)b * S + lo) * DIN + O1 + 256 + hk * 64;
    const int wid = __builtin_amdgcn_readfirstlane(wv);
    asm volatile("s_waitcnt vmcnt(0)" ::: "memory");
    __syncthreads();
#define AT_TILE_K(i_) ((i_) < 4 ? kc + (size_t)(i_) * 64 * DIN : kl + (size_t)((i_) - 4) * 64 * DIN)
    for (int i = 0; i < 3 && i < nt; ++i) at_dma(lds + i * AT_STAGE, AT_TILE_K(i), 128, wid, lane);
    for (int i = 0; i < nt; ++i) {
        const char* st = lds + (i & 3) * AT_STAGE;
        at_wait_tile(nt - 1 - i);
        if (i + 3 < nt) at_dma(lds + ((i + 3) & 3) * AT_STAGE, AT_TILE_K(i + 3), 128, wid, lane);
        if (i >= 4) { const int kb0w = lo + (i - 4) * 64, q0w = qb * 128 + (wv & 3) * 32; if (kb0w + 63 < q0w - WINDOW || kb0w > q0w + 31 + WINDOW) continue; }
        f32x16 s[2]; at_qk(st, qf, s, lane);
        if (i < 4) {
#pragma unroll
            for (int tt = 0; tt < 2; ++tt)
#pragma unroll
                for (int r = 0; r < 16; ++r) s[tt][r] *= 0.125f * 1.4426950408889634f;
        } else {
            const int kb0 = lo + (i - 4) * 64;
#pragma unroll
            for (int tt = 0; tt < 2; ++tt)
#pragma unroll
                for (int r = 0; r < 16; ++r) { const int d = kb0 + at_key(tt, r, fh) - qpos; s[tt][r] = (d >= -WINDOW && d <= WINDOW) ? s[tt][r] * (0.125f * 1.4426950408889634f) : -1e30f; }
        }
        at_softmax_pv(st, s, a, lane);
    }
    at_store(a, ycat + qtok * 1024 + 256 + hq * 64, lane);
}
__device__ __forceinline__ void attn_na_item(char* lds, const bf16* p, bf16* ycat, const float* rpb  , int b, int h, int rg4, bool ctxq) {
    int tid = threadIdx.x; asm volatile("" : "+v"(tid));
    const int lane = tid & 63, wv = tid >> 6, fr = lane & 31, fh = lane >> 5;
    const int r = rg4 * 4 + (wv >> 1), cq = (wv & 1) * 32 + fr;
    const size_t qtok = ctxq ? (size_t)TL + (size_t)b * LC + wv * 32 + fr : (size_t)b * S + r * 64 + cq;
    bf16x8 qf[4]; at_loadq(qf, p + qtok * DIN + O2 + h * 64, lane);
    AttnState a;
#pragma unroll
    for (int dt = 0; dt < 2; ++dt)
#pragma unroll
        for (int rr = 0; rr < 16; ++rr) a.o[dt][rr] = 0.f;
    a.m = -1e30f; a.l = 0.f;
    constexpr int ROWS = S / GRID_W;
    int klo = rg4 * 4 - 4; if (klo < 0) klo = 0; int khi = rg4 * 4 + 3 - 4; if (khi < 0) khi = 0; if (khi > ROWS - NA_KR) khi = ROWS - NA_KR; khi += NA_KR;
    if (klo > ROWS - NA_KR) klo = ROWS - NA_KR;
    const int nloc = ctxq ? 0 : khi - klo, nt = 4 + nloc;
    int myr0 = r - 4; myr0 = myr0 < 0 ? 0 : (myr0 > ROWS - NA_KR ? ROWS - NA_KR : myr0);
    int c0 = cq - 8; c0 = c0 < 0 ? 0 : (c0 > GRID_W - NA_KC ? GRID_W - NA_KC : c0);
    const bf16* kc = p + ((size_t)TL + (size_t)b * LC) * DIN + O2 + 256 + h * 64;
    const bf16* kl = p + ((size_t)b * S + (size_t)klo * 64) * DIN + O2 + 256 + h * 64;
    float* bl = (float*)(lds + AT_RING * AT_STAGE);
    __syncthreads();
    const int wid = __builtin_amdgcn_readfirstlane(wv);
    if (tid < 15 * 31) bl[(tid / 31) * 32 + (tid % 31)] = rpb[h * 15 * 31 + tid];
    asm volatile("s_waitcnt vmcnt(0) lgkmcnt(0)" ::: "memory");
    for (int i = 0; i < 3 && i < nt; ++i) at_dma(lds + i * AT_STAGE, AT_TILE_K(i), 256, wid, lane);
    for (int i = 0; i < nt; ++i) {
        const char* st = lds + (i & 3) * AT_STAGE;
        at_wait_tile(nt - 1 - i);
        if (i + 3 < nt) at_dma(lds + ((i + 3) & 3) * AT_STAGE, AT_TILE_K(i + 3), 256, wid, lane);
        const int krow = klo + (i - 4);
        const bool act = i < 4 || (krow >= myr0 && krow < myr0 + NA_KR);
        if (act) {
            f32x16 s[2]; at_qk(st, qf, s, lane);
            if (i < 4) {
#pragma unroll
                for (int tt = 0; tt < 2; ++tt)
#pragma unroll
                    for (int rr = 0; rr < 16; ++rr) s[tt][rr] *= 0.125f * 1.4426950408889634f;
            } else {
                const float* brow = bl + (krow - r + 7) * 32 + 15 - cq;
#pragma unroll
                for (int tt = 0; tt < 2; ++tt)
#pragma unroll
                    for (int rr = 0; rr < 16; ++rr) { const int kcol = at_key(tt, rr, fh); const bool ok = kcol >= c0 && kcol < c0 + NA_KC;
                        const float bias = ok ? brow[kcol] : 0.f; s[tt][rr] = ok ? (s[tt][rr] * 0.125f + bias) * 1.4426950408889634f : -1e30f; }
            }
            at_softmax_pv(st, s, a, lane);
        }
    }
    at_store(a, ycat + qtok * 1024 + 512 + h * 64, lane);
}
__device__ __forceinline__ void attn_item(char* lds, const WS& w, const Inputs& in, int l, int it) {
    if (it < 256) attn_wa_item(lds, w.p, w.ycat, in.wa_sink + l * 4, it >> 5, (it >> 4) & 1, it & 15, false);
    else if (it < 512) { const int j = it - 256; attn_na_item(lds, w.p, w.ycat, in.na_rpb + l * 4 * 15 * 31, j >> 5, (j >> 3) & 3, j & 7, false); }
    else if (it < 544) { const int j = it - 512; attn_wa_item(lds, w.p, w.ycat, in.wa_sink + l * 4, j >> 2, (j >> 1) & 1, j & 1, true); }
    else { const int j = it - 544; attn_na_item(lds, w.p, w.ycat, in.na_rpb + l * 4 * 15 * 31, j >> 2, j & 3, 0, true); }
}
#endif
#ifndef HOST_SIM
__device__ __forceinline__ float hy_c3(const bf16* pr, int tin, int col, const float* cw) {
    float acc = cw[768 + col] * bf2f(pr[col]);
    if (tin > 0) acc += cw[col] * bf2f(pr[col - DIN]);
    if (tin < S - 1) acc += cw[2 * 768 + col] * bf2f(pr[col + DIN]);
    return acc;
}
__device__ __forceinline__ void hy_prep_item(char* lds, const bf16* p, const float* cw, bf16* x0T, bf16* uvT, int b, int ch, bool ctx = false) {
    int tid = threadIdx.x; asm volatile("" : "+v"(tid));
    bf16* lx = (bf16*)lds;
    bf16* lu = lx + 256 * 72;
    __syncthreads();
    const int tl = tid & 63, cg = tid >> 6;
    const int L = ctx ? LC : S; const int tin = ch * 64 + tl; const bf16* pr = p + ((ctx ? (size_t)TL + (size_t)b * LC : (size_t)b * S) + tin) * DIN;
    for (int it = 0; it < 4; ++it) {
        const int c0 = (it * 8 + cg) * 8;
        float x0[8], x1[8], vv[8];
#pragma unroll
        for (int q = 0; q < 8; ++q) { x0[q] = 0.f; x1[q] = 0.f; vv[q] = 0.f; }
#pragma unroll
        for (int dr = -1; dr <= 1; ++dr) {
            if (tin + dr < 0 || tin + dr >= L) continue;
            const bf16* r = pr + (ptrdiff_t)dr * DIN;
            const u32x4 a = *(const u32x4*)(r + c0), bq = *(const u32x4*)(r + 256 + c0), cq = *(const u32x4*)(r + 512 + c0);
            const float* w0 = cw + (dr + 1) * 768;
#pragma unroll
            for (int q = 0; q < 4; ++q) {
                x0[2 * q] += w0[c0 + 2 * q] * __uint_as_float(a[q] << 16); x0[2 * q + 1] += w0[c0 + 2 * q + 1] * __uint_as_float(a[q] & 0xffff0000u);
                x1[2 * q] += w0[256 + c0 + 2 * q] * __uint_as_float(bq[q] << 16); x1[2 * q + 1] += w0[256 + c0 + 2 * q + 1] * __uint_as_float(bq[q] & 0xffff0000u);
                vv[2 * q] += w0[512 + c0 + 2 * q] * __uint_as_float(cq[q] << 16); vv[2 * q + 1] += w0[512 + c0 + 2 * q + 1] * __uint_as_float(cq[q] & 0xffff0000u);
            }
        }
#pragma unroll
        for (int q = 0; q < 8; ++q) { lx[(c0 + q) * 72 + tl] = f2bf(x0[q]); lu[(c0 + q) * 72 + tl] = f2bf(x1[q] * vv[q]); }
    }
    __syncthreads();
    for (int i = tid; i < 2048; i += NTHREADS) {
        const int c = i >> 3, k = i & 7;
        const size_t g = ((size_t)c * B + b) * L + ch * 64 + k * 8;
        *(u32x4*)(x0T + g) = *(const u32x4*)(lx + c * 72 + k * 8);
        *(u32x4*)(uvT + g) = *(const u32x4*)(lu + c * 72 + k * 8);
    }
}
constexpr int HY_NOFF = 2072, HY_NE = 4128, HY_CS = HY_NE * 2 + 32;
constexpr int HY_URS = S * 2 + 16;
constexpr int HY_LDS_U = 8 * HY_CS, HY_LDS_Z = HY_LDS_U + 8 * HY_URS, HY_LDS_REV = HY_LDS_Z + 64, HY_LDS_END0 = HY_LDS_REV + (HY_NE + 8) * 2;
constexpr int HC_NOFF = 280, HC_NE = 544, HC_CS = HC_NE * 2 + 32, HC_URS = LC * 2 + 16;
constexpr int HC_LDS_C = (HY_LDS_END0 + 15) & ~15, HC_LDS_U = HC_LDS_C + 8 * HC_CS, HC_LDS_REV = HC_LDS_U + 8 * HC_URS, HY_LDS_END = HC_LDS_REV + (HC_NE + 8) * 2;
__device__ __forceinline__ void hy_conv_item(char* lds, const float* filtT, const float* hbias, const bf16* uvT, bf16* x0T  , int c, const bf16* uvTc = nullptr, bf16* x0Tc = nullptr) {
    static_assert(B == 8, "hyena conv assumes batch 8");
    int tid = threadIdx.x; asm volatile("" : "+v"(tid));
    const int lane = tid & 63, wv = tid >> 6, fr = lane & 31, fh = lane >> 5;
    bf16* rev = (bf16*)(lds + HY_LDS_REV);
    __syncthreads();
    const float* hf = filtT + (size_t)c * (S + LC); const float* hb = filtT + (size_t)(256 + c) * (S + LC);
    for (int e = tid; e < HY_NE + 8; e += NTHREADS) {
        const int n = e - HY_NOFF; float v = 0.f;
        if (n > 0 && n < S) v = hb[n]; else if (n <= 0 && n > -S) v = hf[-n];
        rev[e] = f2bf(v);
    }
    for (int i = tid; i < 8 * 256; i += NTHREADS) { const int bb = i >> 8, k = i & 255; *(u32x4*)(lds + HY_LDS_U + bb * HY_URS + k * 16) = *(const u32x4*)(uvT + ((size_t)c * B + bb) * S + k * 8); }
    if (tid < 4) ((unsigned*)(lds + HY_LDS_Z))[tid] = 0u;
    bf16* revc = (bf16*)(lds + HC_LDS_REV);
    if (uvTc) {
        for (int e = tid; e < HC_NE + 8; e += NTHREADS) { const int n = e - HC_NOFF; float v = 0.f; if (n > 0 && n < LC) v = hb[S + n]; else if (n <= 0 && n > -LC) v = hf[S - n]; revc[e] = f2bf(v); }
        for (int i = tid; i < 8 * 32; i += NTHREADS) { const int bb = i >> 5, k = i & 31; *(u32x4*)(lds + HC_LDS_U + bb * HC_URS + k * 16) = *(const u32x4*)(uvTc + ((size_t)c * B + bb) * LC + k * 8); }
    }
    __syncthreads();
    if (uvTc) for (int i = tid; i < 8 * (HC_NE / 2); i += NTHREADS) { const int m = i / (HC_NE / 2), d = i % (HC_NE / 2); const unsigned lo = revc[2 * d + m], hi = revc[2 * d + 1 + m]; *(unsigned*)(lds + HC_LDS_C + m * HC_CS + d * 4) = lo | (hi << 16); }
    for (int i = tid; i < 8 * (HY_NE / 2); i += NTHREADS) {
        const int m = i / (HY_NE / 2), d = i % (HY_NE / 2);
        const unsigned lo = rev[2 * d + m], hi = rev[2 * d + 1 + m];
        *(unsigned*)(lds + m * HY_CS + d * 4) = lo | (hi << 16);
    }
    __syncthreads();
    f32x16 acc[2];
#pragma unroll
    for (int q = 0; q < 2; ++q)
#pragma unroll
        for (int r = 0; r < 16; ++r) acc[q][r] = 0.f;
    const int bb = fr >> 2, pp = fr & 3;
    const int m = (-fr) & 7;
    const char* abase = lds + m * HY_CS;
    const char* ubase = lds + HY_LDS_U + bb * HY_URS + fh * 16;
    auto hstep = [&](int dl, bool a0, bool a1) {
        const int n0 = 8 * fh - fr - 16 * dl;
        const bf16x8 af = *(const bf16x8*)(abase + (n0 - m + HY_NOFF) * 2);
        if (a0) { const int sj = 16 * wv - dl + 2 * pp; const char* up = (sj >= 0 && sj < 128) ? ubase + sj * 32 : lds + HY_LDS_Z;
            acc[0] = __builtin_amdgcn_mfma_f32_32x32x16_bf16(af, *(const bf16x8*)up, acc[0], 0, 0, 0); }
        if (a1) { const int sj = 16 * wv + 8 - dl + 2 * pp; const char* up = (sj >= 0 && sj < 128) ? ubase + sj * 32 : lds + HY_LDS_Z;
            acc[1] = __builtin_amdgcn_mfma_f32_32x32x16_bf16(af, *(const bf16x8*)up, acc[1], 0, 0, 0); }
    };
#pragma unroll
    for (int dl = 16 * wv - 127; dl < 16 * wv - 119; ++dl) hstep(dl, true, false);
#pragma unroll 6
    for (int dl = 16 * wv - 119; dl <= 16 * wv + 6; ++dl) hstep(dl, true, true);
#pragma unroll
    for (int dl = 16 * wv + 7; dl <= 16 * wv + 14; ++dl) hstep(dl, false, true);
    const float hbc = hbias[c];
#pragma unroll
    for (int qq = 0; qq < 2; ++qq) {
        const int tb = 32 * (4 * (2 * wv + qq) + pp) + 4 * fh;
#pragma unroll
        for (int g = 0; g < 4; ++g) {
            const int t = tb + 8 * g;
            const u32x2 uu = *(const u32x2*)(lds + HY_LDS_U + bb * HY_URS + t * 2);
            bf16* xp = x0T + ((size_t)c * B + bb) * S + t; const u32x2 xx = *(const u32x2*)xp;
            const float u0 = __uint_as_float(uu.x << 16), u1 = __uint_as_float(uu.x & 0xffff0000u), u2 = __uint_as_float(uu.y << 16), u3 = __uint_as_float(uu.y & 0xffff0000u);
            const float a0 = __uint_as_float(xx.x << 16), a1 = __uint_as_float(xx.x & 0xffff0000u), a2 = __uint_as_float(xx.y << 16), a3 = __uint_as_float(xx.y & 0xffff0000u);
            u32x2 o; o.x = pack_bf16(a0 * (acc[qq][4 * g] + hbc * u0), a1 * (acc[qq][4 * g + 1] + hbc * u1)); o.y = pack_bf16(a2 * (acc[qq][4 * g + 2] + hbc * u2), a3 * (acc[qq][4 * g + 3] + hbc * u3));
            *(u32x2*)xp = o;
        }
    }
    if (uvTc && wv < 2) {
        f32x16 ac;
#pragma unroll
        for (int r = 0; r < 16; ++r) ac[r] = 0.f;
        const char* cab = lds + HC_LDS_C + m * HC_CS; const char* cub = lds + HC_LDS_U + bb * HC_URS + fh * 16;
        for (int dl = 8 * wv - 15; dl <= 8 * wv + 6; ++dl) {
            const int n0 = 8 * fh - fr - 16 * dl;
            const bf16x8 af = *(const bf16x8*)(cab + (n0 - m + HC_NOFF) * 2);
            const int sj = 8 * wv - dl + 2 * pp; const char* up = (sj >= 0 && sj < 16) ? cub + sj * 32 : lds + HY_LDS_Z;
            ac = __builtin_amdgcn_mfma_f32_32x32x16_bf16(af, *(const bf16x8*)up, ac, 0, 0, 0);
        }
        const int tb = 32 * (4 * wv + pp) + 4 * fh;
#pragma unroll
        for (int g = 0; g < 4; ++g) {
            const int t = tb + 8 * g;
            const u32x2 uu = *(const u32x2*)(lds + HC_LDS_U + bb * HC_URS + t * 2);
            bf16* xp = x0Tc + ((size_t)c * B + bb) * LC + t; const u32x2 xx = *(const u32x2*)xp;
            const float u0 = __uint_as_float(uu.x << 16), u1 = __uint_as_float(uu.x & 0xffff0000u), u2 = __uint_as_float(uu.y << 16), u3 = __uint_as_float(uu.y & 0xffff0000u);
            const float a0 = __uint_as_float(xx.x << 16), a1 = __uint_as_float(xx.x & 0xffff0000u), a2 = __uint_as_float(xx.y << 16), a3 = __uint_as_float(xx.y & 0xffff0000u);
            u32x2 o; o.x = pack_bf16(a0 * (ac[4 * g] + hbc * u0), a1 * (ac[4 * g + 1] + hbc * u1)); o.y = pack_bf16(a2 * (ac[4 * g + 2] + hbc * u2), a3 * (ac[4 * g + 3] + hbc * u3));
            *(u32x2*)xp = o;
        }
    }
}
__device__ __forceinline__ void hy_filter_mlp(char* lds, const float* w1, const float* b1, const float* w2, const float* b2, const float* freq, bf16* f2b) {
    int tid = threadIdx.x; asm volatile("" : "+v"(tid));
    const int lane = tid & 63, wv = tid >> 6;
    float* zl = (float*)lds + wv * 128;
    __syncthreads();
    const float fj = freq[lane], b1j = b1[lane], b2j = b2[lane];
    for (int tt = blockIdx.x * 8 + wv; tt < S + LC; tt += gridDim.x * 8) {
        const int L = tt < S ? S : LC, t = tt < S ? tt : tt - S;
        if (lane < 33) {
            float z;
            if (lane == 0) z = (float)t / (float)(L - 1);
            else { const int bnd = (lane - 1) & 15; const float band = 1e-4f + (float)bnd * ((15.0f - 1e-4f) / 15.0f); const float ang = (6.283185307179586f / (float)L) * (float)t * band; z = lane <= 16 ? cosf(ang) : -sinf(ang); }
            zl[lane] = z;
        }
        __builtin_amdgcn_wave_barrier(); asm volatile("s_waitcnt lgkmcnt(0)" ::: "memory");
        float acc = 0.f;
#pragma unroll
        for (int i = 0; i < 33; ++i) acc += zl[i] * w1[i * 64 + lane];
        zl[64 + lane] = sinf(fj * (acc + b1j));
        __builtin_amdgcn_wave_barrier(); asm volatile("s_waitcnt lgkmcnt(0)" ::: "memory");
        float a2 = 0.f;
#pragma unroll 16
        for (int k = 0; k < 64; ++k) a2 += zl[64 + k] * w2[k * 64 + lane];
        f2b[(size_t)tt * 64 + lane] = f2bf(sinf(fj * (a2 + b2j)));
        __builtin_amdgcn_wave_barrier(); asm volatile("s_waitcnt lgkmcnt(0)" ::: "memory");
    }
}
__device__ __forceinline__ void hy_filter_out(const bf16* w3T  , const bf16* f2b  , float* filt  ) {
    int tid = threadIdx.x; asm volatile("" : "+v"(tid));
    const int lane = tid & 63, wv = tid >> 6, fr = lane & 31, fh = lane >> 5;
    constexpr int NTT = (S + LC) / 32;
    for (int it = blockIdx.x * 8 + wv; it < 16 * NTT; it += gridDim.x * 8) {
        const int ct = it / NTT, tt0 = (it % NTT) * 32;
        f32x16 acc;
#pragma unroll
        for (int r = 0; r < 16; ++r) acc[r] = 0.f;
#pragma unroll
        for (int ks = 0; ks < 4; ++ks) {
            const bf16x8 fa = *(const bf16x8*)(w3T + (size_t)(ct * 32 + fr) * 64 + ks * 16 + fh * 8), fb = *(const bf16x8*)(f2b + (size_t)(tt0 + fr) * 64 + ks * 16 + fh * 8);
            acc = __builtin_amdgcn_mfma_f32_32x32x16_bf16(fa, fb, acc, 0, 0, 0);
        }
        const int tt = tt0 + fr; const int L = tt < S ? S : LC; const float tn = (float)(tt < S ? tt : tt - S) / (float)(L - 1);
#pragma unroll
        for (int r = 0; r < 16; ++r) {
            const int c = ct * 32 + (r & 3) + 8 * (r >> 2) + 4 * fh; const int cc = c & 255;
            const float decay = HY_DECAY_MIN + (float)cc * ((HY_DECAY_MAX - HY_DECAY_MIN) / 255.0f);
            filt[(size_t)c * (S + LC) + tt] = acc[r] * __expf(-tn * decay);
        }
    }
}
__device__ __forceinline__ void hy_fin_item(char* lds, const bf16* yT, bf16* ycat, int b, int ch, bool ctx = false) {
    int tid = threadIdx.x; asm volatile("" : "+v"(tid));
    bf16* ly = (bf16*)lds;
    __syncthreads();
    for (int i = tid; i < 2048; i += NTHREADS) {
        const int c = i >> 3, k = i & 7;
        const u32x4 v = *(const u32x4*)(yT + ((size_t)c * B + b) * (ctx ? LC : S) + ch * 64 + k * 8);
#pragma unroll
        for (int q = 0; q < 4; ++q) { ly[(k * 8 + 2 * q) * 264 + c] = (bf16)(v[q] & 0xffffu); ly[(k * 8 + 2 * q + 1) * 264 + c] = (bf16)(v[q] >> 16); }
    }
    __syncthreads();
    for (int i = tid; i < 2048; i += NTHREADS) {
        const int t = i >> 5, k = i & 31;
        *(u32x4*)(ycat + ((ctx ? (size_t)TL + (size_t)b * LC : (size_t)b * S) + ch * 64 + t) * 1024 + k * 8) = *(const u32x4*)(ly + t * 264 + k * 8);
    }
}
#endif
#ifndef HOST_SIM
constexpr int GD_NC = 36;
__device__ __forceinline__ size_t gd_tok0(int b, int cc) { return cc < 4 ? (size_t)TL + (size_t)b * LC + cc * 64 : (size_t)b * S + (size_t)(cc - 4) * 64; }

constexpr int GP_K = 0, GP_V = 8192, GP_L0 = 16384, GP_T0 = GP_L0 + 2 * 16384, GP_VB0 = GP_T0 + 2 * 8192  , GP_G = GP_VB0 + 2 * 8192  ,
              GP_SM = GP_VB0 + 4 * 8192  , GP_LB = GP_SM + 6 * 256  , GP_END = GP_LB + 2 * 2048;

__device__ __forceinline__ void gdn_pre_item(char* lds, const WS& w, const float* cw  , const float* a_log, const float* dt_bias, int b, int cc, int h) {
    int tid = threadIdx.x; asm volatile("" : "+v"(tid));
    const int lane = tid & 63, wv = tid >> 6, fr = lane & 31, fh = lane >> 5;
    const bf16* p = w.p;
    const int L = cc < 4 ? LC : S; const int tin0 = cc < 4 ? cc * 64 : (cc - 4) * 64; const size_t tok0 = gd_tok0(b, cc);
    float* sm = (float*)(lds + GP_SM);
    __syncthreads();
    {
        const int tl = tid >> 3, dg = tid & 7;
        float q8[8], k8[8], v8[8];
#pragma unroll
        for (int x = 0; x < 8; ++x) { q8[x] = 0.f; k8[x] = 0.f; v8[x] = 0.f; }
#pragma unroll
        for (int i = 0; i < 4; ++i) {
            const int tt = tin0 + tl + i - 2;
            if (tt < 0 || tt >= L) continue;
            const bf16* r = p + (tok0 + tl + i - 2) * DIN + O3 + h * 64 + dg * 8;
            const u32x4 a = *(const u32x4*)r, bq = *(const u32x4*)(r + 256), cq = *(const u32x4*)(r + 512);
            const float* wq = cw + i * 768 + h * 64 + dg * 8;
#pragma unroll
            for (int x = 0; x < 4; ++x) {
                q8[2 * x] += wq[2 * x] * __uint_as_float(a[x] << 16); q8[2 * x + 1] += wq[2 * x + 1] * __uint_as_float(a[x] & 0xffff0000u);
                k8[2 * x] += wq[256 + 2 * x] * __uint_as_float(bq[x] << 16); k8[2 * x + 1] += wq[256 + 2 * x + 1] * __uint_as_float(bq[x] & 0xffff0000u);
                v8[2 * x] += wq[512 + 2 * x] * __uint_as_float(cq[x] << 16); v8[2 * x + 1] += wq[512 + 2 * x + 1] * __uint_as_float(cq[x] & 0xffff0000u);
            }
        }
        float sq = 0.f, sk = 0.f;
#pragma unroll
        for (int x = 0; x < 8; ++x) { q8[x] = q8[x] / (1.0f + __expf(-q8[x])); k8[x] = k8[x] / (1.0f + __expf(-k8[x])); v8[x] = v8[x] / (1.0f + __expf(-v8[x])); sq += q8[x] * q8[x]; sk += k8[x] * k8[x]; }
        sq += __shfl_xor(sq, 1); sq += __shfl_xor(sq, 2); sq += __shfl_xor(sq, 4);
        sk += __shfl_xor(sk, 1); sk += __shfl_xor(sk, 2); sk += __shfl_xor(sk, 4);
        const float rq = 0.125f / sqrtf(sq + EPS), rk = 1.0f / sqrtf(sk + EPS);
        u32x4 qo, ko, vo;
#pragma unroll
        for (int x = 0; x < 4; ++x) { qo[x] = pack_bf16(q8[2 * x] * rq, q8[2 * x + 1] * rq); ko[x] = pack_bf16(k8[2 * x] * rk, k8[2 * x + 1] * rk); vo[x] = pack_bf16(v8[2 * x], v8[2 * x + 1]); }
        bf16* qkg = w.qk + ((size_t)((b * 4 + h) * GD_NC + cc) * 2) * 4096;
        *(u32x4*)(qkg + tl * 64 + dg * 8) = qo; *(u32x4*)(qkg + 4096 + tl * 64 + dg * 8) = ko;
        *(u32x4*)(lds + GP_K + g_lds_off(tl, dg)) = ko;
        *(u32x4*)(lds + GP_V + at_voff(tl, dg * 8)) = vo;
        if (tid < 128) {
            const int dir = tid >> 6, t = tid & 63; const bf16* r = p + (tok0 + t) * DIN + O3 + 1024 + dir * 4 + h;
            const float a = bf2f(r[0]), bbv = bf2f(r[8]); const float x = a + dt_bias[dir * 4 + h]; const float sp = x > 15.f ? x : __logf(1.0f + __expf(x));
            sm[dir * 64 + t] = -__expf(a_log[dir * 4 + h]) * sp; sm[128 + dir * 64 + t] = 1.0f / (1.0f + __expf(-bbv));
        }
    }
    __syncthreads();
    if (wv < 4) {
        const int ta = wv >> 1, tb = wv & 1; f32x16 g;
#pragma unroll
        for (int r = 0; r < 16; ++r) g[r] = 0.f;
#pragma unroll
        for (int ks = 0; ks < 4; ++ks) {
            const bf16x8 fa = *(const bf16x8*)(lds + GP_K + g_lds_off(32 * ta + fr, ks * 2 + fh)), fb = *(const bf16x8*)(lds + GP_K + g_lds_off(32 * tb + fr, ks * 2 + fh));
            g = __builtin_amdgcn_mfma_f32_32x32x16_bf16(fa, fb, g, 0, 0, 0);
        }
        float* G = (float*)(lds + GP_G);
#pragma unroll
        for (int r = 0; r < 16; ++r) G[(32 * ta + (r & 3) + 8 * (r >> 2) + 4 * fh) * 64 + 32 * tb + fr] = g[r];
    } else if (wv < 6) {
        const int dir = wv - 4; float v = sm[dir * 64 + (dir ? 63 - lane : lane)];
#pragma unroll
        for (int o = 1; o < 64; o <<= 1) { const float t = __shfl_up(v, o); if (lane >= o) v += t; }
        sm[256 + dir * 64 + lane] = v;
        float* gcg = w.gc + ((size_t)((b * 4 + h) * 2 + dir) * GD_NC + cc) * 64; gcg[lane] = v;
    }
    __syncthreads();
    const int dir = wv >> 2, t4 = tid & 255;
    {
        const float* G = (const float*)(lds + GP_G); float* Lm = (float*)(lds + GP_L0 + dir * 16384);
        for (int e = t4; e < 4096; e += 256) {
            const int i = e >> 6, j = e & 63; const int ti = dir ? 63 - i : i, tj = dir ? 63 - j : j;
            const float lv = j < i ? sm[128 + dir * 64 + ti] * G[ti * 64 + tj] * __expf(sm[256 + dir * 64 + i] - sm[256 + dir * 64 + j]) : 0.f;
            Lm[e] = lv;
            if (i >= 32 && j < 32) ((bf16*)(lds + GP_LB + dir * 2048))[(i - 32) * 32 + j] = f2bf(lv);
        }
    }
    __syncthreads();
    if ((__builtin_amdgcn_readfirstlane(wv) & 3) == 0) {
        const float* Lm = (const float*)(lds + GP_L0 + dir * 16384);
        char* Tm = lds + GP_T0 + dir * 8192;
        const int blk = lane >> 5, c = lane & 31;
        const LAS float* Lb = (const LAS float*)(Lm + (32 * blk) * 64 + 32 * blk);
        float Tc[32];
#pragma unroll
        for (int i = 0; i < 32; ++i) {
            const LAS float* Lr = Lb + i * 64;
            if (i >= 2) asm volatile("" : "+v"(Lr) : "v"(Tc[i - 2]));
            float a0 = (c == i) ? 1.0f : 0.f, a1 = 0.f, a2 = 0.f, a3 = 0.f;
#pragma unroll
            for (int j4 = 0; j4 < (i & ~3); j4 += 4) {
                const f32x4 l4 = *(const LAS f32x4*)(Lr + j4);
                a0 -= l4[0] * Tc[j4]; a1 -= l4[1] * Tc[j4 + 1]; a2 -= l4[2] * Tc[j4 + 2]; a3 -= l4[3] * Tc[j4 + 3];
            }
#pragma unroll
            for (int j = (i & ~3); j < i; ++j) a0 -= Lr[j] * Tc[j];
            Tc[i] = (a0 + a1) + (a2 + a3);
        }
        {
            int rb = 32 * blk; const int cb = (32 * blk + c) >> 3, cz = (32 * (1 - blk) + c) >> 3, co = (c & 7) * 2;
#pragma unroll
            for (int i = 0; i < 32; ++i) {
                asm volatile("" : "+v"(rb));
                const int row = rb + i, sw = (row >> 1) & 7;
                *(bf16*)(Tm + row * 128 + ((cb ^ sw) << 4) + co) = f2bf(Tc[i]);
                if (blk == 0) *(bf16*)(Tm + row * 128 + ((cz ^ sw) << 4) + co) = (bf16)0;
            }
        }
        asm volatile("s_waitcnt lgkmcnt(0)" ::: "memory");
        const char* Lq = lds + GP_LB + dir * 2048;
        f32x16 X;
#pragma unroll
        for (int r = 0; r < 16; ++r) X[r] = 0.f;
        const int i16 = lane & 15, g1 = (lane >> 4) & 1;
#pragma unroll
        for (int ks = 0; ks < 2; ++ks) {
            const bf16x8 fa = *(const bf16x8*)(Lq + fr * 64 + (ks * 2 + fh) * 16);
            const int jr = 16 * ks + 8 * fh + (i16 >> 2), dc = 16 * g1 + 4 * (i16 & 3);
            const s16x4 t0 = __builtin_amdgcn_ds_read_tr16_b64_v4i16((LAS s16x4*)(Tm + g_lds_off(jr, dc >> 3) + (dc & 7) * 2));
            const s16x4 t1 = __builtin_amdgcn_ds_read_tr16_b64_v4i16((LAS s16x4*)(Tm + g_lds_off(jr + 4, dc >> 3) + (dc & 7) * 2));
            bf16x8 fb; fb[0] = t0[0]; fb[1] = t0[1]; fb[2] = t0[2]; fb[3] = t0[3]; fb[4] = t1[0]; fb[5] = t1[1]; fb[6] = t1[2]; fb[7] = t1[3];
            X = __builtin_amdgcn_mfma_f32_32x32x16_bf16(fa, fb, X, 0, 0, 0);
        }
        f32x16 Y;
#pragma unroll
        for (int r = 0; r < 16; ++r) Y[r] = 0.f;
#pragma unroll
        for (int ks = 0; ks < 2; ++ks) {
            union { bf16x8 v; unsigned u[4]; } xb;
#pragma unroll
            for (int j = 0; j < 4; ++j) xb.u[j] = pack_bf16(X[8 * ks + 2 * j], X[8 * ks + 2 * j + 1]);
            const int c0 = 32 + 16 * ks + 4 * fh, c1 = c0 + 8;
            const u32x2 p0 = *(const u32x2*)(Tm + g_lds_off(32 + fr, c0 >> 3) + (c0 & 7) * 2), p1 = *(const u32x2*)(Tm + g_lds_off(32 + fr, c1 >> 3) + (c1 & 7) * 2);
            union { bf16x8 v; unsigned u[4]; } ta_; ta_.u[0] = p0.x; ta_.u[1] = p0.y; ta_.u[2] = p1.x; ta_.u[3] = p1.y;
            Y = __builtin_amdgcn_mfma_f32_32x32x16_bf16(ta_.v, xb.v, Y, 0, 0, 0);
        }
#pragma unroll
        for (int r = 0; r < 16; ++r) { const int row = 32 + (r & 3) + 8 * (r >> 2) + 4 * fh; *(bf16*)(Tm + g_lds_off(row, fr >> 3) + (fr & 7) * 2) = f2bf(-Y[r]); }
    } else {
        const int t3 = t4 - 64;
        for (int e = t3; e < 1024; e += 192) {
            const int mat = e >> 9, j = (e >> 3) & 63, c8 = e & 7; const int tj = dir ? 63 - j : j;
            const float sc = sm[128 + dir * 64 + tj] * (mat ? __expf(sm[256 + dir * 64 + j]) : 1.0f);
            const u32x4 src = mat ? *(const u32x4*)(lds + GP_K + g_lds_off(tj, c8)) : *(const u32x4*)(lds + GP_V + at_voff(tj, c8 * 8));
            u32x4 d;
#pragma unroll
            for (int x = 0; x < 4; ++x) d[x] = pack_bf16(sc * __uint_as_float(src[x] << 16), sc * __uint_as_float(src[x] & 0xffff0000u));
            *(u32x4*)(lds + GP_VB0 + (dir * 2 + mat) * 8192 + at_voff(j, c8 * 8)) = d;
        }
    }
    __syncthreads();
    {
        const int w4 = wv & 3, ta = w4 >> 1, tb = w4 & 1; const int i16 = lane & 15, g1 = (lane >> 4) & 1;
        const char* Tm = lds + GP_T0 + dir * 8192; const char* vb = lds + GP_VB0 + (dir * 2) * 8192; const char* kbe = vb + 8192;
        f32x16 aw, au;
#pragma unroll
        for (int r = 0; r < 16; ++r) { aw[r] = 0.f; au[r] = 0.f; }
#pragma unroll
        for (int ks = 0; ks < 4; ++ks) {
            const int jr = 16 * ks + 8 * fh + (i16 >> 2), dc = 32 * ta + 16 * g1 + 4 * (i16 & 3);
            const s16x4 k0 = __builtin_amdgcn_ds_read_tr16_b64_v4i16((LAS s16x4*)(kbe + at_voff(jr, dc))), k1 = __builtin_amdgcn_ds_read_tr16_b64_v4i16((LAS s16x4*)(kbe + at_voff(jr + 4, dc)));
            bf16x8 fa; fa[0] = k0[0]; fa[1] = k0[1]; fa[2] = k0[2]; fa[3] = k0[3]; fa[4] = k1[0]; fa[5] = k1[1]; fa[6] = k1[2]; fa[7] = k1[3];
            const bf16x8 fbT = *(const bf16x8*)(Tm + g_lds_off(32 * tb + fr, ks * 2 + fh));
            aw = __builtin_amdgcn_mfma_f32_32x32x16_bf16(fa, fbT, aw, 0, 0, 0);
            const bf16x8 faT = *(const bf16x8*)(Tm + g_lds_off(32 * ta + fr, ks * 2 + fh));
            const int dc2 = 32 * tb + 16 * g1 + 4 * (i16 & 3);
            const s16x4 v0 = __builtin_amdgcn_ds_read_tr16_b64_v4i16((LAS s16x4*)(vb + at_voff(jr, dc2))), v1 = __builtin_amdgcn_ds_read_tr16_b64_v4i16((LAS s16x4*)(vb + at_voff(jr + 4, dc2)));
            bf16x8 fv; fv[0] = v0[0]; fv[1] = v0[1]; fv[2] = v0[2]; fv[3] = v0[3]; fv[4] = v1[0]; fv[5] = v1[1]; fv[6] = v1[2]; fv[7] = v1[3];
            au = __builtin_amdgcn_mfma_f32_32x32x16_bf16(faT, fv, au, 0, 0, 0);
        }
        bf16* uwg = w.uw + ((size_t)(((b * 4 + h) * 2 + dir) * GD_NC + cc) * 2) * 4096;
#pragma unroll
        for (int g = 0; g < 4; ++g) {
            const int rr = 32 * ta + 8 * g + 4 * fh;
            u32x2 o1; o1.x = pack_bf16(-aw[4 * g], -aw[4 * g + 1]); o1.y = pack_bf16(-aw[4 * g + 2], -aw[4 * g + 3]);
            *(u32x2*)(uwg + (32 * tb + fr) * 64 + rr) = o1;
            u32x2 o2; o2.x = pack_bf16(au[4 * g], au[4 * g + 1]); o2.y = pack_bf16(au[4 * g + 2], au[4 * g + 3]);
            *(u32x2*)(uwg + 4096 + (32 * tb + fr) * 64 + rr) = o2;
        }
    }
}
#endif
#ifndef HOST_SIM
constexpr int GS_IN = 0  , GS_ST = 65536  , GS_U1 = GS_ST + 16384, GS_U2 = GS_U1 + 8192, GS_AT = GS_U2 + 8192,
              GS_TB = GS_AT + 8192  , GS_END = GS_TB + 2 * 1024;
__device__ __forceinline__ int gd_chunk_of_step(int dir, int n) { return dir ? (n < 4 ? 3 - n : 39 - n) : n; }

__device__ __forceinline__ void gdn_scan_chain(char* lds, const WS& w, int b, int h, int dir, bool emit_ctx) {
    int tid = threadIdx.x; asm volatile("" : "+v"(tid));
    const int lane = tid & 63, wv = tid >> 6, fr = lane & 31, fh = lane >> 5, w4 = wv & 3, ta = w4 >> 1, tb = w4 & 1;
    const int i16 = lane & 15, g1 = (lane >> 4) & 1;
    const bool lo = wv < 4;
    const size_t chain = (size_t)((b * 4 + h) * 2 + dir) * GD_NC;
    const bf16* qkb = w.qk + (size_t)(b * 4 + h) * GD_NC * 2 * 4096;
    bf16* uwb = w.uw + chain * 2 * 4096; const float* gcb = w.gc + chain * 64;
    const int lrow = tid >> 3, lch = tid & 7;
    const int qrow = dir ? 63 - lrow : lrow;
    __syncthreads();
    *(u32x4*)(lds + GS_ST + tid * 16) = (u32x4){0u, 0u, 0u, 0u};
    f32x16 Sacc;
#pragma unroll
    for (int r = 0; r < 16; ++r) Sacc[r] = 0.f;
    struct Pre { u32x4 rw, rq, rk; float rg; u32x2 uc[4]; };
    Pre pa, pb, pc;
    auto prefetch = [&](int n, Pre& r) {
        const int cc = gd_chunk_of_step(dir, n);
        const bf16* uwp = uwb + (size_t)cc * 2 * 4096; const bf16* qkp = qkb + (size_t)cc * 2 * 4096;
        r.rw = *(const u32x4*)(uwp + lrow * 64 + lch * 8);
        r.rq = *(const u32x4*)(qkp + lrow * 64 + lch * 8); r.rk = *(const u32x4*)(qkp + 4096 + lrow * 64 + lch * 8);
        r.rg = 0.f; if (tid < 64) r.rg = gcb[(size_t)cc * 64 + tid];
        if (lo) { const bf16* up = uwp + 4096 + (32 * tb + fr) * 64 + 32 * ta + 4 * fh;
#pragma unroll
            for (int g = 0; g < 4; ++g) r.uc[g] = *(const u32x2*)(up + 8 * g); }
    };
    auto stage = [&](int buf, const Pre& r) {
        char* ib = lds + GS_IN + buf * 32768;
        *(u32x4*)(ib + g_lds_off(lrow, lch)) = r.rw;
        *(u32x4*)(ib + 8192 + g_lds_off(qrow, lch)) = r.rq;
        *(u32x4*)(ib + 16384 + g_lds_off(qrow, lch)) = r.rk;
        *(u32x4*)(ib + 24576 + at_voff(qrow, lch * 8)) = r.rk;
        float* tbp = (float*)(lds + GS_TB + buf * 1024);
        if (tid < 64) { const float g63 = __shfl(r.rg, 63); tbp[tid] = r.rg; tbp[64 + tid] = __expf(r.rg); tbp[128 + tid] = __expf(g63 - r.rg); if (tid == 0) tbp[192] = __expf(g63); }
    };
    auto step = [&](int n, Pre& cur, const Pre& nx) {
        const int buf = n & 1; const char* ib = lds + GS_IN + buf * 32768; const float* tbp = (const float*)(lds + GS_TB + buf * 1024);
        const char* St = lds + GS_ST + buf * 8192; char* Stn = lds + GS_ST + (buf ^ 1) * 8192;
        const int cc = gd_chunk_of_step(dir, n);
        if (lo) {
            f32x16 acc;
#pragma unroll
            for (int g = 0; g < 4; ++g) { acc[4 * g] = __uint_as_float(cur.uc[g].x << 16); acc[4 * g + 1] = __uint_as_float(cur.uc[g].x & 0xffff0000u); acc[4 * g + 2] = __uint_as_float(cur.uc[g].y << 16); acc[4 * g + 3] = __uint_as_float(cur.uc[g].y & 0xffff0000u); }
#pragma unroll
            for (int ks = 0; ks < 4; ++ks) {
                const bf16x8 fa = *(const bf16x8*)(ib + g_lds_off(32 * ta + fr, ks * 2 + fh)), fb = *(const bf16x8*)(St + g_lds_off(32 * tb + fr, ks * 2 + fh));
                acc = __builtin_amdgcn_mfma_f32_32x32x16_bf16(fa, fb, acc, 0, 0, 0);
            }
#pragma unroll
            for (int g = 0; g < 4; ++g) {
                const int i0 = 32 * ta + 8 * g + 4 * fh; const f32x4 fc = *(const f32x4*)(tbp + 128 + i0);
                u32x2 o1; o1.x = pack_bf16(acc[4 * g], acc[4 * g + 1]); o1.y = pack_bf16(acc[4 * g + 2], acc[4 * g + 3]);
                u32x2 o2; o2.x = pack_bf16(acc[4 * g] * fc[0], acc[4 * g + 1] * fc[1]); o2.y = pack_bf16(acc[4 * g + 2] * fc[2], acc[4 * g + 3] * fc[3]);
                const int off = g_lds_off(32 * tb + fr, i0 >> 3) + (i0 & 7) * 2;
                *(u32x2*)(lds + GS_U1 + off) = o1; *(u32x2*)(lds + GS_U2 + off) = o2;
            }
        } else {
            f32x16 acc;
#pragma unroll
            for (int r = 0; r < 16; ++r) acc[r] = 0.f;
#pragma unroll
            for (int ks = 0; ks < 4; ++ks) {
                const bf16x8 fa = *(const bf16x8*)(ib + 16384 + g_lds_off(32 * ta + fr, ks * 2 + fh)), fb = *(const bf16x8*)(ib + 8192 + g_lds_off(32 * tb + fr, ks * 2 + fh));
                acc = __builtin_amdgcn_mfma_f32_32x32x16_bf16(fa, fb, acc, 0, 0, 0);
            }
            const int i = 32 * tb + fr; const float gi = tbp[i];
#pragma unroll
            for (int g = 0; g < 4; ++g) {
                const int j0 = 32 * ta + 8 * g + 4 * fh; const f32x4 gj = *(const f32x4*)(tbp + j0);
                float v[4];
#pragma unroll
                for (int x = 0; x < 4; ++x) v[x] = (j0 + x <= i) ? acc[4 * g + x] * __expf(gi - gj[x]) : 0.f;
                u32x2 o; o.x = pack_bf16(v[0], v[1]); o.y = pack_bf16(v[2], v[3]);
                *(u32x2*)(lds + GS_AT + g_lds_off(i, j0 >> 3) + (j0 & 7) * 2) = o;
            }
        }
        __syncthreads();
        if (lo) {
            if (cc >= 4 || emit_ctx) {
                f32x16 acc, acc2;
#pragma unroll
                for (int r = 0; r < 16; ++r) { acc[r] = 0.f; acc2[r] = 0.f; }
#pragma unroll
                for (int ks = 0; ks < 4; ++ks) {
                    const bf16x8 fa = *(const bf16x8*)(ib + 8192 + g_lds_off(32 * ta + fr, ks * 2 + fh)), fb = *(const bf16x8*)(St + g_lds_off(32 * tb + fr, ks * 2 + fh));
                    acc = __builtin_amdgcn_mfma_f32_32x32x16_bf16(fa, fb, acc, 0, 0, 0);
                    const bf16x8 fa2 = *(const bf16x8*)(lds + GS_AT + g_lds_off(32 * ta + fr, ks * 2 + fh)), fb2 = *(const bf16x8*)(lds + GS_U1 + g_lds_off(32 * tb + fr, ks * 2 + fh));
                    acc2 = __builtin_amdgcn_mfma_f32_32x32x16_bf16(fa2, fb2, acc2, 0, 0, 0);
                }
                bf16* op = uwb + (size_t)cc * 2 * 4096 + 4096 + (32 * tb + fr) * 64 + 32 * ta + 4 * fh;
#pragma unroll
                for (int g = 0; g < 4; ++g) {
                    const f32x4 eg = *(const f32x4*)(tbp + 64 + 32 * ta + 8 * g + 4 * fh);
                    u32x2 o; o.x = pack_bf16(acc[4 * g] * eg[0] + acc2[4 * g], acc[4 * g + 1] * eg[1] + acc2[4 * g + 1]); o.y = pack_bf16(acc[4 * g + 2] * eg[2] + acc2[4 * g + 2], acc[4 * g + 3] * eg[3] + acc2[4 * g + 3]);
                    *(u32x2*)(op + 8 * g) = o;
                }
            }
        } else {
            const float e63 = tbp[192];
#pragma unroll
            for (int r = 0; r < 16; ++r) Sacc[r] *= e63;
#pragma unroll
            for (int ks = 0; ks < 4; ++ks) {
                const int ir = 16 * ks + 8 * fh + (i16 >> 2), dc = 32 * ta + 16 * g1 + 4 * (i16 & 3);
                const s16x4 k0 = __builtin_amdgcn_ds_read_tr16_b64_v4i16((LAS s16x4*)(ib + 24576 + at_voff(ir, dc))), k1 = __builtin_amdgcn_ds_read_tr16_b64_v4i16((LAS s16x4*)(ib + 24576 + at_voff(ir + 4, dc)));
                bf16x8 fa; fa[0] = k0[0]; fa[1] = k0[1]; fa[2] = k0[2]; fa[3] = k0[3]; fa[4] = k1[0]; fa[5] = k1[1]; fa[6] = k1[2]; fa[7] = k1[3];
                const bf16x8 fb = *(const bf16x8*)(lds + GS_U2 + g_lds_off(32 * tb + fr, ks * 2 + fh));
                Sacc = __builtin_amdgcn_mfma_f32_32x32x16_bf16(fa, fb, Sacc, 0, 0, 0);
            }
#pragma unroll
            for (int g = 0; g < 4; ++g) {
                const int d0 = 32 * ta + 8 * g + 4 * fh; u32x2 o; o.x = pack_bf16(Sacc[4 * g], Sacc[4 * g + 1]); o.y = pack_bf16(Sacc[4 * g + 2], Sacc[4 * g + 3]);
                *(u32x2*)(Stn + g_lds_off(32 * tb + fr, d0 >> 3) + (d0 & 7) * 2) = o;
            }
        }
        if (n + 1 < GD_NC) stage(buf ^ 1, nx);
        if (n + 3 < GD_NC) prefetch(n + 3, cur);
        __syncthreads();
    };
    prefetch(0, pa); prefetch(1, pb); prefetch(2, pc);
    stage(0, pa);
    __syncthreads();
    for (int n = 0; n < GD_NC; n += 3) { step(n, pa, pb); step(n + 1, pb, pc); step(n + 2, pc, pa); }
}

__device__ __forceinline__ void gdn_fin_item(char* lds, const WS& w, const float* ng, int b, int cc, int h) {
    int tid = threadIdx.x; asm volatile("" : "+v"(tid));
    bf16* lo_ = (bf16*)lds;
    __syncthreads();
    for (int i = tid; i < 1024; i += NTHREADS) {
        const int dir = i >> 9, dv = (i >> 3) & 63, k = i & 7;
        const bf16* src = w.uw + ((size_t)(((b * 4 + h) * 2 + dir) * GD_NC + cc) * 2 + 1) * 4096 + dv * 64 + k * 8;
        *(u32x4*)(lo_ + (dir * 64 + dv) * 72 + k * 8) = *(const u32x4*)src;
    }
    __syncthreads();
    const int tl = tid >> 3, dg = tid & 7; const size_t tok = gd_tok0(b, cc) + tl;
    float o[8]; float ss = 0.f;
#pragma unroll
    for (int x = 0; x < 8; ++x) { const int dv = dg * 8 + x; o[x] = bf2f(lo_[dv * 72 + tl]) + bf2f(lo_[(64 + dv) * 72 + 63 - tl]); ss += o[x] * o[x]; }
    ss += __shfl_xor(ss, 1); ss += __shfl_xor(ss, 2); ss += __shfl_xor(ss, 4);
    const float rs = 1.0f / sqrtf(ss * (1.0f / 64.0f) + EPS);
    const u32x4 gt = *(const u32x4*)(w.p + tok * DIN + O3 + 768 + h * 64 + dg * 8);
    u32x4 out;
#pragma unroll
    for (int x = 0; x < 4; ++x) {
        const float g0 = __uint_as_float(gt[x] << 16), g1v = __uint_as_float(gt[x] & 0xffff0000u);
        const float y0 = o[2 * x] * rs * ng[dg * 8 + 2 * x] * (g0 / (1.0f + __expf(-g0))), y1 = o[2 * x + 1] * rs * ng[dg * 8 + 2 * x + 1] * (g1v / (1.0f + __expf(-g1v)));
        out[x] = pack_bf16(y0, y1);
    }
    *(u32x4*)(w.ycat + tok * 1024 + 768 + h * 64 + dg * 8) = out;
}
#endif
#ifndef HOST_SIM
#ifndef XD
#define XD 0
#endif
namespace cg = cooperative_groups;
struct MP { Inputs in; float* out; WS w; };

template <class F> __device__ __forceinline__ void dev_run(const F& f, long n) {
    int t0 = threadIdx.x; asm volatile("" : "+v"(t0));
    for (long i = (long)blockIdx.x * NTHREADS + t0; i < n; i += (long)gridDim.x * NTHREADS) f(i);
}

struct TLInProj {
    const bf16* A; const bf16* Bt; EpiInProj e; static constexpr int K = 1024;
    struct Tile { int m0, n0; };
    __device__ __forceinline__ bool tile(int idx, Tile& t) const {
        constexpr int MT = T / GBM, NT = (DIN + GBN - 1) / GBN;
        if (idx >= MT * NT) return false;
        const int mg = idx / (8 * NT), rem = idx % (8 * NT); t.n0 = (rem / 8) * GBN; t.m0 = (mg * 8 + (rem & 7)) * GBM; return true;
    }
    __device__ __forceinline__ const bf16* arow(const Tile& t, int r) const { return A + (size_t)(t.m0 + r) * D; }
    __device__ __forceinline__ const bf16* brow(const Tile& t, int r) const { return Bt + (size_t)(t.n0 + (r & 64) + perm64(r & 63)) * 1024; }
    __device__ __forceinline__ void epi(const Tile& t, f32x16 (&acc)[2][2], int mr, int nc) const { e(acc, t.m0 + mr, t.n0 + nc); }
};
struct TLOutProj {
    const bf16* A; const bf16* Bt; EpiOutProj e; int ntiles; static constexpr int K = 1024;
    struct Tile { int m0, n0; };
    __device__ __forceinline__ bool tile(int idx, Tile& t) const { if (idx >= ntiles) return false; t.m0 = (idx >> 3) * GBM; t.n0 = (idx & 7) * GBN; return true; }
    __device__ __forceinline__ const bf16* arow(const Tile& t, int r) const { return A + (size_t)(t.m0 + r) * 1024; }
    __device__ __forceinline__ const bf16* brow(const Tile& t, int r) const { return Bt + (size_t)(t.n0 + r) * 1024; }
    __device__ __forceinline__ void epi(const Tile& t, f32x16 (&acc)[2][2], int mr, int nc) const { e(acc, t.m0 + mr, t.n0 + nc); }
};
__device__ __forceinline__ void phase_inproj(char* lds, const WS& w, int l) {
    gemm_stream(lds, TLInProj{l == 0 ? w.h : w.hid2, w.winT + (size_t)l * 3328 * 1024, EpiInProj{w.p, w.rope}});
}
__device__ __forceinline__ void phase_outproj(char* lds, const WS& w, int l, const float* mod, int ntok, const float* xin, const float* cin) {
    gemm_stream(lds, TLOutProj{w.ycat, w.woutT + (size_t)l * 1024 * 1024, EpiOutProj{w.xr, mod, l == 0 ? xin : nullptr, cin}, (ntok / GBM) * 8});
}
struct EpiStoreP { bf16* p;
    __device__ __forceinline__ void operator()(f32x16 (&acc)[2][2], int mrow, int ncol) const {
#pragma unroll
        for (int mi = 0; mi < 2; ++mi)
#pragma unroll
            for (int ni = 0; ni < 2; ++ni)
#pragma unroll
                for (int g = 0; g < 4; ++g) { u32x2 v; v.x = pack_bf16(acc[mi][ni][4 * g], acc[mi][ni][4 * g + 1]); v.y = pack_bf16(acc[mi][ni][4 * g + 2], acc[mi][ni][4 * g + 3]);
                    *(u32x2*)(p + (size_t)(mrow + mi * 32) * 1024 + ncol + ni * 32 + 8 * g) = v; }
    } };
__device__ __forceinline__ void phase_outproj_dup(char* lds, const WS& w, int l, int ntok) {
    const int MT = ntok / GBM, NT = D / GBN;
    const bf16* Bt = w.woutT + (size_t)l * 1024 * 1024;
    for (int tile = blockIdx.x; tile < MT * NT; tile += gridDim.x) {
        const int mt = tile / NT, nt = tile % NT;
        gemm_tile(lds, ARowDense{w.ycat, 1024, mt * GBM}, Bt, 1024, 1024, mt * GBM, nt * GBN, EpiStoreP{w.p});
    }
}
__device__ __forceinline__ int q_next(int* head, int* slot  ) {
    __syncthreads();
    if (threadIdx.x == 0) *slot = __hip_atomic_fetch_add(head, 1, __ATOMIC_RELAXED, __HIP_MEMORY_SCOPE_AGENT);
    __syncthreads();
    return *slot;
}
__global__ void __launch_bounds__(NTHREADS) mega_kernel(MP mp) {
    extern __shared__ __attribute__((aligned(16))) char lds[];
    __shared__ uint4 xb_words;
    __shared__ int q_slot[4];
    cg::grid_group grid = cg::this_grid();
    const Inputs& in = mp.in; const WS& w = mp.w;
    if (threadIdx.x == 0) xb_words = make_uint4(0u, 0u, 0u, 0u);
    __syncthreads();
    XcdBarrier xb = xcd_barrier_post(w.bar, (volatile LAS unsigned*)&xb_words);
#define GSYNC(id) xcd_barrier(xb)
#if XD == 10
    for (int rep = 0; rep < 4; ++rep) phase_ada(lds, w, in);
#endif
#if XD == 11
    for (int rep = 0; rep < 4; ++rep) for (int l = 0; l < 2; ++l) hy_filter_mlp(lds, in.hy_w1 + l * 33 * 64, in.hy_b1 + l * 64, in.hy_w2 + l * 64 * 64, in.hy_b2 + l * 64, in.hy_freq + l * 64, w.f2b + (size_t)l * (S + LC) * 64);
#endif
    phase_ada(lds, w, in);
    dev_run(NkRopeTab{w.rope}, NkRopeTab::count());
    dev_run(NkZeroI{w.cnt}, 4 * 32 * 32);
    dev_run(NkZeroI{w.qctr}, 64 * 64);
    for (int it = blockIdx.x; it < 16 * 52; it += gridDim.x) cvt_tile(lds, in.w_in, DIN, w.winT, 1024, (it / 52) * 64, (it % 52) * 64, DIN, 3328, NMapId{});
    for (int l = 0; l < 2; ++l) {
        hy_filter_mlp(lds, in.hy_w1 + l * 33 * 64, in.hy_b1 + l * 64, in.hy_w2 + l * 64 * 64, in.hy_b2 + l * 64, in.hy_freq + l * 64, w.f2b + (size_t)l * (S + LC) * 64);
        { NkCvtT c4{in.hy_w3 + (size_t)l * 64 * 512, w.w3T + (size_t)l * 512 * 64, 64, 512, 512}; dev_run(c4, c4.count()); }
    }
    if (mp.out == nullptr) grid.sync();
    xcd_barrier(xb);
    row_pass<3, 1>(w, in, T, w.mod, w.mod, in.norm1, 0, 1, nullptr, nullptr, nullptr, w.h);
    GSYNC(0);
    for (int l = 0; l < 2; ++l) {
        const bool need_ctx = l == 0;
        const float* mod = w.mod + (size_t)l * 9 * 6144;
        const long ntok = need_ctx ? T : TL;
        const float* filt = w.filt + (size_t)l * (S + LC) * 512;
#if XD == 1
        for (int rep = 0; rep < 2; ++rep) phase_inproj(lds, w, l);
#endif
#if XD == 2
        for (int rep = 0; rep < 4; ++rep) hy_filter_out(w.w3T + (size_t)l * 512 * 64, w.f2b + (size_t)l * (S + LC) * 64, w.filt + (size_t)l * (S + LC) * 512);
#endif
        phase_inproj(lds, w, l);
        hy_filter_out(w.w3T + (size_t)l * 512 * 64, w.f2b + (size_t)l * (S + LC) * 64, w.filt + (size_t)l * (S + LC) * 512);
        GSYNC(2);
        const float* hcw = in.hy_conv + l * 3 * 768;
#if XD == 3
        for (int rep = 0; rep < 2; ++rep) for (int it = blockIdx.x; it < B * GD_NC * 4; it += gridDim.x) gdn_pre_item(lds, w, in.gdn_conv + l * 4 * 768, in.gdn_a_log + l * 8, in.gdn_dt_bias + l * 8, it / (GD_NC * 4), (it >> 2) % GD_NC, it & 3);
#endif
#if XD == 4
        for (int rep = 0; rep < 4; ++rep) for (int it = blockIdx.x; it < B * 32; it += gridDim.x) hy_prep_item(lds, w.p, hcw, w.x0T, w.uvT, it >> 5, it & 31);
#endif
        if (l == 0) for (int l2 = 0; l2 < 2; ++l2) { NkCvtT c3{in.moe_router + (size_t)l2 * D * 32, w.wrT + (size_t)l2 * 32 * 1024, 1024, 32, 32}; dev_run(c3, c3.count()); }
        {
            const int n_gp = B * GD_NC * 4, n_hp = B * 32 + (need_ctx ? B * 4 : 0), n_cv = l == 0 ? 104 + 64 : 0;
            int* head = w.qctr + (2 + l) * 64;
            for (;;) {
                int it = q_next(head, q_slot);
                if (it >= n_gp + n_hp + n_cv) break;
                if (it < n_gp) { gdn_pre_item(lds, w, in.gdn_conv + l * 4 * 768, in.gdn_a_log + l * 8, in.gdn_dt_bias + l * 8, it / (GD_NC * 4), (it >> 2) % GD_NC, it & 3); continue; }
                it -= n_gp;
                if (it < n_hp) { if (it < B * 32) hy_prep_item(lds, w.p, hcw, w.x0T, w.uvT, it >> 5, it & 31); else hy_prep_item(lds, w.p, hcw, w.x0Tc, w.uvTc, (it - B * 32) >> 2, (it - B * 32) & 3, true); continue; }
                it -= n_hp;
                if (it < 104) { for (int q = it * 8; q < it * 8 + 8; ++q) cvt_tile(lds, in.w_in + (size_t)D * DIN, DIN, w.winT + (size_t)3328 * 1024, 1024, (q / 52) * 64, (q % 52) * 64, DIN, 3328, NMapId{}); }
                else { const int g = it - 104, l2 = g >> 5; for (int q = (g & 31) * 8; q < (g & 31) * 8 + 8; ++q) cvt_tile(lds, in.w_out + (size_t)l2 * 1024 * D, D, w.woutT + (size_t)l2 * 1024 * 1024, 1024, (q >> 4) * 64, (q & 15) * 64, D, D, NMapId{}); }
            }
        }
        GSYNC(90);
#if XD == 9
        for (int rep = 0; rep < 2; ++rep) for (int it = blockIdx.x; it < 512 + (need_ctx ? 64 : 0); it += gridDim.x) attn_item(lds, w, in, l, it);
#endif
        {
            const int natt = 512 + (need_ctx ? 64 : 0);
            int* head = w.qctr + l * 64;
            for (;;) {
                const int it = q_next(head, q_slot);
                if (it >= 64 + 256 + natt) break;
                if (it < 64) gdn_scan_chain(lds, w, it >> 3, (it >> 1) & 3, it & 1, need_ctx);
                else if (it < 320) hy_conv_item(lds, filt, in.hy_bias + l * 256, w.uvT, w.x0T, it - 64, need_ctx ? w.uvTc : nullptr, w.x0Tc);
                else { int a = it - 320; a = a < 256 ? a + 256 : (a < 512 ? a - 256 : a); attn_item(lds, w, in, l, a); }
            }
        }
        GSYNC(91);
#if XD == 5
        for (int rep = 0; rep < 4; ++rep) for (int it = blockIdx.x; it < B * 32; it += gridDim.x) hy_fin_item(lds, w.x0T, w.ycat, it >> 5, it & 31);
#endif
#if XD == 6
        for (int rep = 0; rep < 4; ++rep) for (int it = blockIdx.x; it < B * GD_NC * 4; it += gridDim.x) { const int cc = (it >> 2) % GD_NC; if (cc >= 4 || need_ctx) gdn_fin_item(lds, w, in.gdn_norm + l * 64, it / (GD_NC * 4), cc, it & 3); }
#endif
        for (int it = blockIdx.x; it < B * 32 + (need_ctx ? B * 4 : 0); it += gridDim.x) { if (it < B * 32) hy_fin_item(lds, w.x0T, w.ycat, it >> 5, it & 31); else hy_fin_item(lds, w.x0Tc, w.ycat, (it - B * 32) >> 2, (it - B * 32) & 3, true); }
        for (int it = blockIdx.x; it < B * GD_NC * 4; it += gridDim.x) { const int cc = (it >> 2) % GD_NC; if (cc >= 4 || need_ctx) gdn_fin_item(lds, w, in.gdn_norm + l * 64, it / (GD_NC * 4), cc, it & 3); }
        GSYNC(5);
        phase_outproj(lds, w, l, mod, (int)ntok, in.x, in.ctx);
        {
            for (int it = blockIdx.x; it < 33 * 2 * 16; it += gridDim.x) {
                const int e = it >> 5, which = (it >> 4) & 1, kt = it & 15;
                const float* src = e < 32 ? (which ? in.moe_up : in.moe_gate) + ((size_t)l * 32 + e) * D * 256 : (which ? in.sh_up : in.sh_gate) + (size_t)l * D * 256;
                cvt_strip(lds, src, 256, w.moeUpT + (size_t)e * 512 * 1024, 1024, kt * 64, 0, 256, 256, NMapUp{which});
            }
            for (int it = blockIdx.x; it < 33 * 16; it += gridDim.x) {
                const int e = it >> 4, kt = (it >> 2) & 3, st = it & 3;
                const float* src = e < 32 ? in.moe_down + ((size_t)l * 32 + e) * 256 * D : in.sh_down + (size_t)l * 256 * D;
                cvt_strip(lds, src, D, w.moeDownT + (size_t)e * 1024 * 256, 256, kt * 64, st * 256, D, D, NMapId{});
            }
        }
        GSYNC(6);
        phase_norm2_router(lds, w, in, (int)ntok, mod, in.norm2 + l * D, in.moe_bias + l * 32, l);
        GSYNC(7);
#if XD == 7
        for (int rep = 0; rep < 2; ++rep) phase_moe_up(lds, w, l, (int)ntok);
#endif
        phase_moe_up(lds, w, l, (int)ntok);
        GSYNC(9);
#if XD == 8
        for (int rep = 0; rep < 2; ++rep) phase_moe_down_routed(lds, w, l, (int)ntok, mod);
#endif
        phase_moe_down(lds, w, l, (int)ntok, mod);
        GSYNC(10);
        if (l == 0) row_pass<2, 1>(w, in, (int)ntok, mod, w.mod + (size_t)9 * 6144, in.norm1 + D, 0, 1, (const bf16*)w.h, w.topw, nullptr, w.hid2);
        else row_pass<2, 2>(w, in, (int)ntok, mod, mod, in.norm_f, 0, 0, (const bf16*)w.h, w.topw, mp.out, nullptr);
        GSYNC(11);
    }
}

constexpr size_t kDynLds = G_LDS3;
static_assert(H_LDS <= kDynLds &&  HY_LDS_END <= kDynLds && AT_RING * AT_STAGE + 2048 <= kDynLds && GP_END <= kDynLds && GS_END <= kDynLds, "LDS budget");
extern "C" void kernel_launch(void* const* d_in, const int* in_sizes, int n_in, void* d_out, int out_size, void* d_ws, size_t ws_size, hipStream_t stream) {
    static int grid_blocks = 0;
    if (!grid_blocks) {
        int dev = 0, cus = 0, per_cu = 0;
        hipGetDevice(&dev);
        hipDeviceGetAttribute(&cus, hipDeviceAttributeMultiprocessorCount, dev);
        hipFuncSetAttribute((const void*)mega_kernel, hipFuncAttributeMaxDynamicSharedMemorySize, (int)kDynLds);
        hipOccupancyMaxActiveBlocksPerMultiprocessor(&per_cu, mega_kernel, NTHREADS, kDynLds);
        if (per_cu < 1) per_cu = 1;
        grid_blocks = cus;
    }
    MP mp; memset(&mp, 0, sizeof(mp));
    const float** ip = (const float**)&mp.in;
    for (int i = 0; i < 33; ++i) ip[i] = (const float*)d_in[i];
    mp.out = (float*)d_out; mp.w = make_ws(d_ws);
    hipMemsetAsync(mp.w.bar, 0, 4096 * 4, stream);
    void* args[] = {&mp};
    hipError_t e = hipLaunchCooperativeKernel((void*)mega_kernel, dim3(grid_blocks), dim3(NTHREADS), args, kDynLds, stream);
    if (e != hipSuccess) fprintf(stderr, "cooperative launch failed: %s (grid %d)\n", hipGetErrorString(e), grid_blocks);
}
#endif
```

```cpp
#ifndef HOST_SIM
#include <hip/hip_runtime.h>
#include <hip/hip_cooperative_groups.h>
#include <cstdio>
#include <cstring>
#define HD __host__ __device__ __forceinline__
#else
#include <cmath>
#include <cstdio>
#include <cstdlib>
#include <cstring>
#define HD inline
typedef void* hipStream_t;
#endif
#include <cstdint>
#include <cstddef>

#ifndef BATCH
#define BATCH 8
#endif
constexpr int B = BATCH, S = 2048, D = 1024, LC = 256, GRID_W = 64;
constexpr int TL = B * S, TC = B * LC, T = TL + TC;
constexpr int DIN = 3088, O1 = 768, O2 = 1280, O3 = 2048;
constexpr int WINDOW = 128, NA_KR = 8, NA_KC = 16;
constexpr float EPS = 1e-6f, ROPE_BASE = 10000.0f, ROUTED_SCALE = 2.5f;
constexpr float HY_DECAY_MIN = 3.0701134573253946f;
constexpr float HY_DECAY_MAX = 15.350567286626973f;
typedef unsigned short bf16;

HD float bf2f(bf16 h) { union { unsigned u; float f; } v; v.u = (unsigned)h << 16; return v.f; }
HD bf16 f2bf(float f) { union { float f; unsigned u; } v; v.f = f; unsigned u = v.u; u += 0x7fffu + ((u >> 16) & 1u); return (bf16)(u >> 16); }
HD float siluf(float x) { return x / (1.0f + expf(-x)); }

struct NkCopyX {
    const float* x; const float* ctx; float* xr;
    HD void operator()(long i) const { xr[i] = i < (long)TL * D ? x[i] : ctx[i - (long)TL * D]; }
    static HD long count() { return (long)T * D; }
};

struct NkAda {
    const float* c; const float* cctx; const float* w_ada; const float* b_ada; float* mod;
    HD void operator()(long i) const {
        int n = (int)(i % 6144); int r = (int)((i / 6144) % 9); int l = (int)(i / (6144 * 9));
        const float* cv = r < 8 ? c + (long)(r % B) * D : cctx;
        const float* w = w_ada + (long)l * D * 6144 + n;
        float acc = 0.f;
        for (int k = 0; k < D; ++k) { float v = cv[k]; acc += siluf(v) * w[(long)k * 6144]; }
        mod[i] = acc + b_ada[l * 6144 + n];
    }
    static HD long count() { return 2L * 9 * 6144; }
};

struct NkRstd {
    const float* xr; float* rstd; int nrows;
    HD void operator()(long t) const {
        const float* r = xr + t * D; float s = 0.f;
        for (int k = 0; k < D; ++k) s += r[k] * r[k];
        rstd[t] = 1.0f / sqrtf(s * (1.0f / D) + EPS);
    }
};

struct NkModNorm {
    const float* xr; const float* rstd; const float* g; const float* mod;   int sh_chunk, sc_chunk; bf16* h;
    HD void operator()(long i) const {
        long t = i / D; int k = (int)(i % D); int r = t < TL ? (int)(t / S) : 8;
        const float* m = mod + (long)r * 6144;
        float v = xr[i] * rstd[t] * g[k];
        h[i] = f2bf(v * (1.0f + m[sc_chunk * D + k]) + m[sh_chunk * D + k]);
    }
};

struct NkInProj {
    const bf16* h; const float* w; bf16* p;
    HD void operator()(long i) const {
        long t = i / DIN; int n = (int)(i % DIN);
        const bf16* hr = h + t * D; float acc = 0.f;
        for (int k = 0; k < D; ++k) acc += bf2f(hr[k]) * w[(long)k * DIN + n];
        p[i] = f2bf(acc);
    }
    static HD long count() { return (long)T * DIN; }
};

struct NkRope {
    bf16* p;
    HD void operator()(long i) const {
        int pr = (int)(i % 32); int hd = (int)((i / 32) % 6); long t = i / (32 * 6);
        int s = (int)(t % S); int row = s / GRID_W, col = s % GRID_W;
        int axis = pr >> 4, j = pr & 15;
        float pos = axis == 0 ? (float)row : (float)col;
        float inv = powf(ROPE_BASE, -(float)j / 16.0f);
        float ang = pos * inv; float cs = cosf(ang), sn = sinf(ang);
        bf16* q = p + t * DIN + O1 + hd * 64 + axis * 32;
        float x1 = bf2f(q[j]), x2 = bf2f(q[j + 16]);
        q[j] = f2bf(x1 * cs - x2 * sn); q[j + 16] = f2bf(x1 * sn + x2 * cs);
    }
    static HD long count() { return (long)TL * 6 * 32; }
};

struct NkHyF1 {
    const float* w1; const float* b1; const float* freq; float* f1;
    HD void operator()(long i) const {
        int j = (int)(i % 64); int tt = (int)(i / 64); int L = tt < S ? S : LC; int t = tt < S ? tt : tt - S;
        float tn = (float)t / (float)(L - 1);
        float acc = tn * w1[j];
        for (int bnd = 0; bnd < 16; ++bnd) {
            float band = 1e-4f + (float)bnd * ((15.0f - 1e-4f) / 15.0f);
            float ang = (6.283185307179586f / (float)L) * (float)t * band;
            acc += cosf(ang) * w1[(1 + bnd) * 64 + j] - sinf(ang) * w1[(17 + bnd) * 64 + j];
        }
        f1[i] = sinf(freq[j] * (acc + b1[j]));
    }
    static HD long count() { return (long)(S + LC) * 64; }
};
struct NkHyF2 {
    const float* w2; const float* b2; const float* freq; const float* f1; float* f2; bf16* f2b;
    HD void operator()(long i) const {
        int j = (int)(i % 64); long tt = i / 64; float acc = 0.f;
        for (int k = 0; k < 64; ++k) acc += f1[tt * 64 + k] * w2[k * 64 + j];
        const float v = sinf(freq[j] * (acc + b2[j]));
        f2[i] = v; if (f2b) f2b[i] = f2bf(v);
    }
    static HD long count() { return (long)(S + LC) * 64; }
};
struct NkHyF3 {
    const float* w3; const float* f2; float* filt;
    HD void operator()(long i) const {
        int tt = (int)(i % (S + LC)); int c = (int)(i / (S + LC)); int L = tt < S ? S : LC; int t = tt < S ? tt : tt - S;
        float tn = (float)t / (float)(L - 1);
        float acc = 0.f;
        for (int k = 0; k < 64; ++k) acc += f2[(long)tt * 64 + k] * w3[k * 512 + c];
        int cc = c & 255;
        float decay = HY_DECAY_MIN + (float)cc * ((HY_DECAY_MAX - HY_DECAY_MIN) / 255.0f);
        filt[(long)c * (S + LC) + tt] = acc * expf(-tn * decay);
    }
    static HD long count() { return (long)(S + LC) * 512; }
};
HD float hy_conv3(const bf16* p, long t, int tin, int L, int col, const float* cw) {
    float acc = cw[768 + col] * bf2f(p[t * DIN + col]);
    if (tin > 0) acc += cw[col] * bf2f(p[(t - 1) * DIN + col]);
    if (tin < L - 1) acc += cw[2 * 768 + col] * bf2f(p[(t + 1) * DIN + col]);
    return acc;
}
struct NkHyUV {
    const bf16* p; const float* cw; bf16* uv; long tbase; long ntok; int L;
    HD void operator()(long i) const {
        int c = (int)(i % 256); long t = tbase + i / 256; int tin = (int)((t - tbase) % L);
        float x1 = hy_conv3(p, t, tin, L, 256 + c, cw), v = hy_conv3(p, t, tin, L, 512 + c, cw);
        uv[t * 256 + c] = f2bf(x1 * v);
    }
};
struct NkHyConv {
    const bf16* p; const float* cw; const bf16* uv; const float* filt; const float* hbias; bf16* ycat; long tbase; int L; int foff;
    HD void operator()(long i) const {
        int tin = (int)(i % L); int c = (int)((i / L) % 256); long seq = i / ((long)L * 256); long t0 = tbase + seq * L; long t = t0 + tin;
        const float* f = filt + foff;
        float acc = 0.f;
        for (int s = 0; s < L; ++s) {
            int d = tin - s; float k = d >= 0 ? f[(long)c * (S + LC) + d] : f[(long)(256 + c) * (S + LC) - d];
            acc += k * bf2f(uv[(t0 + s) * 256 + c]);
        }
        acc += hbias[c] * bf2f(uv[t * 256 + c]);
        float x0 = hy_conv3(p, t, tin, L, c, cw);
        ycat[t * 1024 + c] = f2bf(x0 * acc);
    }
};

HD void attn_key(const float (&q)[64], const bf16* kr, const bf16* vr, float bias, float& m, float& l, float (&acc)[64]) {
    float sc = 0.f;
#pragma unroll
    for (int d = 0; d < 64; ++d) sc += q[d] * bf2f(kr[d]);
    sc = sc * 0.125f + bias;
    float mn = fmaxf(m, sc); float ca = expf(m - mn), cb = expf(sc - mn);
    l = l * ca + cb; m = mn;
#pragma unroll
    for (int d = 0; d < 64; ++d) acc[d] = acc[d] * ca + cb * bf2f(vr[d]);
}
struct NkWA {
    const bf16* p; const float* sink; bf16* ycat;
    HD void operator()(long i) const {
        int hq = (int)(i % 4); long t = i / 4; int b = (int)(t / S), s = (int)(t % S); int hk = hq >> 1;
        const bf16* qp = p + t * DIN + O1 + hq * 64;
        float q[64], acc[64];
#pragma unroll
        for (int d = 0; d < 64; ++d) { q[d] = bf2f(qp[d]); acc[d] = 0.f; }
        float m = sink[hq], l = 1.0f;
        for (int j = 0; j < LC; ++j) {
            const bf16* kr = p + ((long)TL + (long)b * LC + j) * DIN + O1 + 256 + hk * 64;
            attn_key(q, kr, kr + 128, 0.f, m, l, acc);
        }
        int j0 = s - WINDOW < 0 ? 0 : s - WINDOW, j1 = s + WINDOW > S - 1 ? S - 1 : s + WINDOW;
        for (int j = j0; j <= j1; ++j) {
            const bf16* kr = p + ((long)b * S + j) * DIN + O1 + 256 + hk * 64;
            attn_key(q, kr, kr + 128, 0.f, m, l, acc);
        }
        float il = 1.0f / l;
#pragma unroll
        for (int d = 0; d < 64; ++d) ycat[t * 1024 + 256 + hq * 64 + d] = f2bf(acc[d] * il);
    }
    static HD long count() { return (long)TL * 4; }
};
struct NkWACtx {
    const bf16* p; const float* sink; bf16* ycat;
    HD void operator()(long i) const {
        int hq = (int)(i % 4); long tc = i / 4; int b = (int)(tc / LC); int hk = hq >> 1; long t = TL + tc;
        const bf16* qp = p + t * DIN + O1 + hq * 64;
        float q[64], acc[64];
#pragma unroll
        for (int d = 0; d < 64; ++d) { q[d] = bf2f(qp[d]); acc[d] = 0.f; }
        float m = sink[hq], l = 1.0f;
        for (int j = 0; j < LC; ++j) {
            const bf16* kr = p + ((long)TL + (long)b * LC + j) * DIN + O1 + 256 + hk * 64;
            attn_key(q, kr, kr + 128, 0.f, m, l, acc);
        }
        float il = 1.0f / l;
#pragma unroll
        for (int d = 0; d < 64; ++d) ycat[t * 1024 + 256 + hq * 64 + d] = f2bf(acc[d] * il);
    }
    static HD long count() { return (long)TC * 4; }
};
struct NkNA {
    const bf16* p; const float* rpb; bf16* ycat;
    HD void operator()(long i) const {
        int h = (int)(i % 4); long t = i / 4; int b = (int)(t / S), s = (int)(t % S);
        int r = s / GRID_W, cq = s % GRID_W;
        const bf16* qp = p + t * DIN + O2 + h * 64;
        float q[64], acc[64];
#pragma unroll
        for (int d = 0; d < 64; ++d) { q[d] = bf2f(qp[d]); acc[d] = 0.f; }
        float m = -1e30f, l = 0.f;
        for (int j = 0; j < LC; ++j) {
            const bf16* kr = p + ((long)TL + (long)b * LC + j) * DIN + O2 + 256 + h * 64;
            attn_key(q, kr, kr + 256, 0.f, m, l, acc);
        }
        int r0 = r - NA_KR / 2; r0 = r0 < 0 ? 0 : (r0 > S / GRID_W - NA_KR ? S / GRID_W - NA_KR : r0);
        int c0 = cq - NA_KC / 2; c0 = c0 < 0 ? 0 : (c0 > GRID_W - NA_KC ? GRID_W - NA_KC : c0);
        for (int kk = 0; kk < NA_KR * NA_KC; ++kk) {
            int kr_ = r0 + kk / NA_KC, kc_ = c0 + kk % NA_KC;
            const bf16* kr = p + ((long)b * S + kr_ * GRID_W + kc_) * DIN + O2 + 256 + h * 64;
            attn_key(q, kr, kr + 256, rpb[(h * 15 + (kr_ - r + 7)) * 31 + (kc_ - cq + 15)], m, l, acc);
        }
        float il = 1.0f / l;
#pragma unroll
        for (int d = 0; d < 64; ++d) ycat[t * 1024 + 512 + h * 64 + d] = f2bf(acc[d] * il);
    }
    static HD long count() { return (long)TL * 4; }
};
struct NkNACtx {
    const bf16* p; bf16* ycat;
    HD void operator()(long i) const {
        int h = (int)(i % 4); long tc = i / 4; int b = (int)(tc / LC); long t = TL + tc;
        const bf16* qp = p + t * DIN + O2 + h * 64;
        float q[64], acc[64];
#pragma unroll
        for (int d = 0; d < 64; ++d) { q[d] = bf2f(qp[d]); acc[d] = 0.f; }
        float m = -1e30f, l = 0.f;
        for (int j = 0; j < LC; ++j) {
            const bf16* kr = p + ((long)TL + (long)b * LC + j) * DIN + O2 + 256 + h * 64;
            attn_key(q, kr, kr + 256, 0.f, m, l, acc);
        }
        float il = 1.0f / l;
#pragma unroll
        for (int d = 0; d < 64; ++d) ycat[t * 1024 + 512 + h * 64 + d] = f2bf(acc[d] * il);
    }
    static HD long count() { return (long)TC * 4; }
};

HD float gdn_conv4(const bf16* p, long t, int tin, int L, int col, const float* cw) {
    float acc = 0.f;
    for (int i = 0; i < 4; ++i) { int o = i - 2; if (tin + o >= 0 && tin + o < L) acc += cw[i * 768 + col] * bf2f(p[(t + o) * DIN + O3 + col]); }
    return siluf(acc);
}
struct NkGdnPrep {
    const bf16* p; const float* cw; bf16* qkv;
    HD void operator()(long i) const {
        int e = (int)(i % 64); int wh = (int)((i / 64) % 12); long t = i / 768; int which = wh / 4;
        int L = t < TL ? S : LC; int tin = t < TL ? (int)(t % S) : (int)((t - TL) % LC);
        int col0 = wh * 64;
        float v = gdn_conv4(p, t, tin, L, col0 + e, cw);
        if (which < 2) {
            float ss = 0.f; for (int d = 0; d < 64; ++d) { float u = gdn_conv4(p, t, tin, L, col0 + d, cw); ss += u * u; }
            v *= 1.0f / sqrtf(ss + EPS); if (which == 0) v *= 0.125f;
        }
        qkv[t * 768 + col0 + e] = f2bf(v);
    }
    static HD long count() { return (long)T * 768; }
};
struct NkGdnGate {
    const bf16* p; const float* a_log; const float* dt_bias; float* gb;
    HD void operator()(long i) const {
        int dh = (int)(i % 8); long t = i / 8;
        float a = bf2f(p[t * DIN + O3 + 1024 + dh]), bb = bf2f(p[t * DIN + O3 + 1032 + dh]);
        float x = a + dt_bias[dh]; float sp = x > 20.f ? x : log1pf(expf(x));
        gb[t * 16 + dh] = -expf(a_log[dh]) * sp; gb[t * 16 + 8 + dh] = 1.0f / (1.0f + expf(-bb));
    }
    static HD long count() { return (long)T * 8; }
};
struct NkGdnRec {
    const bf16* qkv; const float* gb; bf16* o;
    HD void operator()(long i) const {
        int e = (int)(i % 64); int dir = (int)((i / 64) % 2); int h = (int)((i / 128) % 4); int b = (int)(i / 512);
        float Sc[64];
#pragma unroll
        for (int d = 0; d < 64; ++d) Sc[d] = 0.f;
        for (int step = 0; step < LC + S; ++step) {
            long t;
            if (step < LC) { int j = dir ? LC - 1 - step : step; t = (long)TL + (long)b * LC + j; }
            else { int s = step - LC; s = dir ? S - 1 - s : s; t = (long)b * S + s; }
            const bf16* qr = qkv + t * 768 + h * 64; const bf16* kr = qr + 256; float v = bf2f(qr[512 + e]);
            float a = expf(gb[t * 16 + dir * 4 + h]), beta = gb[t * 16 + 8 + dir * 4 + h];
            float kS = 0.f;
#pragma unroll
            for (int c = 0; c < 4; ++c) {
#pragma unroll
                for (int d = c * 16; d < c * 16 + 16; ++d) kS += bf2f(kr[d]) * Sc[d];
                asm volatile("" ::: "memory");
            }
            float w = beta * (v - a * kS); float oo = 0.f;
#pragma unroll
            for (int c = 0; c < 4; ++c) {
#pragma unroll
                for (int d = c * 16; d < c * 16 + 16; ++d) { Sc[d] = a * Sc[d] + bf2f(kr[d]) * w; oo += bf2f(qr[d]) * Sc[d]; }
                asm volatile("" ::: "memory");
            }
            o[((long)dir * T + t) * 256 + h * 64 + e] = f2bf(oo);
        }
    }
    static HD long count() { return (long)B * 4 * 2 * 64; }
};
struct NkGdnFin {
    const bf16* p; const bf16* o; const float* ng; bf16* ycat;
    HD void operator()(long i) const {
        int e = (int)(i % 64); int h = (int)((i / 64) % 4); long t = i / 256;
        const bf16* o0 = o + t * 256 + h * 64; const bf16* o1 = o + ((long)T + t) * 256 + h * 64;
        float ss = 0.f; for (int d = 0; d < 64; ++d) { float u = bf2f(o0[d]) + bf2f(o1[d]); ss += u * u; }
        float v = (bf2f(o0[e]) + bf2f(o1[e])) * (1.0f / sqrtf(ss * (1.0f / 64.0f) + EPS)) * ng[e];
        float gt = bf2f(p[t * DIN + O3 + 768 + h * 64 + e]);
        ycat[t * 1024 + 768 + h * 64 + e] = f2bf(v * siluf(gt));
    }
    static HD long count() { return (long)T * 256; }
};

struct NkOutProj {
    const bf16* ycat; const float* w; const float* mod; float* xr; long ntok;
    HD void operator()(long i) const {
        long t = i / D; int n = (int)(i % D); int r = t < TL ? (int)(t / S) : 8;
        const bf16* yr = ycat + t * 1024; float acc = 0.f;
        for (int k = 0; k < 1024; ++k) acc += bf2f(yr[k]) * w[(long)k * D + n];
        xr[i] += mod[(long)r * 6144 + 2 * D + n] * acc;
    }
};

struct NkRouter {
    const bf16* h; const float* wr; float* scores;
    HD void operator()(long i) const {
        int e = (int)(i % 32); long t = i / 32; float acc = 0.f;
        for (int k = 0; k < D; ++k) acc += bf2f(h[t * D + k]) * wr[k * 32 + e];
        scores[i] = 1.0f / (1.0f + expf(-acc));
    }
};
struct NkTopK {
    const float* scores; const float* ebias; int* topi; float* topw;
    HD void operator()(long t) const {
        int sel[4]; float ss[4]; float sum = 0.f;
#pragma unroll
        for (int k = 0; k < 4; ++k) {
            int best = -1; float bv = -1e30f;
            for (int e = 0; e < 32; ++e) {
                bool used = false;
#pragma unroll
                for (int q = 0; q < 4; ++q) if (q < k && sel[q] == e) used = true;
                float v = scores[t * 32 + e] + ebias[e];
                if (!used && v > bv) { bv = v; best = e; }
            }
            sel[k] = best; ss[k] = scores[t * 32 + best]; sum += ss[k];
        }
#pragma unroll
        for (int k = 0; k < 4; ++k) { topi[t * 4 + k] = sel[k]; topw[t * 4 + k] = ss[k] / sum * ROUTED_SCALE; }
    }
};
struct NkMoeHid {
    const bf16* h; const int* topi; const float* wg; const float* wu; const float* sg; const float* su; bf16* hid;
    HD void operator()(long i) const {
        int j = (int)(i % 256); int slot = (int)((i / 256) % 5); long t = i / 1280;
        const float* g; const float* u;
        if (slot < 4) { int e = topi[t * 4 + slot]; g = wg + (long)e * D * 256; u = wu + (long)e * D * 256; } else { g = sg; u = su; }
        float ag = 0.f, au = 0.f;
        for (int k = 0; k < D; ++k) { float x = bf2f(h[t * D + k]); ag += x * g[(long)k * 256 + j]; au += x * u[(long)k * 256 + j]; }
        hid[i] = f2bf(siluf(ag) * au);
    }
};
struct NkMoeOut {
    const bf16* hid; const int* topi; const float* topw; const float* wd; const float* sd; const float* mod; float* xr;
    HD void operator()(long i) const {
        long t = i / D; int n = (int)(i % D); int r = t < TL ? (int)(t / S) : 8;
        float f = 0.f;
        for (int slot = 0; slot < 5; ++slot) {
            const float* w; float wt;
            if (slot < 4) { w = wd + (long)topi[t * 4 + slot] * 256 * D; wt = topw[t * 4 + slot]; } else { w = sd; wt = 1.0f; }
            float acc = 0.f;
            for (int j = 0; j < 256; ++j) acc += bf2f(hid[(t * 5 + slot) * 256 + j]) * w[(long)j * D + n];
            f += wt * acc;
        }
        xr[i] += mod[(long)r * 6144 + 5 * D + n] * f;
    }
};
struct NkFinal {
    const float* xr; const float* rstd; const float* g; float* out;
    HD void operator()(long i) const { long t = i / D; int k = (int)(i % D); out[i] = xr[i] * rstd[t] * g[k]; }
    static HD long count() { return (long)TL * D; }
};

struct NkCvtT {
    const float* src; bf16* dst; int K, N, Npad;
    HD void operator()(long i) const {
        int n = (int)(i % Npad); int k0 = (int)(i / Npad) * 8;
        bf16 v[8];
#pragma unroll
        for (int j = 0; j < 8; ++j) v[j] = n < N ? f2bf(src[(long)(k0 + j) * N + n]) : (bf16)0;
        bf16* d = dst + (long)n * K + k0;
#pragma unroll
        for (int j = 0; j < 8; ++j) d[j] = v[j];
    }
    HD long count() const { return (long)Npad * (K / 8); }
};
struct NkRopeTab {
    float* rope;
    HD void operator()(long i) const {
        int j = (int)(i % 16); int pos = (int)(i / 16);
        float ang = (float)pos * powf(ROPE_BASE, -(float)j / 16.0f);
        rope[i * 2] = cosf(ang); rope[i * 2 + 1] = sinf(ang);
    }
    static HD long count() { return 64 * 16; }
};

struct NkCvtUp {
    const float* wg; const float* wu; const float* sg; const float* su; bf16* dst;
    HD void operator()(long i) const {
        int j = (int)(i % 256); int k0 = (int)((i / 256) % 128) * 8; int which = (int)((i / (256 * 128)) % 2); int e = (int)(i / (256 * 128 * 2));
        const float* src = e < 32 ? (which ? wu : wg) + (long)e * D * 256 : (which ? su : sg);
        int np = (j >> 6) * 128 + ((j >> 5) & 1) * 64 + which * 32 + (j & 31);
        bf16* d = dst + ((long)e * 512 + np) * 1024 + k0;
#pragma unroll
        for (int q = 0; q < 8; ++q) d[q] = f2bf(src[(long)(k0 + q) * 256 + j]);
    }
    static HD long count() { return 33L * 2 * 128 * 256; }
};
struct NkCvtDown {
    const float* wd; const float* sd; bf16* dst;
    HD void operator()(long i) const {
        int n = (int)(i % 1024); int j0 = (int)((i / 1024) % 32) * 8; int e = (int)(i / (1024 * 32));
        const float* src = e < 32 ? wd + (long)e * 256 * D : sd;
        bf16* d = dst + ((long)e * 1024 + n) * 256 + j0;
#pragma unroll
        for (int q = 0; q < 8; ++q) d[q] = f2bf(src[(long)(j0 + q) * D + n]);
    }
    static HD long count() { return 33L * 32 * 1024; }
};
struct NkZeroI { int* p; HD void operator()(long i) const { p[i] = 0; } };
struct WS {
    float* mod; float* rstd; float* xr; bf16* h; bf16* p; bf16* ycat; float* hyf1; float* hyf2; float* filt; bf16* uv;
    bf16* qkv; float* gb; bf16* o; float* scores; int* topi; float* topw; bf16* hid;
    bf16* winT; bf16* woutT; bf16* wrT; float* rope; unsigned* bar; int* cnt; int* list;
    bf16* moeUpT; bf16* hid2; bf16* moeDownT;
    bf16* qk; bf16* uw; float* gc; bf16* x0T; bf16* uvT; int* qctr; bf16* x0Tc; bf16* uvTc; bf16* w3T; bf16* f2b;
};
static inline WS make_ws(void* d_ws) {
    char* base = (char*)d_ws; size_t off = 0;
    auto take = [&](size_t bytes) { char* r = base + off; off += (bytes + 255) & ~(size_t)255; return r; };
    WS w;
    w.mod = (float*)take(2ul * 9 * 6144 * 4);
    w.rstd = (float*)take((size_t)T * 4);
    w.hyf1 = (float*)take(2 * (size_t)(S + LC) * 64 * 4);
    w.hyf2 = (float*)take(2 * (size_t)(S + LC) * 64 * 4);
    w.filt = (float*)take(2 * (size_t)(S + LC) * 512 * 4);
    w.gb = (float*)take((size_t)T * 16 * 4);
#ifdef HOST_SIM
    w.scores = (float*)take((size_t)T * 32 * 4); w.topi = (int*)take((size_t)T * 4 * 4);
#else
    w.scores = nullptr; w.topi = nullptr;
#endif
    w.topw = (float*)take((size_t)T * 4 * 4);
    w.winT = (bf16*)take(2ul * 3328 * 1024 * 2);
    w.woutT = (bf16*)take(2ul * 1024 * 1024 * 2);
    w.wrT = (bf16*)take(2ul * 32 * 1024 * 2);
    w.rope = (float*)take(64 * 16 * 2 * 4);
    w.bar = (unsigned*)take(4096 * 4);
    w.cnt = (int*)take(4 * 32 * 32 * 4);
    w.list = (int*)take((size_t)32 * T * 4);
    w.qctr = (int*)take(64 * 64 * 4);
    w.w3T = (bf16*)take(2ul * 512 * 64 * 2);
    w.f2b = (bf16*)take(2ul * (S + LC) * 64 * 2);
    w.xr = (float*)take((size_t)T * D * 4);
    w.h = (bf16*)take((size_t)T * D * 2);
    w.p = (bf16*)take((size_t)T * DIN * 2);
    w.hid = (bf16*)w.p;
    char* R = take(0);
    const size_t szUp = 33ul * 512 * 1024 * 2, szHid = ((size_t)5 * T + 256) * 256 * 2, szDown = 33ul * 1024 * 256 * 2;
    w.moeUpT = (bf16*)R; w.hid2 = (bf16*)(R + szUp); w.moeDownT = (bf16*)(R + szUp + szHid);
    w.qkv = (bf16*)R;
    w.qk = (bf16*)R;
    w.ycat = w.hid2;
    w.o = (bf16*)((char*)w.ycat + (size_t)T * 1024 * 2);
    w.x0T = (bf16*)((char*)w.ycat + (size_t)T * 1024 * 2);
    w.uvT = w.x0T + (size_t)256 * B * S;
    w.uv = w.uvT + (size_t)256 * B * S;
    w.uw = w.h; w.gc = w.gb;
    w.x0Tc = w.uv; w.uvTc = w.uv + (size_t)256 * B * LC;
    size_t rsz = szUp + szHid + szDown; const size_t rsz2 = szUp + (size_t)T * 1024 * 2 + (size_t)2 * 256 * B * S * 2 + (size_t)T * 256 * 2;
    if (rsz2 > rsz) rsz = rsz2;
    (void)take(rsz);
    return w;
}
#ifdef HOST_SIM
template <class F> static inline void run(F f, long n, hipStream_t) {
#pragma omp parallel for schedule(dynamic, 256)
    for (long i = 0; i < n; ++i) f(i);
}
#endif

struct Inputs {
    const float *x, *c, *ctx, *c_ctx, *w_ada, *b_ada, *norm1, *norm2, *norm_f, *w_in, *w_out, *hy_conv, *hy_w1, *hy_b1, *hy_w2, *hy_b2, *hy_w3, *hy_freq, *hy_bias,
        *wa_sink, *na_rpb, *gdn_conv, *gdn_a_log, *gdn_dt_bias, *gdn_norm, *moe_router, *moe_bias, *moe_gate, *moe_up, *moe_down, *sh_gate, *sh_up, *sh_down;
};

#ifdef HOST_SIM
static void forward_naive(const Inputs& in, float* out, const WS& w, hipStream_t st) {
    run(NkCopyX{in.x, in.ctx, w.xr}, NkCopyX::count(), st);
    run(NkAda{in.c, in.c_ctx, in.w_ada, in.b_ada, w.mod}, NkAda::count(), st);
    for (int l = 0; l < 2; ++l) {
        const bool need_ctx = l == 0;
        const float* mod = w.mod + (size_t)l * 9 * 6144;
        run(NkRstd{w.xr, w.rstd, T}, T, st);
        run(NkModNorm{w.xr, w.rstd, in.norm1 + l * D, mod, 0, 1, w.h}, (long)T * D, st);
        run(NkInProj{w.h, in.w_in + (size_t)l * D * DIN, w.p}, NkInProj::count(), st);
        run(NkRope{w.p}, NkRope::count(), st);
        run(NkHyF1{in.hy_w1 + l * 33 * 64, in.hy_b1 + l * 64, in.hy_freq + l * 64, w.hyf1}, NkHyF1::count(), st);
        run(NkHyF2{in.hy_w2 + l * 64 * 64, in.hy_b2 + l * 64, in.hy_freq + l * 64, w.hyf1, w.hyf2, nullptr}, NkHyF2::count(), st);
        run(NkHyF3{in.hy_w3 + l * 64 * 512, w.hyf2, w.filt}, NkHyF3::count(), st);
        const float* hcw = in.hy_conv + l * 3 * 768;
        run(NkHyUV{w.p, hcw, w.uv, 0, TL, S}, (long)TL * 256, st);
        run(NkHyConv{w.p, hcw, w.uv, w.filt, in.hy_bias + l * 256, w.ycat, 0, S, 0}, (long)TL * 256, st);
        if (need_ctx) {
            run(NkHyUV{w.p, hcw, w.uv, TL, TC, LC}, (long)TC * 256, st);
            run(NkHyConv{w.p, hcw, w.uv, w.filt, in.hy_bias + l * 256, w.ycat, TL, LC, S}, (long)TC * 256, st);
        }
        run(NkWA{w.p, in.wa_sink + l * 4, w.ycat}, NkWA::count(), st);
        if (need_ctx) run(NkWACtx{w.p, in.wa_sink + l * 4, w.ycat}, NkWACtx::count(), st);
        run(NkNA{w.p, in.na_rpb + l * 4 * 15 * 31, w.ycat}, NkNA::count(), st);
        if (need_ctx) run(NkNACtx{w.p, w.ycat}, NkNACtx::count(), st);
        run(NkGdnPrep{w.p, in.gdn_conv + l * 4 * 768, w.qkv}, NkGdnPrep::count(), st);
        run(NkGdnGate{w.p, in.gdn_a_log + l * 8, in.gdn_dt_bias + l * 8, w.gb}, NkGdnGate::count(), st);
        run(NkGdnRec{w.qkv, w.gb, w.o}, NkGdnRec::count(), st);
        run(NkGdnFin{w.p, w.o, in.gdn_norm + l * 64, w.ycat}, need_ctx ? (long)T * 256 : (long)TL * 256, st);
        const long ntok = need_ctx ? T : TL;
        run(NkOutProj{w.ycat, in.w_out + (size_t)l * 1024 * D, mod, w.xr, ntok}, ntok * D, st);
        run(NkRstd{w.xr, w.rstd, (int)ntok}, ntok, st);
        run(NkModNorm{w.xr, w.rstd, in.norm2 + l * D, mod, 3, 4, w.h}, ntok * D, st);
        run(NkRouter{w.h, in.moe_router + l * D * 32, w.scores}, ntok * 32, st);
        run(NkTopK{w.scores, in.moe_bias + l * 32, w.topi, w.topw}, ntok, st);
        run(NkMoeHid{w.h, w.topi, in.moe_gate + (size_t)l * 32 * D * 256, in.moe_up + (size_t)l * 32 * D * 256, in.sh_gate + (size_t)l * D * 256, in.sh_up + (size_t)l * D * 256, w.hid}, ntok * 1280, st);
        run(NkMoeOut{w.hid, w.topi, w.topw, in.moe_down + (size_t)l * 32 * 256 * D, in.sh_down + (size_t)l * 256 * D, mod, w.xr}, ntok * D, st);
    }
    run(NkRstd{w.xr, w.rstd, TL}, TL, st);
    run(NkFinal{w.xr, w.rstd, in.norm_f, out}, NkFinal::count(), st);
}


#endif
#ifdef HOST_SIM
extern "C" void kernel_launch(void* const* d_in, const int* in_sizes, int n_in, void* d_out, int out_size, void* d_ws, size_t ws_size, hipStream_t stream) {
    Inputs in;
    const float** ip = (const float**)&in;
    for (int i = 0; i < 33; ++i) ip[i] = (const float*)d_in[i];
    WS w = make_ws(d_ws);
    forward_naive(in, (float*)d_out, w, stream);
}

#endif
#ifndef HOST_SIM
#define XB_TMO      128
#define XB_XCNT(j)  (256  + 64 * (j))
#define XB_XSUB(j)  (1280 + 64 * (j))
#define XB_XGEN(j)  (2304 + 64 * (j))
#define XB_TOP      3328
#define XB_TOPGEN   3392
#define XCD_BAR_WORDS 3456
#define XB_SPIN_CAP (1u << 26)
#define LAS __attribute__((address_space(3)))
__device__ __forceinline__ unsigned xb_ld(unsigned* p)              { return __hip_atomic_load(p, __ATOMIC_RELAXED, __HIP_MEMORY_SCOPE_AGENT); }
__device__ __forceinline__ unsigned xb_add(unsigned* p, unsigned v) { return __hip_atomic_fetch_add(p, v, __ATOMIC_RELAXED, __HIP_MEMORY_SCOPE_AGENT); }
__device__ __forceinline__ unsigned xb_xcc_id() { return (unsigned)__builtin_amdgcn_s_getreg((3 << 11) | 20) & 0xFu; }
#define XB_SPIN(cond, bar) do { unsigned _sp = 0; while (cond) { __builtin_amdgcn_s_sleep(1); \
    if ((++_sp & 255u) == 0u) { if (xb_ld(&(bar)[XB_TMO])) break; if (_sp > XB_SPIN_CAP) { atomicAdd(&(bar)[XB_TMO], 1u); break; } } } } while (0)
struct XcdBarrier { unsigned* bar; unsigned x; volatile LAS unsigned* st; };
__device__ __forceinline__ XcdBarrier xcd_barrier_post(unsigned* bar, volatile LAS unsigned* st) {
    XcdBarrier b; b.bar = bar; b.x = xb_xcc_id(); b.st = st;
    if (threadIdx.x == 0) (void)xb_add(&bar[XB_XCNT(b.x)], 1u);
    return b;
}
__device__ __forceinline__ void xcd_barrier_complete(unsigned* bar, unsigned x, unsigned& nloc, unsigned& nx) {
    const unsigned G = gridDim.x * gridDim.y * gridDim.z;
    unsigned sum, cnt, mine, sp = 0u;
    for (;;) {
        sum = 0u; cnt = 0u; mine = 0u;
#pragma unroll
        for (unsigned j = 0; j < 16; ++j) { const unsigned c = xb_ld(&bar[XB_XCNT(j)]); sum += c; cnt += (c > 0u) ? 1u : 0u; mine = (j == x) ? c : mine; }
        if (sum == G) break;
        __builtin_amdgcn_s_sleep(1);
        if ((++sp & 255u) == 0u) { if (xb_ld(&bar[XB_TMO])) break; if (sp > XB_SPIN_CAP) { atomicAdd(&bar[XB_TMO], 1u); break; } }
    }
    nloc = mine > 0u ? mine : 1u; nx = cnt > 0u ? cnt : 1u;
}
__device__ __forceinline__ void xcd_barrier(const XcdBarrier& b) {
    asm volatile("s_waitcnt vmcnt(0)" ::: "memory");
    __syncthreads();
    if (threadIdx.x == 0) {
        unsigned* bar = b.bar;
        __builtin_amdgcn_s_waitcnt(0);
        unsigned nloc = b.st[0], nx = b.st[1];
        if (nloc == 0u) { xcd_barrier_complete(bar, b.x, nloc, nx); b.st[0] = nloc; b.st[1] = nx; }
        const unsigned old = xb_add(&bar[XB_XSUB(b.x)], 1u);
        const unsigned gen = old / nloc;
        if (old + 1u == (gen + 1u) * nloc) {
            __builtin_amdgcn_fence(__ATOMIC_RELEASE, "agent");
            asm volatile("s_waitcnt vmcnt(0)" ::: "memory");
            const unsigned og = xb_add(&bar[XB_TOP], 1u);
            const unsigned tg = og / nx;
            if (og + 1u == (tg + 1u) * nx) xb_add(&bar[XB_TOPGEN], 1u);
            else XB_SPIN(xb_ld(&bar[XB_TOPGEN]) == tg, bar);
            __builtin_amdgcn_fence(__ATOMIC_ACQUIRE, "agent");
            xb_add(&bar[XB_XGEN(b.x)], 1u);
            asm volatile("s_waitcnt vmcnt(0)" ::: "memory");
        } else {
            XB_SPIN(xb_ld(&bar[XB_XGEN(b.x)]) == gen, bar);
            __builtin_amdgcn_fence(__ATOMIC_ACQUIRE, "agent");
            asm volatile("s_waitcnt vmcnt(0)" ::: "memory");
        }
    }
    __syncthreads();
}
#endif
#ifndef HOST_SIM
typedef short bf16x8 __attribute__((ext_vector_type(8)));
typedef float f32x16 __attribute__((ext_vector_type(16)));
typedef float f32x4 __attribute__((ext_vector_type(4)));
typedef unsigned u32x4 __attribute__((ext_vector_type(4)));
typedef unsigned u32x2 __attribute__((ext_vector_type(2)));
#define NTHREADS 512

__device__ __forceinline__ void st_wt8(void* p, u32x2 v) { __hip_atomic_store((unsigned long long*)p, ((unsigned long long)v.y << 32) | v.x, __ATOMIC_RELAXED, __HIP_MEMORY_SCOPE_AGENT); }
__device__ __forceinline__ void st_wt16(void* p, f32x4 v) { asm volatile("global_store_dwordx4 %0, %1, off sc1\n\ts_nop 1" :: "v"(p), "v"(v) : "memory"); }
typedef __bf16 bf16x2n __attribute__((ext_vector_type(2)));
typedef float f32x2n __attribute__((ext_vector_type(2)));
__device__ __forceinline__ unsigned pack_bf16(float lo, float hi) { f32x2n f = {lo, hi}; bf16x2n r = __builtin_convertvector(f, bf16x2n); return __builtin_bit_cast(unsigned, r); }

constexpr int GBM = 256, GBN = 128, GBK = 64;
constexpr int G_ASTAGE = GBM * GBK * 2, G_BSTAGE = GBN * GBK * 2, G_STAGE = G_ASTAGE + G_BSTAGE;
constexpr int G_LDS = 2 * G_STAGE;
__device__ __forceinline__ int g_lds_off(int r, int c) { return r * 128 + ((c ^ ((r >> 1) & 7)) << 4); }

template <class ARow, class Epi>
__device__ __forceinline__ void gemm_tile(char* lds, const ARow& arow, const bf16* __restrict__ Bt, int ldb, int K, int m0, int n0, const Epi& epi) {
    int tid = threadIdx.x; asm volatile("" : "+v"(tid));
    const int lane = tid & 63, wid = __builtin_amdgcn_readfirstlane(tid >> 6), wm = wid >> 1, wn = wid & 1;
    const bf16* ap[4]; const bf16* bp[2];
#pragma unroll
    for (int j = 0; j < 4; ++j) { const int r = 8 * (wid * 4 + j) + (lane >> 3); ap[j] = arow(r) + 8 * ((lane & 7) ^ ((r >> 1) & 7)); }
#pragma unroll
    for (int j = 0; j < 2; ++j) { const int r = 8 * (wid * 2 + j) + (lane >> 3); bp[j] = Bt + (size_t)(n0 + r) * ldb + 8 * ((lane & 7) ^ ((r >> 1) & 7)); }
    f32x16 acc[2][2];
#pragma unroll
    for (int a = 0; a < 2; ++a)
#pragma unroll
        for (int b = 0; b < 2; ++b)
#pragma unroll
            for (int r = 0; r < 16; ++r) acc[a][b][r] = 0.f;
    const int nk = K / GBK;
    __syncthreads();
#define G_DMA(kt_, stage_) do { \
        _Pragma("unroll") for (int j = 0; j < 4; ++j) __builtin_amdgcn_global_load_lds((const unsigned*)(ap[j] + (kt_) * GBK), (LAS unsigned*)((stage_) + (wid * 4 + j) * 1024), 16, 0, 0); \
        _Pragma("unroll") for (int j = 0; j < 2; ++j) __builtin_amdgcn_global_load_lds((const unsigned*)(bp[j] + (kt_) * GBK), (LAS unsigned*)((stage_) + G_ASTAGE + (wid * 2 + j) * 1024), 16, 0, 0); } while (0)
    G_DMA(0, lds);
    __syncthreads();
    const int fr = lane & 31, fh = lane >> 5;
    for (int kt = 0; kt < nk; ++kt) {
        char* cur = lds + (kt & 1) * G_STAGE;
        if (kt + 1 < nk) { char* nxt = lds + ((kt + 1) & 1) * G_STAGE; G_DMA(kt + 1, nxt); }
#pragma unroll
        for (int kk = 0; kk < 4; ++kk) {
            bf16x8 fa[2], fb[2];
#pragma unroll
            for (int mi = 0; mi < 2; ++mi) fa[mi] = *(const bf16x8*)(cur + g_lds_off(wm * 64 + mi * 32 + fr, kk * 2 + fh));
#pragma unroll
            for (int ni = 0; ni < 2; ++ni) fb[ni] = *(const bf16x8*)(cur + G_ASTAGE + g_lds_off(wn * 64 + ni * 32 + fr, kk * 2 + fh));
#pragma unroll
            for (int mi = 0; mi < 2; ++mi)
#pragma unroll
                for (int ni = 0; ni < 2; ++ni) acc[mi][ni] = __builtin_amdgcn_mfma_f32_32x32x16_bf16(fb[ni], fa[mi], acc[mi][ni], 0, 0, 0);
        }
        __syncthreads();
    }
#undef G_DMA
    epi(acc, m0 + wm * 64 + fr, n0 + wn * 64 + 4 * fh);
}


constexpr int G_LDS3 = 3 * G_STAGE;
struct GPtrs { const bf16* a[4]; const bf16* b[2]; };
template <class TL> __device__ __forceinline__ void g_ptrs(const TL& tl, const typename TL::Tile& t, int wid, int lane, GPtrs& P) {
#pragma unroll
    for (int j = 0; j < 4; ++j) { const int r = 8 * (wid * 4 + j) + (lane >> 3); P.a[j] = tl.arow(t, r) + 8 * ((lane & 7) ^ ((r >> 1) & 7)); }
#pragma unroll
    for (int j = 0; j < 2; ++j) { const int r = 8 * (wid * 2 + j) + (lane >> 3); P.b[j] = tl.brow(t, r) + 8 * ((lane & 7) ^ ((r >> 1) & 7)); }
}
__device__ __forceinline__ void g_dma(char* lds, const GPtrs& P, int kt, int stage, int wid) {
    char* st = lds + stage * G_STAGE;
#pragma unroll
    for (int j = 0; j < 4; ++j) __builtin_amdgcn_global_load_lds((const unsigned*)(P.a[j] + kt * GBK), (LAS unsigned*)(st + (wid * 4 + j) * 1024), 16, 0, 0);
#pragma unroll
    for (int j = 0; j < 2; ++j) __builtin_amdgcn_global_load_lds((const unsigned*)(P.b[j] + kt * GBK), (LAS unsigned*)(st + G_ASTAGE + (wid * 2 + j) * 1024), 16, 0, 0);
}
template <class TL, int XF = 0>
__device__ __forceinline__ void gemm_stream(char* lds, const TL& tl) {
    int tid = threadIdx.x; asm volatile("" : "+v"(tid));
    const int lane = tid & 63, wid = __builtin_amdgcn_readfirstlane(tid >> 6), wm = wid >> 1, wn = wid & 1, fr = lane & 31, fh = lane >> 5;
    constexpr int nk = TL::K / GBK;
    static_assert(nk >= 2, "K too small");
    int idx = blockIdx.x;
    typename TL::Tile cur, nxt;
    if (!tl.tile(idx, cur)) return;
    GPtrs P, Pn;
    g_ptrs(tl, cur, wid, lane, P);
    bool has_next = tl.tile(idx + (int)gridDim.x, nxt);
    if (has_next) g_ptrs(tl, nxt, wid, lane, Pn);
    __syncthreads();
    if (!(XF & 1)) { g_dma(lds, P, 0, 0, wid); g_dma(lds, P, 1, 1, wid); }
    int sg = 0;
    for (;;) {
        f32x16 acc[2][2];
#pragma unroll
        for (int a = 0; a < 2; ++a)
#pragma unroll
            for (int b = 0; b < 2; ++b)
#pragma unroll
                for (int r = 0; r < 16; ++r) acc[a][b][r] = 0.f;
        for (int kt = 0; kt < nk; ++kt) {
            if (!(XF & 2)) { if (kt + 1 < nk || has_next) asm volatile("s_waitcnt vmcnt(6)" ::: "memory"); else asm volatile("s_waitcnt vmcnt(0)" ::: "memory");
            __builtin_amdgcn_s_barrier(); }
            asm volatile("" ::: "memory");
            const int s2 = sg >= 1 ? sg - 1 : 2;
            if (!(XF & 1)) { if (kt + 2 < nk) g_dma(lds, P, kt + 2, s2, wid);
            else if (has_next) g_dma(lds, Pn, kt + 2 - nk, s2, wid); }
            const char* cs = lds + sg * G_STAGE;
#pragma unroll
            for (int kk = 0; kk < 4; ++kk) {
                bf16x8 fa[2], fb[2];
#pragma unroll
                for (int mi = 0; mi < 2; ++mi) fa[mi] = *(const bf16x8*)(cs + g_lds_off(wm * 64 + mi * 32 + fr, kk * 2 + fh));
#pragma unroll
                for (int ni = 0; ni < 2; ++ni) fb[ni] = *(const bf16x8*)(cs + G_ASTAGE + g_lds_off(wn * 64 + ni * 32 + fr, kk * 2 + fh));
#pragma unroll
                for (int mi = 0; mi < 2; ++mi)
#pragma unroll
                    for (int ni = 0; ni < 2; ++ni) acc[mi][ni] = __builtin_amdgcn_mfma_f32_32x32x16_bf16(fb[ni], fa[mi], acc[mi][ni], 0, 0, 0);
            }
            sg = sg == 2 ? 0 : sg + 1;
        }
        tl.epi(cur, acc, wm * 64 + fr, wn * 64 + 4 * fh);
        if (!has_next) break;
        asm volatile("s_waitcnt vmcnt(0)" ::: "memory");
        cur = nxt; P = Pn; idx += (int)gridDim.x;
        has_next = tl.tile(idx + (int)gridDim.x, nxt);
        if (has_next) g_ptrs(tl, nxt, wid, lane, Pn);
    }
    asm volatile("s_waitcnt vmcnt(0)" ::: "memory");
}

constexpr int HBK = 32, H_ASTG = 256 * HBK * 2, H_STG = 2 * H_ASTG, H_RING = 4, H_LDS = H_RING * H_STG;
__device__ __forceinline__ int h_lds_off(int r, int c) { return r * 64 + ((c ^ ((r >> 2) & 3)) << 4); }
struct HPtrs { const bf16* a[2]; const bf16* b[2]; };
template <class TL> __device__ __forceinline__ void h_ptrs(const TL& tl, const typename TL::Tile& t, int wid, int lane, HPtrs& P) {
#pragma unroll
    for (int j = 0; j < 2; ++j) { const int r = 16 * (wid * 2 + j) + (lane >> 2); const int c = (lane & 3) ^ ((r >> 2) & 3); P.a[j] = tl.arow(t, r) + 8 * c; P.b[j] = tl.brow(t, r) + 8 * c; }
}
__device__ __forceinline__ void h_dma(char* lds, const HPtrs& P, int kt, int stage, int wid) {
    char* st = lds + stage * H_STG;
#pragma unroll
    for (int j = 0; j < 2; ++j) __builtin_amdgcn_global_load_lds((const unsigned*)(P.a[j] + kt * HBK), (LAS unsigned*)(st + (wid * 2 + j) * 1024), 16, 0, 0);
#pragma unroll
    for (int j = 0; j < 2; ++j) __builtin_amdgcn_global_load_lds((const unsigned*)(P.b[j] + kt * HBK), (LAS unsigned*)(st + H_ASTG + (wid * 2 + j) * 1024), 16, 0, 0);
}
template <class TL>
__device__ __forceinline__ void gemm_stream256(char* lds, const TL& tl) {
    int tid = threadIdx.x; asm volatile("" : "+v"(tid));
    const int lane = tid & 63, wid = __builtin_amdgcn_readfirstlane(tid >> 6), wm = wid >> 1, wn = wid & 1, fr = lane & 31, fh = lane >> 5;
    constexpr int nk = TL::K / HBK;
    static_assert(nk >= 4, "K too small");
    int idx = blockIdx.x;
    typename TL::Tile cur, nxt;
    if (!tl.tile(idx, cur)) return;
    HPtrs P, Pn;
    h_ptrs(tl, cur, wid, lane, P);
    bool has_next = tl.tile(idx + (int)gridDim.x, nxt);
    if (has_next) h_ptrs(tl, nxt, wid, lane, Pn);
    asm volatile("s_waitcnt vmcnt(0)" ::: "memory");
    __syncthreads();
    h_dma(lds, P, 0, 0, wid); h_dma(lds, P, 1, 1, wid); h_dma(lds, P, 2, 2, wid);
    int sg = 0;
    for (;;) {
        f32x16 acc[2][4];
#pragma unroll
        for (int a = 0; a < 2; ++a)
#pragma unroll
            for (int b = 0; b < 4; ++b)
#pragma unroll
                for (int r = 0; r < 16; ++r) acc[a][b][r] = 0.f;
        const unsigned act = tl.active(cur, wn);
        for (int kt = 0; kt < nk; ++kt) {
            const int ahead = (nk - 1 - kt) + (has_next ? 3 : 0);
            if (ahead >= 2) asm volatile("s_waitcnt vmcnt(8)" ::: "memory"); else if (ahead == 1) asm volatile("s_waitcnt vmcnt(4)" ::: "memory"); else asm volatile("s_waitcnt vmcnt(0)" ::: "memory");
            __builtin_amdgcn_s_barrier();
            asm volatile("" ::: "memory");
            const int s3 = (sg + 3) & 3;
            if (kt + 3 < nk) h_dma(lds, P, kt + 3, s3, wid);
            else if (has_next) h_dma(lds, Pn, kt + 3 - nk, s3, wid);
            const char* cs = lds + sg * H_STG;
#pragma unroll
            for (int kk = 0; kk < 2; ++kk) {
                bf16x8 fa[2], fb[4];
#pragma unroll
                for (int mi = 0; mi < 2; ++mi) fa[mi] = *(const bf16x8*)(cs + h_lds_off(wm * 64 + mi * 32 + fr, kk * 2 + fh));
#pragma unroll
                for (int ni = 0; ni < 4; ++ni) fb[ni] = *(const bf16x8*)(cs + H_ASTG + h_lds_off(wn * 128 + ni * 32 + fr, kk * 2 + fh));
#pragma unroll
                for (int ni = 0; ni < 4; ++ni)
                    if (act & (1u << ni)) {
#pragma unroll
                        for (int mi = 0; mi < 2; ++mi) acc[mi][ni] = __builtin_amdgcn_mfma_f32_32x32x16_bf16(fb[ni], fa[mi], acc[mi][ni], 0, 0, 0);
                    }
            }
            sg = (sg + 1) & 3;
        }
        tl.epi(cur, acc, wm * 64 + fr, wn * 128 + 4 * fh);
        if (!has_next) break;
        asm volatile("s_waitcnt vmcnt(0)" ::: "memory");
        cur = nxt; P = Pn; idx += (int)gridDim.x;
        has_next = tl.tile(idx + (int)gridDim.x, nxt);
        if (has_next) h_ptrs(tl, nxt, wid, lane, Pn);
    }
    asm volatile("s_waitcnt vmcnt(0)" ::: "memory");
}

struct ARowDense { const bf16* A; int lda; int m0; __device__ __forceinline__ const bf16* operator()(int i) const { return A + (size_t)(m0 + i) * lda; } };

__device__ __forceinline__ int perm64(int rho) { const int ni = rho >> 5, g = (rho >> 3) & 3, fh = (rho >> 2) & 1, q = rho & 3; return 16 * g + 8 * fh + 4 * ni + q; }
struct EpiInProj {
    bf16* p; const float* rope;
    __device__ __forceinline__ void operator()(f32x16 (&acc)[2][2], int mrow, int ncol  ) const {
        const int nb = ncol & ~63, fh = (ncol >> 2) & 1;
#pragma unroll
        for (int mi = 0; mi < 2; ++mi) {
            const int m = mrow + mi * 32;
            if (nb >= O1 && nb < O1 + 384 && m < TL) {
                const int s = m & (S - 1);
#pragma unroll
                for (int ax = 0; ax < 2; ++ax) {
                    const int pos = ax == 0 ? (s >> 6) : (s & 63);
#pragma unroll
                    for (int ni = 0; ni < 2; ++ni)
#pragma unroll
                        for (int q = 0; q < 4; ++q) {
                            const int j = 8 * fh + 4 * ni + q;
                            const float cs = rope[(pos * 16 + j) * 2], sn = rope[(pos * 16 + j) * 2 + 1];
                            const float x1 = acc[mi][ni][8 * ax + q], x2 = acc[mi][ni][8 * ax + 4 + q];
                            acc[mi][ni][8 * ax + q] = x1 * cs - x2 * sn; acc[mi][ni][8 * ax + 4 + q] = x1 * sn + x2 * cs;
                        }
                }
            }
#pragma unroll
            for (int g = 0; g < 4; ++g) {
                const int n = nb + 16 * g + 8 * fh;
                if (n < DIN) {
                    u32x4 v; v.x = pack_bf16(acc[mi][0][4 * g], acc[mi][0][4 * g + 1]); v.y = pack_bf16(acc[mi][0][4 * g + 2], acc[mi][0][4 * g + 3]);
                    v.z = pack_bf16(acc[mi][1][4 * g], acc[mi][1][4 * g + 1]); v.w = pack_bf16(acc[mi][1][4 * g + 2], acc[mi][1][4 * g + 3]);
                    *(u32x4*)(p + (size_t)m * DIN + n) = v;
                }
            }
        }
    }
};
struct EpiInProjH {
    bf16* p; const float* rope;
    __device__ __forceinline__ void operator()(f32x16 (&acc)[2][4], int mrow, int ncol) const {
#pragma unroll
        for (int mi = 0; mi < 2; ++mi) {
            const int m = mrow + mi * 32;
#pragma unroll
            for (int ni = 0; ni < 4; ++ni) {
                const int nb = ncol + ni * 32;
                if (nb >= DIN) continue;
                if (nb >= O1 && nb < O1 + 384 && m < TL) {
                    const int s = m & (S - 1); const int pos = (ni & 1) == 0 ? (s >> 6) : (s & 63);
                    const int jb = (nb & 31);
#pragma unroll
                    for (int r = 0; r < 8; ++r) {
                        const int j = jb + (r & 3) + 8 * (r >> 2);
                        const float cs = rope[(pos * 16 + j) * 2], sn = rope[(pos * 16 + j) * 2 + 1];
                        const float x1 = acc[mi][ni][r], x2 = acc[mi][ni][r + 8];
                        acc[mi][ni][r] = x1 * cs - x2 * sn; acc[mi][ni][r + 8] = x1 * sn + x2 * cs;
                    }
                }
#pragma unroll
                for (int g = 0; g < 4; ++g) {
                    const int n = nb + 8 * g;
                    if (n < DIN) { u32x2 v; v.x = pack_bf16(acc[mi][ni][4 * g], acc[mi][ni][4 * g + 1]); v.y = pack_bf16(acc[mi][ni][4 * g + 2], acc[mi][ni][4 * g + 3]); *(u32x2*)(p + (size_t)m * DIN + n) = v; }
                }
            }
        }
    }
};
struct EpiOutProjH {
    float* xr; const float* mod;
    __device__ __forceinline__ void operator()(f32x16 (&acc)[2][4], int mrow, int ncol) const {
#pragma unroll
        for (int mi = 0; mi < 2; ++mi) {
            const int m = mrow + mi * 32; const int rb = m < TL ? m / S : 8;
            const float* g1 = mod + (size_t)rb * 6144 + 2 * D;
#pragma unroll
            for (int ni = 0; ni < 4; ++ni)
#pragma unroll
                for (int g = 0; g < 4; ++g) {
                    const int n = ncol + ni * 32 + 8 * g;
                    f32x4 gv = *(const f32x4*)(g1 + n); float* xp = xr + (size_t)m * D + n; f32x4 xv = *(const f32x4*)xp;
                    xv[0] += gv[0] * acc[mi][ni][4 * g]; xv[1] += gv[1] * acc[mi][ni][4 * g + 1]; xv[2] += gv[2] * acc[mi][ni][4 * g + 2]; xv[3] += gv[3] * acc[mi][ni][4 * g + 3];
                    *(f32x4*)xp = xv;
                }
        }
    }
};
struct EpiOutProj {
    float* xr; const float* mod; const float* xin; const float* cin;
    __device__ __forceinline__ void operator()(f32x16 (&acc)[2][2], int mrow, int ncol) const {
#pragma unroll
        for (int mi = 0; mi < 2; ++mi) {
            const int m = mrow + mi * 32; const int rb = m < TL ? m / S : 8;
            const float* g1 = mod + (size_t)rb * 6144 + 2 * D;
            const float* src = xin ? (m < TL ? xin + (size_t)m * D : cin + (size_t)(m - TL) * D) : xr + (size_t)m * D;
#pragma unroll
            for (int ni = 0; ni < 2; ++ni)
#pragma unroll
                for (int g = 0; g < 4; ++g) {
                    const int n = ncol + ni * 32 + 8 * g;
                    f32x4 gv = *(const f32x4*)(g1 + n); f32x4 xv = *(const f32x4*)(src + n);
                    xv[0] += gv[0] * acc[mi][ni][4 * g]; xv[1] += gv[1] * acc[mi][ni][4 * g + 1]; xv[2] += gv[2] * acc[mi][ni][4 * g + 2]; xv[3] += gv[3] * acc[mi][ni][4 * g + 3];
                    *(f32x4*)(xr + (size_t)m * D + n) = xv;
                }
        }
    }
};
#endif
#ifndef HOST_SIM
template <class NMap>
__device__ __forceinline__ void cvt_tile(char* lds, const float* __restrict__ src, int srcN, bf16* __restrict__ dst, int dstK, int k0, int n0, int nvalid  , int nrows  , const NMap& nmap) {
    int tid = threadIdx.x; asm volatile("" : "+v"(tid));
    bf16* t = (bf16*)lds;
    __syncthreads();
#pragma unroll
    for (int i = 0; i < 2; ++i) {
        const int c = tid + i * NTHREADS, k = c >> 4, n4 = (c & 15) * 4;
        f32x4 v = {0.f, 0.f, 0.f, 0.f};
        if (n0 + n4 < nvalid) v = *(const f32x4*)(src + (size_t)(k0 + k) * srcN + n0 + n4);
#pragma unroll
        for (int q = 0; q < 4; ++q) t[(n4 + q) * 66 + k] = f2bf(v[q]);
    }
    __syncthreads();
    {
        const int n = tid >> 3, kc = tid & 7;
        if (n0 + n < nrows) {
            const unsigned* s = (const unsigned*)(t + n * 66 + kc * 8);
            u32x4 o; o.x = s[0]; o.y = s[1]; o.z = s[2]; o.w = s[3];
            *(u32x4*)(dst + (size_t)nmap(n0 + n) * dstK + k0 + kc * 8) = o;
        }
    }
}

template <class NMap>
__device__ __forceinline__ void cvt_strip(char* lds, const float* __restrict__ src, int srcN, bf16* __restrict__ dst, int dstK, int k0, int n0, int nvalid, int nrows, const NMap& nmap) {
    int tid = threadIdx.x; asm volatile("" : "+v"(tid));
    bf16* t = (bf16*)lds;
    __syncthreads();
    f32x4 v[8];
#pragma unroll
    for (int i = 0; i < 8; ++i) {
        const int c = tid + i * NTHREADS, k = c >> 6, n4 = (c & 63) * 4;
        v[i] = (f32x4){0.f, 0.f, 0.f, 0.f};
        if (n0 + n4 < nvalid) v[i] = *(const f32x4*)(src + (size_t)(k0 + k) * srcN + n0 + n4);
    }
#pragma unroll
    for (int i = 0; i < 8; ++i) {
        const int c = tid + i * NTHREADS, k = c >> 6, n4 = (c & 63) * 4;
#pragma unroll
        for (int q = 0; q < 4; ++q) t[(n4 + q) * 66 + k] = f2bf(v[i][q]);
    }
    __syncthreads();
#pragma unroll
    for (int i = 0; i < 4; ++i) {
        const int n = (tid >> 3) + i * 64, kc = tid & 7;
        if (n0 + n < nrows) {
            const unsigned* s = (const unsigned*)(t + n * 66 + kc * 8);
            u32x4 o; o.x = s[0]; o.y = s[1]; o.z = s[2]; o.w = s[3];
            *(u32x4*)(dst + (size_t)nmap(n0 + n) * dstK + k0 + kc * 8) = o;
        }
    }
}
struct NMapId { __device__ __forceinline__ int operator()(int n) const { return n; } };
struct NMapUp { int which; __device__ __forceinline__ int operator()(int j) const { return (j >> 7) * 256 + ((j >> 6) & 1) * 128 + which * 64 + (j & 63); } };
#endif
#ifndef HOST_SIM
__device__ __forceinline__ float wave_sum(float v) {
#pragma unroll
    for (int o = 32; o > 0; o >>= 1) v += __shfl_xor(v, o);
    return v;
}
template <int MODE, int NORM>
__device__ __forceinline__ void row_pass(const WS& w, const Inputs& in, int ntok, const float* mod_cur  , const float* mod_nrm  ,
                                         const float* gnorm, int shc, int scc, const bf16* y, const float* topw, float* out, bf16* hout, int t_first = -1, int t_end = 0, int t_step = 0) {
    int tid = threadIdx.x; asm volatile("" : "+v"(tid));
    const int lane = tid & 63, wv = tid >> 6;
    if (t_first < 0) { t_first = blockIdx.x * 8 + wv; t_end = ntok; t_step = gridDim.x * 8; }
    for (int t = t_first; t < t_end; t += t_step) {
        const int rb = t < TL ? t / S : 8;
        f32x4 v[4];
        float* xrow = w.xr + (size_t)t * D;
        if (MODE == 0 || MODE == 3) {
            const float* src = t < TL ? in.x + (size_t)t * D : in.ctx + (size_t)(t - TL) * D;
#pragma unroll
            for (int j = 0; j < 4; ++j) { v[j] = *(const f32x4*)(src + j * 256 + lane * 4); if (MODE == 0) st_wt16(xrow + j * 256 + lane * 4, v[j]); }
        } else {
#pragma unroll
            for (int j = 0; j < 4; ++j) v[j] = *(const f32x4*)(xrow + j * 256 + lane * 4);
        }
        if (MODE == 2) {
            const float* g2 = mod_cur + (size_t)rb * 6144 + 5 * D;
            f32x4 f[4];
#pragma unroll
            for (int j = 0; j < 4; ++j) f[j] = (f32x4){0.f, 0.f, 0.f, 0.f};
#pragma unroll
            for (int k = 0; k < 4; ++k) {
                const float wk = topw[(size_t)t * 4 + k]; const bf16* yr = y + ((size_t)t * 4 + k) * D;
#pragma unroll
                for (int j = 0; j < 4; ++j) { u32x2 u = *(const u32x2*)(yr + j * 256 + lane * 4);
                    f[j][0] += wk * __uint_as_float(u.x << 16); f[j][1] += wk * __uint_as_float(u.x & 0xffff0000u); f[j][2] += wk * __uint_as_float(u.y << 16); f[j][3] += wk * __uint_as_float(u.y & 0xffff0000u); }
            }
#pragma unroll
            for (int j = 0; j < 4; ++j) { f32x4 g = *(const f32x4*)(g2 + j * 256 + lane * 4); v[j] += g * f[j]; st_wt16(xrow + j * 256 + lane * 4, v[j]); }
        }
        if (NORM == 0) continue;
        if (NORM == 2 && t >= TL) continue;
        float ss = 0.f;
#pragma unroll
        for (int j = 0; j < 4; ++j) ss += v[j][0] * v[j][0] + v[j][1] * v[j][1] + v[j][2] * v[j][2] + v[j][3] * v[j][3];
        ss = wave_sum(ss);
        const float rstd = 1.0f / sqrtf(ss * (1.0f / D) + EPS);
        if (NORM == 1) {
            const float* m = mod_nrm + (size_t)rb * 6144;
#pragma unroll
            for (int j = 0; j < 4; ++j) {
                const int c = j * 256 + lane * 4;
                f32x4 g = *(const f32x4*)(gnorm + c), sc = *(const f32x4*)(m + scc * D + c), sh = *(const f32x4*)(m + shc * D + c);
                f32x4 hv = v[j] * rstd * g * (sc + 1.0f) + sh;
                u32x2 u; u.x = pack_bf16(hv[0], hv[1]); u.y = pack_bf16(hv[2], hv[3]);
                *(u32x2*)(hout + (size_t)t * D + c) = u;
            }
        } else {
#pragma unroll
            for (int j = 0; j < 4; ++j) { const int c = j * 256 + lane * 4; f32x4 g = *(const f32x4*)(gnorm + c); st_wt16(out + (size_t)t * D + c, v[j] * rstd * g); }
        }
    }
}

constexpr int CNT_PAD = 32;
__device__ __forceinline__ void router_rows(char* lds, const WS& w, const float* ebias, int r0, int r1, int l) {
    int tid = threadIdx.x; asm volatile("" : "+v"(tid));
    const int lane = tid & 63, wv = tid >> 6, fr = lane & 15, fq = lane >> 4;
    float* sl = (float*)lds + wv * (16 * 33);
    int* lcnt = (int*)(lds + 8 * 16 * 33 * 4);
    const bf16* Bt = w.wrT + (size_t)l * 32 * 1024;
    int* cnt = w.cnt + l * 32 * CNT_PAD; int* list = w.list;
    const int t0 = r0 + wv * 16;
    if (tid < 32) lcnt[tid] = 0;
    if (t0 < r1) {
        f32x4 a0 = {0.f, 0.f, 0.f, 0.f}, a1 = {0.f, 0.f, 0.f, 0.f};
        const int ra = t0 + fr < r1 ? t0 + fr : r1 - 1;
        const bf16* ar = w.h + (size_t)ra * D + fq * 8;
        const bf16* b0 = Bt + (size_t)fr * 1024 + fq * 8; const bf16* b1 = b0 + 16 * 1024;
#pragma unroll 8
        for (int ks = 0; ks < 32; ++ks) {
            bf16x8 fa = *(const bf16x8*)(ar + ks * 32), fb0 = *(const bf16x8*)(b0 + ks * 32), fb1 = *(const bf16x8*)(b1 + ks * 32);
            a0 = __builtin_amdgcn_mfma_f32_16x16x32_bf16(fa, fb0, a0, 0, 0, 0);
            a1 = __builtin_amdgcn_mfma_f32_16x16x32_bf16(fa, fb1, a1, 0, 0, 0);
        }
#pragma unroll
        for (int j = 0; j < 4; ++j) { sl[(4 * fq + j) * 33 + fr] = a0[j]; sl[(4 * fq + j) * 33 + 16 + fr] = a1[j]; }
    }
    __builtin_amdgcn_wave_barrier(); asm volatile("s_waitcnt lgkmcnt(0)" ::: "memory");
    float* sb = (float*)lds + 8 * 16 * 33 + 64 + wv * (16 * 33);
    if (t0 < r1) {
#pragma unroll
        for (int q = 0; q < 8; ++q) { const int e = (lane >> 4) * 8 + q; const float sg = 1.0f / (1.0f + __expf(-sl[(lane & 15) * 33 + e])); sl[(lane & 15) * 33 + e] = sg; sb[(lane & 15) * 33 + e] = sg + ebias[e]; }
    }
    __syncthreads();
    int sel[4]; int lpos[4];
    const bool mine = lane < 16 && t0 + lane < r1;
    if (mine) {
        const int t = t0 + lane; const float* sr = sl + lane * 33; const float* br = sb + lane * 33;
        float ss[4]; float sum = 0.f;
#pragma unroll
        for (int k = 0; k < 4; ++k) {
            int best = 0; float bv = -1e30f;
            for (int e = 0; e < 32; ++e) {
                bool used = false;
#pragma unroll
                for (int q = 0; q < 4; ++q) if (q < k && sel[q] == e) used = true;
                const float vv = br[e];
                if (!used && vv > bv) { bv = vv; best = e; }
            }
            sel[k] = best; ss[k] = sr[best]; sum += ss[k];
        }
        const float inv = ROUTED_SCALE / sum;
#pragma unroll
        for (int k = 0; k < 4; ++k) { w.topw[(size_t)t * 4 + k] = ss[k] * inv; lpos[k] = atomicAdd(&lcnt[sel[k]], 1); }
    }
    __syncthreads();
    if (tid < 32) lcnt[32 + tid] = atomicAdd(&cnt[tid * CNT_PAD], lcnt[tid]);
    __syncthreads();
    if (mine) {
        const int t = t0 + lane;
#pragma unroll
        for (int k = 0; k < 4; ++k) list[(size_t)sel[k] * T + lcnt[32 + sel[k]] + lpos[k]] = t * 4 + k;
    }
    __syncthreads();
}
__device__ __forceinline__ void phase_norm2_router(char* lds, const WS& w, const Inputs& in, int ntok, const float* mod, const float* gnorm, const float* ebias, int l) {
    int rpb = (ntok + (int)gridDim.x - 1) / (int)gridDim.x; if (rpb > 128) rpb = 128;
    for (int r0 = blockIdx.x * rpb; r0 < ntok; r0 += gridDim.x * rpb) {
        const int r1 = r0 + rpb < ntok ? r0 + rpb : ntok;
        row_pass<1, 1>(w, in, ntok, mod, mod, gnorm, 3, 4, nullptr, nullptr, nullptr, w.h, r0 + (int)(threadIdx.x >> 6), r1, 8);
        asm volatile("s_waitcnt vmcnt(0)" ::: "memory");
        __syncthreads();
        router_rows(lds, w, ebias, r0, r1, l);
    }
}

__device__ __forceinline__ bool moe_decode(int tile, int NT, const int* cnt, int ntok, int& e, int& mt, int& nt, int& base, int& rows) {
    int t = tile / NT; nt = tile % NT; int b = 0;
    for (int i = 0; i < 33; ++i) {
        const int c = i < 32 ? cnt[i * CNT_PAD] : ntok; const int m = (c + GBM - 1) / GBM;
        if (t < m) { e = i; mt = t; rows = c; base = b; return true; }
        t -= m; b += c;
    }
    return false;
}
struct ARowGather {
    const bf16* A; const int* list; int rows; int r0; bool ident;
    __device__ __forceinline__ const bf16* operator()(int i) const {
        const int idx = r0 + i; int tok = 0;
        if (idx < rows) tok = ident ? idx : (list[idx] >> 2);
        return A + (size_t)tok * D;
    }
};
struct EpiUp {
    bf16* hid; int base; int rows;
    __device__ __forceinline__ void operator()(f32x16 (&acc)[2][2], int mrow, int ncol) const {
        const int hc = (ncol >> 7) * 64 + ((ncol >> 6) & 1) * 32 + (ncol & 63);
#pragma unroll
        for (int mi = 0; mi < 2; ++mi) {
            const int idx = mrow + mi * 32;
            if (idx < rows) {
#pragma unroll
                for (int g = 0; g < 4; ++g) {
                    float o[4];
#pragma unroll
                    for (int q = 0; q < 4; ++q) { const float gt = acc[mi][0][4 * g + q], up = acc[mi][1][4 * g + q]; o[q] = gt / (1.0f + expf(-gt)) * up; }
                    u32x2 v; v.x = pack_bf16(o[0], o[1]); v.y = pack_bf16(o[2], o[3]);
                    *(u32x2*)(hid + (size_t)(base + idx) * 256 + hc + 8 * g) = v;
                }
            }
        }
    }
};
struct EpiDown {
    bf16* y; const int* list; int rows; bool shared; float* xr; const float* mod;
    __device__ __forceinline__ void operator()(f32x16 (&acc)[2][2], int mrow, int ncol) const {
#pragma unroll
        for (int mi = 0; mi < 2; ++mi) {
            const int idx = mrow + mi * 32;
            if (idx < rows) {
                if (!shared) {
                    const int asg = list[idx];
#pragma unroll
                    for (int ni = 0; ni < 2; ++ni)
#pragma unroll
                        for (int g = 0; g < 4; ++g) {
                            u32x2 v; v.x = pack_bf16(acc[mi][ni][4 * g], acc[mi][ni][4 * g + 1]); v.y = pack_bf16(acc[mi][ni][4 * g + 2], acc[mi][ni][4 * g + 3]);
                            *(u32x2*)(y + (size_t)asg * D + ncol + ni * 32 + 8 * g) = v;
                        }
                } else {
                    const int rb = idx < TL ? idx / S : 8; const float* g2 = mod + (size_t)rb * 6144 + 5 * D;
#pragma unroll
                    for (int ni = 0; ni < 2; ++ni)
#pragma unroll
                        for (int g = 0; g < 4; ++g) {
                            const int n = ncol + ni * 32 + 8 * g;
                            f32x4 gv = *(const f32x4*)(g2 + n); float* xp = xr + (size_t)idx * D + n; f32x4 xv = *(const f32x4*)xp;
                            xv[0] += gv[0] * acc[mi][ni][4 * g]; xv[1] += gv[1] * acc[mi][ni][4 * g + 1]; xv[2] += gv[2] * acc[mi][ni][4 * g + 2]; xv[3] += gv[3] * acc[mi][ni][4 * g + 3];
                            *(f32x4*)xp = xv;
                        }
                }
            }
        }
    }
};
struct EpiUpH {
    bf16* hid; int base; int rows;
    __device__ __forceinline__ void operator()(f32x16 (&acc)[2][4], int mrow, int ncol  ) const {
        const int fh = (ncol >> 2) & 1; const int hc = (ncol >> 8) * 128 + ((ncol >> 7) & 1) * 64 + 8 * fh;
#pragma unroll
        for (int mi = 0; mi < 2; ++mi) {
            const int idx = mrow + mi * 32;
            if (idx < rows) {
#pragma unroll
                for (int g = 0; g < 4; ++g) {
                    float o[8];
#pragma unroll
                    for (int nh = 0; nh < 2; ++nh)
#pragma unroll
                        for (int q = 0; q < 4; ++q) { const float gt = acc[mi][nh][4 * g + q], up = acc[mi][nh + 2][4 * g + q]; o[4 * nh + q] = gt / (1.0f + __expf(-gt)) * up; }
                    u32x4 v; v.x = pack_bf16(o[0], o[1]); v.y = pack_bf16(o[2], o[3]); v.z = pack_bf16(o[4], o[5]); v.w = pack_bf16(o[6], o[7]);
                    *(u32x4*)(hid + (size_t)(base + idx) * 256 + hc + 16 * g) = v;
                }
            }
        }
    }
};
__device__ __forceinline__ int down_perm(int rho) { const int ni = rho >> 5, g = (rho >> 3) & 3, fh = (rho >> 2) & 1, q = rho & 3; return 64 * (ni >> 1) + 16 * g + 8 * fh + 4 * (ni & 1) + q; }
struct EpiDownH {
    bf16* y; const int* list; int rows; bool shared; float* xr; const float* mod;
    __device__ __forceinline__ void operator()(f32x16 (&acc)[2][4], int mrow, int ncol  ) const {
        const int nbase = (ncol & ~127), fh = (ncol >> 2) & 1;
#pragma unroll
        for (int mi = 0; mi < 2; ++mi) {
            const int idx = mrow + mi * 32;
            if (idx < rows) {
                if (!shared) {
                    const int asg = list[idx];
#pragma unroll
                    for (int hp = 0; hp < 2; ++hp)
#pragma unroll
                        for (int g = 0; g < 4; ++g) {
                            u32x4 v; v.x = pack_bf16(acc[mi][2 * hp][4 * g], acc[mi][2 * hp][4 * g + 1]); v.y = pack_bf16(acc[mi][2 * hp][4 * g + 2], acc[mi][2 * hp][4 * g + 3]);
                            v.z = pack_bf16(acc[mi][2 * hp + 1][4 * g], acc[mi][2 * hp + 1][4 * g + 1]); v.w = pack_bf16(acc[mi][2 * hp + 1][4 * g + 2], acc[mi][2 * hp + 1][4 * g + 3]);
                            *(u32x4*)(y + (size_t)asg * D + nbase + 64 * hp + 16 * g + 8 * fh) = v;
                        }
                } else {
                    const int rb = idx < TL ? idx / S : 8; const float* g2 = mod + (size_t)rb * 6144 + 5 * D;
#pragma unroll
                    for (int hp = 0; hp < 2; ++hp)
#pragma unroll
                        for (int g = 0; g < 4; ++g)
#pragma unroll
                            for (int nl = 0; nl < 2; ++nl) {
                                const int n = nbase + 64 * hp + 16 * g + 8 * fh + 4 * nl;
                                f32x4 gv = *(const f32x4*)(g2 + n); float* xp = xr + (size_t)idx * D + n; f32x4 xv = *(const f32x4*)xp;
                                xv[0] += gv[0] * acc[mi][2 * hp + nl][4 * g]; xv[1] += gv[1] * acc[mi][2 * hp + nl][4 * g + 1]; xv[2] += gv[2] * acc[mi][2 * hp + nl][4 * g + 2]; xv[3] += gv[3] * acc[mi][2 * hp + nl][4 * g + 3];
                                *(f32x4*)xp = xv;
                            }
                }
            }
        }
    }
};
struct TLMoeUp {
    const WS* w; const int* cnt; int ntok; static constexpr int K = 1024;
    struct Tile { int e, mt, nt, base, rows; };
    __device__ __forceinline__ bool tile(int idx, Tile& t) const { return moe_decode(idx, 2, cnt, ntok, t.e, t.mt, t.nt, t.base, t.rows); }
    __device__ __forceinline__ unsigned active(const Tile&, int) const { return 15u; }
    __device__ __forceinline__ const bf16* arow(const Tile& t, int r) const {
        const int i = t.mt * GBM + r; int tok = 0;
        if (i < t.rows) tok = t.e == 32 ? i : (w->list[(size_t)t.e * T + i] >> 2);
        return w->h + (size_t)tok * D;
    }
    __device__ __forceinline__ const bf16* brow(const Tile& t, int r) const { return w->moeUpT + ((size_t)t.e * 512 + t.nt * 256 + (r & ~63) + perm64(r & 63)) * 1024; }
    __device__ __forceinline__ void epi(const Tile& t, f32x16 (&acc)[2][4], int mr, int nc) const { EpiUpH{w->hid2, t.base, t.rows}(acc, t.mt * GBM + mr, t.nt * 256 + nc); }
};
struct TLMoeDown {
    const WS* w; const int* cnt; int ntok; const float* mod; static constexpr int K = 256;
    struct Tile { int e, mt, nt, base, rows; };
    __device__ __forceinline__ bool tile(int idx, Tile& t) const { return moe_decode(idx, 4, cnt, ntok, t.e, t.mt, t.nt, t.base, t.rows); }
    __device__ __forceinline__ unsigned active(const Tile&, int) const { return 15u; }
    __device__ __forceinline__ const bf16* arow(const Tile& t, int r) const { return w->hid2 + (size_t)(t.base + t.mt * GBM + r) * 256; }
    __device__ __forceinline__ const bf16* brow(const Tile& t, int r) const { return w->moeDownT + ((size_t)t.e * 1024 + t.nt * 256 + (r & 128) + down_perm(r & 127)) * 256; }
    __device__ __forceinline__ void epi(const Tile& t, f32x16 (&acc)[2][4], int mr, int nc) const {
        EpiDownH{(bf16*)w->h, w->list + (size_t)t.e * T, t.rows, t.e == 32, w->xr, mod}(acc, t.mt * GBM + mr, t.nt * 256 + nc);
    }
};
struct TLMoeDownR : TLMoeDown {
    __device__ __forceinline__ bool tile(int idx, Tile& t) const { return moe_decode(idx, 4, cnt, ntok, t.e, t.mt, t.nt, t.base, t.rows) && t.e < 32; }
};
__device__ __forceinline__ void phase_moe_down_routed(char* lds, const WS& w, int l, int ntok, const float* mod) { TLMoeDownR tl; tl.w = &w; tl.cnt = w.cnt + l * 32 * CNT_PAD; tl.ntok = ntok; tl.mod = mod; gemm_stream256(lds, tl); }
__device__ __forceinline__ void phase_moe_up(char* lds, const WS& w, int l, int ntok) { gemm_stream256(lds, TLMoeUp{&w, w.cnt + l * 32 * CNT_PAD, ntok}); }
__device__ __forceinline__ void phase_moe_down(char* lds, const WS& w, int l, int ntok, const float* mod) { gemm_stream256(lds, TLMoeDown{&w, w.cnt + l * 32 * CNT_PAD, ntok, mod}); }
#endif
#ifndef HOST_SIM
__device__ __forceinline__ void phase_ada(char* lds, const WS& w, const Inputs& in) {
    int tid = threadIdx.x; asm volatile("" : "+v"(tid));
    const int lane = tid & 63, wv = tid >> 6;
    float* sc = (float*)lds;
    float* red = sc + 9 * 1024;
    if ((int)blockIdx.x >= 192) return;
    __syncthreads();
    for (int i = tid; i < 9 * 1024; i += NTHREADS) { const int r = i >> 10, k = i & 1023; const float v = r < 8 ? in.c[(size_t)(r % B) * D + k] : in.c_ctx[k]; sc[i] = v / (1.0f + __expf(-v)); }
    __syncthreads();
    for (int it = blockIdx.x; it < 192; it += gridDim.x) {
        const int l = it / 96, n = (it % 96) * 64 + lane;
        const float* wp = in.w_ada + (size_t)l * D * 6144 + (size_t)(wv * 128) * 6144 + n;
        float acc[9];
#pragma unroll
        for (int r = 0; r < 9; ++r) acc[r] = 0.f;
        for (int kb = 0; kb < 128; kb += 16) {
            float wq[16];
#pragma unroll
            for (int i = 0; i < 16; ++i) wq[i] = wp[(size_t)(kb + i) * 6144];
#pragma unroll
            for (int r = 0; r < 9; ++r) {
                const float* sr = sc + r * 1024 + wv * 128 + kb;
#pragma unroll
                for (int i4 = 0; i4 < 4; ++i4) { const f32x4 s4 = *(const f32x4*)(sr + 4 * i4); acc[r] += s4[0] * wq[4 * i4] + s4[1] * wq[4 * i4 + 1] + s4[2] * wq[4 * i4 + 2] + s4[3] * wq[4 * i4 + 3]; }
            }
        }
#pragma unroll
        for (int r = 0; r < 9; ++r) red[(wv * 9 + r) * 64 + lane] = acc[r];
        __syncthreads();
        for (int i = tid; i < 9 * 64; i += NTHREADS) {
            const int r = i >> 6, c = i & 63; float s = 0.f;
#pragma unroll
            for (int q = 0; q < 8; ++q) s += red[(q * 9 + r) * 64 + c];
            const int nn = (it % 96) * 64 + c;
            w.mod[((size_t)l * 9 + r) * 6144 + nn] = s + in.b_ada[l * 6144 + nn];
        }
        __syncthreads();
    }
}
#endif
#ifndef HOST_SIM
typedef short s16x4 __attribute__((ext_vector_type(4)));
constexpr int AT_KV = 64 * 128;
constexpr int AT_STAGE = 2 * AT_KV;
__device__ __forceinline__ int at_voff(int key, int dcol) { return key * 128 + ((((dcol >> 5) ^ ((key >> 1) & 1))) << 6) + ((dcol & 31) << 1); }
__device__ __forceinline__ int at_kappa(int r) { return (r & ~12) | ((r & 4) << 1) | ((r & 8) >> 1); }

struct AttnState { f32x16 o[2]; float m, l; };

__device__ __forceinline__ void at_qk(const char* st, const bf16x8 (&qf)[4], f32x16 (&s)[2], int lane) {
    const int fr = lane & 31, fh = lane >> 5, kr = at_kappa(fr);
#pragma unroll
    for (int tt = 0; tt < 2; ++tt) {
#pragma unroll
        for (int r = 0; r < 16; ++r) s[tt][r] = 0.f;
#pragma unroll
        for (int ks = 0; ks < 4; ++ks) {
            const bf16x8 kf = *(const bf16x8*)(st + g_lds_off(32 * tt + kr, ks * 2 + fh));
            s[tt] = __builtin_amdgcn_mfma_f32_32x32x16_bf16(kf, qf[ks], s[tt], 0, 0, 0);
        }
    }
}
__device__ __forceinline__ void at_softmax_pv(const char* st, f32x16 (&s)[2], AttnState& a, int lane) {
    float mx = -1e30f;
#pragma unroll
    for (int tt = 0; tt < 2; ++tt)
#pragma unroll
        for (int r = 0; r < 16; ++r) mx = fmaxf(mx, s[tt][r]);
    mx = fmaxf(mx, __shfl_xor(mx, 32));
    const float mn = fmaxf(a.m, mx), alpha = __builtin_amdgcn_exp2f(a.m - mn);
    float rs = 0.f;
#pragma unroll
    for (int tt = 0; tt < 2; ++tt)
#pragma unroll
        for (int r = 0; r < 16; ++r) { const float p = __builtin_amdgcn_exp2f(s[tt][r] - mn); s[tt][r] = p; rs += p; }
    rs += __shfl_xor(rs, 32);
    a.l = a.l * alpha + rs;
    if (__builtin_amdgcn_ballot_w64(mn > a.m) != 0ull) {
#pragma unroll
        for (int dt = 0; dt < 2; ++dt)
#pragma unroll
            for (int r = 0; r < 16; ++r) a.o[dt][r] *= alpha;
    }
    a.m = mn;
    const int fh = lane >> 5, i16 = lane & 15, g1 = (lane >> 4) & 1;
    const char* vb = st + AT_KV;
#pragma unroll
    for (int tt = 0; tt < 2; ++tt)
#pragma unroll
        for (int sp = 0; sp < 2; ++sp) {
            union { bf16x8 v; unsigned u[4]; } pu;
#pragma unroll
            for (int j = 0; j < 4; ++j) pu.u[j] = pack_bf16(s[tt][8 * sp + 2 * j], s[tt][8 * sp + 2 * j + 1]);
            const bf16x8 pf = pu.v;
#pragma unroll
            for (int dt = 0; dt < 2; ++dt) {
                const int kb = 32 * tt + 16 * sp + 8 * fh + (i16 >> 2), dc = 32 * dt + 16 * g1 + 4 * (i16 & 3);
                const s16x4 v0 = __builtin_amdgcn_ds_read_tr16_b64_v4i16((LAS s16x4*)(vb + at_voff(kb, dc)));
                const s16x4 v1 = __builtin_amdgcn_ds_read_tr16_b64_v4i16((LAS s16x4*)(vb + at_voff(kb + 4, dc)));
                bf16x8 vf; vf[0] = v0[0]; vf[1] = v0[1]; vf[2] = v0[2]; vf[3] = v0[3]; vf[4] = v1[0]; vf[5] = v1[1]; vf[6] = v1[2]; vf[7] = v1[3];
                a.o[dt] = __builtin_amdgcn_mfma_f32_32x32x16_bf16(vf, pf, a.o[dt], 0, 0, 0);
            }
        }
}
__device__ __forceinline__ void at_store(const AttnState& a, bf16* orow  , int lane) {
    const float il = 1.0f / a.l; const int fh = lane >> 5;
#pragma unroll
    for (int dt = 0; dt < 2; ++dt)
#pragma unroll
        for (int g = 0; g < 4; ++g) {
            u32x2 v; v.x = pack_bf16(a.o[dt][4 * g] * il, a.o[dt][4 * g + 1] * il); v.y = pack_bf16(a.o[dt][4 * g + 2] * il, a.o[dt][4 * g + 3] * il);
            *(u32x2*)(orow + 32 * dt + 8 * g + 4 * fh) = v;
        }
}
struct AtRegs { u32x4 k, v; };
__device__ __forceinline__ AtRegs at_load(const bf16* kbase, const bf16* vbase, int tid) {
    const int key = tid >> 3, c = tid & 7; AtRegs r;
    r.k = *(const u32x4*)(kbase + (size_t)key * DIN + c * 8); r.v = *(const u32x4*)(vbase + (size_t)key * DIN + c * 8); return r;
}
__device__ __forceinline__ void at_write(char* st, const AtRegs& r, int tid) {
    const int key = tid >> 3, c = tid & 7;
    *(u32x4*)(st + g_lds_off(key, c)) = r.k; *(u32x4*)(st + AT_KV + at_voff(key, c * 8)) = r.v;
}
__device__ __forceinline__ void at_dma(char* st, const bf16* kbase, int voff, int wid, int lane) {
    const int r = 8 * wid + (lane >> 3), pos = lane & 7;
    const bf16* kr = kbase + (size_t)r * DIN;
    const int ck = pos ^ ((r >> 1) & 7), cv = 4 * ((pos >> 2) ^ ((r >> 1) & 1)) + (pos & 3);
    __builtin_amdgcn_global_load_lds((const unsigned*)(kr + 8 * ck), (LAS unsigned*)(st + wid * 1024), 16, 0, 0);
    __builtin_amdgcn_global_load_lds((const unsigned*)(kr + voff + 8 * cv), (LAS unsigned*)(st + AT_KV + wid * 1024), 16, 0, 0);
}
#define AT_WAIT(n) asm volatile("s_waitcnt vmcnt(" #n ")" ::: "memory")
__device__ __forceinline__ void at_wait_tile(int remaining_after  ) {
    if (remaining_after >= 2) AT_WAIT(4); else if (remaining_after == 1) AT_WAIT(2); else AT_WAIT(0);
    __builtin_amdgcn_s_barrier();
    asm volatile("" ::: "memory");
}
constexpr int AT_RING = 4;
__device__ __forceinline__ void at_loadq(bf16x8 (&qf)[4], const bf16* qrow, int lane) {
    const int fh = lane >> 5;
#pragma unroll
    for (int ks = 0; ks < 4; ++ks) qf[ks] = *(const bf16x8*)(qrow + ks * 16 + fh * 8);
}
__device__ __forceinline__ int at_key(int tt, int r, int fh) { return 32 * tt + (r & 3) + 8 * fh + 4 * ((r >> 2) & 1) + 16 * (r >> 3); }

__device__ __forceinline__ void attn_wa_item(char* lds, const bf16* p, bf16* ycat, const float* sink, int b, int hk, int qb, bool ctxq) {
    int tid = threadIdx.x; asm volatile("" : "+v"(tid));
    const int lane = tid & 63, wv = tid >> 6, fr = lane & 31, fh = lane >> 5;
    const int hq = 2 * hk + (wv >> 2);
    const int qpos = qb * 128 + (wv & 3) * 32 + fr;
    const size_t qtok = ctxq ? (size_t)TL + (size_t)b * LC + qpos : (size_t)b * S + qpos;
    bf16x8 qf[4]; at_loadq(qf, p + qtok * DIN + O1 + hq * 64, lane);
    AttnState a;
#pragma unroll
    for (int dt = 0; dt < 2; ++dt)
#pragma unroll
        for (int r = 0; r < 16; ++r) a.o[dt][r] = 0.f;
    a.m = sink[hq] * 1.4426950408889634f; a.l = 1.0f;
    int lo = qb * 128 - 128, hi = qb * 128 + 256; if (lo < 0) lo = 0; if (hi > S) hi = S;
    const int nloc = ctxq ? 0 : (hi - lo) / 64, nt = 4 + nloc;
    const bf16* kc = p + ((size_t)TL + (size_t)b * LC) * DIN + O1 + 256 + hk * 64;
    const bf16* kl = p + ((size_t)b * S + lo) * DIN + O1 + 256 + hk * 64;
    const int wid = __builtin_amdgcn_readfirstlane(wv);
    asm volatile("s_waitcnt vmcnt(0)" ::: "memory");
    __syncthreads();
#define AT_TILE_K(i_) ((i_) < 4 ? kc + (size_t)(i_) * 64 * DIN : kl + (size_t)((i_) - 4) * 64 * DIN)
    for (int i = 0; i < 3 && i < nt; ++i) at_dma(lds + i * AT_STAGE, AT_TILE_K(i), 128, wid, lane);
    for (int i = 0; i < nt; ++i) {
        const char* st = lds + (i & 3) * AT_STAGE;
        at_wait_tile(nt - 1 - i);
        if (i + 3 < nt) at_dma(lds + ((i + 3) & 3) * AT_STAGE, AT_TILE_K(i + 3), 128, wid, lane);
        if (i >= 4) { const int kb0w = lo + (i - 4) * 64, q0w = qb * 128 + (wv & 3) * 32; if (kb0w + 63 < q0w - WINDOW || kb0w > q0w + 31 + WINDOW) continue; }
        f32x16 s[2]; at_qk(st, qf, s, lane);
        if (i < 4) {
#pragma unroll
            for (int tt = 0; tt < 2; ++tt)
#pragma unroll
                for (int r = 0; r < 16; ++r) s[tt][r] *= 0.125f * 1.4426950408889634f;
        } else {
            const int kb0 = lo + (i - 4) * 64, q0w = qb * 128 + (wv & 3) * 32;
            if (kb0 >= q0w + 31 - WINDOW && kb0 + 63 <= q0w + WINDOW) {
#pragma unroll
                for (int tt = 0; tt < 2; ++tt)
#pragma unroll
                    for (int r = 0; r < 16; ++r) s[tt][r] *= 0.125f * 1.4426950408889634f;
            } else {
#pragma unroll
                for (int tt = 0; tt < 2; ++tt)
#pragma unroll
                    for (int r = 0; r < 16; ++r) { const int d = kb0 + at_key(tt, r, fh) - qpos; s[tt][r] = (d >= -WINDOW && d <= WINDOW) ? s[tt][r] * (0.125f * 1.4426950408889634f) : -1e30f; }
            }
        }
        at_softmax_pv(st, s, a, lane);
    }
    at_store(a, ycat + qtok * 1024 + 256 + hq * 64, lane);
}
__device__ __forceinline__ void attn_na_item(char* lds, const bf16* p, bf16* ycat, const float* rpb  , int b, int h, int rg4, bool ctxq) {
    int tid = threadIdx.x; asm volatile("" : "+v"(tid));
    const int lane = tid & 63, wv = tid >> 6, fr = lane & 31, fh = lane >> 5;
    const int r = rg4 * 4 + (wv >> 1), cq = (wv & 1) * 32 + fr;
    const size_t qtok = ctxq ? (size_t)TL + (size_t)b * LC + wv * 32 + fr : (size_t)b * S + r * 64 + cq;
    bf16x8 qf[4]; at_loadq(qf, p + qtok * DIN + O2 + h * 64, lane);
    AttnState a;
#pragma unroll
    for (int dt = 0; dt < 2; ++dt)
#pragma unroll
        for (int rr = 0; rr < 16; ++rr) a.o[dt][rr] = 0.f;
    a.m = -1e30f; a.l = 0.f;
    constexpr int ROWS = S / GRID_W;
    int klo = rg4 * 4 - 4; if (klo < 0) klo = 0; int khi = rg4 * 4 + 3 - 4; if (khi < 0) khi = 0; if (khi > ROWS - NA_KR) khi = ROWS - NA_KR; khi += NA_KR;
    if (klo > ROWS - NA_KR) klo = ROWS - NA_KR;
    const int nloc = ctxq ? 0 : khi - klo, nt = 4 + nloc;
    int myr0 = r - 4; myr0 = myr0 < 0 ? 0 : (myr0 > ROWS - NA_KR ? ROWS - NA_KR : myr0);
    int c0 = cq - 8; c0 = c0 < 0 ? 0 : (c0 > GRID_W - NA_KC ? GRID_W - NA_KC : c0);
    const bf16* kc = p + ((size_t)TL + (size_t)b * LC) * DIN + O2 + 256 + h * 64;
    const bf16* kl = p + ((size_t)b * S + (size_t)klo * 64) * DIN + O2 + 256 + h * 64;
    float* bl = (float*)(lds + AT_RING * AT_STAGE);
    __syncthreads();
    const int wid = __builtin_amdgcn_readfirstlane(wv);
    if (tid < 15 * 31) bl[(tid / 31) * 32 + (tid % 31)] = rpb[h * 15 * 31 + tid];
    asm volatile("s_waitcnt vmcnt(0) lgkmcnt(0)" ::: "memory");
    for (int i = 0; i < 3 && i < nt; ++i) at_dma(lds + i * AT_STAGE, AT_TILE_K(i), 256, wid, lane);
    for (int i = 0; i < nt; ++i) {
        const char* st = lds + (i & 3) * AT_STAGE;
        at_wait_tile(nt - 1 - i);
        if (i + 3 < nt) at_dma(lds + ((i + 3) & 3) * AT_STAGE, AT_TILE_K(i + 3), 256, wid, lane);
        const int krow = klo + (i - 4);
        const bool act = i < 4 || (krow >= myr0 && krow < myr0 + NA_KR);
        if (act) {
            f32x16 s[2]; at_qk(st, qf, s, lane);
            if (i < 4) {
#pragma unroll
                for (int tt = 0; tt < 2; ++tt)
#pragma unroll
                    for (int rr = 0; rr < 16; ++rr) s[tt][rr] *= 0.125f * 1.4426950408889634f;
            } else {
                const float* brow = bl + (krow - r + 7) * 32 + 15 - cq;
#pragma unroll
                for (int tt = 0; tt < 2; ++tt)
#pragma unroll
                    for (int rr = 0; rr < 16; ++rr) { const int kcol = at_key(tt, rr, fh); const bool ok = kcol >= c0 && kcol < c0 + NA_KC;
                        const float bias = ok ? brow[kcol] : 0.f; s[tt][rr] = ok ? (s[tt][rr] * 0.125f + bias) * 1.4426950408889634f : -1e30f; }
            }
            at_softmax_pv(st, s, a, lane);
        }
    }
    at_store(a, ycat + qtok * 1024 + 512 + h * 64, lane);
}
__device__ __forceinline__ void attn_item(char* lds, const WS& w, const Inputs& in, int l, int it) {
    if (it < 256) attn_wa_item(lds, w.p, w.ycat, in.wa_sink + l * 4, it >> 5, (it >> 4) & 1, it & 15, false);
    else if (it < 512) { const int j = it - 256; attn_na_item(lds, w.p, w.ycat, in.na_rpb + l * 4 * 15 * 31, j >> 5, (j >> 3) & 3, j & 7, false); }
    else if (it < 544) { const int j = it - 512; attn_wa_item(lds, w.p, w.ycat, in.wa_sink + l * 4, j >> 2, (j >> 1) & 1, j & 1, true); }
    else { const int j = it - 544; attn_na_item(lds, w.p, w.ycat, in.na_rpb + l * 4 * 15 * 31, j >> 2, j & 3, 0, true); }
}
#endif
#ifndef HOST_SIM
__device__ __forceinline__ float hy_c3(const bf16* pr, int tin, int col, const float* cw) {
    float acc = cw[768 + col] * bf2f(pr[col]);
    if (tin > 0) acc += cw[col] * bf2f(pr[col - DIN]);
    if (tin < S - 1) acc += cw[2 * 768 + col] * bf2f(pr[col + DIN]);
    return acc;
}
__device__ __forceinline__ void hy_prep_item(char* lds, const bf16* p, const float* cw, bf16* x0T, bf16* uvT, int b, int ch, bool ctx = false) {
    int tid = threadIdx.x; asm volatile("" : "+v"(tid));
    bf16* lx = (bf16*)lds;
    bf16* lu = lx + 256 * 72;
    __syncthreads();
    const int tl = tid & 63, cg = tid >> 6;
    const int L = ctx ? LC : S; const int tin = ch * 64 + tl; const bf16* pr = p + ((ctx ? (size_t)TL + (size_t)b * LC : (size_t)b * S) + tin) * DIN;
    for (int it = 0; it < 4; ++it) {
        const int c0 = (it * 8 + cg) * 8;
        float x0[8], x1[8], vv[8];
#pragma unroll
        for (int q = 0; q < 8; ++q) { x0[q] = 0.f; x1[q] = 0.f; vv[q] = 0.f; }
#pragma unroll
        for (int dr = -1; dr <= 1; ++dr) {
            if (tin + dr < 0 || tin + dr >= L) continue;
            const bf16* r = pr + (ptrdiff_t)dr * DIN;
            const u32x4 a = *(const u32x4*)(r + c0), bq = *(const u32x4*)(r + 256 + c0), cq = *(const u32x4*)(r + 512 + c0);
            const float* w0 = cw + (dr + 1) * 768;
#pragma unroll
            for (int q = 0; q < 4; ++q) {
                x0[2 * q] += w0[c0 + 2 * q] * __uint_as_float(a[q] << 16); x0[2 * q + 1] += w0[c0 + 2 * q + 1] * __uint_as_float(a[q] & 0xffff0000u);
                x1[2 * q] += w0[256 + c0 + 2 * q] * __uint_as_float(bq[q] << 16); x1[2 * q + 1] += w0[256 + c0 + 2 * q + 1] * __uint_as_float(bq[q] & 0xffff0000u);
                vv[2 * q] += w0[512 + c0 + 2 * q] * __uint_as_float(cq[q] << 16); vv[2 * q + 1] += w0[512 + c0 + 2 * q + 1] * __uint_as_float(cq[q] & 0xffff0000u);
            }
        }
#pragma unroll
        for (int q = 0; q < 8; ++q) { lx[(c0 + q) * 72 + tl] = f2bf(x0[q]); lu[(c0 + q) * 72 + tl] = f2bf(x1[q] * vv[q]); }
    }
    __syncthreads();
    for (int i = tid; i < 2048; i += NTHREADS) {
        const int c = i >> 3, k = i & 7;
        const size_t g = ((size_t)c * B + b) * L + ch * 64 + k * 8;
        *(u32x4*)(x0T + g) = *(const u32x4*)(lx + c * 72 + k * 8);
        *(u32x4*)(uvT + g) = *(const u32x4*)(lu + c * 72 + k * 8);
    }
}
constexpr int HY_NOFF = 2072, HY_NE = 4128, HY_CS = HY_NE * 2 + 32;
constexpr int HY_URS = S * 2 + 16;
constexpr int HY_LDS_U = 8 * HY_CS, HY_LDS_Z = HY_LDS_U + 8 * HY_URS, HY_LDS_REV = HY_LDS_Z + 64, HY_LDS_END0 = HY_LDS_REV + (HY_NE + 8) * 2;
constexpr int HC_NOFF = 280, HC_NE = 544, HC_CS = HC_NE * 2 + 32, HC_URS = LC * 2 + 16;
constexpr int HC_LDS_C = (HY_LDS_END0 + 15) & ~15, HC_LDS_U = HC_LDS_C + 8 * HC_CS, HC_LDS_REV = HC_LDS_U + 8 * HC_URS, HY_LDS_END = HC_LDS_REV + (HC_NE + 8) * 2;
__device__ __forceinline__ void hy_conv_item(char* lds, const float* filtT, const float* hbias, const bf16* uvT, bf16* x0T  , int c, const bf16* uvTc = nullptr, bf16* x0Tc = nullptr) {
    static_assert(B == 8, "hyena conv assumes batch 8");
    int tid = threadIdx.x; asm volatile("" : "+v"(tid));
    const int lane = tid & 63, wv = tid >> 6, fr = lane & 31, fh = lane >> 5;
    bf16* rev = (bf16*)(lds + HY_LDS_REV);
    __syncthreads();
    const float* hf = filtT + (size_t)c * (S + LC); const float* hb = filtT + (size_t)(256 + c) * (S + LC);
    for (int e = tid; e < HY_NE + 8; e += NTHREADS) {
        const int n = e - HY_NOFF; float v = 0.f;
        if (n > 0 && n < S) v = hb[n]; else if (n <= 0 && n > -S) v = hf[-n];
        rev[e] = f2bf(v);
    }
    for (int i = tid; i < 8 * 256; i += NTHREADS) { const int bb = i >> 8, k = i & 255; *(u32x4*)(lds + HY_LDS_U + bb * HY_URS + k * 16) = *(const u32x4*)(uvT + ((size_t)c * B + bb) * S + k * 8); }
    if (tid < 4) ((unsigned*)(lds + HY_LDS_Z))[tid] = 0u;
    bf16* revc = (bf16*)(lds + HC_LDS_REV);
    if (uvTc) {
        for (int e = tid; e < HC_NE + 8; e += NTHREADS) { const int n = e - HC_NOFF; float v = 0.f; if (n > 0 && n < LC) v = hb[S + n]; else if (n <= 0 && n > -LC) v = hf[S - n]; revc[e] = f2bf(v); }
        for (int i = tid; i < 8 * 32; i += NTHREADS) { const int bb = i >> 5, k = i & 31; *(u32x4*)(lds + HC_LDS_U + bb * HC_URS + k * 16) = *(const u32x4*)(uvTc + ((size_t)c * B + bb) * LC + k * 8); }
    }
    __syncthreads();
    if (uvTc) for (int i = tid; i < 8 * (HC_NE / 2); i += NTHREADS) { const int m = i / (HC_NE / 2), d = i % (HC_NE / 2); const unsigned lo = revc[2 * d + m], hi = revc[2 * d + 1 + m]; *(unsigned*)(lds + HC_LDS_C + m * HC_CS + d * 4) = lo | (hi << 16); }
    for (int i = tid; i < 8 * (HY_NE / 2); i += NTHREADS) {
        const int m = i / (HY_NE / 2), d = i % (HY_NE / 2);
        const unsigned lo = rev[2 * d + m], hi = rev[2 * d + 1 + m];
        *(unsigned*)(lds + m * HY_CS + d * 4) = lo | (hi << 16);
    }
    __syncthreads();
    f32x16 acc[2];
#pragma unroll
    for (int q = 0; q < 2; ++q)
#pragma unroll
        for (int r = 0; r < 16; ++r) acc[q][r] = 0.f;
    const int bb = fr >> 2, pp = fr & 3;
    const int m = (-fr) & 7;
    const char* abase = lds + m * HY_CS;
    const char* ubase = lds + HY_LDS_U + bb * HY_URS + fh * 16;
    auto hstep = [&](int dl, bool a0, bool a1) {
        const int n0 = 8 * fh - fr - 16 * dl;
        const bf16x8 af = *(const bf16x8*)(abase + (n0 - m + HY_NOFF) * 2);
        if (a0) { const int sj = 16 * wv - dl + 2 * pp; const char* up = (sj >= 0 && sj < 128) ? ubase + sj * 32 : lds + HY_LDS_Z;
            acc[0] = __builtin_amdgcn_mfma_f32_32x32x16_bf16(af, *(const bf16x8*)up, acc[0], 0, 0, 0); }
        if (a1) { const int sj = 16 * wv + 8 - dl + 2 * pp; const char* up = (sj >= 0 && sj < 128) ? ubase + sj * 32 : lds + HY_LDS_Z;
            acc[1] = __builtin_amdgcn_mfma_f32_32x32x16_bf16(af, *(const bf16x8*)up, acc[1], 0, 0, 0); }
    };
#pragma unroll
    for (int dl = 16 * wv - 127; dl < 16 * wv - 119; ++dl) hstep(dl, true, false);
#pragma unroll 6
    for (int dl = 16 * wv - 119; dl <= 16 * wv + 6; ++dl) hstep(dl, true, true);
#pragma unroll
    for (int dl = 16 * wv + 7; dl <= 16 * wv + 14; ++dl) hstep(dl, false, true);
    const float hbc = hbias[c];
#pragma unroll
    for (int qq = 0; qq < 2; ++qq) {
        const int tb = 32 * (4 * (2 * wv + qq) + pp) + 4 * fh;
#pragma unroll
        for (int g = 0; g < 4; ++g) {
            const int t = tb + 8 * g;
            const u32x2 uu = *(const u32x2*)(lds + HY_LDS_U + bb * HY_URS + t * 2);
            bf16* xp = x0T + ((size_t)c * B + bb) * S + t; const u32x2 xx = *(const u32x2*)xp;
            const float u0 = __uint_as_float(uu.x << 16), u1 = __uint_as_float(uu.x & 0xffff0000u), u2 = __uint_as_float(uu.y << 16), u3 = __uint_as_float(uu.y & 0xffff0000u);
            const float a0 = __uint_as_float(xx.x << 16), a1 = __uint_as_float(xx.x & 0xffff0000u), a2 = __uint_as_float(xx.y << 16), a3 = __uint_as_float(xx.y & 0xffff0000u);
            u32x2 o; o.x = pack_bf16(a0 * (acc[qq][4 * g] + hbc * u0), a1 * (acc[qq][4 * g + 1] + hbc * u1)); o.y = pack_bf16(a2 * (acc[qq][4 * g + 2] + hbc * u2), a3 * (acc[qq][4 * g + 3] + hbc * u3));
            *(u32x2*)xp = o;
        }
    }
    if (uvTc && wv < 2) {
        f32x16 ac;
#pragma unroll
        for (int r = 0; r < 16; ++r) ac[r] = 0.f;
        const char* cab = lds + HC_LDS_C + m * HC_CS; const char* cub = lds + HC_LDS_U + bb * HC_URS + fh * 16;
        for (int dl = 8 * wv - 15; dl <= 8 * wv + 6; ++dl) {
            const int n0 = 8 * fh - fr - 16 * dl;
            const bf16x8 af = *(const bf16x8*)(cab + (n0 - m + HC_NOFF) * 2);
            const int sj = 8 * wv - dl + 2 * pp; const char* up = (sj >= 0 && sj < 16) ? cub + sj * 32 : lds + HY_LDS_Z;
            ac = __builtin_amdgcn_mfma_f32_32x32x16_bf16(af, *(const bf16x8*)up, ac, 0, 0, 0);
        }
        const int tb = 32 * (4 * wv + pp) + 4 * fh;
#pragma unroll
        for (int g = 0; g < 4; ++g) {
            const int t = tb + 8 * g;
            const u32x2 uu = *(const u32x2*)(lds + HC_LDS_U + bb * HC_URS + t * 2);
            bf16* xp = x0Tc + ((size_t)c * B + bb) * LC + t; const u32x2 xx = *(const u32x2*)xp;
            const float u0 = __uint_as_float(uu.x << 16), u1 = __uint_as_float(uu.x & 0xffff0000u), u2 = __uint_as_float(uu.y << 16), u3 = __uint_as_float(uu.y & 0xffff0000u);
            const float a0 = __uint_as_float(xx.x << 16), a1 = __uint_as_float(xx.x & 0xffff0000u), a2 = __uint_as_float(xx.y << 16), a3 = __uint_as_float(xx.y & 0xffff0000u);
            u32x2 o; o.x = pack_bf16(a0 * (ac[4 * g] + hbc * u0), a1 * (ac[4 * g + 1] + hbc * u1)); o.y = pack_bf16(a2 * (ac[4 * g + 2] + hbc * u2), a3 * (ac[4 * g + 3] + hbc * u3));
            *(u32x2*)xp = o;
        }
    }
}
__device__ __forceinline__ void hy_filter_mlp(char* lds, const float* w1, const float* b1, const float* w2, const float* b2, const float* freq, bf16* f2b) {
    int tid = threadIdx.x; asm volatile("" : "+v"(tid));
    const int lane = tid & 63, wv = tid >> 6;
    float* zl = (float*)lds + wv * 128;
    __syncthreads();
    const float fj = freq[lane], b1j = b1[lane], b2j = b2[lane];
    for (int tt = blockIdx.x * 8 + wv; tt < S + LC; tt += gridDim.x * 8) {
        const int L = tt < S ? S : LC, t = tt < S ? tt : tt - S;
        if (lane < 33) {
            float z;
            if (lane == 0) z = (float)t / (float)(L - 1);
            else { const int bnd = (lane - 1) & 15; const float band = 1e-4f + (float)bnd * ((15.0f - 1e-4f) / 15.0f); const float ang = (6.283185307179586f / (float)L) * (float)t * band; z = lane <= 16 ? cosf(ang) : -sinf(ang); }
            zl[lane] = z;
        }
        __builtin_amdgcn_wave_barrier(); asm volatile("s_waitcnt lgkmcnt(0)" ::: "memory");
        float acc = 0.f;
#pragma unroll
        for (int i = 0; i < 33; ++i) acc += zl[i] * w1[i * 64 + lane];
        zl[64 + lane] = sinf(fj * (acc + b1j));
        __builtin_amdgcn_wave_barrier(); asm volatile("s_waitcnt lgkmcnt(0)" ::: "memory");
        float a2 = 0.f;
#pragma unroll 16
        for (int k = 0; k < 64; ++k) a2 += zl[64 + k] * w2[k * 64 + lane];
        f2b[(size_t)tt * 64 + lane] = f2bf(sinf(fj * (a2 + b2j)));
        __builtin_amdgcn_wave_barrier(); asm volatile("s_waitcnt lgkmcnt(0)" ::: "memory");
    }
}
__device__ __forceinline__ void hy_filter_out(const bf16* w3T  , const bf16* f2b  , float* filt  ) {
    int tid = threadIdx.x; asm volatile("" : "+v"(tid));
    const int lane = tid & 63, wv = tid >> 6, fr = lane & 31, fh = lane >> 5;
    constexpr int NTT = (S + LC) / 32;
    for (int it = blockIdx.x * 8 + wv; it < 16 * NTT; it += gridDim.x * 8) {
        const int ct = it / NTT, tt0 = (it % NTT) * 32;
        f32x16 acc;
#pragma unroll
        for (int r = 0; r < 16; ++r) acc[r] = 0.f;
#pragma unroll
        for (int ks = 0; ks < 4; ++ks) {
            const bf16x8 fa = *(const bf16x8*)(w3T + (size_t)(ct * 32 + fr) * 64 + ks * 16 + fh * 8), fb = *(const bf16x8*)(f2b + (size_t)(tt0 + fr) * 64 + ks * 16 + fh * 8);
            acc = __builtin_amdgcn_mfma_f32_32x32x16_bf16(fa, fb, acc, 0, 0, 0);
        }
        const int tt = tt0 + fr; const int L = tt < S ? S : LC; const float tn = (float)(tt < S ? tt : tt - S) / (float)(L - 1);
#pragma unroll
        for (int r = 0; r < 16; ++r) {
            const int c = ct * 32 + (r & 3) + 8 * (r >> 2) + 4 * fh; const int cc = c & 255;
            const float decay = HY_DECAY_MIN + (float)cc * ((HY_DECAY_MAX - HY_DECAY_MIN) / 255.0f);
            filt[(size_t)c * (S + LC) + tt] = acc[r] * __expf(-tn * decay);
        }
    }
}
__device__ __forceinline__ void hy_fin_item(char* lds, const bf16* yT, bf16* ycat, int b, int ch, bool ctx = false) {
    int tid = threadIdx.x; asm volatile("" : "+v"(tid));
    bf16* ly = (bf16*)lds;
    __syncthreads();
    for (int i = tid; i < 2048; i += NTHREADS) {
        const int c = i >> 3, k = i & 7;
        const u32x4 v = *(const u32x4*)(yT + ((size_t)c * B + b) * (ctx ? LC : S) + ch * 64 + k * 8);
#pragma unroll
        for (int q = 0; q < 4; ++q) { ly[(k * 8 + 2 * q) * 264 + c] = (bf16)(v[q] & 0xffffu); ly[(k * 8 + 2 * q + 1) * 264 + c] = (bf16)(v[q] >> 16); }
    }
    __syncthreads();
    for (int i = tid; i < 2048; i += NTHREADS) {
        const int t = i >> 5, k = i & 31;
        *(u32x4*)(ycat + ((ctx ? (size_t)TL + (size_t)b * LC : (size_t)b * S) + ch * 64 + t) * 1024 + k * 8) = *(const u32x4*)(ly + t * 264 + k * 8);
    }
}
#endif
#ifndef HOST_SIM
constexpr int GD_NC = 36;
__device__ __forceinline__ size_t gd_tok0(int b, int cc) { return cc < 4 ? (size_t)TL + (size_t)b * LC + cc * 64 : (size_t)b * S + (size_t)(cc - 4) * 64; }

constexpr int GP_K = 0, GP_V = 8192, GP_L0 = 16384, GP_T0 = GP_L0 + 2 * 16384, GP_VB0 = GP_T0 + 2 * 8192  , GP_G = GP_VB0 + 2 * 8192  ,
              GP_SM = GP_VB0 + 4 * 8192  , GP_LB = GP_SM + 6 * 256  , GP_END = GP_LB + 2 * 2048;

__device__ __forceinline__ void gdn_pre_item(char* lds, const WS& w, const float* cw  , const float* a_log, const float* dt_bias, int b, int cc, int h) {
    int tid = threadIdx.x; asm volatile("" : "+v"(tid));
    const int lane = tid & 63, wv = tid >> 6, fr = lane & 31, fh = lane >> 5;
    const bf16* p = w.p;
    const int L = cc < 4 ? LC : S; const int tin0 = cc < 4 ? cc * 64 : (cc - 4) * 64; const size_t tok0 = gd_tok0(b, cc);
    float* sm = (float*)(lds + GP_SM);
    __syncthreads();
    {
        const int tl = tid >> 3, dg = tid & 7;
        float q8[8], k8[8], v8[8];
#pragma unroll
        for (int x = 0; x < 8; ++x) { q8[x] = 0.f; k8[x] = 0.f; v8[x] = 0.f; }
#pragma unroll
        for (int i = 0; i < 4; ++i) {
            const int tt = tin0 + tl + i - 2;
            if (tt < 0 || tt >= L) continue;
            const bf16* r = p + (tok0 + tl + i - 2) * DIN + O3 + h * 64 + dg * 8;
            const u32x4 a = *(const u32x4*)r, bq = *(const u32x4*)(r + 256), cq = *(const u32x4*)(r + 512);
            const float* wq = cw + i * 768 + h * 64 + dg * 8;
#pragma unroll
            for (int x = 0; x < 4; ++x) {
                q8[2 * x] += wq[2 * x] * __uint_as_float(a[x] << 16); q8[2 * x + 1] += wq[2 * x + 1] * __uint_as_float(a[x] & 0xffff0000u);
                k8[2 * x] += wq[256 + 2 * x] * __uint_as_float(bq[x] << 16); k8[2 * x + 1] += wq[256 + 2 * x + 1] * __uint_as_float(bq[x] & 0xffff0000u);
                v8[2 * x] += wq[512 + 2 * x] * __uint_as_float(cq[x] << 16); v8[2 * x + 1] += wq[512 + 2 * x + 1] * __uint_as_float(cq[x] & 0xffff0000u);
            }
        }
        float sq = 0.f, sk = 0.f;
#pragma unroll
        for (int x = 0; x < 8; ++x) { q8[x] = q8[x] / (1.0f + __expf(-q8[x])); k8[x] = k8[x] / (1.0f + __expf(-k8[x])); v8[x] = v8[x] / (1.0f + __expf(-v8[x])); sq += q8[x] * q8[x]; sk += k8[x] * k8[x]; }
        sq += __shfl_xor(sq, 1); sq += __shfl_xor(sq, 2); sq += __shfl_xor(sq, 4);
        sk += __shfl_xor(sk, 1); sk += __shfl_xor(sk, 2); sk += __shfl_xor(sk, 4);
        const float rq = 0.125f / sqrtf(sq + EPS), rk = 1.0f / sqrtf(sk + EPS);
        u32x4 qo, ko, vo;
#pragma unroll
        for (int x = 0; x < 4; ++x) { qo[x] = pack_bf16(q8[2 * x] * rq, q8[2 * x + 1] * rq); ko[x] = pack_bf16(k8[2 * x] * rk, k8[2 * x + 1] * rk); vo[x] = pack_bf16(v8[2 * x], v8[2 * x + 1]); }
        bf16* qkg = w.qk + ((size_t)((b * 4 + h) * GD_NC + cc) * 2) * 4096;
        *(u32x4*)(qkg + tl * 64 + dg * 8) = qo; *(u32x4*)(qkg + 4096 + tl * 64 + dg * 8) = ko;
        *(u32x4*)(lds + GP_K + g_lds_off(tl, dg)) = ko;
        *(u32x4*)(lds + GP_V + at_voff(tl, dg * 8)) = vo;
        if (tid < 128) {
            const int dir = tid >> 6, t = tid & 63; const bf16* r = p + (tok0 + t) * DIN + O3 + 1024 + dir * 4 + h;
            const float a = bf2f(r[0]), bbv = bf2f(r[8]); const float x = a + dt_bias[dir * 4 + h]; const float sp = x > 15.f ? x : __logf(1.0f + __expf(x));
            sm[dir * 64 + t] = -__expf(a_log[dir * 4 + h]) * sp; sm[128 + dir * 64 + t] = 1.0f / (1.0f + __expf(-bbv));
        }
    }
    __syncthreads();
    if (wv < 4) {
        const int ta = wv >> 1, tb = wv & 1; f32x16 g;
#pragma unroll
        for (int r = 0; r < 16; ++r) g[r] = 0.f;
#pragma unroll
        for (int ks = 0; ks < 4; ++ks) {
            const bf16x8 fa = *(const bf16x8*)(lds + GP_K + g_lds_off(32 * ta + fr, ks * 2 + fh)), fb = *(const bf16x8*)(lds + GP_K + g_lds_off(32 * tb + fr, ks * 2 + fh));
            g = __builtin_amdgcn_mfma_f32_32x32x16_bf16(fa, fb, g, 0, 0, 0);
        }
        float* G = (float*)(lds + GP_G);
#pragma unroll
        for (int r = 0; r < 16; ++r) G[(32 * ta + (r & 3) + 8 * (r >> 2) + 4 * fh) * 64 + 32 * tb + fr] = g[r];
    } else if (wv < 6) {
        const int dir = wv - 4; float v = sm[dir * 64 + (dir ? 63 - lane : lane)];
#pragma unroll
        for (int o = 1; o < 64; o <<= 1) { const float t = __shfl_up(v, o); if (lane >= o) v += t; }
        sm[256 + dir * 64 + lane] = v;
        float* gcg = w.gc + ((size_t)((b * 4 + h) * 2 + dir) * GD_NC + cc) * 64; gcg[lane] = v;
    }
    __syncthreads();
    const int dir = wv >> 2, t4 = tid & 255;
    {
        const float* G = (const float*)(lds + GP_G); float* Lm = (float*)(lds + GP_L0 + dir * 16384);
        for (int e = t4; e < 4096; e += 256) {
            const int i = e >> 6, j = e & 63; const int ti = dir ? 63 - i : i, tj = dir ? 63 - j : j;
            const float lv = j < i ? sm[128 + dir * 64 + ti] * G[ti * 64 + tj] * __expf(sm[256 + dir * 64 + i] - sm[256 + dir * 64 + j]) : 0.f;
            Lm[e] = lv;
            if (i >= 32 && j < 32) ((bf16*)(lds + GP_LB + dir * 2048))[(i - 32) * 32 + j] = f2bf(lv);
        }
    }
    __syncthreads();
    if ((__builtin_amdgcn_readfirstlane(wv) & 3) == 0) {
        const float* Lm = (const float*)(lds + GP_L0 + dir * 16384);
        char* Tm = lds + GP_T0 + dir * 8192;
        const int blk = lane >> 5, c = lane & 31;
        const LAS float* Lb = (const LAS float*)(Lm + (32 * blk) * 64 + 32 * blk);
        float Tc[32];
#pragma unroll
        for (int i = 0; i < 32; ++i) {
            const LAS float* Lr = Lb + i * 64;
            if (i >= 2) asm volatile("" : "+v"(Lr) : "v"(Tc[i - 2]));
            float a0 = (c == i) ? 1.0f : 0.f, a1 = 0.f, a2 = 0.f, a3 = 0.f;
#pragma unroll
            for (int j4 = 0; j4 < (i & ~3); j4 += 4) {
                const f32x4 l4 = *(const LAS f32x4*)(Lr + j4);
                a0 -= l4[0] * Tc[j4]; a1 -= l4[1] * Tc[j4 + 1]; a2 -= l4[2] * Tc[j4 + 2]; a3 -= l4[3] * Tc[j4 + 3];
            }
#pragma unroll
            for (int j = (i & ~3); j < i; ++j) a0 -= Lr[j] * Tc[j];
            Tc[i] = (a0 + a1) + (a2 + a3);
        }
        {
            int rb = 32 * blk; const int cb = (32 * blk + c) >> 3, cz = (32 * (1 - blk) + c) >> 3, co = (c & 7) * 2;
#pragma unroll
            for (int i = 0; i < 32; ++i) {
                asm volatile("" : "+v"(rb));
                const int row = rb + i, sw = (row >> 1) & 7;
                *(bf16*)(Tm + row * 128 + ((cb ^ sw) << 4) + co) = f2bf(Tc[i]);
                if (blk == 0) *(bf16*)(Tm + row * 128 + ((cz ^ sw) << 4) + co) = (bf16)0;
            }
        }
        asm volatile("s_waitcnt lgkmcnt(0)" ::: "memory");
        const char* Lq = lds + GP_LB + dir * 2048;
        f32x16 X;
#pragma unroll
        for (int r = 0; r < 16; ++r) X[r] = 0.f;
        const int i16 = lane & 15, g1 = (lane >> 4) & 1;
#pragma unroll
        for (int ks = 0; ks < 2; ++ks) {
            const bf16x8 fa = *(const bf16x8*)(Lq + fr * 64 + (ks * 2 + fh) * 16);
            const int jr = 16 * ks + 8 * fh + (i16 >> 2), dc = 16 * g1 + 4 * (i16 & 3);
            const s16x4 t0 = __builtin_amdgcn_ds_read_tr16_b64_v4i16((LAS s16x4*)(Tm + g_lds_off(jr, dc >> 3) + (dc & 7) * 2));
            const s16x4 t1 = __builtin_amdgcn_ds_read_tr16_b64_v4i16((LAS s16x4*)(Tm + g_lds_off(jr + 4, dc >> 3) + (dc & 7) * 2));
            bf16x8 fb; fb[0] = t0[0]; fb[1] = t0[1]; fb[2] = t0[2]; fb[3] = t0[3]; fb[4] = t1[0]; fb[5] = t1[1]; fb[6] = t1[2]; fb[7] = t1[3];
            X = __builtin_amdgcn_mfma_f32_32x32x16_bf16(fa, fb, X, 0, 0, 0);
        }
        f32x16 Y;
#pragma unroll
        for (int r = 0; r < 16; ++r) Y[r] = 0.f;
#pragma unroll
        for (int ks = 0; ks < 2; ++ks) {
            union { bf16x8 v; unsigned u[4]; } xb;
#pragma unroll
            for (int j = 0; j < 4; ++j) xb.u[j] = pack_bf16(X[8 * ks + 2 * j], X[8 * ks + 2 * j + 1]);
            const int c0 = 32 + 16 * ks + 4 * fh, c1 = c0 + 8;
            const u32x2 p0 = *(const u32x2*)(Tm + g_lds_off(32 + fr, c0 >> 3) + (c0 & 7) * 2), p1 = *(const u32x2*)(Tm + g_lds_off(32 + fr, c1 >> 3) + (c1 & 7) * 2);
            union { bf16x8 v; unsigned u[4]; } ta_; ta_.u[0] = p0.x; ta_.u[1] = p0.y; ta_.u[2] = p1.x; ta_.u[3] = p1.y;
            Y = __builtin_amdgcn_mfma_f32_32x32x16_bf16(ta_.v, xb.v, Y, 0, 0, 0);
        }
#pragma unroll
        for (int r = 0; r < 16; ++r) { const int row = 32 + (r & 3) + 8 * (r >> 2) + 4 * fh; *(bf16*)(Tm + g_lds_off(row, fr >> 3) + (fr & 7) * 2) = f2bf(-Y[r]); }
    } else {
        const int t3 = t4 - 64;
        for (int e = t3; e < 1024; e += 192) {
            const int mat = e >> 9, j = (e >> 3) & 63, c8 = e & 7; const int tj = dir ? 63 - j : j;
            const float sc = sm[128 + dir * 64 + tj] * (mat ? __expf(sm[256 + dir * 64 + j]) : 1.0f);
            const u32x4 src = mat ? *(const u32x4*)(lds + GP_K + g_lds_off(tj, c8)) : *(const u32x4*)(lds + GP_V + at_voff(tj, c8 * 8));
            u32x4 d;
#pragma unroll
            for (int x = 0; x < 4; ++x) d[x] = pack_bf16(sc * __uint_as_float(src[x] << 16), sc * __uint_as_float(src[x] & 0xffff0000u));
            *(u32x4*)(lds + GP_VB0 + (dir * 2 + mat) * 8192 + at_voff(j, c8 * 8)) = d;
        }
    }
    __syncthreads();
    {
        const int w4 = wv & 3, ta = w4 >> 1, tb = w4 & 1; const int i16 = lane & 15, g1 = (lane >> 4) & 1;
        const char* Tm = lds + GP_T0 + dir * 8192; const char* vb = lds + GP_VB0 + (dir * 2) * 8192; const char* kbe = vb + 8192;
        f32x16 aw, au;
#pragma unroll
        for (int r = 0; r < 16; ++r) { aw[r] = 0.f; au[r] = 0.f; }
#pragma unroll
        for (int ks = 0; ks < 4; ++ks) {
            const int jr = 16 * ks + 8 * fh + (i16 >> 2), dc = 32 * ta + 16 * g1 + 4 * (i16 & 3);
            const s16x4 k0 = __builtin_amdgcn_ds_read_tr16_b64_v4i16((LAS s16x4*)(kbe + at_voff(jr, dc))), k1 = __builtin_amdgcn_ds_read_tr16_b64_v4i16((LAS s16x4*)(kbe + at_voff(jr + 4, dc)));
            bf16x8 fa; fa[0] = k0[0]; fa[1] = k0[1]; fa[2] = k0[2]; fa[3] = k0[3]; fa[4] = k1[0]; fa[5] = k1[1]; fa[6] = k1[2]; fa[7] = k1[3];
            const bf16x8 fbT = *(const bf16x8*)(Tm + g_lds_off(32 * tb + fr, ks * 2 + fh));
            aw = __builtin_amdgcn_mfma_f32_32x32x16_bf16(fa, fbT, aw, 0, 0, 0);
            const bf16x8 faT = *(const bf16x8*)(Tm + g_lds_off(32 * ta + fr, ks * 2 + fh));
            const int dc2 = 32 * tb + 16 * g1 + 4 * (i16 & 3);
            const s16x4 v0 = __builtin_amdgcn_ds_read_tr16_b64_v4i16((LAS s16x4*)(vb + at_voff(jr, dc2))), v1 = __builtin_amdgcn_ds_read_tr16_b64_v4i16((LAS s16x4*)(vb + at_voff(jr + 4, dc2)));
            bf16x8 fv; fv[0] = v0[0]; fv[1] = v0[1]; fv[2] = v0[2]; fv[3] = v0[3]; fv[4] = v1[0]; fv[5] = v1[1]; fv[6] = v1[2]; fv[7] = v1[3];
            au = __builtin_amdgcn_mfma_f32_32x32x16_bf16(faT, fv, au, 0, 0, 0);
        }
        bf16* uwg = w.uw + ((size_t)(((b * 4 + h) * 2 + dir) * GD_NC + cc) * 2) * 4096;
#pragma unroll
        for (int g = 0; g < 4; ++g) {
            const int rr = 32 * ta + 8 * g + 4 * fh;
            u32x2 o1; o1.x = pack_bf16(-aw[4 * g], -aw[4 * g + 1]); o1.y = pack_bf16(-aw[4 * g + 2], -aw[4 * g + 3]);
            *(u32x2*)(uwg + (32 * tb + fr) * 64 + rr) = o1;
            u32x2 o2; o2.x = pack_bf16(au[4 * g], au[4 * g + 1]); o2.y = pack_bf16(au[4 * g + 2], au[4 * g + 3]);
            *(u32x2*)(uwg + 4096 + (32 * tb + fr) * 64 + rr) = o2;
        }
    }
}
#endif
#ifndef HOST_SIM
constexpr int GS_IN = 0  , GS_ST = 65536  , GS_U1 = GS_ST + 16384, GS_U2 = GS_U1 + 8192, GS_AT = GS_U2 + 8192,
              GS_TB = GS_AT + 8192  , GS_END = GS_TB + 2 * 1024;
__device__ __forceinline__ int gd_chunk_of_step(int dir, int n) { return dir ? (n < 4 ? 3 - n : 39 - n) : n; }

__device__ __forceinline__ void gdn_scan_chain(char* lds, const WS& w, int b, int h, int dir, bool emit_ctx) {
    int tid = threadIdx.x; asm volatile("" : "+v"(tid));
    const int lane = tid & 63, wv = tid >> 6, fr = lane & 31, fh = lane >> 5, w4 = wv & 3, ta = w4 >> 1, tb = w4 & 1;
    const int i16 = lane & 15, g1 = (lane >> 4) & 1;
    const bool lo = wv < 4;
    const size_t chain = (size_t)((b * 4 + h) * 2 + dir) * GD_NC;
    const bf16* qkb = w.qk + (size_t)(b * 4 + h) * GD_NC * 2 * 4096;
    bf16* uwb = w.uw + chain * 2 * 4096; const float* gcb = w.gc + chain * 64;
    const int lrow = tid >> 3, lch = tid & 7;
    const int qrow = dir ? 63 - lrow : lrow;
    __syncthreads();
    *(u32x4*)(lds + GS_ST + tid * 16) = (u32x4){0u, 0u, 0u, 0u};
    f32x16 Sacc;
#pragma unroll
    for (int r = 0; r < 16; ++r) Sacc[r] = 0.f;
    struct Pre { u32x4 rw, rq, rk; float rg; u32x2 uc[4]; };
    Pre pa, pb, pc;
    auto prefetch = [&](int n, Pre& r) {
        const int cc = gd_chunk_of_step(dir, n);
        const bf16* uwp = uwb + (size_t)cc * 2 * 4096; const bf16* qkp = qkb + (size_t)cc * 2 * 4096;
        r.rw = *(const u32x4*)(uwp + lrow * 64 + lch * 8);
        r.rq = *(const u32x4*)(qkp + lrow * 64 + lch * 8); r.rk = *(const u32x4*)(qkp + 4096 + lrow * 64 + lch * 8);
        r.rg = 0.f; if (tid < 64) r.rg = gcb[(size_t)cc * 64 + tid];
        if (lo) { const bf16* up = uwp + 4096 + (32 * tb + fr) * 64 + 32 * ta + 4 * fh;
#pragma unroll
            for (int g = 0; g < 4; ++g) r.uc[g] = *(const u32x2*)(up + 8 * g); }
    };
    auto stage = [&](int buf, const Pre& r) {
        char* ib = lds + GS_IN + buf * 32768;
        *(u32x4*)(ib + g_lds_off(lrow, lch)) = r.rw;
        *(u32x4*)(ib + 8192 + g_lds_off(qrow, lch)) = r.rq;
        *(u32x4*)(ib + 16384 + g_lds_off(qrow, lch)) = r.rk;
        *(u32x4*)(ib + 24576 + at_voff(qrow, lch * 8)) = r.rk;
        float* tbp = (float*)(lds + GS_TB + buf * 1024);
        if (tid < 64) { const float g63 = __shfl(r.rg, 63); tbp[tid] = r.rg; tbp[64 + tid] = __expf(r.rg); tbp[128 + tid] = __expf(g63 - r.rg); if (tid == 0) tbp[192] = __expf(g63); }
    };
    auto step = [&](int n, Pre& cur, const Pre& nx) {
        const int buf = n & 1; const char* ib = lds + GS_IN + buf * 32768; const float* tbp = (const float*)(lds + GS_TB + buf * 1024);
        const char* St = lds + GS_ST + buf * 8192; char* Stn = lds + GS_ST + (buf ^ 1) * 8192;
        const int cc = gd_chunk_of_step(dir, n);
        if (lo) {
            f32x16 acc;
#pragma unroll
            for (int g = 0; g < 4; ++g) { acc[4 * g] = __uint_as_float(cur.uc[g].x << 16); acc[4 * g + 1] = __uint_as_float(cur.uc[g].x & 0xffff0000u); acc[4 * g + 2] = __uint_as_float(cur.uc[g].y << 16); acc[4 * g + 3] = __uint_as_float(cur.uc[g].y & 0xffff0000u); }
#pragma unroll
            for (int ks = 0; ks < 4; ++ks) {
                const bf16x8 fa = *(const bf16x8*)(ib + g_lds_off(32 * ta + fr, ks * 2 + fh)), fb = *(const bf16x8*)(St + g_lds_off(32 * tb + fr, ks * 2 + fh));
                acc = __builtin_amdgcn_mfma_f32_32x32x16_bf16(fa, fb, acc, 0, 0, 0);
            }
#pragma unroll
            for (int g = 0; g < 4; ++g) {
                const int i0 = 32 * ta + 8 * g + 4 * fh; const f32x4 fc = *(const f32x4*)(tbp + 128 + i0);
                u32x2 o1; o1.x = pack_bf16(acc[4 * g], acc[4 * g + 1]); o1.y = pack_bf16(acc[4 * g + 2], acc[4 * g + 3]);
                u32x2 o2; o2.x = pack_bf16(acc[4 * g] * fc[0], acc[4 * g + 1] * fc[1]); o2.y = pack_bf16(acc[4 * g + 2] * fc[2], acc[4 * g + 3] * fc[3]);
                const int off = g_lds_off(32 * tb + fr, i0 >> 3) + (i0 & 7) * 2;
                *(u32x2*)(lds + GS_U1 + off) = o1; *(u32x2*)(lds + GS_U2 + off) = o2;
            }
        } else {
            f32x16 acc;
#pragma unroll
            for (int r = 0; r < 16; ++r) acc[r] = 0.f;
#pragma unroll
            for (int ks = 0; ks < 4; ++ks) {
                const bf16x8 fa = *(const bf16x8*)(ib + 16384 + g_lds_off(32 * ta + fr, ks * 2 + fh)), fb = *(const bf16x8*)(ib + 8192 + g_lds_off(32 * tb + fr, ks * 2 + fh));
                acc = __builtin_amdgcn_mfma_f32_32x32x16_bf16(fa, fb, acc, 0, 0, 0);
            }
            const int i = 32 * tb + fr; const float gi = tbp[i];
#pragma unroll
            for (int g = 0; g < 4; ++g) {
                const int j0 = 32 * ta + 8 * g + 4 * fh; const f32x4 gj = *(const f32x4*)(tbp + j0);
                float v[4];
#pragma unroll
                for (int x = 0; x < 4; ++x) v[x] = (j0 + x <= i) ? acc[4 * g + x] * __expf(gi - gj[x]) : 0.f;
                u32x2 o; o.x = pack_bf16(v[0], v[1]); o.y = pack_bf16(v[2], v[3]);
                *(u32x2*)(lds + GS_AT + g_lds_off(i, j0 >> 3) + (j0 & 7) * 2) = o;
            }
        }
        __syncthreads();
        if (lo) {
            if (cc >= 4 || emit_ctx) {
                f32x16 acc, acc2;
#pragma unroll
                for (int r = 0; r < 16; ++r) { acc[r] = 0.f; acc2[r] = 0.f; }
#pragma unroll
                for (int ks = 0; ks < 4; ++ks) {
                    const bf16x8 fa = *(const bf16x8*)(ib + 8192 + g_lds_off(32 * ta + fr, ks * 2 + fh)), fb = *(const bf16x8*)(St + g_lds_off(32 * tb + fr, ks * 2 + fh));
                    acc = __builtin_amdgcn_mfma_f32_32x32x16_bf16(fa, fb, acc, 0, 0, 0);
                    const bf16x8 fa2 = *(const bf16x8*)(lds + GS_AT + g_lds_off(32 * ta + fr, ks * 2 + fh)), fb2 = *(const bf16x8*)(lds + GS_U1 + g_lds_off(32 * tb + fr, ks * 2 + fh));
                    acc2 = __builtin_amdgcn_mfma_f32_32x32x16_bf16(fa2, fb2, acc2, 0, 0, 0);
                }
                bf16* op = uwb + (size_t)cc * 2 * 4096 + 4096 + (32 * tb + fr) * 64 + 32 * ta + 4 * fh;
#pragma unroll
                for (int g = 0; g < 4; ++g) {
                    const f32x4 eg = *(const f32x4*)(tbp + 64 + 32 * ta + 8 * g + 4 * fh);
                    u32x2 o; o.x = pack_bf16(acc[4 * g] * eg[0] + acc2[4 * g], acc[4 * g + 1] * eg[1] + acc2[4 * g + 1]); o.y = pack_bf16(acc[4 * g + 2] * eg[2] + acc2[4 * g + 2], acc[4 * g + 3] * eg[3] + acc2[4 * g + 3]);
                    *(u32x2*)(op + 8 * g) = o;
                }
            }
        } else {
            const float e63 = tbp[192];
#pragma unroll
            for (int r = 0; r < 16; ++r) Sacc[r] *= e63;
#pragma unroll
            for (int ks = 0; ks < 4; ++ks) {
                const int ir = 16 * ks + 8 * fh + (i16 >> 2), dc = 32 * ta + 16 * g1 + 4 * (i16 & 3);
                const s16x4 k0 = __builtin_amdgcn_ds_read_tr16_b64_v4i16((LAS s16x4*)(ib + 24576 + at_voff(ir, dc))), k1 = __builtin_amdgcn_ds_read_tr16_b64_v4i16((LAS s16x4*)(ib + 24576 + at_voff(ir + 4, dc)));
                bf16x8 fa; fa[0] = k0[0]; fa[1] = k0[1]; fa[2] = k0[2]; fa[3] = k0[3]; fa[4] = k1[0]; fa[5] = k1[1]; fa[6] = k1[2]; fa[7] = k1[3];
                const bf16x8 fb = *(const bf16x8*)(lds + GS_U2 + g_lds_off(32 * tb + fr, ks * 2 + fh));
                Sacc = __builtin_amdgcn_mfma_f32_32x32x16_bf16(fa, fb, Sacc, 0, 0, 0);
            }
#pragma unroll
            for (int g = 0; g < 4; ++g) {
                const int d0 = 32 * ta + 8 * g + 4 * fh; u32x2 o; o.x = pack_bf16(Sacc[4 * g], Sacc[4 * g + 1]); o.y = pack_bf16(Sacc[4 * g + 2], Sacc[4 * g + 3]);
                *(u32x2*)(Stn + g_lds_off(32 * tb + fr, d0 >> 3) + (d0 & 7) * 2) = o;
            }
        }
        if (n + 1 < GD_NC) stage(buf ^ 1, nx);
        if (n + 3 < GD_NC) prefetch(n + 3, cur);
        __syncthreads();
    };
    prefetch(0, pa); prefetch(1, pb); prefetch(2, pc);
    stage(0, pa);
    __syncthreads();
    for (int n = 0; n < GD_NC; n += 3) { step(n, pa, pb); step(n + 1, pb, pc); step(n + 2, pc, pa); }
}

__device__ __forceinline__ void gdn_fin_item(char* lds, const WS& w, const float* ng, int b, int cc, int h) {
    int tid = threadIdx.x; asm volatile("" : "+v"(tid));
    bf16* lo_ = (bf16*)lds;
    __syncthreads();
    for (int i = tid; i < 1024; i += NTHREADS) {
        const int dir = i >> 9, dv = (i >> 3) & 63, k = i & 7;
        const bf16* src = w.uw + ((size_t)(((b * 4 + h) * 2 + dir) * GD_NC + cc) * 2 + 1) * 4096 + dv * 64 + k * 8;
        *(u32x4*)(lo_ + (dir * 64 + dv) * 72 + k * 8) = *(const u32x4*)src;
    }
    __syncthreads();
    const int tl = tid >> 3, dg = tid & 7; const size_t tok = gd_tok0(b, cc) + tl;
    float o[8]; float ss = 0.f;
#pragma unroll
    for (int x = 0; x < 8; ++x) { const int dv = dg * 8 + x; o[x] = bf2f(lo_[dv * 72 + tl]) + bf2f(lo_[(64 + dv) * 72 + 63 - tl]); ss += o[x] * o[x]; }
    ss += __shfl_xor(ss, 1); ss += __shfl_xor(ss, 2); ss += __shfl_xor(ss, 4);
    const float rs = 1.0f / sqrtf(ss * (1.0f / 64.0f) + EPS);
    const u32x4 gt = *(const u32x4*)(w.p + tok * DIN + O3 + 768 + h * 64 + dg * 8);
    u32x4 out;
#pragma unroll
    for (int x = 0; x < 4; ++x) {
        const float g0 = __uint_as_float(gt[x] << 16), g1v = __uint_as_float(gt[x] & 0xffff0000u);
        const float y0 = o[2 * x] * rs * ng[dg * 8 + 2 * x] * (g0 / (1.0f + __expf(-g0))), y1 = o[2 * x + 1] * rs * ng[dg * 8 + 2 * x + 1] * (g1v / (1.0f + __expf(-g1v)));
        out[x] = pack_bf16(y0, y1);
    }
    *(u32x4*)(w.ycat + tok * 1024 + 768 + h * 64 + dg * 8) = out;
}
#endif
#ifndef HOST_SIM
namespace cg = cooperative_groups;
struct MP { Inputs in; float* out; WS w; };

template <class F> __device__ __forceinline__ void dev_run(const F& f, long n) {
    int t0 = threadIdx.x; asm volatile("" : "+v"(t0));
    for (long i = (long)blockIdx.x * NTHREADS + t0; i < n; i += (long)gridDim.x * NTHREADS) f(i);
}

struct TLInProj {
    const bf16* A; const bf16* Bt; EpiInProj e; static constexpr int K = 1024;
    struct Tile { int m0, n0; };
    __device__ __forceinline__ bool tile(int idx, Tile& t) const {
        constexpr int MT = T / GBM, NT = (DIN + GBN - 1) / GBN;
        if (idx >= MT * NT) return false;
        const int mg = idx / (8 * NT), rem = idx % (8 * NT); t.n0 = (rem / 8) * GBN; t.m0 = (mg * 8 + (rem & 7)) * GBM; return true;
    }
    __device__ __forceinline__ const bf16* arow(const Tile& t, int r) const { return A + (size_t)(t.m0 + r) * D; }
    __device__ __forceinline__ const bf16* brow(const Tile& t, int r) const { return Bt + (size_t)(t.n0 + (r & 64) + perm64(r & 63)) * 1024; }
    __device__ __forceinline__ void epi(const Tile& t, f32x16 (&acc)[2][2], int mr, int nc) const { e(acc, t.m0 + mr, t.n0 + nc); }
};
struct TLOutProj {
    const bf16* A; const bf16* Bt; EpiOutProj e; int ntiles; static constexpr int K = 1024;
    struct Tile { int m0, n0; };
    __device__ __forceinline__ bool tile(int idx, Tile& t) const { if (idx >= ntiles) return false; t.m0 = (idx >> 3) * GBM; t.n0 = (idx & 7) * GBN; return true; }
    __device__ __forceinline__ const bf16* arow(const Tile& t, int r) const { return A + (size_t)(t.m0 + r) * 1024; }
    __device__ __forceinline__ const bf16* brow(const Tile& t, int r) const { return Bt + (size_t)(t.n0 + r) * 1024; }
    __device__ __forceinline__ void epi(const Tile& t, f32x16 (&acc)[2][2], int mr, int nc) const { e(acc, t.m0 + mr, t.n0 + nc); }
};
__device__ __forceinline__ void phase_inproj(char* lds, const WS& w, int l) {
    gemm_stream(lds, TLInProj{l == 0 ? w.h : w.hid2, w.winT + (size_t)l * 3328 * 1024, EpiInProj{w.p, w.rope}});
}
__device__ __forceinline__ void phase_outproj(char* lds, const WS& w, int l, const float* mod, int ntok, const float* xin, const float* cin) {
    gemm_stream(lds, TLOutProj{w.ycat, w.woutT + (size_t)l * 1024 * 1024, EpiOutProj{w.xr, mod, l == 0 ? xin : nullptr, cin}, (ntok / GBM) * 8});
}
struct EpiStoreP { bf16* p;
    __device__ __forceinline__ void operator()(f32x16 (&acc)[2][2], int mrow, int ncol) const {
#pragma unroll
        for (int mi = 0; mi < 2; ++mi)
#pragma unroll
            for (int ni = 0; ni < 2; ++ni)
#pragma unroll
                for (int g = 0; g < 4; ++g) { u32x2 v; v.x = pack_bf16(acc[mi][ni][4 * g], acc[mi][ni][4 * g + 1]); v.y = pack_bf16(acc[mi][ni][4 * g + 2], acc[mi][ni][4 * g + 3]);
                    *(u32x2*)(p + (size_t)(mrow + mi * 32) * 1024 + ncol + ni * 32 + 8 * g) = v; }
    } };
__device__ __forceinline__ void phase_outproj_dup(char* lds, const WS& w, int l, int ntok) {
    const int MT = ntok / GBM, NT = D / GBN;
    const bf16* Bt = w.woutT + (size_t)l * 1024 * 1024;
    for (int tile = blockIdx.x; tile < MT * NT; tile += gridDim.x) {
        const int mt = tile / NT, nt = tile % NT;
        gemm_tile(lds, ARowDense{w.ycat, 1024, mt * GBM}, Bt, 1024, 1024, mt * GBM, nt * GBN, EpiStoreP{w.p});
    }
}
__device__ __forceinline__ int q_next(int* head, int* slot  ) {
    __syncthreads();
    if (threadIdx.x == 0) *slot = __hip_atomic_fetch_add(head, 1, __ATOMIC_RELAXED, __HIP_MEMORY_SCOPE_AGENT);
    __syncthreads();
    return *slot;
}
__global__ void __launch_bounds__(NTHREADS) mega_kernel(MP mp) {
    extern __shared__ __attribute__((aligned(16))) char lds[];
    __shared__ uint4 xb_words;
    __shared__ int q_slot[4];
    cg::grid_group grid = cg::this_grid();
    const Inputs& in = mp.in; const WS& w = mp.w;
    if (threadIdx.x == 0) xb_words = make_uint4(0u, 0u, 0u, 0u);
    __syncthreads();
    XcdBarrier xb = xcd_barrier_post(w.bar, (volatile LAS unsigned*)&xb_words);
#define GSYNC(id) xcd_barrier(xb)
    phase_ada(lds, w, in);
    dev_run(NkRopeTab{w.rope}, NkRopeTab::count());
    dev_run(NkZeroI{w.cnt}, 4 * 32 * 32);
    dev_run(NkZeroI{w.qctr}, 64 * 64);
    for (int it = blockIdx.x; it < 16 * 52; it += gridDim.x) cvt_tile(lds, in.w_in, DIN, w.winT, 1024, (it / 52) * 64, (it % 52) * 64, DIN, 3328, NMapId{});
    for (int l = 0; l < 2; ++l) {
        hy_filter_mlp(lds, in.hy_w1 + l * 33 * 64, in.hy_b1 + l * 64, in.hy_w2 + l * 64 * 64, in.hy_b2 + l * 64, in.hy_freq + l * 64, w.f2b + (size_t)l * (S + LC) * 64);
        { NkCvtT c4{in.hy_w3 + (size_t)l * 64 * 512, w.w3T + (size_t)l * 512 * 64, 64, 512, 512}; dev_run(c4, c4.count()); }
    }
    if (mp.out == nullptr) grid.sync();
    xcd_barrier(xb);
    row_pass<3, 1>(w, in, T, w.mod, w.mod, in.norm1, 0, 1, nullptr, nullptr, nullptr, w.h);
    GSYNC(0);
    for (int l = 0; l < 2; ++l) {
        const bool need_ctx = l == 0;
        const float* mod = w.mod + (size_t)l * 9 * 6144;
        const long ntok = need_ctx ? T : TL;
        const float* filt = w.filt + (size_t)l * (S + LC) * 512;
        phase_inproj(lds, w, l);
        hy_filter_out(w.w3T + (size_t)l * 512 * 64, w.f2b + (size_t)l * (S + LC) * 64, w.filt + (size_t)l * (S + LC) * 512);
        GSYNC(2);
        const float* hcw = in.hy_conv + l * 3 * 768;
        if (l == 0) for (int l2 = 0; l2 < 2; ++l2) { NkCvtT c3{in.moe_router + (size_t)l2 * D * 32, w.wrT + (size_t)l2 * 32 * 1024, 1024, 32, 32}; dev_run(c3, c3.count()); }
        {
            const int n_gp = B * GD_NC * 4, n_hp = B * 32 + (need_ctx ? B * 4 : 0), n_cv = l == 0 ? 104 + 64 : 0;
            int* head = w.qctr + (2 + l) * 64;
            for (;;) {
                int it = q_next(head, q_slot);
                if (it >= n_gp + n_hp + n_cv) break;
                if (it < n_gp) { gdn_pre_item(lds, w, in.gdn_conv + l * 4 * 768, in.gdn_a_log + l * 8, in.gdn_dt_bias + l * 8, it / (GD_NC * 4), (it >> 2) % GD_NC, it & 3); continue; }
                it -= n_gp;
                if (it < n_hp) { if (it < B * 32) hy_prep_item(lds, w.p, hcw, w.x0T, w.uvT, it >> 5, it & 31); else hy_prep_item(lds, w.p, hcw, w.x0Tc, w.uvTc, (it - B * 32) >> 2, (it - B * 32) & 3, true); continue; }
                it -= n_hp;
                if (it < 104) { for (int q = it * 8; q < it * 8 + 8; ++q) cvt_tile(lds, in.w_in + (size_t)D * DIN, DIN, w.winT + (size_t)3328 * 1024, 1024, (q / 52) * 64, (q % 52) * 64, DIN, 3328, NMapId{}); }
                else { const int g = it - 104, l2 = g >> 5; for (int q = (g & 31) * 8; q < (g & 31) * 8 + 8; ++q) cvt_tile(lds, in.w_out + (size_t)l2 * 1024 * D, D, w.woutT + (size_t)l2 * 1024 * 1024, 1024, (q >> 4) * 64, (q & 15) * 64, D, D, NMapId{}); }
            }
        }
        GSYNC(90);
        {
            const int natt = 512 + (need_ctx ? 64 : 0);
            int* head = w.qctr + l * 64;
            for (;;) {
                const int it = q_next(head, q_slot);
                if (it >= 64 + 256 + natt) break;
                if (it < 64) gdn_scan_chain(lds, w, it >> 3, (it >> 1) & 3, it & 1, need_ctx);
                else if (it < 320) hy_conv_item(lds, filt, in.hy_bias + l * 256, w.uvT, w.x0T, it - 64, need_ctx ? w.uvTc : nullptr, w.x0Tc);
                else { int a = it - 320; a = a < 256 ? a + 256 : (a < 512 ? a - 256 : a); attn_item(lds, w, in, l, a); }
            }
        }
        GSYNC(91);
        for (int it = blockIdx.x; it < B * 32 + (need_ctx ? B * 4 : 0); it += gridDim.x) { if (it < B * 32) hy_fin_item(lds, w.x0T, w.ycat, it >> 5, it & 31); else hy_fin_item(lds, w.x0Tc, w.ycat, (it - B * 32) >> 2, (it - B * 32) & 3, true); }
        for (int it = blockIdx.x; it < B * GD_NC * 4; it += gridDim.x) { const int cc = (it >> 2) % GD_NC; if (cc >= 4 || need_ctx) gdn_fin_item(lds, w, in.gdn_norm + l * 64, it / (GD_NC * 4), cc, it & 3); }
        GSYNC(5);
        phase_outproj(lds, w, l, mod, (int)ntok, in.x, in.ctx);
        {
            const int skip = (l == 0 && (int)gridDim.x > 128) ? 64 : 0;
            if ((int)blockIdx.x >= skip) {
                const int b0 = (int)blockIdx.x - skip, nb = (int)gridDim.x - skip;
                for (int it = b0; it < 33 * 2 * 16; it += nb) {
                    const int e = it >> 5, which = (it >> 4) & 1, kt = it & 15;
                    const float* src = e < 32 ? (which ? in.moe_up : in.moe_gate) + ((size_t)l * 32 + e) * D * 256 : (which ? in.sh_up : in.sh_gate) + (size_t)l * D * 256;
                    cvt_strip(lds, src, 256, w.moeUpT + (size_t)e * 512 * 1024, 1024, kt * 64, 0, 256, 256, NMapUp{which});
                }
                for (int it = b0; it < 33 * 16; it += nb) {
                    const int e = it >> 4, kt = (it >> 2) & 3, st = it & 3;
                    const float* src = e < 32 ? in.moe_down + ((size_t)l * 32 + e) * 256 * D : in.sh_down + (size_t)l * 256 * D;
                    cvt_strip(lds, src, D, w.moeDownT + (size_t)e * 1024 * 256, 256, kt * 64, st * 256, D, D, NMapId{});
                }
            }
        }
        GSYNC(6);
        phase_norm2_router(lds, w, in, (int)ntok, mod, in.norm2 + l * D, in.moe_bias + l * 32, l);
        GSYNC(7);
        phase_moe_up(lds, w, l, (int)ntok);
        GSYNC(9);
        phase_moe_down(lds, w, l, (int)ntok, mod);
        GSYNC(10);
        if (l == 0) row_pass<2, 1>(w, in, (int)ntok, mod, w.mod + (size_t)9 * 6144, in.norm1 + D, 0, 1, (const bf16*)w.h, w.topw, nullptr, w.hid2);
        else row_pass<2, 2>(w, in, (int)ntok, mod, mod, in.norm_f, 0, 0, (const bf16*)w.h, w.topw, mp.out, nullptr);
        GSYNC(11);
    }
}

constexpr size_t kDynLds = G_LDS3;
static_assert(H_LDS <= kDynLds &&  HY_LDS_END <= kDynLds && AT_RING * AT_STAGE + 2048 <= kDynLds && GP_END <= kDynLds && GS_END <= kDynLds, "LDS budget");
extern "C" void kernel_launch(void* const* d_in, const int* in_sizes, int n_in, void* d_out, int out_size, void* d_ws, size_t ws_size, hipStream_t stream) {
    static int grid_blocks = 0;
    if (!grid_blocks) {
        int dev = 0, cus = 0, per_cu = 0;
        hipGetDevice(&dev);
        hipDeviceGetAttribute(&cus, hipDeviceAttributeMultiprocessorCount, dev);
        hipFuncSetAttribute((const void*)mega_kernel, hipFuncAttributeMaxDynamicSharedMemorySize, (int)kDynLds);
        hipOccupancyMaxActiveBlocksPerMultiprocessor(&per_cu, mega_kernel, NTHREADS, kDynLds);
        if (per_cu < 1) per_cu = 1;
        grid_blocks = cus;
    }
    MP mp; memset(&mp, 0, sizeof(mp));
    const float** ip = (const float**)&mp.in;
    for (int i = 0; i < 33; ++i) ip[i] = (const float*)d_in[i];
    mp.out = (float*)d_out; mp.w = make_ws(d_ws);
    hipMemsetAsync(mp.w.bar, 0, 4096 * 4, stream);
    void* args[] = {&mp};
    hipError_t e = hipLaunchCooperativeKernel((void*)mega_kernel, dim3(grid_blocks), dim3(NTHREADS), args, kDynLds, stream);
    if (e != hipSuccess) fprintf(stderr, "cooperative launch failed: %s (grid %d)\n", hipGetErrorString(e), grid_blocks);
}
#endif
```

```cpp
#ifndef HOST_SIM
#include <hip/hip_runtime.h>
#include <hip/hip_cooperative_groups.h>
#include <cstdio>
#include <cstring>
#define HD __host__ __device__ __forceinline__
#else
#include <cmath>
#include <cstdio>
#include <cstdlib>
#include <cstring>
#define HD inline
typedef void* hipStream_t;
#endif
#include <cstdint>
#include <cstddef>

#ifndef BATCH
#define BATCH 8
#endif
constexpr int B = BATCH, S = 2048, D = 1024, LC = 256, GRID_W = 64;
constexpr int TL = B * S, TC = B * LC, T = TL + TC;
constexpr int DIN = 3088, O1 = 768, O2 = 1280, O3 = 2048;
constexpr int WINDOW = 128, NA_KR = 8, NA_KC = 16;
constexpr float EPS = 1e-6f, ROPE_BASE = 10000.0f, ROUTED_SCALE = 2.5f;
constexpr float HY_DECAY_MIN = 3.0701134573253946f;
constexpr float HY_DECAY_MAX = 15.350567286626973f;
typedef unsigned short bf16;

HD float bf2f(bf16 h) { union { unsigned u; float f; } v; v.u = (unsigned)h << 16; return v.f; }
HD bf16 f2bf(float f) { union { float f; unsigned u; } v; v.f = f; unsigned u = v.u; u += 0x7fffu + ((u >> 16) & 1u); return (bf16)(u >> 16); }
HD float siluf(float x) { return x / (1.0f + expf(-x)); }

struct NkCopyX {
    const float* x; const float* ctx; float* xr;
    HD void operator()(long i) const { xr[i] = i < (long)TL * D ? x[i] : ctx[i - (long)TL * D]; }
    static HD long count() { return (long)T * D; }
};

struct NkAda {
    const float* c; const float* cctx; const float* w_ada; const float* b_ada; float* mod;
    HD void operator()(long i) const {
        int n = (int)(i % 6144); int r = (int)((i / 6144) % 9); int l = (int)(i / (6144 * 9));
        const float* cv = r < 8 ? c + (long)(r % B) * D : cctx;
        const float* w = w_ada + (long)l * D * 6144 + n;
        float acc = 0.f;
        for (int k = 0; k < D; ++k) { float v = cv[k]; acc += siluf(v) * w[(long)k * 6144]; }
        mod[i] = acc + b_ada[l * 6144 + n];
    }
    static HD long count() { return 2L * 9 * 6144; }
};

struct NkRstd {
    const float* xr; float* rstd; int nrows;
    HD void operator()(long t) const {
        const float* r = xr + t * D; float s = 0.f;
        for (int k = 0; k < D; ++k) s += r[k] * r[k];
        rstd[t] = 1.0f / sqrtf(s * (1.0f / D) + EPS);
    }
};

struct NkModNorm {
    const float* xr; const float* rstd; const float* g; const float* mod;   int sh_chunk, sc_chunk; bf16* h;
    HD void operator()(long i) const {
        long t = i / D; int k = (int)(i % D); int r = t < TL ? (int)(t / S) : 8;
        const float* m = mod + (long)r * 6144;
        float v = xr[i] * rstd[t] * g[k];
        h[i] = f2bf(v * (1.0f + m[sc_chunk * D + k]) + m[sh_chunk * D + k]);
    }
};

struct NkInProj {
    const bf16* h; const float* w; bf16* p;
    HD void operator()(long i) const {
        long t = i / DIN; int n = (int)(i % DIN);
        const bf16* hr = h + t * D; float acc = 0.f;
        for (int k = 0; k < D; ++k) acc += bf2f(hr[k]) * w[(long)k * DIN + n];
        p[i] = f2bf(acc);
    }
    static HD long count() { return (long)T * DIN; }
};

struct NkRope {
    bf16* p;
    HD void operator()(long i) const {
        int pr = (int)(i % 32); int hd = (int)((i / 32) % 6); long t = i / (32 * 6);
        int s = (int)(t % S); int row = s / GRID_W, col = s % GRID_W;
        int axis = pr >> 4, j = pr & 15;
        float pos = axis == 0 ? (float)row : (float)col;
        float inv = powf(ROPE_BASE, -(float)j / 16.0f);
        float ang = pos * inv; float cs = cosf(ang), sn = sinf(ang);
        bf16* q = p + t * DIN + O1 + hd * 64 + axis * 32;
        float x1 = bf2f(q[j]), x2 = bf2f(q[j + 16]);
        q[j] = f2bf(x1 * cs - x2 * sn); q[j + 16] = f2bf(x1 * sn + x2 * cs);
    }
    static HD long count() { return (long)TL * 6 * 32; }
};

struct NkHyF1 {
    const float* w1; const float* b1; const float* freq; float* f1;
    HD void operator()(long i) const {
        int j = (int)(i % 64); int tt = (int)(i / 64); int L = tt < S ? S : LC; int t = tt < S ? tt : tt - S;
        float tn = (float)t / (float)(L - 1);
        float acc = tn * w1[j];
        for (int bnd = 0; bnd < 16; ++bnd) {
            float band = 1e-4f + (float)bnd * ((15.0f - 1e-4f) / 15.0f);
            float ang = (6.283185307179586f / (float)L) * (float)t * band;
            acc += cosf(ang) * w1[(1 + bnd) * 64 + j] - sinf(ang) * w1[(17 + bnd) * 64 + j];
        }
        f1[i] = sinf(freq[j] * (acc + b1[j]));
    }
    static HD long count() { return (long)(S + LC) * 64; }
};
struct NkHyF2 {
    const float* w2; const float* b2; const float* freq; const float* f1; float* f2; bf16* f2b;
    HD void operator()(long i) const {
        int j = (int)(i % 64); long tt = i / 64; float acc = 0.f;
        for (int k = 0; k < 64; ++k) acc += f1[tt * 64 + k] * w2[k * 64 + j];
        const float v = sinf(freq[j] * (acc + b2[j]));
        f2[i] = v; if (f2b) f2b[i] = f2bf(v);
    }
    static HD long count() { return (long)(S + LC) * 64; }
};
struct NkHyF3 {
    const float* w3; const float* f2; float* filt;
    HD void operator()(long i) const {
        int tt = (int)(i % (S + LC)); int c = (int)(i / (S + LC)); int L = tt < S ? S : LC; int t = tt < S ? tt : tt - S;
        float tn = (float)t / (float)(L - 1);
        float acc = 0.f;
        for (int k = 0; k < 64; ++k) acc += f2[(long)tt * 64 + k] * w3[k * 512 + c];
        int cc = c & 255;
        float decay = HY_DECAY_MIN + (float)cc * ((HY_DECAY_MAX - HY_DECAY_MIN) / 255.0f);
        filt[(long)c * (S + LC) + tt] = acc * expf(-tn * decay);
    }
    static HD long count() { return (long)(S + LC) * 512; }
};
HD float hy_conv3(const bf16* p, long t, int tin, int L, int col, const float* cw) {
    float acc = cw[768 + col] * bf2f(p[t * DIN + col]);
    if (tin > 0) acc += cw[col] * bf2f(p[(t - 1) * DIN + col]);
    if (tin < L - 1) acc += cw[2 * 768 + col] * bf2f(p[(t + 1) * DIN + col]);
    return acc;
}
struct NkHyUV {
    const bf16* p; const float* cw; bf16* uv; long tbase; long ntok; int L;
    HD void operator()(long i) const {
        int c = (int)(i % 256); long t = tbase + i / 256; int tin = (int)((t - tbase) % L);
        float x1 = hy_conv3(p, t, tin, L, 256 + c, cw), v = hy_conv3(p, t, tin, L, 512 + c, cw);
        uv[t * 256 + c] = f2bf(x1 * v);
    }
};
struct NkHyConv {
    const bf16* p; const float* cw; const bf16* uv; const float* filt; const float* hbias; bf16* ycat; long tbase; int L; int foff;
    HD void operator()(long i) const {
        int tin = (int)(i % L); int c = (int)((i / L) % 256); long seq = i / ((long)L * 256); long t0 = tbase + seq * L; long t = t0 + tin;
        const float* f = filt + foff;
        float acc = 0.f;
        for (int s = 0; s < L; ++s) {
            int d = tin - s; float k = d >= 0 ? f[(long)c * (S + LC) + d] : f[(long)(256 + c) * (S + LC) - d];
            acc += k * bf2f(uv[(t0 + s) * 256 + c]);
        }
        acc += hbias[c] * bf2f(uv[t * 256 + c]);
        float x0 = hy_conv3(p, t, tin, L, c, cw);
        ycat[t * 1024 + c] = f2bf(x0 * acc);
    }
};

HD void attn_key(const float (&q)[64], const bf16* kr, const bf16* vr, float bias, float& m, float& l, float (&acc)[64]) {
    float sc = 0.f;
#pragma unroll
    for (int d = 0; d < 64; ++d) sc += q[d] * bf2f(kr[d]);
    sc = sc * 0.125f + bias;
    float mn = fmaxf(m, sc); float ca = expf(m - mn), cb = expf(sc - mn);
    l = l * ca + cb; m = mn;
#pragma unroll
    for (int d = 0; d < 64; ++d) acc[d] = acc[d] * ca + cb * bf2f(vr[d]);
}
struct NkWA {
    const bf16* p; const float* sink; bf16* ycat;
    HD void operator()(long i) const {
        int hq = (int)(i % 4); long t = i / 4; int b = (int)(t / S), s = (int)(t % S); int hk = hq >> 1;
        const bf16* qp = p + t * DIN + O1 + hq * 64;
        float q[64], acc[64];
#pragma unroll
        for (int d = 0; d < 64; ++d) { q[d] = bf2f(qp[d]); acc[d] = 0.f; }
        float m = sink[hq], l = 1.0f;
        for (int j = 0; j < LC; ++j) {
            const bf16* kr = p + ((long)TL + (long)b * LC + j) * DIN + O1 + 256 + hk * 64;
            attn_key(q, kr, kr + 128, 0.f, m, l, acc);
        }
        int j0 = s - WINDOW < 0 ? 0 : s - WINDOW, j1 = s + WINDOW > S - 1 ? S - 1 : s + WINDOW;
        for (int j = j0; j <= j1; ++j) {
            const bf16* kr = p + ((long)b * S + j) * DIN + O1 + 256 + hk * 64;
            attn_key(q, kr, kr + 128, 0.f, m, l, acc);
        }
        float il = 1.0f / l;
#pragma unroll
        for (int d = 0; d < 64; ++d) ycat[t * 1024 + 256 + hq * 64 + d] = f2bf(acc[d] * il);
    }
    static HD long count() { return (long)TL * 4; }
};
struct NkWACtx {
    const bf16* p; const float* sink; bf16* ycat;
    HD void operator()(long i) const {
        int hq = (int)(i % 4); long tc = i / 4; int b = (int)(tc / LC); int hk = hq >> 1; long t = TL + tc;
        const bf16* qp = p + t * DIN + O1 + hq * 64;
        float q[64], acc[64];
#pragma unroll
        for (int d = 0; d < 64; ++d) { q[d] = bf2f(qp[d]); acc[d] = 0.f; }
        float m = sink[hq], l = 1.0f;
        for (int j = 0; j < LC; ++j) {
            const bf16* kr = p + ((long)TL + (long)b * LC + j) * DIN + O1 + 256 + hk * 64;
            attn_key(q, kr, kr + 128, 0.f, m, l, acc);
        }
        float il = 1.0f / l;
#pragma unroll
        for (int d = 0; d < 64; ++d) ycat[t * 1024 + 256 + hq * 64 + d] = f2bf(acc[d] * il);
    }
    static HD long count() { return (long)TC * 4; }
};
struct NkNA {
    const bf16* p; const float* rpb; bf16* ycat;
    HD void operator()(long i) const {
        int h = (int)(i % 4); long t = i / 4; int b = (int)(t / S), s = (int)(t % S);
        int r = s / GRID_W, cq = s % GRID_W;
        const bf16* qp = p + t * DIN + O2 + h * 64;
        float q[64], acc[64];
#pragma unroll
        for (int d = 0; d < 64; ++d) { q[d] = bf2f(qp[d]); acc[d] = 0.f; }
        float m = -1e30f, l = 0.f;
        for (int j = 0; j < LC; ++j) {
            const bf16* kr = p + ((long)TL + (long)b * LC + j) * DIN + O2 + 256 + h * 64;
            attn_key(q, kr, kr + 256, 0.f, m, l, acc);
        }
        int r0 = r - NA_KR / 2; r0 = r0 < 0 ? 0 : (r0 > S / GRID_W - NA_KR ? S / GRID_W - NA_KR : r0);
        int c0 = cq - NA_KC / 2; c0 = c0 < 0 ? 0 : (c0 > GRID_W - NA_KC ? GRID_W - NA_KC : c0);
        for (int kk = 0; kk < NA_KR * NA_KC; ++kk) {
            int kr_ = r0 + kk / NA_KC, kc_ = c0 + kk % NA_KC;
            const bf16* kr = p + ((long)b * S + kr_ * GRID_W + kc_) * DIN + O2 + 256 + h * 64;
            attn_key(q, kr, kr + 256, rpb[(h * 15 + (kr_ - r + 7)) * 31 + (kc_ - cq + 15)], m, l, acc);
        }
        float il = 1.0f / l;
#pragma unroll
        for (int d = 0; d < 64; ++d) ycat[t * 1024 + 512 + h * 64 + d] = f2bf(acc[d] * il);
    }
    static HD long count() { return (long)TL * 4; }
};
struct NkNACtx {
    const bf16* p; bf16* ycat;
    HD void operator()(long i) const {
        int h = (int)(i % 4); long tc = i / 4; int b = (int)(tc / LC); long t = TL + tc;
        const bf16* qp = p + t * DIN + O2 + h * 64;
        float q[64], acc[64];
#pragma unroll
        for (int d = 0; d < 64; ++d) { q[d] = bf2f(qp[d]); acc[d] = 0.f; }
        float m = -1e30f, l = 0.f;
        for (int j = 0; j < LC; ++j) {
            const bf16* kr = p + ((long)TL + (long)b * LC + j) * DIN + O2 + 256 + h * 64;
            attn_key(q, kr, kr + 256, 0.f, m, l, acc);
        }
        float il = 1.0f / l;
#pragma unroll
        for (int d = 0; d < 64; ++d) ycat[t * 1024 + 512 + h * 64 + d] = f2bf(acc[d] * il);
    }
    static HD long count() { return (long)TC * 4; }
};

HD float gdn_conv4(const bf16* p, long t, int tin, int L, int col, const float* cw) {
    float acc = 0.f;
    for (int i = 0; i < 4; ++i) { int o = i - 2; if (tin + o >= 0 && tin + o < L) acc += cw[i * 768 + col] * bf2f(p[(t + o) * DIN + O3 + col]); }
    return siluf(acc);
}
struct NkGdnPrep {
    const bf16* p; const float* cw; bf16* qkv;
    HD void operator()(long i) const {
        int e = (int)(i % 64); int wh = (int)((i / 64) % 12); long t = i / 768; int which = wh / 4;
        int L = t < TL ? S : LC; int tin = t < TL ? (int)(t % S) : (int)((t - TL) % LC);
        int col0 = wh * 64;
        float v = gdn_conv4(p, t, tin, L, col0 + e, cw);
        if (which < 2) {
            float ss = 0.f; for (int d = 0; d < 64; ++d) { float u = gdn_conv4(p, t, tin, L, col0 + d, cw); ss += u * u; }
            v *= 1.0f / sqrtf(ss + EPS); if (which == 0) v *= 0.125f;
        }
        qkv[t * 768 + col0 + e] = f2bf(v);
    }
    static HD long count() { return (long)T * 768; }
};
struct NkGdnGate {
    const bf16* p; const float* a_log; const float* dt_bias; float* gb;
    HD void operator()(long i) const {
        int dh = (int)(i % 8); long t = i / 8;
        float a = bf2f(p[t * DIN + O3 + 1024 + dh]), bb = bf2f(p[t * DIN + O3 + 1032 + dh]);
        float x = a + dt_bias[dh]; float sp = x > 20.f ? x : log1pf(expf(x));
        gb[t * 16 + dh] = -expf(a_log[dh]) * sp; gb[t * 16 + 8 + dh] = 1.0f / (1.0f + expf(-bb));
    }
    static HD long count() { return (long)T * 8; }
};
struct NkGdnRec {
    const bf16* qkv; const float* gb; bf16* o;
    HD void operator()(long i) const {
        int e = (int)(i % 64); int dir = (int)((i / 64) % 2); int h = (int)((i / 128) % 4); int b = (int)(i / 512);
        float Sc[64];
#pragma unroll
        for (int d = 0; d < 64; ++d) Sc[d] = 0.f;
        for (int step = 0; step < LC + S; ++step) {
            long t;
            if (step < LC) { int j = dir ? LC - 1 - step : step; t = (long)TL + (long)b * LC + j; }
            else { int s = step - LC; s = dir ? S - 1 - s : s; t = (long)b * S + s; }
            const bf16* qr = qkv + t * 768 + h * 64; const bf16* kr = qr + 256; float v = bf2f(qr[512 + e]);
            float a = expf(gb[t * 16 + dir * 4 + h]), beta = gb[t * 16 + 8 + dir * 4 + h];
            float kS = 0.f;
#pragma unroll
            for (int c = 0; c < 4; ++c) {
#pragma unroll
                for (int d = c * 16; d < c * 16 + 16; ++d) kS += bf2f(kr[d]) * Sc[d];
                asm volatile("" ::: "memory");
            }
            float w = beta * (v - a * kS); float oo = 0.f;
#pragma unroll
            for (int c = 0; c < 4; ++c) {
#pragma unroll
                for (int d = c * 16; d < c * 16 + 16; ++d) { Sc[d] = a * Sc[d] + bf2f(kr[d]) * w; oo += bf2f(qr[d]) * Sc[d]; }
                asm volatile("" ::: "memory");
            }
            o[((long)dir * T + t) * 256 + h * 64 + e] = f2bf(oo);
        }
    }
    static HD long count() { return (long)B * 4 * 2 * 64; }
};
struct NkGdnFin {
    const bf16* p; const bf16* o; const float* ng; bf16* ycat;
    HD void operator()(long i) const {
        int e = (int)(i % 64); int h = (int)((i / 64) % 4); long t = i / 256;
        const bf16* o0 = o + t * 256 + h * 64; const bf16* o1 = o + ((long)T + t) * 256 + h * 64;
        float ss = 0.f; for (int d = 0; d < 64; ++d) { float u = bf2f(o0[d]) + bf2f(o1[d]); ss += u * u; }
        float v = (bf2f(o0[e]) + bf2f(o1[e])) * (1.0f / sqrtf(ss * (1.0f / 64.0f) + EPS)) * ng[e];
        float gt = bf2f(p[t * DIN + O3 + 768 + h * 64 + e]);
        ycat[t * 1024 + 768 + h * 64 + e] = f2bf(v * siluf(gt));
    }
    static HD long count() { return (long)T * 256; }
};

struct NkOutProj {
    const bf16* ycat; const float* w; const float* mod; float* xr; long ntok;
    HD void operator()(long i) const {
        long t = i / D; int n = (int)(i % D); int r = t < TL ? (int)(t / S) : 8;
        const bf16* yr = ycat + t * 1024; float acc = 0.f;
        for (int k = 0; k < 1024; ++k) acc += bf2f(yr[k]) * w[(long)k * D + n];
        xr[i] += mod[(long)r * 6144 + 2 * D + n] * acc;
    }
};

struct NkRouter {
    const bf16* h; const float* wr; float* scores;
    HD void operator()(long i) const {
        int e = (int)(i % 32); long t = i / 32; float acc = 0.f;
        for (int k = 0; k < D; ++k) acc += bf2f(h[t * D + k]) * wr[k * 32 + e];
        scores[i] = 1.0f / (1.0f + expf(-acc));
    }
};
struct NkTopK {
    const float* scores; const float* ebias; int* topi; float* topw;
    HD void operator()(long t) const {
        int sel[4]; float ss[4]; float sum = 0.f;
#pragma unroll
        for (int k = 0; k < 4; ++k) {
            int best = -1; float bv = -1e30f;
            for (int e = 0; e < 32; ++e) {
                bool used = false;
#pragma unroll
                for (int q = 0; q < 4; ++q) if (q < k && sel[q] == e) used = true;
                float v = scores[t * 32 + e] + ebias[e];
                if (!used && v > bv) { bv = v; best = e; }
            }
            sel[k] = best; ss[k] = scores[t * 32 + best]; sum += ss[k];
        }
#pragma unroll
        for (int k = 0; k < 4; ++k) { topi[t * 4 + k] = sel[k]; topw[t * 4 + k] = ss[k] / sum * ROUTED_SCALE; }
    }
};
struct NkMoeHid {
    const bf16* h; const int* topi; const float* wg; const float* wu; const float* sg; const float* su; bf16* hid;
    HD void operator()(long i) const {
        int j = (int)(i % 256); int slot = (int)((i / 256) % 5); long t = i / 1280;
        const float* g; const float* u;
        if (slot < 4) { int e = topi[t * 4 + slot]; g = wg + (long)e * D * 256; u = wu + (long)e * D * 256; } else { g = sg; u = su; }
        float ag = 0.f, au = 0.f;
        for (int k = 0; k < D; ++k) { float x = bf2f(h[t * D + k]); ag += x * g[(long)k * 256 + j]; au += x * u[(long)k * 256 + j]; }
        hid[i] = f2bf(siluf(ag) * au);
    }
};
struct NkMoeOut {
    const bf16* hid; const int* topi; const float* topw; const float* wd; const float* sd; const float* mod; float* xr;
    HD void operator()(long i) const {
        long t = i / D; int n = (int)(i % D); int r = t < TL ? (int)(t / S) : 8;
        float f = 0.f;
        for (int slot = 0; slot < 5; ++slot) {
            const float* w; float wt;
            if (slot < 4) { w = wd + (long)topi[t * 4 + slot] * 256 * D; wt = topw[t * 4 + slot]; } else { w = sd; wt = 1.0f; }
            float acc = 0.f;
            for (int j = 0; j < 256; ++j) acc += bf2f(hid[(t * 5 + slot) * 256 + j]) * w[(long)j * D + n];
            f += wt * acc;
        }
        xr[i] += mod[(long)r * 6144 + 5 * D + n] * f;
    }
};
struct NkFinal {
    const float* xr; const float* rstd; const float* g; float* out;
    HD void operator()(long i) const { long t = i / D; int k = (int)(i % D); out[i] = xr[i] * rstd[t] * g[k]; }
    static HD long count() { return (long)TL * D; }
};

struct NkCvtT {
    const float* src; bf16* dst; int K, N, Npad;
    HD void operator()(long i) const {
        int n = (int)(i % Npad); int k0 = (int)(i / Npad) * 8;
        bf16 v[8];
#pragma unroll
        for (int j = 0; j < 8; ++j) v[j] = n < N ? f2bf(src[(long)(k0 + j) * N + n]) : (bf16)0;
        bf16* d = dst + (long)n * K + k0;
#pragma unroll
        for (int j = 0; j < 8; ++j) d[j] = v[j];
    }
    HD long count() const { return (long)Npad * (K / 8); }
};
struct NkRopeTab {
    float* rope;
    HD void operator()(long i) const {
        int j = (int)(i % 16); int pos = (int)(i / 16);
        float ang = (float)pos * powf(ROPE_BASE, -(float)j / 16.0f);
        rope[i * 2] = cosf(ang); rope[i * 2 + 1] = sinf(ang);
    }
    static HD long count() { return 64 * 16; }
};

struct NkCvtUp {
    const float* wg; const float* wu; const float* sg; const float* su; bf16* dst;
    HD void operator()(long i) const {
        int j = (int)(i % 256); int k0 = (int)((i / 256) % 128) * 8; int which = (int)((i / (256 * 128)) % 2); int e = (int)(i / (256 * 128 * 2));
        const float* src = e < 32 ? (which ? wu : wg) + (long)e * D * 256 : (which ? su : sg);
        int np = (j >> 6) * 128 + ((j >> 5) & 1) * 64 + which * 32 + (j & 31);
        bf16* d = dst + ((long)e * 512 + np) * 1024 + k0;
#pragma unroll
        for (int q = 0; q < 8; ++q) d[q] = f2bf(src[(long)(k0 + q) * 256 + j]);
    }
    static HD long count() { return 33L * 2 * 128 * 256; }
};
struct NkCvtDown {
    const float* wd; const float* sd; bf16* dst;
    HD void operator()(long i) const {
        int n = (int)(i % 1024); int j0 = (int)((i / 1024) % 32) * 8; int e = (int)(i / (1024 * 32));
        const float* src = e < 32 ? wd + (long)e * 256 * D : sd;
        bf16* d = dst + ((long)e * 1024 + n) * 256 + j0;
#pragma unroll
        for (int q = 0; q < 8; ++q) d[q] = f2bf(src[(long)(j0 + q) * D + n]);
    }
    static HD long count() { return 33L * 32 * 1024; }
};
struct NkZeroI { int* p; HD void operator()(long i) const { p[i] = 0; } };
struct WS {
    float* mod; float* rstd; float* xr; bf16* h; bf16* p; bf16* ycat; float* hyf1; float* hyf2; float* filt; bf16* uv;
    bf16* qkv; float* gb; bf16* o; float* scores; int* topi; float* topw; bf16* hid;
    bf16* winT; bf16* woutT; bf16* wrT; float* rope; unsigned* bar; int* cnt; int* list;
    bf16* moeUpT; bf16* hid2; bf16* moeDownT;
    bf16* qk; bf16* uw; float* gc; bf16* x0T; bf16* uvT; int* qctr; bf16* x0Tc; bf16* uvTc; bf16* w3T; bf16* f2b;
};
static inline WS make_ws(void* d_ws) {
    char* base = (char*)d_ws; size_t off = 0;
    auto take = [&](size_t bytes) { char* r = base + off; off += (bytes + 255) & ~(size_t)255; return r; };
    WS w;
    w.mod = (float*)take(2ul * 9 * 6144 * 4);
    w.rstd = (float*)take((size_t)T * 4);
    w.hyf1 = (float*)take(2 * (size_t)(S + LC) * 64 * 4);
    w.hyf2 = (float*)take(2 * (size_t)(S + LC) * 64 * 4);
    w.filt = (float*)take(2 * (size_t)(S + LC) * 512 * 4);
    w.gb = (float*)take((size_t)T * 16 * 4);
#ifdef HOST_SIM
    w.scores = (float*)take((size_t)T * 32 * 4); w.topi = (int*)take((size_t)T * 4 * 4);
#else
    w.scores = nullptr; w.topi = nullptr;
#endif
    w.topw = (float*)take((size_t)T * 4 * 4);
    w.winT = (bf16*)take(2ul * 3328 * 1024 * 2);
    w.woutT = (bf16*)take(2ul * 1024 * 1024 * 2);
    w.wrT = (bf16*)take(2ul * 32 * 1024 * 2);
    w.rope = (float*)take(64 * 16 * 2 * 4);
    w.bar = (unsigned*)take(4096 * 4);
    w.cnt = (int*)take(4 * 32 * 32 * 4);
    w.list = (int*)take((size_t)32 * T * 4);
    w.qctr = (int*)take(64 * 64 * 4);
    w.w3T = (bf16*)take(2ul * 512 * 64 * 2);
    w.f2b = (bf16*)take(2ul * (S + LC) * 64 * 2);
    w.xr = (float*)take((size_t)T * D * 4);
    w.h = (bf16*)take((size_t)T * D * 2);
    w.p = (bf16*)take((size_t)T * DIN * 2);
    w.hid = (bf16*)w.p;
    char* R = take(0);
    const size_t szUp = 33ul * 512 * 1024 * 2, szHid = ((size_t)5 * T + 256) * 256 * 2, szDown = 33ul * 1024 * 256 * 2;
    w.moeUpT = (bf16*)R; w.hid2 = (bf16*)(R + szUp); w.moeDownT = (bf16*)(R + szUp + szHid);
    w.qkv = (bf16*)R;
    w.qk = (bf16*)R;
    w.ycat = w.hid2;
    w.o = (bf16*)((char*)w.ycat + (size_t)T * 1024 * 2);
    w.x0T = (bf16*)((char*)w.ycat + (size_t)T * 1024 * 2);
    w.uvT = w.x0T + (size_t)256 * B * S;
    w.uv = w.uvT + (size_t)256 * B * S;
    w.uw = w.h; w.gc = w.gb;
    w.x0Tc = w.uv; w.uvTc = w.uv + (size_t)256 * B * LC;
    size_t rsz = szUp + szHid + szDown; const size_t rsz2 = szUp + (size_t)T * 1024 * 2 + (size_t)2 * 256 * B * S * 2 + (size_t)T * 256 * 2;
    if (rsz2 > rsz) rsz = rsz2;
    (void)take(rsz);
    return w;
}
#ifdef HOST_SIM
template <class F> static inline void run(F f, long n, hipStream_t) {
#pragma omp parallel for schedule(dynamic, 256)
    for (long i = 0; i < n; ++i) f(i);
}
#endif

struct Inputs {
    const float *x, *c, *ctx, *c_ctx, *w_ada, *b_ada, *norm1, *norm2, *norm_f, *w_in, *w_out, *hy_conv, *hy_w1, *hy_b1, *hy_w2, *hy_b2, *hy_w3, *hy_freq, *hy_bias,
        *wa_sink, *na_rpb, *gdn_conv, *gdn_a_log, *gdn_dt_bias, *gdn_norm, *moe_router, *moe_bias, *moe_gate, *moe_up, *moe_down, *sh_gate, *sh_up, *sh_down;
};

#ifdef HOST_SIM
static void forward_naive(const Inputs& in, float* out, const WS& w, hipStream_t st) {
    run(NkCopyX{in.x, in.ctx, w.xr}, NkCopyX::count(), st);
    run(NkAda{in.c, in.c_ctx, in.w_ada, in.b_ada, w.mod}, NkAda::count(), st);
    for (int l = 0; l < 2; ++l) {
        const bool need_ctx = l == 0;
        const float* mod = w.mod + (size_t)l * 9 * 6144;
        run(NkRstd{w.xr, w.rstd, T}, T, st);
        run(NkModNorm{w.xr, w.rstd, in.norm1 + l * D, mod, 0, 1, w.h}, (long)T * D, st);
        run(NkInProj{w.h, in.w_in + (size_t)l * D * DIN, w.p}, NkInProj::count(), st);
        run(NkRope{w.p}, NkRope::count(), st);
        run(NkHyF1{in.hy_w1 + l * 33 * 64, in.hy_b1 + l * 64, in.hy_freq + l * 64, w.hyf1}, NkHyF1::count(), st);
        run(NkHyF2{in.hy_w2 + l * 64 * 64, in.hy_b2 + l * 64, in.hy_freq + l * 64, w.hyf1, w.hyf2, nullptr}, NkHyF2::count(), st);
        run(NkHyF3{in.hy_w3 + l * 64 * 512, w.hyf2, w.filt}, NkHyF3::count(), st);
        const float* hcw = in.hy_conv + l * 3 * 768;
        run(NkHyUV{w.p, hcw, w.uv, 0, TL, S}, (long)TL * 256, st);
        run(NkHyConv{w.p, hcw, w.uv, w.filt, in.hy_bias + l * 256, w.ycat, 0, S, 0}, (long)TL * 256, st);
        if (need_ctx) {
            run(NkHyUV{w.p, hcw, w.uv, TL, TC, LC}, (long)TC * 256, st);
            run(NkHyConv{w.p, hcw, w.uv, w.filt, in.hy_bias + l * 256, w.ycat, TL, LC, S}, (long)TC * 256, st);
        }
        run(NkWA{w.p, in.wa_sink + l * 4, w.ycat}, NkWA::count(), st);
        if (need_ctx) run(NkWACtx{w.p, in.wa_sink + l * 4, w.ycat}, NkWACtx::count(), st);
        run(NkNA{w.p, in.na_rpb + l * 4 * 15 * 31, w.ycat}, NkNA::count(), st);
        if (need_ctx) run(NkNACtx{w.p, w.ycat}, NkNACtx::count(), st);
        run(NkGdnPrep{w.p, in.gdn_conv + l * 4 * 768, w.qkv}, NkGdnPrep::count(), st);
        run(NkGdnGate{w.p, in.gdn_a_log + l * 8, in.gdn_dt_bias + l * 8, w.gb}, NkGdnGate::count(), st);
        run(NkGdnRec{w.qkv, w.gb, w.o}, NkGdnRec::count(), st);
        run(NkGdnFin{w.p, w.o, in.gdn_norm + l * 64, w.ycat}, need_ctx ? (long)T * 256 : (long)TL * 256, st);
        const long ntok = need_ctx ? T : TL;
        run(NkOutProj{w.ycat, in.w_out + (size_t)l * 1024 * D, mod, w.xr, ntok}, ntok * D, st);
        run(NkRstd{w.xr, w.rstd, (int)ntok}, ntok, st);
        run(NkModNorm{w.xr, w.rstd, in.norm2 + l * D, mod, 3, 4, w.h}, ntok * D, st);
        run(NkRouter{w.h, in.moe_router + l * D * 32, w.scores}, ntok * 32, st);
        run(NkTopK{w.scores, in.moe_bias + l * 32, w.topi, w.topw}, ntok, st);
        run(NkMoeHid{w.h, w.topi, in.moe_gate + (size_t)l * 32 * D * 256, in.moe_up + (size_t)l * 32 * D * 256, in.sh_gate + (size_t)l * D * 256, in.sh_up + (size_t)l * D * 256, w.hid}, ntok * 1280, st);
        run(NkMoeOut{w.hid, w.topi, w.topw, in.moe_down + (size_t)l * 32 * 256 * D, in.sh_down + (size_t)l * 256 * D, mod, w.xr}, ntok * D, st);
    }
    run(NkRstd{w.xr, w.rstd, TL}, TL, st);
    run(NkFinal{w.xr, w.rstd, in.norm_f, out}, NkFinal::count(), st);
}


#endif
#ifdef HOST_SIM
extern "C" void kernel_launch(void* const* d_in, const int* in_sizes, int n_in, void* d_out, int out_size, void* d_ws, size_t ws_size, hipStream_t stream) {
    Inputs in;
    const float** ip = (const float**)&in;
    for (int i = 0; i < 33; ++i) ip[i] = (const float*)d_in[i];
    WS w = make_ws(d_ws);
    forward_naive(in, (float*)d_out, w, stream);
}

#endif
#ifndef HOST_SIM
#define XB_TMO      128
#define XB_XCNT(j)  (256  + 64 * (j))
#define XB_XSUB(j)  (1280 + 64 * (j))
#define XB_XGEN(j)  (2304 + 64 * (j))
#define XB_TOP      3328
#define XB_TOPGEN   3392
#define XCD_BAR_WORDS 3456
#define XB_SPIN_CAP (1u << 26)
#define LAS __attribute__((address_space(3)))
__device__ __forceinline__ unsigned xb_ld(unsigned* p)              { return __hip_atomic_load(p, __ATOMIC_RELAXED, __HIP_MEMORY_SCOPE_AGENT); }
__device__ __forceinline__ unsigned xb_add(unsigned* p, unsigned v) { return __hip_atomic_fetch_add(p, v, __ATOMIC_RELAXED, __HIP_MEMORY_SCOPE_AGENT); }
__device__ __forceinline__ unsigned xb_xcc_id() { return (unsigned)__builtin_amdgcn_s_getreg((3 << 11) | 20) & 0xFu; }
#define XB_SPIN(cond, bar) do { unsigned _sp = 0; while (cond) { __builtin_amdgcn_s_sleep(1); \
    if ((++_sp & 255u) == 0u) { if (xb_ld(&(bar)[XB_TMO])) break; if (_sp > XB_SPIN_CAP) { atomicAdd(&(bar)[XB_TMO], 1u); break; } } } } while (0)
struct XcdBarrier { unsigned* bar; unsigned x; volatile LAS unsigned* st; };
__device__ __forceinline__ XcdBarrier xcd_barrier_post(unsigned* bar, volatile LAS unsigned* st) {
    XcdBarrier b; b.bar = bar; b.x = xb_xcc_id(); b.st = st;
    if (threadIdx.x == 0) (void)xb_add(&bar[XB_XCNT(b.x)], 1u);
    return b;
}
__device__ __forceinline__ void xcd_barrier_complete(unsigned* bar, unsigned x, unsigned& nloc, unsigned& nx) {
    const unsigned G = gridDim.x * gridDim.y * gridDim.z;
    unsigned sum, cnt, mine, sp = 0u;
    for (;;) {
        sum = 0u; cnt = 0u; mine = 0u;
#pragma unroll
        for (unsigned j = 0; j < 16; ++j) { const unsigned c = xb_ld(&bar[XB_XCNT(j)]); sum += c; cnt += (c > 0u) ? 1u : 0u; mine = (j == x) ? c : mine; }
        if (sum == G) break;
        __builtin_amdgcn_s_sleep(1);
        if ((++sp & 255u) == 0u) { if (xb_ld(&bar[XB_TMO])) break; if (sp > XB_SPIN_CAP) { atomicAdd(&bar[XB_TMO], 1u); break; } }
    }
    nloc = mine > 0u ? mine : 1u; nx = cnt > 0u ? cnt : 1u;
}
__device__ __forceinline__ void xcd_barrier(const XcdBarrier& b) {
    asm volatile("s_waitcnt vmcnt(0)" ::: "memory");
    __syncthreads();
    if (threadIdx.x == 0) {
        unsigned* bar = b.bar;
        __builtin_amdgcn_s_waitcnt(0);
        unsigned nloc = b.st[0], nx = b.st[1];
        if (nloc == 0u) { xcd_barrier_complete(bar, b.x, nloc, nx); b.st[0] = nloc; b.st[1] = nx; }
        const unsigned old = xb_add(&bar[XB_XSUB(b.x)], 1u);
        const unsigned gen = old / nloc;
        if (old + 1u == (gen + 1u) * nloc) {
            __builtin_amdgcn_fence(__ATOMIC_RELEASE, "agent");
            asm volatile("s_waitcnt vmcnt(0)" ::: "memory");
            const unsigned og = xb_add(&bar[XB_TOP], 1u);
            const unsigned tg = og / nx;
            if (og + 1u == (tg + 1u) * nx) xb_add(&bar[XB_TOPGEN], 1u);
            else XB_SPIN(xb_ld(&bar[XB_TOPGEN]) == tg, bar);
            __builtin_amdgcn_fence(__ATOMIC_ACQUIRE, "agent");
            xb_add(&bar[XB_XGEN(b.x)], 1u);
            asm volatile("s_waitcnt vmcnt(0)" ::: "memory");
        } else {
            XB_SPIN(xb_ld(&bar[XB_XGEN(b.x)]) == gen, bar);
            __builtin_amdgcn_fence(__ATOMIC_ACQUIRE, "agent");
            asm volatile("s_waitcnt vmcnt(0)" ::: "memory");
        }
    }
    __syncthreads();
}
#endif
#ifndef HOST_SIM
typedef short bf16x8 __attribute__((ext_vector_type(8)));
typedef float f32x16 __attribute__((ext_vector_type(16)));
typedef float f32x4 __attribute__((ext_vector_type(4)));
typedef unsigned u32x4 __attribute__((ext_vector_type(4)));
typedef unsigned u32x2 __attribute__((ext_vector_type(2)));
#define NTHREADS 512

__device__ __forceinline__ void st_wt8(void* p, u32x2 v) { __hip_atomic_store((unsigned long long*)p, ((unsigned long long)v.y << 32) | v.x, __ATOMIC_RELAXED, __HIP_MEMORY_SCOPE_AGENT); }
__device__ __forceinline__ void st_wt16(void* p, f32x4 v) { asm volatile("global_store_dwordx4 %0, %1, off sc1\n\ts_nop 1" :: "v"(p), "v"(v) : "memory"); }
typedef __bf16 bf16x2n __attribute__((ext_vector_type(2)));
typedef float f32x2n __attribute__((ext_vector_type(2)));
__device__ __forceinline__ unsigned pack_bf16(float lo, float hi) { f32x2n f = {lo, hi}; bf16x2n r = __builtin_convertvector(f, bf16x2n); return __builtin_bit_cast(unsigned, r); }

constexpr int GBM = 256, GBN = 128, GBK = 64;
constexpr int G_ASTAGE = GBM * GBK * 2, G_BSTAGE = GBN * GBK * 2, G_STAGE = G_ASTAGE + G_BSTAGE;
constexpr int G_LDS = 2 * G_STAGE;
__device__ __forceinline__ int g_lds_off(int r, int c) { return r * 128 + ((c ^ ((r >> 1) & 7)) << 4); }

template <class ARow, class Epi>
__device__ __forceinline__ void gemm_tile(char* lds, const ARow& arow, const bf16* __restrict__ Bt, int ldb, int K, int m0, int n0, const Epi& epi) {
    int tid = threadIdx.x; asm volatile("" : "+v"(tid));
    const int lane = tid & 63, wid = __builtin_amdgcn_readfirstlane(tid >> 6), wm = wid >> 1, wn = wid & 1;
    const bf16* ap[4]; const bf16* bp[2];
#pragma unroll
    for (int j = 0; j < 4; ++j) { const int r = 8 * (wid * 4 + j) + (lane >> 3); ap[j] = arow(r) + 8 * ((lane & 7) ^ ((r >> 1) & 7)); }
#pragma unroll
    for (int j = 0; j < 2; ++j) { const int r = 8 * (wid * 2 + j) + (lane >> 3); bp[j] = Bt + (size_t)(n0 + r) * ldb + 8 * ((lane & 7) ^ ((r >> 1) & 7)); }
    f32x16 acc[2][2];
#pragma unroll
    for (int a = 0; a < 2; ++a)
#pragma unroll
        for (int b = 0; b < 2; ++b)
#pragma unroll
            for (int r = 0; r < 16; ++r) acc[a][b][r] = 0.f;
    const int nk = K / GBK;
    __syncthreads();
#define G_DMA(kt_, stage_) do { \
        _Pragma("unroll") for (int j = 0; j < 4; ++j) __builtin_amdgcn_global_load_lds((const unsigned*)(ap[j] + (kt_) * GBK), (LAS unsigned*)((stage_) + (wid * 4 + j) * 1024), 16, 0, 0); \
        _Pragma("unroll") for (int j = 0; j < 2; ++j) __builtin_amdgcn_global_load_lds((const unsigned*)(bp[j] + (kt_) * GBK), (LAS unsigned*)((stage_) + G_ASTAGE + (wid * 2 + j) * 1024), 16, 0, 0); } while (0)
    G_DMA(0, lds);
    __syncthreads();
    const int fr = lane & 31, fh = lane >> 5;
    for (int kt = 0; kt < nk; ++kt) {
        char* cur = lds + (kt & 1) * G_STAGE;
        if (kt + 1 < nk) { char* nxt = lds + ((kt + 1) & 1) * G_STAGE; G_DMA(kt + 1, nxt); }
#pragma unroll
        for (int kk = 0; kk < 4; ++kk) {
            bf16x8 fa[2], fb[2];
#pragma unroll
            for (int mi = 0; mi < 2; ++mi) fa[mi] = *(const bf16x8*)(cur + g_lds_off(wm * 64 + mi * 32 + fr, kk * 2 + fh));
#pragma unroll
            for (int ni = 0; ni < 2; ++ni) fb[ni] = *(const bf16x8*)(cur + G_ASTAGE + g_lds_off(wn * 64 + ni * 32 + fr, kk * 2 + fh));
#pragma unroll
            for (int mi = 0; mi < 2; ++mi)
#pragma unroll
                for (int ni = 0; ni < 2; ++ni) acc[mi][ni] = __builtin_amdgcn_mfma_f32_32x32x16_bf16(fb[ni], fa[mi], acc[mi][ni], 0, 0, 0);
        }
        __syncthreads();
    }
#undef G_DMA
    epi(acc, m0 + wm * 64 + fr, n0 + wn * 64 + 4 * fh);
}


constexpr int G_LDS3 = 3 * G_STAGE;
struct GPtrs { const bf16* a[4]; const bf16* b[2]; };
template <class TL> __device__ __forceinline__ void g_ptrs(const TL& tl, const typename TL::Tile& t, int wid, int lane, GPtrs& P) {
#pragma unroll
    for (int j = 0; j < 4; ++j) { const int r = 8 * (wid * 4 + j) + (lane >> 3); P.a[j] = tl.arow(t, r) + 8 * ((lane & 7) ^ ((r >> 1) & 7)); }
#pragma unroll
    for (int j = 0; j < 2; ++j) { const int r = 8 * (wid * 2 + j) + (lane >> 3); P.b[j] = tl.brow(t, r) + 8 * ((lane & 7) ^ ((r >> 1) & 7)); }
}
__device__ __forceinline__ void g_dma(char* lds, const GPtrs& P, int kt, int stage, int wid) {
    char* st = lds + stage * G_STAGE;
#pragma unroll
    for (int j = 0; j < 4; ++j) __builtin_amdgcn_global_load_lds((const unsigned*)(P.a[j] + kt * GBK), (LAS unsigned*)(st + (wid * 4 + j) * 1024), 16, 0, 0);
#pragma unroll
    for (int j = 0; j < 2; ++j) __builtin_amdgcn_global_load_lds((const unsigned*)(P.b[j] + kt * GBK), (LAS unsigned*)(st + G_ASTAGE + (wid * 2 + j) * 1024), 16, 0, 0);
}
template <class TL, int XF = 0>
__device__ __forceinline__ void gemm_stream(char* lds, const TL& tl) {
    int tid = threadIdx.x; asm volatile("" : "+v"(tid));
    const int lane = tid & 63, wid = __builtin_amdgcn_readfirstlane(tid >> 6), wm = wid >> 1, wn = wid & 1, fr = lane & 31, fh = lane >> 5;
    constexpr int nk = TL::K / GBK;
    static_assert(nk >= 2, "K too small");
    int idx = blockIdx.x;
    typename TL::Tile cur, nxt;
    if (!tl.tile(idx, cur)) return;
    GPtrs P, Pn;
    g_ptrs(tl, cur, wid, lane, P);
    bool has_next = tl.tile(idx + (int)gridDim.x, nxt);
    if (has_next) g_ptrs(tl, nxt, wid, lane, Pn);
    __syncthreads();
    if (!(XF & 1)) { g_dma(lds, P, 0, 0, wid); g_dma(lds, P, 1, 1, wid); }
    int sg = 0;
    for (;;) {
        f32x16 acc[2][2];
#pragma unroll
        for (int a = 0; a < 2; ++a)
#pragma unroll
            for (int b = 0; b < 2; ++b)
#pragma unroll
                for (int r = 0; r < 16; ++r) acc[a][b][r] = 0.f;
        for (int kt = 0; kt < nk; ++kt) {
            if (!(XF & 2)) { if (kt + 1 < nk || has_next) asm volatile("s_waitcnt vmcnt(6)" ::: "memory"); else asm volatile("s_waitcnt vmcnt(0)" ::: "memory");
            __builtin_amdgcn_s_barrier(); }
            asm volatile("" ::: "memory");
            const int s2 = sg >= 1 ? sg - 1 : 2;
            if (!(XF & 1)) { if (kt + 2 < nk) g_dma(lds, P, kt + 2, s2, wid);
            else if (has_next) g_dma(lds, Pn, kt + 2 - nk, s2, wid); }
            const char* cs = lds + sg * G_STAGE;
#pragma unroll
            for (int kk = 0; kk < 4; ++kk) {
                bf16x8 fa[2], fb[2];
#pragma unroll
                for (int mi = 0; mi < 2; ++mi) fa[mi] = *(const bf16x8*)(cs + g_lds_off(wm * 64 + mi * 32 + fr, kk * 2 + fh));
#pragma unroll
                for (int ni = 0; ni < 2; ++ni) fb[ni] = *(const bf16x8*)(cs + G_ASTAGE + g_lds_off(wn * 64 + ni * 32 + fr, kk * 2 + fh));
#pragma unroll
                for (int mi = 0; mi < 2; ++mi)
#pragma unroll
                    for (int ni = 0; ni < 2; ++ni) acc[mi][ni] = __builtin_amdgcn_mfma_f32_32x32x16_bf16(fb[ni], fa[mi], acc[mi][ni], 0, 0, 0);
            }
            sg = sg == 2 ? 0 : sg + 1;
        }
        tl.epi(cur, acc, wm * 64 + fr, wn * 64 + 4 * fh);
        if (!has_next) break;
        asm volatile("s_waitcnt vmcnt(0)" ::: "memory");
        cur = nxt; P = Pn; idx += (int)gridDim.x;
        has_next = tl.tile(idx + (int)gridDim.x, nxt);
        if (has_next) g_ptrs(tl, nxt, wid, lane, Pn);
    }
    asm volatile("s_waitcnt vmcnt(0)" ::: "memory");
}

constexpr int HBK = 32, H_ASTG = 256 * HBK * 2, H_STG = 2 * H_ASTG, H_RING = 4, H_LDS = H_RING * H_STG;
__device__ __forceinline__ int h_lds_off(int r, int c) { return r * 64 + ((c ^ ((r >> 2) & 3)) << 4); }
struct HPtrs { const bf16* a[2]; const bf16* b[2]; };
template <class TL> __device__ __forceinline__ void h_ptrs(const TL& tl, const typename TL::Tile& t, int wid, int lane, HPtrs& P) {
#pragma unroll
    for (int j = 0; j < 2; ++j) { const int r = 16 * (wid * 2 + j) + (lane >> 2); const int c = (lane & 3) ^ ((r >> 2) & 3); P.a[j] = tl.arow(t, r) + 8 * c; P.b[j] = tl.brow(t, r) + 8 * c; }
}
__device__ __forceinline__ void h_dma(char* lds, const HPtrs& P, int kt, int stage, int wid) {
    char* st = lds + stage * H_STG;
#pragma unroll
    for (int j = 0; j < 2; ++j) __builtin_amdgcn_global_load_lds((const unsigned*)(P.a[j] + kt * HBK), (LAS unsigned*)(st + (wid * 2 + j) * 1024), 16, 0, 0);
#pragma unroll
    for (int j = 0; j < 2; ++j) __builtin_amdgcn_global_load_lds((const unsigned*)(P.b[j] + kt * HBK), (LAS unsigned*)(st + H_ASTG + (wid * 2 + j) * 1024), 16, 0, 0);
}
template <class TL>
__device__ __forceinline__ void gemm_stream256(char* lds, const TL& tl) {
    int tid = threadIdx.x; asm volatile("" : "+v"(tid));
    const int lane = tid & 63, wid = __builtin_amdgcn_readfirstlane(tid >> 6), wm = wid >> 1, wn = wid & 1, fr = lane & 31, fh = lane >> 5;
    constexpr int nk = TL::K / HBK;
    static_assert(nk >= 4, "K too small");
    int idx = blockIdx.x;
    typename TL::Tile cur, nxt;
    if (!tl.tile(idx, cur)) return;
    HPtrs P, Pn;
    h_ptrs(tl, cur, wid, lane, P);
    bool has_next = tl.tile(idx + (int)gridDim.x, nxt);
    if (has_next) h_ptrs(tl, nxt, wid, lane, Pn);
    asm volatile("s_waitcnt vmcnt(0)" ::: "memory");
    __syncthreads();
    h_dma(lds, P, 0, 0, wid); h_dma(lds, P, 1, 1, wid); h_dma(lds, P, 2, 2, wid);
    int sg = 0;
    for (;;) {
        f32x16 acc[2][4];
#pragma unroll
        for (int a = 0; a < 2; ++a)
#pragma unroll
            for (int b = 0; b < 4; ++b)
#pragma unroll
                for (int r = 0; r < 16; ++r) acc[a][b][r] = 0.f;
        const unsigned act = tl.active(cur, wn);
        for (int kt = 0; kt < nk; ++kt) {
            const int ahead = (nk - 1 - kt) + (has_next ? 3 : 0);
            if (ahead >= 2) asm volatile("s_waitcnt vmcnt(8)" ::: "memory"); else if (ahead == 1) asm volatile("s_waitcnt vmcnt(4)" ::: "memory"); else asm volatile("s_waitcnt vmcnt(0)" ::: "memory");
            __builtin_amdgcn_s_barrier();
            asm volatile("" ::: "memory");
            const int s3 = (sg + 3) & 3;
            if (kt + 3 < nk) h_dma(lds, P, kt + 3, s3, wid);
            else if (has_next) h_dma(lds, Pn, kt + 3 - nk, s3, wid);
            const char* cs = lds + sg * H_STG;
#pragma unroll
            for (int kk = 0; kk < 2; ++kk) {
                bf16x8 fa[2], fb[4];
#pragma unroll
                for (int mi = 0; mi < 2; ++mi) fa[mi] = *(const bf16x8*)(cs + h_lds_off(wm * 64 + mi * 32 + fr, kk * 2 + fh));
#pragma unroll
                for (int ni = 0; ni < 4; ++ni) fb[ni] = *(const bf16x8*)(cs + H_ASTG + h_lds_off(wn * 128 + ni * 32 + fr, kk * 2 + fh));
#pragma unroll
                for (int ni = 0; ni < 4; ++ni)
                    if (act & (1u << ni)) {
#pragma unroll
                        for (int mi = 0; mi < 2; ++mi) acc[mi][ni] = __builtin_amdgcn_mfma_f32_32x32x16_bf16(fb[ni], fa[mi], acc[mi][ni], 0, 0, 0);
                    }
            }
            sg = (sg + 1) & 3;
        }
        tl.epi(cur, acc, wm * 64 + fr, wn * 128 + 4 * fh);
        if (!has_next) break;
        asm volatile("s_waitcnt vmcnt(0)" ::: "memory");
        cur = nxt; P = Pn; idx += (int)gridDim.x;
        has_next = tl.tile(idx + (int)gridDim.x, nxt);
        if (has_next) h_ptrs(tl, nxt, wid, lane, Pn);
    }
    asm volatile("s_waitcnt vmcnt(0)" ::: "memory");
}

struct ARowDense { const bf16* A; int lda; int m0; __device__ __forceinline__ const bf16* operator()(int i) const { return A + (size_t)(m0 + i) * lda; } };

__device__ __forceinline__ int perm64(int rho) { const int ni = rho >> 5, g = (rho >> 3) & 3, fh = (rho >> 2) & 1, q = rho & 3; return 16 * g + 8 * fh + 4 * ni + q; }
struct EpiInProj {
    bf16* p; const float* rope;
    __device__ __forceinline__ void operator()(f32x16 (&acc)[2][2], int mrow, int ncol  ) const {
        const int nb = ncol & ~63, fh = (ncol >> 2) & 1;
#pragma unroll
        for (int mi = 0; mi < 2; ++mi) {
            const int m = mrow + mi * 32;
            if (nb >= O1 && nb < O1 + 384 && m < TL) {
                const int s = m & (S - 1);
#pragma unroll
                for (int ax = 0; ax < 2; ++ax) {
                    const int pos = ax == 0 ? (s >> 6) : (s & 63);
#pragma unroll
                    for (int ni = 0; ni < 2; ++ni)
#pragma unroll
                        for (int q = 0; q < 4; ++q) {
                            const int j = 8 * fh + 4 * ni + q;
                            const float cs = rope[(pos * 16 + j) * 2], sn = rope[(pos * 16 + j) * 2 + 1];
                            const float x1 = acc[mi][ni][8 * ax + q], x2 = acc[mi][ni][8 * ax + 4 + q];
                            acc[mi][ni][8 * ax + q] = x1 * cs - x2 * sn; acc[mi][ni][8 * ax + 4 + q] = x1 * sn + x2 * cs;
                        }
                }
            }
#pragma unroll
            for (int g = 0; g < 4; ++g) {
                const int n = nb + 16 * g + 8 * fh;
                if (n < DIN) {
                    u32x4 v; v.x = pack_bf16(acc[mi][0][4 * g], acc[mi][0][4 * g + 1]); v.y = pack_bf16(acc[mi][0][4 * g + 2], acc[mi][0][4 * g + 3]);
                    v.z = pack_bf16(acc[mi][1][4 * g], acc[mi][1][4 * g + 1]); v.w = pack_bf16(acc[mi][1][4 * g + 2], acc[mi][1][4 * g + 3]);
                    *(u32x4*)(p + (size_t)m * DIN + n) = v;
                }
            }
        }
    }
};
struct EpiInProjH {
    bf16* p; const float* rope;
    __device__ __forceinline__ void operator()(f32x16 (&acc)[2][4], int mrow, int ncol) const {
#pragma unroll
        for (int mi = 0; mi < 2; ++mi) {
            const int m = mrow + mi * 32;
#pragma unroll
            for (int ni = 0; ni < 4; ++ni) {
                const int nb = ncol + ni * 32;
                if (nb >= DIN) continue;
                if (nb >= O1 && nb < O1 + 384 && m < TL) {
                    const int s = m & (S - 1); const int pos = (ni & 1) == 0 ? (s >> 6) : (s & 63);
                    const int jb = (nb & 31);
#pragma unroll
                    for (int r = 0; r < 8; ++r) {
                        const int j = jb + (r & 3) + 8 * (r >> 2);
                        const float cs = rope[(pos * 16 + j) * 2], sn = rope[(pos * 16 + j) * 2 + 1];
                        const float x1 = acc[mi][ni][r], x2 = acc[mi][ni][r + 8];
                        acc[mi][ni][r] = x1 * cs - x2 * sn; acc[mi][ni][r + 8] = x1 * sn + x2 * cs;
                    }
                }
#pragma unroll
                for (int g = 0; g < 4; ++g) {
                    const int n = nb + 8 * g;
                    if (n < DIN) { u32x2 v; v.x = pack_bf16(acc[mi][ni][4 * g], acc[mi][ni][4 * g + 1]); v.y = pack_bf16(acc[mi][ni][4 * g + 2], acc[mi][ni][4 * g + 3]); *(u32x2*)(p + (size_t)m * DIN + n) = v; }
                }
            }
        }
    }
};
struct EpiOutProjH {
    float* xr; const float* mod;
    __device__ __forceinline__ void operator()(f32x16 (&acc)[2][4], int mrow, int ncol) const {
#pragma unroll
        for (int mi = 0; mi < 2; ++mi) {
            const int m = mrow + mi * 32; const int rb = m < TL ? m / S : 8;
            const float* g1 = mod + (size_t)rb * 6144 + 2 * D;
#pragma unroll
            for (int ni = 0; ni < 4; ++ni)
#pragma unroll
                for (int g = 0; g < 4; ++g) {
                    const int n = ncol + ni * 32 + 8 * g;
                    f32x4 gv = *(const f32x4*)(g1 + n); float* xp = xr + (size_t)m * D + n; f32x4 xv = *(const f32x4*)xp;
                    xv[0] += gv[0] * acc[mi][ni][4 * g]; xv[1] += gv[1] * acc[mi][ni][4 * g + 1]; xv[2] += gv[2] * acc[mi][ni][4 * g + 2]; xv[3] += gv[3] * acc[mi][ni][4 * g + 3];
                    *(f32x4*)xp = xv;
                }
        }
    }
};
struct EpiOutProj {
    float* xr; const float* mod; const float* xin; const float* cin;
    __device__ __forceinline__ void operator()(f32x16 (&acc)[2][2], int mrow, int ncol) const {
#pragma unroll
        for (int mi = 0; mi < 2; ++mi) {
            const int m = mrow + mi * 32; const int rb = m < TL ? m / S : 8;
            const float* g1 = mod + (size_t)rb * 6144 + 2 * D;
            const float* src = xin ? (m < TL ? xin + (size_t)m * D : cin + (size_t)(m - TL) * D) : xr + (size_t)m * D;
#pragma unroll
            for (int ni = 0; ni < 2; ++ni)
#pragma unroll
                for (int g = 0; g < 4; ++g) {
                    const int n = ncol + ni * 32 + 8 * g;
                    f32x4 gv = *(const f32x4*)(g1 + n); f32x4 xv = *(const f32x4*)(src + n);
                    xv[0] += gv[0] * acc[mi][ni][4 * g]; xv[1] += gv[1] * acc[mi][ni][4 * g + 1]; xv[2] += gv[2] * acc[mi][ni][4 * g + 2]; xv[3] += gv[3] * acc[mi][ni][4 * g + 3];
                    *(f32x4*)(xr + (size_t)m * D + n) = xv;
                }
        }
    }
};
#endif
#ifndef HOST_SIM
template <class NMap>
__device__ __forceinline__ void cvt_tile(char* lds, const float* __restrict__ src, int srcN, bf16* __restrict__ dst, int dstK, int k0, int n0, int nvalid  , int nrows  , const NMap& nmap) {
    int tid = threadIdx.x; asm volatile("" : "+v"(tid));
    bf16* t = (bf16*)lds;
    __syncthreads();
#pragma unroll
    for (int i = 0; i < 2; ++i) {
        const int c = tid + i * NTHREADS, k = c >> 4, n4 = (c & 15) * 4;
        f32x4 v = {0.f, 0.f, 0.f, 0.f};
        if (n0 + n4 < nvalid) v = *(const f32x4*)(src + (size_t)(k0 + k) * srcN + n0 + n4);
#pragma unroll
        for (int q = 0; q < 4; ++q) t[(n4 + q) * 66 + k] = f2bf(v[q]);
    }
    __syncthreads();
    {
        const int n = tid >> 3, kc = tid & 7;
        if (n0 + n < nrows) {
            const unsigned* s = (const unsigned*)(t + n * 66 + kc * 8);
            u32x4 o; o.x = s[0]; o.y = s[1]; o.z = s[2]; o.w = s[3];
            *(u32x4*)(dst + (size_t)nmap(n0 + n) * dstK + k0 + kc * 8) = o;
        }
    }
}

template <class NMap>
__device__ __forceinline__ void cvt_strip(char* lds, const float* __restrict__ src, int srcN, bf16* __restrict__ dst, int dstK, int k0, int n0, int nvalid, int nrows, const NMap& nmap) {
    int tid = threadIdx.x; asm volatile("" : "+v"(tid));
    bf16* t = (bf16*)lds;
    __syncthreads();
    f32x4 v[8];
#pragma unroll
    for (int i = 0; i < 8; ++i) {
        const int c = tid + i * NTHREADS, k = c >> 6, n4 = (c & 63) * 4;
        v[i] = (f32x4){0.f, 0.f, 0.f, 0.f};
        if (n0 + n4 < nvalid) v[i] = *(const f32x4*)(src + (size_t)(k0 + k) * srcN + n0 + n4);
    }
#pragma unroll
    for (int i = 0; i < 8; ++i) {
        const int c = tid + i * NTHREADS, k = c >> 6, n4 = (c & 63) * 4;
#pragma unroll
        for (int q = 0; q < 4; ++q) t[(n4 + q) * 66 + k] = f2bf(v[i][q]);
    }
    __syncthreads();
#pragma unroll
    for (int i = 0; i < 4; ++i) {
        const int n = (tid >> 3) + i * 64, kc = tid & 7;
        if (n0 + n < nrows) {
            const unsigned* s = (const unsigned*)(t + n * 66 + kc * 8);
            u32x4 o; o.x = s[0]; o.y = s[1]; o.z = s[2]; o.w = s[3];
            *(u32x4*)(dst + (size_t)nmap(n0 + n) * dstK + k0 + kc * 8) = o;
        }
    }
}
struct NMapId { __device__ __forceinline__ int operator()(int n) const { return n; } };
struct NMapUp { int which; __device__ __forceinline__ int operator()(int j) const { return (j >> 7) * 256 + ((j >> 6) & 1) * 128 + which * 64 + (j & 63); } };
#endif
#ifndef HOST_SIM
__device__ __forceinline__ float wave_sum(float v) {
#pragma unroll
    for (int o = 32; o > 0; o >>= 1) v += __shfl_xor(v, o);
    return v;
}
template <int MODE, int NORM>
__device__ __forceinline__ void row_pass(const WS& w, const Inputs& in, int ntok, const float* mod_cur  , const float* mod_nrm  ,
                                         const float* gnorm, int shc, int scc, const bf16* y, const float* topw, float* out, bf16* hout, int t_first = -1, int t_end = 0, int t_step = 0) {
    int tid = threadIdx.x; asm volatile("" : "+v"(tid));
    const int lane = tid & 63, wv = tid >> 6;
    if (t_first < 0) { t_first = blockIdx.x * 8 + wv; t_end = ntok; t_step = gridDim.x * 8; }
    for (int t = t_first; t < t_end; t += t_step) {
        const int rb = t < TL ? t / S : 8;
        f32x4 v[4];
        float* xrow = w.xr + (size_t)t * D;
        if (MODE == 0 || MODE == 3) {
            const float* src = t < TL ? in.x + (size_t)t * D : in.ctx + (size_t)(t - TL) * D;
#pragma unroll
            for (int j = 0; j < 4; ++j) { v[j] = *(const f32x4*)(src + j * 256 + lane * 4); if (MODE == 0) st_wt16(xrow + j * 256 + lane * 4, v[j]); }
        } else {
#pragma unroll
            for (int j = 0; j < 4; ++j) v[j] = *(const f32x4*)(xrow + j * 256 + lane * 4);
        }
        if (MODE == 2) {
            const float* g2 = mod_cur + (size_t)rb * 6144 + 5 * D;
            f32x4 f[4];
#pragma unroll
            for (int j = 0; j < 4; ++j) f[j] = (f32x4){0.f, 0.f, 0.f, 0.f};
#pragma unroll
            for (int k = 0; k < 4; ++k) {
                const float wk = topw[(size_t)t * 4 + k]; const bf16* yr = y + ((size_t)t * 4 + k) * D;
#pragma unroll
                for (int j = 0; j < 4; ++j) { u32x2 u = *(const u32x2*)(yr + j * 256 + lane * 4);
                    f[j][0] += wk * __uint_as_float(u.x << 16); f[j][1] += wk * __uint_as_float(u.x & 0xffff0000u); f[j][2] += wk * __uint_as_float(u.y << 16); f[j][3] += wk * __uint_as_float(u.y & 0xffff0000u); }
            }
#pragma unroll
            for (int j = 0; j < 4; ++j) { f32x4 g = *(const f32x4*)(g2 + j * 256 + lane * 4); v[j] += g * f[j]; st_wt16(xrow + j * 256 + lane * 4, v[j]); }
        }
        if (NORM == 0) continue;
        if (NORM == 2 && t >= TL) continue;
        float ss = 0.f;
#pragma unroll
        for (int j = 0; j < 4; ++j) ss += v[j][0] * v[j][0] + v[j][1] * v[j][1] + v[j][2] * v[j][2] + v[j][3] * v[j][3];
        ss = wave_sum(ss);
        const float rstd = 1.0f / sqrtf(ss * (1.0f / D) + EPS);
        if (NORM == 1) {
            const float* m = mod_nrm + (size_t)rb * 6144;
#pragma unroll
            for (int j = 0; j < 4; ++j) {
                const int c = j * 256 + lane * 4;
                f32x4 g = *(const f32x4*)(gnorm + c), sc = *(const f32x4*)(m + scc * D + c), sh = *(const f32x4*)(m + shc * D + c);
                f32x4 hv = v[j] * rstd * g * (sc + 1.0f) + sh;
                u32x2 u; u.x = pack_bf16(hv[0], hv[1]); u.y = pack_bf16(hv[2], hv[3]);
                *(u32x2*)(hout + (size_t)t * D + c) = u;
            }
        } else {
#pragma unroll
            for (int j = 0; j < 4; ++j) { const int c = j * 256 + lane * 4; f32x4 g = *(const f32x4*)(gnorm + c); st_wt16(out + (size_t)t * D + c, v[j] * rstd * g); }
        }
    }
}

constexpr int CNT_PAD = 32;
__device__ __forceinline__ void router_rows(char* lds, const WS& w, const float* ebias, int r0, int r1, int l) {
    int tid = threadIdx.x; asm volatile("" : "+v"(tid));
    const int lane = tid & 63, wv = tid >> 6, fr = lane & 15, fq = lane >> 4;
    float* part = (float*)lds;
    float* sl = part + 8 * 80 * 33;
    float* sb = sl + 80 * 33;
    int* lcnt = (int*)(sb + 80 * 33);
    const bf16* Bt = w.wrT + (size_t)l * 32 * 1024;
    int* cnt = w.cnt + l * 32 * CNT_PAD; int* list = w.list;
    const int nrows = r1 - r0, ng = (nrows + 15) >> 4;
    if (tid < 32) lcnt[tid] = 0;
    {
        const bf16* b0 = Bt + (size_t)fr * 1024 + wv * 128 + fq * 8; const bf16* b1 = b0 + 16 * 1024;
        bf16x8 fb0[4], fb1[4];
#pragma unroll
        for (int ks = 0; ks < 4; ++ks) { fb0[ks] = *(const bf16x8*)(b0 + ks * 32); fb1[ks] = *(const bf16x8*)(b1 + ks * 32); }
        for (int g = 0; g < ng; ++g) {
            const int ra = r0 + g * 16 + fr < r1 ? r0 + g * 16 + fr : r1 - 1;
            const bf16* ar = w.h + (size_t)ra * D + wv * 128 + fq * 8;
            f32x4 a0 = {0.f, 0.f, 0.f, 0.f}, a1 = {0.f, 0.f, 0.f, 0.f};
#pragma unroll
            for (int ks = 0; ks < 4; ++ks) {
                const bf16x8 fa = *(const bf16x8*)(ar + ks * 32);
                a0 = __builtin_amdgcn_mfma_f32_16x16x32_bf16(fa, fb0[ks], a0, 0, 0, 0);
                a1 = __builtin_amdgcn_mfma_f32_16x16x32_bf16(fa, fb1[ks], a1, 0, 0, 0);
            }
            float* pp = part + (wv * 80 + g * 16) * 33;
#pragma unroll
            for (int j = 0; j < 4; ++j) { pp[(4 * fq + j) * 33 + fr] = a0[j]; pp[(4 * fq + j) * 33 + 16 + fr] = a1[j]; }
        }
    }
    __syncthreads();
    for (int i = tid; i < ng * 16 * 32; i += NTHREADS) {
        const int row = i >> 5, e = i & 31; float s = 0.f;
#pragma unroll
        for (int q = 0; q < 8; ++q) s += part[(q * 80 + row) * 33 + e];
        const float sg = 1.0f / (1.0f + __expf(-s));
        sl[row * 33 + e] = sg; sb[row * 33 + e] = sg + ebias[e];
    }
    __syncthreads();
    int sel[4]; int lpos[4];
    const int myrow = wv * 16 + lane;
    const bool mine = lane < 16 && wv < ng && myrow < nrows;
    if (mine) {
        const int t = r0 + myrow; const float* sr = sl + myrow * 33; const float* br = sb + myrow * 33;
        float ss[4]; float sum = 0.f;
#pragma unroll
        for (int k = 0; k < 4; ++k) {
            int best = 0; float bv = -1e30f;
            for (int e = 0; e < 32; ++e) {
                bool used = false;
#pragma unroll
                for (int q = 0; q < 4; ++q) if (q < k && sel[q] == e) used = true;
                const float vv = br[e];
                if (!used && vv > bv) { bv = vv; best = e; }
            }
            sel[k] = best; ss[k] = sr[best]; sum += ss[k];
        }
        const float inv = ROUTED_SCALE / sum;
#pragma unroll
        for (int k = 0; k < 4; ++k) { w.topw[(size_t)t * 4 + k] = ss[k] * inv; lpos[k] = atomicAdd(&lcnt[sel[k]], 1); }
    }
    __syncthreads();
    if (tid < 32) lcnt[32 + tid] = atomicAdd(&cnt[tid * CNT_PAD], lcnt[tid]);
    __syncthreads();
    if (mine) {
        const int t = r0 + myrow;
#pragma unroll
        for (int k = 0; k < 4; ++k) list[(size_t)sel[k] * T + lcnt[32 + sel[k]] + lpos[k]] = t * 4 + k;
    }
    __syncthreads();
}
__device__ __forceinline__ void phase_norm2_router(char* lds, const WS& w, const Inputs& in, int ntok, const float* mod, const float* gnorm, const float* ebias, int l) {
    int rpb = (ntok + (int)gridDim.x - 1) / (int)gridDim.x; if (rpb > 80) rpb = 80;
    for (int r0 = blockIdx.x * rpb; r0 < ntok; r0 += gridDim.x * rpb) {
        const int r1 = r0 + rpb < ntok ? r0 + rpb : ntok;
        row_pass<1, 1>(w, in, ntok, mod, mod, gnorm, 3, 4, nullptr, nullptr, nullptr, w.h, r0 + (int)(threadIdx.x >> 6), r1, 8);
        asm volatile("s_waitcnt vmcnt(0)" ::: "memory");
        __syncthreads();
        router_rows(lds, w, ebias, r0, r1, l);
    }
}

__device__ __forceinline__ bool moe_decode(int tile, int NT, const int* cnt, int ntok, int& e, int& mt, int& nt, int& base, int& rows) {
    int t = tile / NT; nt = tile % NT; int b = 0;
    for (int i = 0; i < 33; ++i) {
        const int c = i < 32 ? cnt[i * CNT_PAD] : ntok; const int m = (c + GBM - 1) / GBM;
        if (t < m) { e = i; mt = t; rows = c; base = b; return true; }
        t -= m; b += c;
    }
    return false;
}
struct ARowGather {
    const bf16* A; const int* list; int rows; int r0; bool ident;
    __device__ __forceinline__ const bf16* operator()(int i) const {
        const int idx = r0 + i; int tok = 0;
        if (idx < rows) tok = ident ? idx : (list[idx] >> 2);
        return A + (size_t)tok * D;
    }
};
struct EpiUp {
    bf16* hid; int base; int rows;
    __device__ __forceinline__ void operator()(f32x16 (&acc)[2][2], int mrow, int ncol) const {
        const int hc = (ncol >> 7) * 64 + ((ncol >> 6) & 1) * 32 + (ncol & 63);
#pragma unroll
        for (int mi = 0; mi < 2; ++mi) {
            const int idx = mrow + mi * 32;
            if (idx < rows) {
#pragma unroll
                for (int g = 0; g < 4; ++g) {
                    float o[4];
#pragma unroll
                    for (int q = 0; q < 4; ++q) { const float gt = acc[mi][0][4 * g + q], up = acc[mi][1][4 * g + q]; o[q] = gt / (1.0f + expf(-gt)) * up; }
                    u32x2 v; v.x = pack_bf16(o[0], o[1]); v.y = pack_bf16(o[2], o[3]);
                    *(u32x2*)(hid + (size_t)(base + idx) * 256 + hc + 8 * g) = v;
                }
            }
        }
    }
};
struct EpiDown {
    bf16* y; const int* list; int rows; bool shared; float* xr; const float* mod;
    __device__ __forceinline__ void operator()(f32x16 (&acc)[2][2], int mrow, int ncol) const {
#pragma unroll
        for (int mi = 0; mi < 2; ++mi) {
            const int idx = mrow + mi * 32;
            if (idx < rows) {
                if (!shared) {
                    const int asg = list[idx];
#pragma unroll
                    for (int ni = 0; ni < 2; ++ni)
#pragma unroll
                        for (int g = 0; g < 4; ++g) {
                            u32x2 v; v.x = pack_bf16(acc[mi][ni][4 * g], acc[mi][ni][4 * g + 1]); v.y = pack_bf16(acc[mi][ni][4 * g + 2], acc[mi][ni][4 * g + 3]);
                            *(u32x2*)(y + (size_t)asg * D + ncol + ni * 32 + 8 * g) = v;
                        }
                } else {
                    const int rb = idx < TL ? idx / S : 8; const float* g2 = mod + (size_t)rb * 6144 + 5 * D;
#pragma unroll
                    for (int ni = 0; ni < 2; ++ni)
#pragma unroll
                        for (int g = 0; g < 4; ++g) {
                            const int n = ncol + ni * 32 + 8 * g;
                            f32x4 gv = *(const f32x4*)(g2 + n); float* xp = xr + (size_t)idx * D + n; f32x4 xv = *(const f32x4*)xp;
                            xv[0] += gv[0] * acc[mi][ni][4 * g]; xv[1] += gv[1] * acc[mi][ni][4 * g + 1]; xv[2] += gv[2] * acc[mi][ni][4 * g + 2]; xv[3] += gv[3] * acc[mi][ni][4 * g + 3];
                            *(f32x4*)xp = xv;
                        }
                }
            }
        }
    }
};
struct EpiUpH {
    bf16* hid; int base; int rows;
    __device__ __forceinline__ void operator()(f32x16 (&acc)[2][4], int mrow, int ncol  ) const {
        const int fh = (ncol >> 2) & 1; const int hc = (ncol >> 8) * 128 + ((ncol >> 7) & 1) * 64 + 8 * fh;
#pragma unroll
        for (int mi = 0; mi < 2; ++mi) {
            const int idx = mrow + mi * 32;
            if (idx < rows) {
#pragma unroll
                for (int g = 0; g < 4; ++g) {
                    float o[8];
#pragma unroll
                    for (int nh = 0; nh < 2; ++nh)
#pragma unroll
                        for (int q = 0; q < 4; ++q) { const float gt = acc[mi][nh][4 * g + q], up = acc[mi][nh + 2][4 * g + q]; o[4 * nh + q] = gt / (1.0f + __expf(-gt)) * up; }
                    u32x4 v; v.x = pack_bf16(o[0], o[1]); v.y = pack_bf16(o[2], o[3]); v.z = pack_bf16(o[4], o[5]); v.w = pack_bf16(o[6], o[7]);
                    *(u32x4*)(hid + (size_t)(base + idx) * 256 + hc + 16 * g) = v;
                }
            }
        }
    }
};
__device__ __forceinline__ int down_perm(int rho) { const int ni = rho >> 5, g = (rho >> 3) & 3, fh = (rho >> 2) & 1, q = rho & 3; return 64 * (ni >> 1) + 16 * g + 8 * fh + 4 * (ni & 1) + q; }
struct EpiDownH {
    bf16* y; const int* list; int rows; bool shared; float* xr; const float* mod;
    __device__ __forceinline__ void operator()(f32x16 (&acc)[2][4], int mrow, int ncol  ) const {
        const int nbase = (ncol & ~127), fh = (ncol >> 2) & 1;
#pragma unroll
        for (int mi = 0; mi < 2; ++mi) {
            const int idx = mrow + mi * 32;
            if (idx < rows) {
                if (!shared) {
                    const int asg = list[idx];
#pragma unroll
                    for (int hp = 0; hp < 2; ++hp)
#pragma unroll
                        for (int g = 0; g < 4; ++g) {
                            u32x4 v; v.x = pack_bf16(acc[mi][2 * hp][4 * g], acc[mi][2 * hp][4 * g + 1]); v.y = pack_bf16(acc[mi][2 * hp][4 * g + 2], acc[mi][2 * hp][4 * g + 3]);
                            v.z = pack_bf16(acc[mi][2 * hp + 1][4 * g], acc[mi][2 * hp + 1][4 * g + 1]); v.w = pack_bf16(acc[mi][2 * hp + 1][4 * g + 2], acc[mi][2 * hp + 1][4 * g + 3]);
                            *(u32x4*)(y + (size_t)asg * D + nbase + 64 * hp + 16 * g + 8 * fh) = v;
                        }
                } else {
                    const int rb = idx < TL ? idx / S : 8; const float* g2 = mod + (size_t)rb * 6144 + 5 * D;
#pragma unroll
                    for (int hp = 0; hp < 2; ++hp)
#pragma unroll
                        for (int g = 0; g < 4; ++g)
#pragma unroll
                            for (int nl = 0; nl < 2; ++nl) {
                                const int n = nbase + 64 * hp + 16 * g + 8 * fh + 4 * nl;
                                f32x4 gv = *(const f32x4*)(g2 + n); float* xp = xr + (size_t)idx * D + n; f32x4 xv = *(const f32x4*)xp;
                                xv[0] += gv[0] * acc[mi][2 * hp + nl][4 * g]; xv[1] += gv[1] * acc[mi][2 * hp + nl][4 * g + 1]; xv[2] += gv[2] * acc[mi][2 * hp + nl][4 * g + 2]; xv[3] += gv[3] * acc[mi][2 * hp + nl][4 * g + 3];
                                *(f32x4*)xp = xv;
                            }
                }
            }
        }
    }
};
struct TLMoeUp {
    const WS* w; const int* cnt; int ntok; static constexpr int K = 1024;
    struct Tile { int e, mt, nt, base, rows; };
    __device__ __forceinline__ bool tile(int idx, Tile& t) const { return moe_decode(idx, 2, cnt, ntok, t.e, t.mt, t.nt, t.base, t.rows); }
    __device__ __forceinline__ unsigned active(const Tile&, int) const { return 15u; }
    __device__ __forceinline__ const bf16* arow(const Tile& t, int r) const {
        const int i = t.mt * GBM + r; int tok = 0;
        if (i < t.rows) tok = t.e == 32 ? i : (w->list[(size_t)t.e * T + i] >> 2);
        return w->h + (size_t)tok * D;
    }
    __device__ __forceinline__ const bf16* brow(const Tile& t, int r) const { return w->moeUpT + ((size_t)t.e * 512 + t.nt * 256 + (r & ~63) + perm64(r & 63)) * 1024; }
    __device__ __forceinline__ void epi(const Tile& t, f32x16 (&acc)[2][4], int mr, int nc) const { EpiUpH{w->hid2, t.base, t.rows}(acc, t.mt * GBM + mr, t.nt * 256 + nc); }
};
struct TLMoeDown {
    const WS* w; const int* cnt; int ntok; const float* mod; static constexpr int K = 256;
    struct Tile { int e, mt, nt, base, rows; };
    __device__ __forceinline__ bool tile(int idx, Tile& t) const { return moe_decode(idx, 4, cnt, ntok, t.e, t.mt, t.nt, t.base, t.rows); }
    __device__ __forceinline__ unsigned active(const Tile&, int) const { return 15u; }
    __device__ __forceinline__ const bf16* arow(const Tile& t, int r) const { return w->hid2 + (size_t)(t.base + t.mt * GBM + r) * 256; }
    __device__ __forceinline__ const bf16* brow(const Tile& t, int r) const { return w->moeDownT + ((size_t)t.e * 1024 + t.nt * 256 + (r & 128) + down_perm(r & 127)) * 256; }
    __device__ __forceinline__ void epi(const Tile& t, f32x16 (&acc)[2][4], int mr, int nc) const {
        EpiDownH{(bf16*)w->h, w->list + (size_t)t.e * T, t.rows, t.e == 32, w->xr, mod}(acc, t.mt * GBM + mr, t.nt * 256 + nc);
    }
};
struct TLMoeDownR : TLMoeDown {
    __device__ __forceinline__ bool tile(int idx, Tile& t) const { return moe_decode(idx, 4, cnt, ntok, t.e, t.mt, t.nt, t.base, t.rows) && t.e < 32; }
};
__device__ __forceinline__ void phase_moe_down_routed(char* lds, const WS& w, int l, int ntok, const float* mod) { TLMoeDownR tl; tl.w = &w; tl.cnt = w.cnt + l * 32 * CNT_PAD; tl.ntok = ntok; tl.mod = mod; gemm_stream256(lds, tl); }
__device__ __forceinline__ void phase_moe_up(char* lds, const WS& w, int l, int ntok) { gemm_stream256(lds, TLMoeUp{&w, w.cnt + l * 32 * CNT_PAD, ntok}); }
__device__ __forceinline__ void phase_moe_down(char* lds, const WS& w, int l, int ntok, const float* mod) { gemm_stream256(lds, TLMoeDown{&w, w.cnt + l * 32 * CNT_PAD, ntok, mod}); }
#endif
#ifndef HOST_SIM
__device__ __forceinline__ void phase_ada(char* lds, const WS& w, const Inputs& in) {
    int tid = threadIdx.x; asm volatile("" : "+v"(tid));
    const int lane = tid & 63, wv = tid >> 6;
    float* sc = (float*)lds;
    float* red = sc + 9 * 1024;
    if ((int)blockIdx.x >= 192) return;
    __syncthreads();
    for (int i = tid; i < 9 * 1024; i += NTHREADS) { const int r = i >> 10, k = i & 1023; const float v = r < 8 ? in.c[(size_t)(r % B) * D + k] : in.c_ctx[k]; sc[i] = v / (1.0f + __expf(-v)); }
    __syncthreads();
    for (int it = blockIdx.x; it < 192; it += gridDim.x) {
        const int l = it / 96, n = (it % 96) * 64 + lane;
        const float* wp = in.w_ada + (size_t)l * D * 6144 + (size_t)(wv * 128) * 6144 + n;
        float acc[9];
#pragma unroll
        for (int r = 0; r < 9; ++r) acc[r] = 0.f;
        for (int kb = 0; kb < 128; kb += 16) {
            float wq[16];
#pragma unroll
            for (int i = 0; i < 16; ++i) wq[i] = wp[(size_t)(kb + i) * 6144];
#pragma unroll
            for (int r = 0; r < 9; ++r) {
                const float* sr = sc + r * 1024 + wv * 128 + kb;
#pragma unroll
                for (int i4 = 0; i4 < 4; ++i4) { const f32x4 s4 = *(const f32x4*)(sr + 4 * i4); acc[r] += s4[0] * wq[4 * i4] + s4[1] * wq[4 * i4 + 1] + s4[2] * wq[4 * i4 + 2] + s4[3] * wq[4 * i4 + 3]; }
            }
        }
#pragma unroll
        for (int r = 0; r < 9; ++r) red[(wv * 9 + r) * 64 + lane] = acc[r];
        __syncthreads();
        for (int i = tid; i < 9 * 64; i += NTHREADS) {
            const int r = i >> 6, c = i & 63; float s = 0.f;
#pragma unroll
            for (int q = 0; q < 8; ++q) s += red[(q * 9 + r) * 64 + c];
            const int nn = (it % 96) * 64 + c;
            w.mod[((size_t)l * 9 + r) * 6144 + nn] = s + in.b_ada[l * 6144 + nn];
        }
        __syncthreads();
    }
}
#endif
#ifndef HOST_SIM
typedef short s16x4 __attribute__((ext_vector_type(4)));
constexpr int AT_KV = 64 * 128;
constexpr int AT_STAGE = 2 * AT_KV;
__device__ __forceinline__ int at_voff(int key, int dcol) { return key * 128 + ((((dcol >> 5) ^ ((key >> 1) & 1))) << 6) + ((dcol & 31) << 1); }
__device__ __forceinline__ int at_kappa(int r) { return (r & ~12) | ((r & 4) << 1) | ((r & 8) >> 1); }

struct AttnState { f32x16 o[2]; float m, l; };

__device__ __forceinline__ void at_qk(const char* st, const bf16x8 (&qf)[4], f32x16 (&s)[2], int lane) {
    const int fr = lane & 31, fh = lane >> 5, kr = at_kappa(fr);
#pragma unroll
    for (int tt = 0; tt < 2; ++tt) {
#pragma unroll
        for (int r = 0; r < 16; ++r) s[tt][r] = 0.f;
#pragma unroll
        for (int ks = 0; ks < 4; ++ks) {
            const bf16x8 kf = *(const bf16x8*)(st + g_lds_off(32 * tt + kr, ks * 2 + fh));
            s[tt] = __builtin_amdgcn_mfma_f32_32x32x16_bf16(kf, qf[ks], s[tt], 0, 0, 0);
        }
    }
}
__device__ __forceinline__ void at_softmax_pv(const char* st, f32x16 (&s)[2], AttnState& a, int lane) {
    float mx = -1e30f;
#pragma unroll
    for (int tt = 0; tt < 2; ++tt)
#pragma unroll
        for (int r = 0; r < 16; ++r) mx = fmaxf(mx, s[tt][r]);
    mx = fmaxf(mx, __shfl_xor(mx, 32));
    const float mn = fmaxf(a.m, mx), alpha = __builtin_amdgcn_exp2f(a.m - mn);
    float rs = 0.f;
#pragma unroll
    for (int tt = 0; tt < 2; ++tt)
#pragma unroll
        for (int r = 0; r < 16; ++r) { const float p = __builtin_amdgcn_exp2f(s[tt][r] - mn); s[tt][r] = p; rs += p; }
    rs += __shfl_xor(rs, 32);
    a.l = a.l * alpha + rs;
    if (__builtin_amdgcn_ballot_w64(mn > a.m) != 0ull) {
#pragma unroll
        for (int dt = 0; dt < 2; ++dt)
#pragma unroll
            for (int r = 0; r < 16; ++r) a.o[dt][r] *= alpha;
    }
    a.m = mn;
    const int fh = lane >> 5, i16 = lane & 15, g1 = (lane >> 4) & 1;
    const char* vb = st + AT_KV;
#pragma unroll
    for (int tt = 0; tt < 2; ++tt)
#pragma unroll
        for (int sp = 0; sp < 2; ++sp) {
            union { bf16x8 v; unsigned u[4]; } pu;
#pragma unroll
            for (int j = 0; j < 4; ++j) pu.u[j] = pack_bf16(s[tt][8 * sp + 2 * j], s[tt][8 * sp + 2 * j + 1]);
            const bf16x8 pf = pu.v;
#pragma unroll
            for (int dt = 0; dt < 2; ++dt) {
                const int kb = 32 * tt + 16 * sp + 8 * fh + (i16 >> 2), dc = 32 * dt + 16 * g1 + 4 * (i16 & 3);
                const s16x4 v0 = __builtin_amdgcn_ds_read_tr16_b64_v4i16((LAS s16x4*)(vb + at_voff(kb, dc)));
                const s16x4 v1 = __builtin_amdgcn_ds_read_tr16_b64_v4i16((LAS s16x4*)(vb + at_voff(kb + 4, dc)));
                bf16x8 vf; vf[0] = v0[0]; vf[1] = v0[1]; vf[2] = v0[2]; vf[3] = v0[3]; vf[4] = v1[0]; vf[5] = v1[1]; vf[6] = v1[2]; vf[7] = v1[3];
                a.o[dt] = __builtin_amdgcn_mfma_f32_32x32x16_bf16(vf, pf, a.o[dt], 0, 0, 0);
            }
        }
}
__device__ __forceinline__ void at_store(const AttnState& a, bf16* orow  , int lane) {
    const float il = 1.0f / a.l; const int fh = lane >> 5;
#pragma unroll
    for (int dt = 0; dt < 2; ++dt)
#pragma unroll
        for (int g = 0; g < 4; ++g) {
            u32x2 v; v.x = pack_bf16(a.o[dt][4 * g] * il, a.o[dt][4 * g + 1] * il); v.y = pack_bf16(a.o[dt][4 * g + 2] * il, a.o[dt][4 * g + 3] * il);
            *(u32x2*)(orow + 32 * dt + 8 * g + 4 * fh) = v;
        }
}
struct AtRegs { u32x4 k, v; };
__device__ __forceinline__ AtRegs at_load(const bf16* kbase, const bf16* vbase, int tid) {
    const int key = tid >> 3, c = tid & 7; AtRegs r;
    r.k = *(const u32x4*)(kbase + (size_t)key * DIN + c * 8); r.v = *(const u32x4*)(vbase + (size_t)key * DIN + c * 8); return r;
}
__device__ __forceinline__ void at_write(char* st, const AtRegs& r, int tid) {
    const int key = tid >> 3, c = tid & 7;
    *(u32x4*)(st + g_lds_off(key, c)) = r.k; *(u32x4*)(st + AT_KV + at_voff(key, c * 8)) = r.v;
}
__device__ __forceinline__ void at_dma(char* st, const bf16* kbase, int voff, int wid, int lane) {
    const int r = 8 * wid + (lane >> 3), pos = lane & 7;
    const bf16* kr = kbase + (size_t)r * DIN;
    const int ck = pos ^ ((r >> 1) & 7), cv = 4 * ((pos >> 2) ^ ((r >> 1) & 1)) + (pos & 3);
    __builtin_amdgcn_global_load_lds((const unsigned*)(kr + 8 * ck), (LAS unsigned*)(st + wid * 1024), 16, 0, 0);
    __builtin_amdgcn_global_load_lds((const unsigned*)(kr + voff + 8 * cv), (LAS unsigned*)(st + AT_KV + wid * 1024), 16, 0, 0);
}
#define AT_WAIT(n) asm volatile("s_waitcnt vmcnt(" #n ")" ::: "memory")
__device__ __forceinline__ void at_wait_tile(int remaining_after  ) {
    if (remaining_after >= 2) AT_WAIT(4); else if (remaining_after == 1) AT_WAIT(2); else AT_WAIT(0);
    __builtin_amdgcn_s_barrier();
    asm volatile("" ::: "memory");
}
constexpr int AT_RING = 4;
__device__ __forceinline__ void at_loadq(bf16x8 (&qf)[4], const bf16* qrow, int lane) {
    const int fh = lane >> 5;
#pragma unroll
    for (int ks = 0; ks < 4; ++ks) qf[ks] = *(const bf16x8*)(qrow + ks * 16 + fh * 8);
}
__device__ __forceinline__ int at_key(int tt, int r, int fh) { return 32 * tt + (r & 3) + 8 * fh + 4 * ((r >> 2) & 1) + 16 * (r >> 3); }

__device__ __forceinline__ void attn_wa_item(char* lds, const bf16* p, bf16* ycat, const float* sink, int b, int hk, int qb, bool ctxq) {
    int tid = threadIdx.x; asm volatile("" : "+v"(tid));
    const int lane = tid & 63, wv = tid >> 6, fr = lane & 31, fh = lane >> 5;
    const int hq = 2 * hk + (wv >> 2);
    const int qpos = qb * 128 + (wv & 3) * 32 + fr;
    const size_t qtok = ctxq ? (size_t)TL + (size_t)b * LC + qpos : (size_t)b * S + qpos;
    bf16x8 qf[4]; at_loadq(qf, p + qtok * DIN + O1 + hq * 64, lane);
    AttnState a;
#pragma unroll
    for (int dt = 0; dt < 2; ++dt)
#pragma unroll
        for (int r = 0; r < 16; ++r) a.o[dt][r] = 0.f;
    a.m = sink[hq] * 1.4426950408889634f; a.l = 1.0f;
    int lo = qb * 128 - 128, hi = qb * 128 + 256; if (lo < 0) lo = 0; if (hi > S) hi = S;
    const int nloc = ctxq ? 0 : (hi - lo) / 64, nt = 4 + nloc;
    const bf16* kc = p + ((size_t)TL + (size_t)b * LC) * DIN + O1 + 256 + hk * 64;
    const bf16* kl = p + ((size_t)b * S + lo) * DIN + O1 + 256 + hk * 64;
    const int wid = __builtin_amdgcn_readfirstlane(wv);
    asm volatile("s_waitcnt vmcnt(0)" ::: "memory");
    __syncthreads();
#define AT_TILE_K(i_) ((i_) < 4 ? kc + (size_t)(i_) * 64 * DIN : kl + (size_t)((i_) - 4) * 64 * DIN)
    for (int i = 0; i < 3 && i < nt; ++i) at_dma(lds + i * AT_STAGE, AT_TILE_K(i), 128, wid, lane);
    for (int i = 0; i < nt; ++i) {
        const char* st = lds + (i & 3) * AT_STAGE;
        at_wait_tile(nt - 1 - i);
        if (i + 3 < nt) at_dma(lds + ((i + 3) & 3) * AT_STAGE, AT_TILE_K(i + 3), 128, wid, lane);
        if (i >= 4) { const int kb0w = lo + (i - 4) * 64, q0w = qb * 128 + (wv & 3) * 32; if (kb0w + 63 < q0w - WINDOW || kb0w > q0w + 31 + WINDOW) continue; }
        f32x16 s[2]; at_qk(st, qf, s, lane);
        if (i < 4) {
#pragma unroll
            for (int tt = 0; tt < 2; ++tt)
#pragma unroll
                for (int r = 0; r < 16; ++r) s[tt][r] *= 0.125f * 1.4426950408889634f;
        } else {
            const int kb0 = lo + (i - 4) * 64, q0w = qb * 128 + (wv & 3) * 32;
            if (kb0 >= q0w + 31 - WINDOW && kb0 + 63 <= q0w + WINDOW) {
#pragma unroll
                for (int tt = 0; tt < 2; ++tt)
#pragma unroll
                    for (int r = 0; r < 16; ++r) s[tt][r] *= 0.125f * 1.4426950408889634f;
            } else {
#pragma unroll
                for (int tt = 0; tt < 2; ++tt)
#pragma unroll
                    for (int r = 0; r < 16; ++r) { const int d = kb0 + at_key(tt, r, fh) - qpos; s[tt][r] = (d >= -WINDOW && d <= WINDOW) ? s[tt][r] * (0.125f * 1.4426950408889634f) : -1e30f; }
            }
        }
        at_softmax_pv(st, s, a, lane);
    }
    at_store(a, ycat + qtok * 1024 + 256 + hq * 64, lane);
}
__device__ __forceinline__ void attn_na_item(char* lds, const bf16* p, bf16* ycat, const float* rpb  , int b, int h, int rg4, bool ctxq) {
    int tid = threadIdx.x; asm volatile("" : "+v"(tid));
    const int lane = tid & 63, wv = tid >> 6, fr = lane & 31, fh = lane >> 5;
    const int r = rg4 * 4 + (wv >> 1), cq = (wv & 1) * 32 + fr;
    const size_t qtok = ctxq ? (size_t)TL + (size_t)b * LC + wv * 32 + fr : (size_t)b * S + r * 64 + cq;
    bf16x8 qf[4]; at_loadq(qf, p + qtok * DIN + O2 + h * 64, lane);
    AttnState a;
#pragma unroll
    for (int dt = 0; dt < 2; ++dt)
#pragma unroll
        for (int rr = 0; rr < 16; ++rr) a.o[dt][rr] = 0.f;
    a.m = -1e30f; a.l = 0.f;
    constexpr int ROWS = S / GRID_W;
    int klo = rg4 * 4 - 4; if (klo < 0) klo = 0; int khi = rg4 * 4 + 3 - 4; if (khi < 0) khi = 0; if (khi > ROWS - NA_KR) khi = ROWS - NA_KR; khi += NA_KR;
    if (klo > ROWS - NA_KR) klo = ROWS - NA_KR;
    const int nloc = ctxq ? 0 : khi - klo, nt = 4 + nloc;
    int myr0 = r - 4; myr0 = myr0 < 0 ? 0 : (myr0 > ROWS - NA_KR ? ROWS - NA_KR : myr0);
    int c0 = cq - 8; c0 = c0 < 0 ? 0 : (c0 > GRID_W - NA_KC ? GRID_W - NA_KC : c0);
    const bf16* kc = p + ((size_t)TL + (size_t)b * LC) * DIN + O2 + 256 + h * 64;
    const bf16* kl = p + ((size_t)b * S + (size_t)klo * 64) * DIN + O2 + 256 + h * 64;
    float* bl = (float*)(lds + AT_RING * AT_STAGE);
    __syncthreads();
    const int wid = __builtin_amdgcn_readfirstlane(wv);
    if (tid < 15 * 31) bl[(tid / 31) * 32 + (tid % 31)] = rpb[h * 15 * 31 + tid];
    asm volatile("s_waitcnt vmcnt(0) lgkmcnt(0)" ::: "memory");
    for (int i = 0; i < 3 && i < nt; ++i) at_dma(lds + i * AT_STAGE, AT_TILE_K(i), 256, wid, lane);
    for (int i = 0; i < nt; ++i) {
        const char* st = lds + (i & 3) * AT_STAGE;
        at_wait_tile(nt - 1 - i);
        if (i + 3 < nt) at_dma(lds + ((i + 3) & 3) * AT_STAGE, AT_TILE_K(i + 3), 256, wid, lane);
        const int krow = klo + (i - 4);
        const bool act = i < 4 || (krow >= myr0 && krow < myr0 + NA_KR);
        if (act) {
            f32x16 s[2]; at_qk(st, qf, s, lane);
            if (i < 4) {
#pragma unroll
                for (int tt = 0; tt < 2; ++tt)
#pragma unroll
                    for (int rr = 0; rr < 16; ++rr) s[tt][rr] *= 0.125f * 1.4426950408889634f;
            } else {
                const float* brow = bl + (krow - r + 7) * 32 + 15 - cq;
#pragma unroll
                for (int tt = 0; tt < 2; ++tt)
#pragma unroll
                    for (int rr = 0; rr < 16; ++rr) { const int kcol = at_key(tt, rr, fh); const bool ok = kcol >= c0 && kcol < c0 + NA_KC;
                        const float bias = ok ? brow[kcol] : 0.f; s[tt][rr] = ok ? (s[tt][rr] * 0.125f + bias) * 1.4426950408889634f : -1e30f; }
            }
            at_softmax_pv(st, s, a, lane);
        }
    }
    at_store(a, ycat + qtok * 1024 + 512 + h * 64, lane);
}
__device__ __forceinline__ void attn_item(char* lds, const WS& w, const Inputs& in, int l, int it) {
    if (it < 256) attn_wa_item(lds, w.p, w.ycat, in.wa_sink + l * 4, it >> 5, (it >> 4) & 1, it & 15, false);
    else if (it < 512) { const int j = it - 256; attn_na_item(lds, w.p, w.ycat, in.na_rpb + l * 4 * 15 * 31, j >> 5, (j >> 3) & 3, j & 7, false); }
    else if (it < 544) { const int j = it - 512; attn_wa_item(lds, w.p, w.ycat, in.wa_sink + l * 4, j >> 2, (j >> 1) & 1, j & 1, true); }
    else { const int j = it - 544; attn_na_item(lds, w.p, w.ycat, in.na_rpb + l * 4 * 15 * 31, j >> 2, j & 3, 0, true); }
}
#endif
#ifndef HOST_SIM
__device__ __forceinline__ float hy_c3(const bf16* pr, int tin, int col, const float* cw) {
    float acc = cw[768 + col] * bf2f(pr[col]);
    if (tin > 0) acc += cw[col] * bf2f(pr[col - DIN]);
    if (tin < S - 1) acc += cw[2 * 768 + col] * bf2f(pr[col + DIN]);
    return acc;
}
__device__ __forceinline__ void hy_prep_item(char* lds, const bf16* p, const float* cw, bf16* x0T, bf16* uvT, int b, int ch, bool ctx = false) {
    int tid = threadIdx.x; asm volatile("" : "+v"(tid));
    bf16* lx = (bf16*)lds;
    bf16* lu = lx + 256 * 72;
    __syncthreads();
    const int tl = tid & 63, cg = tid >> 6;
    const int L = ctx ? LC : S; const int tin = ch * 64 + tl; const bf16* pr = p + ((ctx ? (size_t)TL + (size_t)b * LC : (size_t)b * S) + tin) * DIN;
    for (int it = 0; it < 4; ++it) {
        const int c0 = (it * 8 + cg) * 8;
        float x0[8], x1[8], vv[8];
#pragma unroll
        for (int q = 0; q < 8; ++q) { x0[q] = 0.f; x1[q] = 0.f; vv[q] = 0.f; }
#pragma unroll
        for (int dr = -1; dr <= 1; ++dr) {
            if (tin + dr < 0 || tin + dr >= L) continue;
            const bf16* r = pr + (ptrdiff_t)dr * DIN;
            const u32x4 a = *(const u32x4*)(r + c0), bq = *(const u32x4*)(r + 256 + c0), cq = *(const u32x4*)(r + 512 + c0);
            const float* w0 = cw + (dr + 1) * 768;
#pragma unroll
            for (int q = 0; q < 4; ++q) {
                x0[2 * q] += w0[c0 + 2 * q] * __uint_as_float(a[q] << 16); x0[2 * q + 1] += w0[c0 + 2 * q + 1] * __uint_as_float(a[q] & 0xffff0000u);
                x1[2 * q] += w0[256 + c0 + 2 * q] * __uint_as_float(bq[q] << 16); x1[2 * q + 1] += w0[256 + c0 + 2 * q + 1] * __uint_as_float(bq[q] & 0xffff0000u);
                vv[2 * q] += w0[512 + c0 + 2 * q] * __uint_as_float(cq[q] << 16); vv[2 * q + 1] += w0[512 + c0 + 2 * q + 1] * __uint_as_float(cq[q] & 0xffff0000u);
            }
        }
#pragma unroll
        for (int q = 0; q < 8; ++q) { lx[(c0 + q) * 72 + tl] = f2bf(x0[q]); lu[(c0 + q) * 72 + tl] = f2bf(x1[q] * vv[q]); }
    }
    __syncthreads();
    for (int i = tid; i < 2048; i += NTHREADS) {
        const int c = i >> 3, k = i & 7;
        const size_t g = ((size_t)c * B + b) * L + ch * 64 + k * 8;
        *(u32x4*)(x0T + g) = *(const u32x4*)(lx + c * 72 + k * 8);
        *(u32x4*)(uvT + g) = *(const u32x4*)(lu + c * 72 + k * 8);
    }
}
constexpr int HY_NOFF = 2072, HY_NE = 4128, HY_CS = HY_NE * 2 + 32;
constexpr int HY_URS = S * 2 + 16;
constexpr int HY_LDS_U = 8 * HY_CS, HY_LDS_Z = HY_LDS_U + 8 * HY_URS, HY_LDS_REV = HY_LDS_Z + 64, HY_LDS_END0 = HY_LDS_REV + (HY_NE + 8) * 2;
constexpr int HC_NOFF = 280, HC_NE = 544, HC_CS = HC_NE * 2 + 32, HC_URS = LC * 2 + 16;
constexpr int HC_LDS_C = (HY_LDS_END0 + 15) & ~15, HC_LDS_U = HC_LDS_C + 8 * HC_CS, HC_LDS_REV = HC_LDS_U + 8 * HC_URS, HY_LDS_END = HC_LDS_REV + (HC_NE + 8) * 2;
__device__ __forceinline__ void hy_conv_item(char* lds, const float* filtT, const float* hbias, const bf16* uvT, bf16* x0T  , int c, const bf16* uvTc = nullptr, bf16* x0Tc = nullptr) {
    static_assert(B == 8, "hyena conv assumes batch 8");
    int tid = threadIdx.x; asm volatile("" : "+v"(tid));
    const int lane = tid & 63, wv = tid >> 6, fr = lane & 31, fh = lane >> 5;
    bf16* rev = (bf16*)(lds + HY_LDS_REV);
    __syncthreads();
    const float* hf = filtT + (size_t)c * (S + LC); const float* hb = filtT + (size_t)(256 + c) * (S + LC);
    for (int e = tid; e < HY_NE + 8; e += NTHREADS) {
        const int n = e - HY_NOFF; float v = 0.f;
        if (n > 0 && n < S) v = hb[n]; else if (n <= 0 && n > -S) v = hf[-n];
        rev[e] = f2bf(v);
    }
    for (int i = tid; i < 8 * 256; i += NTHREADS) { const int bb = i >> 8, k = i & 255; *(u32x4*)(lds + HY_LDS_U + bb * HY_URS + k * 16) = *(const u32x4*)(uvT + ((size_t)c * B + bb) * S + k * 8); }
    if (tid < 4) ((unsigned*)(lds + HY_LDS_Z))[tid] = 0u;
    bf16* revc = (bf16*)(lds + HC_LDS_REV);
    if (uvTc) {
        for (int e = tid; e < HC_NE + 8; e += NTHREADS) { const int n = e - HC_NOFF; float v = 0.f; if (n > 0 && n < LC) v = hb[S + n]; else if (n <= 0 && n > -LC) v = hf[S - n]; revc[e] = f2bf(v); }
        for (int i = tid; i < 8 * 32; i += NTHREADS) { const int bb = i >> 5, k = i & 31; *(u32x4*)(lds + HC_LDS_U + bb * HC_URS + k * 16) = *(const u32x4*)(uvTc + ((size_t)c * B + bb) * LC + k * 8); }
    }
    __syncthreads();
    if (uvTc) for (int i = tid; i < 8 * (HC_NE / 2); i += NTHREADS) { const int m = i / (HC_NE / 2), d = i % (HC_NE / 2); const unsigned lo = revc[2 * d + m], hi = revc[2 * d + 1 + m]; *(unsigned*)(lds + HC_LDS_C + m * HC_CS + d * 4) = lo | (hi << 16); }
    {
        const unsigned* rdw = (const unsigned*)rev;
#pragma unroll
        for (int m = 0; m < 8; ++m)
            for (int d = tid; d < HY_NE / 2; d += NTHREADS) {
                unsigned v;
                if ((m & 1) == 0) v = rdw[d + (m >> 1)];
                else { const unsigned a = rdw[d + (m >> 1)], b = rdw[d + (m >> 1) + 1]; v = (a >> 16) | (b << 16); }
                *(unsigned*)(lds + m * HY_CS + d * 4) = v;
            }
    }
    __syncthreads();
    f32x16 acc[2];
#pragma unroll
    for (int q = 0; q < 2; ++q)
#pragma unroll
        for (int r = 0; r < 16; ++r) acc[q][r] = 0.f;
    const int bb = fr >> 2, pp = fr & 3;
    const int m = (-fr) & 7;
    const char* abase = lds + m * HY_CS;
    const char* ubase = lds + HY_LDS_U + bb * HY_URS + fh * 16;
    auto hstep = [&](int dl, bool a0, bool a1) {
        const int n0 = 8 * fh - fr - 16 * dl;
        const bf16x8 af = *(const bf16x8*)(abase + (n0 - m + HY_NOFF) * 2);
        if (a0) { const int sj = 16 * wv - dl + 2 * pp; const char* up = (sj >= 0 && sj < 128) ? ubase + sj * 32 : lds + HY_LDS_Z;
            acc[0] = __builtin_amdgcn_mfma_f32_32x32x16_bf16(af, *(const bf16x8*)up, acc[0], 0, 0, 0); }
        if (a1) { const int sj = 16 * wv + 8 - dl + 2 * pp; const char* up = (sj >= 0 && sj < 128) ? ubase + sj * 32 : lds + HY_LDS_Z;
            acc[1] = __builtin_amdgcn_mfma_f32_32x32x16_bf16(af, *(const bf16x8*)up, acc[1], 0, 0, 0); }
    };
#pragma unroll
    for (int dl = 16 * wv - 127; dl < 16 * wv - 119; ++dl) hstep(dl, true, false);
#pragma unroll 6
    for (int dl = 16 * wv - 119; dl <= 16 * wv + 6; ++dl) hstep(dl, true, true);
#pragma unroll
    for (int dl = 16 * wv + 7; dl <= 16 * wv + 14; ++dl) hstep(dl, false, true);
    const float hbc = hbias[c];
#pragma unroll
    for (int qq = 0; qq < 2; ++qq) {
        const int tb = 32 * (4 * (2 * wv + qq) + pp) + 4 * fh;
#pragma unroll
        for (int g = 0; g < 4; ++g) {
            const int t = tb + 8 * g;
            const u32x2 uu = *(const u32x2*)(lds + HY_LDS_U + bb * HY_URS + t * 2);
            bf16* xp = x0T + ((size_t)c * B + bb) * S + t; const u32x2 xx = *(const u32x2*)xp;
            const float u0 = __uint_as_float(uu.x << 16), u1 = __uint_as_float(uu.x & 0xffff0000u), u2 = __uint_as_float(uu.y << 16), u3 = __uint_as_float(uu.y & 0xffff0000u);
            const float a0 = __uint_as_float(xx.x << 16), a1 = __uint_as_float(xx.x & 0xffff0000u), a2 = __uint_as_float(xx.y << 16), a3 = __uint_as_float(xx.y & 0xffff0000u);
            u32x2 o; o.x = pack_bf16(a0 * (acc[qq][4 * g] + hbc * u0), a1 * (acc[qq][4 * g + 1] + hbc * u1)); o.y = pack_bf16(a2 * (acc[qq][4 * g + 2] + hbc * u2), a3 * (acc[qq][4 * g + 3] + hbc * u3));
            *(u32x2*)xp = o;
        }
    }
    if (uvTc && wv < 2) {
        f32x16 ac;
#pragma unroll
        for (int r = 0; r < 16; ++r) ac[r] = 0.f;
        const char* cab = lds + HC_LDS_C + m * HC_CS; const char* cub = lds + HC_LDS_U + bb * HC_URS + fh * 16;
        for (int dl = 8 * wv - 15; dl <= 8 * wv + 6; ++dl) {
            const int n0 = 8 * fh - fr - 16 * dl;
            const bf16x8 af = *(const bf16x8*)(cab + (n0 - m + HC_NOFF) * 2);
            const int sj = 8 * wv - dl + 2 * pp; const char* up = (sj >= 0 && sj < 16) ? cub + sj * 32 : lds + HY_LDS_Z;
            ac = __builtin_amdgcn_mfma_f32_32x32x16_bf16(af, *(const bf16x8*)up, ac, 0, 0, 0);
        }
        const int tb = 32 * (4 * wv + pp) + 4 * fh;
#pragma unroll
        for (int g = 0; g < 4; ++g) {
            const int t = tb + 8 * g;
            const u32x2 uu = *(const u32x2*)(lds + HC_LDS_U + bb * HC_URS + t * 2);
            bf16* xp = x0Tc + ((size_t)c * B + bb) * LC + t; const u32x2 xx = *(const u32x2*)xp;
            const float u0 = __uint_as_float(uu.x << 16), u1 = __uint_as_float(uu.x & 0xffff0000u), u2 = __uint_as_float(uu.y << 16), u3 = __uint_as_float(uu.y & 0xffff0000u);
            const float a0 = __uint_as_float(xx.x << 16), a1 = __uint_as_float(xx.x & 0xffff0000u), a2 = __uint_as_float(xx.y << 16), a3 = __uint_as_float(xx.y & 0xffff0000u);
            u32x2 o; o.x = pack_bf16(a0 * (ac[4 * g] + hbc * u0), a1 * (ac[4 * g + 1] + hbc * u1)); o.y = pack_bf16(a2 * (ac[4 * g + 2] + hbc * u2), a3 * (ac[4 * g + 3] + hbc * u3));
            *(u32x2*)xp = o;
        }
    }
}
__device__ __forceinline__ void hy_filter_mlp(char* lds, const float* w1, const float* b1, const float* w2, const float* b2, const float* freq, bf16* f2b) {
    int tid = threadIdx.x; asm volatile("" : "+v"(tid));
    const int lane = tid & 63, wv = tid >> 6;
    float* zl = (float*)lds + wv * 128;
    __syncthreads();
    const float fj = freq[lane], b1j = b1[lane], b2j = b2[lane];
    for (int tt = blockIdx.x * 8 + wv; tt < S + LC; tt += gridDim.x * 8) {
        const int L = tt < S ? S : LC, t = tt < S ? tt : tt - S;
        if (lane < 33) {
            float z;
            if (lane == 0) z = (float)t / (float)(L - 1);
            else { const int bnd = (lane - 1) & 15; const float band = 1e-4f + (float)bnd * ((15.0f - 1e-4f) / 15.0f); const float ang = (6.283185307179586f / (float)L) * (float)t * band; z = lane <= 16 ? cosf(ang) : -sinf(ang); }
            zl[lane] = z;
        }
        __builtin_amdgcn_wave_barrier(); asm volatile("s_waitcnt lgkmcnt(0)" ::: "memory");
        float acc = 0.f;
#pragma unroll
        for (int i = 0; i < 33; ++i) acc += zl[i] * w1[i * 64 + lane];
        zl[64 + lane] = sinf(fj * (acc + b1j));
        __builtin_amdgcn_wave_barrier(); asm volatile("s_waitcnt lgkmcnt(0)" ::: "memory");
        float a2 = 0.f;
#pragma unroll 16
        for (int k = 0; k < 64; ++k) a2 += zl[64 + k] * w2[k * 64 + lane];
        f2b[(size_t)tt * 64 + lane] = f2bf(sinf(fj * (a2 + b2j)));
        __builtin_amdgcn_wave_barrier(); asm volatile("s_waitcnt lgkmcnt(0)" ::: "memory");
    }
}
__device__ __forceinline__ void hy_filter_out(const bf16* w3T  , const bf16* f2b  , float* filt  ) {
    int tid = threadIdx.x; asm volatile("" : "+v"(tid));
    const int lane = tid & 63, wv = tid >> 6, fr = lane & 31, fh = lane >> 5;
    constexpr int NTT = (S + LC) / 32;
    for (int it = blockIdx.x * 8 + wv; it < 16 * NTT; it += gridDim.x * 8) {
        const int ct = it / NTT, tt0 = (it % NTT) * 32;
        f32x16 acc;
#pragma unroll
        for (int r = 0; r < 16; ++r) acc[r] = 0.f;
#pragma unroll
        for (int ks = 0; ks < 4; ++ks) {
            const bf16x8 fa = *(const bf16x8*)(w3T + (size_t)(ct * 32 + fr) * 64 + ks * 16 + fh * 8), fb = *(const bf16x8*)(f2b + (size_t)(tt0 + fr) * 64 + ks * 16 + fh * 8);
            acc = __builtin_amdgcn_mfma_f32_32x32x16_bf16(fa, fb, acc, 0, 0, 0);
        }
        const int tt = tt0 + fr; const int L = tt < S ? S : LC; const float tn = (float)(tt < S ? tt : tt - S) / (float)(L - 1);
#pragma unroll
        for (int r = 0; r < 16; ++r) {
            const int c = ct * 32 + (r & 3) + 8 * (r >> 2) + 4 * fh; const int cc = c & 255;
            const float decay = HY_DECAY_MIN + (float)cc * ((HY_DECAY_MAX - HY_DECAY_MIN) / 255.0f);
            filt[(size_t)c * (S + LC) + tt] = acc[r] * __expf(-tn * decay);
        }
    }
}
__device__ __forceinline__ void hy_fin_item(char* lds, const bf16* yT, bf16* ycat, int b, int ch, bool ctx = false) {
    int tid = threadIdx.x; asm volatile("" : "+v"(tid));
    bf16* ly = (bf16*)lds;
    __syncthreads();
    for (int i = tid; i < 2048; i += NTHREADS) {
        const int c = i >> 3, k = i & 7;
        const u32x4 v = *(const u32x4*)(yT + ((size_t)c * B + b) * (ctx ? LC : S) + ch * 64 + k * 8);
#pragma unroll
        for (int q = 0; q < 4; ++q) { ly[(k * 8 + 2 * q) * 264 + c] = (bf16)(v[q] & 0xffffu); ly[(k * 8 + 2 * q + 1) * 264 + c] = (bf16)(v[q] >> 16); }
    }
    __syncthreads();
    for (int i = tid; i < 2048; i += NTHREADS) {
        const int t = i >> 5, k = i & 31;
        *(u32x4*)(ycat + ((ctx ? (size_t)TL + (size_t)b * LC : (size_t)b * S) + ch * 64 + t) * 1024 + k * 8) = *(const u32x4*)(ly + t * 264 + k * 8);
    }
}
#endif
#ifndef HOST_SIM
constexpr int GD_NC = 36;
__device__ __forceinline__ size_t gd_tok0(int b, int cc) { return cc < 4 ? (size_t)TL + (size_t)b * LC + cc * 64 : (size_t)b * S + (size_t)(cc - 4) * 64; }

constexpr int GP_K = 0, GP_V = 8192, GP_L0 = 16384, GP_T0 = GP_L0 + 2 * 16384, GP_VB0 = GP_T0 + 2 * 8192  , GP_G = GP_VB0 + 2 * 8192  ,
              GP_SM = GP_VB0 + 4 * 8192  , GP_LB = GP_SM + 6 * 256  , GP_END = GP_LB + 2 * 2048;

__device__ __forceinline__ void gdn_pre_item(char* lds, const WS& w, const float* cw  , const float* a_log, const float* dt_bias, int b, int cc, int h) {
    int tid = threadIdx.x; asm volatile("" : "+v"(tid));
    const int lane = tid & 63, wv = tid >> 6, fr = lane & 31, fh = lane >> 5;
    const bf16* p = w.p;
    const int L = cc < 4 ? LC : S; const int tin0 = cc < 4 ? cc * 64 : (cc - 4) * 64; const size_t tok0 = gd_tok0(b, cc);
    float* sm = (float*)(lds + GP_SM);
    __syncthreads();
    {
        const int tl = tid >> 3, dg = tid & 7;
        float q8[8], k8[8], v8[8];
#pragma unroll
        for (int x = 0; x < 8; ++x) { q8[x] = 0.f; k8[x] = 0.f; v8[x] = 0.f; }
#pragma unroll
        for (int i = 0; i < 4; ++i) {
            const int tt = tin0 + tl + i - 2;
            if (tt < 0 || tt >= L) continue;
            const bf16* r = p + (tok0 + tl + i - 2) * DIN + O3 + h * 64 + dg * 8;
            const u32x4 a = *(const u32x4*)r, bq = *(const u32x4*)(r + 256), cq = *(const u32x4*)(r + 512);
            const float* wq = cw + i * 768 + h * 64 + dg * 8;
#pragma unroll
            for (int x = 0; x < 4; ++x) {
                q8[2 * x] += wq[2 * x] * __uint_as_float(a[x] << 16); q8[2 * x + 1] += wq[2 * x + 1] * __uint_as_float(a[x] & 0xffff0000u);
                k8[2 * x] += wq[256 + 2 * x] * __uint_as_float(bq[x] << 16); k8[2 * x + 1] += wq[256 + 2 * x + 1] * __uint_as_float(bq[x] & 0xffff0000u);
                v8[2 * x] += wq[512 + 2 * x] * __uint_as_float(cq[x] << 16); v8[2 * x + 1] += wq[512 + 2 * x + 1] * __uint_as_float(cq[x] & 0xffff0000u);
            }
        }
        float sq = 0.f, sk = 0.f;
#pragma unroll
        for (int x = 0; x < 8; ++x) { q8[x] = q8[x] / (1.0f + __expf(-q8[x])); k8[x] = k8[x] / (1.0f + __expf(-k8[x])); v8[x] = v8[x] / (1.0f + __expf(-v8[x])); sq += q8[x] * q8[x]; sk += k8[x] * k8[x]; }
        sq += __shfl_xor(sq, 1); sq += __shfl_xor(sq, 2); sq += __shfl_xor(sq, 4);
        sk += __shfl_xor(sk, 1); sk += __shfl_xor(sk, 2); sk += __shfl_xor(sk, 4);
        const float rq = 0.125f / sqrtf(sq + EPS), rk = 1.0f / sqrtf(sk + EPS);
        u32x4 qo, ko, vo;
#pragma unroll
        for (int x = 0; x < 4; ++x) { qo[x] = pack_bf16(q8[2 * x] * rq, q8[2 * x + 1] * rq); ko[x] = pack_bf16(k8[2 * x] * rk, k8[2 * x + 1] * rk); vo[x] = pack_bf16(v8[2 * x], v8[2 * x + 1]); }
        bf16* qkg = w.qk + ((size_t)((b * 4 + h) * GD_NC + cc) * 2) * 4096;
        *(u32x4*)(qkg + tl * 64 + dg * 8) = qo; *(u32x4*)(qkg + 4096 + tl * 64 + dg * 8) = ko;
        *(u32x4*)(lds + GP_K + g_lds_off(tl, dg)) = ko;
        *(u32x4*)(lds + GP_V + at_voff(tl, dg * 8)) = vo;
        if (tid < 128) {
            const int dir = tid >> 6, t = tid & 63; const bf16* r = p + (tok0 + t) * DIN + O3 + 1024 + dir * 4 + h;
            const float a = bf2f(r[0]), bbv = bf2f(r[8]); const float x = a + dt_bias[dir * 4 + h]; const float sp = x > 15.f ? x : __logf(1.0f + __expf(x));
            sm[dir * 64 + t] = -__expf(a_log[dir * 4 + h]) * sp; sm[128 + dir * 64 + t] = 1.0f / (1.0f + __expf(-bbv));
        }
    }
    __syncthreads();
    if (wv < 4) {
        const int ta = wv >> 1, tb = wv & 1; f32x16 g;
#pragma unroll
        for (int r = 0; r < 16; ++r) g[r] = 0.f;
#pragma unroll
        for (int ks = 0; ks < 4; ++ks) {
            const bf16x8 fa = *(const bf16x8*)(lds + GP_K + g_lds_off(32 * ta + fr, ks * 2 + fh)), fb = *(const bf16x8*)(lds + GP_K + g_lds_off(32 * tb + fr, ks * 2 + fh));
            g = __builtin_amdgcn_mfma_f32_32x32x16_bf16(fa, fb, g, 0, 0, 0);
        }
        float* G = (float*)(lds + GP_G);
#pragma unroll
        for (int r = 0; r < 16; ++r) G[(32 * ta + (r & 3) + 8 * (r >> 2) + 4 * fh) * 64 + 32 * tb + fr] = g[r];
    } else if (wv < 6) {
        const int dir = wv - 4; float v = sm[dir * 64 + (dir ? 63 - lane : lane)];
#pragma unroll
        for (int o = 1; o < 64; o <<= 1) { const float t = __shfl_up(v, o); if (lane >= o) v += t; }
        sm[256 + dir * 64 + lane] = v;
        float* gcg = w.gc + ((size_t)((b * 4 + h) * 2 + dir) * GD_NC + cc) * 64; gcg[lane] = v;
    }
    __syncthreads();
    const int dir = wv >> 2, t4 = tid & 255;
    {
        const float* G = (const float*)(lds + GP_G); float* Lm = (float*)(lds + GP_L0 + dir * 16384);
        for (int e = t4; e < 4096; e += 256) {
            const int i = e >> 6, j = e & 63; const int ti = dir ? 63 - i : i, tj = dir ? 63 - j : j;
            const float lv = j < i ? sm[128 + dir * 64 + ti] * G[ti * 64 + tj] * __expf(sm[256 + dir * 64 + i] - sm[256 + dir * 64 + j]) : 0.f;
            Lm[e] = lv;
            if (i >= 32 && j < 32) ((bf16*)(lds + GP_LB + dir * 2048))[(i - 32) * 32 + j] = f2bf(lv);
        }
    }
    __syncthreads();
    if ((__builtin_amdgcn_readfirstlane(wv) & 3) == 0) {
        const float* Lm = (const float*)(lds + GP_L0 + dir * 16384);
        char* Tm = lds + GP_T0 + dir * 8192;
        const int blk = lane >> 5, c = lane & 31;
        const LAS float* Lb = (const LAS float*)(Lm + (32 * blk) * 64 + 32 * blk);
        float Tc[32];
#pragma unroll
        for (int i = 0; i < 32; ++i) {
            const LAS float* Lr = Lb + i * 64;
            if (i >= 2) asm volatile("" : "+v"(Lr) : "v"(Tc[i - 2]));
            float a0 = (c == i) ? 1.0f : 0.f, a1 = 0.f, a2 = 0.f, a3 = 0.f;
#pragma unroll
            for (int j4 = 0; j4 < (i & ~3); j4 += 4) {
                const f32x4 l4 = *(const LAS f32x4*)(Lr + j4);
                a0 -= l4[0] * Tc[j4]; a1 -= l4[1] * Tc[j4 + 1]; a2 -= l4[2] * Tc[j4 + 2]; a3 -= l4[3] * Tc[j4 + 3];
            }
#pragma unroll
            for (int j = (i & ~3); j < i; ++j) a0 -= Lr[j] * Tc[j];
            Tc[i] = (a0 + a1) + (a2 + a3);
        }
        {
            int rb = 32 * blk; const int cb = (32 * blk + c) >> 3, cz = (32 * (1 - blk) + c) >> 3, co = (c & 7) * 2;
#pragma unroll
            for (int i = 0; i < 32; ++i) {
                asm volatile("" : "+v"(rb));
                const int row = rb + i, sw = (row >> 1) & 7;
                *(bf16*)(Tm + row * 128 + ((cb ^ sw) << 4) + co) = f2bf(Tc[i]);
                if (blk == 0) *(bf16*)(Tm + row * 128 + ((cz ^ sw) << 4) + co) = (bf16)0;
            }
        }
        asm volatile("s_waitcnt lgkmcnt(0)" ::: "memory");
        const char* Lq = lds + GP_LB + dir * 2048;
        f32x16 X;
#pragma unroll
        for (int r = 0; r < 16; ++r) X[r] = 0.f;
        const int i16 = lane & 15, g1 = (lane >> 4) & 1;
#pragma unroll
        for (int ks = 0; ks < 2; ++ks) {
            const bf16x8 fa = *(const bf16x8*)(Lq + fr * 64 + (ks * 2 + fh) * 16);
            const int jr = 16 * ks + 8 * fh + (i16 >> 2), dc = 16 * g1 + 4 * (i16 & 3);
            const s16x4 t0 = __builtin_amdgcn_ds_read_tr16_b64_v4i16((LAS s16x4*)(Tm + g_lds_off(jr, dc >> 3) + (dc & 7) * 2));
            const s16x4 t1 = __builtin_amdgcn_ds_read_tr16_b64_v4i16((LAS s16x4*)(Tm + g_lds_off(jr + 4, dc >> 3) + (dc & 7) * 2));
            bf16x8 fb; fb[0] = t0[0]; fb[1] = t0[1]; fb[2] = t0[2]; fb[3] = t0[3]; fb[4] = t1[0]; fb[5] = t1[1]; fb[6] = t1[2]; fb[7] = t1[3];
            X = __builtin_amdgcn_mfma_f32_32x32x16_bf16(fa, fb, X, 0, 0, 0);
        }
        f32x16 Y;
#pragma unroll
        for (int r = 0; r < 16; ++r) Y[r] = 0.f;
#pragma unroll
        for (int ks = 0; ks < 2; ++ks) {
            union { bf16x8 v; unsigned u[4]; } xb;
#pragma unroll
            for (int j = 0; j < 4; ++j) xb.u[j] = pack_bf16(X[8 * ks + 2 * j], X[8 * ks + 2 * j + 1]);
            const int c0 = 32 + 16 * ks + 4 * fh, c1 = c0 + 8;
            const u32x2 p0 = *(const u32x2*)(Tm + g_lds_off(32 + fr, c0 >> 3) + (c0 & 7) * 2), p1 = *(const u32x2*)(Tm + g_lds_off(32 + fr, c1 >> 3) + (c1 & 7) * 2);
            union { bf16x8 v; unsigned u[4]; } ta_; ta_.u[0] = p0.x; ta_.u[1] = p0.y; ta_.u[2] = p1.x; ta_.u[3] = p1.y;
            Y = __builtin_amdgcn_mfma_f32_32x32x16_bf16(ta_.v, xb.v, Y, 0, 0, 0);
        }
#pragma unroll
        for (int r = 0; r < 16; ++r) { const int row = 32 + (r & 3) + 8 * (r >> 2) + 4 * fh; *(bf16*)(Tm + g_lds_off(row, fr >> 3) + (fr & 7) * 2) = f2bf(-Y[r]); }
    } else {
        const int t3 = t4 - 64;
        for (int e = t3; e < 1024; e += 192) {
            const int mat = e >> 9, j = (e >> 3) & 63, c8 = e & 7; const int tj = dir ? 63 - j : j;
            const float sc = sm[128 + dir * 64 + tj] * (mat ? __expf(sm[256 + dir * 64 + j]) : 1.0f);
            const u32x4 src = mat ? *(const u32x4*)(lds + GP_K + g_lds_off(tj, c8)) : *(const u32x4*)(lds + GP_V + at_voff(tj, c8 * 8));
            u32x4 d;
#pragma unroll
            for (int x = 0; x < 4; ++x) d[x] = pack_bf16(sc * __uint_as_float(src[x] << 16), sc * __uint_as_float(src[x] & 0xffff0000u));
            *(u32x4*)(lds + GP_VB0 + (dir * 2 + mat) * 8192 + at_voff(j, c8 * 8)) = d;
        }
    }
    __syncthreads();
    {
        const int w4 = wv & 3, ta = w4 >> 1, tb = w4 & 1; const int i16 = lane & 15, g1 = (lane >> 4) & 1;
        const char* Tm = lds + GP_T0 + dir * 8192; const char* vb = lds + GP_VB0 + (dir * 2) * 8192; const char* kbe = vb + 8192;
        f32x16 aw, au;
#pragma unroll
        for (int r = 0; r < 16; ++r) { aw[r] = 0.f; au[r] = 0.f; }
#pragma unroll
        for (int ks = 0; ks < 4; ++ks) {
            const int jr = 16 * ks + 8 * fh + (i16 >> 2), dc = 32 * ta + 16 * g1 + 4 * (i16 & 3);
            const s16x4 k0 = __builtin_amdgcn_ds_read_tr16_b64_v4i16((LAS s16x4*)(kbe + at_voff(jr, dc))), k1 = __builtin_amdgcn_ds_read_tr16_b64_v4i16((LAS s16x4*)(kbe + at_voff(jr + 4, dc)));
            bf16x8 fa; fa[0] = k0[0]; fa[1] = k0[1]; fa[2] = k0[2]; fa[3] = k0[3]; fa[4] = k1[0]; fa[5] = k1[1]; fa[6] = k1[2]; fa[7] = k1[3];
            const bf16x8 fbT = *(const bf16x8*)(Tm + g_lds_off(32 * tb + fr, ks * 2 + fh));
            aw = __builtin_amdgcn_mfma_f32_32x32x16_bf16(fa, fbT, aw, 0, 0, 0);
            const bf16x8 faT = *(const bf16x8*)(Tm + g_lds_off(32 * ta + fr, ks * 2 + fh));
            const int dc2 = 32 * tb + 16 * g1 + 4 * (i16 & 3);
            const s16x4 v0 = __builtin_amdgcn_ds_read_tr16_b64_v4i16((LAS s16x4*)(vb + at_voff(jr, dc2))), v1 = __builtin_amdgcn_ds_read_tr16_b64_v4i16((LAS s16x4*)(vb + at_voff(jr + 4, dc2)));
            bf16x8 fv; fv[0] = v0[0]; fv[1] = v0[1]; fv[2] = v0[2]; fv[3] = v0[3]; fv[4] = v1[0]; fv[5] = v1[1]; fv[6] = v1[2]; fv[7] = v1[3];
            au = __builtin_amdgcn_mfma_f32_32x32x16_bf16(faT, fv, au, 0, 0, 0);
        }
        bf16* uwg = w.uw + ((size_t)(((b * 4 + h) * 2 + dir) * GD_NC + cc) * 2) * 4096;
#pragma unroll
        for (int g = 0; g < 4; ++g) {
            const int rr = 32 * ta + 8 * g + 4 * fh;
            u32x2 o1; o1.x = pack_bf16(-aw[4 * g], -aw[4 * g + 1]); o1.y = pack_bf16(-aw[4 * g + 2], -aw[4 * g + 3]);
            *(u32x2*)(uwg + (32 * tb + fr) * 64 + rr) = o1;
            u32x2 o2; o2.x = pack_bf16(au[4 * g], au[4 * g + 1]); o2.y = pack_bf16(au[4 * g + 2], au[4 * g + 3]);
            *(u32x2*)(uwg + 4096 + (32 * tb + fr) * 64 + rr) = o2;
        }
    }
}
#endif
#ifndef HOST_SIM
constexpr int GS_IN = 0  , GS_ST = 65536  , GS_U1 = GS_ST + 16384, GS_U2 = GS_U1 + 8192, GS_AT = GS_U2 + 8192,
              GS_TB = GS_AT + 8192  , GS_END = GS_TB + 2 * 1024;
__device__ __forceinline__ int gd_chunk_of_step(int dir, int n) { return dir ? (n < 4 ? 3 - n : 39 - n) : n; }

__device__ __forceinline__ void gdn_scan_chain(char* lds, const WS& w, int b, int h, int dir, bool emit_ctx) {
    int tid = threadIdx.x; asm volatile("" : "+v"(tid));
    const int lane = tid & 63, wv = tid >> 6, fr = lane & 31, fh = lane >> 5, w4 = wv & 3, ta = w4 >> 1, tb = w4 & 1;
    const int i16 = lane & 15, g1 = (lane >> 4) & 1;
    const bool lo = wv < 4;
    const size_t chain = (size_t)((b * 4 + h) * 2 + dir) * GD_NC;
    const bf16* qkb = w.qk + (size_t)(b * 4 + h) * GD_NC * 2 * 4096;
    bf16* uwb = w.uw + chain * 2 * 4096; const float* gcb = w.gc + chain * 64;
    const int lrow = tid >> 3, lch = tid & 7;
    const int qrow = dir ? 63 - lrow : lrow;
    __syncthreads();
    *(u32x4*)(lds + GS_ST + tid * 16) = (u32x4){0u, 0u, 0u, 0u};
    f32x16 Sacc;
#pragma unroll
    for (int r = 0; r < 16; ++r) Sacc[r] = 0.f;
    struct Pre { u32x4 rw, rq, rk; float rg; u32x2 uc[4]; };
    Pre pa, pb, pc;
    auto prefetch = [&](int n, Pre& r) {
        const int cc = gd_chunk_of_step(dir, n);
        const bf16* uwp = uwb + (size_t)cc * 2 * 4096; const bf16* qkp = qkb + (size_t)cc * 2 * 4096;
        r.rw = *(const u32x4*)(uwp + lrow * 64 + lch * 8);
        r.rq = *(const u32x4*)(qkp + lrow * 64 + lch * 8); r.rk = *(const u32x4*)(qkp + 4096 + lrow * 64 + lch * 8);
        r.rg = 0.f; if (tid < 64) r.rg = gcb[(size_t)cc * 64 + tid];
        if (lo) { const bf16* up = uwp + 4096 + (32 * tb + fr) * 64 + 32 * ta + 4 * fh;
#pragma unroll
            for (int g = 0; g < 4; ++g) r.uc[g] = *(const u32x2*)(up + 8 * g); }
    };
    auto stage = [&](int buf, const Pre& r) {
        char* ib = lds + GS_IN + buf * 32768;
        *(u32x4*)(ib + g_lds_off(lrow, lch)) = r.rw;
        *(u32x4*)(ib + 8192 + g_lds_off(qrow, lch)) = r.rq;
        *(u32x4*)(ib + 16384 + g_lds_off(qrow, lch)) = r.rk;
        *(u32x4*)(ib + 24576 + at_voff(qrow, lch * 8)) = r.rk;
        float* tbp = (float*)(lds + GS_TB + buf * 1024);
        if (tid < 64) { const float g63 = __shfl(r.rg, 63); tbp[tid] = r.rg; tbp[64 + tid] = __expf(r.rg); tbp[128 + tid] = __expf(g63 - r.rg); if (tid == 0) tbp[192] = __expf(g63); }
    };
    auto step = [&](int n, Pre& cur, const Pre& nx) {
        const int buf = n & 1; const char* ib = lds + GS_IN + buf * 32768; const float* tbp = (const float*)(lds + GS_TB + buf * 1024);
        const char* St = lds + GS_ST + buf * 8192; char* Stn = lds + GS_ST + (buf ^ 1) * 8192;
        const int cc = gd_chunk_of_step(dir, n);
        if (lo) {
            f32x16 acc;
#pragma unroll
            for (int g = 0; g < 4; ++g) { acc[4 * g] = __uint_as_float(cur.uc[g].x << 16); acc[4 * g + 1] = __uint_as_float(cur.uc[g].x & 0xffff0000u); acc[4 * g + 2] = __uint_as_float(cur.uc[g].y << 16); acc[4 * g + 3] = __uint_as_float(cur.uc[g].y & 0xffff0000u); }
#pragma unroll
            for (int ks = 0; ks < 4; ++ks) {
                const bf16x8 fa = *(const bf16x8*)(ib + g_lds_off(32 * ta + fr, ks * 2 + fh)), fb = *(const bf16x8*)(St + g_lds_off(32 * tb + fr, ks * 2 + fh));
                acc = __builtin_amdgcn_mfma_f32_32x32x16_bf16(fa, fb, acc, 0, 0, 0);
            }
#pragma unroll
            for (int g = 0; g < 4; ++g) {
                const int i0 = 32 * ta + 8 * g + 4 * fh; const f32x4 fc = *(const f32x4*)(tbp + 128 + i0);
                u32x2 o1; o1.x = pack_bf16(acc[4 * g], acc[4 * g + 1]); o1.y = pack_bf16(acc[4 * g + 2], acc[4 * g + 3]);
                u32x2 o2; o2.x = pack_bf16(acc[4 * g] * fc[0], acc[4 * g + 1] * fc[1]); o2.y = pack_bf16(acc[4 * g + 2] * fc[2], acc[4 * g + 3] * fc[3]);
                const int off = g_lds_off(32 * tb + fr, i0 >> 3) + (i0 & 7) * 2;
                *(u32x2*)(lds + GS_U1 + off) = o1; *(u32x2*)(lds + GS_U2 + off) = o2;
            }
        } else {
            f32x16 acc;
#pragma unroll
            for (int r = 0; r < 16; ++r) acc[r] = 0.f;
#pragma unroll
            for (int ks = 0; ks < 4; ++ks) {
                const bf16x8 fa = *(const bf16x8*)(ib + 16384 + g_lds_off(32 * ta + fr, ks * 2 + fh)), fb = *(const bf16x8*)(ib + 8192 + g_lds_off(32 * tb + fr, ks * 2 + fh));
                acc = __builtin_amdgcn_mfma_f32_32x32x16_bf16(fa, fb, acc, 0, 0, 0);
            }
            const int i = 32 * tb + fr; const float gi = tbp[i];
#pragma unroll
            for (int g = 0; g < 4; ++g) {
                const int j0 = 32 * ta + 8 * g + 4 * fh; const f32x4 gj = *(const f32x4*)(tbp + j0);
                float v[4];
#pragma unroll
                for (int x = 0; x < 4; ++x) v[x] = (j0 + x <= i) ? acc[4 * g + x] * __expf(gi - gj[x]) : 0.f;
                u32x2 o; o.x = pack_bf16(v[0], v[1]); o.y = pack_bf16(v[2], v[3]);
                *(u32x2*)(lds + GS_AT + g_lds_off(i, j0 >> 3) + (j0 & 7) * 2) = o;
            }
        }
        __syncthreads();
        if (lo) {
            if (cc >= 4 || emit_ctx) {
                f32x16 acc, acc2;
#pragma unroll
                for (int r = 0; r < 16; ++r) { acc[r] = 0.f; acc2[r] = 0.f; }
#pragma unroll
                for (int ks = 0; ks < 4; ++ks) {
                    const bf16x8 fa = *(const bf16x8*)(ib + 8192 + g_lds_off(32 * ta + fr, ks * 2 + fh)), fb = *(const bf16x8*)(St + g_lds_off(32 * tb + fr, ks * 2 + fh));
                    acc = __builtin_amdgcn_mfma_f32_32x32x16_bf16(fa, fb, acc, 0, 0, 0);
                    const bf16x8 fa2 = *(const bf16x8*)(lds + GS_AT + g_lds_off(32 * ta + fr, ks * 2 + fh)), fb2 = *(const bf16x8*)(lds + GS_U1 + g_lds_off(32 * tb + fr, ks * 2 + fh));
                    acc2 = __builtin_amdgcn_mfma_f32_32x32x16_bf16(fa2, fb2, acc2, 0, 0, 0);
                }
                bf16* op = uwb + (size_t)cc * 2 * 4096 + 4096 + (32 * tb + fr) * 64 + 32 * ta + 4 * fh;
#pragma unroll
                for (int g = 0; g < 4; ++g) {
                    const f32x4 eg = *(const f32x4*)(tbp + 64 + 32 * ta + 8 * g + 4 * fh);
                    u32x2 o; o.x = pack_bf16(acc[4 * g] * eg[0] + acc2[4 * g], acc[4 * g + 1] * eg[1] + acc2[4 * g + 1]); o.y = pack_bf16(acc[4 * g + 2] * eg[2] + acc2[4 * g + 2], acc[4 * g + 3] * eg[3] + acc2[4 * g + 3]);
                    *(u32x2*)(op + 8 * g) = o;
                }
            }
        } else {
            const float e63 = tbp[192];
#pragma unroll
            for (int r = 0; r < 16; ++r) Sacc[r] *= e63;
#pragma unroll
            for (int ks = 0; ks < 4; ++ks) {
                const int ir = 16 * ks + 8 * fh + (i16 >> 2), dc = 32 * ta + 16 * g1 + 4 * (i16 & 3);
                const s16x4 k0 = __builtin_amdgcn_ds_read_tr16_b64_v4i16((LAS s16x4*)(ib + 24576 + at_voff(ir, dc))), k1 = __builtin_amdgcn_ds_read_tr16_b64_v4i16((LAS s16x4*)(ib + 24576 + at_voff(ir + 4, dc)));
                bf16x8 fa; fa[0] = k0[0]; fa[1] = k0[1]; fa[2] = k0[2]; fa[3] = k0[3]; fa[4] = k1[0]; fa[5] = k1[1]; fa[6] = k1[2]; fa[7] = k1[3];
                const bf16x8 fb = *(const bf16x8*)(lds + GS_U2 + g_lds_off(32 * tb + fr, ks * 2 + fh));
                Sacc = __builtin_amdgcn_mfma_f32_32x32x16_bf16(fa, fb, Sacc, 0, 0, 0);
            }
#pragma unroll
            for (int g = 0; g < 4; ++g) {
                const int d0 = 32 * ta + 8 * g + 4 * fh; u32x2 o; o.x = pack_bf16(Sacc[4 * g], Sacc[4 * g + 1]); o.y = pack_bf16(Sacc[4 * g + 2], Sacc[4 * g + 3]);
                *(u32x2*)(Stn + g_lds_off(32 * tb + fr, d0 >> 3) + (d0 & 7) * 2) = o;
            }
        }
        if (n + 1 < GD_NC) stage(buf ^ 1, nx);
        if (n + 3 < GD_NC) prefetch(n + 3, cur);
        __syncthreads();
    };
    prefetch(0, pa); prefetch(1, pb); prefetch(2, pc);
    stage(0, pa);
    __syncthreads();
    for (int n = 0; n < GD_NC; n += 3) { step(n, pa, pb); step(n + 1, pb, pc); step(n + 2, pc, pa); }
}

__device__ __forceinline__ void gdn_fin_item(char* lds, const WS& w, const float* ng, int b, int cc, int h) {
    int tid = threadIdx.x; asm volatile("" : "+v"(tid));
    bf16* lo_ = (bf16*)lds;
    __syncthreads();
    for (int i = tid; i < 1024; i += NTHREADS) {
        const int dir = i >> 9, dv = (i >> 3) & 63, k = i & 7;
        const bf16* src = w.uw + ((size_t)(((b * 4 + h) * 2 + dir) * GD_NC + cc) * 2 + 1) * 4096 + dv * 64 + k * 8;
        *(u32x4*)(lo_ + (dir * 64 + dv) * 72 + k * 8) = *(const u32x4*)src;
    }
    __syncthreads();
    const int tl = tid >> 3, dg = tid & 7; const size_t tok = gd_tok0(b, cc) + tl;
    float o[8]; float ss = 0.f;
#pragma unroll
    for (int x = 0; x < 8; ++x) { const int dv = dg * 8 + x; o[x] = bf2f(lo_[dv * 72 + tl]) + bf2f(lo_[(64 + dv) * 72 + 63 - tl]); ss += o[x] * o[x]; }
    ss += __shfl_xor(ss, 1); ss += __shfl_xor(ss, 2); ss += __shfl_xor(ss, 4);
    const float rs = 1.0f / sqrtf(ss * (1.0f / 64.0f) + EPS);
    const u32x4 gt = *(const u32x4*)(w.p + tok * DIN + O3 + 768 + h * 64 + dg * 8);
    u32x4 out;
#pragma unroll
    for (int x = 0; x < 4; ++x) {
        const float g0 = __uint_as_float(gt[x] << 16), g1v = __uint_as_float(gt[x] & 0xffff0000u);
        const float y0 = o[2 * x] * rs * ng[dg * 8 + 2 * x] * (g0 / (1.0f + __expf(-g0))), y1 = o[2 * x + 1] * rs * ng[dg * 8 + 2 * x + 1] * (g1v / (1.0f + __expf(-g1v)));
        out[x] = pack_bf16(y0, y1);
    }
    *(u32x4*)(w.ycat + tok * 1024 + 768 + h * 64 + dg * 8) = out;
}
#endif
#ifndef HOST_SIM
namespace cg = cooperative_groups;
struct MP { Inputs in; float* out; WS w; };

template <class F> __device__ __forceinline__ void dev_run(const F& f, long n) {
    int t0 = threadIdx.x; asm volatile("" : "+v"(t0));
    for (long i = (long)blockIdx.x * NTHREADS + t0; i < n; i += (long)gridDim.x * NTHREADS) f(i);
}

struct TLInProj {
    const bf16* A; const bf16* Bt; EpiInProj e; static constexpr int K = 1024;
    struct Tile { int m0, n0; };
    __device__ __forceinline__ bool tile(int idx, Tile& t) const {
        constexpr int MT = T / GBM, NT = (DIN + GBN - 1) / GBN;
        if (idx >= MT * NT) return false;
        const int mg = idx / (8 * NT), rem = idx % (8 * NT); t.n0 = (rem / 8) * GBN; t.m0 = (mg * 8 + (rem & 7)) * GBM; return true;
    }
    __device__ __forceinline__ const bf16* arow(const Tile& t, int r) const { return A + (size_t)(t.m0 + r) * D; }
    __device__ __forceinline__ const bf16* brow(const Tile& t, int r) const { return Bt + (size_t)(t.n0 + (r & 64) + perm64(r & 63)) * 1024; }
    __device__ __forceinline__ void epi(const Tile& t, f32x16 (&acc)[2][2], int mr, int nc) const { e(acc, t.m0 + mr, t.n0 + nc); }
};
struct TLOutProj {
    const bf16* A; const bf16* Bt; EpiOutProj e; int ntiles; static constexpr int K = 1024;
    struct Tile { int m0, n0; };
    __device__ __forceinline__ bool tile(int idx, Tile& t) const { if (idx >= ntiles) return false; t.m0 = (idx >> 3) * GBM; t.n0 = (idx & 7) * GBN; return true; }
    __device__ __forceinline__ const bf16* arow(const Tile& t, int r) const { return A + (size_t)(t.m0 + r) * 1024; }
    __device__ __forceinline__ const bf16* brow(const Tile& t, int r) const { return Bt + (size_t)(t.n0 + r) * 1024; }
    __device__ __forceinline__ void epi(const Tile& t, f32x16 (&acc)[2][2], int mr, int nc) const { e(acc, t.m0 + mr, t.n0 + nc); }
};
__device__ __forceinline__ void phase_inproj(char* lds, const WS& w, int l) {
    gemm_stream(lds, TLInProj{l == 0 ? w.h : w.hid2, w.winT + (size_t)l * 3328 * 1024, EpiInProj{w.p, w.rope}});
}
__device__ __forceinline__ void phase_outproj(char* lds, const WS& w, int l, const float* mod, int ntok, const float* xin, const float* cin) {
    gemm_stream(lds, TLOutProj{w.ycat, w.woutT + (size_t)l * 1024 * 1024, EpiOutProj{w.xr, mod, l == 0 ? xin : nullptr, cin}, (ntok / GBM) * 8});
}
struct EpiStoreP { bf16* p;
    __device__ __forceinline__ void operator()(f32x16 (&acc)[2][2], int mrow, int ncol) const {
#pragma unroll
        for (int mi = 0; mi < 2; ++mi)
#pragma unroll
            for (int ni = 0; ni < 2; ++ni)
#pragma unroll
                for (int g = 0; g < 4; ++g) { u32x2 v; v.x = pack_bf16(acc[mi][ni][4 * g], acc[mi][ni][4 * g + 1]); v.y = pack_bf16(acc[mi][ni][4 * g + 2], acc[mi][ni][4 * g + 3]);
                    *(u32x2*)(p + (size_t)(mrow + mi * 32) * 1024 + ncol + ni * 32 + 8 * g) = v; }
    } };
__device__ __forceinline__ void phase_outproj_dup(char* lds, const WS& w, int l, int ntok) {
    const int MT = ntok / GBM, NT = D / GBN;
    const bf16* Bt = w.woutT + (size_t)l * 1024 * 1024;
    for (int tile = blockIdx.x; tile < MT * NT; tile += gridDim.x) {
        const int mt = tile / NT, nt = tile % NT;
        gemm_tile(lds, ARowDense{w.ycat, 1024, mt * GBM}, Bt, 1024, 1024, mt * GBM, nt * GBN, EpiStoreP{w.p});
    }
}
__device__ __forceinline__ int q_next(int* head, int* slot  ) {
    __syncthreads();
    if (threadIdx.x == 0) *slot = __hip_atomic_fetch_add(head, 1, __ATOMIC_RELAXED, __HIP_MEMORY_SCOPE_AGENT);
    __syncthreads();
    return *slot;
}
__global__ void __launch_bounds__(NTHREADS) mega_kernel(MP mp) {
    extern __shared__ __attribute__((aligned(16))) char lds[];
    __shared__ uint4 xb_words;
    __shared__ int q_slot[4];
    cg::grid_group grid = cg::this_grid();
    const Inputs& in = mp.in; const WS& w = mp.w;
    if (threadIdx.x == 0) xb_words = make_uint4(0u, 0u, 0u, 0u);
    __syncthreads();
    XcdBarrier xb = xcd_barrier_post(w.bar, (volatile LAS unsigned*)&xb_words);
#define GSYNC(id) xcd_barrier(xb)
    phase_ada(lds, w, in);
    dev_run(NkRopeTab{w.rope}, NkRopeTab::count());
    dev_run(NkZeroI{w.cnt}, 4 * 32 * 32);
    dev_run(NkZeroI{w.qctr}, 64 * 64);
    for (int it = blockIdx.x; it < 16 * 52; it += gridDim.x) cvt_tile(lds, in.w_in, DIN, w.winT, 1024, (it / 52) * 64, (it % 52) * 64, DIN, 3328, NMapId{});
    for (int l = 0; l < 2; ++l) {
        hy_filter_mlp(lds, in.hy_w1 + l * 33 * 64, in.hy_b1 + l * 64, in.hy_w2 + l * 64 * 64, in.hy_b2 + l * 64, in.hy_freq + l * 64, w.f2b + (size_t)l * (S + LC) * 64);
        { NkCvtT c4{in.hy_w3 + (size_t)l * 64 * 512, w.w3T + (size_t)l * 512 * 64, 64, 512, 512}; dev_run(c4, c4.count()); }
    }
    if (mp.out == nullptr) grid.sync();
    xcd_barrier(xb);
    row_pass<3, 1>(w, in, T, w.mod, w.mod, in.norm1, 0, 1, nullptr, nullptr, nullptr, w.h);
    GSYNC(0);
    for (int l = 0; l < 2; ++l) {
        const bool need_ctx = l == 0;
        const float* mod = w.mod + (size_t)l * 9 * 6144;
        const long ntok = need_ctx ? T : TL;
        const float* filt = w.filt + (size_t)l * (S + LC) * 512;
        phase_inproj(lds, w, l);
        hy_filter_out(w.w3T + (size_t)l * 512 * 64, w.f2b + (size_t)l * (S + LC) * 64, w.filt + (size_t)l * (S + LC) * 512);
        GSYNC(2);
        const float* hcw = in.hy_conv + l * 3 * 768;
        if (l == 0) for (int l2 = 0; l2 < 2; ++l2) { NkCvtT c3{in.moe_router + (size_t)l2 * D * 32, w.wrT + (size_t)l2 * 32 * 1024, 1024, 32, 32}; dev_run(c3, c3.count()); }
        {
            const int n_gp = B * GD_NC * 4, n_hp = B * 32 + (need_ctx ? B * 4 : 0), n_cv = l == 0 ? 104 + 64 : 0;
            int* head = w.qctr + (2 + l) * 64;
            for (;;) {
                int it = q_next(head, q_slot);
                if (it >= n_gp + n_hp + n_cv) break;
                if (it < n_gp) { gdn_pre_item(lds, w, in.gdn_conv + l * 4 * 768, in.gdn_a_log + l * 8, in.gdn_dt_bias + l * 8, it / (GD_NC * 4), (it >> 2) % GD_NC, it & 3); continue; }
                it -= n_gp;
                if (it < n_hp) { if (it < B * 32) hy_prep_item(lds, w.p, hcw, w.x0T, w.uvT, it >> 5, it & 31); else hy_prep_item(lds, w.p, hcw, w.x0Tc, w.uvTc, (it - B * 32) >> 2, (it - B * 32) & 3, true); continue; }
                it -= n_hp;
                if (it < 104) { for (int q = it * 8; q < it * 8 + 8; ++q) cvt_tile(lds, in.w_in + (size_t)D * DIN, DIN, w.winT + (size_t)3328 * 1024, 1024, (q / 52) * 64, (q % 52) * 64, DIN, 3328, NMapId{}); }
                else { const int g = it - 104, l2 = g >> 5; for (int q = (g & 31) * 8; q < (g & 31) * 8 + 8; ++q) cvt_tile(lds, in.w_out + (size_t)l2 * 1024 * D, D, w.woutT + (size_t)l2 * 1024 * 1024, 1024, (q >> 4) * 64, (q & 15) * 64, D, D, NMapId{}); }
            }
        }
        GSYNC(90);
        {
            const int natt = 512 + (need_ctx ? 64 : 0);
            int* head = w.qctr + l * 64;
            for (;;) {
                const int it = q_next(head, q_slot);
                if (it >= 64 + 256 + natt) break;
                if (it < 64) gdn_scan_chain(lds, w, it >> 3, (it >> 1) & 3, it & 1, need_ctx);
                else if (it < 320) hy_conv_item(lds, filt, in.hy_bias + l * 256, w.uvT, w.x0T, it - 64, need_ctx ? w.uvTc : nullptr, w.x0Tc);
                else { int a = it - 320; a = a < 256 ? a + 256 : (a < 512 ? a - 256 : a); attn_item(lds, w, in, l, a); }
            }
        }
        GSYNC(91);
        for (int it = blockIdx.x; it < B * 32 + (need_ctx ? B * 4 : 0); it += gridDim.x) { if (it < B * 32) hy_fin_item(lds, w.x0T, w.ycat, it >> 5, it & 31); else hy_fin_item(lds, w.x0Tc, w.ycat, (it - B * 32) >> 2, (it - B * 32) & 3, true); }
        for (int it = blockIdx.x; it < B * GD_NC * 4; it += gridDim.x) { const int cc = (it >> 2) % GD_NC; if (cc >= 4 || need_ctx) gdn_fin_item(lds, w, in.gdn_norm + l * 64, it / (GD_NC * 4), cc, it & 3); }
        GSYNC(5);
        phase_outproj(lds, w, l, mod, (int)ntok, in.x, in.ctx);
        {
            const int skip = (l == 0 && (int)gridDim.x > 128) ? 64 : 0;
            if ((int)blockIdx.x >= skip) {
                const int b0 = (int)blockIdx.x - skip, nb = (int)gridDim.x - skip;
                for (int it = b0; it < 33 * 2 * 16; it += nb) {
                    const int e = it >> 5, which = (it >> 4) & 1, kt = it & 15;
                    const float* src = e < 32 ? (which ? in.moe_up : in.moe_gate) + ((size_t)l * 32 + e) * D * 256 : (which ? in.sh_up : in.sh_gate) + (size_t)l * D * 256;
                    cvt_strip(lds, src, 256, w.moeUpT + (size_t)e * 512 * 1024, 1024, kt * 64, 0, 256, 256, NMapUp{which});
                }
                for (int it = b0; it < 33 * 16; it += nb) {
                    const int e = it >> 4, kt = (it >> 2) & 3, st = it & 3;
                    const float* src = e < 32 ? in.moe_down + ((size_t)l * 32 + e) * 256 * D : in.sh_down + (size_t)l * 256 * D;
                    cvt_strip(lds, src, D, w.moeDownT + (size_t)e * 1024 * 256, 256, kt * 64, st * 256, D, D, NMapId{});
                }
            }
        }
        GSYNC(6);
        phase_norm2_router(lds, w, in, (int)ntok, mod, in.norm2 + l * D, in.moe_bias + l * 32, l);
        GSYNC(7);
        phase_moe_up(lds, w, l, (int)ntok);
        GSYNC(9);
        phase_moe_down(lds, w, l, (int)ntok, mod);
        GSYNC(10);
        if (l == 0) row_pass<2, 1>(w, in, (int)ntok, mod, w.mod + (size_t)9 * 6144, in.norm1 + D, 0, 1, (const bf16*)w.h, w.topw, nullptr, w.hid2);
        else row_pass<2, 2>(w, in, (int)ntok, mod, mod, in.norm_f, 0, 0, (const bf16*)w.h, w.topw, mp.out, nullptr);
        GSYNC(11);
    }
}

constexpr size_t kDynLds = G_LDS3;
static_assert(H_LDS <= kDynLds &&  HY_LDS_END <= kDynLds && AT_RING * AT_STAGE + 2048 <= kDynLds && GP_END <= kDynLds && GS_END <= kDynLds, "LDS budget");
extern "C" void kernel_launch(void* const* d_in, const int* in_sizes, int n_in, void* d_out, int out_size, void* d_ws, size_t ws_size, hipStream_t stream) {
    static int grid_blocks = 0;
    if (!grid_blocks) {
        int dev = 0, cus = 0, per_cu = 0;
        hipGetDevice(&dev);
        hipDeviceGetAttribute(&cus, hipDeviceAttributeMultiprocessorCount, dev);
        hipFuncSetAttribute((const void*)mega_kernel, hipFuncAttributeMaxDynamicSharedMemorySize, (int)kDynLds);
        hipOccupancyMaxActiveBlocksPerMultiprocessor(&per_cu, mega_kernel, NTHREADS, kDynLds);
        if (per_cu < 1) per_cu = 1;
        grid_blocks = cus;
    }
    MP mp; memset(&mp, 0, sizeof(mp));
    const float** ip = (const float**)&mp.in;
    for (int i = 0; i < 33; ++i) ip[i] = (const float*)d_in[i];
    mp.out = (float*)d_out; mp.w = make_ws(d_ws);
    hipMemsetAsync(mp.w.bar, 0, 4096 * 4, stream);
    void* args[] = {&mp};
    hipError_t e = hipLaunchCooperativeKernel((void*)mega_kernel, dim3(grid_blocks), dim3(NTHREADS), args, kDynLds, stream);
    if (e != hipSuccess) fprintf(stderr, "cooperative launch failed: %s (grid %d)\n", hipGetErrorString(e), grid_blocks);
}
#endif
```

```cpp
#ifndef HOST_SIM
#include <hip/hip_runtime.h>
#include <hip/hip_cooperative_groups.h>
#include <cstdio>
#include <cstring>
#define HD __host__ __device__ __forceinline__
#else
#include <cmath>
#include <cstdio>
#include <cstdlib>
#include <cstring>
#define HD inline
typedef void* hipStream_t;
#endif
#include <cstdint>
#include <cstddef>

#ifndef BATCH
#define BATCH 8
#endif
constexpr int B = BATCH, S = 2048, D = 1024, LC = 256, GRID_W = 64;
constexpr int TL = B * S, TC = B * LC, T = TL + TC;
constexpr int DIN = 3088, O1 = 768, O2 = 1280, O3 = 2048;
constexpr int WINDOW = 128, NA_KR = 8, NA_KC = 16;
constexpr float EPS = 1e-6f, ROPE_BASE = 10000.0f, ROUTED_SCALE = 2.5f;
constexpr float HY_DECAY_MIN = 3.0701134573253946f;
constexpr float HY_DECAY_MAX = 15.350567286626973f;
typedef unsigned short bf16;

HD float bf2f(bf16 h) { union { unsigned u; float f; } v; v.u = (unsigned)h << 16; return v.f; }
HD bf16 f2bf(float f) { union { float f; unsigned u; } v; v.f = f; unsigned u = v.u; u += 0x7fffu + ((u >> 16) & 1u); return (bf16)(u >> 16); }
HD float siluf(float x) { return x / (1.0f + expf(-x)); }

struct NkCopyX {
    const float* x; const float* ctx; float* xr;
    HD void operator()(long i) const { xr[i] = i < (long)TL * D ? x[i] : ctx[i - (long)TL * D]; }
    static HD long count() { return (long)T * D; }
};

struct NkAda {
    const float* c; const float* cctx; const float* w_ada; const float* b_ada; float* mod;
    HD void operator()(long i) const {
        int n = (int)(i % 6144); int r = (int)((i / 6144) % 9); int l = (int)(i / (6144 * 9));
        const float* cv = r < 8 ? c + (long)(r % B) * D : cctx;
        const float* w = w_ada + (long)l * D * 6144 + n;
        float acc = 0.f;
        for (int k = 0; k < D; ++k) { float v = cv[k]; acc += siluf(v) * w[(long)k * 6144]; }
        mod[i] = acc + b_ada[l * 6144 + n];
    }
    static HD long count() { return 2L * 9 * 6144; }
};

struct NkRstd {
    const float* xr; float* rstd; int nrows;
    HD void operator()(long t) const {
        const float* r = xr + t * D; float s = 0.f;
        for (int k = 0; k < D; ++k) s += r[k] * r[k];
        rstd[t] = 1.0f / sqrtf(s * (1.0f / D) + EPS);
    }
};

struct NkModNorm {
    const float* xr; const float* rstd; const float* g; const float* mod;   int sh_chunk, sc_chunk; bf16* h;
    HD void operator()(long i) const {
        long t = i / D; int k = (int)(i % D); int r = t < TL ? (int)(t / S) : 8;
        const float* m = mod + (long)r * 6144;
        float v = xr[i] * rstd[t] * g[k];
        h[i] = f2bf(v * (1.0f + m[sc_chunk * D + k]) + m[sh_chunk * D + k]);
    }
};

struct NkInProj {
    const bf16* h; const float* w; bf16* p;
    HD void operator()(long i) const {
        long t = i / DIN; int n = (int)(i % DIN);
        const bf16* hr = h + t * D; float acc = 0.f;
        for (int k = 0; k < D; ++k) acc += bf2f(hr[k]) * w[(long)k * DIN + n];
        p[i] = f2bf(acc);
    }
    static HD long count() { return (long)T * DIN; }
};

struct NkRope {
    bf16* p;
    HD void operator()(long i) const {
        int pr = (int)(i % 32); int hd = (int)((i / 32) % 6); long t = i / (32 * 6);
        int s = (int)(t % S); int row = s / GRID_W, col = s % GRID_W;
        int axis = pr >> 4, j = pr & 15;
        float pos = axis == 0 ? (float)row : (float)col;
        float inv = powf(ROPE_BASE, -(float)j / 16.0f);
        float ang = pos * inv; float cs = cosf(ang), sn = sinf(ang);
        bf16* q = p + t * DIN + O1 + hd * 64 + axis * 32;
        float x1 = bf2f(q[j]), x2 = bf2f(q[j + 16]);
        q[j] = f2bf(x1 * cs - x2 * sn); q[j + 16] = f2bf(x1 * sn + x2 * cs);
    }
    static HD long count() { return (long)TL * 6 * 32; }
};

struct NkHyF1 {
    const float* w1; const float* b1; const float* freq; float* f1;
    HD void operator()(long i) const {
        int j = (int)(i % 64); int tt = (int)(i / 64); int L = tt < S ? S : LC; int t = tt < S ? tt : tt - S;
        float tn = (float)t / (float)(L - 1);
        float acc = tn * w1[j];
        for (int bnd = 0; bnd < 16; ++bnd) {
            float band = 1e-4f + (float)bnd * ((15.0f - 1e-4f) / 15.0f);
            float ang = (6.283185307179586f / (float)L) * (float)t * band;
            acc += cosf(ang) * w1[(1 + bnd) * 64 + j] - sinf(ang) * w1[(17 + bnd) * 64 + j];
        }
        f1[i] = sinf(freq[j] * (acc + b1[j]));
    }
    static HD long count() { return (long)(S + LC) * 64; }
};
struct NkHyF2 {
    const float* w2; const float* b2; const float* freq; const float* f1; float* f2; bf16* f2b;
    HD void operator()(long i) const {
        int j = (int)(i % 64); long tt = i / 64; float acc = 0.f;
        for (int k = 0; k < 64; ++k) acc += f1[tt * 64 + k] * w2[k * 64 + j];
        const float v = sinf(freq[j] * (acc + b2[j]));
        f2[i] = v; if (f2b) f2b[i] = f2bf(v);
    }
    static HD long count() { return (long)(S + LC) * 64; }
};
struct NkHyF3 {
    const float* w3; const float* f2; float* filt;
    HD void operator()(long i) const {
        int tt = (int)(i % (S + LC)); int c = (int)(i / (S + LC)); int L = tt < S ? S : LC; int t = tt < S ? tt : tt - S;
        float tn = (float)t / (float)(L - 1);
        float acc = 0.f;
        for (int k = 0; k < 64; ++k) acc += f2[(long)tt * 64 + k] * w3[k * 512 + c];
        int cc = c & 255;
        float decay = HY_DECAY_MIN + (float)cc * ((HY_DECAY_MAX - HY_DECAY_MIN) / 255.0f);
        filt[(long)c * (S + LC) + tt] = acc * expf(-tn * decay);
    }
    static HD long count() { return (long)(S + LC) * 512; }
};
HD float hy_conv3(const bf16* p, long t, int tin, int L, int col, const float* cw) {
    float acc = cw[768 + col] * bf2f(p[t * DIN + col]);
    if (tin > 0) acc += cw[col] * bf2f(p[(t - 1) * DIN + col]);
    if (tin < L - 1) acc += cw[2 * 768 + col] * bf2f(p[(t + 1) * DIN + col]);
    return acc;
}
struct NkHyUV {
    const bf16* p; const float* cw; bf16* uv; long tbase; long ntok; int L;
    HD void operator()(long i) const {
        int c = (int)(i % 256); long t = tbase + i / 256; int tin = (int)((t - tbase) % L);
        float x1 = hy_conv3(p, t, tin, L, 256 + c, cw), v = hy_conv3(p, t, tin, L, 512 + c, cw);
        uv[t * 256 + c] = f2bf(x1 * v);
    }
};
struct NkHyConv {
    const bf16* p; const float* cw; const bf16* uv; const float* filt; const float* hbias; bf16* ycat; long tbase; int L; int foff;
    HD void operator()(long i) const {
        int tin = (int)(i % L); int c = (int)((i / L) % 256); long seq = i / ((long)L * 256); long t0 = tbase + seq * L; long t = t0 + tin;
        const float* f = filt + foff;
        float acc = 0.f;
        for (int s = 0; s < L; ++s) {
            int d = tin - s; float k = d >= 0 ? f[(long)c * (S + LC) + d] : f[(long)(256 + c) * (S + LC) - d];
            acc += k * bf2f(uv[(t0 + s) * 256 + c]);
        }
        acc += hbias[c] * bf2f(uv[t * 256 + c]);
        float x0 = hy_conv3(p, t, tin, L, c, cw);
        ycat[t * 1024 + c] = f2bf(x0 * acc);
    }
};

HD void attn_key(const float (&q)[64], const bf16* kr, const bf16* vr, float bias, float& m, float& l, float (&acc)[64]) {
    float sc = 0.f;
#pragma unroll
    for (int d = 0; d < 64; ++d) sc += q[d] * bf2f(kr[d]);
    sc = sc * 0.125f + bias;
    float mn = fmaxf(m, sc); float ca = expf(m - mn), cb = expf(sc - mn);
    l = l * ca + cb; m = mn;
#pragma unroll
    for (int d = 0; d < 64; ++d) acc[d] = acc[d] * ca + cb * bf2f(vr[d]);
}
struct NkWA {
    const bf16* p; const float* sink; bf16* ycat;
    HD void operator()(long i) const {
        int hq = (int)(i % 4); long t = i / 4; int b = (int)(t / S), s = (int)(t % S); int hk = hq >> 1;
        const bf16* qp = p + t * DIN + O1 + hq * 64;
        float q[64], acc[64];
#pragma unroll
        for (int d = 0; d < 64; ++d) { q[d] = bf2f(qp[d]); acc[d] = 0.f; }
        float m = sink[hq], l = 1.0f;
        for (int j = 0; j < LC; ++j) {
            const bf16* kr = p + ((long)TL + (long)b * LC + j) * DIN + O1 + 256 + hk * 64;
            attn_key(q, kr, kr + 128, 0.f, m, l, acc);
        }
        int j0 = s - WINDOW < 0 ? 0 : s - WINDOW, j1 = s + WINDOW > S - 1 ? S - 1 : s + WINDOW;
        for (int j = j0; j <= j1; ++j) {
            const bf16* kr = p + ((long)b * S + j) * DIN + O1 + 256 + hk * 64;
            attn_key(q, kr, kr + 128, 0.f, m, l, acc);
        }
        float il = 1.0f / l;
#pragma unroll
        for (int d = 0; d < 64; ++d) ycat[t * 1024 + 256 + hq * 64 + d] = f2bf(acc[d] * il);
    }
    static HD long count() { return (long)TL * 4; }
};
struct NkWACtx {
    const bf16* p; const float* sink; bf16* ycat;
    HD void operator()(long i) const {
        int hq = (int)(i % 4); long tc = i / 4; int b = (int)(tc / LC); int hk = hq >> 1; long t = TL + tc;
        const bf16* qp = p + t * DIN + O1 + hq * 64;
        float q[64], acc[64];
#pragma unroll
        for (int d = 0; d < 64; ++d) { q[d] = bf2f(qp[d]); acc[d] = 0.f; }
        float m = sink[hq], l = 1.0f;
        for (int j = 0; j < LC; ++j) {
            const bf16* kr = p + ((long)TL + (long)b * LC + j) * DIN + O1 + 256 + hk * 64;
            attn_key(q, kr, kr + 128, 0.f, m, l, acc);
        }
        float il = 1.0f / l;
#pragma unroll
        for (int d = 0; d < 64; ++d) ycat[t * 1024 + 256 + hq * 64 + d] = f2bf(acc[d] * il);
    }
    static HD long count() { return (long)TC * 4; }
};
struct NkNA {
    const bf16* p; const float* rpb; bf16* ycat;
    HD void operator()(long i) const {
        int h = (int)(i % 4); long t = i / 4; int b = (int)(t / S), s = (int)(t % S);
        int r = s / GRID_W, cq = s % GRID_W;
        const bf16* qp = p + t * DIN + O2 + h * 64;
        float q[64], acc[64];
#pragma unroll
        for (int d = 0; d < 64; ++d) { q[d] = bf2f(qp[d]); acc[d] = 0.f; }
        float m = -1e30f, l = 0.f;
        for (int j = 0; j < LC; ++j) {
            const bf16* kr = p + ((long)TL + (long)b * LC + j) * DIN + O2 + 256 + h * 64;
            attn_key(q, kr, kr + 256, 0.f, m, l, acc);
        }
        int r0 = r - NA_KR / 2; r0 = r0 < 0 ? 0 : (r0 > S / GRID_W - NA_KR ? S / GRID_W - NA_KR : r0);
        int c0 = cq - NA_KC / 2; c0 = c0 < 0 ? 0 : (c0 > GRID_W - NA_KC ? GRID_W - NA_KC : c0);
        for (int kk = 0; kk < NA_KR * NA_KC; ++kk) {
            int kr_ = r0 + kk / NA_KC, kc_ = c0 + kk % NA_KC;
            const bf16* kr = p + ((long)b * S + kr_ * GRID_W + kc_) * DIN + O2 + 256 + h * 64;
            attn_key(q, kr, kr + 256, rpb[(h * 15 + (kr_ - r + 7)) * 31 + (kc_ - cq + 15)], m, l, acc);
        }
        float il = 1.0f / l;
#pragma unroll
        for (int d = 0; d < 64; ++d) ycat[t * 1024 + 512 + h * 64 + d] = f2bf(acc[d] * il);
    }
    static HD long count() { return (long)TL * 4; }
};
struct NkNACtx {
    const bf16* p; bf16* ycat;
    HD void operator()(long i) const {
        int h = (int)(i % 4); long tc = i / 4; int b = (int)(tc / LC); long t = TL + tc;
        const bf16* qp = p + t * DIN + O2 + h * 64;
        float q[64], acc[64];
#pragma unroll
        for (int d = 0; d < 64; ++d) { q[d] = bf2f(qp[d]); acc[d] = 0.f; }
        float m = -1e30f, l = 0.f;
        for (int j = 0; j < LC; ++j) {
            const bf16* kr = p + ((long)TL + (long)b * LC + j) * DIN + O2 + 256 + h * 64;
            attn_key(q, kr, kr + 256, 0.f, m, l, acc);
        }
        float il = 1.0f / l;
#pragma unroll
        for (int d = 0; d < 64; ++d) ycat[t * 1024 + 512 + h * 64 + d] = f2bf(acc[d] * il);
    }
    static HD long count() { return (long)TC * 4; }
};

HD float gdn_conv4(const bf16* p, long t, int tin, int L, int col, const float* cw) {
    float acc = 0.f;
    for (int i = 0; i < 4; ++i) { int o = i - 2; if (tin + o >= 0 && tin + o < L) acc += cw[i * 768 + col] * bf2f(p[(t + o) * DIN + O3 + col]); }
    return siluf(acc);
}
struct NkGdnPrep {
    const bf16* p; const float* cw; bf16* qkv;
    HD void operator()(long i) const {
        int e = (int)(i % 64); int wh = (int)((i / 64) % 12); long t = i / 768; int which = wh / 4;
        int L = t < TL ? S : LC; int tin = t < TL ? (int)(t % S) : (int)((t - TL) % LC);
        int col0 = wh * 64;
        float v = gdn_conv4(p, t, tin, L, col0 + e, cw);
        if (which < 2) {
            float ss = 0.f; for (int d = 0; d < 64; ++d) { float u = gdn_conv4(p, t, tin, L, col0 + d, cw); ss += u * u; }
            v *= 1.0f / sqrtf(ss + EPS); if (which == 0) v *= 0.125f;
        }
        qkv[t * 768 + col0 + e] = f2bf(v);
    }
    static HD long count() { return (long)T * 768; }
};
struct NkGdnGate {
    const bf16* p; const float* a_log; const float* dt_bias; float* gb;
    HD void operator()(long i) const {
        int dh = (int)(i % 8); long t = i / 8;
        float a = bf2f(p[t * DIN + O3 + 1024 + dh]), bb = bf2f(p[t * DIN + O3 + 1032 + dh]);
        float x = a + dt_bias[dh]; float sp = x > 20.f ? x : log1pf(expf(x));
        gb[t * 16 + dh] = -expf(a_log[dh]) * sp; gb[t * 16 + 8 + dh] = 1.0f / (1.0f + expf(-bb));
    }
    static HD long count() { return (long)T * 8; }
};
struct NkGdnRec {
    const bf16* qkv; const float* gb; bf16* o;
    HD void operator()(long i) const {
        int e = (int)(i % 64); int dir = (int)((i / 64) % 2); int h = (int)((i / 128) % 4); int b = (int)(i / 512);
        float Sc[64];
#pragma unroll
        for (int d = 0; d < 64; ++d) Sc[d] = 0.f;
        for (int step = 0; step < LC + S; ++step) {
            long t;
            if (step < LC) { int j = dir ? LC - 1 - step : step; t = (long)TL + (long)b * LC + j; }
            else { int s = step - LC; s = dir ? S - 1 - s : s; t = (long)b * S + s; }
            const bf16* qr = qkv + t * 768 + h * 64; const bf16* kr = qr + 256; float v = bf2f(qr[512 + e]);
            float a = expf(gb[t * 16 + dir * 4 + h]), beta = gb[t * 16 + 8 + dir * 4 + h];
            float kS = 0.f;
#pragma unroll
            for (int c = 0; c < 4; ++c) {
#pragma unroll
                for (int d = c * 16; d < c * 16 + 16; ++d) kS += bf2f(kr[d]) * Sc[d];
                asm volatile("" ::: "memory");
            }
            float w = beta * (v - a * kS); float oo = 0.f;
#pragma unroll
            for (int c = 0; c < 4; ++c) {
#pragma unroll
                for (int d = c * 16; d < c * 16 + 16; ++d) { Sc[d] = a * Sc[d] + bf2f(kr[d]) * w; oo += bf2f(qr[d]) * Sc[d]; }
                asm volatile("" ::: "memory");
            }
            o[((long)dir * T + t) * 256 + h * 64 + e] = f2bf(oo);
        }
    }
    static HD long count() { return (long)B * 4 * 2 * 64; }
};
struct NkGdnFin {
    const bf16* p; const bf16* o; const float* ng; bf16* ycat;
    HD void operator()(long i) const {
        int e = (int)(i % 64); int h = (int)((i / 64) % 4); long t = i / 256;
        const bf16* o0 = o + t * 256 + h * 64; const bf16* o1 = o + ((long)T + t) * 256 + h * 64;
        float ss = 0.f; for (int d = 0; d < 64; ++d) { float u = bf2f(o0[d]) + bf2f(o1[d]); ss += u * u; }
        float v = (bf2f(o0[e]) + bf2f(o1[e])) * (1.0f / sqrtf(ss * (1.0f / 64.0f) + EPS)) * ng[e];
        float gt = bf2f(p[t * DIN + O3 + 768 + h * 64 + e]);
        ycat[t * 1024 + 768 + h * 64 + e] = f2bf(v * siluf(gt));
    }
    static HD long count() { return (long)T * 256; }
};

struct NkOutProj {
    const bf16* ycat; const float* w; const float* mod; float* xr; long ntok;
    HD void operator()(long i) const {
        long t = i / D; int n = (int)(i % D); int r = t < TL ? (int)(t / S) : 8;
        const bf16* yr = ycat + t * 1024; float acc = 0.f;
        for (int k = 0; k < 1024; ++k) acc += bf2f(yr[k]) * w[(long)k * D + n];
        xr[i] += mod[(long)r * 6144 + 2 * D + n] * acc;
    }
};

struct NkRouter {
    const bf16* h; const float* wr; float* scores;
    HD void operator()(long i) const {
        int e = (int)(i % 32); long t = i / 32; float acc = 0.f;
        for (int k = 0; k < D; ++k) acc += bf2f(h[t * D + k]) * wr[k * 32 + e];
        scores[i] = 1.0f / (1.0f + expf(-acc));
    }
};
struct NkTopK {
    const float* scores; const float* ebias; int* topi; float* topw;
    HD void operator()(long t) const {
        int sel[4]; float ss[4]; float sum = 0.f;
#pragma unroll
        for (int k = 0; k < 4; ++k) {
            int best = -1; float bv = -1e30f;
            for (int e = 0; e < 32; ++e) {
                bool used = false;
#pragma unroll
                for (int q = 0; q < 4; ++q) if (q < k && sel[q] == e) used = true;
                float v = scores[t * 32 + e] + ebias[e];
                if (!used && v > bv) { bv = v; best = e; }
            }
            sel[k] = best; ss[k] = scores[t * 32 + best]; sum += ss[k];
        }
#pragma unroll
        for (int k = 0; k < 4; ++k) { topi[t * 4 + k] = sel[k]; topw[t * 4 + k] = ss[k] / sum * ROUTED_SCALE; }
    }
};
struct NkMoeHid {
    const bf16* h; const int* topi; const float* wg; const float* wu; const float* sg; const float* su; bf16* hid;
    HD void operator()(long i) const {
        int j = (int)(i % 256); int slot = (int)((i / 256) % 5); long t = i / 1280;
        const float* g; const float* u;
        if (slot < 4) { int e = topi[t * 4 + slot]; g = wg + (long)e * D * 256; u = wu + (long)e * D * 256; } else { g = sg; u = su; }
        float ag = 0.f, au = 0.f;
        for (int k = 0; k < D; ++k) { float x = bf2f(h[t * D + k]); ag += x * g[(long)k * 256 + j]; au += x * u[(long)k * 256 + j]; }
        hid[i] = f2bf(siluf(ag) * au);
    }
};
struct NkMoeOut {
    const bf16* hid; const int* topi; const float* topw; const float* wd; const float* sd; const float* mod; float* xr;
    HD void operator()(long i) const {
        long t = i / D; int n = (int)(i % D); int r = t < TL ? (int)(t / S) : 8;
        float f = 0.f;
        for (int slot = 0; slot < 5; ++slot) {
            const float* w; float wt;
            if (slot < 4) { w = wd + (long)topi[t * 4 + slot] * 256 * D; wt = topw[t * 4 + slot]; } else { w = sd; wt = 1.0f; }
            float acc = 0.f;
            for (int j = 0; j < 256; ++j) acc += bf2f(hid[(t * 5 + slot) * 256 + j]) * w[(long)j * D + n];
            f += wt * acc;
        }
        xr[i] += mod[(long)r * 6144 + 5 * D + n] * f;
    }
};
struct NkFinal {
    const float* xr; const float* rstd; const float* g; float* out;
    HD void operator()(long i) const { long t = i / D; int k = (int)(i % D); out[i] = xr[i] * rstd[t] * g[k]; }
    static HD long count() { return (long)TL * D; }
};

struct NkCvtT {
    const float* src; bf16* dst; int K, N, Npad;
    HD void operator()(long i) const {
        int n = (int)(i % Npad); int k0 = (int)(i / Npad) * 8;
        bf16 v[8];
#pragma unroll
        for (int j = 0; j < 8; ++j) v[j] = n < N ? f2bf(src[(long)(k0 + j) * N + n]) : (bf16)0;
        bf16* d = dst + (long)n * K + k0;
#pragma unroll
        for (int j = 0; j < 8; ++j) d[j] = v[j];
    }
    HD long count() const { return (long)Npad * (K / 8); }
};
struct NkRopeTab {
    float* rope;
    HD void operator()(long i) const {
        int j = (int)(i % 16); int pos = (int)(i / 16);
        float ang = (float)pos * powf(ROPE_BASE, -(float)j / 16.0f);
        rope[i * 2] = cosf(ang); rope[i * 2 + 1] = sinf(ang);
    }
    static HD long count() { return 64 * 16; }
};

struct NkCvtUp {
    const float* wg; const float* wu; const float* sg; const float* su; bf16* dst;
    HD void operator()(long i) const {
        int j = (int)(i % 256); int k0 = (int)((i / 256) % 128) * 8; int which = (int)((i / (256 * 128)) % 2); int e = (int)(i / (256 * 128 * 2));
        const float* src = e < 32 ? (which ? wu : wg) + (long)e * D * 256 : (which ? su : sg);
        int np = (j >> 6) * 128 + ((j >> 5) & 1) * 64 + which * 32 + (j & 31);
        bf16* d = dst + ((long)e * 512 + np) * 1024 + k0;
#pragma unroll
        for (int q = 0; q < 8; ++q) d[q] = f2bf(src[(long)(k0 + q) * 256 + j]);
    }
    static HD long count() { return 33L * 2 * 128 * 256; }
};
struct NkCvtDown {
    const float* wd; const float* sd; bf16* dst;
    HD void operator()(long i) const {
        int n = (int)(i % 1024); int j0 = (int)((i / 1024) % 32) * 8; int e = (int)(i / (1024 * 32));
        const float* src = e < 32 ? wd + (long)e * 256 * D : sd;
        bf16* d = dst + ((long)e * 1024 + n) * 256 + j0;
#pragma unroll
        for (int q = 0; q < 8; ++q) d[q] = f2bf(src[(long)(j0 + q) * D + n]);
    }
    static HD long count() { return 33L * 32 * 1024; }
};
struct NkZeroI { int* p; HD void operator()(long i) const { p[i] = 0; } };
struct WS {
    float* mod; float* rstd; float* xr; bf16* h; bf16* p; bf16* ycat; float* hyf1; float* hyf2; float* filt; bf16* uv;
    bf16* qkv; float* gb; bf16* o; float* scores; int* topi; float* topw; bf16* hid;
    bf16* winT; bf16* woutT; bf16* wrT; float* rope; unsigned* bar; int* cnt; int* list;
    bf16* moeUpT; bf16* hid2; bf16* moeDownT;
    bf16* qk; bf16* uw; float* gc; bf16* x0T; bf16* uvT; int* qctr; bf16* x0Tc; bf16* uvTc; bf16* w3T; bf16* f2b;
};
static inline WS make_ws(void* d_ws) {
    char* base = (char*)d_ws; size_t off = 0;
    auto take = [&](size_t bytes) { char* r = base + off; off += (bytes + 255) & ~(size_t)255; return r; };
    WS w;
    w.mod = (float*)take(2ul * 9 * 6144 * 4);
    w.rstd = (float*)take((size_t)T * 4);
    w.hyf1 = (float*)take(2 * (size_t)(S + LC) * 64 * 4);
    w.hyf2 = (float*)take(2 * (size_t)(S + LC) * 64 * 4);
    w.filt = (float*)take(2 * (size_t)(S + LC) * 512 * 4);
    w.gb = (float*)take((size_t)T * 16 * 4);
#ifdef HOST_SIM
    w.scores = (float*)take((size_t)T * 32 * 4); w.topi = (int*)take((size_t)T * 4 * 4);
#else
    w.scores = nullptr; w.topi = nullptr;
#endif
    w.topw = (float*)take((size_t)T * 4 * 4);
    w.winT = (bf16*)take(2ul * 3328 * 1024 * 2);
    w.woutT = (bf16*)take(2ul * 1024 * 1024 * 2);
    w.wrT = (bf16*)take(2ul * 32 * 1024 * 2);
    w.rope = (float*)take(64 * 16 * 2 * 4);
    w.bar = (unsigned*)take(4096 * 4);
    w.cnt = (int*)take(4 * 32 * 32 * 4);
    w.list = (int*)take((size_t)32 * T * 4);
    w.qctr = (int*)take(64 * 64 * 4);
    w.w3T = (bf16*)take(2ul * 512 * 64 * 2);
    w.f2b = (bf16*)take(2ul * (S + LC) * 64 * 2);
    w.xr = (float*)take((size_t)T * D * 4);
    w.h = (bf16*)take((size_t)T * D * 2);
    w.p = (bf16*)take((size_t)T * DIN * 2);
    w.hid = (bf16*)w.p;
    char* R = take(0);
    const size_t szUp = 33ul * 512 * 1024 * 2, szHid = ((size_t)5 * T + 256) * 256 * 2, szDown = 33ul * 1024 * 256 * 2;
    w.moeUpT = (bf16*)R; w.hid2 = (bf16*)(R + szUp); w.moeDownT = (bf16*)(R + szUp + szHid);
    w.qkv = (bf16*)R;
    w.qk = (bf16*)R;
    w.ycat = w.hid2;
    w.o = (bf16*)((char*)w.ycat + (size_t)T * 1024 * 2);
    w.x0T = (bf16*)((char*)w.ycat + (size_t)T * 1024 * 2);
    w.uvT = w.x0T + (size_t)256 * B * S;
    w.uv = w.uvT + (size_t)256 * B * S;
    w.uw = w.h; w.gc = w.gb;
    w.x0Tc = w.uv; w.uvTc = w.uv + (size_t)256 * B * LC;
    size_t rsz = szUp + szHid + szDown; const size_t rsz2 = szUp + (size_t)T * 1024 * 2 + (size_t)2 * 256 * B * S * 2 + (size_t)T * 256 * 2;
    if (rsz2 > rsz) rsz = rsz2;
    (void)take(rsz);
    return w;
}
#ifdef HOST_SIM
template <class F> static inline void run(F f, long n, hipStream_t) {
#pragma omp parallel for schedule(dynamic, 256)
    for (long i = 0; i < n; ++i) f(i);
}
#endif

struct Inputs {
    const float *x, *c, *ctx, *c_ctx, *w_ada, *b_ada, *norm1, *norm2, *norm_f, *w_in, *w_out, *hy_conv, *hy_w1, *hy_b1, *hy_w2, *hy_b2, *hy_w3, *hy_freq, *hy_bias,
        *wa_sink, *na_rpb, *gdn_conv, *gdn_a_log, *gdn_dt_bias, *gdn_norm, *moe_router, *moe_bias, *moe_gate, *moe_up, *moe_down, *sh_gate, *sh_up, *sh_down;
};

#ifdef HOST_SIM
static void forward_naive(const Inputs& in, float* out, const WS& w, hipStream_t st) {
    run(NkCopyX{in.x, in.ctx, w.xr}, NkCopyX::count(), st);
    run(NkAda{in.c, in.c_ctx, in.w_ada, in.b_ada, w.mod}, NkAda::count(), st);
    for (int l = 0; l < 2; ++l) {
        const bool need_ctx = l == 0;
        const float* mod = w.mod + (size_t)l * 9 * 6144;
        run(NkRstd{w.xr, w.rstd, T}, T, st);
        run(NkModNorm{w.xr, w.rstd, in.norm1 + l * D, mod, 0, 1, w.h}, (long)T * D, st);
        run(NkInProj{w.h, in.w_in + (size_t)l * D * DIN, w.p}, NkInProj::count(), st);
        run(NkRope{w.p}, NkRope::count(), st);
        run(NkHyF1{in.hy_w1 + l * 33 * 64, in.hy_b1 + l * 64, in.hy_freq + l * 64, w.hyf1}, NkHyF1::count(), st);
        run(NkHyF2{in.hy_w2 + l * 64 * 64, in.hy_b2 + l * 64, in.hy_freq + l * 64, w.hyf1, w.hyf2, nullptr}, NkHyF2::count(), st);
        run(NkHyF3{in.hy_w3 + l * 64 * 512, w.hyf2, w.filt}, NkHyF3::count(), st);
        const float* hcw = in.hy_conv + l * 3 * 768;
        run(NkHyUV{w.p, hcw, w.uv, 0, TL, S}, (long)TL * 256, st);
        run(NkHyConv{w.p, hcw, w.uv, w.filt, in.hy_bias + l * 256, w.ycat, 0, S, 0}, (long)TL * 256, st);
        if (need_ctx) {
            run(NkHyUV{w.p, hcw, w.uv, TL, TC, LC}, (long)TC * 256, st);
            run(NkHyConv{w.p, hcw, w.uv, w.filt, in.hy_bias + l * 256, w.ycat, TL, LC, S}, (long)TC * 256, st);
        }
        run(NkWA{w.p, in.wa_sink + l * 4, w.ycat}, NkWA::count(), st);
        if (need_ctx) run(NkWACtx{w.p, in.wa_sink + l * 4, w.ycat}, NkWACtx::count(), st);
        run(NkNA{w.p, in.na_rpb + l * 4 * 15 * 31, w.ycat}, NkNA::count(), st);
        if (need_ctx) run(NkNACtx{w.p, w.ycat}, NkNACtx::count(), st);
        run(NkGdnPrep{w.p, in.gdn_conv + l * 4 * 768, w.qkv}, NkGdnPrep::count(), st);
        run(NkGdnGate{w.p, in.gdn_a_log + l * 8, in.gdn_dt_bias + l * 8, w.gb}, NkGdnGate::count(), st);
        run(NkGdnRec{w.qkv, w.gb, w.o}, NkGdnRec::count(), st);
        run(NkGdnFin{w.p, w.o, in.gdn_norm + l * 64, w.ycat}, need_ctx ? (long)T * 256 : (long)TL * 256, st);
        const long ntok = need_ctx ? T : TL;
        run(NkOutProj{w.ycat, in.w_out + (size_t)l * 1024 * D, mod, w.xr, ntok}, ntok * D, st);
        run(NkRstd{w.xr, w.rstd, (int)ntok}, ntok, st);
        run(NkModNorm{w.xr, w.rstd, in.norm2 + l * D, mod, 3, 4, w.h}, ntok * D, st);
        run(NkRouter{w.h, in.moe_router + l * D * 32, w.scores}, ntok * 32, st);
        run(NkTopK{w.scores, in.moe_bias + l * 32, w.topi, w.topw}, ntok, st);
        run(NkMoeHid{w.h, w.topi, in.moe_gate + (size_t)l * 32 * D * 256, in.moe_up + (size_t)l * 32 * D * 256, in.sh_gate + (size_t)l * D * 256, in.sh_up + (size_t)l * D * 256, w.hid}, ntok * 1280, st);
        run(NkMoeOut{w.hid, w.topi, w.topw, in.moe_down + (size_t)l * 32 * 256 * D, in.sh_down + (size_t)l * 256 * D, mod, w.xr}, ntok * D, st);
    }
    run(NkRstd{w.xr, w.rstd, TL}, TL, st);
    run(NkFinal{w.xr, w.rstd, in.norm_f, out}, NkFinal::count(), st);
}


#endif
#ifdef HOST_SIM
extern "C" void kernel_launch(void* const* d_in, const int* in_sizes, int n_in, void* d_out, int out_size, void* d_ws, size_t ws_size, hipStream_t stream) {
    Inputs in;
    const float** ip = (const float**)&in;
    for (int i = 0; i < 33; ++i) ip[i] = (const float*)d_in[i];
    WS w = make_ws(d_ws);
    forward_naive(in, (float*)d_out, w, stream);
}

#endif
#ifndef HOST_SIM
#define XB_TMO      128
#define XB_XCNT(j)  (256  + 64 * (j))
#define XB_XSUB(j)  (1280 + 64 * (j))
#define XB_XGEN(j)  (2304 + 64 * (j))
#define XB_TOP      3328
#define XB_TOPGEN   3392
#define XCD_BAR_WORDS 3456
#define XB_SPIN_CAP (1u << 26)
#define LAS __attribute__((address_space(3)))
__device__ __forceinline__ unsigned xb_ld(unsigned* p)              { return __hip_atomic_load(p, __ATOMIC_RELAXED, __HIP_MEMORY_SCOPE_AGENT); }
__device__ __forceinline__ unsigned xb_add(unsigned* p, unsigned v) { return __hip_atomic_fetch_add(p, v, __ATOMIC_RELAXED, __HIP_MEMORY_SCOPE_AGENT); }
__device__ __forceinline__ unsigned xb_xcc_id() { return (unsigned)__builtin_amdgcn_s_getreg((3 << 11) | 20) & 0xFu; }
#define XB_SPIN(cond, bar) do { unsigned _sp = 0; while (cond) { __builtin_amdgcn_s_sleep(1); \
    if ((++_sp & 255u) == 0u) { if (xb_ld(&(bar)[XB_TMO])) break; if (_sp > XB_SPIN_CAP) { atomicAdd(&(bar)[XB_TMO], 1u); break; } } } } while (0)
struct XcdBarrier { unsigned* bar; unsigned x; volatile LAS unsigned* st; };
__device__ __forceinline__ XcdBarrier xcd_barrier_post(unsigned* bar, volatile LAS unsigned* st) {
    XcdBarrier b; b.bar = bar; b.x = xb_xcc_id(); b.st = st;
    if (threadIdx.x == 0) (void)xb_add(&bar[XB_XCNT(b.x)], 1u);
    return b;
}
__device__ __forceinline__ void xcd_barrier_complete(unsigned* bar, unsigned x, unsigned& nloc, unsigned& nx) {
    const unsigned G = gridDim.x * gridDim.y * gridDim.z;
    unsigned sum, cnt, mine, sp = 0u;
    for (;;) {
        sum = 0u; cnt = 0u; mine = 0u;
#pragma unroll
        for (unsigned j = 0; j < 16; ++j) { const unsigned c = xb_ld(&bar[XB_XCNT(j)]); sum += c; cnt += (c > 0u) ? 1u : 0u; mine = (j == x) ? c : mine; }
        if (sum == G) break;
        __builtin_amdgcn_s_sleep(1);
        if ((++sp & 255u) == 0u) { if (xb_ld(&bar[XB_TMO])) break; if (sp > XB_SPIN_CAP) { atomicAdd(&bar[XB_TMO], 1u); break; } }
    }
    nloc = mine > 0u ? mine : 1u; nx = cnt > 0u ? cnt : 1u;
}
__device__ __forceinline__ void xcd_barrier(const XcdBarrier& b) {
    asm volatile("s_waitcnt vmcnt(0)" ::: "memory");
    __syncthreads();
    if (threadIdx.x == 0) {
        unsigned* bar = b.bar;
        __builtin_amdgcn_s_waitcnt(0);
        unsigned nloc = b.st[0], nx = b.st[1];
        if (nloc == 0u) { xcd_barrier_complete(bar, b.x, nloc, nx); b.st[0] = nloc; b.st[1] = nx; }
        const unsigned old = xb_add(&bar[XB_XSUB(b.x)], 1u);
        const unsigned gen = old / nloc;
        if (old + 1u == (gen + 1u) * nloc) {
            __builtin_amdgcn_fence(__ATOMIC_RELEASE, "agent");
            asm volatile("s_waitcnt vmcnt(0)" ::: "memory");
            const unsigned og = xb_add(&bar[XB_TOP], 1u);
            const unsigned tg = og / nx;
            if (og + 1u == (tg + 1u) * nx) xb_add(&bar[XB_TOPGEN], 1u);
            else XB_SPIN(xb_ld(&bar[XB_TOPGEN]) == tg, bar);
            __builtin_amdgcn_fence(__ATOMIC_ACQUIRE, "agent");
            xb_add(&bar[XB_XGEN(b.x)], 1u);
            asm volatile("s_waitcnt vmcnt(0)" ::: "memory");
        } else {
            XB_SPIN(xb_ld(&bar[XB_XGEN(b.x)]) == gen, bar);
            __builtin_amdgcn_fence(__ATOMIC_ACQUIRE, "agent");
            asm volatile("s_waitcnt vmcnt(0)" ::: "memory");
        }
    }
    __syncthreads();
}
#endif
#ifndef HOST_SIM
typedef short bf16x8 __attribute__((ext_vector_type(8)));
typedef float f32x16 __attribute__((ext_vector_type(16)));
typedef float f32x4 __attribute__((ext_vector_type(4)));
typedef unsigned u32x4 __attribute__((ext_vector_type(4)));
typedef unsigned u32x2 __attribute__((ext_vector_type(2)));
#define NTHREADS 512

__device__ __forceinline__ void st_wt8(void* p, u32x2 v) { __hip_atomic_store((unsigned long long*)p, ((unsigned long long)v.y << 32) | v.x, __ATOMIC_RELAXED, __HIP_MEMORY_SCOPE_AGENT); }
__device__ __forceinline__ void st_wt16(void* p, f32x4 v) { asm volatile("global_store_dwordx4 %0, %1, off sc1\n\ts_nop 1" :: "v"(p), "v"(v) : "memory"); }
typedef __bf16 bf16x2n __attribute__((ext_vector_type(2)));
typedef float f32x2n __attribute__((ext_vector_type(2)));
__device__ __forceinline__ unsigned pack_bf16(float lo, float hi) { f32x2n f = {lo, hi}; bf16x2n r = __builtin_convertvector(f, bf16x2n); return __builtin_bit_cast(unsigned, r); }

constexpr int GBM = 256, GBN = 128, GBK = 64;
constexpr int G_ASTAGE = GBM * GBK * 2, G_BSTAGE = GBN * GBK * 2, G_STAGE = G_ASTAGE + G_BSTAGE;
constexpr int G_LDS = 2 * G_STAGE;
__device__ __forceinline__ int g_lds_off(int r, int c) { return r * 128 + ((c ^ ((r >> 1) & 7)) << 4); }

template <class ARow, class Epi>
__device__ __forceinline__ void gemm_tile(char* lds, const ARow& arow, const bf16* __restrict__ Bt, int ldb, int K, int m0, int n0, const Epi& epi) {
    int tid = threadIdx.x; asm volatile("" : "+v"(tid));
    const int lane = tid & 63, wid = __builtin_amdgcn_readfirstlane(tid >> 6), wm = wid >> 1, wn = wid & 1;
    const bf16* ap[4]; const bf16* bp[2];
#pragma unroll
    for (int j = 0; j < 4; ++j) { const int r = 8 * (wid * 4 + j) + (lane >> 3); ap[j] = arow(r) + 8 * ((lane & 7) ^ ((r >> 1) & 7)); }
#pragma unroll
    for (int j = 0; j < 2; ++j) { const int r = 8 * (wid * 2 + j) + (lane >> 3); bp[j] = Bt + (size_t)(n0 + r) * ldb + 8 * ((lane & 7) ^ ((r >> 1) & 7)); }
    f32x16 acc[2][2];
#pragma unroll
    for (int a = 0; a < 2; ++a)
#pragma unroll
        for (int b = 0; b < 2; ++b)
#pragma unroll
            for (int r = 0; r < 16; ++r) acc[a][b][r] = 0.f;
    const int nk = K / GBK;
    __syncthreads();
#define G_DMA(kt_, stage_) do { \
        _Pragma("unroll") for (int j = 0; j < 4; ++j) __builtin_amdgcn_global_load_lds((const unsigned*)(ap[j] + (kt_) * GBK), (LAS unsigned*)((stage_) + (wid * 4 + j) * 1024), 16, 0, 0); \
        _Pragma("unroll") for (int j = 0; j < 2; ++j) __builtin_amdgcn_global_load_lds((const unsigned*)(bp[j] + (kt_) * GBK), (LAS unsigned*)((stage_) + G_ASTAGE + (wid * 2 + j) * 1024), 16, 0, 0); } while (0)
    G_DMA(0, lds);
    __syncthreads();
    const int fr = lane & 31, fh = lane >> 5;
    for (int kt = 0; kt < nk; ++kt) {
        char* cur = lds + (kt & 1) * G_STAGE;
        if (kt + 1 < nk) { char* nxt = lds + ((kt + 1) & 1) * G_STAGE; G_DMA(kt + 1, nxt); }
#pragma unroll
        for (int kk = 0; kk < 4; ++kk) {
            bf16x8 fa[2], fb[2];
#pragma unroll
            for (int mi = 0; mi < 2; ++mi) fa[mi] = *(const bf16x8*)(cur + g_lds_off(wm * 64 + mi * 32 + fr, kk * 2 + fh));
#pragma unroll
            for (int ni = 0; ni < 2; ++ni) fb[ni] = *(const bf16x8*)(cur + G_ASTAGE + g_lds_off(wn * 64 + ni * 32 + fr, kk * 2 + fh));
#pragma unroll
            for (int mi = 0; mi < 2; ++mi)
#pragma unroll
                for (int ni = 0; ni < 2; ++ni) acc[mi][ni] = __builtin_amdgcn_mfma_f32_32x32x16_bf16(fb[ni], fa[mi], acc[mi][ni], 0, 0, 0);
        }
        __syncthreads();
    }
#undef G_DMA
    epi(acc, m0 + wm * 64 + fr, n0 + wn * 64 + 4 * fh);
}


constexpr int G_LDS3 = 3 * G_STAGE;
struct GPtrs { const bf16* a[4]; const bf16* b[2]; };
template <class TL> __device__ __forceinline__ void g_ptrs(const TL& tl, const typename TL::Tile& t, int wid, int lane, GPtrs& P) {
#pragma unroll
    for (int j = 0; j < 4; ++j) { const int r = 8 * (wid * 4 + j) + (lane >> 3); P.a[j] = tl.arow(t, r) + 8 * ((lane & 7) ^ ((r >> 1) & 7)); }
#pragma unroll
    for (int j = 0; j < 2; ++j) { const int r = 8 * (wid * 2 + j) + (lane >> 3); P.b[j] = tl.brow(t, r) + 8 * ((lane & 7) ^ ((r >> 1) & 7)); }
}
__device__ __forceinline__ void g_dma(char* lds, const GPtrs& P, int kt, int stage, int wid) {
    char* st = lds + stage * G_STAGE;
#pragma unroll
    for (int j = 0; j < 4; ++j) __builtin_amdgcn_global_load_lds((const unsigned*)(P.a[j] + kt * GBK), (LAS unsigned*)(st + (wid * 4 + j) * 1024), 16, 0, 0);
#pragma unroll
    for (int j = 0; j < 2; ++j) __builtin_amdgcn_global_load_lds((const unsigned*)(P.b[j] + kt * GBK), (LAS unsigned*)(st + G_ASTAGE + (wid * 2 + j) * 1024), 16, 0, 0);
}
template <class TL, int XF = 0>
__device__ __forceinline__ void gemm_stream(char* lds, const TL& tl) {
    int tid = threadIdx.x; asm volatile("" : "+v"(tid));
    const int lane = tid & 63, wid = __builtin_amdgcn_readfirstlane(tid >> 6), wm = wid >> 1, wn = wid & 1, fr = lane & 31, fh = lane >> 5;
    constexpr int nk = TL::K / GBK;
    static_assert(nk >= 2, "K too small");
    int idx = blockIdx.x;
    typename TL::Tile cur, nxt;
    if (!tl.tile(idx, cur)) return;
    GPtrs P, Pn;
    g_ptrs(tl, cur, wid, lane, P);
    bool has_next = tl.tile(idx + (int)gridDim.x, nxt);
    if (has_next) g_ptrs(tl, nxt, wid, lane, Pn);
    __syncthreads();
    if (!(XF & 1)) { g_dma(lds, P, 0, 0, wid); g_dma(lds, P, 1, 1, wid); }
    int sg = 0;
    for (;;) {
        f32x16 acc[2][2];
#pragma unroll
        for (int a = 0; a < 2; ++a)
#pragma unroll
            for (int b = 0; b < 2; ++b)
#pragma unroll
                for (int r = 0; r < 16; ++r) acc[a][b][r] = 0.f;
        for (int kt = 0; kt < nk; ++kt) {
            if (!(XF & 2)) { if (kt + 1 < nk || has_next) asm volatile("s_waitcnt vmcnt(6)" ::: "memory"); else asm volatile("s_waitcnt vmcnt(0)" ::: "memory");
            __builtin_amdgcn_s_barrier(); }
            asm volatile("" ::: "memory");
            const int s2 = sg >= 1 ? sg - 1 : 2;
            if (!(XF & 1)) { if (kt + 2 < nk) g_dma(lds, P, kt + 2, s2, wid);
            else if (has_next) g_dma(lds, Pn, kt + 2 - nk, s2, wid); }
            const char* cs = lds + sg * G_STAGE;
#pragma unroll
            for (int kk = 0; kk < 4; ++kk) {
                bf16x8 fa[2], fb[2];
#pragma unroll
                for (int mi = 0; mi < 2; ++mi) fa[mi] = *(const bf16x8*)(cs + g_lds_off(wm * 64 + mi * 32 + fr, kk * 2 + fh));
#pragma unroll
                for (int ni = 0; ni < 2; ++ni) fb[ni] = *(const bf16x8*)(cs + G_ASTAGE + g_lds_off(wn * 64 + ni * 32 + fr, kk * 2 + fh));
#pragma unroll
                for (int mi = 0; mi < 2; ++mi)
#pragma unroll
                    for (int ni = 0; ni < 2; ++ni) acc[mi][ni] = __builtin_amdgcn_mfma_f32_32x32x16_bf16(fb[ni], fa[mi], acc[mi][ni], 0, 0, 0);
            }
            sg = sg == 2 ? 0 : sg + 1;
        }
        tl.epi(cur, acc, wm * 64 + fr, wn * 64 + 4 * fh);
        if (!has_next) break;
        asm volatile("s_waitcnt vmcnt(0)" ::: "memory");
        cur = nxt; P = Pn; idx += (int)gridDim.x;
        has_next = tl.tile(idx + (int)gridDim.x, nxt);
        if (has_next) g_ptrs(tl, nxt, wid, lane, Pn);
    }
    asm volatile("s_waitcnt vmcnt(0)" ::: "memory");
}

constexpr int HBK = 32, H_ASTG = 256 * HBK * 2, H_STG = 2 * H_ASTG, H_RING = 4, H_LDS = H_RING * H_STG;
__device__ __forceinline__ int h_lds_off(int r, int c) { return r * 64 + ((c ^ ((r >> 2) & 3)) << 4); }
struct HPtrs { const bf16* a[2]; const bf16* b[2]; };
template <class TL> __device__ __forceinline__ void h_ptrs(const TL& tl, const typename TL::Tile& t, int wid, int lane, HPtrs& P) {
#pragma unroll
    for (int j = 0; j < 2; ++j) { const int r = 16 * (wid * 2 + j) + (lane >> 2); const int c = (lane & 3) ^ ((r >> 2) & 3); P.a[j] = tl.arow(t, r) + 8 * c; P.b[j] = tl.brow(t, r) + 8 * c; }
}
__device__ __forceinline__ void h_dma(char* lds, const HPtrs& P, int kt, int stage, int wid) {
    char* st = lds + stage * H_STG;
#pragma unroll
    for (int j = 0; j < 2; ++j) __builtin_amdgcn_global_load_lds((const unsigned*)(P.a[j] + kt * HBK), (LAS unsigned*)(st + (wid * 2 + j) * 1024), 16, 0, 0);
#pragma unroll
    for (int j = 0; j < 2; ++j) __builtin_amdgcn_global_load_lds((const unsigned*)(P.b[j] + kt * HBK), (LAS unsigned*)(st + H_ASTG + (wid * 2 + j) * 1024), 16, 0, 0);
}
template <class TL>
__device__ __forceinline__ void gemm_stream256(char* lds, const TL& tl) {
    int tid = threadIdx.x; asm volatile("" : "+v"(tid));
    const int lane = tid & 63, wid = __builtin_amdgcn_readfirstlane(tid >> 6), wm = wid >> 1, wn = wid & 1, fr = lane & 31, fh = lane >> 5;
    constexpr int nk = TL::K / HBK;
    static_assert(nk >= 4, "K too small");
    int idx = blockIdx.x;
    typename TL::Tile cur, nxt;
    if (!tl.tile(idx, cur)) return;
    HPtrs P, Pn;
    h_ptrs(tl, cur, wid, lane, P);
    bool has_next = tl.tile(idx + (int)gridDim.x, nxt);
    if (has_next) h_ptrs(tl, nxt, wid, lane, Pn);
    asm volatile("s_waitcnt vmcnt(0)" ::: "memory");
    __syncthreads();
    h_dma(lds, P, 0, 0, wid); h_dma(lds, P, 1, 1, wid); h_dma(lds, P, 2, 2, wid);
    int sg = 0;
    for (;;) {
        f32x16 acc[2][4];
#pragma unroll
        for (int a = 0; a < 2; ++a)
#pragma unroll
            for (int b = 0; b < 4; ++b)
#pragma unroll
                for (int r = 0; r < 16; ++r) acc[a][b][r] = 0.f;
        const unsigned act = tl.active(cur, wn);
        for (int kt = 0; kt < nk; ++kt) {
            const int ahead = (nk - 1 - kt) + (has_next ? 3 : 0);
            if (ahead >= 2) asm volatile("s_waitcnt vmcnt(8)" ::: "memory"); else if (ahead == 1) asm volatile("s_waitcnt vmcnt(4)" ::: "memory"); else asm volatile("s_waitcnt vmcnt(0)" ::: "memory");
            __builtin_amdgcn_s_barrier();
            asm volatile("" ::: "memory");
            const int s3 = (sg + 3) & 3;
            if (kt + 3 < nk) h_dma(lds, P, kt + 3, s3, wid);
            else if (has_next) h_dma(lds, Pn, kt + 3 - nk, s3, wid);
            const char* cs = lds + sg * H_STG;
#pragma unroll
            for (int kk = 0; kk < 2; ++kk) {
                bf16x8 fa[2], fb[4];
#pragma unroll
                for (int mi = 0; mi < 2; ++mi) fa[mi] = *(const bf16x8*)(cs + h_lds_off(wm * 64 + mi * 32 + fr, kk * 2 + fh));
#pragma unroll
                for (int ni = 0; ni < 4; ++ni) fb[ni] = *(const bf16x8*)(cs + H_ASTG + h_lds_off(wn * 128 + ni * 32 + fr, kk * 2 + fh));
#pragma unroll
                for (int ni = 0; ni < 4; ++ni)
                    if (act & (1u << ni)) {
#pragma unroll
                        for (int mi = 0; mi < 2; ++mi) acc[mi][ni] = __builtin_amdgcn_mfma_f32_32x32x16_bf16(fb[ni], fa[mi], acc[mi][ni], 0, 0, 0);
                    }
            }
            sg = (sg + 1) & 3;
        }
        tl.epi(cur, acc, wm * 64 + fr, wn * 128 + 4 * fh);
        if (!has_next) break;
        asm volatile("s_waitcnt vmcnt(0)" ::: "memory");
        cur = nxt; P = Pn; idx += (int)gridDim.x;
        has_next = tl.tile(idx + (int)gridDim.x, nxt);
        if (has_next) h_ptrs(tl, nxt, wid, lane, Pn);
    }
    asm volatile("s_waitcnt vmcnt(0)" ::: "memory");
}

struct ARowDense { const bf16* A; int lda; int m0; __device__ __forceinline__ const bf16* operator()(int i) const { return A + (size_t)(m0 + i) * lda; } };

__device__ __forceinline__ int perm64(int rho) { const int ni = rho >> 5, g = (rho >> 3) & 3, fh = (rho >> 2) & 1, q = rho & 3; return 16 * g + 8 * fh + 4 * ni + q; }
struct EpiInProj {
    bf16* p; const float* rope;
    __device__ __forceinline__ void operator()(f32x16 (&acc)[2][2], int mrow, int ncol  ) const {
        const int nb = ncol & ~63, fh = (ncol >> 2) & 1;
#pragma unroll
        for (int mi = 0; mi < 2; ++mi) {
            const int m = mrow + mi * 32;
            if (nb >= O1 && nb < O1 + 384 && m < TL) {
                const int s = m & (S - 1);
#pragma unroll
                for (int ax = 0; ax < 2; ++ax) {
                    const int pos = ax == 0 ? (s >> 6) : (s & 63);
#pragma unroll
                    for (int ni = 0; ni < 2; ++ni)
#pragma unroll
                        for (int q = 0; q < 4; ++q) {
                            const int j = 8 * fh + 4 * ni + q;
                            const float cs = rope[(pos * 16 + j) * 2], sn = rope[(pos * 16 + j) * 2 + 1];
                            const float x1 = acc[mi][ni][8 * ax + q], x2 = acc[mi][ni][8 * ax + 4 + q];
                            acc[mi][ni][8 * ax + q] = x1 * cs - x2 * sn; acc[mi][ni][8 * ax + 4 + q] = x1 * sn + x2 * cs;
                        }
                }
            }
#pragma unroll
            for (int g = 0; g < 4; ++g) {
                const int n = nb + 16 * g + 8 * fh;
                if (n < DIN) {
                    u32x4 v; v.x = pack_bf16(acc[mi][0][4 * g], acc[mi][0][4 * g + 1]); v.y = pack_bf16(acc[mi][0][4 * g + 2], acc[mi][0][4 * g + 3]);
                    v.z = pack_bf16(acc[mi][1][4 * g], acc[mi][1][4 * g + 1]); v.w = pack_bf16(acc[mi][1][4 * g + 2], acc[mi][1][4 * g + 3]);
                    *(u32x4*)(p + (size_t)m * DIN + n) = v;
                }
            }
        }
    }
};
struct EpiInProjH {
    bf16* p; const float* rope;
    __device__ __forceinline__ void operator()(f32x16 (&acc)[2][4], int mrow, int ncol) const {
#pragma unroll
        for (int mi = 0; mi < 2; ++mi) {
            const int m = mrow + mi * 32;
#pragma unroll
            for (int ni = 0; ni < 4; ++ni) {
                const int nb = ncol + ni * 32;
                if (nb >= DIN) continue;
                if (nb >= O1 && nb < O1 + 384 && m < TL) {
                    const int s = m & (S - 1); const int pos = (ni & 1) == 0 ? (s >> 6) : (s & 63);
                    const int jb = (nb & 31);
#pragma unroll
                    for (int r = 0; r < 8; ++r) {
                        const int j = jb + (r & 3) + 8 * (r >> 2);
                        const float cs = rope[(pos * 16 + j) * 2], sn = rope[(pos * 16 + j) * 2 + 1];
                        const float x1 = acc[mi][ni][r], x2 = acc[mi][ni][r + 8];
                        acc[mi][ni][r] = x1 * cs - x2 * sn; acc[mi][ni][r + 8] = x1 * sn + x2 * cs;
                    }
                }
#pragma unroll
                for (int g = 0; g < 4; ++g) {
                    const int n = nb + 8 * g;
                    if (n < DIN) { u32x2 v; v.x = pack_bf16(acc[mi][ni][4 * g], acc[mi][ni][4 * g + 1]); v.y = pack_bf16(acc[mi][ni][4 * g + 2], acc[mi][ni][4 * g + 3]); *(u32x2*)(p + (size_t)m * DIN + n) = v; }
                }
            }
        }
    }
};
struct EpiOutProjH {
    float* xr; const float* mod;
    __device__ __forceinline__ void operator()(f32x16 (&acc)[2][4], int mrow, int ncol) const {
#pragma unroll
        for (int mi = 0; mi < 2; ++mi) {
            const int m = mrow + mi * 32; const int rb = m < TL ? m / S : 8;
            const float* g1 = mod + (size_t)rb * 6144 + 2 * D;
#pragma unroll
            for (int ni = 0; ni < 4; ++ni)
#pragma unroll
                for (int g = 0; g < 4; ++g) {
                    const int n = ncol + ni * 32 + 8 * g;
                    f32x4 gv = *(const f32x4*)(g1 + n); float* xp = xr + (size_t)m * D + n; f32x4 xv = *(const f32x4*)xp;
                    xv[0] += gv[0] * acc[mi][ni][4 * g]; xv[1] += gv[1] * acc[mi][ni][4 * g + 1]; xv[2] += gv[2] * acc[mi][ni][4 * g + 2]; xv[3] += gv[3] * acc[mi][ni][4 * g + 3];
                    *(f32x4*)xp = xv;
                }
        }
    }
};
struct EpiOutProj {
    float* xr; const float* mod; const float* xin; const float* cin;
    __device__ __forceinline__ void operator()(f32x16 (&acc)[2][2], int mrow, int ncol) const {
#pragma unroll
        for (int mi = 0; mi < 2; ++mi) {
            const int m = mrow + mi * 32; const int rb = m < TL ? m / S : 8;
            const float* g1 = mod + (size_t)rb * 6144 + 2 * D;
            const float* src = xin ? (m < TL ? xin + (size_t)m * D : cin + (size_t)(m - TL) * D) : xr + (size_t)m * D;
#pragma unroll
            for (int ni = 0; ni < 2; ++ni)
#pragma unroll
                for (int g = 0; g < 4; ++g) {
                    const int n = ncol + ni * 32 + 8 * g;
                    f32x4 gv = *(const f32x4*)(g1 + n); f32x4 xv = *(const f32x4*)(src + n);
                    xv[0] += gv[0] * acc[mi][ni][4 * g]; xv[1] += gv[1] * acc[mi][ni][4 * g + 1]; xv[2] += gv[2] * acc[mi][ni][4 * g + 2]; xv[3] += gv[3] * acc[mi][ni][4 * g + 3];
                    *(f32x4*)(xr + (size_t)m * D + n) = xv;
                }
        }
    }
};
#endif
#ifndef HOST_SIM
template <class NMap>
__device__ __forceinline__ void cvt_tile(char* lds, const float* __restrict__ src, int srcN, bf16* __restrict__ dst, int dstK, int k0, int n0, int nvalid  , int nrows  , const NMap& nmap) {
    int tid = threadIdx.x; asm volatile("" : "+v"(tid));
    bf16* t = (bf16*)lds;
    __syncthreads();
#pragma unroll
    for (int i = 0; i < 2; ++i) {
        const int c = tid + i * NTHREADS, k = c >> 4, n4 = (c & 15) * 4;
        f32x4 v = {0.f, 0.f, 0.f, 0.f};
        if (n0 + n4 < nvalid) v = *(const f32x4*)(src + (size_t)(k0 + k) * srcN + n0 + n4);
#pragma unroll
        for (int q = 0; q < 4; ++q) t[(n4 + q) * 66 + k] = f2bf(v[q]);
    }
    __syncthreads();
    {
        const int n = tid >> 3, kc = tid & 7;
        if (n0 + n < nrows) {
            const unsigned* s = (const unsigned*)(t + n * 66 + kc * 8);
            u32x4 o; o.x = s[0]; o.y = s[1]; o.z = s[2]; o.w = s[3];
            *(u32x4*)(dst + (size_t)nmap(n0 + n) * dstK + k0 + kc * 8) = o;
        }
    }
}

template <class NMap>
__device__ __forceinline__ void cvt_strip(char* lds, const float* __restrict__ src, int srcN, bf16* __restrict__ dst, int dstK, int k0, int n0, int nvalid, int nrows, const NMap& nmap) {
    int tid = threadIdx.x; asm volatile("" : "+v"(tid));
    bf16* t = (bf16*)lds;
    __syncthreads();
    f32x4 v[8];
#pragma unroll
    for (int i = 0; i < 8; ++i) {
        const int c = tid + i * NTHREADS, k = c >> 6, n4 = (c & 63) * 4;
        v[i] = (f32x4){0.f, 0.f, 0.f, 0.f};
        if (n0 + n4 < nvalid) v[i] = *(const f32x4*)(src + (size_t)(k0 + k) * srcN + n0 + n4);
    }
#pragma unroll
    for (int i = 0; i < 8; ++i) {
        const int c = tid + i * NTHREADS, k = c >> 6, n4 = (c & 63) * 4;
#pragma unroll
        for (int q = 0; q < 4; ++q) t[(n4 + q) * 66 + k] = f2bf(v[i][q]);
    }
    __syncthreads();
#pragma unroll
    for (int i = 0; i < 4; ++i) {
        const int n = (tid >> 3) + i * 64, kc = tid & 7;
        if (n0 + n < nrows) {
            const unsigned* s = (const unsigned*)(t + n * 66 + kc * 8);
            u32x4 o; o.x = s[0]; o.y = s[1]; o.z = s[2]; o.w = s[3];
            *(u32x4*)(dst + (size_t)nmap(n0 + n) * dstK + k0 + kc * 8) = o;
        }
    }
}
struct NMapId { __device__ __forceinline__ int operator()(int n) const { return n; } };
struct NMapUp { int which; __device__ __forceinline__ int operator()(int j) const { return (j >> 7) * 256 + ((j >> 6) & 1) * 128 + which * 64 + (j & 63); } };
#endif
#ifndef HOST_SIM
__device__ __forceinline__ float wave_sum(float v) {
#pragma unroll
    for (int o = 32; o > 0; o >>= 1) v += __shfl_xor(v, o);
    return v;
}
template <int MODE, int NORM>
__device__ __forceinline__ void row_pass(const WS& w, const Inputs& in, int ntok, const float* mod_cur  , const float* mod_nrm  ,
                                         const float* gnorm, int shc, int scc, const bf16* y, const float* topw, float* out, bf16* hout, int t_first = -1, int t_end = 0, int t_step = 0) {
    int tid = threadIdx.x; asm volatile("" : "+v"(tid));
    const int lane = tid & 63, wv = tid >> 6;
    if (t_first < 0) { t_first = blockIdx.x * 8 + wv; t_end = ntok; t_step = gridDim.x * 8; }
    for (int t = t_first; t < t_end; t += t_step) {
        const int rb = t < TL ? t / S : 8;
        f32x4 v[4];
        float* xrow = w.xr + (size_t)t * D;
        if (MODE == 0 || MODE == 3) {
            const float* src = t < TL ? in.x + (size_t)t * D : in.ctx + (size_t)(t - TL) * D;
#pragma unroll
            for (int j = 0; j < 4; ++j) { v[j] = *(const f32x4*)(src + j * 256 + lane * 4); if (MODE == 0) st_wt16(xrow + j * 256 + lane * 4, v[j]); }
        } else {
#pragma unroll
            for (int j = 0; j < 4; ++j) v[j] = *(const f32x4*)(xrow + j * 256 + lane * 4);
        }
        if (MODE == 2) {
            const float* g2 = mod_cur + (size_t)rb * 6144 + 5 * D;
            f32x4 f[4];
#pragma unroll
            for (int j = 0; j < 4; ++j) f[j] = (f32x4){0.f, 0.f, 0.f, 0.f};
#pragma unroll
            for (int k = 0; k < 4; ++k) {
                const float wk = topw[(size_t)t * 4 + k]; const bf16* yr = y + ((size_t)t * 4 + k) * D;
#pragma unroll
                for (int j = 0; j < 4; ++j) { u32x2 u = *(const u32x2*)(yr + j * 256 + lane * 4);
                    f[j][0] += wk * __uint_as_float(u.x << 16); f[j][1] += wk * __uint_as_float(u.x & 0xffff0000u); f[j][2] += wk * __uint_as_float(u.y << 16); f[j][3] += wk * __uint_as_float(u.y & 0xffff0000u); }
            }
#pragma unroll
            for (int j = 0; j < 4; ++j) { f32x4 g = *(const f32x4*)(g2 + j * 256 + lane * 4); v[j] += g * f[j]; if (NORM != 2) st_wt16(xrow + j * 256 + lane * 4, v[j]); }
        }
        if (NORM == 0) continue;
        if (NORM == 2 && t >= TL) continue;
        float ss = 0.f;
#pragma unroll
        for (int j = 0; j < 4; ++j) ss += v[j][0] * v[j][0] + v[j][1] * v[j][1] + v[j][2] * v[j][2] + v[j][3] * v[j][3];
        ss = wave_sum(ss);
        const float rstd = 1.0f / sqrtf(ss * (1.0f / D) + EPS);
        if (NORM == 1) {
            const float* m = mod_nrm + (size_t)rb * 6144;
#pragma unroll
            for (int j = 0; j < 4; ++j) {
                const int c = j * 256 + lane * 4;
                f32x4 g = *(const f32x4*)(gnorm + c), sc = *(const f32x4*)(m + scc * D + c), sh = *(const f32x4*)(m + shc * D + c);
                f32x4 hv = v[j] * rstd * g * (sc + 1.0f) + sh;
                u32x2 u; u.x = pack_bf16(hv[0], hv[1]); u.y = pack_bf16(hv[2], hv[3]);
                *(u32x2*)(hout + (size_t)t * D + c) = u;
            }
        } else {
#pragma unroll
            for (int j = 0; j < 4; ++j) { const int c = j * 256 + lane * 4; f32x4 g = *(const f32x4*)(gnorm + c); st_wt16(out + (size_t)t * D + c, v[j] * rstd * g); }
        }
    }
}

constexpr int CNT_PAD = 32;
__device__ __forceinline__ void router_rows(char* lds, const WS& w, const float* ebias, int r0, int r1, int l) {
    int tid = threadIdx.x; asm volatile("" : "+v"(tid));
    const int lane = tid & 63, wv = tid >> 6, fr = lane & 15, fq = lane >> 4;
    float* part = (float*)lds;
    float* sl = part + 8 * 80 * 33;
    float* sb = sl + 80 * 33;
    int* lcnt = (int*)(sb + 80 * 33);
    const bf16* Bt = w.wrT + (size_t)l * 32 * 1024;
    int* cnt = w.cnt + l * 32 * CNT_PAD; int* list = w.list;
    const int nrows = r1 - r0, ng = (nrows + 15) >> 4;
    if (tid < 32) lcnt[tid] = 0;
    {
        const bf16* b0 = Bt + (size_t)fr * 1024 + wv * 128 + fq * 8; const bf16* b1 = b0 + 16 * 1024;
        bf16x8 fb0[4], fb1[4];
#pragma unroll
        for (int ks = 0; ks < 4; ++ks) { fb0[ks] = *(const bf16x8*)(b0 + ks * 32); fb1[ks] = *(const bf16x8*)(b1 + ks * 32); }
        for (int g = 0; g < ng; ++g) {
            const int ra = r0 + g * 16 + fr < r1 ? r0 + g * 16 + fr : r1 - 1;
            const bf16* ar = w.h + (size_t)ra * D + wv * 128 + fq * 8;
            f32x4 a0 = {0.f, 0.f, 0.f, 0.f}, a1 = {0.f, 0.f, 0.f, 0.f};
#pragma unroll
            for (int ks = 0; ks < 4; ++ks) {
                const bf16x8 fa = *(const bf16x8*)(ar + ks * 32);
                a0 = __builtin_amdgcn_mfma_f32_16x16x32_bf16(fa, fb0[ks], a0, 0, 0, 0);
                a1 = __builtin_amdgcn_mfma_f32_16x16x32_bf16(fa, fb1[ks], a1, 0, 0, 0);
            }
            float* pp = part + (wv * 80 + g * 16) * 33;
#pragma unroll
            for (int j = 0; j < 4; ++j) { pp[(4 * fq + j) * 33 + fr] = a0[j]; pp[(4 * fq + j) * 33 + 16 + fr] = a1[j]; }
        }
    }
    __syncthreads();
    for (int i = tid; i < ng * 16 * 32; i += NTHREADS) {
        const int row = i >> 5, e = i & 31; float s = 0.f;
#pragma unroll
        for (int q = 0; q < 8; ++q) s += part[(q * 80 + row) * 33 + e];
        const float sg = 1.0f / (1.0f + __expf(-s));
        sl[row * 33 + e] = sg; sb[row * 33 + e] = sg + ebias[e];
    }
    __syncthreads();
    int sel[4]; int lpos[4];
    const int myrow = wv * 16 + lane;
    const bool mine = lane < 16 && wv < ng && myrow < nrows;
    if (mine) {
        const int t = r0 + myrow; const float* sr = sl + myrow * 33; const float* br = sb + myrow * 33;
        float ss[4]; float sum = 0.f;
#pragma unroll
        for (int k = 0; k < 4; ++k) {
            int best = 0; float bv = -1e30f;
            for (int e = 0; e < 32; ++e) {
                bool used = false;
#pragma unroll
                for (int q = 0; q < 4; ++q) if (q < k && sel[q] == e) used = true;
                const float vv = br[e];
                if (!used && vv > bv) { bv = vv; best = e; }
            }
            sel[k] = best; ss[k] = sr[best]; sum += ss[k];
        }
        const float inv = ROUTED_SCALE / sum;
#pragma unroll
        for (int k = 0; k < 4; ++k) { w.topw[(size_t)t * 4 + k] = ss[k] * inv; lpos[k] = atomicAdd(&lcnt[sel[k]], 1); }
    }
    __syncthreads();
    if (tid < 32) lcnt[32 + tid] = atomicAdd(&cnt[tid * CNT_PAD], lcnt[tid]);
    __syncthreads();
    if (mine) {
        const int t = r0 + myrow;
#pragma unroll
        for (int k = 0; k < 4; ++k) list[(size_t)sel[k] * T + lcnt[32 + sel[k]] + lpos[k]] = t * 4 + k;
    }
    __syncthreads();
}
__device__ __forceinline__ void phase_norm2_router(char* lds, const WS& w, const Inputs& in, int ntok, const float* mod, const float* gnorm, const float* ebias, int l) {
    int rpb = (ntok + (int)gridDim.x - 1) / (int)gridDim.x; if (rpb > 80) rpb = 80;
    for (int r0 = blockIdx.x * rpb; r0 < ntok; r0 += gridDim.x * rpb) {
        const int r1 = r0 + rpb < ntok ? r0 + rpb : ntok;
        row_pass<1, 1>(w, in, ntok, mod, mod, gnorm, 3, 4, nullptr, nullptr, nullptr, w.h, r0 + (int)(threadIdx.x >> 6), r1, 8);
        asm volatile("s_waitcnt vmcnt(0)" ::: "memory");
        __syncthreads();
        router_rows(lds, w, ebias, r0, r1, l);
    }
}

__device__ __forceinline__ bool moe_decode(int tile, int NT, const int* cnt, int ntok, int& e, int& mt, int& nt, int& base, int& rows) {
    int t = tile / NT; nt = tile % NT; int b = 0;
    for (int i = 0; i < 33; ++i) {
        const int c = i < 32 ? cnt[i * CNT_PAD] : ntok; const int m = (c + GBM - 1) / GBM;
        if (t < m) { e = i; mt = t; rows = c; base = b; return true; }
        t -= m; b += c;
    }
    return false;
}
struct ARowGather {
    const bf16* A; const int* list; int rows; int r0; bool ident;
    __device__ __forceinline__ const bf16* operator()(int i) const {
        const int idx = r0 + i; int tok = 0;
        if (idx < rows) tok = ident ? idx : (list[idx] >> 2);
        return A + (size_t)tok * D;
    }
};
struct EpiUp {
    bf16* hid; int base; int rows;
    __device__ __forceinline__ void operator()(f32x16 (&acc)[2][2], int mrow, int ncol) const {
        const int hc = (ncol >> 7) * 64 + ((ncol >> 6) & 1) * 32 + (ncol & 63);
#pragma unroll
        for (int mi = 0; mi < 2; ++mi) {
            const int idx = mrow + mi * 32;
            if (idx < rows) {
#pragma unroll
                for (int g = 0; g < 4; ++g) {
                    float o[4];
#pragma unroll
                    for (int q = 0; q < 4; ++q) { const float gt = acc[mi][0][4 * g + q], up = acc[mi][1][4 * g + q]; o[q] = gt / (1.0f + expf(-gt)) * up; }
                    u32x2 v; v.x = pack_bf16(o[0], o[1]); v.y = pack_bf16(o[2], o[3]);
                    *(u32x2*)(hid + (size_t)(base + idx) * 256 + hc + 8 * g) = v;
                }
            }
        }
    }
};
struct EpiDown {
    bf16* y; const int* list; int rows; bool shared; float* xr; const float* mod;
    __device__ __forceinline__ void operator()(f32x16 (&acc)[2][2], int mrow, int ncol) const {
#pragma unroll
        for (int mi = 0; mi < 2; ++mi) {
            const int idx = mrow + mi * 32;
            if (idx < rows) {
                if (!shared) {
                    const int asg = list[idx];
#pragma unroll
                    for (int ni = 0; ni < 2; ++ni)
#pragma unroll
                        for (int g = 0; g < 4; ++g) {
                            u32x2 v; v.x = pack_bf16(acc[mi][ni][4 * g], acc[mi][ni][4 * g + 1]); v.y = pack_bf16(acc[mi][ni][4 * g + 2], acc[mi][ni][4 * g + 3]);
                            *(u32x2*)(y + (size_t)asg * D + ncol + ni * 32 + 8 * g) = v;
                        }
                } else {
                    const int rb = idx < TL ? idx / S : 8; const float* g2 = mod + (size_t)rb * 6144 + 5 * D;
#pragma unroll
                    for (int ni = 0; ni < 2; ++ni)
#pragma unroll
                        for (int g = 0; g < 4; ++g) {
                            const int n = ncol + ni * 32 + 8 * g;
                            f32x4 gv = *(const f32x4*)(g2 + n); float* xp = xr + (size_t)idx * D + n; f32x4 xv = *(const f32x4*)xp;
                            xv[0] += gv[0] * acc[mi][ni][4 * g]; xv[1] += gv[1] * acc[mi][ni][4 * g + 1]; xv[2] += gv[2] * acc[mi][ni][4 * g + 2]; xv[3] += gv[3] * acc[mi][ni][4 * g + 3];
                            *(f32x4*)xp = xv;
                        }
                }
            }
        }
    }
};
struct EpiUpH {
    bf16* hid; int base; int rows;
    __device__ __forceinline__ void operator()(f32x16 (&acc)[2][4], int mrow, int ncol  ) const {
        const int fh = (ncol >> 2) & 1; const int hc = (ncol >> 8) * 128 + ((ncol >> 7) & 1) * 64 + 8 * fh;
#pragma unroll
        for (int mi = 0; mi < 2; ++mi) {
            const int idx = mrow + mi * 32;
            if (idx < rows) {
#pragma unroll
                for (int g = 0; g < 4; ++g) {
                    float o[8];
#pragma unroll
                    for (int nh = 0; nh < 2; ++nh)
#pragma unroll
                        for (int q = 0; q < 4; ++q) { const float gt = acc[mi][nh][4 * g + q], up = acc[mi][nh + 2][4 * g + q]; o[4 * nh + q] = gt / (1.0f + __expf(-gt)) * up; }
                    u32x4 v; v.x = pack_bf16(o[0], o[1]); v.y = pack_bf16(o[2], o[3]); v.z = pack_bf16(o[4], o[5]); v.w = pack_bf16(o[6], o[7]);
                    *(u32x4*)(hid + (size_t)(base + idx) * 256 + hc + 16 * g) = v;
                }
            }
        }
    }
};
__device__ __forceinline__ int down_perm(int rho) { const int ni = rho >> 5, g = (rho >> 3) & 3, fh = (rho >> 2) & 1, q = rho & 3; return 64 * (ni >> 1) + 16 * g + 8 * fh + 4 * (ni & 1) + q; }
struct EpiDownH {
    bf16* y; const int* list; int rows; bool shared; float* xr; const float* mod;
    __device__ __forceinline__ void operator()(f32x16 (&acc)[2][4], int mrow, int ncol  ) const {
        const int nbase = (ncol & ~127), fh = (ncol >> 2) & 1;
#pragma unroll
        for (int mi = 0; mi < 2; ++mi) {
            const int idx = mrow + mi * 32;
            if (idx < rows) {
                if (!shared) {
                    const int asg = list[idx];
#pragma unroll
                    for (int hp = 0; hp < 2; ++hp)
#pragma unroll
                        for (int g = 0; g < 4; ++g) {
                            u32x4 v; v.x = pack_bf16(acc[mi][2 * hp][4 * g], acc[mi][2 * hp][4 * g + 1]); v.y = pack_bf16(acc[mi][2 * hp][4 * g + 2], acc[mi][2 * hp][4 * g + 3]);
                            v.z = pack_bf16(acc[mi][2 * hp + 1][4 * g], acc[mi][2 * hp + 1][4 * g + 1]); v.w = pack_bf16(acc[mi][2 * hp + 1][4 * g + 2], acc[mi][2 * hp + 1][4 * g + 3]);
                            *(u32x4*)(y + (size_t)asg * D + nbase + 64 * hp + 16 * g + 8 * fh) = v;
                        }
                } else {
                    const int rb = idx < TL ? idx / S : 8; const float* g2 = mod + (size_t)rb * 6144 + 5 * D;
#pragma unroll
                    for (int hp = 0; hp < 2; ++hp)
#pragma unroll
                        for (int g = 0; g < 4; ++g)
#pragma unroll
                            for (int nl = 0; nl < 2; ++nl) {
                                const int n = nbase + 64 * hp + 16 * g + 8 * fh + 4 * nl;
                                f32x4 gv = *(const f32x4*)(g2 + n); float* xp = xr + (size_t)idx * D + n; f32x4 xv = *(const f32x4*)xp;
                                xv[0] += gv[0] * acc[mi][2 * hp + nl][4 * g]; xv[1] += gv[1] * acc[mi][2 * hp + nl][4 * g + 1]; xv[2] += gv[2] * acc[mi][2 * hp + nl][4 * g + 2]; xv[3] += gv[3] * acc[mi][2 * hp + nl][4 * g + 3];
                                *(f32x4*)xp = xv;
                            }
                }
            }
        }
    }
};
struct TLMoeUp {
    const WS* w; const int* cnt; int ntok; static constexpr int K = 1024;
    struct Tile { int e, mt, nt, base, rows; };
    __device__ __forceinline__ bool tile(int idx, Tile& t) const { return moe_decode(idx, 2, cnt, ntok, t.e, t.mt, t.nt, t.base, t.rows); }
    __device__ __forceinline__ unsigned active(const Tile&, int) const { return 15u; }
    __device__ __forceinline__ const bf16* arow(const Tile& t, int r) const {
        const int i = t.mt * GBM + r; int tok = 0;
        if (i < t.rows) tok = t.e == 32 ? i : (w->list[(size_t)t.e * T + i] >> 2);
        return w->h + (size_t)tok * D;
    }
    __device__ __forceinline__ const bf16* brow(const Tile& t, int r) const { return w->moeUpT + ((size_t)t.e * 512 + t.nt * 256 + (r & ~63) + perm64(r & 63)) * 1024; }
    __device__ __forceinline__ void epi(const Tile& t, f32x16 (&acc)[2][4], int mr, int nc) const { EpiUpH{w->hid2, t.base, t.rows}(acc, t.mt * GBM + mr, t.nt * 256 + nc); }
};
struct TLMoeDown {
    const WS* w; const int* cnt; int ntok; const float* mod; static constexpr int K = 256;
    struct Tile { int e, mt, nt, base, rows; };
    __device__ __forceinline__ bool tile(int idx, Tile& t) const { return moe_decode(idx, 4, cnt, ntok, t.e, t.mt, t.nt, t.base, t.rows); }
    __device__ __forceinline__ unsigned active(const Tile&, int) const { return 15u; }
    __device__ __forceinline__ const bf16* arow(const Tile& t, int r) const { return w->hid2 + (size_t)(t.base + t.mt * GBM + r) * 256; }
    __device__ __forceinline__ const bf16* brow(const Tile& t, int r) const { return w->moeDownT + ((size_t)t.e * 1024 + t.nt * 256 + (r & 128) + down_perm(r & 127)) * 256; }
    __device__ __forceinline__ void epi(const Tile& t, f32x16 (&acc)[2][4], int mr, int nc) const {
        EpiDownH{(bf16*)w->h, w->list + (size_t)t.e * T, t.rows, t.e == 32, w->xr, mod}(acc, t.mt * GBM + mr, t.nt * 256 + nc);
    }
};
struct TLMoeDownR : TLMoeDown {
    __device__ __forceinline__ bool tile(int idx, Tile& t) const { return moe_decode(idx, 4, cnt, ntok, t.e, t.mt, t.nt, t.base, t.rows) && t.e < 32; }
};
__device__ __forceinline__ void phase_moe_down_routed(char* lds, const WS& w, int l, int ntok, const float* mod) { TLMoeDownR tl; tl.w = &w; tl.cnt = w.cnt + l * 32 * CNT_PAD; tl.ntok = ntok; tl.mod = mod; gemm_stream256(lds, tl); }
__device__ __forceinline__ void phase_moe_up(char* lds, const WS& w, int l, int ntok) { gemm_stream256(lds, TLMoeUp{&w, w.cnt + l * 32 * CNT_PAD, ntok}); }
__device__ __forceinline__ void phase_moe_down(char* lds, const WS& w, int l, int ntok, const float* mod) { gemm_stream256(lds, TLMoeDown{&w, w.cnt + l * 32 * CNT_PAD, ntok, mod}); }
#endif
#ifndef HOST_SIM
__device__ __forceinline__ void phase_ada(char* lds, const WS& w, const Inputs& in) {
    int tid = threadIdx.x; asm volatile("" : "+v"(tid));
    const int lane = tid & 63, wv = tid >> 6;
    float* sc = (float*)lds;
    float* red = sc + 9 * 1024;
    if ((int)blockIdx.x >= 192) return;
    __syncthreads();
    for (int i = tid; i < 9 * 1024; i += NTHREADS) { const int r = i >> 10, k = i & 1023; const float v = r < 8 ? in.c[(size_t)(r % B) * D + k] : in.c_ctx[k]; sc[i] = v / (1.0f + __expf(-v)); }
    __syncthreads();
    for (int it = blockIdx.x; it < 192; it += gridDim.x) {
        const int l = it / 96, n = (it % 96) * 64 + lane;
        const float* wp = in.w_ada + (size_t)l * D * 6144 + (size_t)(wv * 128) * 6144 + n;
        float acc[9];
#pragma unroll
        for (int r = 0; r < 9; ++r) acc[r] = 0.f;
        for (int kb = 0; kb < 128; kb += 16) {
            float wq[16];
#pragma unroll
            for (int i = 0; i < 16; ++i) wq[i] = wp[(size_t)(kb + i) * 6144];
#pragma unroll
            for (int r = 0; r < 9; ++r) {
                const float* sr = sc + r * 1024 + wv * 128 + kb;
#pragma unroll
                for (int i4 = 0; i4 < 4; ++i4) { const f32x4 s4 = *(const f32x4*)(sr + 4 * i4); acc[r] += s4[0] * wq[4 * i4] + s4[1] * wq[4 * i4 + 1] + s4[2] * wq[4 * i4 + 2] + s4[3] * wq[4 * i4 + 3]; }
            }
        }
#pragma unroll
        for (int r = 0; r < 9; ++r) red[(wv * 9 + r) * 64 + lane] = acc[r];
        __syncthreads();
        for (int i = tid; i < 9 * 64; i += NTHREADS) {
            const int r = i >> 6, c = i & 63; float s = 0.f;
#pragma unroll
            for (int q = 0; q < 8; ++q) s += red[(q * 9 + r) * 64 + c];
            const int nn = (it % 96) * 64 + c;
            w.mod[((size_t)l * 9 + r) * 6144 + nn] = s + in.b_ada[l * 6144 + nn];
        }
        __syncthreads();
    }
}
#endif
#ifndef HOST_SIM
typedef short s16x4 __attribute__((ext_vector_type(4)));
constexpr int AT_KV = 64 * 128;
constexpr int AT_STAGE = 2 * AT_KV;
__device__ __forceinline__ int at_voff(int key, int dcol) { return key * 128 + ((((dcol >> 5) ^ ((key >> 1) & 1))) << 6) + ((dcol & 31) << 1); }
__device__ __forceinline__ int at_kappa(int r) { return (r & ~12) | ((r & 4) << 1) | ((r & 8) >> 1); }

struct AttnState { f32x16 o[2]; float m, l; };

__device__ __forceinline__ void at_qk(const char* st, const bf16x8 (&qf)[4], f32x16 (&s)[2], int lane) {
    const int fr = lane & 31, fh = lane >> 5, kr = at_kappa(fr);
#pragma unroll
    for (int tt = 0; tt < 2; ++tt) {
#pragma unroll
        for (int r = 0; r < 16; ++r) s[tt][r] = 0.f;
#pragma unroll
        for (int ks = 0; ks < 4; ++ks) {
            const bf16x8 kf = *(const bf16x8*)(st + g_lds_off(32 * tt + kr, ks * 2 + fh));
            s[tt] = __builtin_amdgcn_mfma_f32_32x32x16_bf16(kf, qf[ks], s[tt], 0, 0, 0);
        }
    }
}
__device__ __forceinline__ void at_softmax_pv(const char* st, f32x16 (&s)[2], AttnState& a, int lane) {
    float mx = -1e30f;
#pragma unroll
    for (int tt = 0; tt < 2; ++tt)
#pragma unroll
        for (int r = 0; r < 16; ++r) mx = fmaxf(mx, s[tt][r]);
    mx = fmaxf(mx, __shfl_xor(mx, 32));
    const float mn = fmaxf(a.m, mx), alpha = __builtin_amdgcn_exp2f(a.m - mn);
    float rs = 0.f;
#pragma unroll
    for (int tt = 0; tt < 2; ++tt)
#pragma unroll
        for (int r = 0; r < 16; ++r) { const float p = __builtin_amdgcn_exp2f(s[tt][r] - mn); s[tt][r] = p; rs += p; }
    rs += __shfl_xor(rs, 32);
    a.l = a.l * alpha + rs;
    if (__builtin_amdgcn_ballot_w64(mn > a.m) != 0ull) {
#pragma unroll
        for (int dt = 0; dt < 2; ++dt)
#pragma unroll
            for (int r = 0; r < 16; ++r) a.o[dt][r] *= alpha;
    }
    a.m = mn;
    const int fh = lane >> 5, i16 = lane & 15, g1 = (lane >> 4) & 1;
    const char* vb = st + AT_KV;
#pragma unroll
    for (int tt = 0; tt < 2; ++tt)
#pragma unroll
        for (int sp = 0; sp < 2; ++sp) {
            union { bf16x8 v; unsigned u[4]; } pu;
#pragma unroll
            for (int j = 0; j < 4; ++j) pu.u[j] = pack_bf16(s[tt][8 * sp + 2 * j], s[tt][8 * sp + 2 * j + 1]);
            const bf16x8 pf = pu.v;
#pragma unroll
            for (int dt = 0; dt < 2; ++dt) {
                const int kb = 32 * tt + 16 * sp + 8 * fh + (i16 >> 2), dc = 32 * dt + 16 * g1 + 4 * (i16 & 3);
                const s16x4 v0 = __builtin_amdgcn_ds_read_tr16_b64_v4i16((LAS s16x4*)(vb + at_voff(kb, dc)));
                const s16x4 v1 = __builtin_amdgcn_ds_read_tr16_b64_v4i16((LAS s16x4*)(vb + at_voff(kb + 4, dc)));
                bf16x8 vf; vf[0] = v0[0]; vf[1] = v0[1]; vf[2] = v0[2]; vf[3] = v0[3]; vf[4] = v1[0]; vf[5] = v1[1]; vf[6] = v1[2]; vf[7] = v1[3];
                a.o[dt] = __builtin_amdgcn_mfma_f32_32x32x16_bf16(vf, pf, a.o[dt], 0, 0, 0);
            }
        }
}
__device__ __forceinline__ void at_store(const AttnState& a, bf16* orow  , int lane) {
    const float il = 1.0f / a.l; const int fh = lane >> 5;
#pragma unroll
    for (int dt = 0; dt < 2; ++dt)
#pragma unroll
        for (int g = 0; g < 4; ++g) {
            u32x2 v; v.x = pack_bf16(a.o[dt][4 * g] * il, a.o[dt][4 * g + 1] * il); v.y = pack_bf16(a.o[dt][4 * g + 2] * il, a.o[dt][4 * g + 3] * il);
            *(u32x2*)(orow + 32 * dt + 8 * g + 4 * fh) = v;
        }
}
struct AtRegs { u32x4 k, v; };
__device__ __forceinline__ AtRegs at_load(const bf16* kbase, const bf16* vbase, int tid) {
    const int key = tid >> 3, c = tid & 7; AtRegs r;
    r.k = *(const u32x4*)(kbase + (size_t)key * DIN + c * 8); r.v = *(const u32x4*)(vbase + (size_t)key * DIN + c * 8); return r;
}
__device__ __forceinline__ void at_write(char* st, const AtRegs& r, int tid) {
    const int key = tid >> 3, c = tid & 7;
    *(u32x4*)(st + g_lds_off(key, c)) = r.k; *(u32x4*)(st + AT_KV + at_voff(key, c * 8)) = r.v;
}
__device__ __forceinline__ void at_dma(char* st, const bf16* kbase, int voff, int wid, int lane) {
    const int r = 8 * wid + (lane >> 3), pos = lane & 7;
    const bf16* kr = kbase + (size_t)r * DIN;
    const int ck = pos ^ ((r >> 1) & 7), cv = 4 * ((pos >> 2) ^ ((r >> 1) & 1)) + (pos & 3);
    __builtin_amdgcn_global_load_lds((const unsigned*)(kr + 8 * ck), (LAS unsigned*)(st + wid * 1024), 16, 0, 0);
    __builtin_amdgcn_global_load_lds((const unsigned*)(kr + voff + 8 * cv), (LAS unsigned*)(st + AT_KV + wid * 1024), 16, 0, 0);
}
#define AT_WAIT(n) asm volatile("s_waitcnt vmcnt(" #n ")" ::: "memory")
__device__ __forceinline__ void at_wait_tile(int remaining_after  ) {
    if (remaining_after >= 2) AT_WAIT(4); else if (remaining_after == 1) AT_WAIT(2); else AT_WAIT(0);
    __builtin_amdgcn_s_barrier();
    asm volatile("" ::: "memory");
}
constexpr int AT_RING = 4;
__device__ __forceinline__ void at_loadq(bf16x8 (&qf)[4], const bf16* qrow, int lane) {
    const int fh = lane >> 5;
#pragma unroll
    for (int ks = 0; ks < 4; ++ks) qf[ks] = *(const bf16x8*)(qrow + ks * 16 + fh * 8);
}
__device__ __forceinline__ int at_key(int tt, int r, int fh) { return 32 * tt + (r & 3) + 8 * fh + 4 * ((r >> 2) & 1) + 16 * (r >> 3); }

__device__ __forceinline__ void attn_wa_item(char* lds, const bf16* p, bf16* ycat, const float* sink, int b, int hk, int qb, bool ctxq) {
    int tid = threadIdx.x; asm volatile("" : "+v"(tid));
    const int lane = tid & 63, wv = tid >> 6, fr = lane & 31, fh = lane >> 5;
    const int hq = 2 * hk + (wv >> 2);
    const int qpos = qb * 128 + (wv & 3) * 32 + fr;
    const size_t qtok = ctxq ? (size_t)TL + (size_t)b * LC + qpos : (size_t)b * S + qpos;
    bf16x8 qf[4]; at_loadq(qf, p + qtok * DIN + O1 + hq * 64, lane);
    AttnState a;
#pragma unroll
    for (int dt = 0; dt < 2; ++dt)
#pragma unroll
        for (int r = 0; r < 16; ++r) a.o[dt][r] = 0.f;
    a.m = sink[hq] * 1.4426950408889634f; a.l = 1.0f;
    int lo = qb * 128 - 128, hi = qb * 128 + 256; if (lo < 0) lo = 0; if (hi > S) hi = S;
    const int nloc = ctxq ? 0 : (hi - lo) / 64, nt = 4 + nloc;
    const bf16* kc = p + ((size_t)TL + (size_t)b * LC) * DIN + O1 + 256 + hk * 64;
    const bf16* kl = p + ((size_t)b * S + lo) * DIN + O1 + 256 + hk * 64;
    const int wid = __builtin_amdgcn_readfirstlane(wv);
    asm volatile("s_waitcnt vmcnt(0)" ::: "memory");
    __syncthreads();
#define AT_TILE_K(i_) ((i_) < 4 ? kc + (size_t)(i_) * 64 * DIN : kl + (size_t)((i_) - 4) * 64 * DIN)
    for (int i = 0; i < 3 && i < nt; ++i) at_dma(lds + i * AT_STAGE, AT_TILE_K(i), 128, wid, lane);
    for (int i = 0; i < nt; ++i) {
        const char* st = lds + (i & 3) * AT_STAGE;
        at_wait_tile(nt - 1 - i);
        if (i + 3 < nt) at_dma(lds + ((i + 3) & 3) * AT_STAGE, AT_TILE_K(i + 3), 128, wid, lane);
        if (i >= 4) { const int kb0w = lo + (i - 4) * 64, q0w = qb * 128 + (wv & 3) * 32; if (kb0w + 63 < q0w - WINDOW || kb0w > q0w + 31 + WINDOW) continue; }
        f32x16 s[2]; at_qk(st, qf, s, lane);
        if (i < 4) {
#pragma unroll
            for (int tt = 0; tt < 2; ++tt)
#pragma unroll
                for (int r = 0; r < 16; ++r) s[tt][r] *= 0.125f * 1.4426950408889634f;
        } else {
            const int kb0 = lo + (i - 4) * 64, q0w = qb * 128 + (wv & 3) * 32;
            if (kb0 >= q0w + 31 - WINDOW && kb0 + 63 <= q0w + WINDOW) {
#pragma unroll
                for (int tt = 0; tt < 2; ++tt)
#pragma unroll
                    for (int r = 0; r < 16; ++r) s[tt][r] *= 0.125f * 1.4426950408889634f;
            } else {
#pragma unroll
                for (int tt = 0; tt < 2; ++tt)
#pragma unroll
                    for (int r = 0; r < 16; ++r) { const int d = kb0 + at_key(tt, r, fh) - qpos; s[tt][r] = (d >= -WINDOW && d <= WINDOW) ? s[tt][r] * (0.125f * 1.4426950408889634f) : -1e30f; }
            }
        }
        at_softmax_pv(st, s, a, lane);
    }
    at_store(a, ycat + qtok * 1024 + 256 + hq * 64, lane);
}
__device__ __forceinline__ void attn_na_item(char* lds, const bf16* p, bf16* ycat, const float* rpb  , int b, int h, int rg4, bool ctxq) {
    int tid = threadIdx.x; asm volatile("" : "+v"(tid));
    const int lane = tid & 63, wv = tid >> 6, fr = lane & 31, fh = lane >> 5;
    const int r = rg4 * 4 + (wv >> 1), cq = (wv & 1) * 32 + fr;
    const size_t qtok = ctxq ? (size_t)TL + (size_t)b * LC + wv * 32 + fr : (size_t)b * S + r * 64 + cq;
    bf16x8 qf[4]; at_loadq(qf, p + qtok * DIN + O2 + h * 64, lane);
    AttnState a;
#pragma unroll
    for (int dt = 0; dt < 2; ++dt)
#pragma unroll
        for (int rr = 0; rr < 16; ++rr) a.o[dt][rr] = 0.f;
    a.m = -1e30f; a.l = 0.f;
    constexpr int ROWS = S / GRID_W;
    int klo = rg4 * 4 - 4; if (klo < 0) klo = 0; int khi = rg4 * 4 + 3 - 4; if (khi < 0) khi = 0; if (khi > ROWS - NA_KR) khi = ROWS - NA_KR; khi += NA_KR;
    if (klo > ROWS - NA_KR) klo = ROWS - NA_KR;
    const int nloc = ctxq ? 0 : khi - klo, nt = 4 + nloc;
    int myr0 = r - 4; myr0 = myr0 < 0 ? 0 : (myr0 > ROWS - NA_KR ? ROWS - NA_KR : myr0);
    int c0 = cq - 8; c0 = c0 < 0 ? 0 : (c0 > GRID_W - NA_KC ? GRID_W - NA_KC : c0);
    const bf16* kc = p + ((size_t)TL + (size_t)b * LC) * DIN + O2 + 256 + h * 64;
    const bf16* kl = p + ((size_t)b * S + (size_t)klo * 64) * DIN + O2 + 256 + h * 64;
    float* bl = (float*)(lds + AT_RING * AT_STAGE);
    __syncthreads();
    const int wid = __builtin_amdgcn_readfirstlane(wv);
    if (tid < 15 * 31) bl[(tid / 31) * 32 + (tid % 31)] = rpb[h * 15 * 31 + tid];
    asm volatile("s_waitcnt vmcnt(0) lgkmcnt(0)" ::: "memory");
    for (int i = 0; i < 3 && i < nt; ++i) at_dma(lds + i * AT_STAGE, AT_TILE_K(i), 256, wid, lane);
    for (int i = 0; i < nt; ++i) {
        const char* st = lds + (i & 3) * AT_STAGE;
        at_wait_tile(nt - 1 - i);
        if (i + 3 < nt) at_dma(lds + ((i + 3) & 3) * AT_STAGE, AT_TILE_K(i + 3), 256, wid, lane);
        const int krow = klo + (i - 4);
        const bool act = i < 4 || (krow >= myr0 && krow < myr0 + NA_KR);
        if (act) {
            f32x16 s[2]; at_qk(st, qf, s, lane);
            if (i < 4) {
#pragma unroll
                for (int tt = 0; tt < 2; ++tt)
#pragma unroll
                    for (int rr = 0; rr < 16; ++rr) s[tt][rr] *= 0.125f * 1.4426950408889634f;
            } else {
                const float* brow = bl + (krow - r + 7) * 32 + 15 - cq;
#pragma unroll
                for (int tt = 0; tt < 2; ++tt)
#pragma unroll
                    for (int rr = 0; rr < 16; ++rr) { const int kcol = at_key(tt, rr, fh); const bool ok = kcol >= c0 && kcol < c0 + NA_KC;
                        const float bias = ok ? brow[kcol] : 0.f; s[tt][rr] = ok ? (s[tt][rr] * 0.125f + bias) * 1.4426950408889634f : -1e30f; }
            }
            at_softmax_pv(st, s, a, lane);
        }
    }
    at_store(a, ycat + qtok * 1024 + 512 + h * 64, lane);
}
__device__ __forceinline__ void attn_item(char* lds, const WS& w, const Inputs& in, int l, int it) {
    if (it < 256) attn_wa_item(lds, w.p, w.ycat, in.wa_sink + l * 4, it >> 5, (it >> 4) & 1, it & 15, false);
    else if (it < 512) { const int j = it - 256; attn_na_item(lds, w.p, w.ycat, in.na_rpb + l * 4 * 15 * 31, j >> 5, (j >> 3) & 3, j & 7, false); }
    else if (it < 544) { const int j = it - 512; attn_wa_item(lds, w.p, w.ycat, in.wa_sink + l * 4, j >> 2, (j >> 1) & 1, j & 1, true); }
    else { const int j = it - 544; attn_na_item(lds, w.p, w.ycat, in.na_rpb + l * 4 * 15 * 31, j >> 2, j & 3, 0, true); }
}
#endif
#ifndef HOST_SIM
__device__ __forceinline__ float hy_c3(const bf16* pr, int tin, int col, const float* cw) {
    float acc = cw[768 + col] * bf2f(pr[col]);
    if (tin > 0) acc += cw[col] * bf2f(pr[col - DIN]);
    if (tin < S - 1) acc += cw[2 * 768 + col] * bf2f(pr[col + DIN]);
    return acc;
}
__device__ __forceinline__ void hy_prep_item(char* lds, const bf16* p, const float* cw, bf16* x0T, bf16* uvT, int b, int ch, bool ctx = false) {
    int tid = threadIdx.x; asm volatile("" : "+v"(tid));
    bf16* lx = (bf16*)lds;
    bf16* lu = lx + 256 * 72;
    __syncthreads();
    const int tl = tid & 63, cg = tid >> 6;
    const int L = ctx ? LC : S; const int tin = ch * 64 + tl; const bf16* pr = p + ((ctx ? (size_t)TL + (size_t)b * LC : (size_t)b * S) + tin) * DIN;
    for (int it = 0; it < 4; ++it) {
        const int c0 = (it * 8 + cg) * 8;
        float x0[8], x1[8], vv[8];
#pragma unroll
        for (int q = 0; q < 8; ++q) { x0[q] = 0.f; x1[q] = 0.f; vv[q] = 0.f; }
#pragma unroll
        for (int dr = -1; dr <= 1; ++dr) {
            if (tin + dr < 0 || tin + dr >= L) continue;
            const bf16* r = pr + (ptrdiff_t)dr * DIN;
            const u32x4 a = *(const u32x4*)(r + c0), bq = *(const u32x4*)(r + 256 + c0), cq = *(const u32x4*)(r + 512 + c0);
            const float* w0 = cw + (dr + 1) * 768;
#pragma unroll
            for (int q = 0; q < 4; ++q) {
                x0[2 * q] += w0[c0 + 2 * q] * __uint_as_float(a[q] << 16); x0[2 * q + 1] += w0[c0 + 2 * q + 1] * __uint_as_float(a[q] & 0xffff0000u);
                x1[2 * q] += w0[256 + c0 + 2 * q] * __uint_as_float(bq[q] << 16); x1[2 * q + 1] += w0[256 + c0 + 2 * q + 1] * __uint_as_float(bq[q] & 0xffff0000u);
                vv[2 * q] += w0[512 + c0 + 2 * q] * __uint_as_float(cq[q] << 16); vv[2 * q + 1] += w0[512 + c0 + 2 * q + 1] * __uint_as_float(cq[q] & 0xffff0000u);
            }
        }
#pragma unroll
        for (int q = 0; q < 8; ++q) { lx[(c0 + q) * 72 + tl] = f2bf(x0[q]); lu[(c0 + q) * 72 + tl] = f2bf(x1[q] * vv[q]); }
    }
    __syncthreads();
    for (int i = tid; i < 2048; i += NTHREADS) {
        const int c = i >> 3, k = i & 7;
        const size_t g = ((size_t)c * B + b) * L + ch * 64 + k * 8;
        *(u32x4*)(x0T + g) = *(const u32x4*)(lx + c * 72 + k * 8);
        *(u32x4*)(uvT + g) = *(const u32x4*)(lu + c * 72 + k * 8);
    }
}
constexpr int HY_NOFF = 2072, HY_NE = 4128, HY_CS = HY_NE * 2 + 32;
constexpr int HY_URS = S * 2 + 16;
constexpr int HY_LDS_U = 8 * HY_CS, HY_LDS_Z = HY_LDS_U + 8 * HY_URS, HY_LDS_REV = HY_LDS_Z + 64, HY_LDS_END0 = HY_LDS_REV + (HY_NE + 8) * 2;
constexpr int HC_NOFF = 280, HC_NE = 544, HC_CS = HC_NE * 2 + 32, HC_URS = LC * 2 + 16;
constexpr int HC_LDS_C = (HY_LDS_END0 + 15) & ~15, HC_LDS_U = HC_LDS_C + 8 * HC_CS, HC_LDS_REV = HC_LDS_U + 8 * HC_URS, HY_LDS_END = HC_LDS_REV + (HC_NE + 8) * 2;
__device__ __forceinline__ void hy_conv_item(char* lds, const float* filtT, const float* hbias, const bf16* uvT, bf16* x0T  , int c, const bf16* uvTc = nullptr, bf16* x0Tc = nullptr) {
    static_assert(B == 8, "hyena conv assumes batch 8");
    int tid = threadIdx.x; asm volatile("" : "+v"(tid));
    const int lane = tid & 63, wv = tid >> 6, fr = lane & 31, fh = lane >> 5;
    bf16* rev = (bf16*)(lds + HY_LDS_REV);
    __syncthreads();
    const float* hf = filtT + (size_t)c * (S + LC); const float* hb = filtT + (size_t)(256 + c) * (S + LC);
    for (int e = tid; e < HY_NE + 8; e += NTHREADS) {
        const int n = e - HY_NOFF; float v = 0.f;
        if (n > 0 && n < S) v = hb[n]; else if (n <= 0 && n > -S) v = hf[-n];
        rev[e] = f2bf(v);
    }
    for (int i = tid; i < 8 * 256; i += NTHREADS) { const int bb = i >> 8, k = i & 255; *(u32x4*)(lds + HY_LDS_U + bb * HY_URS + k * 16) = *(const u32x4*)(uvT + ((size_t)c * B + bb) * S + k * 8); }
    if (tid < 4) ((unsigned*)(lds + HY_LDS_Z))[tid] = 0u;
    bf16* revc = (bf16*)(lds + HC_LDS_REV);
    if (uvTc) {
        for (int e = tid; e < HC_NE + 8; e += NTHREADS) { const int n = e - HC_NOFF; float v = 0.f; if (n > 0 && n < LC) v = hb[S + n]; else if (n <= 0 && n > -LC) v = hf[S - n]; revc[e] = f2bf(v); }
        for (int i = tid; i < 8 * 32; i += NTHREADS) { const int bb = i >> 5, k = i & 31; *(u32x4*)(lds + HC_LDS_U + bb * HC_URS + k * 16) = *(const u32x4*)(uvTc + ((size_t)c * B + bb) * LC + k * 8); }
    }
    __syncthreads();
    if (uvTc) for (int i = tid; i < 8 * (HC_NE / 2); i += NTHREADS) { const int m = i / (HC_NE / 2), d = i % (HC_NE / 2); const unsigned lo = revc[2 * d + m], hi = revc[2 * d + 1 + m]; *(unsigned*)(lds + HC_LDS_C + m * HC_CS + d * 4) = lo | (hi << 16); }
    {
        const unsigned* rdw = (const unsigned*)rev;
#pragma unroll
        for (int m = 0; m < 8; ++m)
            for (int d = tid; d < HY_NE / 2; d += NTHREADS) {
                unsigned v;
                if ((m & 1) == 0) v = rdw[d + (m >> 1)];
                else { const unsigned a = rdw[d + (m >> 1)], b = rdw[d + (m >> 1) + 1]; v = (a >> 16) | (b << 16); }
                *(unsigned*)(lds + m * HY_CS + d * 4) = v;
            }
    }
    __syncthreads();
    f32x16 acc[2];
#pragma unroll
    for (int q = 0; q < 2; ++q)
#pragma unroll
        for (int r = 0; r < 16; ++r) acc[q][r] = 0.f;
    const int bb = fr >> 2, pp = fr & 3;
    const int m = (-fr) & 7;
    const char* abase = lds + m * HY_CS;
    const char* ubase = lds + HY_LDS_U + bb * HY_URS + fh * 16;
    auto hstep = [&](int dl, bool a0, bool a1) {
        const int n0 = 8 * fh - fr - 16 * dl;
        const bf16x8 af = *(const bf16x8*)(abase + (n0 - m + HY_NOFF) * 2);
        if (a0) { const int sj = 16 * wv - dl + 2 * pp; const char* up = (sj >= 0 && sj < 128) ? ubase + sj * 32 : lds + HY_LDS_Z;
            acc[0] = __builtin_amdgcn_mfma_f32_32x32x16_bf16(af, *(const bf16x8*)up, acc[0], 0, 0, 0); }
        if (a1) { const int sj = 16 * wv + 8 - dl + 2 * pp; const char* up = (sj >= 0 && sj < 128) ? ubase + sj * 32 : lds + HY_LDS_Z;
            acc[1] = __builtin_amdgcn_mfma_f32_32x32x16_bf16(af, *(const bf16x8*)up, acc[1], 0, 0, 0); }
    };
#pragma unroll
    for (int dl = 16 * wv - 127; dl < 16 * wv - 119; ++dl) hstep(dl, true, false);
#pragma unroll 6
    for (int dl = 16 * wv - 119; dl <= 16 * wv + 6; ++dl) hstep(dl, true, true);
#pragma unroll
    for (int dl = 16 * wv + 7; dl <= 16 * wv + 14; ++dl) hstep(dl, false, true);
    const float hbc = hbias[c];
#pragma unroll
    for (int qq = 0; qq < 2; ++qq) {
        const int tb = 32 * (4 * (2 * wv + qq) + pp) + 4 * fh;
#pragma unroll
        for (int g = 0; g < 4; ++g) {
            const int t = tb + 8 * g;
            const u32x2 uu = *(const u32x2*)(lds + HY_LDS_U + bb * HY_URS + t * 2);
            bf16* xp = x0T + ((size_t)c * B + bb) * S + t; const u32x2 xx = *(const u32x2*)xp;
            const float u0 = __uint_as_float(uu.x << 16), u1 = __uint_as_float(uu.x & 0xffff0000u), u2 = __uint_as_float(uu.y << 16), u3 = __uint_as_float(uu.y & 0xffff0000u);
            const float a0 = __uint_as_float(xx.x << 16), a1 = __uint_as_float(xx.x & 0xffff0000u), a2 = __uint_as_float(xx.y << 16), a3 = __uint_as_float(xx.y & 0xffff0000u);
            u32x2 o; o.x = pack_bf16(a0 * (acc[qq][4 * g] + hbc * u0), a1 * (acc[qq][4 * g + 1] + hbc * u1)); o.y = pack_bf16(a2 * (acc[qq][4 * g + 2] + hbc * u2), a3 * (acc[qq][4 * g + 3] + hbc * u3));
            *(u32x2*)xp = o;
        }
    }
    if (uvTc && wv < 2) {
        f32x16 ac;
#pragma unroll
        for (int r = 0; r < 16; ++r) ac[r] = 0.f;
        const char* cab = lds + HC_LDS_C + m * HC_CS; const char* cub = lds + HC_LDS_U + bb * HC_URS + fh * 16;
        for (int dl = 8 * wv - 15; dl <= 8 * wv + 6; ++dl) {
            const int n0 = 8 * fh - fr - 16 * dl;
            const bf16x8 af = *(const bf16x8*)(cab + (n0 - m + HC_NOFF) * 2);
            const int sj = 8 * wv - dl + 2 * pp; const char* up = (sj >= 0 && sj < 16) ? cub + sj * 32 : lds + HY_LDS_Z;
            ac = __builtin_amdgcn_mfma_f32_32x32x16_bf16(af, *(const bf16x8*)up, ac, 0, 0, 0);
        }
        const int tb = 32 * (4 * wv + pp) + 4 * fh;
#pragma unroll
        for (int g = 0; g < 4; ++g) {
            const int t = tb + 8 * g;
            const u32x2 uu = *(const u32x2*)(lds + HC_LDS_U + bb * HC_URS + t * 2);
            bf16* xp = x0Tc + ((size_t)c * B + bb) * LC + t; const u32x2 xx = *(const u32x2*)xp;
            const float u0 = __uint_as_float(uu.x << 16), u1 = __uint_as_float(uu.x & 0xffff0000u), u2 = __uint_as_float(uu.y << 16), u3 = __uint_as_float(uu.y & 0xffff0000u);
            const float a0 = __uint_as_float(xx.x << 16), a1 = __uint_as_float(xx.x & 0xffff0000u), a2 = __uint_as_float(xx.y << 16), a3 = __uint_as_float(xx.y & 0xffff0000u);
            u32x2 o; o.x = pack_bf16(a0 * (ac[4 * g] + hbc * u0), a1 * (ac[4 * g + 1] + hbc * u1)); o.y = pack_bf16(a2 * (ac[4 * g + 2] + hbc * u2), a3 * (ac[4 * g + 3] + hbc * u3));
            *(u32x2*)xp = o;
        }
    }
}
__device__ __forceinline__ void hy_filter_mlp(char* lds, const float* w1, const float* b1, const float* w2, const float* b2, const float* freq, bf16* f2b) {
    int tid = threadIdx.x; asm volatile("" : "+v"(tid));
    const int lane = tid & 63, wv = tid >> 6;
    float* zl = (float*)lds + wv * 128;
    __syncthreads();
    const float fj = freq[lane], b1j = b1[lane], b2j = b2[lane];
    for (int tt = blockIdx.x * 8 + wv; tt < S + LC; tt += gridDim.x * 8) {
        const int L = tt < S ? S : LC, t = tt < S ? tt : tt - S;
        if (lane < 33) {
            float z;
            if (lane == 0) z = (float)t / (float)(L - 1);
            else { const int bnd = (lane - 1) & 15; const float band = 1e-4f + (float)bnd * ((15.0f - 1e-4f) / 15.0f); const float ang = (6.283185307179586f / (float)L) * (float)t * band; z = lane <= 16 ? cosf(ang) : -sinf(ang); }
            zl[lane] = z;
        }
        __builtin_amdgcn_wave_barrier(); asm volatile("s_waitcnt lgkmcnt(0)" ::: "memory");
        float acc = 0.f;
#pragma unroll
        for (int i = 0; i < 33; ++i) acc += zl[i] * w1[i * 64 + lane];
        zl[64 + lane] = sinf(fj * (acc + b1j));
        __builtin_amdgcn_wave_barrier(); asm volatile("s_waitcnt lgkmcnt(0)" ::: "memory");
        float a2 = 0.f;
#pragma unroll 16
        for (int k = 0; k < 64; ++k) a2 += zl[64 + k] * w2[k * 64 + lane];
        f2b[(size_t)tt * 64 + lane] = f2bf(sinf(fj * (a2 + b2j)));
        __builtin_amdgcn_wave_barrier(); asm volatile("s_waitcnt lgkmcnt(0)" ::: "memory");
    }
}
__device__ __forceinline__ void hy_filter_out(const bf16* w3T  , const bf16* f2b  , float* filt  ) {
    int tid = threadIdx.x; asm volatile("" : "+v"(tid));
    const int lane = tid & 63, wv = tid >> 6, fr = lane & 31, fh = lane >> 5;
    constexpr int NTT = (S + LC) / 32;
    for (int it = blockIdx.x * 8 + wv; it < 16 * NTT; it += gridDim.x * 8) {
        const int ct = it / NTT, tt0 = (it % NTT) * 32;
        f32x16 acc;
#pragma unroll
        for (int r = 0; r < 16; ++r) acc[r] = 0.f;
#pragma unroll
        for (int ks = 0; ks < 4; ++ks) {
            const bf16x8 fa = *(const bf16x8*)(w3T + (size_t)(ct * 32 + fr) * 64 + ks * 16 + fh * 8), fb = *(const bf16x8*)(f2b + (size_t)(tt0 + fr) * 64 + ks * 16 + fh * 8);
            acc = __builtin_amdgcn_mfma_f32_32x32x16_bf16(fa, fb, acc, 0, 0, 0);
        }
        const int tt = tt0 + fr; const int L = tt < S ? S : LC; const float tn = (float)(tt < S ? tt : tt - S) / (float)(L - 1);
#pragma unroll
        for (int r = 0; r < 16; ++r) {
            const int c = ct * 32 + (r & 3) + 8 * (r >> 2) + 4 * fh; const int cc = c & 255;
            const float decay = HY_DECAY_MIN + (float)cc * ((HY_DECAY_MAX - HY_DECAY_MIN) / 255.0f);
            filt[(size_t)c * (S + LC) + tt] = acc[r] * __expf(-tn * decay);
        }
    }
}
__device__ __forceinline__ void hy_fin_item(char* lds, const bf16* yT, bf16* ycat, int b, int ch, bool ctx = false) {
    int tid = threadIdx.x; asm volatile("" : "+v"(tid));
    bf16* ly = (bf16*)lds;
    __syncthreads();
    for (int i = tid; i < 2048; i += NTHREADS) {
        const int c = i >> 3, k = i & 7;
        const u32x4 v = *(const u32x4*)(yT + ((size_t)c * B + b) * (ctx ? LC : S) + ch * 64 + k * 8);
#pragma unroll
        for (int q = 0; q < 4; ++q) { ly[(k * 8 + 2 * q) * 264 + c] = (bf16)(v[q] & 0xffffu); ly[(k * 8 + 2 * q + 1) * 264 + c] = (bf16)(v[q] >> 16); }
    }
    __syncthreads();
    for (int i = tid; i < 2048; i += NTHREADS) {
        const int t = i >> 5, k = i & 31;
        *(u32x4*)(ycat + ((ctx ? (size_t)TL + (size_t)b * LC : (size_t)b * S) + ch * 64 + t) * 1024 + k * 8) = *(const u32x4*)(ly + t * 264 + k * 8);
    }
}
#endif
#ifndef HOST_SIM
constexpr int GD_NC = 36;
__device__ __forceinline__ size_t gd_tok0(int b, int cc) { return cc < 4 ? (size_t)TL + (size_t)b * LC + cc * 64 : (size_t)b * S + (size_t)(cc - 4) * 64; }

constexpr int GP_K = 0, GP_V = 8192, GP_L0 = 16384, GP_T0 = GP_L0 + 2 * 16384, GP_VB0 = GP_T0 + 2 * 8192  , GP_G = GP_VB0 + 2 * 8192  ,
              GP_SM = GP_VB0 + 4 * 8192  , GP_LB = GP_SM + 6 * 256  , GP_END = GP_LB + 2 * 2048;

__device__ __forceinline__ void gdn_pre_item(char* lds, const WS& w, const float* cw  , const float* a_log, const float* dt_bias, int b, int cc, int h) {
    int tid = threadIdx.x; asm volatile("" : "+v"(tid));
    const int lane = tid & 63, wv = tid >> 6, fr = lane & 31, fh = lane >> 5;
    const bf16* p = w.p;
    const int L = cc < 4 ? LC : S; const int tin0 = cc < 4 ? cc * 64 : (cc - 4) * 64; const size_t tok0 = gd_tok0(b, cc);
    float* sm = (float*)(lds + GP_SM);
    __syncthreads();
    {
        const int tl = tid >> 3, dg = tid & 7;
        float q8[8], k8[8], v8[8];
#pragma unroll
        for (int x = 0; x < 8; ++x) { q8[x] = 0.f; k8[x] = 0.f; v8[x] = 0.f; }
#pragma unroll
        for (int i = 0; i < 4; ++i) {
            const int tt = tin0 + tl + i - 2;
            if (tt < 0 || tt >= L) continue;
            const bf16* r = p + (tok0 + tl + i - 2) * DIN + O3 + h * 64 + dg * 8;
            const u32x4 a = *(const u32x4*)r, bq = *(const u32x4*)(r + 256), cq = *(const u32x4*)(r + 512);
            const float* wq = cw + i * 768 + h * 64 + dg * 8;
#pragma unroll
            for (int x = 0; x < 4; ++x) {
                q8[2 * x] += wq[2 * x] * __uint_as_float(a[x] << 16); q8[2 * x + 1] += wq[2 * x + 1] * __uint_as_float(a[x] & 0xffff0000u);
                k8[2 * x] += wq[256 + 2 * x] * __uint_as_float(bq[x] << 16); k8[2 * x + 1] += wq[256 + 2 * x + 1] * __uint_as_float(bq[x] & 0xffff0000u);
                v8[2 * x] += wq[512 + 2 * x] * __uint_as_float(cq[x] << 16); v8[2 * x + 1] += wq[512 + 2 * x + 1] * __uint_as_float(cq[x] & 0xffff0000u);
            }
        }
        float sq = 0.f, sk = 0.f;
#pragma unroll
        for (int x = 0; x < 8; ++x) { q8[x] = q8[x] / (1.0f + __expf(-q8[x])); k8[x] = k8[x] / (1.0f + __expf(-k8[x])); v8[x] = v8[x] / (1.0f + __expf(-v8[x])); sq += q8[x] * q8[x]; sk += k8[x] * k8[x]; }
        sq += __shfl_xor(sq, 1); sq += __shfl_xor(sq, 2); sq += __shfl_xor(sq, 4);
        sk += __shfl_xor(sk, 1); sk += __shfl_xor(sk, 2); sk += __shfl_xor(sk, 4);
        const float rq = 0.125f / sqrtf(sq + EPS), rk = 1.0f / sqrtf(sk + EPS);
        u32x4 qo, ko, vo;
#pragma unroll
        for (int x = 0; x < 4; ++x) { qo[x] = pack_bf16(q8[2 * x] * rq, q8[2 * x + 1] * rq); ko[x] = pack_bf16(k8[2 * x] * rk, k8[2 * x + 1] * rk); vo[x] = pack_bf16(v8[2 * x], v8[2 * x + 1]); }
        bf16* qkg = w.qk + ((size_t)((b * 4 + h) * GD_NC + cc) * 2) * 4096;
        *(u32x4*)(qkg + tl * 64 + dg * 8) = qo; *(u32x4*)(qkg + 4096 + tl * 64 + dg * 8) = ko;
        *(u32x4*)(lds + GP_K + g_lds_off(tl, dg)) = ko;
        *(u32x4*)(lds + GP_V + at_voff(tl, dg * 8)) = vo;
        if (tid < 128) {
            const int dir = tid >> 6, t = tid & 63; const bf16* r = p + (tok0 + t) * DIN + O3 + 1024 + dir * 4 + h;
            const float a = bf2f(r[0]), bbv = bf2f(r[8]); const float x = a + dt_bias[dir * 4 + h]; const float sp = x > 15.f ? x : __logf(1.0f + __expf(x));
            sm[dir * 64 + t] = -__expf(a_log[dir * 4 + h]) * sp; sm[128 + dir * 64 + t] = 1.0f / (1.0f + __expf(-bbv));
        }
    }
    __syncthreads();
    if (wv < 4) {
        const int ta = wv >> 1, tb = wv & 1; f32x16 g;
#pragma unroll
        for (int r = 0; r < 16; ++r) g[r] = 0.f;
#pragma unroll
        for (int ks = 0; ks < 4; ++ks) {
            const bf16x8 fa = *(const bf16x8*)(lds + GP_K + g_lds_off(32 * ta + fr, ks * 2 + fh)), fb = *(const bf16x8*)(lds + GP_K + g_lds_off(32 * tb + fr, ks * 2 + fh));
            g = __builtin_amdgcn_mfma_f32_32x32x16_bf16(fa, fb, g, 0, 0, 0);
        }
        float* G = (float*)(lds + GP_G);
#pragma unroll
        for (int r = 0; r < 16; ++r) G[(32 * ta + (r & 3) + 8 * (r >> 2) + 4 * fh) * 64 + 32 * tb + fr] = g[r];
    } else if (wv < 6) {
        const int dir = wv - 4; float v = sm[dir * 64 + (dir ? 63 - lane : lane)];
#pragma unroll
        for (int o = 1; o < 64; o <<= 1) { const float t = __shfl_up(v, o); if (lane >= o) v += t; }
        sm[256 + dir * 64 + lane] = v;
        float* gcg = w.gc + ((size_t)((b * 4 + h) * 2 + dir) * GD_NC + cc) * 64; gcg[lane] = v;
    }
    __syncthreads();
    const int dir = wv >> 2, t4 = tid & 255;
    {
        const float* G = (const float*)(lds + GP_G); float* Lm = (float*)(lds + GP_L0 + dir * 16384);
        for (int e = t4; e < 4096; e += 256) {
            const int i = e >> 6, j = e & 63; const int ti = dir ? 63 - i : i, tj = dir ? 63 - j : j;
            const float lv = j < i ? sm[128 + dir * 64 + ti] * G[ti * 64 + tj] * __expf(sm[256 + dir * 64 + i] - sm[256 + dir * 64 + j]) : 0.f;
            Lm[e] = lv;
            if (i >= 32 && j < 32) ((bf16*)(lds + GP_LB + dir * 2048))[(i - 32) * 32 + j] = f2bf(lv);
        }
    }
    __syncthreads();
    if ((__builtin_amdgcn_readfirstlane(wv) & 3) == 0) {
        const float* Lm = (const float*)(lds + GP_L0 + dir * 16384);
        char* Tm = lds + GP_T0 + dir * 8192;
        const int blk = lane >> 5, c = lane & 31;
        const LAS float* Lb = (const LAS float*)(Lm + (32 * blk) * 64 + 32 * blk);
        float Tc[32];
#pragma unroll
        for (int i = 0; i < 32; ++i) {
            const LAS float* Lr = Lb + i * 64;
            if (i >= 2) asm volatile("" : "+v"(Lr) : "v"(Tc[i - 2]));
            float a0 = (c == i) ? 1.0f : 0.f, a1 = 0.f, a2 = 0.f, a3 = 0.f;
#pragma unroll
            for (int j4 = 0; j4 < (i & ~3); j4 += 4) {
                const f32x4 l4 = *(const LAS f32x4*)(Lr + j4);
                a0 -= l4[0] * Tc[j4]; a1 -= l4[1] * Tc[j4 + 1]; a2 -= l4[2] * Tc[j4 + 2]; a3 -= l4[3] * Tc[j4 + 3];
            }
#pragma unroll
            for (int j = (i & ~3); j < i; ++j) a0 -= Lr[j] * Tc[j];
            Tc[i] = (a0 + a1) + (a2 + a3);
        }
        {
            int rb = 32 * blk; const int cb = (32 * blk + c) >> 3, cz = (32 * (1 - blk) + c) >> 3, co = (c & 7) * 2;
#pragma unroll
            for (int i = 0; i < 32; ++i) {
                asm volatile("" : "+v"(rb));
                const int row = rb + i, sw = (row >> 1) & 7;
                *(bf16*)(Tm + row * 128 + ((cb ^ sw) << 4) + co) = f2bf(Tc[i]);
                if (blk == 0) *(bf16*)(Tm + row * 128 + ((cz ^ sw) << 4) + co) = (bf16)0;
            }
        }
        asm volatile("s_waitcnt lgkmcnt(0)" ::: "memory");
        const char* Lq = lds + GP_LB + dir * 2048;
        f32x16 X;
#pragma unroll
        for (int r = 0; r < 16; ++r) X[r] = 0.f;
        const int i16 = lane & 15, g1 = (lane >> 4) & 1;
#pragma unroll
        for (int ks = 0; ks < 2; ++ks) {
            const bf16x8 fa = *(const bf16x8*)(Lq + fr * 64 + (ks * 2 + fh) * 16);
            const int jr = 16 * ks + 8 * fh + (i16 >> 2), dc = 16 * g1 + 4 * (i16 & 3);
            const s16x4 t0 = __builtin_amdgcn_ds_read_tr16_b64_v4i16((LAS s16x4*)(Tm + g_lds_off(jr, dc >> 3) + (dc & 7) * 2));
            const s16x4 t1 = __builtin_amdgcn_ds_read_tr16_b64_v4i16((LAS s16x4*)(Tm + g_lds_off(jr + 4, dc >> 3) + (dc & 7) * 2));
            bf16x8 fb; fb[0] = t0[0]; fb[1] = t0[1]; fb[2] = t0[2]; fb[3] = t0[3]; fb[4] = t1[0]; fb[5] = t1[1]; fb[6] = t1[2]; fb[7] = t1[3];
            X = __builtin_amdgcn_mfma_f32_32x32x16_bf16(fa, fb, X, 0, 0, 0);
        }
        f32x16 Y;
#pragma unroll
        for (int r = 0; r < 16; ++r) Y[r] = 0.f;
#pragma unroll
        for (int ks = 0; ks < 2; ++ks) {
            union { bf16x8 v; unsigned u[4]; } xb;
#pragma unroll
            for (int j = 0; j < 4; ++j) xb.u[j] = pack_bf16(X[8 * ks + 2 * j], X[8 * ks + 2 * j + 1]);
            const int c0 = 32 + 16 * ks + 4 * fh, c1 = c0 + 8;
            const u32x2 p0 = *(const u32x2*)(Tm + g_lds_off(32 + fr, c0 >> 3) + (c0 & 7) * 2), p1 = *(const u32x2*)(Tm + g_lds_off(32 + fr, c1 >> 3) + (c1 & 7) * 2);
            union { bf16x8 v; unsigned u[4]; } ta_; ta_.u[0] = p0.x; ta_.u[1] = p0.y; ta_.u[2] = p1.x; ta_.u[3] = p1.y;
            Y = __builtin_amdgcn_mfma_f32_32x32x16_bf16(ta_.v, xb.v, Y, 0, 0, 0);
        }
#pragma unroll
        for (int r = 0; r < 16; ++r) { const int row = 32 + (r & 3) + 8 * (r >> 2) + 4 * fh; *(bf16*)(Tm + g_lds_off(row, fr >> 3) + (fr & 7) * 2) = f2bf(-Y[r]); }
    } else {
        const int t3 = t4 - 64;
        for (int e = t3; e < 1024; e += 192) {
            const int mat = e >> 9, j = (e >> 3) & 63, c8 = e & 7; const int tj = dir ? 63 - j : j;
            const float sc = sm[128 + dir * 64 + tj] * (mat ? __expf(sm[256 + dir * 64 + j]) : 1.0f);
            const u32x4 src = mat ? *(const u32x4*)(lds + GP_K + g_lds_off(tj, c8)) : *(const u32x4*)(lds + GP_V + at_voff(tj, c8 * 8));
            u32x4 d;
#pragma unroll
            for (int x = 0; x < 4; ++x) d[x] = pack_bf16(sc * __uint_as_float(src[x] << 16), sc * __uint_as_float(src[x] & 0xffff0000u));
            *(u32x4*)(lds + GP_VB0 + (dir * 2 + mat) * 8192 + at_voff(j, c8 * 8)) = d;
        }
    }
    __syncthreads();
    {
        const int w4 = wv & 3, ta = w4 >> 1, tb = w4 & 1; const int i16 = lane & 15, g1 = (lane >> 4) & 1;
        const char* Tm = lds + GP_T0 + dir * 8192; const char* vb = lds + GP_VB0 + (dir * 2) * 8192; const char* kbe = vb + 8192;
        f32x16 aw, au;
#pragma unroll
        for (int r = 0; r < 16; ++r) { aw[r] = 0.f; au[r] = 0.f; }
#pragma unroll
        for (int ks = 0; ks < 4; ++ks) {
            const int jr = 16 * ks + 8 * fh + (i16 >> 2), dc = 32 * ta + 16 * g1 + 4 * (i16 & 3);
            const s16x4 k0 = __builtin_amdgcn_ds_read_tr16_b64_v4i16((LAS s16x4*)(kbe + at_voff(jr, dc))), k1 = __builtin_amdgcn_ds_read_tr16_b64_v4i16((LAS s16x4*)(kbe + at_voff(jr + 4, dc)));
            bf16x8 fa; fa[0] = k0[0]; fa[1] = k0[1]; fa[2] = k0[2]; fa[3] = k0[3]; fa[4] = k1[0]; fa[5] = k1[1]; fa[6] = k1[2]; fa[7] = k1[3];
            const bf16x8 fbT = *(const bf16x8*)(Tm + g_lds_off(32 * tb + fr, ks * 2 + fh));
            aw = __builtin_amdgcn_mfma_f32_32x32x16_bf16(fa, fbT, aw, 0, 0, 0);
            const bf16x8 faT = *(const bf16x8*)(Tm + g_lds_off(32 * ta + fr, ks * 2 + fh));
            const int dc2 = 32 * tb + 16 * g1 + 4 * (i16 & 3);
            const s16x4 v0 = __builtin_amdgcn_ds_read_tr16_b64_v4i16((LAS s16x4*)(vb + at_voff(jr, dc2))), v1 = __builtin_amdgcn_ds_read_tr16_b64_v4i16((LAS s16x4*)(vb + at_voff(jr + 4, dc2)));
            bf16x8 fv; fv[0] = v0[0]; fv[1] = v0[1]; fv[2] = v0[2]; fv[3] = v0[3]; fv[4] = v1[0]; fv[5] = v1[1]; fv[6] = v1[2]; fv[7] = v1[3];
            au = __builtin_amdgcn_mfma_f32_32x32x16_bf16(faT, fv, au, 0, 0, 0);
        }
        bf16* uwg = w.uw + ((size_t)(((b * 4 + h) * 2 + dir) * GD_NC + cc) * 2) * 4096;
#pragma unroll
        for (int g = 0; g < 4; ++g) {
            const int rr = 32 * ta + 8 * g + 4 * fh;
            u32x2 o1; o1.x = pack_bf16(-aw[4 * g], -aw[4 * g + 1]); o1.y = pack_bf16(-aw[4 * g + 2], -aw[4 * g + 3]);
            *(u32x2*)(uwg + (32 * tb + fr) * 64 + rr) = o1;
            u32x2 o2; o2.x = pack_bf16(au[4 * g], au[4 * g + 1]); o2.y = pack_bf16(au[4 * g + 2], au[4 * g + 3]);
            *(u32x2*)(uwg + 4096 + (32 * tb + fr) * 64 + rr) = o2;
        }
    }
}
#endif
#ifndef HOST_SIM
constexpr int GS_IN = 0  , GS_ST = 65536  , GS_U1 = GS_ST + 16384, GS_U2 = GS_U1 + 8192, GS_AT = GS_U2 + 8192,
              GS_TB = GS_AT + 8192  , GS_END = GS_TB + 2 * 1024;
__device__ __forceinline__ int gd_chunk_of_step(int dir, int n) { return dir ? (n < 4 ? 3 - n : 39 - n) : n; }

__device__ __forceinline__ void gdn_scan_chain(char* lds, const WS& w, int b, int h, int dir, bool emit_ctx) {
    int tid = threadIdx.x; asm volatile("" : "+v"(tid));
    const int lane = tid & 63, wv = tid >> 6, fr = lane & 31, fh = lane >> 5, w4 = wv & 3, ta = w4 >> 1, tb = w4 & 1;
    const int i16 = lane & 15, g1 = (lane >> 4) & 1;
    const bool lo = wv < 4;
    const size_t chain = (size_t)((b * 4 + h) * 2 + dir) * GD_NC;
    const bf16* qkb = w.qk + (size_t)(b * 4 + h) * GD_NC * 2 * 4096;
    bf16* uwb = w.uw + chain * 2 * 4096; const float* gcb = w.gc + chain * 64;
    const int lrow = tid >> 3, lch = tid & 7;
    const int qrow = dir ? 63 - lrow : lrow;
    __syncthreads();
    *(u32x4*)(lds + GS_ST + tid * 16) = (u32x4){0u, 0u, 0u, 0u};
    f32x16 Sacc;
#pragma unroll
    for (int r = 0; r < 16; ++r) Sacc[r] = 0.f;
    struct Pre { u32x4 rw, rq, rk; float rg; u32x2 uc[4]; };
    Pre pa, pb, pc;
    auto prefetch = [&](int n, Pre& r) {
        const int cc = gd_chunk_of_step(dir, n);
        const bf16* uwp = uwb + (size_t)cc * 2 * 4096; const bf16* qkp = qkb + (size_t)cc * 2 * 4096;
        r.rw = *(const u32x4*)(uwp + lrow * 64 + lch * 8);
        r.rq = *(const u32x4*)(qkp + lrow * 64 + lch * 8); r.rk = *(const u32x4*)(qkp + 4096 + lrow * 64 + lch * 8);
        r.rg = 0.f; if (tid < 64) r.rg = gcb[(size_t)cc * 64 + tid];
        if (lo) { const bf16* up = uwp + 4096 + (32 * tb + fr) * 64 + 32 * ta + 4 * fh;
#pragma unroll
            for (int g = 0; g < 4; ++g) r.uc[g] = *(const u32x2*)(up + 8 * g); }
    };
    auto stage = [&](int buf, const Pre& r) {
        char* ib = lds + GS_IN + buf * 32768;
        *(u32x4*)(ib + g_lds_off(lrow, lch)) = r.rw;
        *(u32x4*)(ib + 8192 + g_lds_off(qrow, lch)) = r.rq;
        *(u32x4*)(ib + 16384 + g_lds_off(qrow, lch)) = r.rk;
        *(u32x4*)(ib + 24576 + at_voff(qrow, lch * 8)) = r.rk;
        float* tbp = (float*)(lds + GS_TB + buf * 1024);
        if (tid < 64) { const float g63 = __shfl(r.rg, 63); tbp[tid] = r.rg; tbp[64 + tid] = __expf(r.rg); tbp[128 + tid] = __expf(g63 - r.rg); if (tid == 0) tbp[192] = __expf(g63); }
    };
    auto step = [&](int n, Pre& cur, const Pre& nx) {
        const int buf = n & 1; const char* ib = lds + GS_IN + buf * 32768; const float* tbp = (const float*)(lds + GS_TB + buf * 1024);
        const char* St = lds + GS_ST + buf * 8192; char* Stn = lds + GS_ST + (buf ^ 1) * 8192;
        const int cc = gd_chunk_of_step(dir, n);
        if (lo) {
            f32x16 acc;
#pragma unroll
            for (int g = 0; g < 4; ++g) { acc[4 * g] = __uint_as_float(cur.uc[g].x << 16); acc[4 * g + 1] = __uint_as_float(cur.uc[g].x & 0xffff0000u); acc[4 * g + 2] = __uint_as_float(cur.uc[g].y << 16); acc[4 * g + 3] = __uint_as_float(cur.uc[g].y & 0xffff0000u); }
#pragma unroll
            for (int ks = 0; ks < 4; ++ks) {
                const bf16x8 fa = *(const bf16x8*)(ib + g_lds_off(32 * ta + fr, ks * 2 + fh)), fb = *(const bf16x8*)(St + g_lds_off(32 * tb + fr, ks * 2 + fh));
                acc = __builtin_amdgcn_mfma_f32_32x32x16_bf16(fa, fb, acc, 0, 0, 0);
            }
#pragma unroll
            for (int g = 0; g < 4; ++g) {
                const int i0 = 32 * ta + 8 * g + 4 * fh; const f32x4 fc = *(const f32x4*)(tbp + 128 + i0);
                u32x2 o1; o1.x = pack_bf16(acc[4 * g], acc[4 * g + 1]); o1.y = pack_bf16(acc[4 * g + 2], acc[4 * g + 3]);
                u32x2 o2; o2.x = pack_bf16(acc[4 * g] * fc[0], acc[4 * g + 1] * fc[1]); o2.y = pack_bf16(acc[4 * g + 2] * fc[2], acc[4 * g + 3] * fc[3]);
                const int off = g_lds_off(32 * tb + fr, i0 >> 3) + (i0 & 7) * 2;
                *(u32x2*)(lds + GS_U1 + off) = o1; *(u32x2*)(lds + GS_U2 + off) = o2;
            }
        } else {
            f32x16 acc;
#pragma unroll
            for (int r = 0; r < 16; ++r) acc[r] = 0.f;
#pragma unroll
            for (int ks = 0; ks < 4; ++ks) {
                const bf16x8 fa = *(const bf16x8*)(ib + 16384 + g_lds_off(32 * ta + fr, ks * 2 + fh)), fb = *(const bf16x8*)(ib + 8192 + g_lds_off(32 * tb + fr, ks * 2 + fh));
                acc = __builtin_amdgcn_mfma_f32_32x32x16_bf16(fa, fb, acc, 0, 0, 0);
            }
            const int i = 32 * tb + fr; const float gi = tbp[i];
#pragma unroll
            for (int g = 0; g < 4; ++g) {
                const int j0 = 32 * ta + 8 * g + 4 * fh; const f32x4 gj = *(const f32x4*)(tbp + j0);
                float v[4];
#pragma unroll
                for (int x = 0; x < 4; ++x) v[x] = (j0 + x <= i) ? acc[4 * g + x] * __expf(gi - gj[x]) : 0.f;
                u32x2 o; o.x = pack_bf16(v[0], v[1]); o.y = pack_bf16(v[2], v[3]);
                *(u32x2*)(lds + GS_AT + g_lds_off(i, j0 >> 3) + (j0 & 7) * 2) = o;
            }
        }
        __syncthreads();
        if (lo) {
            if (cc >= 4 || emit_ctx) {
                f32x16 acc, acc2;
#pragma unroll
                for (int r = 0; r < 16; ++r) { acc[r] = 0.f; acc2[r] = 0.f; }
#pragma unroll
                for (int ks = 0; ks < 4; ++ks) {
                    const bf16x8 fa = *(const bf16x8*)(ib + 8192 + g_lds_off(32 * ta + fr, ks * 2 + fh)), fb = *(const bf16x8*)(St + g_lds_off(32 * tb + fr, ks * 2 + fh));
                    acc = __builtin_amdgcn_mfma_f32_32x32x16_bf16(fa, fb, acc, 0, 0, 0);
                    const bf16x8 fa2 = *(const bf16x8*)(lds + GS_AT + g_lds_off(32 * ta + fr, ks * 2 + fh)), fb2 = *(const bf16x8*)(lds + GS_U1 + g_lds_off(32 * tb + fr, ks * 2 + fh));
                    acc2 = __builtin_amdgcn_mfma_f32_32x32x16_bf16(fa2, fb2, acc2, 0, 0, 0);
                }
                bf16* op = uwb + (size_t)cc * 2 * 4096 + 4096 + (32 * tb + fr) * 64 + 32 * ta + 4 * fh;
#pragma unroll
                for (int g = 0; g < 4; ++g) {
                    const f32x4 eg = *(const f32x4*)(tbp + 64 + 32 * ta + 8 * g + 4 * fh);
                    u32x2 o; o.x = pack_bf16(acc[4 * g] * eg[0] + acc2[4 * g], acc[4 * g + 1] * eg[1] + acc2[4 * g + 1]); o.y = pack_bf16(acc[4 * g + 2] * eg[2] + acc2[4 * g + 2], acc[4 * g + 3] * eg[3] + acc2[4 * g + 3]);
                    *(u32x2*)(op + 8 * g) = o;
                }
            }
        } else {
            const float e63 = tbp[192];
#pragma unroll
            for (int r = 0; r < 16; ++r) Sacc[r] *= e63;
#pragma unroll
            for (int ks = 0; ks < 4; ++ks) {
                const int ir = 16 * ks + 8 * fh + (i16 >> 2), dc = 32 * ta + 16 * g1 + 4 * (i16 & 3);
                const s16x4 k0 = __builtin_amdgcn_ds_read_tr16_b64_v4i16((LAS s16x4*)(ib + 24576 + at_voff(ir, dc))), k1 = __builtin_amdgcn_ds_read_tr16_b64_v4i16((LAS s16x4*)(ib + 24576 + at_voff(ir + 4, dc)));
                bf16x8 fa; fa[0] = k0[0]; fa[1] = k0[1]; fa[2] = k0[2]; fa[3] = k0[3]; fa[4] = k1[0]; fa[5] = k1[1]; fa[6] = k1[2]; fa[7] = k1[3];
                const bf16x8 fb = *(const bf16x8*)(lds + GS_U2 + g_lds_off(32 * tb + fr, ks * 2 + fh));
                Sacc = __builtin_amdgcn_mfma_f32_32x32x16_bf16(fa, fb, Sacc, 0, 0, 0);
            }
#pragma unroll
            for (int g = 0; g < 4; ++g) {
                const int d0 = 32 * ta + 8 * g + 4 * fh; u32x2 o; o.x = pack_bf16(Sacc[4 * g], Sacc[4 * g + 1]); o.y = pack_bf16(Sacc[4 * g + 2], Sacc[4 * g + 3]);
                *(u32x2*)(Stn + g_lds_off(32 * tb + fr, d0 >> 3) + (d0 & 7) * 2) = o;
            }
        }
        if (n + 1 < GD_NC) stage(buf ^ 1, nx);
        if (n + 3 < GD_NC) prefetch(n + 3, cur);
        __syncthreads();
    };
    prefetch(0, pa); prefetch(1, pb); prefetch(2, pc);
    stage(0, pa);
    __syncthreads();
    for (int n = 0; n < GD_NC; n += 3) { step(n, pa, pb); step(n + 1, pb, pc); step(n + 2, pc, pa); }
}

__device__ __forceinline__ void gdn_fin_item(char* lds, const WS& w, const float* ng, int b, int cc, int h) {
    int tid = threadIdx.x; asm volatile("" : "+v"(tid));
    bf16* lo_ = (bf16*)lds;
    __syncthreads();
    for (int i = tid; i < 1024; i += NTHREADS) {
        const int dir = i >> 9, dv = (i >> 3) & 63, k = i & 7;
        const bf16* src = w.uw + ((size_t)(((b * 4 + h) * 2 + dir) * GD_NC + cc) * 2 + 1) * 4096 + dv * 64 + k * 8;
        *(u32x4*)(lo_ + (dir * 64 + dv) * 72 + k * 8) = *(const u32x4*)src;
    }
    __syncthreads();
    const int tl = tid >> 3, dg = tid & 7; const size_t tok = gd_tok0(b, cc) + tl;
    float o[8]; float ss = 0.f;
#pragma unroll
    for (int x = 0; x < 8; ++x) { const int dv = dg * 8 + x; o[x] = bf2f(lo_[dv * 72 + tl]) + bf2f(lo_[(64 + dv) * 72 + 63 - tl]); ss += o[x] * o[x]; }
    ss += __shfl_xor(ss, 1); ss += __shfl_xor(ss, 2); ss += __shfl_xor(ss, 4);
    const float rs = 1.0f / sqrtf(ss * (1.0f / 64.0f) + EPS);
    const u32x4 gt = *(const u32x4*)(w.p + tok * DIN + O3 + 768 + h * 64 + dg * 8);
    u32x4 out;
#pragma unroll
    for (int x = 0; x < 4; ++x) {
        const float g0 = __uint_as_float(gt[x] << 16), g1v = __uint_as_float(gt[x] & 0xffff0000u);
        const float y0 = o[2 * x] * rs * ng[dg * 8 + 2 * x] * (g0 / (1.0f + __expf(-g0))), y1 = o[2 * x + 1] * rs * ng[dg * 8 + 2 * x + 1] * (g1v / (1.0f + __expf(-g1v)));
        out[x] = pack_bf16(y0, y1);
    }
    *(u32x4*)(w.ycat + tok * 1024 + 768 + h * 64 + dg * 8) = out;
}
#endif
#ifndef HOST_SIM
namespace cg = cooperative_groups;
struct MP { Inputs in; float* out; WS w; };

template <class F> __device__ __forceinline__ void dev_run(const F& f, long n) {
    int t0 = threadIdx.x; asm volatile("" : "+v"(t0));
    for (long i = (long)blockIdx.x * NTHREADS + t0; i < n; i += (long)gridDim.x * NTHREADS) f(i);
}

struct TLInProj {
    const bf16* A; const bf16* Bt; EpiInProj e; bool last; static constexpr int K = 1024;
    struct Tile { int m0, n0; };
    __device__ __forceinline__ bool tile(int idx, Tile& t) const {
        constexpr int NT = (DIN + GBN - 1) / GBN, LT = (TL / GBM) * NT;
        if (idx < LT) { const int mg = idx / (8 * NT), rem = idx % (8 * NT); t.n0 = (rem / 8) * GBN; t.m0 = (mg * 8 + (rem & 7)) * GBM; return true; }
        idx -= LT;
        const int nct = last ? 15 : NT;
        if (idx >= (TC / GBM) * nct) return false;
        int nt = idx >> 3; if (last) nt = nt < 2 ? 8 + nt : 10 + nt;
        t.n0 = nt * GBN; t.m0 = TL + (idx & 7) * GBM; return true;
    }
    __device__ __forceinline__ const bf16* arow(const Tile& t, int r) const { return A + (size_t)(t.m0 + r) * D; }
    __device__ __forceinline__ const bf16* brow(const Tile& t, int r) const { return Bt + (size_t)(t.n0 + (r & 64) + perm64(r & 63)) * 1024; }
    __device__ __forceinline__ void epi(const Tile& t, f32x16 (&acc)[2][2], int mr, int nc) const { e(acc, t.m0 + mr, t.n0 + nc); }
};
struct TLOutProj {
    const bf16* A; const bf16* Bt; EpiOutProj e; int ntiles; static constexpr int K = 1024;
    struct Tile { int m0, n0; };
    __device__ __forceinline__ bool tile(int idx, Tile& t) const { if (idx >= ntiles) return false; t.m0 = (idx >> 3) * GBM; t.n0 = (idx & 7) * GBN; return true; }
    __device__ __forceinline__ const bf16* arow(const Tile& t, int r) const { return A + (size_t)(t.m0 + r) * 1024; }
    __device__ __forceinline__ const bf16* brow(const Tile& t, int r) const { return Bt + (size_t)(t.n0 + r) * 1024; }
    __device__ __forceinline__ void epi(const Tile& t, f32x16 (&acc)[2][2], int mr, int nc) const { e(acc, t.m0 + mr, t.n0 + nc); }
};
__device__ __forceinline__ void phase_inproj(char* lds, const WS& w, int l) {
    gemm_stream(lds, TLInProj{l == 0 ? w.h : w.hid2, w.winT + (size_t)l * 3328 * 1024, EpiInProj{w.p, w.rope}, l == 1});
}
__device__ __forceinline__ void phase_outproj(char* lds, const WS& w, int l, const float* mod, int ntok, const float* xin, const float* cin) {
    gemm_stream(lds, TLOutProj{w.ycat, w.woutT + (size_t)l * 1024 * 1024, EpiOutProj{w.xr, mod, l == 0 ? xin : nullptr, cin}, (ntok / GBM) * 8});
}
struct EpiStoreP { bf16* p;
    __device__ __forceinline__ void operator()(f32x16 (&acc)[2][2], int mrow, int ncol) const {
#pragma unroll
        for (int mi = 0; mi < 2; ++mi)
#pragma unroll
            for (int ni = 0; ni < 2; ++ni)
#pragma unroll
                for (int g = 0; g < 4; ++g) { u32x2 v; v.x = pack_bf16(acc[mi][ni][4 * g], acc[mi][ni][4 * g + 1]); v.y = pack_bf16(acc[mi][ni][4 * g + 2], acc[mi][ni][4 * g + 3]);
                    *(u32x2*)(p + (size_t)(mrow + mi * 32) * 1024 + ncol + ni * 32 + 8 * g) = v; }
    } };
__device__ __forceinline__ void phase_outproj_dup(char* lds, const WS& w, int l, int ntok) {
    const int MT = ntok / GBM, NT = D / GBN;
    const bf16* Bt = w.woutT + (size_t)l * 1024 * 1024;
    for (int tile = blockIdx.x; tile < MT * NT; tile += gridDim.x) {
        const int mt = tile / NT, nt = tile % NT;
        gemm_tile(lds, ARowDense{w.ycat, 1024, mt * GBM}, Bt, 1024, 1024, mt * GBM, nt * GBN, EpiStoreP{w.p});
    }
}
__device__ __forceinline__ int q_next(int* head, int* slot  ) {
    __syncthreads();
    if (threadIdx.x == 0) *slot = __hip_atomic_fetch_add(head, 1, __ATOMIC_RELAXED, __HIP_MEMORY_SCOPE_AGENT);
    __syncthreads();
    return *slot;
}
__global__ void __launch_bounds__(NTHREADS) mega_kernel(MP mp) {
    extern __shared__ __attribute__((aligned(16))) char lds[];
    __shared__ uint4 xb_words;
    __shared__ int q_slot[4];
    cg::grid_group grid = cg::this_grid();
    const Inputs& in = mp.in; const WS& w = mp.w;
    if (threadIdx.x == 0) xb_words = make_uint4(0u, 0u, 0u, 0u);
    __syncthreads();
    XcdBarrier xb = xcd_barrier_post(w.bar, (volatile LAS unsigned*)&xb_words);
#define GSYNC(id) xcd_barrier(xb)
    phase_ada(lds, w, in);
    dev_run(NkRopeTab{w.rope}, NkRopeTab::count());
    dev_run(NkZeroI{w.cnt}, 4 * 32 * 32);
    dev_run(NkZeroI{w.qctr}, 64 * 64);
    for (int it = blockIdx.x; it < 16 * 52; it += gridDim.x) cvt_tile(lds, in.w_in, DIN, w.winT, 1024, (it / 52) * 64, (it % 52) * 64, DIN, 3328, NMapId{});
    for (int l = 0; l < 2; ++l) {
        hy_filter_mlp(lds, in.hy_w1 + l * 33 * 64, in.hy_b1 + l * 64, in.hy_w2 + l * 64 * 64, in.hy_b2 + l * 64, in.hy_freq + l * 64, w.f2b + (size_t)l * (S + LC) * 64);
        { NkCvtT c4{in.hy_w3 + (size_t)l * 64 * 512, w.w3T + (size_t)l * 512 * 64, 64, 512, 512}; dev_run(c4, c4.count()); }
    }
    if (mp.out == nullptr) grid.sync();
    xcd_barrier(xb);
    row_pass<3, 1>(w, in, T, w.mod, w.mod, in.norm1, 0, 1, nullptr, nullptr, nullptr, w.h);
    GSYNC(0);
    for (int l = 0; l < 2; ++l) {
        const bool need_ctx = l == 0;
        const float* mod = w.mod + (size_t)l * 9 * 6144;
        const long ntok = need_ctx ? T : TL;
        const float* filt = w.filt + (size_t)l * (S + LC) * 512;
        phase_inproj(lds, w, l);
        hy_filter_out(w.w3T + (size_t)l * 512 * 64, w.f2b + (size_t)l * (S + LC) * 64, w.filt + (size_t)l * (S + LC) * 512);
        GSYNC(2);
        const float* hcw = in.hy_conv + l * 3 * 768;
        if (l == 0) for (int l2 = 0; l2 < 2; ++l2) { NkCvtT c3{in.moe_router + (size_t)l2 * D * 32, w.wrT + (size_t)l2 * 32 * 1024, 1024, 32, 32}; dev_run(c3, c3.count()); }
        {
            const int n_gp = B * GD_NC * 4, n_hp = B * 32 + (need_ctx ? B * 4 : 0), n_cv = l == 0 ? 104 + 64 : 0;
            int* head = w.qctr + (2 + l) * 64;
            for (;;) {
                int it = q_next(head, q_slot);
                if (it >= n_gp + n_hp + n_cv) break;
                if (it < n_gp) { gdn_pre_item(lds, w, in.gdn_conv + l * 4 * 768, in.gdn_a_log + l * 8, in.gdn_dt_bias + l * 8, it / (GD_NC * 4), (it >> 2) % GD_NC, it & 3); continue; }
                it -= n_gp;
                if (it < n_hp) { if (it < B * 32) hy_prep_item(lds, w.p, hcw, w.x0T, w.uvT, it >> 5, it & 31); else hy_prep_item(lds, w.p, hcw, w.x0Tc, w.uvTc, (it - B * 32) >> 2, (it - B * 32) & 3, true); continue; }
                it -= n_hp;
                if (it < 104) { for (int q = it * 8; q < it * 8 + 8; ++q) cvt_tile(lds, in.w_in + (size_t)D * DIN, DIN, w.winT + (size_t)3328 * 1024, 1024, (q / 52) * 64, (q % 52) * 64, DIN, 3328, NMapId{}); }
                else { const int g = it - 104, l2 = g >> 5; for (int q = (g & 31) * 8; q < (g & 31) * 8 + 8; ++q) cvt_tile(lds, in.w_out + (size_t)l2 * 1024 * D, D, w.woutT + (size_t)l2 * 1024 * 1024, 1024, (q >> 4) * 64, (q & 15) * 64, D, D, NMapId{}); }
            }
        }
        GSYNC(90);
        {
            const int natt = 512 + (need_ctx ? 64 : 0);
            int* head = w.qctr + l * 64;
            for (;;) {
                const int it = q_next(head, q_slot);
                if (it >= 64 + 256 + natt) break;
                if (it < 64) gdn_scan_chain(lds, w, it >> 3, (it >> 1) & 3, it & 1, need_ctx);
                else if (it < 320) hy_conv_item(lds, filt, in.hy_bias + l * 256, w.uvT, w.x0T, it - 64, need_ctx ? w.uvTc : nullptr, w.x0Tc);
                else { int a = it - 320; a = a < 256 ? a + 256 : (a < 512 ? a - 256 : a); attn_item(lds, w, in, l, a); }
            }
        }
        GSYNC(91);
        for (int it = blockIdx.x; it < B * 32 + (need_ctx ? B * 4 : 0); it += gridDim.x) { if (it < B * 32) hy_fin_item(lds, w.x0T, w.ycat, it >> 5, it & 31); else hy_fin_item(lds, w.x0Tc, w.ycat, (it - B * 32) >> 2, (it - B * 32) & 3, true); }
        for (int it = blockIdx.x; it < B * GD_NC * 4; it += gridDim.x) { const int cc = (it >> 2) % GD_NC; if (cc >= 4 || need_ctx) gdn_fin_item(lds, w, in.gdn_norm + l * 64, it / (GD_NC * 4), cc, it & 3); }
        GSYNC(5);
        phase_outproj(lds, w, l, mod, (int)ntok, in.x, in.ctx);
        {
            const int skip = (l == 0 && (int)gridDim.x > 128) ? 64 : 0;
            if ((int)blockIdx.x >= skip) {
                const int b0 = (int)blockIdx.x - skip, nb = (int)gridDim.x - skip;
                for (int it = b0; it < 33 * 2 * 16; it += nb) {
                    const int e = it >> 5, which = (it >> 4) & 1, kt = it & 15;
                    const float* src = e < 32 ? (which ? in.moe_up : in.moe_gate) + ((size_t)l * 32 + e) * D * 256 : (which ? in.sh_up : in.sh_gate) + (size_t)l * D * 256;
                    cvt_strip(lds, src, 256, w.moeUpT + (size_t)e * 512 * 1024, 1024, kt * 64, 0, 256, 256, NMapUp{which});
                }
                for (int it = b0; it < 33 * 16; it += nb) {
                    const int e = it >> 4, kt = (it >> 2) & 3, st = it & 3;
                    const float* src = e < 32 ? in.moe_down + ((size_t)l * 32 + e) * 256 * D : in.sh_down + (size_t)l * 256 * D;
                    cvt_strip(lds, src, D, w.moeDownT + (size_t)e * 1024 * 256, 256, kt * 64, st * 256, D, D, NMapId{});
                }
            }
        }
        GSYNC(6);
        phase_norm2_router(lds, w, in, (int)ntok, mod, in.norm2 + l * D, in.moe_bias + l * 32, l);
        GSYNC(7);
        phase_moe_up(lds, w, l, (int)ntok);
        GSYNC(9);
        phase_moe_down(lds, w, l, (int)ntok, mod);
        GSYNC(10);
        if (l == 0) row_pass<2, 1>(w, in, (int)ntok, mod, w.mod + (size_t)9 * 6144, in.norm1 + D, 0, 1, (const bf16*)w.h, w.topw, nullptr, w.hid2);
        else row_pass<2, 2>(w, in, (int)ntok, mod, mod, in.norm_f, 0, 0, (const bf16*)w.h, w.topw, mp.out, nullptr);
        GSYNC(11);
    }
}

constexpr size_t kDynLds = G_LDS3;
static_assert(H_LDS <= kDynLds &&  HY_LDS_END <= kDynLds && AT_RING * AT_STAGE + 2048 <= kDynLds && GP_END <= kDynLds && GS_END <= kDynLds, "LDS budget");
extern "C" void kernel_launch(void* const* d_in, const int* in_sizes, int n_in, void* d_out, int out_size, void* d_ws, size_t ws_size, hipStream_t stream) {
    static int grid_blocks = 0;
    if (!grid_blocks) {
        int dev = 0, cus = 0, per_cu = 0;
        hipGetDevice(&dev);
        hipDeviceGetAttribute(&cus, hipDeviceAttributeMultiprocessorCount, dev);
        hipFuncSetAttribute((const void*)mega_kernel, hipFuncAttributeMaxDynamicSharedMemorySize, (int)kDynLds);
        hipOccupancyMaxActiveBlocksPerMultiprocessor(&per_cu, mega_kernel, NTHREADS, kDynLds);
        if (per_cu < 1) per_cu = 1;
        grid_blocks = cus;
    }
    MP mp; memset(&mp, 0, sizeof(mp));
    const float** ip = (const float**)&mp.in;
    for (int i = 0; i < 33; ++i) ip[i] = (const float*)d_in[i];
    mp.out = (float*)d_out; mp.w = make_ws(d_ws);
    hipMemsetAsync(mp.w.bar, 0, 4096 * 4, stream);
    void* args[] = {&mp};
    hipError_t e = hipLaunchCooperativeKernel((void*)mega_kernel, dim3(grid_blocks), dim3(NTHREADS), args, kDynLds, stream);
    if (e != hipSuccess) fprintf(stderr, "cooperative launch failed: %s (grid %d)\n", hipGetErrorString(e), grid_blocks);
}
#endif
```
